# Optimizing an MI355X kernel written in HIP

```python
import math
import jax, jax.numpy as jnp
from jax import lax
import numpy as np

D_MODEL = 1024
BATCH = 8
SEQ = 2048
DEPTH = 2

N_MEM = 256
HEAD_DIM = 128
DN_HEADS = D_MODEL // HEAD_DIM
FOX_HEADS = D_MODEL // HEAD_DIM
MEM_HEADS = 4
MIX_WIDTH = D_MODEL
MEM_WIDTH = MEM_HEADS * HEAD_DIM
D_FF = 4 * D_MODEL
CONV_WIDTH = 4
CHUNK = 64
Q_BLOCK = 128
EPS = 1e-6
N_DN = (DEPTH + 1) // 2
N_FOX = DEPTH // 2
DN_IN = 4 * MIX_WIDTH + 2 * DN_HEADS + MEM_WIDTH
FOX_IN = 4 * MIX_WIDTH + FOX_HEADS + MEM_WIDTH
OUT_IN = MIX_WIDTH + MEM_WIDTH

kernel_name = "hybrid_deltanet_fox_memory_decoder"


def rms_norm(x, w):
    xf = x.astype(jnp.float32)
    y = xf * lax.rsqrt(jnp.mean(xf * xf, axis=-1, keepdims=True) + EPS)
    return (y * w.astype(jnp.float32)).astype(x.dtype)


def l2_norm(x):
    xf = x.astype(jnp.float32)
    return xf * lax.rsqrt(jnp.sum(xf * xf, axis=-1, keepdims=True) + EPS)


def split_heads(t, heads):
    return t.reshape(t.shape[:-1] + (heads, HEAD_DIM))


def causal_depthwise_conv(x, w):
    c = x.shape[-1]
    return lax.conv_general_dilated(
        x, w[:, None, :].astype(x.dtype), window_strides=(1,),
        padding=[(CONV_WIDTH - 1, 0)], dimension_numbers=("NWC", "WIO", "NWC"),
        feature_group_count=c)


def chunked_gated_delta_rule(q, k, v, g, beta):
    bsz, seq, heads, _ = q.shape
    n = seq // CHUNK

    def chunks(t):
        return t.reshape(bsz, n, CHUNK, heads, -1).transpose(1, 0, 3, 2, 4)

    qc, kc, vc = chunks(q), chunks(k), chunks(v)
    gc = chunks(g[..., None])[..., 0]
    bc = chunks(beta[..., None])[..., 0]
    gcum = jnp.cumsum(gc, axis=-1)
    causal = jnp.tril(jnp.ones((CHUNK, CHUNK), dtype=bool))
    strict = jnp.tril(jnp.ones((CHUNK, CHUNK), dtype=bool), -1)
    diff = gcum[..., :, None] - gcum[..., None, :]
    decay = jnp.where(causal, jnp.exp(jnp.where(causal, diff, 0.0)), 0.0)
    kb = kc * bc[..., None]
    a_mat = jnp.where(strict, jnp.einsum("nbhik,nbhjk->nbhij", kb, kc) * decay, 0.0)
    eye = jnp.eye(CHUNK, dtype=jnp.float32)
    t_mat = lax.linalg.triangular_solve(
        eye + a_mat, jnp.broadcast_to(eye, a_mat.shape), left_side=True, lower=True)
    u = jnp.einsum("nbhij,nbhjv->nbhiv", t_mat, vc * bc[..., None])
    w = jnp.einsum("nbhij,nbhjk->nbhik", t_mat, kb * jnp.exp(gcum)[..., None])
    qk = jnp.where(causal, jnp.einsum("nbhik,nbhjk->nbhij", qc, kc) * decay, 0.0)

    def step(state, inp):
        q_i, k_i, u_i, w_i, qk_i, g_i = inp
        v_new = u_i - jnp.einsum("bhck,bhkv->bhcv", w_i, state)
        out = (jnp.einsum("bhck,bhkv->bhcv", q_i * jnp.exp(g_i)[..., None], state)
               + jnp.einsum("bhij,bhjv->bhiv", qk_i, v_new))
        g_last = g_i[..., -1:]
        k_dec = k_i * jnp.exp(g_last - g_i)[..., None]
        state = state * jnp.exp(g_last)[..., None] + jnp.einsum("bhck,bhcv->bhkv", k_dec, v_new)
        return state, out

    state0 = jnp.zeros((bsz, heads, q.shape[-1], v.shape[-1]), jnp.float32)
    _, o = lax.scan(step, state0, (qc, kc, u, w, qk, gcum))
    return o.transpose(1, 0, 3, 2, 4).reshape(bsz, seq, heads, -1)


def gated_deltanet(h, w_in, conv_w, a_log, dt_bias, o_norm_w):
    bsz, seq, _ = h.shape
    proj = h @ w_in
    qkv = proj[..., : 3 * MIX_WIDTH]
    z = proj[..., 3 * MIX_WIDTH: 4 * MIX_WIDTH]
    a = proj[..., 4 * MIX_WIDTH: 4 * MIX_WIDTH + DN_HEADS]
    b = proj[..., 4 * MIX_WIDTH + DN_HEADS: 4 * MIX_WIDTH + 2 * DN_HEADS]
    q_mem = proj[..., 4 * MIX_WIDTH + 2 * DN_HEADS:]
    qkv = jax.nn.silu(causal_depthwise_conv(qkv, conv_w))
    q = l2_norm(split_heads(qkv[..., :MIX_WIDTH], DN_HEADS)) * (HEAD_DIM ** -0.5)
    k = l2_norm(split_heads(qkv[..., MIX_WIDTH: 2 * MIX_WIDTH], DN_HEADS))
    v = split_heads(qkv[..., 2 * MIX_WIDTH:], DN_HEADS).astype(jnp.float32)
    beta = jax.nn.sigmoid(b.astype(jnp.float32))
    g = -jnp.exp(a_log.astype(jnp.float32)) * jax.nn.softplus(
        a.astype(jnp.float32) + dt_bias.astype(jnp.float32))
    o = chunked_gated_delta_rule(q, k, v, g, beta)
    o = rms_norm(o, o_norm_w) * jax.nn.silu(split_heads(z, DN_HEADS).astype(jnp.float32))
    return o.reshape(bsz, seq, MIX_WIDTH).astype(h.dtype), q_mem


def forgetting_attention(h, w_in, f_bias, q_norm_w, k_norm_w):
    bsz, seq, _ = h.shape
    proj = h @ w_in
    q = split_heads(proj[..., :MIX_WIDTH], FOX_HEADS)
    k = split_heads(proj[..., MIX_WIDTH: 2 * MIX_WIDTH], FOX_HEADS)
    v = split_heads(proj[..., 2 * MIX_WIDTH: 3 * MIX_WIDTH], FOX_HEADS)
    gate = proj[..., 3 * MIX_WIDTH: 4 * MIX_WIDTH]
    f_logit = proj[..., 4 * MIX_WIDTH: 4 * MIX_WIDTH + FOX_HEADS]
    q_mem = proj[..., 4 * MIX_WIDTH + FOX_HEADS:]
    q = rms_norm(q, q_norm_w).astype(jnp.float32) * (HEAD_DIM ** -0.5)
    k = rms_norm(k, k_norm_w).astype(jnp.float32)
    log_f = jax.nn.log_sigmoid(f_logit.astype(jnp.float32) + f_bias.astype(jnp.float32))
    f_cum = jnp.cumsum(log_f, axis=1).transpose(0, 2, 1)
    nb = seq // Q_BLOCK
    q_blocks = q.reshape(bsz, nb, Q_BLOCK, FOX_HEADS, HEAD_DIM).transpose(1, 0, 2, 3, 4)
    f_blocks = f_cum.reshape(bsz, FOX_HEADS, nb, Q_BLOCK).transpose(2, 0, 1, 3)
    k_pos = jnp.arange(seq)

    def block(args):
        qb, fb, i = args
        s = jnp.einsum("bqhd,bkhd->bhqk", qb, k)
        bias = fb[..., :, None] - f_cum[:, :, None, :]
        q_pos = i * Q_BLOCK + jnp.arange(Q_BLOCK)
        mask = k_pos[None, :] <= q_pos[:, None]
        p = jax.nn.softmax(jnp.where(mask, s + bias, -jnp.inf), axis=-1)
        return jnp.einsum("bhqk,bkhd->bqhd", p.astype(v.dtype), v)

    o = lax.map(block, (q_blocks, f_blocks, jnp.arange(nb)))
    o = o.transpose(1, 0, 2, 3, 4).reshape(bsz, seq, MIX_WIDTH)
    o = o.astype(jnp.float32) * jax.nn.sigmoid(gate.astype(jnp.float32))
    return o.astype(h.dtype), q_mem


def memory_attention(q_mem, mem_k, mem_v, q_norm_w):
    bsz, seq, _ = q_mem.shape
    q = rms_norm(split_heads(q_mem, MEM_HEADS), q_norm_w).astype(jnp.float32) * (HEAD_DIM ** -0.5)
    p = jax.nn.softmax(jnp.einsum("bthd,bmhd->bhtm", q, mem_k), axis=-1)
    o = jnp.einsum("bhtm,bmhd->bthd", p.astype(mem_v.dtype), mem_v)
    return o.reshape(bsz, seq, MEM_WIDTH).astype(q_mem.dtype)


def setup_inputs(seed: int = 0) -> dict:
    key = jax.random.key(seed)
    ks = jax.random.split(key, 20)
    f32 = jnp.float32

    def dense(k, shape, fan_in):
        return jax.random.normal(k, shape, f32) * fan_in ** -0.5

    def gain(k, shape):
        return 1.0 + 0.02 * jax.random.normal(k, shape, f32)

    dt = jnp.exp(jax.random.uniform(ks[9], (N_DN, DN_HEADS), f32, math.log(1e-3), math.log(1e-1)))
    return {
        "x": jax.random.normal(ks[0], (BATCH, SEQ, D_MODEL), f32),
        "mem": jax.random.normal(ks[1], (BATCH, N_MEM, D_MODEL), f32),
        "mem_norm_w": gain(ks[2], (D_MODEL,)),
        "w_mem_kv": dense(ks[3], (D_MODEL, 2 * MEM_WIDTH), D_MODEL),
        "mem_k_norm_w": gain(ks[4], (HEAD_DIM,)),
        "norm1_w": gain(ks[5], (DEPTH, D_MODEL)),
        "dn_w_in": dense(ks[6], (N_DN, D_MODEL, DN_IN), D_MODEL),
        "dn_conv_w": dense(ks[7], (N_DN, CONV_WIDTH, 3 * MIX_WIDTH), CONV_WIDTH),
        "dn_a_log": jnp.log(jax.random.uniform(ks[8], (N_DN, DN_HEADS), f32, 1.0, 16.0)),
        "dn_dt_bias": dt + jnp.log(-jnp.expm1(-dt)),
        "dn_o_norm_w": gain(ks[10], (N_DN, HEAD_DIM)),
        "fox_w_in": dense(ks[11], (N_FOX, D_MODEL, FOX_IN), D_MODEL),
        "fox_f_bias": jax.random.uniform(ks[12], (N_FOX, FOX_HEADS), f32, 1.0, 4.0),
        "fox_q_norm_w": gain(ks[13], (N_FOX, HEAD_DIM)),
        "fox_k_norm_w": gain(ks[14], (N_FOX, HEAD_DIM)),
        "memq_norm_w": gain(ks[15], (DEPTH, HEAD_DIM)),
        "w_out": dense(ks[16], (DEPTH, OUT_IN, D_MODEL), OUT_IN),
        "norm2_w": gain(ks[17], (DEPTH, D_MODEL)),
        "w_mlp1": dense(ks[18], (DEPTH, D_MODEL, D_FF), D_MODEL),
        "w_mlp2": dense(ks[19], (DEPTH, D_FF, D_MODEL), D_FF),
    }


def reference(x, mem, mem_norm_w, w_mem_kv, mem_k_norm_w, norm1_w, dn_w_in, dn_conv_w,
              dn_a_log, dn_dt_bias, dn_o_norm_w, fox_w_in, fox_f_bias, fox_q_norm_w,
              fox_k_norm_w, memq_norm_w, w_out, norm2_w, w_mlp1, w_mlp2):
    mem_kv = rms_norm(mem, mem_norm_w) @ w_mem_kv
    mem_k = rms_norm(split_heads(mem_kv[..., :MEM_WIDTH], MEM_HEADS), mem_k_norm_w).astype(jnp.float32)
    mem_v = split_heads(mem_kv[..., MEM_WIDTH:], MEM_HEADS)
    for i in range(DEPTH):
        h = rms_norm(x, norm1_w[i])
        j = i // 2
        if i % 2 == 0:
            mix, q_mem = gated_deltanet(h, dn_w_in[j], dn_conv_w[j], dn_a_log[j],
                                        dn_dt_bias[j], dn_o_norm_w[j])
        else:
            mix, q_mem = forgetting_attention(h, fox_w_in[j], fox_f_bias[j],
                                              fox_q_norm_w[j], fox_k_norm_w[j])
        mem_out = memory_attention(q_mem, mem_k, mem_v, memq_norm_w[i])
        x = x + jnp.concatenate([mix, mem_out], axis=-1) @ w_out[i]
        h = rms_norm(x, norm2_w[i])
        x = x + jnp.square(jax.nn.relu(h @ w_mlp1[i])) @ w_mlp2[i]
    return x
```

```cpp
#include <hip/hip_runtime.h>
#include <cstdio>
#include <cstdint>

constexpr int BATCH = 8, SEQ = 2048, DM = 1024, MROWS = BATCH * SEQ;
constexpr int NMEM = 256, MMEM = BATCH * NMEM;
constexpr int HD = 128, NH = 8, NMH = 4, FF = 4096;
constexpr int PW = 4608;
constexpr int PC_K = 0, PC_V = 1024, PC_Z = 2048, PC_Q = 3072, PC_QM = 4096, PC_AB = 4608;
constexpr int N_IN = 4864;
constexpr int DN_IN = 4624, FOX_IN = 4616, OUT_IN = 1536;
constexpr float EPS = 1e-6f;
constexpr float QSCALE = 0.08838834764831845f;

namespace pg8 {
#define PG8_LAS __attribute__((address_space(3)))
typedef unsigned short bf16_t;
typedef short bf16x8 __attribute__((ext_vector_type(8)));
typedef float f32x4 __attribute__((ext_vector_type(4)));
typedef unsigned u32x4 __attribute__((ext_vector_type(4)));
constexpr int BM = 256, BK = 64, HALF = 128, HTB = HALF * BK * 2  , STAGE_BYTES = 8 * HTB, NXCD = 8, WGM = 8;

__host__ __device__ __forceinline__ int lds_byte(int r, int c) { const int st = (r >> 4) * 2 + (c >> 5), rr = r & 15, cc = c & 31, ob = rr * 64 + cc * 2; return st * 1024 + (ob ^ (((ob >> 9) & 1) << 5)); }
__host__ __device__ __forceinline__ void stage_rc(int b, int& R, int& C) { const int st = b / 1024, sb = b % 1024, swz = sb ^ (((sb >> 9) & 1) << 5); R = (st >> 1) * 16 + swz / 64; C = (st & 1) * 32 + (swz % 64) / 2; }
__host__ __device__ __forceinline__ int perm32(int rho) { const int n = rho >> 4, i = rho & 15; return 8 * (i >> 2) + 4 * n + (i & 3); }

struct Unit { int pm, pn; };
struct Gemm { const bf16_t* A; const bf16_t* Bt; int M, N, K, lda; };

struct StaticOrder {
    int nM, nN, nwg, G, c;
    __host__ __device__ void init(int M, int N, int G_, int c_) { nM = M / BM; nN = N / BM; nwg = nM * nN; G = G_; c = c_; }
    __host__ __device__ bool next(int i, Unit& u) const {
        const long L = (long)i * G + c; if (L >= nwg) return false;
        int wgid = (int)L; { const int q = nwg / NXCD, r = nwg % NXCD, xcd = wgid % NXCD, off = wgid / NXCD; wgid = (xcd < r ? xcd * (q + 1) : r * (q + 1) + (xcd - r) * q) + off; }
        const int nig = WGM * nN, gid = wgid / nig, fm = gid * WGM, gsz = (nM - fm) < WGM ? (nM - fm) : WGM;
        u.pm = fm + ((wgid % nig) % gsz); u.pn = (wgid % nig) / gsz; return true;
    }
    __device__ __forceinline__ void a_ready(const Unit&) const {}
    __device__ __forceinline__ void done(const Unit&) const {}
};


__device__ __forceinline__ unsigned cvt_pk_bf16(float lo, float hi) { unsigned r; asm volatile("v_cvt_pk_bf16_f32 %0, %1, %2" : "=v"(r) : "v"(lo), "v"(hi)); return r; }

template <bool SSQ, bool RELU2> struct EpiProj {
    static constexpr bool PERM = true, AFTER_DRAIN = false;
    bf16_t* O; int ldc; const float* xsq; float* ssq; int ssq_rows; float* ab; int n_main;
    __device__ __forceinline__ void operator()(const f32x4 (&acc)[2][2][4][2], const Unit& u, int wr, int wc, int fr, int fq) const {
        const int row0 = u.pm * BM + wr * 64 + fr, colt = u.pn * BM;
        const bool is_ab = u.pn >= n_main;
#pragma unroll
        for (int ai = 0; ai < 2; ++ai)
#pragma unroll
            for (int m = 0; m < 4; ++m) {
                const int r = row0 + ai * HALF + m * 16;
                const f32x4 q4 = *(const f32x4*)(xsq + (size_t)r * 16 + 4 * fq);
                float s = (q4[0] + q4[1]) + (q4[2] + q4[3]);
                s += __shfl_xor(s, 16); s += __shfl_xor(s, 32);
                const float rstd = rsqrtf(s * (1.0f / 1024.0f) + 1e-6f);
                if (!is_ab) {
#pragma unroll
                    for (int bj = 0; bj < 2; ++bj) {
                        f32x4 v0 = acc[ai][bj][m][0] * rstd, v1 = acc[ai][bj][m][1] * rstd;
                        if (SSQ) {
                            float ss = ((v0[0] * v0[0] + v0[1] * v0[1]) + (v0[2] * v0[2] + v0[3] * v0[3])) + ((v1[0] * v1[0] + v1[1] * v1[1]) + (v1[2] * v1[2] + v1[3] * v1[3]));
                            ss += __shfl_xor(ss, 16); ss += __shfl_xor(ss, 32);
                            if (fq == 0) ssq[((size_t)((colt >> 7) + bj) * ssq_rows + r) * 4 + wc] = ss;
                        }
                        if (RELU2) {
#pragma unroll
                            for (int e = 0; e < 4; ++e) { const float a = fmaxf(v0[e], 0.f), b = fmaxf(v1[e], 0.f); v0[e] = a * a; v1[e] = b * b; }
                        }
                        u32x4 w; w.x = cvt_pk_bf16(v0[0], v0[1]); w.y = cvt_pk_bf16(v0[2], v0[3]); w.z = cvt_pk_bf16(v1[0], v1[1]); w.w = cvt_pk_bf16(v1[2], v1[3]);
                        *(u32x4*)(O + (size_t)r * ldc + colt + bj * HALF + wc * 32 + 8 * fq) = w;
                    }
                } else if (ab != nullptr && wc == 0 && fq < 2) {
                    float* p = ab + (size_t)r * 16 + 8 * fq;
                    *(f32x4*)p = acc[ai][0][m][0] * rstd; *(f32x4*)(p + 4) = acc[ai][0][m][1] * rstd;
                }
            }
    }
};
struct EpiRes {
    static constexpr bool PERM = true, AFTER_DRAIN = false;
    const float* xold; float* xnew; bf16_t* xb; float* xsq;
    __device__ __forceinline__ void operator()(const f32x4 (&acc)[2][2][4][2], const Unit& u, int wr, int wc, int fr, int fq) const {
        const int row0 = u.pm * BM + wr * 64 + fr, colt = u.pn * BM;
#pragma unroll
        for (int ai = 0; ai < 2; ++ai)
#pragma unroll
            for (int m = 0; m < 4; ++m) {
                const int r = row0 + ai * HALF + m * 16; float ss = 0.f;
#pragma unroll
                for (int bj = 0; bj < 2; ++bj) {
                    const size_t off = (size_t)r * 1024 + colt + bj * HALF + wc * 32 + 8 * fq;
                    const f32x4 v0 = acc[ai][bj][m][0] + *(const f32x4*)(xold + off), v1 = acc[ai][bj][m][1] + *(const f32x4*)(xold + off + 4);
                    *(f32x4*)(xnew + off) = v0; *(f32x4*)(xnew + off + 4) = v1;
                    ss += ((v0[0] * v0[0] + v0[1] * v0[1]) + (v0[2] * v0[2] + v0[3] * v0[3])) + ((v1[0] * v1[0] + v1[1] * v1[1]) + (v1[2] * v1[2] + v1[3] * v1[3]));
                    u32x4 w; w.x = cvt_pk_bf16(v0[0], v0[1]); w.y = cvt_pk_bf16(v0[2], v0[3]); w.z = cvt_pk_bf16(v1[0], v1[1]); w.w = cvt_pk_bf16(v1[2], v1[3]);
                    *(u32x4*)(xb + off) = w;
                }
                ss += __shfl_xor(ss, 16); ss += __shfl_xor(ss, 32);
                if (fq == 0) xsq[(size_t)r * 16 + u.pn * 4 + wc] = ss;
            }
    }
};

template <class Epi, class Sched, bool ALIGN_EPI = false, bool SP2 = false>
__device__ __forceinline__ void gemm_phase(PG8_LAS unsigned char* lds, const Gemm g, const Sched& S, const Epi& E) {
    int tid = threadIdx.x; asm volatile("" : "+v"(tid));
    const int wid = __builtin_amdgcn_readfirstlane(tid >> 6), lane = tid & 63, wr = wid >> 2, wc = wid & 3, fr = lane & 15, fq = lane >> 4;
    const int K = g.K, nt = K / BK;
    unsigned voffA[2], voffB[2];
#pragma unroll
    for (int i = 0; i < 2; ++i) { int R, C; stage_rc(tid * 16 + i * 8192, R, C); const int Rb = Epi::PERM ? ((R & ~31) + perm32(R & 31)) : R;
        voffA[i] = (unsigned)(R * g.lda + C) * 2u; voffB[i] = (unsigned)(Rb * K + C) * 2u; }
    const size_t kstep = (size_t)(BK * 2);
    const size_t hstepA = (size_t)HALF * g.lda * 2, hstepB = (size_t)HALF * K * 2;
    const size_t tstepA = 2 * hstepA, tstepB = 2 * hstepB;
    const unsigned ldsw = (unsigned)wid * 1024u;
    const int aoff = lds_byte(wr * 64 + fr, fq * 8), boff = lds_byte(wc * 32 + fr, fq * 8);
#define PG8_SA(b, h) (((b) * 2 + (h)) * HTB)
#define PG8_SB(b, h) ((4 + (b) * 2 + (h)) * HTB)
#define PG8_STAGE(bufoff, gbase, voff) do { _Pragma("unroll") for (int _i = 0; _i < 2; ++_i) \
        __builtin_amdgcn_global_load_lds((const unsigned*)((const char*)(gbase) + (voff)[_i]), (PG8_LAS unsigned*)(lds + (bufoff) + ldsw + _i * 8192), 16, 0, 0); } while (0)
#define PG8_LDA(dst, b, h) do { _Pragma("unroll") for (int m = 0; m < 4; ++m) _Pragma("unroll") for (int k = 0; k < 2; ++k) dst[m][k] = *(const PG8_LAS bf16x8*)(lds + PG8_SA(b, h) + aoff + m * 2048 + k * 1024); } while (0)
#define PG8_LDB(dst, b, h) do { _Pragma("unroll") for (int n = 0; n < 2; ++n) _Pragma("unroll") for (int k = 0; k < 2; ++k) dst[n][k] = *(const PG8_LAS bf16x8*)(lds + PG8_SB(b, h) + boff + n * 2048 + k * 1024); } while (0)
#define PG8_MMA(ai, bj, At, Bt) do { __builtin_amdgcn_s_setprio(1); _Pragma("unroll") for (int m = 0; m < 4; ++m) _Pragma("unroll") for (int n = 0; n < 2; ++n) _Pragma("unroll") for (int k = 0; k < 2; ++k) \
        acc[ai][bj][m][n] = __builtin_amdgcn_mfma_f32_16x16x32_bf16(Bt[n][k], At[m][k], acc[ai][bj][m][n], 0, 0, 0); __builtin_amdgcn_s_setprio(0); } while (0)
#define PG8_WAIT_V(n) asm volatile("s_waitcnt vmcnt(" #n ")" ::: "memory")
#define PG8_WAIT_L(n) asm volatile("s_waitcnt lgkmcnt(" #n ")" ::: "memory")
#define PG8_BAR __builtin_amdgcn_s_barrier()
#define PG8_SCHED __builtin_amdgcn_sched_barrier(0)
    Unit cur, nxt; int ui = 0;
    if (!S.next(0, cur)) return;
    f32x4 acc[2][2][4][2];
#pragma unroll
    for (int a = 0; a < 2; ++a)
#pragma unroll
        for (int b = 0; b < 2; ++b)
#pragma unroll
            for (int m = 0; m < 4; ++m)
#pragma unroll
                for (int n = 0; n < 2; ++n) acc[a][b][m][n] = (f32x4){0.f, 0.f, 0.f, 0.f};
    bf16x8 At[4][2], B0[2][2], B1[2][2];
    const char* cA = (const char*)g.A + (size_t)cur.pm * tstepA; const char* cB = (const char*)g.Bt + (size_t)cur.pn * tstepB;
    S.a_ready(cur);
    if constexpr (SP2) {
        PG8_STAGE(PG8_SB(0, 0), cB, voffB); PG8_STAGE(PG8_SB(0, 1), cB + hstepB, voffB); PG8_STAGE(PG8_SA(0, 0), cA, voffA); PG8_STAGE(PG8_SA(0, 1), cA + hstepA, voffA);
        if (wr == 1) PG8_BAR;
        PG8_WAIT_V(2); PG8_BAR;
        PG8_STAGE(PG8_SB(1, 0), cB + kstep, voffB); PG8_STAGE(PG8_SA(1, 0), cA + kstep, voffA); PG8_STAGE(PG8_SB(1, 1), cB + hstepB + kstep, voffB);
        PG8_WAIT_V(6); PG8_BAR;
    } else {
        PG8_STAGE(PG8_SB(0, 0), cB, voffB); PG8_STAGE(PG8_SA(0, 0), cA, voffA); PG8_STAGE(PG8_SB(0, 1), cB + hstepB, voffB); PG8_STAGE(PG8_SA(0, 1), cA + hstepA, voffA);
        if (wr == 1) PG8_BAR;
        PG8_WAIT_V(4); PG8_BAR;
        PG8_STAGE(PG8_SB(1, 0), cB + kstep, voffB); PG8_STAGE(PG8_SA(1, 0), cA + kstep, voffA); PG8_STAGE(PG8_SB(1, 1), cB + hstepB + kstep, voffB);
        PG8_WAIT_V(6); PG8_BAR;
    }
    for (;;) {
        const bool has_next = S.next(ui + 1, nxt);
        const char* nA = has_next ? (const char*)g.A + (size_t)nxt.pm * tstepA : cA; const char* nB = has_next ? (const char*)g.Bt + (size_t)nxt.pn * tstepB : cB;
        for (int t = 0; t < nt; t += 2) {
            const bool last = (t == nt - 2);
            const char* a1 = cA + (size_t)(t + 1) * kstep;
            const char* a2 = last ? nA : cA + (size_t)(t + 2) * kstep; const char* b2 = last ? nB : cB + (size_t)(t + 2) * kstep;
            const char* a3 = a2 + kstep; const char* b3 = b2 + kstep;
            if (last && has_next) S.a_ready(nxt);
            if constexpr (SP2) {
            PG8_LDB(B0, 0, 0); PG8_LDB(B1, 0, 1); PG8_SCHED; PG8_LDA(At, 0, 0); PG8_STAGE(PG8_SA(1, 1), a1 + hstepA, voffA);
            PG8_WAIT_V(8); PG8_WAIT_L(0); PG8_BAR; PG8_MMA(0, 0, At, B0); PG8_MMA(0, 1, At, B1); PG8_BAR; PG8_SCHED;
            PG8_LDA(At, 0, 1); PG8_STAGE(PG8_SB(0, 0), b2, voffB); PG8_STAGE(PG8_SB(0, 1), b2 + hstepB, voffB); PG8_STAGE(PG8_SA(0, 0), a2, voffA);
            PG8_WAIT_V(8); PG8_WAIT_L(0); PG8_BAR; PG8_MMA(1, 0, At, B0); PG8_MMA(1, 1, At, B1); PG8_BAR; PG8_SCHED;
            PG8_LDB(B0, 1, 0); PG8_LDB(B1, 1, 1); PG8_SCHED; PG8_LDA(At, 1, 0); PG8_STAGE(PG8_SA(0, 1), a2 + hstepA, voffA);
            PG8_WAIT_V(8); PG8_WAIT_L(0); PG8_BAR; PG8_MMA(0, 0, At, B0); PG8_MMA(0, 1, At, B1); PG8_BAR; PG8_SCHED;
            PG8_LDA(At, 1, 1); PG8_STAGE(PG8_SB(1, 0), b3, voffB); PG8_STAGE(PG8_SB(1, 1), b3 + hstepB, voffB); PG8_STAGE(PG8_SA(1, 0), a3, voffA);
            PG8_WAIT_V(8); PG8_WAIT_L(0); PG8_BAR; PG8_MMA(1, 0, At, B0); PG8_MMA(1, 1, At, B1); PG8_BAR; PG8_SCHED;
            } else {
            PG8_LDB(B0, 0, 0); PG8_SCHED; PG8_LDA(At, 0, 0); PG8_STAGE(PG8_SA(1, 1), a1 + hstepA, voffA);
            PG8_WAIT_L(8); PG8_BAR; PG8_WAIT_L(0); PG8_MMA(0, 0, At, B0); PG8_BAR; PG8_SCHED;
            PG8_LDB(B1, 0, 1); PG8_STAGE(PG8_SB(0, 0), b2, voffB);
            PG8_BAR; PG8_WAIT_L(0); PG8_MMA(0, 1, At, B1); PG8_BAR;
            PG8_LDA(At, 0, 1); PG8_STAGE(PG8_SA(0, 0), a2, voffA);
            PG8_BAR; PG8_WAIT_L(0); PG8_MMA(1, 0, At, B0); PG8_BAR; PG8_SCHED;
            PG8_STAGE(PG8_SB(0, 1), b2 + hstepB, voffB);
            PG8_WAIT_V(6); PG8_BAR; PG8_MMA(1, 1, At, B1); PG8_BAR;
            PG8_LDB(B0, 1, 0); PG8_SCHED; PG8_LDA(At, 1, 0); PG8_STAGE(PG8_SA(0, 1), a2 + hstepA, voffA);
            PG8_WAIT_L(8); PG8_BAR; PG8_WAIT_L(0); PG8_MMA(0, 0, At, B0); PG8_BAR; PG8_SCHED;
            PG8_LDB(B1, 1, 1); PG8_STAGE(PG8_SB(1, 0), b3, voffB);
            PG8_BAR; PG8_WAIT_L(0); PG8_MMA(0, 1, At, B1); PG8_BAR;
            PG8_LDA(At, 1, 1); PG8_STAGE(PG8_SA(1, 0), a3, voffA);
            PG8_BAR; PG8_WAIT_L(0); PG8_MMA(1, 0, At, B0); PG8_BAR; PG8_SCHED;
            PG8_STAGE(PG8_SB(1, 1), b3 + hstepB, voffB);
            PG8_WAIT_V(6); PG8_BAR; PG8_MMA(1, 1, At, B1); PG8_BAR;
            }
        }
        if constexpr (ALIGN_EPI) { if (wr == 0) PG8_BAR; }
        if constexpr (!Epi::AFTER_DRAIN) { E(acc, cur, wr, wc, fr, fq); S.done(cur); }
        if (!has_next) break;
#pragma unroll
        for (int a = 0; a < 2; ++a)
#pragma unroll
            for (int b = 0; b < 2; ++b)
#pragma unroll
                for (int m = 0; m < 4; ++m)
#pragma unroll
                    for (int n = 0; n < 2; ++n) acc[a][b][m][n] = (f32x4){0.f, 0.f, 0.f, 0.f};
        cur = nxt; cA = nA; cB = nB; ++ui;
        if constexpr (ALIGN_EPI) { if (wr == 1) PG8_BAR; }
    }
    PG8_WAIT_V(0);
    if constexpr (!ALIGN_EPI) { if (wr == 0) PG8_BAR; }
    PG8_BAR;
    if constexpr (Epi::AFTER_DRAIN) { E.fused(acc, cur, wr, wc, fr, fq, lds, wid, lane); S.done(cur); }
#undef PG8_SA
#undef PG8_SB
#undef PG8_STAGE
#undef PG8_LDA
#undef PG8_LDB
#undef PG8_MMA
#undef PG8_WAIT_V
#undef PG8_WAIT_L
#undef PG8_BAR
#undef PG8_SCHED
}
}

constexpr int NWAVES = 8;
#ifndef MK_LAUNCH_PER_PHASE
#define MK_LAUNCH_PER_PHASE 0
#endif
constexpr int N_PHASES = 12;

constexpr size_t KiB = 1u << 10, MiB = 1u << 20;
constexpr size_t WS_CTL = 0, CTL_ZERO_BYTES = 1 * MiB;
constexpr size_t WS_WIN0 = 1 * MiB, WS_WIN1 = WS_WIN0 + (size_t)N_IN * DM * 2;
constexpr size_t WS_WOUT0 = 20 * MiB, WS_WOUT1 = 23 * MiB;
constexpr size_t WS_WM1_0 = 26 * MiB, WS_WM1_1 = 34 * MiB, WS_WM2_0 = 42 * MiB, WS_WM2_1 = 50 * MiB;
constexpr size_t WS_WMKV = 58 * MiB;
constexpr size_t WS_PROJ = 60 * MiB;
constexpr size_t WS_XB = 204 * MiB;
constexpr size_t WS_SSQ = 236 * MiB;
constexpr size_t WS_AB = 245 * MiB;
constexpr size_t WS_MEMKV = 246 * MiB;
constexpr size_t WS_XSQ = 250 * MiB;
constexpr size_t WS_FCUM = 251 * MiB;
constexpr size_t WS_MSSQ = 251 * MiB + 512 * KiB;
constexpr size_t WS_MSQ = 251 * MiB + 768 * KiB;
constexpr size_t WS_END = 252 * MiB;
static_assert(WS_WIN1 + (size_t)N_IN * DM * 2 <= WS_WOUT0 && WS_PROJ + (size_t)MROWS * PW * 2 <= WS_XB && WS_SSQ + (size_t)36 * MROWS * 16 <= WS_AB, "d_ws map");
constexpr size_t DO_MEMB = 0;
constexpr int CW_BAR = 4096;

constexpr int LDS_BYTES = 155648;
constexpr int MISC_OFF = LDS_BYTES - 256;

#define GAS __attribute__((address_space(1)))
#define LAS __attribute__((address_space(3)))
typedef unsigned short bf16;
typedef unsigned v4u __attribute__((ext_vector_type(4)));
typedef float f32x4 __attribute__((ext_vector_type(4)));
typedef short bf16x8 __attribute__((ext_vector_type(8)));
typedef GAS unsigned gu32;
typedef GAS unsigned long long gu64;
#define RLX_AGENT __ATOMIC_RELAXED, __HIP_MEMORY_SCOPE_AGENT
#define LDS_WAIT() asm volatile("s_waitcnt lgkmcnt(0)" ::: "memory")
#define VM_WAIT() asm volatile("s_waitcnt vmcnt(0)" ::: "memory")
__device__ __forceinline__ unsigned long long rt() { return __builtin_amdgcn_s_memrealtime(); }
__device__ __forceinline__ unsigned f2bf(float f) { unsigned u = __builtin_bit_cast(unsigned, f); return (u + 0x7fffu + ((u >> 16) & 1u)) >> 16; }
__device__ __forceinline__ unsigned pk2(float lo, float hi) { return f2bf(lo) | (f2bf(hi) << 16); }

#define XB_TMO      128
#define XB_XCNT(j)  (256  + 64 * (j))
#define XB_XSUB(j)  (1280 + 64 * (j))
#define XB_XGEN(j)  (2304 + 64 * (j))
#define XB_TOP      3328
#define XB_TOPGEN   3392
#define XCD_BAR_WORDS 3456
#define XB_SPIN_CAP (1u << 18)

__device__ __forceinline__ unsigned xb_ld(unsigned* p)              { return __hip_atomic_load(p, __ATOMIC_RELAXED, __HIP_MEMORY_SCOPE_AGENT); }
__device__ __forceinline__ unsigned xb_add(unsigned* p, unsigned v) { return __hip_atomic_fetch_add(p, v, __ATOMIC_RELAXED, __HIP_MEMORY_SCOPE_AGENT); }
__device__ __forceinline__ unsigned xb_xcc_id() { return (unsigned)__builtin_amdgcn_s_getreg((3 << 11) | 20) & 0xFu; }
#define XB_SPIN(cond, bar) do { unsigned _sp = 0; while (cond) { __builtin_amdgcn_s_sleep(1); \
    if ((++_sp & 255u) == 0u) { if (xb_ld(&(bar)[XB_TMO])) break; if (_sp > XB_SPIN_CAP) { atomicAdd(&(bar)[XB_TMO], 1u); break; } } } } while (0)

struct XcdBarrier {
    unsigned* bar; unsigned x;
    volatile LAS unsigned* st;
};

__device__ __forceinline__ XcdBarrier xcd_barrier_post(unsigned* bar, volatile LAS unsigned* st) {
    XcdBarrier b; b.bar = bar; b.x = xb_xcc_id(); b.st = st;
    if (threadIdx.x == 0) (void)xb_add(&bar[XB_XCNT(b.x)], 1u);
    return b;
}
__device__ __forceinline__ void xcd_barrier_complete(unsigned* bar, unsigned x, unsigned& nloc, unsigned& nx) {
    const unsigned G = gridDim.x * gridDim.y * gridDim.z;
    unsigned sum, cnt, mine, sp = 0u;
    for (;;) {
        sum = 0u; cnt = 0u; mine = 0u;
#pragma unroll
        for (unsigned j = 0; j < 16; ++j) { const unsigned c = xb_ld(&bar[XB_XCNT(j)]); sum += c; cnt += (c > 0u) ? 1u : 0u; mine = (j == x) ? c : mine; }
        if (sum == G) break;
        __builtin_amdgcn_s_sleep(1);
        if ((++sp & 255u) == 0u) { if (xb_ld(&bar[XB_TMO])) break; if (sp > XB_SPIN_CAP) { atomicAdd(&bar[XB_TMO], 1u); break; } }
    }
    nloc = mine > 0u ? mine : 1u; nx = cnt > 0u ? cnt : 1u;
}

__device__ __forceinline__ void xcd_barrier(const XcdBarrier& b) {
    asm volatile("s_waitcnt vmcnt(0)" ::: "memory");
    __syncthreads();
    if (threadIdx.x == 0) {
        unsigned* bar = b.bar;
        __builtin_amdgcn_s_waitcnt(0);
        unsigned nloc = b.st[0], nx = b.st[1];
        if (nloc == 0u) { xcd_barrier_complete(bar, b.x, nloc, nx); b.st[0] = nloc; b.st[1] = nx; }
        const unsigned old = xb_add(&bar[XB_XSUB(b.x)], 1u);
        const unsigned gen = old / nloc;
        if (old + 1u == (gen + 1u) * nloc) {
            __builtin_amdgcn_fence(__ATOMIC_RELEASE, "agent");
            asm volatile("s_waitcnt vmcnt(0)" ::: "memory");
            const unsigned og = xb_add(&bar[XB_TOP], 1u);
            const unsigned tg = og / nx;
            if (og + 1u == (tg + 1u) * nx) xb_add(&bar[XB_TOPGEN], 1u);
            else XB_SPIN(xb_ld(&bar[XB_TOPGEN]) == tg, bar);
            __builtin_amdgcn_fence(__ATOMIC_ACQUIRE, "agent");
            xb_add(&bar[XB_XGEN(b.x)], 1u);
            asm volatile("s_waitcnt vmcnt(0)" ::: "memory");
        } else {
            XB_SPIN(xb_ld(&bar[XB_XGEN(b.x)]) == gen, bar);
            __builtin_amdgcn_fence(__ATOMIC_ACQUIRE, "agent");
            asm volatile("s_waitcnt vmcnt(0)" ::: "memory");
        }
    }
    __syncthreads();
}


__device__ __forceinline__ float bflo(unsigned u) { return __builtin_bit_cast(float, u << 16); }
__device__ __forceinline__ float bfhi(unsigned u) { return __builtin_bit_cast(float, u & 0xffff0000u); }
__device__ __forceinline__ unsigned pkbf(float lo, float hi) { return pg8::cvt_pk_bf16(lo, hi); }
__device__ __forceinline__ float wave_sum(float v) {
#pragma unroll
    for (int o = 1; o < 64; o <<= 1) v += __shfl_xor(v, o);
    return v;
}
__device__ __forceinline__ float wave_max(float v) {
#pragma unroll
    for (int o = 1; o < 64; o <<= 1) v = fmaxf(v, __shfl_xor(v, o));
    return v;
}

struct Args { const float* in[20]; float* out; unsigned char* ws; int ph_lo, ph_hi, li, pad; };
enum { I_X = 0, I_MEM, I_MEMNW, I_WMKV, I_MEMKNW, I_NORM1, I_DNWIN, I_DNCONV, I_DNALOG, I_DNDT, I_DNONW, I_FOXWIN, I_FOXFB, I_FOXQNW, I_FOXKNW, I_MEMQNW, I_WOUT, I_NORM2, I_WM1, I_WM2 };

struct Frame {
    LAS unsigned char* lds;
    int G, bid;
    const float* const* in; float* out; unsigned char* ws;
};


struct Tix { int tid, lane, wave; };
__device__ __forceinline__ Tix tix() { Tix t; int x = threadIdx.x; asm volatile("" : "+v"(x)); t.tid = x; t.lane = x & 63; t.wave = __builtin_amdgcn_readfirstlane(x >> 6); return t; }
struct TSeg { const float* W; int K, ldw, src0, ncols; bf16* WT; int dst0; const float* scale; };
__device__ __forceinline__ TSeg get_seg(const Frame& F, int s) {
    TSeg t; t.scale = nullptr; t.src0 = 0; t.dst0 = 0;
    if (s < 12) {
        const int l = s / 6, j = s % 6;
        t.W = l ? F.in[I_FOXWIN] : F.in[I_DNWIN]; t.K = DM; t.ldw = l ? FOX_IN : DN_IN; t.WT = (bf16*)(F.ws + (l ? WS_WIN1 : WS_WIN0)); t.scale = F.in[I_NORM1] + l * DM;
        const int qm0 = l ? 4104 : 4112, nsc = l ? 8 : 16;
        t.ncols = 1024;
        if (j == 0) { t.src0 = 1024; t.dst0 = PC_K; } else if (j == 1) { t.src0 = 2048; t.dst0 = PC_V; } else if (j == 2) { t.src0 = 3072; t.dst0 = PC_Z; }
        else if (j == 3) { t.src0 = 0; t.dst0 = PC_Q; } else if (j == 4) { t.src0 = qm0; t.dst0 = PC_QM; t.ncols = 512; } else { t.src0 = 4096; t.dst0 = PC_AB; t.ncols = nsc; }
    } else if (s < 14) { const int l = s - 12; t.W = F.in[I_WOUT] + (size_t)l * OUT_IN * DM; t.K = OUT_IN; t.ldw = DM; t.ncols = DM; t.WT = (bf16*)(F.ws + (l ? WS_WOUT1 : WS_WOUT0)); }
    else if (s < 16) { const int l = s - 14; t.W = F.in[I_WM1] + (size_t)l * DM * FF; t.K = DM; t.ldw = FF; t.ncols = FF; t.WT = (bf16*)(F.ws + (l ? WS_WM1_1 : WS_WM1_0)); t.scale = F.in[I_NORM2] + l * DM; }
    else if (s < 18) { const int l = s - 16; t.W = F.in[I_WM2] + (size_t)l * FF * DM; t.K = FF; t.ldw = DM; t.ncols = DM; t.WT = (bf16*)(F.ws + (l ? WS_WM2_1 : WS_WM2_0)); }
    else { t.W = F.in[I_WMKV]; t.K = DM; t.ldw = DM; t.ncols = DM; t.WT = (bf16*)(F.ws + WS_WMKV); t.scale = F.in[I_MEMNW]; }
    return t;
}
__device__ __forceinline__ int seg_items(const TSeg& t) { return (t.K / 64) * ((t.ncols + 31) / 32); }
__device__ __forceinline__ void transpose_item(const TSeg& t, LAS float* scr, int item, int lane) {
    const int nblk = (t.ncols + 31) / 32, kb = item / nblk, nb = item % nblk, k0 = 64 * kb, n0 = 32 * nb;
    const int nl = lane & 31; const bool ok = (n0 + nl) < t.ncols;
#pragma unroll 8
    for (int i = 0; i < 32; ++i) { const int kk = 2 * i + (lane >> 5);
        float w = ok ? t.W[(size_t)(k0 + kk) * t.ldw + t.src0 + n0 + nl] : 0.f;
        if (t.scale) w *= t.scale[k0 + kk];
        scr[kk * 33 + nl] = w; }
    LDS_WAIT(); asm volatile("" ::: "memory");
    const int c = lane & 7;
#pragma unroll
    for (int j = 0; j < 4; ++j) { const int n = (lane >> 3) + 8 * j; const LAS float* s = scr + (8 * c) * 33 + n;
        v4u o; o.x = pkbf(s[0 * 33], s[1 * 33]); o.y = pkbf(s[2 * 33], s[3 * 33]); o.z = pkbf(s[4 * 33], s[5 * 33]); o.w = pkbf(s[6 * 33], s[7 * 33]);
        if (n0 + n < t.ncols) *(v4u*)(t.WT + (size_t)(t.dst0 + n0 + n) * t.K + k0 + 8 * c) = o; }
    LDS_WAIT(); asm volatile("" ::: "memory");
}
__device__ __forceinline__ void row_to_bf16(int lane, const float* xrow, bf16* orow, float* sq) {
    const f32x4* xr = (const f32x4*)xrow + lane;
    f32x4 v[4]; float s = 0.f;
#pragma unroll
    for (int j = 0; j < 4; ++j) { v[j] = xr[64 * j]; s += (v[j].x * v[j].x + v[j].y * v[j].y) + (v[j].z * v[j].z + v[j].w * v[j].w); }
    s = wave_sum(s);
    unsigned long long* o8 = (unsigned long long*)orow + lane;
#pragma unroll
    for (int j = 0; j < 4; ++j) o8[64 * j] = (unsigned long long)pkbf(v[j].x, v[j].y) | ((unsigned long long)pkbf(v[j].z, v[j].w) << 32);
    if (lane < 16) sq[lane] = lane == 0 ? s : 0.f;
}
__device__ __forceinline__ void p0_prologue(const Frame& F) {
    const Tix T = tix();
    LAS float* scr = (LAS float*)(F.lds + T.wave * 16384);
    const int gw = F.bid * NWAVES + T.wave, NGW = F.G * NWAVES;
    for (int m = gw; m < MROWS; m += NGW) row_to_bf16(T.lane, F.in[I_X] + (size_t)m * DM, (bf16*)(F.ws + WS_XB) + (size_t)m * DM, (float*)(F.ws + WS_XSQ) + (size_t)m * 16);
    for (int m = gw; m < MMEM; m += NGW) row_to_bf16(T.lane, F.in[I_MEM] + (size_t)m * DM, (bf16*)((unsigned char*)F.out + DO_MEMB) + (size_t)m * DM, (float*)(F.ws + WS_MSQ) + (size_t)m * 16);
    int base = 0;
    for (int s = 0; s < 19; ++s) {
        const TSeg t = get_seg(F, s); const int n = seg_items(t);
        int it = gw - (base % NGW); if (it < 0) it += NGW;
        for (; it < n; it += NGW) transpose_item(t, scr, it, T.lane);
        base += n;
    }
}

__device__ __forceinline__ void dn_naive_unit(const Frame& F, int bh) {
    const Tix T = tix(); const int b = bh >> 3, h = bh & 7, tid = T.tid, lane = T.lane, wave = T.wave;
    LAS bf16* raw = (LAS bf16*)F.lds;
    LAS float* ob = (LAS float*)F.lds;
    LAS float* qh = (LAS float*)(F.lds + 51712); LAS float* kh = qh + 8192; LAS float* vv = kh + 8192;
    LAS float* part = vv + 8192; LAS float* part2 = part + 512; LAS float* egb = part2 + 512;
    bf16* proj = (bf16*)(F.ws + WS_PROJ); const float* AB = (const float*)(F.ws + WS_AB);
    const float* convw = F.in[I_DNCONV]; const float a_exp = __expf(F.in[I_DNALOG][h]), dtb = F.in[I_DNDT][h]; const float* onw = F.in[I_DNONW];
    float S[32];
#pragma unroll
    for (int k = 0; k < 32; ++k) S[k] = 0.f;
    const int v = tid & 127, kq = tid >> 7;
    for (int blk = 0; blk < SEQ / 64; ++blk) {
        const size_t row0 = (size_t)b * SEQ + blk * 64;
        for (int i = tid; i < 576; i += 512) { const unsigned val = blk ? ((LAS unsigned*)raw)[64 * 192 + i] : 0u; ((LAS unsigned*)raw)[i] = val; }
        __syncthreads();
        for (int id = tid; id < 64 * 48; id += 512) { const int r = id / 48, rem = id % 48, seg = rem >> 4, ch = rem & 15;
            const int col = (seg == 0 ? PC_Q : seg == 1 ? PC_K : PC_V) + h * HD + ch * 8;
            const v4u val = *(const v4u*)(proj + (row0 + r) * PW + col);
            *(LAS v4u*)(raw + (3 + r) * 384 + seg * 128 + ch * 8) = val; }
        __syncthreads();
        float cw0 = 0, cw1 = 0, cw2 = 0, cw3 = 0, x0 = 0, x1 = 0, x2 = 0;
        if (tid < 384) { const int seg = tid >> 7, d = tid & 127, gch = seg * 1024 + h * HD + d;
            cw0 = convw[gch]; cw1 = convw[3072 + gch]; cw2 = convw[2 * 3072 + gch]; cw3 = convw[3 * 3072 + gch];
            x0 = bflo((unsigned)raw[0 * 384 + tid]); x1 = bflo((unsigned)raw[1 * 384 + tid]); x2 = bflo((unsigned)raw[2 * 384 + tid]); }
        if (tid < 384) { const int seg = tid >> 7, d = tid & 127; LAS float* dst = seg == 0 ? qh : seg == 1 ? kh : vv;
#pragma unroll 8
            for (int i = 0; i < 64; ++i) { const float x3 = bflo((unsigned)raw[(3 + i) * 384 + tid]);
                const float y = cw0 * x0 + cw1 * x1 + cw2 * x2 + cw3 * x3; dst[i * 128 + d] = y / (1.f + __expf(-y)); x0 = x1; x1 = x2; x2 = x3; } }
        __syncthreads();
        for (int j = 0; j < 8; ++j) { const int i = wave * 8 + j;
            const float q0 = qh[i * 128 + 2 * lane], q1 = qh[i * 128 + 2 * lane + 1], k0 = kh[i * 128 + 2 * lane], k1 = kh[i * 128 + 2 * lane + 1];
            const float sq = wave_sum(q0 * q0 + q1 * q1), sk = wave_sum(k0 * k0 + k1 * k1);
            const float rq = rsqrtf(sq + EPS) * QSCALE, rk = rsqrtf(sk + EPS);
            qh[i * 128 + 2 * lane] = q0 * rq; qh[i * 128 + 2 * lane + 1] = q1 * rq; kh[i * 128 + 2 * lane] = k0 * rk; kh[i * 128 + 2 * lane + 1] = k1 * rk;
            if (lane == 0) { const float a = AB[(row0 + i) * 16 + h], bb = AB[(row0 + i) * 16 + 8 + h];
                const float x = a + dtb, sp = fmaxf(x, 0.f) + log1pf(__expf(-fabsf(x)));
                egb[i] = __expf(-a_exp * sp); egb[64 + i] = 1.f / (1.f + __expf(-bb)); } }
        __syncthreads();
        for (int i = 0; i < 64; ++i) {
            const LAS float* kr = kh + i * 128 + kq * 32; const LAS float* qr = qh + i * 128 + kq * 32;
            float ks = 0.f;
#pragma unroll
            for (int k = 0; k < 32; ++k) ks += kr[k] * S[k];
            part[kq * 128 + v] = ks;
            __syncthreads();
            const float kS = (part[v] + part[128 + v]) + (part[256 + v] + part[384 + v]);
            const float eg = egb[i], be = egb[64 + i];
            const float dv = be * (vv[i * 128 + v] - eg * kS);
            float po = 0.f;
#pragma unroll
            for (int k = 0; k < 32; ++k) { S[k] = eg * S[k] + kr[k] * dv; po += S[k] * qr[k]; }
            part2[kq * 128 + v] = po;
            __syncthreads();
            if (kq == 0) ob[i * 128 + v] = (part2[v] + part2[128 + v]) + (part2[256 + v] + part2[384 + v]);
        }
        __syncthreads();
        for (int j = 0; j < 8; ++j) { const int i = wave * 8 + j;
            const float o0 = ob[i * 128 + 2 * lane], o1 = ob[i * 128 + 2 * lane + 1];
            const float rn = rsqrtf(wave_sum(o0 * o0 + o1 * o1) * (1.f / 128.f) + EPS);
            const unsigned zz = *(const unsigned*)(proj + (row0 + i) * PW + PC_Z + h * HD + 2 * lane);
            const float z0 = bflo(zz), z1 = bfhi(zz);
            const float r0 = o0 * rn * onw[2 * lane] * (z0 / (1.f + __expf(-z0))), r1 = o1 * rn * onw[2 * lane + 1] * (z1 / (1.f + __expf(-z1)));
            *(unsigned*)(proj + (row0 + i) * PW + PC_Q + h * HD + 2 * lane) = pkbf(r0, r1); }
        __syncthreads();
    }
}

struct NA {
    const bf16* Q; size_t qpitch; const float* qssq;
    const bf16* K; const bf16* V; size_t kvpitch; const float* kssq;
    const float* bias;
    const float* wq; const float* wk;
    const bf16* gate;
    bf16* O;
    int causal;
};
__device__ __forceinline__ void nattn_unit(const Frame& F, const NA& a, size_t qrow0, int t0, size_t krow0, int nblk) {
    const Tix T = tix(); const int tid = T.tid, lane = T.lane, wave = T.wave;
    LAS unsigned char* Ks = F.lds; LAS unsigned char* Vs = F.lds + 67584;
    LAS float* qb = (LAS float*)(F.lds + 133120) + wave * 128; LAS float* pb = (LAS float*)(F.lds + 137216) + wave * 256; LAS float* akbk = (LAS float*)(F.lds + 145408);
    float m_[8], l_[8], o0[8], o1[8];
#pragma unroll
    for (int ri = 0; ri < 8; ++ri) { m_[ri] = -1e30f; l_[ri] = 0.f; o0[ri] = 0.f; o1[ri] = 0.f; }
    const float wqk0 = a.wq[2 * lane] * a.wk[2 * lane] * QSCALE, wqk1 = a.wq[2 * lane + 1] * a.wk[2 * lane + 1] * QSCALE;
    for (int kbi = 0; kbi < nblk; ++kbi) {
        const int kb = kbi * 256;
        __syncthreads();
        for (int id = tid; id < 4096; id += 512) { const int r = id >> 4, ch = id & 15;
            const v4u kv = *(const v4u*)(a.K + (krow0 + kb + r) * a.kvpitch + ch * 8), vvv = *(const v4u*)(a.V + (krow0 + kb + r) * a.kvpitch + ch * 8);
            LAS unsigned long long* kd = (LAS unsigned long long*)(Ks + r * 264 + ch * 16);
            kd[0] = (unsigned long long)kv.x | ((unsigned long long)kv.y << 32); kd[1] = (unsigned long long)kv.z | ((unsigned long long)kv.w << 32);
            *(LAS v4u*)(Vs + r * 256 + ch * 16) = vvv; }
        if (tid < 256) { const f32x4 s4 = *(const f32x4*)(a.kssq + (krow0 + kb + tid) * 4);
            akbk[tid] = rsqrtf(((s4[0] + s4[1]) + (s4[2] + s4[3])) * (1.f / 128.f) + EPS);
            akbk[256 + tid] = a.bias ? -a.bias[kb + tid] : 0.f; }
        __syncthreads();
#pragma unroll
        for (int ri = 0; ri < 8; ++ri) {
            const int i = wave * 8 + ri, tq = t0 + i;
            { const unsigned qq = *(const unsigned*)(a.Q + (qrow0 + i) * a.qpitch + 2 * lane);
              const f32x4 s4 = *(const f32x4*)(a.qssq + (qrow0 + i) * 4);
              const float rq = rsqrtf(((s4[0] + s4[1]) + (s4[2] + s4[3])) * (1.f / 128.f) + EPS);
              qb[2 * lane] = bflo(qq) * rq * wqk0; qb[2 * lane + 1] = bfhi(qq) * rq * wqk1; }
            LDS_WAIT();
            float s[4] = {0.f, 0.f, 0.f, 0.f};
#pragma unroll 8
            for (int d4 = 0; d4 < 32; ++d4) { const f32x4 qq = *(const LAS f32x4*)(qb + 4 * d4);
#pragma unroll
                for (int j = 0; j < 4; ++j) { const unsigned long long kk = *(const LAS unsigned long long*)(Ks + (lane + 64 * j) * 264 + d4 * 8);
                    const unsigned klo = (unsigned)kk, khi = (unsigned)(kk >> 32);
                    s[j] += (qq[0] * bflo(klo) + qq[1] * bfhi(klo)) + (qq[2] * bflo(khi) + qq[3] * bfhi(khi)); } }
            float mx = -__builtin_inff();
#pragma unroll
            for (int j = 0; j < 4; ++j) { const int mm = lane + 64 * j; s[j] = s[j] * akbk[mm] + akbk[256 + mm]; if (a.causal && kb + mm > tq) s[j] = -__builtin_inff(); mx = fmaxf(mx, s[j]); }
            mx = wave_max(mx);
            const float mn = fmaxf(m_[ri], mx), alpha = __expf(m_[ri] - mn);
            float ps = 0.f;
#pragma unroll
            for (int j = 0; j < 4; ++j) { const float p = __expf(s[j] - mn); ps += p; pb[lane + 64 * j] = p; }
            ps = wave_sum(ps);
            l_[ri] = l_[ri] * alpha + ps; m_[ri] = mn; float a0 = o0[ri] * alpha, a1 = o1[ri] * alpha;
            LDS_WAIT();
#pragma unroll 4
            for (int m4 = 0; m4 < 64; ++m4) { const f32x4 pp = *(const LAS f32x4*)(pb + 4 * m4);
#pragma unroll
                for (int e = 0; e < 4; ++e) { const unsigned vw = *(const LAS unsigned*)(Vs + (4 * m4 + e) * 256 + lane * 4); a0 += pp[e] * bflo(vw); a1 += pp[e] * bfhi(vw); } }
            o0[ri] = a0; o1[ri] = a1;
        }
    }
#pragma unroll
    for (int ri = 0; ri < 8; ++ri) { const int i = wave * 8 + ri; const float inv = 1.f / l_[ri]; float r0 = o0[ri] * inv, r1 = o1[ri] * inv;
        if (a.gate) { const unsigned gg = *(const unsigned*)(a.gate + (qrow0 + i) * a.qpitch + 2 * lane); r0 *= 1.f / (1.f + __expf(-bflo(gg))); r1 *= 1.f / (1.f + __expf(-bfhi(gg))); }
        *(unsigned*)(a.O + (qrow0 + i) * a.qpitch + 2 * lane) = pkbf(r0, r1); }
}
__device__ __forceinline__ void memattn_unit(const Frame& F, int layer, int u) {
    const int tq = u & 31, hm = (u >> 5) & 3, b = u >> 7;
    bf16* proj = (bf16*)(F.ws + WS_PROJ); const bf16* mkv = (const bf16*)(F.ws + WS_MEMKV);
    NA a; a.Q = proj + PC_QM + hm * HD; a.qpitch = PW; a.qssq = (const float*)(F.ws + WS_SSQ) + (size_t)(32 + hm) * MROWS * 4;
    a.K = mkv + hm * HD; a.V = mkv + 512 + hm * HD; a.kvpitch = DM; a.kssq = (const float*)(F.ws + WS_MSSQ) + (size_t)hm * MMEM * 4;
    a.bias = nullptr; a.wq = F.in[I_MEMQNW] + layer * HD; a.wk = F.in[I_MEMKNW]; a.gate = nullptr; a.O = proj + PC_QM + hm * HD; a.causal = 0;
    nattn_unit(F, a, (size_t)b * SEQ + tq * 64, tq * 64, (size_t)b * NMEM, 1);
}
__device__ __forceinline__ void fox_unit(const Frame& F, int u) {
    const int tq = 31 - (u >> 6), bh = u & 63, b = bh >> 3, h = bh & 7;
    bf16* proj = (bf16*)(F.ws + WS_PROJ); const float* ssq = (const float*)(F.ws + WS_SSQ);
    NA a; a.Q = proj + PC_Q + h * HD; a.qpitch = PW; a.qssq = ssq + (size_t)(24 + h) * MROWS * 4;
    a.K = proj + PC_K + h * HD; a.V = proj + PC_V + h * HD; a.kvpitch = PW; a.kssq = ssq + (size_t)h * MROWS * 4;
    a.bias = (const float*)(F.ws + WS_FCUM) + (size_t)bh * SEQ; a.wq = F.in[I_FOXQNW]; a.wk = F.in[I_FOXKNW]; a.gate = proj + PC_Z + h * HD; a.O = proj + PC_Q + h * HD; a.causal = 1;
    nattn_unit(F, a, (size_t)b * SEQ + tq * 64, tq * 64, (size_t)b * SEQ, tq / 4 + 1);
}
__device__ __forceinline__ void fcum_unit(const Frame& F, int bh) {
    const Tix T = tix(); const int b = bh >> 3, h = bh & 7, tid = T.tid, lane = T.lane, wave = T.wave;
    const float* AB = (const float*)(F.ws + WS_AB); const float fb = F.in[I_FOXFB][h];
    LAS float* wt = (LAS float*)F.lds;
    float f[4];
#pragma unroll
    for (int e = 0; e < 4; ++e) { const float x = AB[((size_t)b * SEQ + tid * 4 + e) * 16 + h] + fb; f[e] = fminf(x, 0.f) - log1pf(__expf(-fabsf(x))); }
    f[1] += f[0]; f[2] += f[1]; f[3] += f[2];
    float sc = f[3];
#pragma unroll
    for (int o = 1; o < 64; o <<= 1) { const float t = __shfl_up(sc, o); if (lane >= o) sc += t; }
    __syncthreads();
    if (lane == 63) wt[wave] = sc;
    __syncthreads();
    float off = sc - f[3];
    for (int w = 0; w < wave; ++w) off += wt[w];
    float* out = (float*)(F.ws + WS_FCUM) + (size_t)bh * SEQ + tid * 4;
    *(f32x4*)out = (f32x4){f[0] + off, f[1] + off, f[2] + off, f[3] + off};
    __syncthreads();
}

__global__ void __launch_bounds__(NWAVES * 64, 2) hyb_fwd(Args args) {
    extern __shared__ __attribute__((aligned(16))) unsigned char lds[];
    Frame F;
    F.lds = (LAS unsigned char*)lds;
    F.G = gridDim.x; F.bid = blockIdx.x; F.in = args.in; F.out = args.out; F.ws = args.ws;
    volatile LAS unsigned* MISC = (volatile LAS unsigned*)(F.lds + MISC_OFF);
    gu32* ctl = (gu32*)(args.ws + WS_CTL);
    for (int u = threadIdx.x; u < (LDS_BYTES - MISC_OFF) / 4; u += NWAVES * 64) ((LAS unsigned*)(F.lds + MISC_OFF))[u] = 0u;
    __syncthreads();
    XcdBarrier bar; bar.bar = (unsigned*)(ctl + CW_BAR) + args.li * XCD_BAR_WORDS; bar.x = 0; bar.st = nullptr;
    if (!MK_LAUNCH_PER_PHASE) bar = xcd_barrier_post((unsigned*)(ctl + CW_BAR) + args.li * XCD_BAR_WORDS, MISC + 8);
    const int lo = args.ph_lo, hi = args.ph_hi;
#define IN(k) (lo <= (k) && (k) < hi)
#define SEAM(k) do { if (IN(k) && IN((k) + 1)) xcd_barrier(bar); } while (0)
    bf16* proj = (bf16*)(F.ws + WS_PROJ); bf16* xb = (bf16*)(F.ws + WS_XB); float* xsq = (float*)(F.ws + WS_XSQ);
    float* ssq = (float*)(F.ws + WS_SSQ); float* ab = (float*)(F.ws + WS_AB);

    if (IN(0)) { p0_prologue(F); } SEAM(0);

    for (int layer = 0; layer < 2; ++layer) {
        const int pb = 1 + (layer ? 5 : 0);
        if (IN(pb)) {
            pg8::Gemm g{xb, (const bf16*)(F.ws + (layer ? WS_WIN1 : WS_WIN0)), MROWS, N_IN, DM, DM}; pg8::StaticOrder S; S.init(MROWS, N_IN, F.G, F.bid);
            pg8::EpiProj<true, false> E{proj, PW, xsq, ssq, MROWS, ab, 18};
            pg8::gemm_phase<pg8::EpiProj<true, false>, pg8::StaticOrder, true, true>(F.lds, g, S, E);
            if (layer == 0) {
                pg8::Gemm g2{(const bf16*)((unsigned char*)F.out + DO_MEMB), (const bf16*)(F.ws + WS_WMKV), MMEM, DM, DM, DM}; pg8::StaticOrder S2; S2.init(MMEM, DM, F.G, F.G - 1 - F.bid);
                pg8::EpiProj<true, false> E2{(bf16*)(F.ws + WS_MEMKV), DM, (const float*)(F.ws + WS_MSQ), (float*)(F.ws + WS_MSSQ), MMEM, nullptr, 4};
                pg8::gemm_phase<pg8::EpiProj<true, false>, pg8::StaticOrder, true, true>(F.lds, g2, S2, E2);
            }
        }
        SEAM(pb);
        int pm = pb + 1;
        if (layer == 1) {
            if (IN(pm)) { for (int bh = F.bid; bh < 64; bh += F.G) fcum_unit(F, bh); }
            SEAM(pm); ++pm;
        }
        if (IN(pm)) {
            if (layer == 0) {
                if (F.G > 64) { if (F.bid < 64) dn_naive_unit(F, F.bid); else for (int u = F.bid - 64; u < 1024; u += F.G - 64) memattn_unit(F, 0, u); }
                else { for (int bh = F.bid; bh < 64; bh += F.G) dn_naive_unit(F, bh); for (int u = F.bid; u < 1024; u += F.G) memattn_unit(F, 0, u); }
            } else {
                for (int u = F.bid; u < 2048; u += F.G) fox_unit(F, u);
                for (int u = F.bid; u < 1024; u += F.G) memattn_unit(F, 1, u);
            }
            __syncthreads();
        }
        SEAM(pm);
        if (IN(pm + 1)) {
            pg8::Gemm g{proj + PC_Q, (const bf16*)(F.ws + (layer ? WS_WOUT1 : WS_WOUT0)), MROWS, DM, OUT_IN, PW}; pg8::StaticOrder S; S.init(MROWS, DM, F.G, F.bid);
            pg8::EpiRes E{layer ? (const float*)F.out : F.in[I_X], F.out, xb, xsq};
            pg8::gemm_phase<pg8::EpiRes, pg8::StaticOrder, true, true>(F.lds, g, S, E);
        }
        SEAM(pm + 1);
        if (IN(pm + 2)) {
            pg8::Gemm g{xb, (const bf16*)(F.ws + (layer ? WS_WM1_1 : WS_WM1_0)), MROWS, FF, DM, DM}; pg8::StaticOrder S; S.init(MROWS, FF, F.G, F.bid);
            pg8::EpiProj<false, true> E{proj, FF, xsq, nullptr, 0, nullptr, 16};
            pg8::gemm_phase<pg8::EpiProj<false, true>, pg8::StaticOrder, true, true>(F.lds, g, S, E);
        }
        SEAM(pm + 2);
        if (IN(pm + 3)) {
            pg8::Gemm g{proj, (const bf16*)(F.ws + (layer ? WS_WM2_1 : WS_WM2_0)), MROWS, DM, FF, FF}; pg8::StaticOrder S; S.init(MROWS, DM, F.G, F.bid);
            pg8::EpiRes E{(const float*)F.out, F.out, xb, xsq};
            pg8::gemm_phase<pg8::EpiRes, pg8::StaticOrder, true, true>(F.lds, g, S, E);
        }
        SEAM(pm + 3);
    }
#undef IN
#undef SEAM
}

extern "C" void kernel_launch(void* const* d_in, const int* in_sizes, int n_in, void* d_out, int out_size, void* d_ws, size_t ws_size, hipStream_t stream) {
    static int grid = 0;
    if (grid == 0) {
        if (n_in != 20 || in_sizes[0] != MROWS * DM || out_size != MROWS * DM || ws_size < WS_END) {
            fprintf(stderr, "kernel_launch: shape/workspace mismatch (n_in %d, in0 %d, out %d, ws %zu; need ws >= %zu); nothing launched\n", n_in, n_in > 0 ? in_sizes[0] : -1, out_size, ws_size, (size_t)WS_END); grid = -1; return; }
        int dev = 0, cus = 0, per_cu = 0;
        if (hipGetDevice(&dev) != hipSuccess || hipDeviceGetAttribute(&cus, hipDeviceAttributeMultiprocessorCount, dev) != hipSuccess) { fprintf(stderr, "kernel_launch: device query failed\n"); grid = -1; return; }
        if (hipFuncSetAttribute((const void*)hyb_fwd, hipFuncAttributeMaxDynamicSharedMemorySize, LDS_BYTES) != hipSuccess) { fprintf(stderr, "kernel_launch: hipFuncSetAttribute failed\n"); grid = -1; return; }
        if (hipOccupancyMaxActiveBlocksPerMultiprocessor(&per_cu, (const void*)hyb_fwd, NWAVES * 64, LDS_BYTES) != hipSuccess || per_cu < 1) {
            fprintf(stderr, "kernel_launch: occupancy query reports %d workgroups per CU; nothing launched\n", per_cu); (void)hipGetLastError(); grid = -1; return; }
        grid = cus;
    }
    if (grid < 0) return;
    if (hipMemsetAsync((char*)d_ws + WS_CTL, 0, CTL_ZERO_BYTES, stream) != hipSuccess) { fprintf(stderr, "kernel_launch: memset failed\n"); return; }
    Args a{};
    for (int i = 0; i < 20; ++i) a.in[i] = (const float*)d_in[i];
    a.out = (float*)d_out; a.ws = (unsigned char*)d_ws;
#if MK_LAUNCH_PER_PHASE
    for (int p = 0; p < N_PHASES; ++p) { a.ph_lo = p; a.ph_hi = p + 1; a.li = 0; hipLaunchKernelGGL(hyb_fwd, dim3(grid), dim3(NWAVES * 64), LDS_BYTES, stream, a); }
#else
    a.ph_lo = 0; a.ph_hi = N_PHASES; a.li = 0;
    hipLaunchKernelGGL(hyb_fwd, dim3(grid), dim3(NWAVES * 64), LDS_BYTES, stream, a);
#endif
    const hipError_t le = hipPeekAtLastError();
    if (le != hipSuccess) fprintf(stderr, "kernel_launch: launch failed: %s\n", hipGetErrorName(le));
}
```

```cpp
#include <hip/hip_runtime.h>
#include <cstdio>
#include <cstdint>

constexpr int BATCH = 8, SEQ = 2048, DM = 1024, MROWS = BATCH * SEQ;
constexpr int NMEM = 256, MMEM = BATCH * NMEM;
constexpr int HD = 128, NH = 8, NMH = 4, FF = 4096;
constexpr int PW = 4608;
constexpr int PC_K = 0, PC_V = 1024, PC_Z = 2048, PC_Q = 3072, PC_QM = 4096, PC_AB = 4608;
constexpr int N_IN = 4864;
constexpr int DN_IN = 4624, FOX_IN = 4616, OUT_IN = 1536;
constexpr float EPS = 1e-6f;
constexpr float QSCALE = 0.08838834764831845f;

namespace pg8 {
#define PG8_LAS __attribute__((address_space(3)))
typedef unsigned short bf16_t;
typedef short bf16x8 __attribute__((ext_vector_type(8)));
typedef float f32x4 __attribute__((ext_vector_type(4)));
typedef unsigned u32x4 __attribute__((ext_vector_type(4)));
constexpr int BM = 256, BK = 64, HALF = 128, HTB = HALF * BK * 2  , STAGE_BYTES = 8 * HTB, NXCD = 8, WGM = 8;

__host__ __device__ __forceinline__ int lds_byte(int r, int c) { const int st = (r >> 4) * 2 + (c >> 5), rr = r & 15, cc = c & 31, ob = rr * 64 + cc * 2; return st * 1024 + (ob ^ (((ob >> 9) & 1) << 5)); }
__host__ __device__ __forceinline__ void stage_rc(int b, int& R, int& C) { const int st = b / 1024, sb = b % 1024, swz = sb ^ (((sb >> 9) & 1) << 5); R = (st >> 1) * 16 + swz / 64; C = (st & 1) * 32 + (swz % 64) / 2; }
__host__ __device__ __forceinline__ int perm32(int rho) { const int n = rho >> 4, i = rho & 15; return 8 * (i >> 2) + 4 * n + (i & 3); }

struct Unit { int pm, pn; };
struct Gemm { const bf16_t* A; const bf16_t* Bt; int M, N, K, lda; };

struct StaticOrder {
    int nM, nN, nwg, G, c;
    __host__ __device__ void init(int M, int N, int G_, int c_) { nM = M / BM; nN = N / BM; nwg = nM * nN; G = G_; c = c_; }
    __host__ __device__ bool next(int i, Unit& u) const {
        const long L = (long)i * G + c; if (L >= nwg) return false;
        int wgid = (int)L; { const int q = nwg / NXCD, r = nwg % NXCD, xcd = wgid % NXCD, off = wgid / NXCD; wgid = (xcd < r ? xcd * (q + 1) : r * (q + 1) + (xcd - r) * q) + off; }
        const int nig = WGM * nN, gid = wgid / nig, fm = gid * WGM, gsz = (nM - fm) < WGM ? (nM - fm) : WGM;
        u.pm = fm + ((wgid % nig) % gsz); u.pn = (wgid % nig) / gsz; return true;
    }
    __device__ __forceinline__ void a_ready(const Unit&) const {}
    __device__ __forceinline__ void done(const Unit&) const {}
};


__device__ __forceinline__ unsigned cvt_pk_bf16(float lo, float hi) { unsigned r; asm volatile("v_cvt_pk_bf16_f32 %0, %1, %2" : "=v"(r) : "v"(lo), "v"(hi)); return r; }

template <bool SSQ, bool RELU2> struct EpiProj {
    static constexpr bool PERM = true, AFTER_DRAIN = false;
    bf16_t* O; int ldc; const float* xsq; float* ssq; int ssq_rows; float* ab; int n_main;
    __device__ __forceinline__ void operator()(const f32x4 (&acc)[2][2][4][2], const Unit& u, int wr, int wc, int fr, int fq) const {
        const int row0 = u.pm * BM + wr * 64 + fr, colt = u.pn * BM;
        const bool is_ab = u.pn >= n_main;
#pragma unroll
        for (int ai = 0; ai < 2; ++ai)
#pragma unroll
            for (int m = 0; m < 4; ++m) {
                const int r = row0 + ai * HALF + m * 16;
                const f32x4 q4 = *(const f32x4*)(xsq + (size_t)r * 16 + 4 * fq);
                float s = (q4[0] + q4[1]) + (q4[2] + q4[3]);
                s += __shfl_xor(s, 16); s += __shfl_xor(s, 32);
                const float rstd = rsqrtf(s * (1.0f / 1024.0f) + 1e-6f);
                if (!is_ab) {
#pragma unroll
                    for (int bj = 0; bj < 2; ++bj) {
                        f32x4 v0 = acc[ai][bj][m][0] * rstd, v1 = acc[ai][bj][m][1] * rstd;
                        if (SSQ) {
                            float ss = ((v0[0] * v0[0] + v0[1] * v0[1]) + (v0[2] * v0[2] + v0[3] * v0[3])) + ((v1[0] * v1[0] + v1[1] * v1[1]) + (v1[2] * v1[2] + v1[3] * v1[3]));
                            ss += __shfl_xor(ss, 16); ss += __shfl_xor(ss, 32);
                            if (fq == 0) ssq[((size_t)((colt >> 7) + bj) * ssq_rows + r) * 4 + wc] = ss;
                        }
                        if (RELU2) {
#pragma unroll
                            for (int e = 0; e < 4; ++e) { const float a = fmaxf(v0[e], 0.f), b = fmaxf(v1[e], 0.f); v0[e] = a * a; v1[e] = b * b; }
                        }
                        u32x4 w; w.x = cvt_pk_bf16(v0[0], v0[1]); w.y = cvt_pk_bf16(v0[2], v0[3]); w.z = cvt_pk_bf16(v1[0], v1[1]); w.w = cvt_pk_bf16(v1[2], v1[3]);
                        *(u32x4*)(O + (size_t)r * ldc + colt + bj * HALF + wc * 32 + 8 * fq) = w;
                    }
                } else if (ab != nullptr && wc == 0 && fq < 2) {
                    float* p = ab + (size_t)r * 16 + 8 * fq;
                    *(f32x4*)p = acc[ai][0][m][0] * rstd; *(f32x4*)(p + 4) = acc[ai][0][m][1] * rstd;
                }
            }
    }
};
struct EpiRes {
    static constexpr bool PERM = true, AFTER_DRAIN = false;
    const float* xold; float* xnew; bf16_t* xb; float* xsq;
    __device__ __forceinline__ void operator()(const f32x4 (&acc)[2][2][4][2], const Unit& u, int wr, int wc, int fr, int fq) const {
        const int row0 = u.pm * BM + wr * 64 + fr, colt = u.pn * BM;
#pragma unroll
        for (int ai = 0; ai < 2; ++ai)
#pragma unroll
            for (int m = 0; m < 4; ++m) {
                const int r = row0 + ai * HALF + m * 16; float ss = 0.f;
#pragma unroll
                for (int bj = 0; bj < 2; ++bj) {
                    const size_t off = (size_t)r * 1024 + colt + bj * HALF + wc * 32 + 8 * fq;
                    const f32x4 v0 = acc[ai][bj][m][0] + *(const f32x4*)(xold + off), v1 = acc[ai][bj][m][1] + *(const f32x4*)(xold + off + 4);
                    *(f32x4*)(xnew + off) = v0; *(f32x4*)(xnew + off + 4) = v1;
                    ss += ((v0[0] * v0[0] + v0[1] * v0[1]) + (v0[2] * v0[2] + v0[3] * v0[3])) + ((v1[0] * v1[0] + v1[1] * v1[1]) + (v1[2] * v1[2] + v1[3] * v1[3]));
                    u32x4 w; w.x = cvt_pk_bf16(v0[0], v0[1]); w.y = cvt_pk_bf16(v0[2], v0[3]); w.z = cvt_pk_bf16(v1[0], v1[1]); w.w = cvt_pk_bf16(v1[2], v1[3]);
                    *(u32x4*)(xb + off) = w;
                }
                ss += __shfl_xor(ss, 16); ss += __shfl_xor(ss, 32);
                if (fq == 0) xsq[(size_t)r * 16 + u.pn * 4 + wc] = ss;
            }
    }
};

template <class Epi, class Sched, bool ALIGN_EPI = false, bool SP2 = false>
__device__ __forceinline__ void gemm_phase(PG8_LAS unsigned char* lds, const Gemm g, const Sched& S, const Epi& E, int wid) {
    int lane = (int)__builtin_amdgcn_mbcnt_hi(~0u, __builtin_amdgcn_mbcnt_lo(~0u, 0u)); asm volatile("" : "+v"(lane));
    const int tid = wid * 64 + lane, wr = wid >> 2, wc = wid & 3, fr = lane & 15, fq = lane >> 4;
    const int K = g.K, nt = K / BK;
    unsigned voffA[2], voffB[2];
#pragma unroll
    for (int i = 0; i < 2; ++i) { int R, C; stage_rc(tid * 16 + i * 8192, R, C); const int Rb = Epi::PERM ? ((R & ~31) + perm32(R & 31)) : R;
        voffA[i] = (unsigned)(R * g.lda + C) * 2u; voffB[i] = (unsigned)(Rb * K + C) * 2u; }
    const size_t kstep = (size_t)(BK * 2);
    const size_t hstepA = (size_t)HALF * g.lda * 2, hstepB = (size_t)HALF * K * 2;
    const size_t tstepA = 2 * hstepA, tstepB = 2 * hstepB;
    const unsigned ldsw = (unsigned)wid * 1024u;
    const int aoff = lds_byte(wr * 64 + fr, fq * 8), boff = lds_byte(wc * 32 + fr, fq * 8);
#define PG8_SA(b, h) (((b) * 2 + (h)) * HTB)
#define PG8_SB(b, h) ((4 + (b) * 2 + (h)) * HTB)
#define PG8_STAGE(bufoff, gbase, voff) do { _Pragma("unroll") for (int _i = 0; _i < 2; ++_i) \
        __builtin_amdgcn_global_load_lds((const unsigned*)((const char*)(gbase) + (voff)[_i]), (PG8_LAS unsigned*)(lds + (bufoff) + ldsw + _i * 8192), 16, 0, 0); } while (0)
#define PG8_LDA(dst, b, h) do { _Pragma("unroll") for (int m = 0; m < 4; ++m) _Pragma("unroll") for (int k = 0; k < 2; ++k) dst[m][k] = *(const PG8_LAS bf16x8*)(lds + PG8_SA(b, h) + aoff + m * 2048 + k * 1024); } while (0)
#define PG8_LDB(dst, b, h) do { _Pragma("unroll") for (int n = 0; n < 2; ++n) _Pragma("unroll") for (int k = 0; k < 2; ++k) dst[n][k] = *(const PG8_LAS bf16x8*)(lds + PG8_SB(b, h) + boff + n * 2048 + k * 1024); } while (0)
#define PG8_MMA(ai, bj, At, Bt) do { __builtin_amdgcn_s_setprio(1); _Pragma("unroll") for (int m = 0; m < 4; ++m) _Pragma("unroll") for (int n = 0; n < 2; ++n) _Pragma("unroll") for (int k = 0; k < 2; ++k) \
        acc[ai][bj][m][n] = __builtin_amdgcn_mfma_f32_16x16x32_bf16(Bt[n][k], At[m][k], acc[ai][bj][m][n], 0, 0, 0); __builtin_amdgcn_s_setprio(0); } while (0)
#define PG8_WAIT_V(n) asm volatile("s_waitcnt vmcnt(" #n ")" ::: "memory")
#define PG8_WAIT_L(n) asm volatile("s_waitcnt lgkmcnt(" #n ")" ::: "memory")
#define PG8_BAR __builtin_amdgcn_s_barrier()
#define PG8_SCHED __builtin_amdgcn_sched_barrier(0)
    Unit cur, nxt; int ui = 0;
    if (!S.next(0, cur)) return;
    f32x4 acc[2][2][4][2];
#pragma unroll
    for (int a = 0; a < 2; ++a)
#pragma unroll
        for (int b = 0; b < 2; ++b)
#pragma unroll
            for (int m = 0; m < 4; ++m)
#pragma unroll
                for (int n = 0; n < 2; ++n) acc[a][b][m][n] = (f32x4){0.f, 0.f, 0.f, 0.f};
    bf16x8 At[4][2], B0[2][2], B1[2][2];
    const char* cA = (const char*)g.A + (size_t)cur.pm * tstepA; const char* cB = (const char*)g.Bt + (size_t)cur.pn * tstepB;
    S.a_ready(cur);
    if constexpr (SP2) {
        PG8_STAGE(PG8_SB(0, 0), cB, voffB); PG8_STAGE(PG8_SB(0, 1), cB + hstepB, voffB); PG8_STAGE(PG8_SA(0, 0), cA, voffA); PG8_STAGE(PG8_SA(0, 1), cA + hstepA, voffA);
        if (wr == 1) PG8_BAR;
        PG8_WAIT_V(2); PG8_BAR;
        PG8_STAGE(PG8_SB(1, 0), cB + kstep, voffB); PG8_STAGE(PG8_SA(1, 0), cA + kstep, voffA); PG8_STAGE(PG8_SB(1, 1), cB + hstepB + kstep, voffB);
        PG8_WAIT_V(6); PG8_BAR;
    } else {
        PG8_STAGE(PG8_SB(0, 0), cB, voffB); PG8_STAGE(PG8_SA(0, 0), cA, voffA); PG8_STAGE(PG8_SB(0, 1), cB + hstepB, voffB); PG8_STAGE(PG8_SA(0, 1), cA + hstepA, voffA);
        if (wr == 1) PG8_BAR;
        PG8_WAIT_V(4); PG8_BAR;
        PG8_STAGE(PG8_SB(1, 0), cB + kstep, voffB); PG8_STAGE(PG8_SA(1, 0), cA + kstep, voffA); PG8_STAGE(PG8_SB(1, 1), cB + hstepB + kstep, voffB);
        PG8_WAIT_V(6); PG8_BAR;
    }
    for (;;) {
        const bool has_next = S.next(ui + 1, nxt);
        const char* nA = has_next ? (const char*)g.A + (size_t)nxt.pm * tstepA : cA; const char* nB = has_next ? (const char*)g.Bt + (size_t)nxt.pn * tstepB : cB;
        for (int t = 0; t < nt; t += 2) {
            const bool last = (t == nt - 2);
            const char* a1 = cA + (size_t)(t + 1) * kstep;
            const char* a2 = last ? nA : cA + (size_t)(t + 2) * kstep; const char* b2 = last ? nB : cB + (size_t)(t + 2) * kstep;
            const char* a3 = a2 + kstep; const char* b3 = b2 + kstep;
            if (last && has_next) S.a_ready(nxt);
            if constexpr (SP2) {
            PG8_LDB(B0, 0, 0); PG8_LDB(B1, 0, 1); PG8_SCHED; PG8_LDA(At, 0, 0); PG8_STAGE(PG8_SA(1, 1), a1 + hstepA, voffA);
            PG8_WAIT_V(8); PG8_WAIT_L(0); PG8_BAR; PG8_MMA(0, 0, At, B0); PG8_MMA(0, 1, At, B1); PG8_BAR; PG8_SCHED;
            PG8_LDA(At, 0, 1); PG8_STAGE(PG8_SB(0, 0), b2, voffB); PG8_STAGE(PG8_SB(0, 1), b2 + hstepB, voffB); PG8_STAGE(PG8_SA(0, 0), a2, voffA);
            PG8_WAIT_V(8); PG8_WAIT_L(0); PG8_BAR; PG8_MMA(1, 0, At, B0); PG8_MMA(1, 1, At, B1); PG8_BAR; PG8_SCHED;
            PG8_LDB(B0, 1, 0); PG8_LDB(B1, 1, 1); PG8_SCHED; PG8_LDA(At, 1, 0); PG8_STAGE(PG8_SA(0, 1), a2 + hstepA, voffA);
            PG8_WAIT_V(8); PG8_WAIT_L(0); PG8_BAR; PG8_MMA(0, 0, At, B0); PG8_MMA(0, 1, At, B1); PG8_BAR; PG8_SCHED;
            PG8_LDA(At, 1, 1); PG8_STAGE(PG8_SB(1, 0), b3, voffB); PG8_STAGE(PG8_SB(1, 1), b3 + hstepB, voffB); PG8_STAGE(PG8_SA(1, 0), a3, voffA);
            PG8_WAIT_V(8); PG8_WAIT_L(0); PG8_BAR; PG8_MMA(1, 0, At, B0); PG8_MMA(1, 1, At, B1); PG8_BAR; PG8_SCHED;
            } else {
            PG8_LDB(B0, 0, 0); PG8_SCHED; PG8_LDA(At, 0, 0); PG8_STAGE(PG8_SA(1, 1), a1 + hstepA, voffA);
            PG8_WAIT_L(8); PG8_BAR; PG8_WAIT_L(0); PG8_MMA(0, 0, At, B0); PG8_BAR; PG8_SCHED;
            PG8_LDB(B1, 0, 1); PG8_STAGE(PG8_SB(0, 0), b2, voffB);
            PG8_BAR; PG8_WAIT_L(0); PG8_MMA(0, 1, At, B1); PG8_BAR;
            PG8_LDA(At, 0, 1); PG8_STAGE(PG8_SA(0, 0), a2, voffA);
            PG8_BAR; PG8_WAIT_L(0); PG8_MMA(1, 0, At, B0); PG8_BAR; PG8_SCHED;
            PG8_STAGE(PG8_SB(0, 1), b2 + hstepB, voffB);
            PG8_WAIT_V(6); PG8_BAR; PG8_MMA(1, 1, At, B1); PG8_BAR;
            PG8_LDB(B0, 1, 0); PG8_SCHED; PG8_LDA(At, 1, 0); PG8_STAGE(PG8_SA(0, 1), a2 + hstepA, voffA);
            PG8_WAIT_L(8); PG8_BAR; PG8_WAIT_L(0); PG8_MMA(0, 0, At, B0); PG8_BAR; PG8_SCHED;
            PG8_LDB(B1, 1, 1); PG8_STAGE(PG8_SB(1, 0), b3, voffB);
            PG8_BAR; PG8_WAIT_L(0); PG8_MMA(0, 1, At, B1); PG8_BAR;
            PG8_LDA(At, 1, 1); PG8_STAGE(PG8_SA(1, 0), a3, voffA);
            PG8_BAR; PG8_WAIT_L(0); PG8_MMA(1, 0, At, B0); PG8_BAR; PG8_SCHED;
            PG8_STAGE(PG8_SB(1, 1), b3 + hstepB, voffB);
            PG8_WAIT_V(6); PG8_BAR; PG8_MMA(1, 1, At, B1); PG8_BAR;
            }
        }
        if constexpr (ALIGN_EPI) { if (wr == 0) PG8_BAR; }
        if constexpr (!Epi::AFTER_DRAIN) { E(acc, cur, wr, wc, fr, fq); S.done(cur); }
        if (!has_next) break;
#pragma unroll
        for (int a = 0; a < 2; ++a)
#pragma unroll
            for (int b = 0; b < 2; ++b)
#pragma unroll
                for (int m = 0; m < 4; ++m)
#pragma unroll
                    for (int n = 0; n < 2; ++n) acc[a][b][m][n] = (f32x4){0.f, 0.f, 0.f, 0.f};
        cur = nxt; cA = nA; cB = nB; ++ui;
        if constexpr (ALIGN_EPI) { if (wr == 1) PG8_BAR; }
    }
    PG8_WAIT_V(0);
    if constexpr (!ALIGN_EPI) { if (wr == 0) PG8_BAR; }
    PG8_BAR;
    if constexpr (Epi::AFTER_DRAIN) { E.fused(acc, cur, wr, wc, fr, fq, lds, wid, lane); S.done(cur); }
#undef PG8_SA
#undef PG8_SB
#undef PG8_STAGE
#undef PG8_LDA
#undef PG8_LDB
#undef PG8_MMA
#undef PG8_WAIT_V
#undef PG8_WAIT_L
#undef PG8_BAR
#undef PG8_SCHED
}
}

namespace att {
typedef unsigned short bf16_t;
typedef short bf16x8 __attribute__((ext_vector_type(8)));
typedef short s16x4 __attribute__((ext_vector_type(4)));
typedef float f32x16 __attribute__((ext_vector_type(16)));
typedef float f32x4 __attribute__((ext_vector_type(4)));
typedef unsigned u32x4 __attribute__((ext_vector_type(4)));
constexpr int NW = 8, QBLK = 32, KVBLK = 64, QB = NW * QBLK, D = 128;
constexpr int SHM_V = KVBLK * D * 2, SHM_K = KVBLK * D * 2;
constexpr int OFF_WS = 2 * SHM_V + 2 * SHM_K, OFF_BK = OFF_WS + NW * 64 * 4, ATT_LDS = OFF_BK + 8192;
constexpr float SCALE = 0.08838834764831845f, THR = 8.f;
constexpr int WBIG = 1 << 30;
#define KSWZ(row, colB) ((row) * 256 + ((colB) ^ (((row) & 7) << 4)))
#define SBAR() __builtin_amdgcn_sched_barrier(0)
__device__ __forceinline__ int v_st(int k, int c) { const int kk = (k & ~0xC) | ((k & 4) << 1) | ((k & 8) >> 1); return ((kk >> 3) * 4 + (c >> 5)) * 512 + ((kk & 7) * 32 + (c & 31)) * 2; }
__device__ __forceinline__ int v_rd_base(int lane) { return ((lane & 3) << 3) | (((lane >> 2) & 3) << 6) | (((lane >> 4) & 1) << 5) | (((lane >> 5) & 1) << 8); }
constexpr int v_rd_off(int d0, int ks, int half) { return d0 * 512 + ks * 4096 + half * 2048; }
__device__ __forceinline__ int crow(int r, int hi) { return (r & 3) + 8 * (r >> 2) + 4 * hi; }
__device__ __forceinline__ unsigned cvtpk(float lo, float hi) { unsigned r; asm volatile("v_cvt_pk_bf16_f32 %0, %1, %2" : "=v"(r) : "v"(lo), "v"(hi)); return r; }
__device__ __forceinline__ bf16x8 load8(const bf16_t* p) { return *reinterpret_cast<const bf16x8*>(p); }
__device__ __forceinline__ void mask_tile(f32x16& p0, f32x16& p1, int dq, unsigned W) {
    const float NEG = -__builtin_inff();
#pragma unroll
    for (int r = 0; r < 16; ++r) { const int c = (r & 3) + 8 * (r >> 2);
        if ((unsigned)(dq - c) >= W) p0[r] = NEG;
        if ((unsigned)(dq - c - 32) >= W) p1[r] = NEG; }
}
__device__ __forceinline__ void partialSM(f32x16& p0, f32x16& p1, float& m_reg, float& mn, float& alpha) {
    float pmax = p0[0]; for (int r = 1; r < 16; ++r) pmax = fmaxf(pmax, p0[r]); for (int r = 0; r < 16; ++r) pmax = fmaxf(pmax, p1[r]);
    { auto rr = __builtin_amdgcn_permlane32_swap(__float_as_uint(pmax), __float_as_uint(pmax), false, false);
      pmax = fmaxf(__uint_as_float(rr[0]), __uint_as_float(rr[1])); }
    constexpr float C2 = 1.4426950408889634f * SCALE;
    if (__builtin_expect(__all((pmax - m_reg) * SCALE <= THR), 1)) { mn = m_reg; alpha = 1.f; }
    else { mn = fmaxf(m_reg, pmax); alpha = __builtin_amdgcn_exp2f((m_reg - mn) * C2); m_reg = mn; }
    const float mnL = -mn * C2;
    for (int r = 0; r < 16; ++r) p0[r] = fmaf(p0[r], C2, mnL); for (int r = 0; r < 16; ++r) p1[r] = fmaf(p1[r], C2, mnL);
    for (int r = 0; r < 16; ++r) p0[r] = __builtin_amdgcn_exp2f(p0[r]);
}
__device__ __forceinline__ void finishSM(f32x16& p0, f32x16& p1, float alpha, float& l_reg, bf16x8& pa0, bf16x8& pa1, bf16x8& pa2, bf16x8& pa3) {
    for (int r = 0; r < 16; ++r) p1[r] = __builtin_amdgcn_exp2f(p1[r]);
    float ps = 0; for (int r = 0; r < 16; ++r) ps += p0[r]; for (int r = 0; r < 16; ++r) ps += p1[r];
    { auto rr = __builtin_amdgcn_permlane32_swap(__float_as_uint(ps), __float_as_uint(ps), false, false);
      ps = __uint_as_float(rr[0]) + __uint_as_float(rr[1]); }
    l_reg = l_reg * alpha + ps;
#define PK4(P, B_, OUT) do { unsigned a0 = cvtpk(P[B_+0], P[B_+1]), a1 = cvtpk(P[B_+2], P[B_+3]);                          \
        unsigned b0 = cvtpk(P[B_+4], P[B_+5]), b1 = cvtpk(P[B_+6], P[B_+7]);                                             \
        auto r0 = __builtin_amdgcn_permlane32_swap(a0, b0, false, false); auto r1 = __builtin_amdgcn_permlane32_swap(a1, b1, false, false); \
        u32x4 w = {r0[0], r1[0], r0[1], r1[1]}; OUT = *reinterpret_cast<bf16x8*>(&w); } while (0)
    PK4(p0, 0, pa0); PK4(p0, 8, pa1); PK4(p1, 0, pa2); PK4(p1, 8, pa3);
#undef PK4
}
template <int KB>
__device__ __forceinline__ void qkt(f32x16& p0, f32x16& p1, const char* K_lds, int r32, int hi, const bf16x8* qr, const float* bb) {
#pragma unroll
    for (int g = 0; g < 4; ++g) { const f32x4 b0 = *(const f32x4*)(bb + 8 * g), b1 = *(const f32x4*)(bb + 32 + 8 * g);
#pragma unroll
        for (int i = 0; i < 4; ++i) { p0[4 * g + i] = b0[i]; p1[4 * g + i] = b1[i]; } }
    const char* kb[4];
#pragma unroll
    for (int dd = 0; dd < 4; ++dd) kb[dd] = K_lds + KB * SHM_K + KSWZ(r32, (dd * 16 + hi * 8) * 2);
#pragma unroll
    for (int d0 = 0; d0 < 8; ++d0) { const char* a = kb[d0 & 3] + (d0 >> 2) * 128;
        bf16x8 b0 = *reinterpret_cast<const bf16x8*>(a);
        bf16x8 b1 = *reinterpret_cast<const bf16x8*>(a + 32 * 256);
        p0 = __builtin_amdgcn_mfma_f32_32x32x16_bf16(b0, qr[d0], p0, 0, 0, 0);
        p1 = __builtin_amdgcn_mfma_f32_32x32x16_bf16(b1, qr[d0], p1, 0, 0, 0); }
}
template <int VB>
__device__ __forceinline__ void pv_tile(f32x16* o, int vb0, bf16x8 pa0, bf16x8 pa1, bf16x8 pa2, bf16x8 pa3) {
#define TRRD(dst, off) asm volatile("ds_read_b64_tr_b16 %0, %1 offset:%2" : "=&v"(dst) : "v"(vb0), "i"(off) : "memory")
#define PV_D0(d0) do { s16x4 l0, l1, l2, l3, h0, h1, h2, h3; constexpr int b_ = VB * SHM_V + v_rd_off(d0, 0, 0);   \
        TRRD(l0, b_); TRRD(h0, b_ + 2048); TRRD(l1, b_ + 4096); TRRD(h1, b_ + 6144); TRRD(l2, b_ + 8192); TRRD(h2, b_ + 10240); TRRD(l3, b_ + 12288); TRRD(h3, b_ + 14336); \
        asm volatile("s_waitcnt lgkmcnt(0)" ::: "memory"); SBAR();   \
        o[d0] = __builtin_amdgcn_mfma_f32_32x32x16_bf16(pa0, (bf16x8){l0[0], l0[1], l0[2], l0[3], h0[0], h0[1], h0[2], h0[3]}, o[d0], 0, 0, 0);   \
        o[d0] = __builtin_amdgcn_mfma_f32_32x32x16_bf16(pa1, (bf16x8){l1[0], l1[1], l1[2], l1[3], h1[0], h1[1], h1[2], h1[3]}, o[d0], 0, 0, 0);   \
        o[d0] = __builtin_amdgcn_mfma_f32_32x32x16_bf16(pa2, (bf16x8){l2[0], l2[1], l2[2], l2[3], h2[0], h2[1], h2[2], h2[3]}, o[d0], 0, 0, 0);   \
        o[d0] = __builtin_amdgcn_mfma_f32_32x32x16_bf16(pa3, (bf16x8){l3[0], l3[1], l3[2], l3[3], h3[0], h3[1], h3[2], h3[3]}, o[d0], 0, 0, 0); } while (0)
    PV_D0(0); PV_D0(1); PV_D0(2); PV_D0(3);
#undef PV_D0
#undef TRRD
}
constexpr int QP = 4608;
struct Blk { bf16_t* Q; const bf16_t* K; const float* fcum; int voff, goff, P0, skv, kvpitch; };
struct Seam { bf16x8 qr[8]; bf16x8 st_v0, st_v1, st_k0, st_k1; };
#define ROW(p, pitch, k0, rr) ((p) + (size_t)((k0) + (rr)) * (pitch) + sc)
#define VMW() asm volatile("s_waitcnt vmcnt(0)" ::: "memory")
#define VMWN(n) asm volatile("s_waitcnt vmcnt(%0)" :: "i"(n) : "memory")
#define SLOAD_H(Kp, Vp, pitch, k0) do { S.st_v0 = load8(ROW(Vp, pitch, k0, sr)); S.st_v1 = load8(ROW(Vp, pitch, k0, 32 + sr));              \
                         S.st_k0 = load8(ROW(Kp, pitch, k0, sr)); S.st_k1 = load8(ROW(Kp, pitch, k0, 32 + sr)); } while (0)
#define SWRITE_HK(bf) do { *(bf16x8*)(K_lds + (bf) * SHM_K + kws) = S.st_k0; *(bf16x8*)(K_lds + (bf) * SHM_K + kws + 32 * 256) = S.st_k1; } while (0)
#define SWRITE_HV(bf) do { *(bf16x8*)(V_lds + (bf) * SHM_V + vst0) = S.st_v0; *(bf16x8*)(V_lds + (bf) * SHM_V + vst1) = S.st_v1; } while (0)
#define SWRITE_H(bf) do { SWRITE_HV(bf); SWRITE_HK(bf); } while (0)
__device__ __forceinline__ void prime(const Blk& cur, char* lds, Seam& S, int wid) {
    int lane = (int)__builtin_amdgcn_mbcnt_hi(~0u, __builtin_amdgcn_mbcnt_lo(~0u, 0u)); asm volatile("" : "+v"(lane));
    const int tid = wid * 64 + lane, r32 = lane & 31, hi = lane >> 5;
    const int sr = tid >> 4, sc = (tid & 15) * 8, kws = KSWZ(sr, sc * 2); char* K_lds = lds + 2 * SHM_V;
    for (int d0 = 0; d0 < 8; ++d0) S.qr[d0] = load8(cur.Q + (size_t)(wid * QBLK + r32) * QP + d0 * 16 + hi * 8);
    SLOAD_H(cur.K, cur.K + cur.voff, cur.kvpitch, 0); VMW(); SWRITE_HK(0);
    __syncthreads();
}
__device__ __forceinline__ void block(const Blk& cur, const Blk& nxt, char* lds, Seam& S, int wid) {
    int lane = (int)__builtin_amdgcn_mbcnt_hi(~0u, __builtin_amdgcn_mbcnt_lo(~0u, 0u)); asm volatile("" : "+v"(lane));
    const int tid = wid * 64 + lane, r32 = lane & 31, hi = lane >> 5;
    constexpr int W = WBIG;
    int j_hi = (cur.P0 + QB - 1) / KVBLK + 1; if (j_hi > cur.skv / KVBLK) j_hi = cur.skv / KVBLK;
    const int NT = j_hi;
    const int qlo = cur.P0 + wid * QBLK, qm = qlo + r32 - 4 * hi;
    char* V_lds = lds; char* K_lds = lds + 2 * SHM_V;
    float* ws = (float*)(lds + OFF_WS) + wid * 64; float* li_l = ws, * al_l = ws + 32;
    float* bkl = (float*)(lds + OFF_BK);
    { const int nkeys = NT * KVBLK;
      for (int k = tid; k < nkeys; k += NW * 64) bkl[k] = cur.fcum ? -cur.fcum[k] * (1.f / SCALE) : 0.f;
      __syncthreads(); }
    float m_reg = -1e30f, l_reg = 0; f32x16 o[4] = {};
    const int sr = tid >> 4, sc = (tid & 15) * 8, vst0 = v_st(sr, sc), vst1 = v_st(32 + sr, sc), kws = KSWZ(sr, sc * 2);
    const int vb0 = (int)(uintptr_t)V_lds + v_rd_base(lane);
    const bf16_t* Kh = cur.K; const bf16_t* Vh = cur.K + cur.voff; const int kvp = cur.kvpitch;
#define RESC(a) do { if (__any((a) < 1.f)) { if (hi == 0) al_l[r32] = (a); asm volatile("s_waitcnt lgkmcnt(0)" ::: "memory");              \
                     for (int d_ = 0; d_ < 4; ++d_) for (int r = 0; r < 16; ++r) o[d_][r] *= al_l[crow(r, hi)]; } } while (0)
#define KBASE(t) ((t) * KVBLK)
#define MASKT(P0_, P1_, t) do { const int kb_ = KBASE(t); if (kb_ + KVBLK - 1 > qlo) mask_tile(P0_, P1_, qm - kb_, (unsigned)W); } while (0)
#define BB(t) (bkl + KBASE(t) + 4 * hi)
    constexpr int NQL = 8;
#define SEAM_K0() do { VMWN(NQL); SWRITE_HK(0); SBAR(); } while (0)
    f32x16 pA0, pA1, pB0, pB1; float mnA, mnB, alA, alB; bf16x8 pa0, pa1, pa2, pa3;
    SWRITE_HV(0); SBAR();
    if (NT > 1) { SLOAD_H(Kh, Vh, kvp, KBASE(1)); }
    SBAR(); qkt<0>(pA0, pA1, K_lds, r32, hi, S.qr, BB(0));
    MASKT(pA0, pA1, 0); partialSM(pA0, pA1, m_reg, mnA, alA);
    if (NT > 1) { VMW(); SWRITE_H(1); }
    __syncthreads();
#define HALF_STEP(PX0, PX1, mnX, alX, PY0, PY1, alY, t, KB, VB, SB) do {                                                      \
        SBAR(); qkt<KB>(PX0, PX1, K_lds, r32, hi, S.qr, BB(t));                                                                      \
        finishSM(PY0, PY1, alY, l_reg, pa0, pa1, pa2, pa3); SBAR();                                                           \
        if ((t) + 1 < NT) { SLOAD_H(Kh, Vh, kvp, KBASE((t) + 1)); SBAR(); }                                                   \
        pv_tile<VB>(o, vb0, pa0, pa1, pa2, pa3); MASKT(PX0, PX1, (t)); partialSM(PX0, PX1, m_reg, mnX, alX);   \
        __syncthreads();                                                                                                      \
        if ((t) + 1 < NT) { VMW(); SWRITE_H(SB); }                                                                            \
        RESC(alX); __syncthreads(); } while (0)
    for (int t = 1; t + 1 < NT; t += 2) {
        HALF_STEP(pB0, pB1, mnB, alB, pA0, pA1, alA, t, 1, 0, 0);
        HALF_STEP(pA0, pA1, mnA, alA, pB0, pB1, alB, t + 1, 0, 1, 1);
    }
    const bool even = (NT & 1) == 0;
    if (even) { SBAR(); qkt<1>(pB0, pB1, K_lds, r32, hi, S.qr, BB(NT - 1)); SBAR(); }
    SLOAD_H(nxt.K, nxt.K + nxt.voff, nxt.kvpitch, 0); SBAR();
#pragma unroll
    for (int d0 = 0; d0 < 8; ++d0) S.qr[d0] = load8(nxt.Q + (size_t)(wid * QBLK + r32) * QP + d0 * 16 + hi * 8);
    SBAR();
    finishSM(pA0, pA1, alA, l_reg, pa0, pa1, pa2, pa3); SBAR();
    pv_tile<0>(o, vb0, pa0, pa1, pa2, pa3);
    if (even) { MASKT(pB0, pB1, NT - 1); partialSM(pB0, pB1, m_reg, mnB, alB); __syncthreads(); RESC(alB);
        finishSM(pB0, pB1, alB, l_reg, pa0, pa1, pa2, pa3); SBAR(); pv_tile<1>(o, vb0, pa0, pa1, pa2, pa3); }
    SBAR(); SEAM_K0();
    if (hi == 0) li_l[r32] = l_reg; asm volatile("s_waitcnt lgkmcnt(0)" ::: "memory");
    float rli[16];
#pragma unroll
    for (int r = 0; r < 16; ++r) rli[r] = __builtin_amdgcn_rcpf(li_l[crow(r, hi)]);
    bf16_t* Ow = cur.Q + (size_t)(wid * QBLK + 4 * hi) * QP + r32; const int goff = cur.goff;
#pragma unroll
    for (int r = 0; r < 16; ++r) { const int ro = ((r & 3) + 8 * (r >> 2)) * QP;
#pragma unroll
        for (int d0 = 0; d0 < 4; ++d0) { float v = o[d0][r] * rli[r];
            if (goff) { const float g = __uint_as_float((unsigned)Ow[goff + ro + d0 * 32] << 16); v *= __builtin_amdgcn_rcpf(1.f + __expf(-g)); }
            const float vn = __shfl_xor(v, 1);
            if ((r32 & 1) == 0) *(unsigned*)(Ow + ro + d0 * 32) = cvtpk(v, vn); } }
    __syncthreads();
#undef RESC
#undef KBASE
#undef MASKT
#undef BB
#undef SEAM_K0
#undef HALF_STEP
}
#undef ROW
#undef VMW
#undef VMWN
#undef SLOAD_H
#undef SWRITE_HK
#undef SWRITE_HV
#undef SWRITE_H
#undef KSWZ
#undef SBAR
template <class Src> __device__ __forceinline__ void phase(char* lds, const Src& src, int wid) {
    Blk cur, nxt; if (!src(0, cur)) return;
    Seam S; prime(cur, lds, S, wid);
    for (int n = 0;; ++n) { const bool more = src(n + 1, nxt); if (!more) nxt = cur; block(cur, nxt, lds, S, wid); if (!more) break; cur = nxt; }
}
}

constexpr int NWAVES = 8;
#ifndef MK_LAUNCH_PER_PHASE
#define MK_LAUNCH_PER_PHASE 0
#endif
constexpr int N_PHASES = 13;

constexpr size_t KiB = 1u << 10, MiB = 1u << 20;
constexpr size_t WS_CTL = 0, CTL_ZERO_BYTES = 1 * MiB;
constexpr size_t WS_WIN0 = 1 * MiB, WS_WIN1 = WS_WIN0 + (size_t)N_IN * DM * 2;
constexpr size_t WS_WOUT0 = 20 * MiB, WS_WOUT1 = 23 * MiB;
constexpr size_t WS_WM1_0 = 26 * MiB, WS_WM1_1 = 34 * MiB, WS_WM2_0 = 42 * MiB, WS_WM2_1 = 50 * MiB;
constexpr size_t WS_WMKV = 58 * MiB;
constexpr size_t WS_PROJ = 60 * MiB;
constexpr size_t WS_XB = 204 * MiB;
constexpr size_t WS_SSQ = 236 * MiB;
constexpr size_t WS_AB = 245 * MiB;
constexpr size_t WS_MEMKV = 246 * MiB;
constexpr size_t WS_XSQ = 250 * MiB;
constexpr size_t WS_FCUM = 251 * MiB;
constexpr size_t WS_MSSQ = 251 * MiB + 512 * KiB;
constexpr size_t WS_MSQ = 251 * MiB + 768 * KiB;
constexpr size_t WS_END = 252 * MiB;
static_assert(WS_WIN1 + (size_t)N_IN * DM * 2 <= WS_WOUT0 && WS_PROJ + (size_t)MROWS * PW * 2 <= WS_XB && WS_SSQ + (size_t)36 * MROWS * 16 <= WS_AB, "d_ws map");
constexpr size_t DO_MEMB = 0;
constexpr int CW_BAR = 4096;

constexpr int LDS_BYTES = 155648;
constexpr int MISC_OFF = LDS_BYTES - 256;

#define GAS __attribute__((address_space(1)))
#define LAS __attribute__((address_space(3)))
typedef unsigned short bf16;
typedef unsigned v4u __attribute__((ext_vector_type(4)));
typedef float f32x4 __attribute__((ext_vector_type(4)));
typedef short bf16x8 __attribute__((ext_vector_type(8)));
typedef GAS unsigned gu32;
typedef GAS unsigned long long gu64;
#define RLX_AGENT __ATOMIC_RELAXED, __HIP_MEMORY_SCOPE_AGENT
#define LDS_WAIT() asm volatile("s_waitcnt lgkmcnt(0)" ::: "memory")
#define VM_WAIT() asm volatile("s_waitcnt vmcnt(0)" ::: "memory")
__device__ __forceinline__ unsigned long long rt() { return __builtin_amdgcn_s_memrealtime(); }
__device__ __forceinline__ unsigned f2bf(float f) { unsigned u = __builtin_bit_cast(unsigned, f); return (u + 0x7fffu + ((u >> 16) & 1u)) >> 16; }
__device__ __forceinline__ unsigned pk2(float lo, float hi) { return f2bf(lo) | (f2bf(hi) << 16); }

#define XB_TMO      128
#define XB_XCNT(j)  (256  + 64 * (j))
#define XB_XSUB(j)  (1280 + 64 * (j))
#define XB_XGEN(j)  (2304 + 64 * (j))
#define XB_TOP      3328
#define XB_TOPGEN   3392
#define XCD_BAR_WORDS 3456
#define XB_SPIN_CAP (1u << 18)

__device__ __forceinline__ unsigned xb_ld(unsigned* p)              { return __hip_atomic_load(p, __ATOMIC_RELAXED, __HIP_MEMORY_SCOPE_AGENT); }
__device__ __forceinline__ unsigned xb_add(unsigned* p, unsigned v) { return __hip_atomic_fetch_add(p, v, __ATOMIC_RELAXED, __HIP_MEMORY_SCOPE_AGENT); }
__device__ __forceinline__ unsigned xb_xcc_id() { return (unsigned)__builtin_amdgcn_s_getreg((3 << 11) | 20) & 0xFu; }
#define XB_SPIN(cond, bar) do { unsigned _sp = 0; while (cond) { __builtin_amdgcn_s_sleep(1); \
    if ((++_sp & 255u) == 0u) { if (xb_ld(&(bar)[XB_TMO])) break; if (_sp > XB_SPIN_CAP) { atomicAdd(&(bar)[XB_TMO], 1u); break; } } } } while (0)

struct XcdBarrier {
    unsigned* bar; unsigned x; int wv;
    volatile LAS unsigned* st;
};

__device__ __forceinline__ XcdBarrier xcd_barrier_post(unsigned* bar, volatile LAS unsigned* st) {
    XcdBarrier b; b.bar = bar; b.x = xb_xcc_id(); b.st = st;
    if (threadIdx.x == 0) (void)xb_add(&bar[XB_XCNT(b.x)], 1u);
    return b;
}
__device__ __forceinline__ void xcd_barrier_complete(unsigned* bar, unsigned x, unsigned& nloc, unsigned& nx) {
    const unsigned G = gridDim.x * gridDim.y * gridDim.z;
    unsigned sum, cnt, mine, sp = 0u;
    for (;;) {
        sum = 0u; cnt = 0u; mine = 0u;
#pragma unroll
        for (unsigned j = 0; j < 16; ++j) { const unsigned c = xb_ld(&bar[XB_XCNT(j)]); sum += c; cnt += (c > 0u) ? 1u : 0u; mine = (j == x) ? c : mine; }
        if (sum == G) break;
        __builtin_amdgcn_s_sleep(1);
        if ((++sp & 255u) == 0u) { if (xb_ld(&bar[XB_TMO])) break; if (sp > XB_SPIN_CAP) { atomicAdd(&bar[XB_TMO], 1u); break; } }
    }
    nloc = mine > 0u ? mine : 1u; nx = cnt > 0u ? cnt : 1u;
}

__device__ __forceinline__ void xcd_barrier(const XcdBarrier& b) {
    asm volatile("s_waitcnt vmcnt(0)" ::: "memory");
    __syncthreads();
    if (b.wv == 0 && (int)__builtin_amdgcn_mbcnt_hi(~0u, __builtin_amdgcn_mbcnt_lo(~0u, 0u)) == 0) {
        unsigned* bar = b.bar;
        __builtin_amdgcn_s_waitcnt(0);
        unsigned nloc = b.st[0], nx = b.st[1];
        if (nloc == 0u) { xcd_barrier_complete(bar, b.x, nloc, nx); b.st[0] = nloc; b.st[1] = nx; }
        const unsigned old = xb_add(&bar[XB_XSUB(b.x)], 1u);
        const unsigned gen = old / nloc;
        if (old + 1u == (gen + 1u) * nloc) {
            __builtin_amdgcn_fence(__ATOMIC_RELEASE, "agent");
            asm volatile("s_waitcnt vmcnt(0)" ::: "memory");
            const unsigned og = xb_add(&bar[XB_TOP], 1u);
            const unsigned tg = og / nx;
            if (og + 1u == (tg + 1u) * nx) xb_add(&bar[XB_TOPGEN], 1u);
            else XB_SPIN(xb_ld(&bar[XB_TOPGEN]) == tg, bar);
            __builtin_amdgcn_fence(__ATOMIC_ACQUIRE, "agent");
            xb_add(&bar[XB_XGEN(b.x)], 1u);
            asm volatile("s_waitcnt vmcnt(0)" ::: "memory");
        } else {
            XB_SPIN(xb_ld(&bar[XB_XGEN(b.x)]) == gen, bar);
            __builtin_amdgcn_fence(__ATOMIC_ACQUIRE, "agent");
            asm volatile("s_waitcnt vmcnt(0)" ::: "memory");
        }
    }
    __syncthreads();
}


__device__ __forceinline__ float bflo(unsigned u) { return __builtin_bit_cast(float, u << 16); }
__device__ __forceinline__ float bfhi(unsigned u) { return __builtin_bit_cast(float, u & 0xffff0000u); }
__device__ __forceinline__ unsigned pkbf(float lo, float hi) { return pg8::cvt_pk_bf16(lo, hi); }
__device__ __forceinline__ float wave_sum(float v) {
#pragma unroll
    for (int o = 1; o < 64; o <<= 1) v += __shfl_xor(v, o);
    return v;
}
__device__ __forceinline__ float wave_max(float v) {
#pragma unroll
    for (int o = 1; o < 64; o <<= 1) v = fmaxf(v, __shfl_xor(v, o));
    return v;
}

struct Args { const float* in[20]; float* out; unsigned char* ws; int ph_lo, ph_hi, li, pad; };
enum { I_X = 0, I_MEM, I_MEMNW, I_WMKV, I_MEMKNW, I_NORM1, I_DNWIN, I_DNCONV, I_DNALOG, I_DNDT, I_DNONW, I_FOXWIN, I_FOXFB, I_FOXQNW, I_FOXKNW, I_MEMQNW, I_WOUT, I_NORM2, I_WM1, I_WM2 };

struct Frame {
    LAS unsigned char* lds;
    int G, bid, wv;
    const float* const* in; float* out; unsigned char* ws;
};


struct Tix { int tid, lane, wave; };
__device__ __forceinline__ int lane_id() { int x = (int)__builtin_amdgcn_mbcnt_hi(~0u, __builtin_amdgcn_mbcnt_lo(~0u, 0u)); asm volatile("" : "+v"(x)); return x; }
__device__ __forceinline__ Tix tix(int wv) { Tix t; t.lane = lane_id(); t.wave = wv; t.tid = wv * 64 + t.lane; return t; }
struct TSeg { const float* W; int K, ldw, src0, ncols; bf16* WT; int dst0; const float* scale; };
__device__ __forceinline__ TSeg get_seg(const Frame& F, int s) {
    TSeg t; t.scale = nullptr; t.src0 = 0; t.dst0 = 0;
    if (s < 12) {
        const int l = s / 6, j = s % 6;
        t.W = l ? F.in[I_FOXWIN] : F.in[I_DNWIN]; t.K = DM; t.ldw = l ? FOX_IN : DN_IN; t.WT = (bf16*)(F.ws + (l ? WS_WIN1 : WS_WIN0)); t.scale = F.in[I_NORM1] + l * DM;
        const int qm0 = l ? 4104 : 4112, nsc = l ? 8 : 16;
        t.ncols = 1024;
        if (j == 0) { t.src0 = 1024; t.dst0 = PC_K; } else if (j == 1) { t.src0 = 2048; t.dst0 = PC_V; } else if (j == 2) { t.src0 = 3072; t.dst0 = PC_Z; }
        else if (j == 3) { t.src0 = 0; t.dst0 = PC_Q; } else if (j == 4) { t.src0 = qm0; t.dst0 = PC_QM; t.ncols = 512; } else { t.src0 = 4096; t.dst0 = PC_AB; t.ncols = nsc; }
    } else if (s < 14) { const int l = s - 12; t.W = F.in[I_WOUT] + (size_t)l * OUT_IN * DM; t.K = OUT_IN; t.ldw = DM; t.ncols = DM; t.WT = (bf16*)(F.ws + (l ? WS_WOUT1 : WS_WOUT0)); }
    else if (s < 16) { const int l = s - 14; t.W = F.in[I_WM1] + (size_t)l * DM * FF; t.K = DM; t.ldw = FF; t.ncols = FF; t.WT = (bf16*)(F.ws + (l ? WS_WM1_1 : WS_WM1_0)); t.scale = F.in[I_NORM2] + l * DM; }
    else if (s < 18) { const int l = s - 16; t.W = F.in[I_WM2] + (size_t)l * FF * DM; t.K = FF; t.ldw = DM; t.ncols = DM; t.WT = (bf16*)(F.ws + (l ? WS_WM2_1 : WS_WM2_0)); }
    else { t.W = F.in[I_WMKV]; t.K = DM; t.ldw = DM; t.ncols = DM; t.WT = (bf16*)(F.ws + WS_WMKV); t.scale = F.in[I_MEMNW]; }
    return t;
}
__device__ __forceinline__ int seg_items(const TSeg& t) { return (t.K / 64) * ((t.ncols + 31) / 32); }
__device__ __forceinline__ void transpose_item(const TSeg& t, LAS float* scr, int item, int lane) {
    const int nblk = (t.ncols + 31) / 32, kb = item / nblk, nb = item % nblk, k0 = 64 * kb, n0 = 32 * nb;
    const int nl = lane & 31; const bool ok = (n0 + nl) < t.ncols;
#pragma unroll 8
    for (int i = 0; i < 32; ++i) { const int kk = 2 * i + (lane >> 5);
        float w = ok ? t.W[(size_t)(k0 + kk) * t.ldw + t.src0 + n0 + nl] : 0.f;
        if (t.scale) w *= t.scale[k0 + kk];
        scr[kk * 33 + nl] = w; }
    LDS_WAIT(); asm volatile("" ::: "memory");
    const int c = lane & 7;
#pragma unroll
    for (int j = 0; j < 4; ++j) { const int n = (lane >> 3) + 8 * j; const LAS float* s = scr + (8 * c) * 33 + n;
        v4u o; o.x = pkbf(s[0 * 33], s[1 * 33]); o.y = pkbf(s[2 * 33], s[3 * 33]); o.z = pkbf(s[4 * 33], s[5 * 33]); o.w = pkbf(s[6 * 33], s[7 * 33]);
        if (n0 + n < t.ncols) *(v4u*)(t.WT + (size_t)(t.dst0 + n0 + n) * t.K + k0 + 8 * c) = o; }
    LDS_WAIT(); asm volatile("" ::: "memory");
}
__device__ __forceinline__ void row_to_bf16(int lane, const float* xrow, bf16* orow, float* sq) {
    const f32x4* xr = (const f32x4*)xrow + lane;
    f32x4 v[4]; float s = 0.f;
#pragma unroll
    for (int j = 0; j < 4; ++j) { v[j] = xr[64 * j]; s += (v[j].x * v[j].x + v[j].y * v[j].y) + (v[j].z * v[j].z + v[j].w * v[j].w); }
    s = wave_sum(s);
    unsigned long long* o8 = (unsigned long long*)orow + lane;
#pragma unroll
    for (int j = 0; j < 4; ++j) o8[64 * j] = (unsigned long long)pkbf(v[j].x, v[j].y) | ((unsigned long long)pkbf(v[j].z, v[j].w) << 32);
    if (lane < 16) sq[lane] = lane == 0 ? s : 0.f;
}
__device__ __forceinline__ void p0_prologue(const Frame& F) {
    const Tix T = tix(F.wv);
    LAS float* scr = (LAS float*)(F.lds + T.wave * 16384);
    const int gw = F.bid * NWAVES + T.wave, NGW = F.G * NWAVES;
    for (int m = gw; m < MROWS; m += NGW) row_to_bf16(T.lane, F.in[I_X] + (size_t)m * DM, (bf16*)(F.ws + WS_XB) + (size_t)m * DM, (float*)(F.ws + WS_XSQ) + (size_t)m * 16);
    for (int m = gw; m < MMEM; m += NGW) row_to_bf16(T.lane, F.in[I_MEM] + (size_t)m * DM, (bf16*)((unsigned char*)F.out + DO_MEMB) + (size_t)m * DM, (float*)(F.ws + WS_MSQ) + (size_t)m * 16);
    int base = 0;
#pragma unroll
    for (int s = 0; s < 19; ++s) {
        const TSeg t = get_seg(F, s); const int n = seg_items(t);
        int it = gw - (base % NGW); if (it < 0) it += NGW;
        for (; it < n; it += NGW) transpose_item(t, scr, it, T.lane);
        base += n;
    }
}

__device__ __forceinline__ void dn_naive_unit(const Frame& F, int bh) {
    const Tix T = tix(F.wv); const int b = bh >> 3, h = bh & 7, tid = T.tid, lane = T.lane, wave = T.wave;
    LAS bf16* raw = (LAS bf16*)F.lds;
    LAS float* ob = (LAS float*)F.lds;
    LAS float* qh = (LAS float*)(F.lds + 51712); LAS float* kh = qh + 8192; LAS float* vv = kh + 8192;
    LAS float* part = vv + 8192; LAS float* part2 = part + 512; LAS float* egb = part2 + 512;
    bf16* proj = (bf16*)(F.ws + WS_PROJ); const float* AB = (const float*)(F.ws + WS_AB);
    const float* convw = F.in[I_DNCONV]; const float a_exp = __expf(F.in[I_DNALOG][h]), dtb = F.in[I_DNDT][h]; const float* onw = F.in[I_DNONW];
    float S[32];
#pragma unroll
    for (int k = 0; k < 32; ++k) S[k] = 0.f;
    const int v = tid & 127, kq = tid >> 7;
    for (int blk = 0; blk < SEQ / 64; ++blk) {
        const size_t row0 = (size_t)b * SEQ + blk * 64;
        for (int i = tid; i < 576; i += 512) { const unsigned val = blk ? ((LAS unsigned*)raw)[64 * 192 + i] : 0u; ((LAS unsigned*)raw)[i] = val; }
        __syncthreads();
        for (int id = tid; id < 64 * 48; id += 512) { const int r = id / 48, rem = id % 48, seg = rem >> 4, ch = rem & 15;
            const int col = (seg == 0 ? PC_Q : seg == 1 ? PC_K : PC_V) + h * HD + ch * 8;
            const v4u val = *(const v4u*)(proj + (row0 + r) * PW + col);
            *(LAS v4u*)(raw + (3 + r) * 384 + seg * 128 + ch * 8) = val; }
        __syncthreads();
        float cw0 = 0, cw1 = 0, cw2 = 0, cw3 = 0, x0 = 0, x1 = 0, x2 = 0;
        if (tid < 384) { const int seg = tid >> 7, d = tid & 127, gch = seg * 1024 + h * HD + d;
            cw0 = convw[gch]; cw1 = convw[3072 + gch]; cw2 = convw[2 * 3072 + gch]; cw3 = convw[3 * 3072 + gch];
            x0 = bflo((unsigned)raw[0 * 384 + tid]); x1 = bflo((unsigned)raw[1 * 384 + tid]); x2 = bflo((unsigned)raw[2 * 384 + tid]); }
        if (tid < 384) { const int seg = tid >> 7, d = tid & 127; LAS float* dst = seg == 0 ? qh : seg == 1 ? kh : vv;
#pragma unroll 8
            for (int i = 0; i < 64; ++i) { const float x3 = bflo((unsigned)raw[(3 + i) * 384 + tid]);
                const float y = cw0 * x0 + cw1 * x1 + cw2 * x2 + cw3 * x3; dst[i * 128 + d] = y / (1.f + __expf(-y)); x0 = x1; x1 = x2; x2 = x3; } }
        __syncthreads();
        for (int j = 0; j < 8; ++j) { const int i = wave * 8 + j;
            const float q0 = qh[i * 128 + 2 * lane], q1 = qh[i * 128 + 2 * lane + 1], k0 = kh[i * 128 + 2 * lane], k1 = kh[i * 128 + 2 * lane + 1];
            const float sq = wave_sum(q0 * q0 + q1 * q1), sk = wave_sum(k0 * k0 + k1 * k1);
            const float rq = rsqrtf(sq + EPS) * QSCALE, rk = rsqrtf(sk + EPS);
            qh[i * 128 + 2 * lane] = q0 * rq; qh[i * 128 + 2 * lane + 1] = q1 * rq; kh[i * 128 + 2 * lane] = k0 * rk; kh[i * 128 + 2 * lane + 1] = k1 * rk;
            if (lane == 0) { const float a = AB[(row0 + i) * 16 + h], bb = AB[(row0 + i) * 16 + 8 + h];
                const float x = a + dtb, sp = fmaxf(x, 0.f) + log1pf(__expf(-fabsf(x)));
                egb[i] = __expf(-a_exp * sp); egb[64 + i] = 1.f / (1.f + __expf(-bb)); } }
        __syncthreads();
        for (int i = 0; i < 64; ++i) {
            const LAS float* kr = kh + i * 128 + kq * 32; const LAS float* qr = qh + i * 128 + kq * 32;
            float ks = 0.f;
#pragma unroll
            for (int k = 0; k < 32; ++k) ks += kr[k] * S[k];
            part[kq * 128 + v] = ks;
            __syncthreads();
            const float kS = (part[v] + part[128 + v]) + (part[256 + v] + part[384 + v]);
            const float eg = egb[i], be = egb[64 + i];
            const float dv = be * (vv[i * 128 + v] - eg * kS);
            float po = 0.f;
#pragma unroll
            for (int k = 0; k < 32; ++k) { S[k] = eg * S[k] + kr[k] * dv; po += S[k] * qr[k]; }
            part2[kq * 128 + v] = po;
            __syncthreads();
            if (kq == 0) ob[i * 128 + v] = (part2[v] + part2[128 + v]) + (part2[256 + v] + part2[384 + v]);
        }
        __syncthreads();
        for (int j = 0; j < 8; ++j) { const int i = wave * 8 + j;
            const float o0 = ob[i * 128 + 2 * lane], o1 = ob[i * 128 + 2 * lane + 1];
            const float rn = rsqrtf(wave_sum(o0 * o0 + o1 * o1) * (1.f / 128.f) + EPS);
            const unsigned zz = *(const unsigned*)(proj + (row0 + i) * PW + PC_Z + h * HD + 2 * lane);
            const float z0 = bflo(zz), z1 = bfhi(zz);
            const float r0 = o0 * rn * onw[2 * lane] * (z0 / (1.f + __expf(-z0))), r1 = o1 * rn * onw[2 * lane + 1] * (z1 / (1.f + __expf(-z1)));
            *(unsigned*)(proj + (row0 + i) * PW + PC_Q + h * HD + 2 * lane) = pkbf(r0, r1); }
        __syncthreads();
    }
}

__device__ __forceinline__ void norm_heads(int lane, bf16* rowp, int nheads, const float* ssq, size_t hb_stride, const float* w) {
    if (lane < 8 * nheads) { const int head = lane >> 3, d0 = (lane & 7) * 16;
        const f32x4 s4 = *(const f32x4*)(ssq + (size_t)head * hb_stride);
        const float r = rsqrtf(((s4[0] + s4[1]) + (s4[2] + s4[3])) * (1.f / 128.f) + EPS);
        bf16* p = rowp + head * HD + d0;
        const v4u a = *(const v4u*)p, b = *(const v4u*)(p + 8);
        const f32x4 w0 = *(const f32x4*)(w + d0), w1 = *(const f32x4*)(w + d0 + 4), w2 = *(const f32x4*)(w + d0 + 8), w3 = *(const f32x4*)(w + d0 + 12);
        v4u oa, ob;
        oa.x = pkbf(bflo(a.x) * r * w0[0], bfhi(a.x) * r * w0[1]); oa.y = pkbf(bflo(a.y) * r * w0[2], bfhi(a.y) * r * w0[3]);
        oa.z = pkbf(bflo(a.z) * r * w1[0], bfhi(a.z) * r * w1[1]); oa.w = pkbf(bflo(a.w) * r * w1[2], bfhi(a.w) * r * w1[3]);
        ob.x = pkbf(bflo(b.x) * r * w2[0], bfhi(b.x) * r * w2[1]); ob.y = pkbf(bflo(b.y) * r * w2[2], bfhi(b.y) * r * w2[3]);
        ob.z = pkbf(bflo(b.z) * r * w3[0], bfhi(b.z) * r * w3[1]); ob.w = pkbf(bflo(b.w) * r * w3[2], bfhi(b.w) * r * w3[3]);
        *(v4u*)p = oa; *(v4u*)(p + 8) = ob; }
}
__device__ __forceinline__ void norm_pass(const Frame& F, int layer) {
    const Tix T = tix(F.wv); const int gw = F.bid * NWAVES + T.wave, NGW = F.G * NWAVES;
    bf16* proj = (bf16*)(F.ws + WS_PROJ); const float* ssq = (const float*)(F.ws + WS_SSQ); const size_t hbs = (size_t)MROWS * 4;
    for (int m = gw; m < MROWS; m += NGW) {
        if (layer == 1) { norm_heads(T.lane, proj + (size_t)m * PW + PC_K, 8, ssq + (size_t)m * 4, hbs, F.in[I_FOXKNW]);
                          norm_heads(T.lane, proj + (size_t)m * PW + PC_Q, 8, ssq + 24 * hbs + (size_t)m * 4, hbs, F.in[I_FOXQNW]); }
        norm_heads(T.lane, proj + (size_t)m * PW + PC_QM, 4, ssq + 32 * hbs + (size_t)m * 4, hbs, F.in[I_MEMQNW] + layer * HD);
    }
    if (layer == 0) for (int m = gw; m < MMEM; m += NGW)
        norm_heads(T.lane, (bf16*)(F.ws + WS_MEMKV) + (size_t)m * DM, 4, (const float*)(F.ws + WS_MSSQ) + (size_t)m * 4, (size_t)MMEM * 4, F.in[I_MEMKNW]);
}
__device__ __forceinline__ void fox_blk(const Frame& F, int it, int j, att::Blk& k) {
    const int bh = it >> 2, y = it & 3, qb = j == 0 ? y : 7 - y, b = bh >> 3, h = bh & 7; const size_t row0 = (size_t)b * SEQ + qb * 256;
    bf16* proj = (bf16*)(F.ws + WS_PROJ);
    k.Q = proj + row0 * PW + PC_Q + h * HD; k.K = proj + (size_t)b * SEQ * PW + PC_K + h * HD; k.voff = PC_V - PC_K; k.goff = PC_Z - PC_Q;
    k.fcum = (const float*)(F.ws + WS_FCUM) + (size_t)bh * SEQ; k.P0 = qb * 256; k.skv = SEQ; k.kvpitch = PW;
}
__device__ __forceinline__ void mem_blk(const Frame& F, int idx, att::Blk& k) {
    const int b = idx >> 5, hm = (idx >> 3) & 3, qb = idx & 7; const size_t row0 = (size_t)b * SEQ + qb * 256;
    bf16* proj = (bf16*)(F.ws + WS_PROJ); const bf16* mkv = (const bf16*)(F.ws + WS_MEMKV);
    static_assert(att::QP == PW, "attention Q pitch");
    k.Q = proj + row0 * PW + PC_QM + hm * HD; k.K = mkv + (size_t)b * NMEM * DM + hm * HD; k.voff = 512; k.goff = 0;
    k.fcum = nullptr; k.P0 = 1 << 20; k.skv = NMEM; k.kvpitch = DM;
}
struct SrcL1 { const Frame* F; int vcu;
    __device__ __forceinline__ bool operator()(int n, att::Blk& k) const { const int it = vcu + (n / 3) * F->G, j = n % 3; if (it >= 256) return false;
        if (j < 2) fox_blk(*F, it, j, k); else mem_blk(*F, it, k); return true; } };
struct SrcL0 { const Frame* F; int first, stride;
    __device__ __forceinline__ bool operator()(int n, att::Blk& k) const { const int idx = first + n * stride; if (idx >= 256) return false; mem_blk(*F, idx, k); return true; } };
__device__ __forceinline__ void fcum_unit(const Frame& F, int bh) {
    const Tix T = tix(F.wv); const int b = bh >> 3, h = bh & 7, tid = T.tid, lane = T.lane, wave = T.wave;
    const float* AB = (const float*)(F.ws + WS_AB); const float fb = F.in[I_FOXFB][h];
    LAS float* wt = (LAS float*)F.lds;
    float f[4];
#pragma unroll
    for (int e = 0; e < 4; ++e) { const float x = AB[((size_t)b * SEQ + tid * 4 + e) * 16 + h] + fb; f[e] = fminf(x, 0.f) - log1pf(__expf(-fabsf(x))); }
    f[1] += f[0]; f[2] += f[1]; f[3] += f[2];
    float sc = f[3];
#pragma unroll
    for (int o = 1; o < 64; o <<= 1) { const float t = __shfl_up(sc, o); if (lane >= o) sc += t; }
    __syncthreads();
    if (lane == 63) wt[wave] = sc;
    __syncthreads();
    float off = sc - f[3];
    for (int w = 0; w < wave; ++w) off += wt[w];
    float* out = (float*)(F.ws + WS_FCUM) + (size_t)bh * SEQ + tid * 4;
    *(f32x4*)out = (f32x4){f[0] + off, f[1] + off, f[2] + off, f[3] + off};
    __syncthreads();
}

#define IN(k) (lo <= (k) && (k) < hi)
#define SEAM(k) do { if (IN(k) && IN((k) + 1)) xcd_barrier(bar); } while (0)
template <int layer> __device__ __forceinline__ void layer_body(const Frame& F, const XcdBarrier& bar, int lo, int hi, unsigned char* lds) {
    bf16* proj = (bf16*)(F.ws + WS_PROJ); bf16* xb = (bf16*)(F.ws + WS_XB); float* xsq = (float*)(F.ws + WS_XSQ);
    float* ssq = (float*)(F.ws + WS_SSQ); float* ab = (float*)(F.ws + WS_AB);

        const int pb = 1 + (layer ? 6 : 0);
        if (IN(pb)) {
            pg8::Gemm g{xb, (const bf16*)(F.ws + (layer ? WS_WIN1 : WS_WIN0)), MROWS, N_IN, DM, DM}; pg8::StaticOrder S; S.init(MROWS, N_IN, F.G, F.bid);
            pg8::EpiProj<true, false> E{proj, PW, xsq, ssq, MROWS, ab, 18};
            pg8::gemm_phase<pg8::EpiProj<true, false>, pg8::StaticOrder, true, true>(F.lds, g, S, E, F.wv);
            if (layer == 0) {
                pg8::Gemm g2{(const bf16*)((unsigned char*)F.out + DO_MEMB), (const bf16*)(F.ws + WS_WMKV), MMEM, DM, DM, DM}; pg8::StaticOrder S2; S2.init(MMEM, DM, F.G, F.G - 1 - F.bid);
                pg8::EpiProj<true, false> E2{(bf16*)(F.ws + WS_MEMKV), DM, (const float*)(F.ws + WS_MSQ), (float*)(F.ws + WS_MSSQ), MMEM, nullptr, 4};
                pg8::gemm_phase<pg8::EpiProj<true, false>, pg8::StaticOrder, true, true>(F.lds, g2, S2, E2, F.wv);
            }
        }
        SEAM(pb);
        const int pm = pb + 2;
        if (IN(pb + 1)) { if (layer == 1) for (int bh = F.bid; bh < 64; bh += F.G) fcum_unit(F, bh);
                          norm_pass(F, layer); }
        SEAM(pb + 1);
        if (IN(pm)) {
            if (layer == 0) {
                if (F.G > 64) { if (F.bid < 64) dn_naive_unit(F, F.bid); else { const SrcL0 src{&F, F.bid - 64, F.G - 64}; att::phase((char*)lds, src, F.wv); } }
                else { for (int bh = F.bid; bh < 64; bh += F.G) dn_naive_unit(F, bh); const SrcL0 src{&F, F.bid, F.G}; att::phase((char*)lds, src, F.wv); }
            } else {
                const int vcu = (F.G % 8 == 0) ? (F.bid % 8) * (F.G / 8) + F.bid / 8 : F.bid;
                const SrcL1 src{&F, vcu}; att::phase((char*)lds, src, F.wv);
            }
            __syncthreads();
        }
        SEAM(pm);
        if (IN(pm + 1)) {
            pg8::Gemm g{proj + PC_Q, (const bf16*)(F.ws + (layer ? WS_WOUT1 : WS_WOUT0)), MROWS, DM, OUT_IN, PW}; pg8::StaticOrder S; S.init(MROWS, DM, F.G, F.bid);
            pg8::EpiRes E{layer ? (const float*)F.out : F.in[I_X], F.out, xb, xsq};
            pg8::gemm_phase<pg8::EpiRes, pg8::StaticOrder, true, true>(F.lds, g, S, E, F.wv);
        }
        SEAM(pm + 1);
        if (IN(pm + 2)) {
            pg8::Gemm g{xb, (const bf16*)(F.ws + (layer ? WS_WM1_1 : WS_WM1_0)), MROWS, FF, DM, DM}; pg8::StaticOrder S; S.init(MROWS, FF, F.G, F.bid);
            pg8::EpiProj<false, true> E{proj, FF, xsq, nullptr, 0, nullptr, 16};
            pg8::gemm_phase<pg8::EpiProj<false, true>, pg8::StaticOrder, true, true>(F.lds, g, S, E, F.wv);
        }
        SEAM(pm + 2);
        if (IN(pm + 3)) {
            pg8::Gemm g{proj, (const bf16*)(F.ws + (layer ? WS_WM2_1 : WS_WM2_0)), MROWS, DM, FF, FF}; pg8::StaticOrder S; S.init(MROWS, DM, F.G, F.bid);
            pg8::EpiRes E{(const float*)F.out, F.out, xb, xsq};
            pg8::gemm_phase<pg8::EpiRes, pg8::StaticOrder, true, true>(F.lds, g, S, E, F.wv);
        }
        SEAM(pm + 3);
    }
#undef IN
#undef SEAM
__global__ void __launch_bounds__(NWAVES * 64, 2) hyb_fwd(Args args) {
    extern __shared__ __attribute__((aligned(16))) unsigned char lds[];
    Frame F;
    F.lds = (LAS unsigned char*)lds;
    F.G = gridDim.x; F.bid = blockIdx.x; F.in = args.in; F.out = args.out; F.ws = args.ws; F.wv = __builtin_amdgcn_readfirstlane((int)threadIdx.x >> 6);
    volatile LAS unsigned* MISC = (volatile LAS unsigned*)(F.lds + MISC_OFF);
    gu32* ctl = (gu32*)(args.ws + WS_CTL);
    for (int u = threadIdx.x; u < (LDS_BYTES - MISC_OFF) / 4; u += NWAVES * 64) ((LAS unsigned*)(F.lds + MISC_OFF))[u] = 0u;
    __syncthreads();
    XcdBarrier bar; bar.bar = (unsigned*)(ctl + CW_BAR) + args.li * XCD_BAR_WORDS; bar.x = 0; bar.st = nullptr; bar.wv = F.wv;
    if (!MK_LAUNCH_PER_PHASE) { bar = xcd_barrier_post((unsigned*)(ctl + CW_BAR) + args.li * XCD_BAR_WORDS, MISC + 8); bar.wv = F.wv; }
    const int lo = args.ph_lo, hi = args.ph_hi;
#define IN(k) (lo <= (k) && (k) < hi)
#define SEAM(k) do { if (IN(k) && IN((k) + 1)) xcd_barrier(bar); } while (0)
    bf16* proj = (bf16*)(F.ws + WS_PROJ); bf16* xb = (bf16*)(F.ws + WS_XB); float* xsq = (float*)(F.ws + WS_XSQ);
    float* ssq = (float*)(F.ws + WS_SSQ); float* ab = (float*)(F.ws + WS_AB);

    if (IN(0)) { p0_prologue(F); } SEAM(0);

    layer_body<0>(F, bar, lo, hi, lds);
    layer_body<1>(F, bar, lo, hi, lds);
#undef IN
#undef SEAM
}

extern "C" void kernel_launch(void* const* d_in, const int* in_sizes, int n_in, void* d_out, int out_size, void* d_ws, size_t ws_size, hipStream_t stream) {
    static int grid = 0;
    if (grid == 0) {
        if (n_in != 20 || in_sizes[0] != MROWS * DM || out_size != MROWS * DM || ws_size < WS_END) {
            fprintf(stderr, "kernel_launch: shape/workspace mismatch (n_in %d, in0 %d, out %d, ws %zu; need ws >= %zu); nothing launched\n", n_in, n_in > 0 ? in_sizes[0] : -1, out_size, ws_size, (size_t)WS_END); grid = -1; return; }
        int dev = 0, cus = 0, per_cu = 0;
        if (hipGetDevice(&dev) != hipSuccess || hipDeviceGetAttribute(&cus, hipDeviceAttributeMultiprocessorCount, dev) != hipSuccess) { fprintf(stderr, "kernel_launch: device query failed\n"); grid = -1; return; }
        if (hipFuncSetAttribute((const void*)hyb_fwd, hipFuncAttributeMaxDynamicSharedMemorySize, LDS_BYTES) != hipSuccess) { fprintf(stderr, "kernel_launch: hipFuncSetAttribute failed\n"); grid = -1; return; }
        if (hipOccupancyMaxActiveBlocksPerMultiprocessor(&per_cu, (const void*)hyb_fwd, NWAVES * 64, LDS_BYTES) != hipSuccess || per_cu < 1) {
            fprintf(stderr, "kernel_launch: occupancy query reports %d workgroups per CU; nothing launched\n", per_cu); (void)hipGetLastError(); grid = -1; return; }
        grid = cus;
    }
    if (grid < 0) return;
    if (hipMemsetAsync((char*)d_ws + WS_CTL, 0, CTL_ZERO_BYTES, stream) != hipSuccess) { fprintf(stderr, "kernel_launch: memset failed\n"); return; }
    Args a{};
    for (int i = 0; i < 20; ++i) a.in[i] = (const float*)d_in[i];
    a.out = (float*)d_out; a.ws = (unsigned char*)d_ws;
#if MK_LAUNCH_PER_PHASE
    for (int p = 0; p < N_PHASES; ++p) { a.ph_lo = p; a.ph_hi = p + 1; a.li = 0; hipLaunchKernelGGL(hyb_fwd, dim3(grid), dim3(NWAVES * 64), LDS_BYTES, stream, a); }
#else
    a.ph_lo = 0; a.ph_hi = N_PHASES; a.li = 0;
    hipLaunchKernelGGL(hyb_fwd, dim3(grid), dim3(NWAVES * 64), LDS_BYTES, stream, a);
#endif
    const hipError_t le = hipPeekAtLastError();
    if (le != hipSuccess) fprintf(stderr, "kernel_launch: launch failed: %s\n", hipGetErrorName(le));
}
```

```cpp
#include <hip/hip_runtime.h>
#include <cstdio>
#include <cstdint>

constexpr int BATCH = 8, SEQ = 2048, DM = 1024, MROWS = BATCH * SEQ;
constexpr int NMEM = 256, MMEM = BATCH * NMEM;
constexpr int HD = 128, NH = 8, NMH = 4, FF = 4096;
constexpr int PW = 4608;
constexpr int PC_K = 0, PC_V = 1024, PC_Z = 2048, PC_Q = 3072, PC_QM = 4096, PC_AB = 4608;
constexpr int N_IN = 4864;
constexpr int DN_IN = 4624, FOX_IN = 4616, OUT_IN = 1536;
constexpr float EPS = 1e-6f;
constexpr float QSCALE = 0.08838834764831845f;

namespace pg8 {
#define PG8_LAS __attribute__((address_space(3)))
typedef unsigned short bf16_t;
typedef short bf16x8 __attribute__((ext_vector_type(8)));
typedef float f32x4 __attribute__((ext_vector_type(4)));
typedef unsigned u32x4 __attribute__((ext_vector_type(4)));
constexpr int BM = 256, BK = 64, HALF = 128, HTB = HALF * BK * 2  , STAGE_BYTES = 8 * HTB, NXCD = 8, WGM = 8;

__host__ __device__ __forceinline__ int lds_byte(int r, int c) { const int st = (r >> 4) * 2 + (c >> 5), rr = r & 15, cc = c & 31, ob = rr * 64 + cc * 2; return st * 1024 + (ob ^ (((ob >> 9) & 1) << 5)); }
__host__ __device__ __forceinline__ void stage_rc(int b, int& R, int& C) { const int st = b / 1024, sb = b % 1024, swz = sb ^ (((sb >> 9) & 1) << 5); R = (st >> 1) * 16 + swz / 64; C = (st & 1) * 32 + (swz % 64) / 2; }
__host__ __device__ __forceinline__ int perm32(int rho) { const int n = rho >> 4, i = rho & 15; return 8 * (i >> 2) + 4 * n + (i & 3); }

struct Unit { int pm, pn; };
struct Gemm { const bf16_t* A; const bf16_t* Bt; int M, N, K, lda; };

struct StaticOrder {
    int nM, nN, nwg, G, c;
    __host__ __device__ void init(int M, int N, int G_, int c_) { nM = M / BM; nN = N / BM; nwg = nM * nN; G = G_; c = c_; }
    __host__ __device__ bool next(int i, Unit& u) const {
        const long L = (long)i * G + c; if (L >= nwg) return false;
        int wgid = (int)L; { const int q = nwg / NXCD, r = nwg % NXCD, xcd = wgid % NXCD, off = wgid / NXCD; wgid = (xcd < r ? xcd * (q + 1) : r * (q + 1) + (xcd - r) * q) + off; }
        const int nig = WGM * nN, gid = wgid / nig, fm = gid * WGM, gsz = (nM - fm) < WGM ? (nM - fm) : WGM;
        u.pm = fm + ((wgid % nig) % gsz); u.pn = (wgid % nig) / gsz; return true;
    }
    __device__ __forceinline__ void a_ready(const Unit&) const {}
    __device__ __forceinline__ void done(const Unit&) const {}
};


__device__ __forceinline__ unsigned cvt_pk_bf16(float lo, float hi) { unsigned r; asm volatile("v_cvt_pk_bf16_f32 %0, %1, %2" : "=v"(r) : "v"(lo), "v"(hi)); return r; }

template <bool SSQ, bool RELU2, bool HALO = false> struct EpiProj {
    static constexpr bool PERM = true, AFTER_DRAIN = false;
    bf16_t* O; int ldc; const float* xsq; float* ssq; int ssq_rows; float* ab; int n_main; bf16_t* halo;
    __device__ __forceinline__ void operator()(const f32x4 (&acc)[2][2][4][2], const Unit& u, int wr, int wc, int fr, int fq) const {
        const int row0 = u.pm * BM + wr * 64 + fr, colt = u.pn * BM;
        const bool is_ab = u.pn >= n_main;
#pragma unroll
        for (int ai = 0; ai < 2; ++ai)
#pragma unroll
            for (int m = 0; m < 4; ++m) {
                const int r = row0 + ai * HALF + m * 16;
                const f32x4 q4 = *(const f32x4*)(xsq + (size_t)r * 16 + 4 * fq);
                float s = (q4[0] + q4[1]) + (q4[2] + q4[3]);
                s += __shfl_xor(s, 16); s += __shfl_xor(s, 32);
                const float rstd = rsqrtf(s * (1.0f / 1024.0f) + 1e-6f);
                if (!is_ab) {
#pragma unroll
                    for (int bj = 0; bj < 2; ++bj) {
                        f32x4 v0 = acc[ai][bj][m][0] * rstd, v1 = acc[ai][bj][m][1] * rstd;
                        if (SSQ) {
                            float ss = ((v0[0] * v0[0] + v0[1] * v0[1]) + (v0[2] * v0[2] + v0[3] * v0[3])) + ((v1[0] * v1[0] + v1[1] * v1[1]) + (v1[2] * v1[2] + v1[3] * v1[3]));
                            ss += __shfl_xor(ss, 16); ss += __shfl_xor(ss, 32);
                            if (fq == 0) ssq[((size_t)((colt >> 7) + bj) * ssq_rows + r) * 4 + wc] = ss;
                        }
                        if (RELU2) {
#pragma unroll
                            for (int e = 0; e < 4; ++e) { const float a = fmaxf(v0[e], 0.f), b = fmaxf(v1[e], 0.f); v0[e] = a * a; v1[e] = b * b; }
                        }
                        u32x4 w; w.x = cvt_pk_bf16(v0[0], v0[1]); w.y = cvt_pk_bf16(v0[2], v0[3]); w.z = cvt_pk_bf16(v1[0], v1[1]); w.w = cvt_pk_bf16(v1[2], v1[3]);
                        *(u32x4*)(O + (size_t)r * ldc + colt + bj * HALF + wc * 32 + 8 * fq) = w;
                        if (HALO && m == 3 && fr >= 13) *(u32x4*)(halo + ((size_t)(r >> 6) * 3 + ((r & 63) - 61)) * ldc + colt + bj * HALF + wc * 32 + 8 * fq) = w;
                    }
                } else if (ab != nullptr && wc == 0 && fq < 2) {
                    float* p = ab + (size_t)r * 16 + 8 * fq;
                    *(f32x4*)p = acc[ai][0][m][0] * rstd; *(f32x4*)(p + 4) = acc[ai][0][m][1] * rstd;
                }
            }
    }
};
struct EpiRes {
    static constexpr bool PERM = true, AFTER_DRAIN = false;
    const float* xold; float* xnew; bf16_t* xb; float* xsq;
    __device__ __forceinline__ void operator()(const f32x4 (&acc)[2][2][4][2], const Unit& u, int wr, int wc, int fr, int fq) const {
        const int row0 = u.pm * BM + wr * 64 + fr, colt = u.pn * BM;
#pragma unroll
        for (int ai = 0; ai < 2; ++ai)
#pragma unroll
            for (int m = 0; m < 4; ++m) {
                const int r = row0 + ai * HALF + m * 16; float ss = 0.f;
#pragma unroll
                for (int bj = 0; bj < 2; ++bj) {
                    const size_t off = (size_t)r * 1024 + colt + bj * HALF + wc * 32 + 8 * fq;
                    const f32x4 v0 = acc[ai][bj][m][0] + *(const f32x4*)(xold + off), v1 = acc[ai][bj][m][1] + *(const f32x4*)(xold + off + 4);
                    *(f32x4*)(xnew + off) = v0; *(f32x4*)(xnew + off + 4) = v1;
                    ss += ((v0[0] * v0[0] + v0[1] * v0[1]) + (v0[2] * v0[2] + v0[3] * v0[3])) + ((v1[0] * v1[0] + v1[1] * v1[1]) + (v1[2] * v1[2] + v1[3] * v1[3]));
                    u32x4 w; w.x = cvt_pk_bf16(v0[0], v0[1]); w.y = cvt_pk_bf16(v0[2], v0[3]); w.z = cvt_pk_bf16(v1[0], v1[1]); w.w = cvt_pk_bf16(v1[2], v1[3]);
                    *(u32x4*)(xb + off) = w;
                }
                ss += __shfl_xor(ss, 16); ss += __shfl_xor(ss, 32);
                if (fq == 0) xsq[(size_t)r * 16 + u.pn * 4 + wc] = ss;
            }
    }
};

template <class Epi, class Sched, bool ALIGN_EPI = false, bool SP2 = false>
__device__ __forceinline__ void gemm_phase(PG8_LAS unsigned char* lds, const Gemm g, const Sched& S, const Epi& E, int wid) {
    int lane = (int)__builtin_amdgcn_mbcnt_hi(~0u, __builtin_amdgcn_mbcnt_lo(~0u, 0u)); asm volatile("" : "+v"(lane));
    const int tid = wid * 64 + lane, wr = wid >> 2, wc = wid & 3, fr = lane & 15, fq = lane >> 4;
    const int K = g.K, nt = K / BK;
    unsigned voffA[2], voffB[2];
#pragma unroll
    for (int i = 0; i < 2; ++i) { int R, C; stage_rc(tid * 16 + i * 8192, R, C); const int Rb = Epi::PERM ? ((R & ~31) + perm32(R & 31)) : R;
        voffA[i] = (unsigned)(R * g.lda + C) * 2u; voffB[i] = (unsigned)(Rb * K + C) * 2u; }
    const size_t kstep = (size_t)(BK * 2);
    const size_t hstepA = (size_t)HALF * g.lda * 2, hstepB = (size_t)HALF * K * 2;
    const size_t tstepA = 2 * hstepA, tstepB = 2 * hstepB;
    const unsigned ldsw = (unsigned)wid * 1024u;
    const int aoff = lds_byte(wr * 64 + fr, fq * 8), boff = lds_byte(wc * 32 + fr, fq * 8);
#define PG8_SA(b, h) (((b) * 2 + (h)) * HTB)
#define PG8_SB(b, h) ((4 + (b) * 2 + (h)) * HTB)
#define PG8_STAGE(bufoff, gbase, voff) do { _Pragma("unroll") for (int _i = 0; _i < 2; ++_i) \
        __builtin_amdgcn_global_load_lds((const unsigned*)((const char*)(gbase) + (voff)[_i]), (PG8_LAS unsigned*)(lds + (bufoff) + ldsw + _i * 8192), 16, 0, 0); } while (0)
#define PG8_LDA(dst, b, h) do { _Pragma("unroll") for (int m = 0; m < 4; ++m) _Pragma("unroll") for (int k = 0; k < 2; ++k) dst[m][k] = *(const PG8_LAS bf16x8*)(lds + PG8_SA(b, h) + aoff + m * 2048 + k * 1024); } while (0)
#define PG8_LDB(dst, b, h) do { _Pragma("unroll") for (int n = 0; n < 2; ++n) _Pragma("unroll") for (int k = 0; k < 2; ++k) dst[n][k] = *(const PG8_LAS bf16x8*)(lds + PG8_SB(b, h) + boff + n * 2048 + k * 1024); } while (0)
#define PG8_MMA(ai, bj, At, Bt) do { __builtin_amdgcn_s_setprio(1); _Pragma("unroll") for (int m = 0; m < 4; ++m) _Pragma("unroll") for (int n = 0; n < 2; ++n) _Pragma("unroll") for (int k = 0; k < 2; ++k) \
        acc[ai][bj][m][n] = __builtin_amdgcn_mfma_f32_16x16x32_bf16(Bt[n][k], At[m][k], acc[ai][bj][m][n], 0, 0, 0); __builtin_amdgcn_s_setprio(0); } while (0)
#define PG8_WAIT_V(n) asm volatile("s_waitcnt vmcnt(" #n ")" ::: "memory")
#define PG8_WAIT_L(n) asm volatile("s_waitcnt lgkmcnt(" #n ")" ::: "memory")
#define PG8_BAR __builtin_amdgcn_s_barrier()
#define PG8_SCHED __builtin_amdgcn_sched_barrier(0)
    Unit cur, nxt; int ui = 0;
    if (!S.next(0, cur)) return;
    f32x4 acc[2][2][4][2];
#pragma unroll
    for (int a = 0; a < 2; ++a)
#pragma unroll
        for (int b = 0; b < 2; ++b)
#pragma unroll
            for (int m = 0; m < 4; ++m)
#pragma unroll
                for (int n = 0; n < 2; ++n) acc[a][b][m][n] = (f32x4){0.f, 0.f, 0.f, 0.f};
    bf16x8 At[4][2], B0[2][2], B1[2][2];
    const char* cA = (const char*)g.A + (size_t)cur.pm * tstepA; const char* cB = (const char*)g.Bt + (size_t)cur.pn * tstepB;
    S.a_ready(cur);
    if constexpr (SP2) {
        PG8_STAGE(PG8_SB(0, 0), cB, voffB); PG8_STAGE(PG8_SB(0, 1), cB + hstepB, voffB); PG8_STAGE(PG8_SA(0, 0), cA, voffA); PG8_STAGE(PG8_SA(0, 1), cA + hstepA, voffA);
        if (wr == 1) PG8_BAR;
        PG8_WAIT_V(2); PG8_BAR;
        PG8_STAGE(PG8_SB(1, 0), cB + kstep, voffB); PG8_STAGE(PG8_SA(1, 0), cA + kstep, voffA); PG8_STAGE(PG8_SB(1, 1), cB + hstepB + kstep, voffB);
        PG8_WAIT_V(6); PG8_BAR;
    } else {
        PG8_STAGE(PG8_SB(0, 0), cB, voffB); PG8_STAGE(PG8_SA(0, 0), cA, voffA); PG8_STAGE(PG8_SB(0, 1), cB + hstepB, voffB); PG8_STAGE(PG8_SA(0, 1), cA + hstepA, voffA);
        if (wr == 1) PG8_BAR;
        PG8_WAIT_V(4); PG8_BAR;
        PG8_STAGE(PG8_SB(1, 0), cB + kstep, voffB); PG8_STAGE(PG8_SA(1, 0), cA + kstep, voffA); PG8_STAGE(PG8_SB(1, 1), cB + hstepB + kstep, voffB);
        PG8_WAIT_V(6); PG8_BAR;
    }
    for (;;) {
        const bool has_next = S.next(ui + 1, nxt);
        const char* nA = has_next ? (const char*)g.A + (size_t)nxt.pm * tstepA : cA; const char* nB = has_next ? (const char*)g.Bt + (size_t)nxt.pn * tstepB : cB;
        for (int t = 0; t < nt; t += 2) {
            const bool last = (t == nt - 2);
            const char* a1 = cA + (size_t)(t + 1) * kstep;
            const char* a2 = last ? nA : cA + (size_t)(t + 2) * kstep; const char* b2 = last ? nB : cB + (size_t)(t + 2) * kstep;
            const char* a3 = a2 + kstep; const char* b3 = b2 + kstep;
            if (last && has_next) S.a_ready(nxt);
            if constexpr (SP2) {
            PG8_LDB(B0, 0, 0); PG8_LDB(B1, 0, 1); PG8_SCHED; PG8_LDA(At, 0, 0); PG8_STAGE(PG8_SA(1, 1), a1 + hstepA, voffA);
            PG8_WAIT_V(8); PG8_WAIT_L(0); PG8_BAR; PG8_MMA(0, 0, At, B0); PG8_MMA(0, 1, At, B1); PG8_BAR; PG8_SCHED;
            PG8_LDA(At, 0, 1); PG8_STAGE(PG8_SB(0, 0), b2, voffB); PG8_STAGE(PG8_SB(0, 1), b2 + hstepB, voffB); PG8_STAGE(PG8_SA(0, 0), a2, voffA);
            PG8_WAIT_V(8); PG8_WAIT_L(0); PG8_BAR; PG8_MMA(1, 0, At, B0); PG8_MMA(1, 1, At, B1); PG8_BAR; PG8_SCHED;
            PG8_LDB(B0, 1, 0); PG8_LDB(B1, 1, 1); PG8_SCHED; PG8_LDA(At, 1, 0); PG8_STAGE(PG8_SA(0, 1), a2 + hstepA, voffA);
            PG8_WAIT_V(8); PG8_WAIT_L(0); PG8_BAR; PG8_MMA(0, 0, At, B0); PG8_MMA(0, 1, At, B1); PG8_BAR; PG8_SCHED;
            PG8_LDA(At, 1, 1); PG8_STAGE(PG8_SB(1, 0), b3, voffB); PG8_STAGE(PG8_SB(1, 1), b3 + hstepB, voffB); PG8_STAGE(PG8_SA(1, 0), a3, voffA);
            PG8_WAIT_V(8); PG8_WAIT_L(0); PG8_BAR; PG8_MMA(1, 0, At, B0); PG8_MMA(1, 1, At, B1); PG8_BAR; PG8_SCHED;
            } else {
            PG8_LDB(B0, 0, 0); PG8_SCHED; PG8_LDA(At, 0, 0); PG8_STAGE(PG8_SA(1, 1), a1 + hstepA, voffA);
            PG8_WAIT_L(8); PG8_BAR; PG8_WAIT_L(0); PG8_MMA(0, 0, At, B0); PG8_BAR; PG8_SCHED;
            PG8_LDB(B1, 0, 1); PG8_STAGE(PG8_SB(0, 0), b2, voffB);
            PG8_BAR; PG8_WAIT_L(0); PG8_MMA(0, 1, At, B1); PG8_BAR;
            PG8_LDA(At, 0, 1); PG8_STAGE(PG8_SA(0, 0), a2, voffA);
            PG8_BAR; PG8_WAIT_L(0); PG8_MMA(1, 0, At, B0); PG8_BAR; PG8_SCHED;
            PG8_STAGE(PG8_SB(0, 1), b2 + hstepB, voffB);
            PG8_WAIT_V(6); PG8_BAR; PG8_MMA(1, 1, At, B1); PG8_BAR;
            PG8_LDB(B0, 1, 0); PG8_SCHED; PG8_LDA(At, 1, 0); PG8_STAGE(PG8_SA(0, 1), a2 + hstepA, voffA);
            PG8_WAIT_L(8); PG8_BAR; PG8_WAIT_L(0); PG8_MMA(0, 0, At, B0); PG8_BAR; PG8_SCHED;
            PG8_LDB(B1, 1, 1); PG8_STAGE(PG8_SB(1, 0), b3, voffB);
            PG8_BAR; PG8_WAIT_L(0); PG8_MMA(0, 1, At, B1); PG8_BAR;
            PG8_LDA(At, 1, 1); PG8_STAGE(PG8_SA(1, 0), a3, voffA);
            PG8_BAR; PG8_WAIT_L(0); PG8_MMA(1, 0, At, B0); PG8_BAR; PG8_SCHED;
            PG8_STAGE(PG8_SB(1, 1), b3 + hstepB, voffB);
            PG8_WAIT_V(6); PG8_BAR; PG8_MMA(1, 1, At, B1); PG8_BAR;
            }
        }
        if constexpr (ALIGN_EPI) { if (wr == 0) PG8_BAR; }
        if constexpr (!Epi::AFTER_DRAIN) { E(acc, cur, wr, wc, fr, fq); S.done(cur); }
        if (!has_next) break;
#pragma unroll
        for (int a = 0; a < 2; ++a)
#pragma unroll
            for (int b = 0; b < 2; ++b)
#pragma unroll
                for (int m = 0; m < 4; ++m)
#pragma unroll
                    for (int n = 0; n < 2; ++n) acc[a][b][m][n] = (f32x4){0.f, 0.f, 0.f, 0.f};
        cur = nxt; cA = nA; cB = nB; ++ui;
        if constexpr (ALIGN_EPI) { if (wr == 1) PG8_BAR; }
    }
    PG8_WAIT_V(0);
    if constexpr (!ALIGN_EPI) { if (wr == 0) PG8_BAR; }
    PG8_BAR;
    if constexpr (Epi::AFTER_DRAIN) { E.fused(acc, cur, wr, wc, fr, fq, lds, wid, lane); S.done(cur); }
#undef PG8_SA
#undef PG8_SB
#undef PG8_STAGE
#undef PG8_LDA
#undef PG8_LDB
#undef PG8_MMA
#undef PG8_WAIT_V
#undef PG8_WAIT_L
#undef PG8_BAR
#undef PG8_SCHED
}
}

namespace att {
typedef unsigned short bf16_t;
typedef short bf16x8 __attribute__((ext_vector_type(8)));
typedef short s16x4 __attribute__((ext_vector_type(4)));
typedef float f32x16 __attribute__((ext_vector_type(16)));
typedef float f32x4 __attribute__((ext_vector_type(4)));
typedef unsigned u32x4 __attribute__((ext_vector_type(4)));
constexpr int NW = 8, QBLK = 32, KVBLK = 64, QB = NW * QBLK, D = 128;
constexpr int SHM_V = KVBLK * D * 2, SHM_K = KVBLK * D * 2;
constexpr int OFF_WS = 2 * SHM_V + 2 * SHM_K, OFF_BK = OFF_WS + NW * 64 * 4, ATT_LDS = OFF_BK + 8192;
constexpr float SCALE = 0.08838834764831845f, THR = 8.f;
constexpr int WBIG = 1 << 30;
#define KSWZ(row, colB) ((row) * 256 + ((colB) ^ (((row) & 7) << 4)))
#define SBAR() __builtin_amdgcn_sched_barrier(0)
__device__ __forceinline__ int v_st(int k, int c) { const int kk = (k & ~0xC) | ((k & 4) << 1) | ((k & 8) >> 1); return ((kk >> 3) * 4 + (c >> 5)) * 512 + ((kk & 7) * 32 + (c & 31)) * 2; }
__device__ __forceinline__ int v_rd_base(int lane) { return ((lane & 3) << 3) | (((lane >> 2) & 3) << 6) | (((lane >> 4) & 1) << 5) | (((lane >> 5) & 1) << 8); }
constexpr int v_rd_off(int d0, int ks, int half) { return d0 * 512 + ks * 4096 + half * 2048; }
__device__ __forceinline__ int crow(int r, int hi) { return (r & 3) + 8 * (r >> 2) + 4 * hi; }
__device__ __forceinline__ unsigned cvtpk(float lo, float hi) { unsigned r; asm volatile("v_cvt_pk_bf16_f32 %0, %1, %2" : "=v"(r) : "v"(lo), "v"(hi)); return r; }
__device__ __forceinline__ bf16x8 load8(const bf16_t* p) { return *reinterpret_cast<const bf16x8*>(p); }
__device__ __forceinline__ void mask_tile(f32x16& p0, f32x16& p1, int dq, unsigned W) {
    const float NEG = -__builtin_inff();
#pragma unroll
    for (int r = 0; r < 16; ++r) { const int c = (r & 3) + 8 * (r >> 2);
        if ((unsigned)(dq - c) >= W) p0[r] = NEG;
        if ((unsigned)(dq - c - 32) >= W) p1[r] = NEG; }
}
__device__ __forceinline__ void partialSM(f32x16& p0, f32x16& p1, float& m_reg, float& mn, float& alpha) {
    float pmax = p0[0]; for (int r = 1; r < 16; ++r) pmax = fmaxf(pmax, p0[r]); for (int r = 0; r < 16; ++r) pmax = fmaxf(pmax, p1[r]);
    { auto rr = __builtin_amdgcn_permlane32_swap(__float_as_uint(pmax), __float_as_uint(pmax), false, false);
      pmax = fmaxf(__uint_as_float(rr[0]), __uint_as_float(rr[1])); }
    constexpr float C2 = 1.4426950408889634f * SCALE;
    if (__builtin_expect(__all((pmax - m_reg) * SCALE <= THR), 1)) { mn = m_reg; alpha = 1.f; }
    else { mn = fmaxf(m_reg, pmax); alpha = __builtin_amdgcn_exp2f((m_reg - mn) * C2); m_reg = mn; }
    const float mnL = -mn * C2;
    for (int r = 0; r < 16; ++r) p0[r] = fmaf(p0[r], C2, mnL); for (int r = 0; r < 16; ++r) p1[r] = fmaf(p1[r], C2, mnL);
    for (int r = 0; r < 16; ++r) p0[r] = __builtin_amdgcn_exp2f(p0[r]);
}
__device__ __forceinline__ void finishSM(f32x16& p0, f32x16& p1, float alpha, float& l_reg, bf16x8& pa0, bf16x8& pa1, bf16x8& pa2, bf16x8& pa3) {
    for (int r = 0; r < 16; ++r) p1[r] = __builtin_amdgcn_exp2f(p1[r]);
    float ps = 0; for (int r = 0; r < 16; ++r) ps += p0[r]; for (int r = 0; r < 16; ++r) ps += p1[r];
    { auto rr = __builtin_amdgcn_permlane32_swap(__float_as_uint(ps), __float_as_uint(ps), false, false);
      ps = __uint_as_float(rr[0]) + __uint_as_float(rr[1]); }
    l_reg = l_reg * alpha + ps;
#define PK4(P, B_, OUT) do { unsigned a0 = cvtpk(P[B_+0], P[B_+1]), a1 = cvtpk(P[B_+2], P[B_+3]);                          \
        unsigned b0 = cvtpk(P[B_+4], P[B_+5]), b1 = cvtpk(P[B_+6], P[B_+7]);                                             \
        auto r0 = __builtin_amdgcn_permlane32_swap(a0, b0, false, false); auto r1 = __builtin_amdgcn_permlane32_swap(a1, b1, false, false); \
        u32x4 w = {r0[0], r1[0], r0[1], r1[1]}; OUT = *reinterpret_cast<bf16x8*>(&w); } while (0)
    PK4(p0, 0, pa0); PK4(p0, 8, pa1); PK4(p1, 0, pa2); PK4(p1, 8, pa3);
#undef PK4
}
template <int KB>
__device__ __forceinline__ void qkt(f32x16& p0, f32x16& p1, const char* K_lds, int r32, int hi, const bf16x8* qr, const float* bb) {
#pragma unroll
    for (int g = 0; g < 4; ++g) { const f32x4 b0 = *(const f32x4*)(bb + 8 * g), b1 = *(const f32x4*)(bb + 32 + 8 * g);
#pragma unroll
        for (int i = 0; i < 4; ++i) { p0[4 * g + i] = b0[i]; p1[4 * g + i] = b1[i]; } }
    const char* kb[4];
#pragma unroll
    for (int dd = 0; dd < 4; ++dd) kb[dd] = K_lds + KB * SHM_K + KSWZ(r32, (dd * 16 + hi * 8) * 2);
#pragma unroll
    for (int d0 = 0; d0 < 8; ++d0) { const char* a = kb[d0 & 3] + (d0 >> 2) * 128;
        bf16x8 b0 = *reinterpret_cast<const bf16x8*>(a);
        bf16x8 b1 = *reinterpret_cast<const bf16x8*>(a + 32 * 256);
        p0 = __builtin_amdgcn_mfma_f32_32x32x16_bf16(b0, qr[d0], p0, 0, 0, 0);
        p1 = __builtin_amdgcn_mfma_f32_32x32x16_bf16(b1, qr[d0], p1, 0, 0, 0); }
}
template <int VB>
__device__ __forceinline__ void pv_tile(f32x16* o, int vb0, bf16x8 pa0, bf16x8 pa1, bf16x8 pa2, bf16x8 pa3) {
#define TRRD(dst, off) asm volatile("ds_read_b64_tr_b16 %0, %1 offset:%2" : "=&v"(dst) : "v"(vb0), "i"(off) : "memory")
#define PV_D0(d0) do { s16x4 l0, l1, l2, l3, h0, h1, h2, h3; constexpr int b_ = VB * SHM_V + v_rd_off(d0, 0, 0);   \
        TRRD(l0, b_); TRRD(h0, b_ + 2048); TRRD(l1, b_ + 4096); TRRD(h1, b_ + 6144); TRRD(l2, b_ + 8192); TRRD(h2, b_ + 10240); TRRD(l3, b_ + 12288); TRRD(h3, b_ + 14336); \
        asm volatile("s_waitcnt lgkmcnt(0)" ::: "memory"); SBAR();   \
        o[d0] = __builtin_amdgcn_mfma_f32_32x32x16_bf16(pa0, (bf16x8){l0[0], l0[1], l0[2], l0[3], h0[0], h0[1], h0[2], h0[3]}, o[d0], 0, 0, 0);   \
        o[d0] = __builtin_amdgcn_mfma_f32_32x32x16_bf16(pa1, (bf16x8){l1[0], l1[1], l1[2], l1[3], h1[0], h1[1], h1[2], h1[3]}, o[d0], 0, 0, 0);   \
        o[d0] = __builtin_amdgcn_mfma_f32_32x32x16_bf16(pa2, (bf16x8){l2[0], l2[1], l2[2], l2[3], h2[0], h2[1], h2[2], h2[3]}, o[d0], 0, 0, 0);   \
        o[d0] = __builtin_amdgcn_mfma_f32_32x32x16_bf16(pa3, (bf16x8){l3[0], l3[1], l3[2], l3[3], h3[0], h3[1], h3[2], h3[3]}, o[d0], 0, 0, 0); } while (0)
    PV_D0(0); PV_D0(1); PV_D0(2); PV_D0(3);
#undef PV_D0
#undef TRRD
}
constexpr int QP = 4608;
struct Blk { bf16_t* Q; const bf16_t* K; const float* fcum; int voff, goff, P0, skv, kvpitch; };
struct Seam { bf16x8 qr[8]; bf16x8 st_v0, st_v1, st_k0, st_k1; };
#define ROW(p, pitch, k0, rr) ((p) + (size_t)((k0) + (rr)) * (pitch) + sc)
#define VMW() asm volatile("s_waitcnt vmcnt(0)" ::: "memory")
#define VMWN(n) asm volatile("s_waitcnt vmcnt(%0)" :: "i"(n) : "memory")
#define SLOAD_H(Kp, Vp, pitch, k0) do { S.st_v0 = load8(ROW(Vp, pitch, k0, sr)); S.st_v1 = load8(ROW(Vp, pitch, k0, 32 + sr));              \
                         S.st_k0 = load8(ROW(Kp, pitch, k0, sr)); S.st_k1 = load8(ROW(Kp, pitch, k0, 32 + sr)); } while (0)
#define SWRITE_HK(bf) do { *(bf16x8*)(K_lds + (bf) * SHM_K + kws) = S.st_k0; *(bf16x8*)(K_lds + (bf) * SHM_K + kws + 32 * 256) = S.st_k1; } while (0)
#define SWRITE_HV(bf) do { *(bf16x8*)(V_lds + (bf) * SHM_V + vst0) = S.st_v0; *(bf16x8*)(V_lds + (bf) * SHM_V + vst1) = S.st_v1; } while (0)
#define SWRITE_H(bf) do { SWRITE_HV(bf); SWRITE_HK(bf); } while (0)
__device__ __forceinline__ void prime(const Blk& cur, char* lds, Seam& S, int wid) {
    int lane = (int)__builtin_amdgcn_mbcnt_hi(~0u, __builtin_amdgcn_mbcnt_lo(~0u, 0u)); asm volatile("" : "+v"(lane));
    const int tid = wid * 64 + lane, r32 = lane & 31, hi = lane >> 5;
    const int sr = tid >> 4, sc = (tid & 15) * 8, kws = KSWZ(sr, sc * 2); char* K_lds = lds + 2 * SHM_V;
    for (int d0 = 0; d0 < 8; ++d0) S.qr[d0] = load8(cur.Q + (size_t)(wid * QBLK + r32) * QP + d0 * 16 + hi * 8);
    SLOAD_H(cur.K, cur.K + cur.voff, cur.kvpitch, 0); VMW(); SWRITE_HK(0);
    __syncthreads();
}
__device__ __forceinline__ void block(const Blk& cur, const Blk& nxt, char* lds, Seam& S, int wid) {
    int lane = (int)__builtin_amdgcn_mbcnt_hi(~0u, __builtin_amdgcn_mbcnt_lo(~0u, 0u)); asm volatile("" : "+v"(lane));
    const int tid = wid * 64 + lane, r32 = lane & 31, hi = lane >> 5;
    constexpr int W = WBIG;
    int j_hi = (cur.P0 + QB - 1) / KVBLK + 1; if (j_hi > cur.skv / KVBLK) j_hi = cur.skv / KVBLK;
    const int NT = j_hi;
    const int qlo = cur.P0 + wid * QBLK, qm = qlo + r32 - 4 * hi;
    char* V_lds = lds; char* K_lds = lds + 2 * SHM_V;
    float* ws = (float*)(lds + OFF_WS) + wid * 64; float* li_l = ws, * al_l = ws + 32;
    float* bkl = (float*)(lds + OFF_BK);
    { const int nkeys = NT * KVBLK;
      for (int k = tid; k < nkeys; k += NW * 64) bkl[k] = cur.fcum ? -cur.fcum[k] * (1.f / SCALE) : 0.f;
      __syncthreads(); }
    float m_reg = -1e30f, l_reg = 0; f32x16 o[4] = {};
    const int sr = tid >> 4, sc = (tid & 15) * 8, vst0 = v_st(sr, sc), vst1 = v_st(32 + sr, sc), kws = KSWZ(sr, sc * 2);
    const int vb0 = (int)(uintptr_t)V_lds + v_rd_base(lane);
    const bf16_t* Kh = cur.K; const bf16_t* Vh = cur.K + cur.voff; const int kvp = cur.kvpitch;
#define RESC(a) do { if (__any((a) < 1.f)) { if (hi == 0) al_l[r32] = (a); asm volatile("s_waitcnt lgkmcnt(0)" ::: "memory");              \
                     for (int d_ = 0; d_ < 4; ++d_) for (int r = 0; r < 16; ++r) o[d_][r] *= al_l[crow(r, hi)]; } } while (0)
#define KBASE(t) ((t) * KVBLK)
#define MASKT(P0_, P1_, t) do { const int kb_ = KBASE(t); if (kb_ + KVBLK - 1 > qlo) mask_tile(P0_, P1_, qm - kb_, (unsigned)W); } while (0)
#define BB(t) (bkl + KBASE(t) + 4 * hi)
    constexpr int NQL = 8;
#define SEAM_K0() do { VMWN(NQL); SWRITE_HK(0); SBAR(); } while (0)
    f32x16 pA0, pA1, pB0, pB1; float mnA, mnB, alA, alB; bf16x8 pa0, pa1, pa2, pa3;
    SWRITE_HV(0); SBAR();
    if (NT > 1) { SLOAD_H(Kh, Vh, kvp, KBASE(1)); }
    SBAR(); qkt<0>(pA0, pA1, K_lds, r32, hi, S.qr, BB(0));
    MASKT(pA0, pA1, 0); partialSM(pA0, pA1, m_reg, mnA, alA);
    if (NT > 1) { VMW(); SWRITE_H(1); }
    __syncthreads();
#define HALF_STEP(PX0, PX1, mnX, alX, PY0, PY1, alY, t, KB, VB, SB) do {                                                      \
        SBAR(); qkt<KB>(PX0, PX1, K_lds, r32, hi, S.qr, BB(t));                                                                      \
        finishSM(PY0, PY1, alY, l_reg, pa0, pa1, pa2, pa3); SBAR();                                                           \
        if ((t) + 1 < NT) { SLOAD_H(Kh, Vh, kvp, KBASE((t) + 1)); SBAR(); }                                                   \
        pv_tile<VB>(o, vb0, pa0, pa1, pa2, pa3); MASKT(PX0, PX1, (t)); partialSM(PX0, PX1, m_reg, mnX, alX);   \
        __syncthreads();                                                                                                      \
        if ((t) + 1 < NT) { VMW(); SWRITE_H(SB); }                                                                            \
        RESC(alX); __syncthreads(); } while (0)
    for (int t = 1; t + 1 < NT; t += 2) {
        HALF_STEP(pB0, pB1, mnB, alB, pA0, pA1, alA, t, 1, 0, 0);
        HALF_STEP(pA0, pA1, mnA, alA, pB0, pB1, alB, t + 1, 0, 1, 1);
    }
    const bool even = (NT & 1) == 0;
    if (even) { SBAR(); qkt<1>(pB0, pB1, K_lds, r32, hi, S.qr, BB(NT - 1)); SBAR(); }
    SLOAD_H(nxt.K, nxt.K + nxt.voff, nxt.kvpitch, 0); SBAR();
#pragma unroll
    for (int d0 = 0; d0 < 8; ++d0) S.qr[d0] = load8(nxt.Q + (size_t)(wid * QBLK + r32) * QP + d0 * 16 + hi * 8);
    SBAR();
    finishSM(pA0, pA1, alA, l_reg, pa0, pa1, pa2, pa3); SBAR();
    pv_tile<0>(o, vb0, pa0, pa1, pa2, pa3);
    if (even) { MASKT(pB0, pB1, NT - 1); partialSM(pB0, pB1, m_reg, mnB, alB); __syncthreads(); RESC(alB);
        finishSM(pB0, pB1, alB, l_reg, pa0, pa1, pa2, pa3); SBAR(); pv_tile<1>(o, vb0, pa0, pa1, pa2, pa3); }
    SBAR(); SEAM_K0();
    if (hi == 0) li_l[r32] = l_reg; asm volatile("s_waitcnt lgkmcnt(0)" ::: "memory");
    float rli[16];
#pragma unroll
    for (int r = 0; r < 16; ++r) rli[r] = __builtin_amdgcn_rcpf(li_l[crow(r, hi)]);
    bf16_t* Ow = cur.Q + (size_t)(wid * QBLK + 4 * hi) * QP + r32; const int goff = cur.goff;
#pragma unroll
    for (int r = 0; r < 16; ++r) { const int ro = ((r & 3) + 8 * (r >> 2)) * QP;
#pragma unroll
        for (int d0 = 0; d0 < 4; ++d0) { float v = o[d0][r] * rli[r];
            if (goff) { const float g = __uint_as_float((unsigned)Ow[goff + ro + d0 * 32] << 16); v *= __builtin_amdgcn_rcpf(1.f + __expf(-g)); }
            const float vn = __shfl_xor(v, 1);
            if ((r32 & 1) == 0) *(unsigned*)(Ow + ro + d0 * 32) = cvtpk(v, vn); } }
    __syncthreads();
#undef RESC
#undef KBASE
#undef MASKT
#undef BB
#undef SEAM_K0
#undef HALF_STEP
}
#undef ROW
#undef VMW
#undef VMWN
#undef SLOAD_H
#undef SWRITE_HK
#undef SWRITE_HV
#undef SWRITE_H
#undef KSWZ
#undef SBAR
template <class Src> __device__ __forceinline__ void phase(char* lds, const Src& src, int wid) {
    Blk cur, nxt; if (!src(0, cur)) return;
    Seam S; prime(cur, lds, S, wid);
    for (int n = 0;; ++n) { const bool more = src(n + 1, nxt); if (!more) nxt = cur; block(cur, nxt, lds, S, wid); if (!more) break; cur = nxt; }
}
}

constexpr int NWAVES = 8;
#ifndef MK_LAUNCH_PER_PHASE
#define MK_LAUNCH_PER_PHASE 0
#endif
constexpr int N_PHASES = 13;

constexpr size_t KiB = 1u << 10, MiB = 1u << 20;
constexpr size_t WS_CTL = 0, CTL_ZERO_BYTES = 1 * MiB;
constexpr size_t WS_WIN0 = 1 * MiB, WS_WIN1 = WS_WIN0 + (size_t)N_IN * DM * 2;
constexpr size_t WS_WOUT0 = 20 * MiB, WS_WOUT1 = 23 * MiB;
constexpr size_t WS_WM1_0 = 26 * MiB, WS_WM1_1 = 34 * MiB, WS_WM2_0 = 42 * MiB, WS_WM2_1 = 50 * MiB;
constexpr size_t WS_WMKV = 58 * MiB;
constexpr size_t WS_PROJ = 60 * MiB;
constexpr size_t WS_XB = 204 * MiB;
constexpr size_t WS_SSQ = 236 * MiB;
constexpr size_t WS_AB = 245 * MiB;
constexpr size_t WS_MEMKV = 246 * MiB;
constexpr size_t WS_XSQ = 250 * MiB;
constexpr size_t WS_FCUM = 251 * MiB;
constexpr size_t WS_MSSQ = 251 * MiB + 512 * KiB;
constexpr size_t WS_MSQ = 251 * MiB + 768 * KiB;
constexpr size_t WS_END = 252 * MiB;
static_assert(WS_WIN1 + (size_t)N_IN * DM * 2 <= WS_WOUT0 && WS_PROJ + (size_t)MROWS * PW * 2 <= WS_XB && WS_SSQ + (size_t)36 * MROWS * 16 <= WS_AB, "d_ws map");
constexpr size_t DO_MEMB = 0;
constexpr int CW_BAR = 4096;

constexpr int LDS_BYTES = 155648;
constexpr int MISC_OFF = LDS_BYTES - 256;

#define GAS __attribute__((address_space(1)))
#define LAS __attribute__((address_space(3)))
typedef unsigned short bf16;
typedef unsigned v4u __attribute__((ext_vector_type(4)));
typedef float f32x4 __attribute__((ext_vector_type(4)));
typedef short bf16x8 __attribute__((ext_vector_type(8)));
typedef GAS unsigned gu32;
typedef GAS unsigned long long gu64;
#define RLX_AGENT __ATOMIC_RELAXED, __HIP_MEMORY_SCOPE_AGENT
#define LDS_WAIT() asm volatile("s_waitcnt lgkmcnt(0)" ::: "memory")
#define VM_WAIT() asm volatile("s_waitcnt vmcnt(0)" ::: "memory")
__device__ __forceinline__ unsigned long long rt() { return __builtin_amdgcn_s_memrealtime(); }
__device__ __forceinline__ unsigned f2bf(float f) { unsigned u = __builtin_bit_cast(unsigned, f); return (u + 0x7fffu + ((u >> 16) & 1u)) >> 16; }
__device__ __forceinline__ unsigned pk2(float lo, float hi) { return f2bf(lo) | (f2bf(hi) << 16); }

#define XB_TMO      128
#define XB_XCNT(j)  (256  + 64 * (j))
#define XB_XSUB(j)  (1280 + 64 * (j))
#define XB_XGEN(j)  (2304 + 64 * (j))
#define XB_TOP      3328
#define XB_TOPGEN   3392
#define XCD_BAR_WORDS 3456
#define XB_SPIN_CAP (1u << 18)

__device__ __forceinline__ unsigned xb_ld(unsigned* p)              { return __hip_atomic_load(p, __ATOMIC_RELAXED, __HIP_MEMORY_SCOPE_AGENT); }
__device__ __forceinline__ unsigned xb_add(unsigned* p, unsigned v) { return __hip_atomic_fetch_add(p, v, __ATOMIC_RELAXED, __HIP_MEMORY_SCOPE_AGENT); }
__device__ __forceinline__ unsigned xb_xcc_id() { return (unsigned)__builtin_amdgcn_s_getreg((3 << 11) | 20) & 0xFu; }
#define XB_SPIN(cond, bar) do { unsigned _sp = 0; while (cond) { __builtin_amdgcn_s_sleep(1); \
    if ((++_sp & 255u) == 0u) { if (xb_ld(&(bar)[XB_TMO])) break; if (_sp > XB_SPIN_CAP) { atomicAdd(&(bar)[XB_TMO], 1u); break; } } } } while (0)

struct XcdBarrier {
    unsigned* bar; unsigned x; int wv;
    volatile LAS unsigned* st;
};

__device__ __forceinline__ XcdBarrier xcd_barrier_post(unsigned* bar, volatile LAS unsigned* st) {
    XcdBarrier b; b.bar = bar; b.x = xb_xcc_id(); b.st = st;
    if (threadIdx.x == 0) (void)xb_add(&bar[XB_XCNT(b.x)], 1u);
    return b;
}
__device__ __forceinline__ void xcd_barrier_complete(unsigned* bar, unsigned x, unsigned& nloc, unsigned& nx) {
    const unsigned G = gridDim.x * gridDim.y * gridDim.z;
    unsigned sum, cnt, mine, sp = 0u;
    for (;;) {
        sum = 0u; cnt = 0u; mine = 0u;
#pragma unroll
        for (unsigned j = 0; j < 16; ++j) { const unsigned c = xb_ld(&bar[XB_XCNT(j)]); sum += c; cnt += (c > 0u) ? 1u : 0u; mine = (j == x) ? c : mine; }
        if (sum == G) break;
        __builtin_amdgcn_s_sleep(1);
        if ((++sp & 255u) == 0u) { if (xb_ld(&bar[XB_TMO])) break; if (sp > XB_SPIN_CAP) { atomicAdd(&bar[XB_TMO], 1u); break; } }
    }
    nloc = mine > 0u ? mine : 1u; nx = cnt > 0u ? cnt : 1u;
}

__device__ __forceinline__ void xcd_barrier(const XcdBarrier& b) {
    asm volatile("s_waitcnt vmcnt(0)" ::: "memory");
    __syncthreads();
    if (b.wv == 0 && (int)__builtin_amdgcn_mbcnt_hi(~0u, __builtin_amdgcn_mbcnt_lo(~0u, 0u)) == 0) {
        unsigned* bar = b.bar;
        __builtin_amdgcn_s_waitcnt(0);
        unsigned nloc = b.st[0], nx = b.st[1];
        if (nloc == 0u) { xcd_barrier_complete(bar, b.x, nloc, nx); b.st[0] = nloc; b.st[1] = nx; }
        const unsigned old = xb_add(&bar[XB_XSUB(b.x)], 1u);
        const unsigned gen = old / nloc;
        if (old + 1u == (gen + 1u) * nloc) {
            __builtin_amdgcn_fence(__ATOMIC_RELEASE, "agent");
            asm volatile("s_waitcnt vmcnt(0)" ::: "memory");
            const unsigned og = xb_add(&bar[XB_TOP], 1u);
            const unsigned tg = og / nx;
            if (og + 1u == (tg + 1u) * nx) xb_add(&bar[XB_TOPGEN], 1u);
            else XB_SPIN(xb_ld(&bar[XB_TOPGEN]) == tg, bar);
            __builtin_amdgcn_fence(__ATOMIC_ACQUIRE, "agent");
            xb_add(&bar[XB_XGEN(b.x)], 1u);
            asm volatile("s_waitcnt vmcnt(0)" ::: "memory");
        } else {
            XB_SPIN(xb_ld(&bar[XB_XGEN(b.x)]) == gen, bar);
            __builtin_amdgcn_fence(__ATOMIC_ACQUIRE, "agent");
            asm volatile("s_waitcnt vmcnt(0)" ::: "memory");
        }
    }
    __syncthreads();
}


__device__ __forceinline__ float bflo(unsigned u) { return __builtin_bit_cast(float, u << 16); }
__device__ __forceinline__ float bfhi(unsigned u) { return __builtin_bit_cast(float, u & 0xffff0000u); }
typedef float f32x2_t __attribute__((ext_vector_type(2))); typedef __bf16 bf16x2_t __attribute__((ext_vector_type(2)));
__device__ __forceinline__ unsigned pkbf(float lo, float hi) { const f32x2_t v = {lo, hi}; const bf16x2_t b = __builtin_convertvector(v, bf16x2_t); return __builtin_bit_cast(unsigned, b); }
__device__ __forceinline__ float wave_sum(float v) {
#pragma unroll
    for (int o = 1; o < 64; o <<= 1) v += __shfl_xor(v, o);
    return v;
}
__device__ __forceinline__ float wave_max(float v) {
#pragma unroll
    for (int o = 1; o < 64; o <<= 1) v = fmaxf(v, __shfl_xor(v, o));
    return v;
}

struct Args { const float* in[20]; float* out; unsigned char* ws; int ph_lo, ph_hi, li, pad; };
enum { I_X = 0, I_MEM, I_MEMNW, I_WMKV, I_MEMKNW, I_NORM1, I_DNWIN, I_DNCONV, I_DNALOG, I_DNDT, I_DNONW, I_FOXWIN, I_FOXFB, I_FOXQNW, I_FOXKNW, I_MEMQNW, I_WOUT, I_NORM2, I_WM1, I_WM2 };

struct Frame {
    LAS unsigned char* lds;
    int G, bid, wv;
    const float* const* in; float* out; unsigned char* ws;
};


struct Tix { int tid, lane, wave; };
__device__ __forceinline__ int lane_id() { int x = (int)__builtin_amdgcn_mbcnt_hi(~0u, __builtin_amdgcn_mbcnt_lo(~0u, 0u)); asm volatile("" : "+v"(x)); return x; }
__device__ __forceinline__ Tix tix(int wv) { Tix t; t.lane = lane_id(); t.wave = wv; t.tid = wv * 64 + t.lane; return t; }
struct TSeg { const float* W; int K, ldw, src0, ncols; bf16* WT; int dst0; const float* scale; };
__device__ __forceinline__ TSeg get_seg(const Frame& F, int s) {
    TSeg t; t.scale = nullptr; t.src0 = 0; t.dst0 = 0;
    if (s < 12) {
        const int l = s / 6, j = s % 6;
        t.W = l ? F.in[I_FOXWIN] : F.in[I_DNWIN]; t.K = DM; t.ldw = l ? FOX_IN : DN_IN; t.WT = (bf16*)(F.ws + (l ? WS_WIN1 : WS_WIN0)); t.scale = F.in[I_NORM1] + l * DM;
        const int qm0 = l ? 4104 : 4112, nsc = l ? 8 : 16;
        t.ncols = 1024;
        if (j == 0) { t.src0 = 1024; t.dst0 = PC_K; } else if (j == 1) { t.src0 = 2048; t.dst0 = PC_V; } else if (j == 2) { t.src0 = 3072; t.dst0 = PC_Z; }
        else if (j == 3) { t.src0 = 0; t.dst0 = PC_Q; } else if (j == 4) { t.src0 = qm0; t.dst0 = PC_QM; t.ncols = 512; } else { t.src0 = 4096; t.dst0 = PC_AB; t.ncols = nsc; }
    } else if (s < 14) { const int l = s - 12; t.W = F.in[I_WOUT] + (size_t)l * OUT_IN * DM; t.K = OUT_IN; t.ldw = DM; t.ncols = DM; t.WT = (bf16*)(F.ws + (l ? WS_WOUT1 : WS_WOUT0)); }
    else if (s < 16) { const int l = s - 14; t.W = F.in[I_WM1] + (size_t)l * DM * FF; t.K = DM; t.ldw = FF; t.ncols = FF; t.WT = (bf16*)(F.ws + (l ? WS_WM1_1 : WS_WM1_0)); t.scale = F.in[I_NORM2] + l * DM; }
    else if (s < 18) { const int l = s - 16; t.W = F.in[I_WM2] + (size_t)l * FF * DM; t.K = FF; t.ldw = DM; t.ncols = DM; t.WT = (bf16*)(F.ws + (l ? WS_WM2_1 : WS_WM2_0)); }
    else { t.W = F.in[I_WMKV]; t.K = DM; t.ldw = DM; t.ncols = DM; t.WT = (bf16*)(F.ws + WS_WMKV); t.scale = F.in[I_MEMNW]; }
    return t;
}
__device__ __forceinline__ int seg_items(const TSeg& t) { return (t.K / 64) * ((t.ncols + 31) / 32); }
__device__ __forceinline__ void transpose_item(const TSeg& t, LAS float* scr, int item, int lane) {
    const int nblk = (t.ncols + 31) / 32, kb = item / nblk, nb = item % nblk, k0 = 64 * kb, n0 = 32 * nb;
    const int nl = lane & 31; const bool ok = (n0 + nl) < t.ncols;
#pragma unroll 8
    for (int i = 0; i < 32; ++i) { const int kk = 2 * i + (lane >> 5);
        float w = ok ? t.W[(size_t)(k0 + kk) * t.ldw + t.src0 + n0 + nl] : 0.f;
        if (t.scale) w *= t.scale[k0 + kk];
        scr[kk * 33 + nl] = w; }
    LDS_WAIT(); asm volatile("" ::: "memory");
    const int c = lane & 7;
#pragma unroll
    for (int j = 0; j < 4; ++j) { const int n = (lane >> 3) + 8 * j; const LAS float* s = scr + (8 * c) * 33 + n;
        v4u o; o.x = pkbf(s[0 * 33], s[1 * 33]); o.y = pkbf(s[2 * 33], s[3 * 33]); o.z = pkbf(s[4 * 33], s[5 * 33]); o.w = pkbf(s[6 * 33], s[7 * 33]);
        if (n0 + n < t.ncols) *(v4u*)(t.WT + (size_t)(t.dst0 + n0 + n) * t.K + k0 + 8 * c) = o; }
    LDS_WAIT(); asm volatile("" ::: "memory");
}
__device__ __forceinline__ void row_to_bf16(int lane, const float* xrow, bf16* orow, float* sq) {
    const f32x4* xr = (const f32x4*)xrow + lane;
    f32x4 v[4]; float s = 0.f;
#pragma unroll
    for (int j = 0; j < 4; ++j) { v[j] = xr[64 * j]; s += (v[j].x * v[j].x + v[j].y * v[j].y) + (v[j].z * v[j].z + v[j].w * v[j].w); }
    s = wave_sum(s);
    unsigned long long* o8 = (unsigned long long*)orow + lane;
#pragma unroll
    for (int j = 0; j < 4; ++j) o8[64 * j] = (unsigned long long)pkbf(v[j].x, v[j].y) | ((unsigned long long)pkbf(v[j].z, v[j].w) << 32);
    if (lane < 16) sq[lane] = lane == 0 ? s : 0.f;
}
__device__ __forceinline__ void p0_prologue(const Frame& F) {
    const Tix T = tix(F.wv);
    LAS float* scr = (LAS float*)(F.lds + T.wave * 16384);
    const int gw = F.bid * NWAVES + T.wave, NGW = F.G * NWAVES;
    for (int m = gw; m < MROWS; m += NGW) row_to_bf16(T.lane, F.in[I_X] + (size_t)m * DM, (bf16*)(F.ws + WS_XB) + (size_t)m * DM, (float*)(F.ws + WS_XSQ) + (size_t)m * 16);
    for (int m = gw; m < MMEM; m += NGW) row_to_bf16(T.lane, F.in[I_MEM] + (size_t)m * DM, (bf16*)((unsigned char*)F.out + DO_MEMB) + (size_t)m * DM, (float*)(F.ws + WS_MSQ) + (size_t)m * 16);
    int base = 0;
#pragma unroll
    for (int s = 0; s < 19; ++s) {
        const TSeg t = get_seg(F, s); const int n = seg_items(t);
        int it = gw - (base % NGW); if (it < 0) it += NGW;
        for (; it < n; it += NGW) transpose_item(t, scr, it, T.lane);
        base += n;
    }
}

typedef short dn_bf16x8 __attribute__((ext_vector_type(8)));
typedef unsigned dn_u32x2 __attribute__((ext_vector_type(2)));
__device__ __forceinline__ f32x4 mfma16(dn_bf16x8 a, dn_bf16x8 b, f32x4 c) { return __builtin_amdgcn_mfma_f32_16x16x32_bf16(a, b, c, 0, 0, 0); }
__device__ __forceinline__ f32x4 mfma4(float a, float b, f32x4 c) { return __builtin_amdgcn_mfma_f32_16x16x4f32(a, b, c, 0, 0, 0); }
__device__ __forceinline__ dn_bf16x8 pack8f(f32x4 x, f32x4 y) { v4u w; w.x = pkbf(x[0], x[1]); w.y = pkbf(x[2], x[3]); w.z = pkbf(y[0], y[1]); w.w = pkbf(y[2], y[3]); return __builtin_bit_cast(dn_bf16x8, w); }
__device__ __forceinline__ dn_u32x2 pack4f(f32x4 x) { dn_u32x2 w; w.x = pkbf(x[0], x[1]); w.y = pkbf(x[2], x[3]); return w; }
__device__ __forceinline__ unsigned short bf1(float x) { return (unsigned short)(pkbf(x, 0.f) & 0xffffu); }
constexpr size_t DO_QKS = 4 * MiB, DO_HALO = 20 * MiB, DO_EGL = 27 * MiB;
constexpr int P_RAW = 0, P_GB = 51712, P_QH = 53248, P_KH = 70656, P_VBT = 88064, P_KBGT = 106496, P_QKL = 124928, P_END = 134144;
constexpr int P_AT = 0, P_TB = 17408, P_PS = 26624, P_PS2 = 29184;
__device__ __forceinline__ void dn_prep_unit(const Frame& F, int u) {
    const Tix T = tix(F.wv); const int tid = T.tid, lane = T.lane, wave = T.wave, m = lane & 15, g = lane >> 4;
    const int bh = u >> 5, c = u & 31, b = bh >> 3, h = bh & 7; const size_t row0 = (size_t)b * SEQ + c * 64; const int gch = b * 32 + c;
    bf16* proj = (bf16*)(F.ws + WS_PROJ); const float* AB = (const float*)(F.ws + WS_AB); const bf16* halo = (const bf16*)((unsigned char*)F.out + DO_HALO);
    bf16* xbimg = (bf16*)(F.ws + WS_XB) + (size_t)u * 8192; bf16* qks = (bf16*)((unsigned char*)F.out + DO_QKS) + (size_t)u * 4096; float* egl = (float*)((unsigned char*)F.out + DO_EGL);
    LAS unsigned char* L = F.lds; LAS float* GB = (LAS float*)(L + P_GB);
    for (int id = tid; id < 67 * 48; id += 512) { const int r = id / 48, rem = id - r * 48, seg = rem >> 4, ch = rem & 15;
        const int col = (seg == 0 ? PC_Q : seg == 1 ? PC_K : PC_V) + h * HD + ch * 8;
        v4u val = {0u, 0u, 0u, 0u};
        if (r >= 3) val = *(const v4u*)(proj + (row0 + r - 3) * PW + col);
        else if (c > 0) val = *(const v4u*)(halo + ((size_t)(gch - 1) * 3 + r) * PW + col);
        *(LAS v4u*)(L + P_RAW + r * 768 + seg * 256 + ch * 16) = val; }
    if (wave == 0) { const float a = AB[(row0 + lane) * 16 + h], bb = AB[(row0 + lane) * 16 + 8 + h];
        const float x = a + F.in[I_DNDT][h], sp = fmaxf(x, 0.f) + log1pf(__expf(-fabsf(x)));
        const float gt = -__expf(F.in[I_DNALOG][h]) * sp, beta = 1.f / (1.f + __expf(-bb));
        float gc = gt;
#pragma unroll
        for (int o = 1; o < 64; o <<= 1) { const float t = __shfl_up(gc, o); if (lane >= o) gc += t; }
        const float gl = __shfl(gc, 63);
        GB[lane] = gc; GB[64 + lane] = beta; GB[128 + lane] = beta * __expf(gc); GB[192 + lane] = __expf(gl - gc); GB[256 + lane] = __expf(gc);
        if (lane == 0) egl[u] = __expf(gl); }
    __syncthreads();
    { const int hf = lane >> 5, c4 = lane & 31; const float* convw = F.in[I_DNCONV];
      for (int jj = 0; jj < 12; ++jj) { const int wi = wave + 8 * jj, seg = wi >> 5, i = 2 * (wi & 31) + hf;
        f32x4 y = {0.f, 0.f, 0.f, 0.f};
#pragma unroll
        for (int j = 0; j < 4; ++j) { const f32x4 w = *(const f32x4*)(convw + j * 3072 + seg * 1024 + h * HD + 4 * c4);
            const dn_u32x2 xx = *(const LAS dn_u32x2*)(L + P_RAW + (i + j) * 768 + seg * 256 + c4 * 8);
            y[0] += w[0] * bflo(xx.x); y[1] += w[1] * bfhi(xx.x); y[2] += w[2] * bflo(xx.y); y[3] += w[3] * bfhi(xx.y); }
        f32x4 s;
#pragma unroll
        for (int e = 0; e < 4; ++e) s[e] = y[e] / (1.f + __expf(-y[e]));
        if (seg < 2) { float ss = (s[0] * s[0] + s[1] * s[1]) + (s[2] * s[2] + s[3] * s[3]);
            ss += __shfl_xor(ss, 1); ss += __shfl_xor(ss, 2); ss += __shfl_xor(ss, 4); ss += __shfl_xor(ss, 8); ss += __shfl_xor(ss, 16);
            const float r = rsqrtf(ss + EPS) * (seg == 0 ? QSCALE : 1.f);
            s = s * r;
            *(LAS dn_u32x2*)(L + (seg == 0 ? P_QH : P_KH) + i * 272 + c4 * 8) = pack4f(s);
            if (seg == 0) { const int cc = c4 & 7, p0 = cc < 4 ? 8 * cc : 8 * (cc - 4) + 4;
                *(dn_u32x2*)(proj + (row0 + i) * PW + PC_Q + h * HD + 32 * (c4 >> 3) + p0) = pack4f(s * GB[256 + i]); }
            else { const float bge = GB[128 + i];
#pragma unroll
                for (int e = 0; e < 4; ++e) *(LAS unsigned short*)(L + P_KBGT + (4 * c4 + e) * 144 + i * 2) = bf1(s[e] * bge); } }
        else { const float be = GB[64 + i];
#pragma unroll
            for (int e = 0; e < 4; ++e) *(LAS unsigned short*)(L + P_VBT + (4 * c4 + e) * 144 + i * 2) = bf1(s[e] * be); } } }
    __syncthreads();
    LAS float* AT = (LAS float*)(L + P_AT);
#pragma unroll
    for (int q = 0; q < 2; ++q) { const int tt = wave + 8 * q, it = tt >> 2, jt = tt & 3;
        f32x4 kk = {0.f, 0.f, 0.f, 0.f}, qk = {0.f, 0.f, 0.f, 0.f};
        if (jt <= it) {
#pragma unroll
            for (int kq = 0; kq < 4; ++kq) { const dn_bf16x8 bk = *(const LAS dn_bf16x8*)(L + P_KH + (16 * jt + m) * 272 + (32 * kq + 8 * g) * 2);
                const dn_bf16x8 ak = *(const LAS dn_bf16x8*)(L + P_KH + (16 * it + m) * 272 + (32 * kq + 8 * g) * 2), aq = *(const LAS dn_bf16x8*)(L + P_QH + (16 * it + m) * 272 + (32 * kq + 8 * g) * 2);
                kk = mfma16(ak, bk, kk); qk = mfma16(aq, bk, qk); } }
        const int j = 16 * jt + m, jl = j & 31, p = jl < 16 ? 8 * (jl >> 2) + (jl & 3) : 8 * ((jl - 16) >> 2) + 4 + (jl & 3);
        const float gcj = GB[j];
#pragma unroll
        for (int r = 0; r < 4; ++r) { const int i = 16 * it + 4 * g + r; const float dec = i >= j ? __expf(GB[i] - gcj) : 0.f;
            AT[i * 68 + j] = i > j ? GB[64 + i] * kk[r] * dec : 0.f;
            *(LAS unsigned short*)(L + P_QKL + i * 144 + (32 * (j >> 5) + p) * 2) = bf1(qk[r] * dec); } }
    __syncthreads();
    if (wave >= 4) { const int t4 = tid - 256;
        for (int id = t4; id < 1024; id += 256) { const int k = id >> 3, sp = (id >> 2) & 1, gg = id & 3; float o8[8];
#pragma unroll
            for (int j = 0; j < 8; ++j) { const int cc = 32 * sp + (j < 4 ? 4 * gg + j : 16 + 4 * gg + j - 4);
                o8[j] = bflo((unsigned)*(const LAS unsigned short*)(L + P_KH + cc * 272 + k * 2)) * GB[192 + cc]; }
            v4u w; w.x = pkbf(o8[0], o8[1]); w.y = pkbf(o8[2], o8[3]); w.z = pkbf(o8[4], o8[5]); w.w = pkbf(o8[6], o8[7]);
            *(v4u*)(proj + (row0 + (k >> 1)) * PW + PC_K + h * HD + (k & 1) * 64 + 32 * sp + 8 * gg) = w; }
        for (int id = t4; id < 512; id += 256) { const int i = id >> 3, j8 = (id & 7) * 8;
            *(v4u*)(qks + i * 64 + j8) = *(const LAS v4u*)(L + P_QKL + i * 144 + j8 * 2); } }
    if (wave == 0) { const int bb = g, j = m; float X[16];
        X[0] = j == 0 ? 1.f : 0.f;
#pragma unroll
        for (int i = 1; i < 16; ++i) { const LAS float* Lr = AT + (16 * bb + i) * 68 + 16 * bb; float Lv[16];
#pragma unroll
            for (int q = 0; q < (i + 3) / 4; ++q) { const f32x4 t = *(const LAS f32x4*)(Lr + 4 * q); Lv[4 * q] = t[0]; Lv[4 * q + 1] = t[1]; Lv[4 * q + 2] = t[2]; Lv[4 * q + 3] = t[3]; }
            float acc = i == j ? 1.f : 0.f;
#pragma unroll
            for (int mm = 0; mm < i; ++mm) acc -= Lv[mm] * X[mm];
            X[i] = acc; }
#pragma unroll
        for (int i = 0; i < 16; ++i) AT[(16 * bb + i) * 68 + 16 * bb + j] = X[i]; }
    __syncthreads();
    if (wave < 2) { const int lo = 2 * wave, hi = 2 * wave + 1; LAS float* PS = (LAS float*)(L + P_PS) + wave * 320;
        f32x4 acc = {0.f, 0.f, 0.f, 0.f};
#pragma unroll
        for (int s = 0; s < 4; ++s) acc = mfma4(AT[(16 * hi + m) * 68 + 16 * lo + 4 * s + g], AT[(16 * lo + 4 * s + g) * 68 + 16 * lo + m], acc);
#pragma unroll
        for (int r = 0; r < 4; ++r) PS[(4 * g + r) * 20 + m] = acc[r];
        LDS_WAIT();
        f32x4 acc2 = {0.f, 0.f, 0.f, 0.f};
#pragma unroll
        for (int s = 0; s < 4; ++s) acc2 = mfma4(AT[(16 * hi + m) * 68 + 16 * hi + 4 * s + g], PS[(4 * s + g) * 20 + m], acc2);
#pragma unroll
        for (int r = 0; r < 4; ++r) AT[(16 * hi + 4 * g + r) * 68 + 16 * lo + m] = -acc2[r]; }
    __syncthreads();
    { LAS float* PS2 = (LAS float*)(L + P_PS2); const int ti = (wave >> 1) & 1, tj = wave & 1;
      if (wave < 4) { f32x4 acc = {0.f, 0.f, 0.f, 0.f};
#pragma unroll
          for (int s = 0; s < 8; ++s) acc = mfma4(AT[(32 + 16 * ti + m) * 68 + 4 * s + g], AT[(4 * s + g) * 68 + 16 * tj + m], acc);
#pragma unroll
          for (int r = 0; r < 4; ++r) PS2[(16 * ti + 4 * g + r) * 36 + 16 * tj + m] = acc[r]; }
      __syncthreads();
      if (wave < 4) { f32x4 acc = {0.f, 0.f, 0.f, 0.f};
#pragma unroll
          for (int s = 0; s < 8; ++s) acc = mfma4(AT[(32 + 16 * ti + m) * 68 + 32 + 4 * s + g], PS2[(4 * s + g) * 36 + 16 * tj + m], acc);
#pragma unroll
          for (int r = 0; r < 4; ++r) AT[(32 + 16 * ti + 4 * g + r) * 68 + 16 * tj + m] = -acc[r]; } }
    __syncthreads();
    { const int i = tid >> 3, j0 = (tid & 7) * 8; const f32x4 t0 = *(const LAS f32x4*)(AT + i * 68 + j0), t1 = *(const LAS f32x4*)(AT + i * 68 + j0 + 4);
      v4u w; w.x = pkbf(t0[0], t0[1]); w.y = pkbf(t0[2], t0[3]); w.z = pkbf(t1[0], t1[1]); w.w = pkbf(t1[2], t1[3]);
      *(LAS v4u*)(L + P_TB + i * 144 + j0 * 2) = w; }
    __syncthreads();
#pragma unroll
    for (int q = 0; q < 8; ++q) { const int tt = wave + 8 * q; f32x4 acc = {0.f, 0.f, 0.f, 0.f};
        if (tt < 32) { const int ct = tt >> 3, nt = tt & 7;
#pragma unroll
            for (int sp = 0; sp < 2; ++sp) acc = mfma16(*(const LAS dn_bf16x8*)(L + P_TB + (16 * ct + m) * 144 + (32 * sp + 8 * g) * 2), *(const LAS dn_bf16x8*)(L + P_VBT + (16 * nt + m) * 144 + (32 * sp + 8 * g) * 2), acc);
            const int v = 16 * nt + m;
            *(dn_u32x2*)(proj + (row0 + (v >> 1)) * PW + PC_V + h * HD + (v & 1) * 64 + 16 * ct + 4 * g) = pack4f(acc); }
        else { const int t2 = tt - 32, kt = t2 >> 2, ct = t2 & 3;
#pragma unroll
            for (int sp = 0; sp < 2; ++sp) acc = mfma16(*(const LAS dn_bf16x8*)(L + P_KBGT + (16 * kt + m) * 144 + (32 * sp + 8 * g) * 2), *(const LAS dn_bf16x8*)(L + P_TB + (16 * ct + m) * 144 + (32 * sp + 8 * g) * 2), acc);
            *(dn_u32x2*)(xbimg + (16 * ct + m) * 128 + 32 * (kt >> 1) + 8 * g + 4 * (kt & 1)) = pack4f(-acc); } }
    __syncthreads();
}
constexpr int S_WN = 0, S_QG = 17408, S_KDT = 34816, S_QKM = 53248, S_UT = 62464, S_OB = 80896, S_PSQ = 114688, S_END = 116736;
__device__ __forceinline__ void dn_scan_unit(const Frame& F, int bh) {
    const Tix T = tix(F.wv); const int tid = T.tid, lane = T.lane, wave = T.wave, m = lane & 15, g = lane >> 4, n0 = 16 * wave;
    const int b = bh >> 3, h = bh & 7;
    bf16* proj = (bf16*)(F.ws + WS_PROJ); const bf16* xbi = (const bf16*)(F.ws + WS_XB); const bf16* qks = (const bf16*)((unsigned char*)F.out + DO_QKS); const float* egl = (const float*)((unsigned char*)F.out + DO_EGL);
    const float* onw = F.in[I_DNONW];
    LAS unsigned char* L = F.lds;
    f32x4 Sacc[8];
#pragma unroll
    for (int kt = 0; kt < 8; ++kt) Sacc[kt] = (f32x4){0.f, 0.f, 0.f, 0.f};
    v4u R[9];
#define DN_LOAD(cc) do { const size_t r0_ = (size_t)b * SEQ + (cc) * 64; const size_t u_ = (size_t)bh * 32 + (cc);                                         \
        _Pragma("unroll") for (int j_ = 0; j_ < 2; ++j_) { const int q_ = tid + 512 * j_;                                                                  \
            R[j_] = *(const v4u*)(xbi + u_ * 8192 + q_ * 8);                                                                                                \
            R[2 + j_] = *(const v4u*)(proj + (r0_ + (q_ >> 4)) * PW + PC_Q + h * HD + (q_ & 15) * 8);                                                       \
            R[4 + j_] = *(const v4u*)(proj + (r0_ + (q_ >> 4)) * PW + PC_K + h * HD + ((q_ >> 3) & 1) * 64 + (q_ & 7) * 8);                                 \
            R[6 + j_] = *(const v4u*)(proj + (r0_ + (q_ >> 4)) * PW + PC_V + h * HD + ((q_ >> 3) & 1) * 64 + (q_ & 7) * 8); }                               \
        R[8] = *(const v4u*)(qks + u_ * 4096 + tid * 8); } while (0)
#define DN_WRITE() do { _Pragma("unroll") for (int j_ = 0; j_ < 2; ++j_) { const int q_ = tid + 512 * j_;                                                  \
            *(LAS v4u*)(L + S_WN + (q_ >> 4) * 272 + (q_ & 15) * 16) = R[j_]; *(LAS v4u*)(L + S_QG + (q_ >> 4) * 272 + (q_ & 15) * 16) = R[2 + j_];          \
            *(LAS v4u*)(L + S_KDT + (q_ >> 3) * 144 + (q_ & 7) * 16) = R[4 + j_]; *(LAS v4u*)(L + S_UT + (q_ >> 3) * 144 + (q_ & 7) * 16) = R[6 + j_]; }   \
        *(LAS v4u*)(L + S_QKM + (tid >> 3) * 144 + (tid & 7) * 16) = R[8]; } while (0)
    DN_LOAD(0); DN_WRITE();
    __syncthreads();
    LAS float* OB = (LAS float*)(L + S_OB); LAS float* PSQ = (LAS float*)(L + S_PSQ);
    for (int c = 0; c < SEQ / 64; ++c) {
        const size_t row0 = (size_t)b * SEQ + c * 64;
        if (c + 1 < SEQ / 64) DN_LOAD(c + 1);
        const int fr_ = tid >> 3, fp_ = tid & 7;
        const v4u z0 = *(const v4u*)(proj + (row0 + fr_) * PW + PC_Z + h * HD + fp_ * 16), z1 = *(const v4u*)(proj + (row0 + fr_) * PW + PC_Z + h * HD + fp_ * 16 + 8);
        const float eg = __uint_as_float(__hip_atomic_load((const unsigned*)egl + (size_t)bh * 32 + c, __ATOMIC_RELAXED, __HIP_MEMORY_SCOPE_AGENT));
        dn_bf16x8 SB[4];
#pragma unroll
        for (int s = 0; s < 4; ++s) SB[s] = pack8f(Sacc[2 * s], Sacc[2 * s + 1]);
        f32x4 VN[4], O[4];
#pragma unroll
        for (int ct = 0; ct < 4; ++ct) { const dn_u32x2 uu = *(const LAS dn_u32x2*)(L + S_UT + (n0 + m) * 144 + (16 * ct + 4 * g) * 2);
            VN[ct] = (f32x4){bflo(uu.x), bfhi(uu.x), bflo(uu.y), bfhi(uu.y)}; O[ct] = (f32x4){0.f, 0.f, 0.f, 0.f};
#pragma unroll
            for (int s = 0; s < 4; ++s) { VN[ct] = mfma16(*(const LAS dn_bf16x8*)(L + S_WN + (16 * ct + m) * 272 + (32 * s + 8 * g) * 2), SB[s], VN[ct]);
                O[ct] = mfma16(*(const LAS dn_bf16x8*)(L + S_QG + (16 * ct + m) * 272 + (32 * s + 8 * g) * 2), SB[s], O[ct]); } }
        dn_bf16x8 VNB[2];
#pragma unroll
        for (int sp = 0; sp < 2; ++sp) VNB[sp] = pack8f(VN[2 * sp], VN[2 * sp + 1]);
#pragma unroll
        for (int ct = 0; ct < 4; ++ct)
#pragma unroll
            for (int sp = 0; sp < 2; ++sp) O[ct] = mfma16(*(const LAS dn_bf16x8*)(L + S_QKM + (16 * ct + m) * 144 + (32 * sp + 8 * g) * 2), VNB[sp], O[ct]);
#pragma unroll
        for (int kt = 0; kt < 8; ++kt) { Sacc[kt] = Sacc[kt] * eg;
#pragma unroll
            for (int sp = 0; sp < 2; ++sp) Sacc[kt] = mfma16(*(const LAS dn_bf16x8*)(L + S_KDT + (16 * kt + m) * 144 + (32 * sp + 8 * g) * 2), VNB[sp], Sacc[kt]); }
#pragma unroll
        for (int ct = 0; ct < 4; ++ct)
#pragma unroll
            for (int r = 0; r < 4; ++r) { const float x = O[ct][r]; OB[(16 * ct + 4 * g + r) * 132 + n0 + m] = x;
                float ss = x * x; ss += __shfl_xor(ss, 1); ss += __shfl_xor(ss, 2); ss += __shfl_xor(ss, 4); ss += __shfl_xor(ss, 8);
                if (m == 0) PSQ[wave * 64 + 16 * ct + 4 * g + r] = ss; }
        __syncthreads();
        if (c + 1 < SEQ / 64) DN_WRITE();
        { float ss = 0.f;
#pragma unroll
          for (int w = 0; w < 8; ++w) ss += PSQ[w * 64 + fr_];
          const float rn = rsqrtf(ss * (1.f / 128.f) + EPS);
          f32x4 o4[4], w4[4];
#pragma unroll
          for (int q = 0; q < 4; ++q) { o4[q] = *(const LAS f32x4*)(OB + fr_ * 132 + fp_ * 16 + 4 * q); w4[q] = *(const f32x4*)(onw + fp_ * 16 + 4 * q); }
          const unsigned zz[8] = {z0.x, z0.y, z0.z, z0.w, z1.x, z1.y, z1.z, z1.w}; unsigned ow[8];
#pragma unroll
          for (int q = 0; q < 8; ++q) { const float za = bflo(zz[q]), zb = bfhi(zz[q]);
              const float a = o4[q >> 1][2 * (q & 1)] * rn * w4[q >> 1][2 * (q & 1)] * (za / (1.f + __expf(-za)));
              const float bq = o4[q >> 1][2 * (q & 1) + 1] * rn * w4[q >> 1][2 * (q & 1) + 1] * (zb / (1.f + __expf(-zb)));
              ow[q] = pkbf(a, bq); }
          bf16* dst = proj + (row0 + fr_) * PW + PC_Q + h * HD + fp_ * 16;
          *(v4u*)dst = (v4u){ow[0], ow[1], ow[2], ow[3]}; *(v4u*)(dst + 8) = (v4u){ow[4], ow[5], ow[6], ow[7]}; }
        __syncthreads();
    }
#undef DN_LOAD
#undef DN_WRITE
}
__device__ __forceinline__ void norm_heads(int lane, bf16* rowp, int nheads, const float* ssq, size_t hb_stride, const float* w) {
    if (lane < 8 * nheads) { const int head = lane >> 3, d0 = (lane & 7) * 16;
        const f32x4 s4 = *(const f32x4*)(ssq + (size_t)head * hb_stride);
        const float r = rsqrtf(((s4[0] + s4[1]) + (s4[2] + s4[3])) * (1.f / 128.f) + EPS);
        bf16* p = rowp + head * HD + d0;
        const v4u a = *(const v4u*)p, b = *(const v4u*)(p + 8);
        const f32x4 w0 = *(const f32x4*)(w + d0), w1 = *(const f32x4*)(w + d0 + 4), w2 = *(const f32x4*)(w + d0 + 8), w3 = *(const f32x4*)(w + d0 + 12);
        v4u oa, ob;
        oa.x = pkbf(bflo(a.x) * r * w0[0], bfhi(a.x) * r * w0[1]); oa.y = pkbf(bflo(a.y) * r * w0[2], bfhi(a.y) * r * w0[3]);
        oa.z = pkbf(bflo(a.z) * r * w1[0], bfhi(a.z) * r * w1[1]); oa.w = pkbf(bflo(a.w) * r * w1[2], bfhi(a.w) * r * w1[3]);
        ob.x = pkbf(bflo(b.x) * r * w2[0], bfhi(b.x) * r * w2[1]); ob.y = pkbf(bflo(b.y) * r * w2[2], bfhi(b.y) * r * w2[3]);
        ob.z = pkbf(bflo(b.z) * r * w3[0], bfhi(b.z) * r * w3[1]); ob.w = pkbf(bflo(b.w) * r * w3[2], bfhi(b.w) * r * w3[3]);
        *(v4u*)p = oa; *(v4u*)(p + 8) = ob; }
}
__device__ __forceinline__ void norm_pass(const Frame& F, int layer) {
    const Tix T = tix(F.wv); const int gw = F.bid * NWAVES + T.wave, NGW = F.G * NWAVES;
    bf16* proj = (bf16*)(F.ws + WS_PROJ); const float* ssq = (const float*)(F.ws + WS_SSQ); const size_t hbs = (size_t)MROWS * 4;
    for (int m = gw; m < MROWS; m += NGW) {
        if (layer == 1) { norm_heads(T.lane, proj + (size_t)m * PW + PC_K, 8, ssq + (size_t)m * 4, hbs, F.in[I_FOXKNW]);
                          norm_heads(T.lane, proj + (size_t)m * PW + PC_Q, 8, ssq + 24 * hbs + (size_t)m * 4, hbs, F.in[I_FOXQNW]); }
        norm_heads(T.lane, proj + (size_t)m * PW + PC_QM, 4, ssq + 32 * hbs + (size_t)m * 4, hbs, F.in[I_MEMQNW] + layer * HD);
    }
    if (layer == 0) for (int m = gw; m < MMEM; m += NGW)
        norm_heads(T.lane, (bf16*)(F.ws + WS_MEMKV) + (size_t)m * DM, 4, (const float*)(F.ws + WS_MSSQ) + (size_t)m * 4, (size_t)MMEM * 4, F.in[I_MEMKNW]);
}
__device__ __forceinline__ void fox_blk(const Frame& F, int it, int j, att::Blk& k) {
    const int bh = it >> 2, y = it & 3, qb = j == 0 ? y : 7 - y, b = bh >> 3, h = bh & 7; const size_t row0 = (size_t)b * SEQ + qb * 256;
    bf16* proj = (bf16*)(F.ws + WS_PROJ);
    k.Q = proj + row0 * PW + PC_Q + h * HD; k.K = proj + (size_t)b * SEQ * PW + PC_K + h * HD; k.voff = PC_V - PC_K; k.goff = PC_Z - PC_Q;
    k.fcum = (const float*)(F.ws + WS_FCUM) + (size_t)bh * SEQ; k.P0 = qb * 256; k.skv = SEQ; k.kvpitch = PW;
}
__device__ __forceinline__ void mem_blk(const Frame& F, int idx, att::Blk& k) {
    const int b = idx >> 5, hm = (idx >> 3) & 3, qb = idx & 7; const size_t row0 = (size_t)b * SEQ + qb * 256;
    bf16* proj = (bf16*)(F.ws + WS_PROJ); const bf16* mkv = (const bf16*)(F.ws + WS_MEMKV);
    static_assert(att::QP == PW, "attention Q pitch");
    k.Q = proj + row0 * PW + PC_QM + hm * HD; k.K = mkv + (size_t)b * NMEM * DM + hm * HD; k.voff = 512; k.goff = 0;
    k.fcum = nullptr; k.P0 = 1 << 20; k.skv = NMEM; k.kvpitch = DM;
}
struct SrcL1 { const Frame* F; int vcu;
    __device__ __forceinline__ bool operator()(int n, att::Blk& k) const { const int it = vcu + (n / 3) * F->G, j = n % 3; if (it >= 256) return false;
        if (j < 2) fox_blk(*F, it, j, k); else mem_blk(*F, it, k); return true; } };
struct SrcL0 { const Frame* F; int first, stride;
    __device__ __forceinline__ bool operator()(int n, att::Blk& k) const { const int idx = first + n * stride; if (idx >= 256) return false; mem_blk(*F, idx, k); return true; } };
__device__ __forceinline__ void fcum_unit(const Frame& F, int bh) {
    const Tix T = tix(F.wv); const int b = bh >> 3, h = bh & 7, tid = T.tid, lane = T.lane, wave = T.wave;
    const float* AB = (const float*)(F.ws + WS_AB); const float fb = F.in[I_FOXFB][h];
    LAS float* wt = (LAS float*)F.lds;
    float f[4];
#pragma unroll
    for (int e = 0; e < 4; ++e) { const float x = AB[((size_t)b * SEQ + tid * 4 + e) * 16 + h] + fb; f[e] = fminf(x, 0.f) - log1pf(__expf(-fabsf(x))); }
    f[1] += f[0]; f[2] += f[1]; f[3] += f[2];
    float sc = f[3];
#pragma unroll
    for (int o = 1; o < 64; o <<= 1) { const float t = __shfl_up(sc, o); if (lane >= o) sc += t; }
    __syncthreads();
    if (lane == 63) wt[wave] = sc;
    __syncthreads();
    float off = sc - f[3];
    for (int w = 0; w < wave; ++w) off += wt[w];
    float* out = (float*)(F.ws + WS_FCUM) + (size_t)bh * SEQ + tid * 4;
    *(f32x4*)out = (f32x4){f[0] + off, f[1] + off, f[2] + off, f[3] + off};
    __syncthreads();
}

#define IN(k) (lo <= (k) && (k) < hi)
#define SEAM(k) do { if (IN(k) && IN((k) + 1)) xcd_barrier(bar); } while (0)
template <int layer> __device__ __forceinline__ void layer_body(const Frame& F, const XcdBarrier& bar, int lo, int hi, unsigned char* lds) {
    bf16* proj = (bf16*)(F.ws + WS_PROJ); bf16* xb = (bf16*)(F.ws + WS_XB); float* xsq = (float*)(F.ws + WS_XSQ);
    float* ssq = (float*)(F.ws + WS_SSQ); float* ab = (float*)(F.ws + WS_AB);

        const int pb = 1 + (layer ? 6 : 0);
        if (IN(pb)) {
            pg8::Gemm g{xb, (const bf16*)(F.ws + (layer ? WS_WIN1 : WS_WIN0)), MROWS, N_IN, DM, DM}; pg8::StaticOrder S; S.init(MROWS, N_IN, F.G, F.bid);
            pg8::EpiProj<true, false, layer == 0> E{proj, PW, xsq, ssq, MROWS, ab, 18, (bf16*)((unsigned char*)F.out + DO_HALO)};
            pg8::gemm_phase<pg8::EpiProj<true, false, layer == 0>, pg8::StaticOrder, true, true>(F.lds, g, S, E, F.wv);
            if (layer == 0) {
                pg8::Gemm g2{(const bf16*)((unsigned char*)F.out + DO_MEMB), (const bf16*)(F.ws + WS_WMKV), MMEM, DM, DM, DM}; pg8::StaticOrder S2; S2.init(MMEM, DM, F.G, F.G - 1 - F.bid);
                pg8::EpiProj<true, false> E2{(bf16*)(F.ws + WS_MEMKV), DM, (const float*)(F.ws + WS_MSQ), (float*)(F.ws + WS_MSSQ), MMEM, nullptr, 4, nullptr};
                pg8::gemm_phase<pg8::EpiProj<true, false>, pg8::StaticOrder, true, true>(F.lds, g2, S2, E2, F.wv);
            }
        }
        SEAM(pb);
        const int pm = pb + 2;
        if (IN(pb + 1)) { if (layer == 1) for (int bh = F.bid; bh < 64; bh += F.G) fcum_unit(F, bh);
                          norm_pass(F, layer);
                          if (layer == 0) for (int u = F.bid; u < BATCH * NH * (SEQ / 64); u += F.G) dn_prep_unit(F, u); }
        SEAM(pb + 1);
        if (IN(pm)) {
            if (layer == 0) {
                if (F.G > 64) { if (F.bid < 64) dn_scan_unit(F, F.bid); else { const SrcL0 src{&F, F.bid - 64, F.G - 64}; att::phase((char*)lds, src, F.wv); } }
                else { for (int bh = F.bid; bh < 64; bh += F.G) dn_scan_unit(F, bh); const SrcL0 src{&F, F.bid, F.G}; att::phase((char*)lds, src, F.wv); }
            } else {
                const int vcu = (F.G % 8 == 0) ? (F.bid % 8) * (F.G / 8) + F.bid / 8 : F.bid;
                const SrcL1 src{&F, vcu}; att::phase((char*)lds, src, F.wv);
            }
            __syncthreads();
        }
        SEAM(pm);
        if (IN(pm + 1)) {
            pg8::Gemm g{proj + PC_Q, (const bf16*)(F.ws + (layer ? WS_WOUT1 : WS_WOUT0)), MROWS, DM, OUT_IN, PW}; pg8::StaticOrder S; S.init(MROWS, DM, F.G, F.bid);
            pg8::EpiRes E{layer ? (const float*)F.out : F.in[I_X], F.out, xb, xsq};
            pg8::gemm_phase<pg8::EpiRes, pg8::StaticOrder, true, true>(F.lds, g, S, E, F.wv);
        }
        SEAM(pm + 1);
        if (IN(pm + 2)) {
            pg8::Gemm g{xb, (const bf16*)(F.ws + (layer ? WS_WM1_1 : WS_WM1_0)), MROWS, FF, DM, DM}; pg8::StaticOrder S; S.init(MROWS, FF, F.G, F.bid);
            pg8::EpiProj<false, true> E{proj, FF, xsq, nullptr, 0, nullptr, 16, nullptr};
            pg8::gemm_phase<pg8::EpiProj<false, true>, pg8::StaticOrder, true, true>(F.lds, g, S, E, F.wv);
        }
        SEAM(pm + 2);
        if (IN(pm + 3)) {
            pg8::Gemm g{proj, (const bf16*)(F.ws + (layer ? WS_WM2_1 : WS_WM2_0)), MROWS, DM, FF, FF}; pg8::StaticOrder S; S.init(MROWS, DM, F.G, F.bid);
            pg8::EpiRes E{(const float*)F.out, F.out, xb, xsq};
            pg8::gemm_phase<pg8::EpiRes, pg8::StaticOrder, true, true>(F.lds, g, S, E, F.wv);
        }
        SEAM(pm + 3);
    }
#undef IN
#undef SEAM
__global__ void __launch_bounds__(NWAVES * 64, 2) hyb_fwd(Args args) {
    extern __shared__ __attribute__((aligned(16))) unsigned char lds[];
    Frame F;
    F.lds = (LAS unsigned char*)lds;
    F.G = gridDim.x; F.bid = blockIdx.x; F.in = args.in; F.out = args.out; F.ws = args.ws; F.wv = __builtin_amdgcn_readfirstlane((int)threadIdx.x >> 6);
    volatile LAS unsigned* MISC = (volatile LAS unsigned*)(F.lds + MISC_OFF);
    gu32* ctl = (gu32*)(args.ws + WS_CTL);
    for (int u = threadIdx.x; u < (LDS_BYTES - MISC_OFF) / 4; u += NWAVES * 64) ((LAS unsigned*)(F.lds + MISC_OFF))[u] = 0u;
    __syncthreads();
    XcdBarrier bar; bar.bar = (unsigned*)(ctl + CW_BAR) + args.li * XCD_BAR_WORDS; bar.x = 0; bar.st = nullptr; bar.wv = F.wv;
    if (!MK_LAUNCH_PER_PHASE) { bar = xcd_barrier_post((unsigned*)(ctl + CW_BAR) + args.li * XCD_BAR_WORDS, MISC + 8); bar.wv = F.wv; }
    const int lo = args.ph_lo, hi = args.ph_hi;
#define IN(k) (lo <= (k) && (k) < hi)
#define SEAM(k) do { if (IN(k) && IN((k) + 1)) xcd_barrier(bar); } while (0)
    bf16* proj = (bf16*)(F.ws + WS_PROJ); bf16* xb = (bf16*)(F.ws + WS_XB); float* xsq = (float*)(F.ws + WS_XSQ);
    float* ssq = (float*)(F.ws + WS_SSQ); float* ab = (float*)(F.ws + WS_AB);

    if (IN(0)) { p0_prologue(F); } SEAM(0);

    layer_body<0>(F, bar, lo, hi, lds);
    layer_body<1>(F, bar, lo, hi, lds);
#undef IN
#undef SEAM
}

extern "C" void kernel_launch(void* const* d_in, const int* in_sizes, int n_in, void* d_out, int out_size, void* d_ws, size_t ws_size, hipStream_t stream) {
    static int grid = 0;
    if (grid == 0) {
        if (n_in != 20 || in_sizes[0] != MROWS * DM || out_size != MROWS * DM || ws_size < WS_END) {
            fprintf(stderr, "kernel_launch: shape/workspace mismatch (n_in %d, in0 %d, out %d, ws %zu; need ws >= %zu); nothing launched\n", n_in, n_in > 0 ? in_sizes[0] : -1, out_size, ws_size, (size_t)WS_END); grid = -1; return; }
        int dev = 0, cus = 0, per_cu = 0;
        if (hipGetDevice(&dev) != hipSuccess || hipDeviceGetAttribute(&cus, hipDeviceAttributeMultiprocessorCount, dev) != hipSuccess) { fprintf(stderr, "kernel_launch: device query failed\n"); grid = -1; return; }
        if (hipFuncSetAttribute((const void*)hyb_fwd, hipFuncAttributeMaxDynamicSharedMemorySize, LDS_BYTES) != hipSuccess) { fprintf(stderr, "kernel_launch: hipFuncSetAttribute failed\n"); grid = -1; return; }
        if (hipOccupancyMaxActiveBlocksPerMultiprocessor(&per_cu, (const void*)hyb_fwd, NWAVES * 64, LDS_BYTES) != hipSuccess || per_cu < 1) {
            fprintf(stderr, "kernel_launch: occupancy query reports %d workgroups per CU; nothing launched\n", per_cu); (void)hipGetLastError(); grid = -1; return; }
        grid = cus;
    }
    if (grid < 0) return;
    if (hipMemsetAsync((char*)d_ws + WS_CTL, 0, CTL_ZERO_BYTES, stream) != hipSuccess) { fprintf(stderr, "kernel_launch: memset failed\n"); return; }
    Args a{};
    for (int i = 0; i < 20; ++i) a.in[i] = (const float*)d_in[i];
    a.out = (float*)d_out; a.ws = (unsigned char*)d_ws;
#if MK_LAUNCH_PER_PHASE
    for (int p = 0; p < N_PHASES; ++p) { a.ph_lo = p; a.ph_hi = p + 1; a.li = 0; hipLaunchKernelGGL(hyb_fwd, dim3(grid), dim3(NWAVES * 64), LDS_BYTES, stream, a); }
#else
    a.ph_lo = 0; a.ph_hi = N_PHASES; a.li = 0;
    hipLaunchKernelGGL(hyb_fwd, dim3(grid), dim3(NWAVES * 64), LDS_BYTES, stream, a);
#endif
    const hipError_t le = hipPeekAtLastError();
    if (le != hipSuccess) fprintf(stderr, "kernel_launch: launch failed: %s\n", hipGetErrorName(le));
}
```

```cpp
#include <hip/hip_runtime.h>
#include <cstdio>
#include <cstdint>

constexpr int BATCH = 8, SEQ = 2048, DM = 1024, MROWS = BATCH * SEQ;
constexpr int NMEM = 256, MMEM = BATCH * NMEM;
constexpr int HD = 128, NH = 8, NMH = 4, FF = 4096;
constexpr int PW = 4608;
constexpr int PC_K = 0, PC_V = 1024, PC_Z = 2048, PC_Q = 3072, PC_QM = 4096, PC_AB = 4608;
constexpr int N_IN = 4864;
constexpr int DN_IN = 4624, FOX_IN = 4616, OUT_IN = 1536;
constexpr float EPS = 1e-6f;
constexpr float QSCALE = 0.08838834764831845f;

template <int CTRL> __device__ __forceinline__ float dppf(float x) { return __builtin_bit_cast(float, __builtin_amdgcn_update_dpp(0, __builtin_bit_cast(int, x), CTRL, 0xf, 0xf, true)); }
__device__ __forceinline__ float row16_sum(float x) { x += dppf<0xB1>(x); x += dppf<0x4E>(x); x += dppf<0x141>(x); x += dppf<0x140>(x); return x; }
__device__ __forceinline__ float add_xor16(float x) { auto r = __builtin_amdgcn_permlane16_swap(__float_as_uint(x), __float_as_uint(x), false, false); return __uint_as_float(r[0]) + __uint_as_float(r[1]); }
__device__ __forceinline__ float add_xor32(float x) { auto r = __builtin_amdgcn_permlane32_swap(__float_as_uint(x), __float_as_uint(x), false, false); return __uint_as_float(r[0]) + __uint_as_float(r[1]); }
namespace pg8 {
#define PG8_LAS __attribute__((address_space(3)))
typedef unsigned short bf16_t;
typedef short bf16x8 __attribute__((ext_vector_type(8)));
typedef float f32x4 __attribute__((ext_vector_type(4)));
typedef unsigned u32x4 __attribute__((ext_vector_type(4)));
constexpr int BM = 256, BK = 64, HALF = 128, HTB = HALF * BK * 2  , STAGE_BYTES = 8 * HTB, NXCD = 8, WGM = 8;

__host__ __device__ __forceinline__ int lds_byte(int r, int c) { const int st = (r >> 4) * 2 + (c >> 5), rr = r & 15, cc = c & 31, ob = rr * 64 + cc * 2; return st * 1024 + (ob ^ (((ob >> 9) & 1) << 5)); }
__host__ __device__ __forceinline__ void stage_rc(int b, int& R, int& C) { const int st = b / 1024, sb = b % 1024, swz = sb ^ (((sb >> 9) & 1) << 5); R = (st >> 1) * 16 + swz / 64; C = (st & 1) * 32 + (swz % 64) / 2; }
__host__ __device__ __forceinline__ int perm32(int rho) { const int n = rho >> 4, i = rho & 15; return 8 * (i >> 2) + 4 * n + (i & 3); }

struct Unit { int pm, pn; };
struct Gemm { const bf16_t* A; const bf16_t* Bt; int M, N, K, lda; };

struct StaticOrder {
    int nM, nN, nwg, G, c;
    __host__ __device__ void init(int M, int N, int G_, int c_) { nM = M / BM; nN = N / BM; nwg = nM * nN; G = G_; c = c_; }
    __host__ __device__ bool next(int i, Unit& u) const {
        const long L = (long)i * G + c; if (L >= nwg) return false;
        int wgid = (int)L; { const int q = nwg / NXCD, r = nwg % NXCD, xcd = wgid % NXCD, off = wgid / NXCD; wgid = (xcd < r ? xcd * (q + 1) : r * (q + 1) + (xcd - r) * q) + off; }
        const int nig = WGM * nN, gid = wgid / nig, fm = gid * WGM, gsz = (nM - fm) < WGM ? (nM - fm) : WGM;
        u.pm = fm + ((wgid % nig) % gsz); u.pn = (wgid % nig) / gsz; return true;
    }
    __device__ __forceinline__ void a_ready(const Unit&) const {}
    __device__ __forceinline__ void done(const Unit&) const {}
};


__device__ __forceinline__ unsigned cvt_pk_bf16(float lo, float hi) { unsigned r; asm volatile("v_cvt_pk_bf16_f32 %0, %1, %2" : "=v"(r) : "v"(lo), "v"(hi)); return r; }

template <bool SSQ, bool RELU2, bool HALO = false> struct EpiProj {
    static constexpr bool PERM = true, AFTER_DRAIN = false;
    bf16_t* O; int ldc; const float* xsq; float* ssq; int ssq_rows; float* ab; int n_main; bf16_t* halo;
    __device__ __forceinline__ void operator()(const f32x4 (&acc)[2][2][4][2], const Unit& u, int wr, int wc, int fr, int fq) const {
        const int row0 = u.pm * BM + wr * 64 + fr, colt = u.pn * BM;
        const bool is_ab = u.pn >= n_main;
#pragma unroll
        for (int ai = 0; ai < 2; ++ai)
#pragma unroll
            for (int m = 0; m < 4; ++m) {
                const int r = row0 + ai * HALF + m * 16;
                const f32x4 q4 = *(const f32x4*)(xsq + (size_t)r * 16 + 4 * fq);
                float s = (q4[0] + q4[1]) + (q4[2] + q4[3]);
                s = add_xor32(add_xor16(s));
                const float rstd = rsqrtf(s * (1.0f / 1024.0f) + 1e-6f);
                if (!is_ab) {
#pragma unroll
                    for (int bj = 0; bj < 2; ++bj) {
                        f32x4 v0 = acc[ai][bj][m][0] * rstd, v1 = acc[ai][bj][m][1] * rstd;
                        if (SSQ) {
                            float ss = ((v0[0] * v0[0] + v0[1] * v0[1]) + (v0[2] * v0[2] + v0[3] * v0[3])) + ((v1[0] * v1[0] + v1[1] * v1[1]) + (v1[2] * v1[2] + v1[3] * v1[3]));
                            ss = add_xor32(add_xor16(ss));
                            if (fq == 0) ssq[((size_t)((colt >> 7) + bj) * ssq_rows + r) * 4 + wc] = ss;
                        }
                        if (RELU2) {
#pragma unroll
                            for (int e = 0; e < 4; ++e) { const float a = fmaxf(v0[e], 0.f), b = fmaxf(v1[e], 0.f); v0[e] = a * a; v1[e] = b * b; }
                        }
                        u32x4 w; w.x = cvt_pk_bf16(v0[0], v0[1]); w.y = cvt_pk_bf16(v0[2], v0[3]); w.z = cvt_pk_bf16(v1[0], v1[1]); w.w = cvt_pk_bf16(v1[2], v1[3]);
                        *(u32x4*)(O + (size_t)r * ldc + colt + bj * HALF + wc * 32 + 8 * fq) = w;
                        if (HALO && m == 3 && fr >= 13) *(u32x4*)(halo + ((size_t)(r >> 6) * 3 + ((r & 63) - 61)) * ldc + colt + bj * HALF + wc * 32 + 8 * fq) = w;
                    }
                } else if (ab != nullptr && wc == 0 && fq < 2) {
                    float* p = ab + (size_t)r * 16 + 8 * fq;
                    *(f32x4*)p = acc[ai][0][m][0] * rstd; *(f32x4*)(p + 4) = acc[ai][0][m][1] * rstd;
                }
            }
    }
};
struct EpiRes {
    static constexpr bool PERM = true, AFTER_DRAIN = false;
    const float* xold; float* xnew; bf16_t* xb; float* xsq;
    __device__ __forceinline__ void operator()(const f32x4 (&acc)[2][2][4][2], const Unit& u, int wr, int wc, int fr, int fq) const {
        const int row0 = u.pm * BM + wr * 64 + fr, colt = u.pn * BM;
#pragma unroll
        for (int ai = 0; ai < 2; ++ai)
#pragma unroll
            for (int m = 0; m < 4; ++m) {
                const int r = row0 + ai * HALF + m * 16; float ss = 0.f;
#pragma unroll
                for (int bj = 0; bj < 2; ++bj) {
                    const size_t off = (size_t)r * 1024 + colt + bj * HALF + wc * 32 + 8 * fq;
                    const f32x4 v0 = acc[ai][bj][m][0] + *(const f32x4*)(xold + off), v1 = acc[ai][bj][m][1] + *(const f32x4*)(xold + off + 4);
                    *(f32x4*)(xnew + off) = v0; *(f32x4*)(xnew + off + 4) = v1;
                    ss += ((v0[0] * v0[0] + v0[1] * v0[1]) + (v0[2] * v0[2] + v0[3] * v0[3])) + ((v1[0] * v1[0] + v1[1] * v1[1]) + (v1[2] * v1[2] + v1[3] * v1[3]));
                    u32x4 w; w.x = cvt_pk_bf16(v0[0], v0[1]); w.y = cvt_pk_bf16(v0[2], v0[3]); w.z = cvt_pk_bf16(v1[0], v1[1]); w.w = cvt_pk_bf16(v1[2], v1[3]);
                    *(u32x4*)(xb + off) = w;
                }
                ss = add_xor32(add_xor16(ss));
                if (fq == 0) xsq[(size_t)r * 16 + u.pn * 4 + wc] = ss;
            }
    }
};

template <class Epi, class Sched, bool ALIGN_EPI = false, bool SP2 = false>
__device__ __forceinline__ void gemm_phase(PG8_LAS unsigned char* lds, const Gemm g, const Sched& S, const Epi& E, int wid) {
    int lane = (int)__builtin_amdgcn_mbcnt_hi(~0u, __builtin_amdgcn_mbcnt_lo(~0u, 0u)); asm volatile("" : "+v"(lane));
    const int tid = wid * 64 + lane, wr = wid >> 2, wc = wid & 3, fr = lane & 15, fq = lane >> 4;
    const int K = g.K, nt = K / BK;
    unsigned voffA[2], voffB[2];
#pragma unroll
    for (int i = 0; i < 2; ++i) { int R, C; stage_rc(tid * 16 + i * 8192, R, C); const int Rb = Epi::PERM ? ((R & ~31) + perm32(R & 31)) : R;
        voffA[i] = (unsigned)(R * g.lda + C) * 2u; voffB[i] = (unsigned)(Rb * K + C) * 2u; }
    const size_t kstep = (size_t)(BK * 2);
    const size_t hstepA = (size_t)HALF * g.lda * 2, hstepB = (size_t)HALF * K * 2;
    const size_t tstepA = 2 * hstepA, tstepB = 2 * hstepB;
    const unsigned ldsw = (unsigned)wid * 1024u;
    const int aoff = lds_byte(wr * 64 + fr, fq * 8), boff = lds_byte(wc * 32 + fr, fq * 8);
#define PG8_SA(b, h) (((b) * 2 + (h)) * HTB)
#define PG8_SB(b, h) ((4 + (b) * 2 + (h)) * HTB)
#define PG8_STAGE(bufoff, gbase, voff) do { _Pragma("unroll") for (int _i = 0; _i < 2; ++_i) \
        __builtin_amdgcn_global_load_lds((const unsigned*)((const char*)(gbase) + (voff)[_i]), (PG8_LAS unsigned*)(lds + (bufoff) + ldsw + _i * 8192), 16, 0, 0); } while (0)
#define PG8_LDA(dst, b, h) do { _Pragma("unroll") for (int m = 0; m < 4; ++m) _Pragma("unroll") for (int k = 0; k < 2; ++k) dst[m][k] = *(const PG8_LAS bf16x8*)(lds + PG8_SA(b, h) + aoff + m * 2048 + k * 1024); } while (0)
#define PG8_LDB(dst, b, h) do { _Pragma("unroll") for (int n = 0; n < 2; ++n) _Pragma("unroll") for (int k = 0; k < 2; ++k) dst[n][k] = *(const PG8_LAS bf16x8*)(lds + PG8_SB(b, h) + boff + n * 2048 + k * 1024); } while (0)
#define PG8_MMA(ai, bj, At, Bt) do { __builtin_amdgcn_s_setprio(1); _Pragma("unroll") for (int m = 0; m < 4; ++m) _Pragma("unroll") for (int n = 0; n < 2; ++n) _Pragma("unroll") for (int k = 0; k < 2; ++k) \
        acc[ai][bj][m][n] = __builtin_amdgcn_mfma_f32_16x16x32_bf16(Bt[n][k], At[m][k], acc[ai][bj][m][n], 0, 0, 0); __builtin_amdgcn_s_setprio(0); } while (0)
#define PG8_WAIT_V(n) asm volatile("s_waitcnt vmcnt(" #n ")" ::: "memory")
#define PG8_WAIT_L(n) asm volatile("s_waitcnt lgkmcnt(" #n ")" ::: "memory")
#define PG8_BAR __builtin_amdgcn_s_barrier()
#define PG8_SCHED __builtin_amdgcn_sched_barrier(0)
    Unit cur, nxt; int ui = 0;
    if (!S.next(0, cur)) return;
    f32x4 acc[2][2][4][2];
#pragma unroll
    for (int a = 0; a < 2; ++a)
#pragma unroll
        for (int b = 0; b < 2; ++b)
#pragma unroll
            for (int m = 0; m < 4; ++m)
#pragma unroll
                for (int n = 0; n < 2; ++n) acc[a][b][m][n] = (f32x4){0.f, 0.f, 0.f, 0.f};
    bf16x8 At[4][2], B0[2][2], B1[2][2];
    const char* cA = (const char*)g.A + (size_t)cur.pm * tstepA; const char* cB = (const char*)g.Bt + (size_t)cur.pn * tstepB;
    S.a_ready(cur);
    if constexpr (SP2) {
        PG8_STAGE(PG8_SB(0, 0), cB, voffB); PG8_STAGE(PG8_SB(0, 1), cB + hstepB, voffB); PG8_STAGE(PG8_SA(0, 0), cA, voffA); PG8_STAGE(PG8_SA(0, 1), cA + hstepA, voffA);
        if (wr == 1) PG8_BAR;
        PG8_WAIT_V(2); PG8_BAR;
        PG8_STAGE(PG8_SB(1, 0), cB + kstep, voffB); PG8_STAGE(PG8_SA(1, 0), cA + kstep, voffA); PG8_STAGE(PG8_SB(1, 1), cB + hstepB + kstep, voffB);
        PG8_WAIT_V(6); PG8_BAR;
    } else {
        PG8_STAGE(PG8_SB(0, 0), cB, voffB); PG8_STAGE(PG8_SA(0, 0), cA, voffA); PG8_STAGE(PG8_SB(0, 1), cB + hstepB, voffB); PG8_STAGE(PG8_SA(0, 1), cA + hstepA, voffA);
        if (wr == 1) PG8_BAR;
        PG8_WAIT_V(4); PG8_BAR;
        PG8_STAGE(PG8_SB(1, 0), cB + kstep, voffB); PG8_STAGE(PG8_SA(1, 0), cA + kstep, voffA); PG8_STAGE(PG8_SB(1, 1), cB + hstepB + kstep, voffB);
        PG8_WAIT_V(6); PG8_BAR;
    }
    for (;;) {
        const bool has_next = S.next(ui + 1, nxt);
        const char* nA = has_next ? (const char*)g.A + (size_t)nxt.pm * tstepA : cA; const char* nB = has_next ? (const char*)g.Bt + (size_t)nxt.pn * tstepB : cB;
        for (int t = 0; t < nt; t += 2) {
            const bool last = (t == nt - 2);
            const char* a1 = cA + (size_t)(t + 1) * kstep;
            const char* a2 = last ? nA : cA + (size_t)(t + 2) * kstep; const char* b2 = last ? nB : cB + (size_t)(t + 2) * kstep;
            const char* a3 = a2 + kstep; const char* b3 = b2 + kstep;
            if (last && has_next) S.a_ready(nxt);
            if constexpr (SP2) {
            PG8_LDB(B0, 0, 0); PG8_LDB(B1, 0, 1); PG8_SCHED; PG8_LDA(At, 0, 0); PG8_STAGE(PG8_SA(1, 1), a1 + hstepA, voffA);
            PG8_WAIT_V(8); PG8_WAIT_L(0); PG8_BAR; PG8_MMA(0, 0, At, B0); PG8_MMA(0, 1, At, B1); PG8_BAR; PG8_SCHED;
            PG8_LDA(At, 0, 1); PG8_STAGE(PG8_SB(0, 0), b2, voffB); PG8_STAGE(PG8_SB(0, 1), b2 + hstepB, voffB); PG8_STAGE(PG8_SA(0, 0), a2, voffA);
            PG8_WAIT_V(8); PG8_WAIT_L(0); PG8_BAR; PG8_MMA(1, 0, At, B0); PG8_MMA(1, 1, At, B1); PG8_BAR; PG8_SCHED;
            PG8_LDB(B0, 1, 0); PG8_LDB(B1, 1, 1); PG8_SCHED; PG8_LDA(At, 1, 0); PG8_STAGE(PG8_SA(0, 1), a2 + hstepA, voffA);
            PG8_WAIT_V(8); PG8_WAIT_L(0); PG8_BAR; PG8_MMA(0, 0, At, B0); PG8_MMA(0, 1, At, B1); PG8_BAR; PG8_SCHED;
            PG8_LDA(At, 1, 1); PG8_STAGE(PG8_SB(1, 0), b3, voffB); PG8_STAGE(PG8_SB(1, 1), b3 + hstepB, voffB); PG8_STAGE(PG8_SA(1, 0), a3, voffA);
            PG8_WAIT_V(8); PG8_WAIT_L(0); PG8_BAR; PG8_MMA(1, 0, At, B0); PG8_MMA(1, 1, At, B1); PG8_BAR; PG8_SCHED;
            } else {
            PG8_LDB(B0, 0, 0); PG8_SCHED; PG8_LDA(At, 0, 0); PG8_STAGE(PG8_SA(1, 1), a1 + hstepA, voffA);
            PG8_WAIT_L(8); PG8_BAR; PG8_WAIT_L(0); PG8_MMA(0, 0, At, B0); PG8_BAR; PG8_SCHED;
            PG8_LDB(B1, 0, 1); PG8_STAGE(PG8_SB(0, 0), b2, voffB);
            PG8_BAR; PG8_WAIT_L(0); PG8_MMA(0, 1, At, B1); PG8_BAR;
            PG8_LDA(At, 0, 1); PG8_STAGE(PG8_SA(0, 0), a2, voffA);
            PG8_BAR; PG8_WAIT_L(0); PG8_MMA(1, 0, At, B0); PG8_BAR; PG8_SCHED;
            PG8_STAGE(PG8_SB(0, 1), b2 + hstepB, voffB);
            PG8_WAIT_V(6); PG8_BAR; PG8_MMA(1, 1, At, B1); PG8_BAR;
            PG8_LDB(B0, 1, 0); PG8_SCHED; PG8_LDA(At, 1, 0); PG8_STAGE(PG8_SA(0, 1), a2 + hstepA, voffA);
            PG8_WAIT_L(8); PG8_BAR; PG8_WAIT_L(0); PG8_MMA(0, 0, At, B0); PG8_BAR; PG8_SCHED;
            PG8_LDB(B1, 1, 1); PG8_STAGE(PG8_SB(1, 0), b3, voffB);
            PG8_BAR; PG8_WAIT_L(0); PG8_MMA(0, 1, At, B1); PG8_BAR;
            PG8_LDA(At, 1, 1); PG8_STAGE(PG8_SA(1, 0), a3, voffA);
            PG8_BAR; PG8_WAIT_L(0); PG8_MMA(1, 0, At, B0); PG8_BAR; PG8_SCHED;
            PG8_STAGE(PG8_SB(1, 1), b3 + hstepB, voffB);
            PG8_WAIT_V(6); PG8_BAR; PG8_MMA(1, 1, At, B1); PG8_BAR;
            }
        }
        if constexpr (ALIGN_EPI) { if (wr == 0) PG8_BAR; }
        if constexpr (!Epi::AFTER_DRAIN) { E(acc, cur, wr, wc, fr, fq); S.done(cur); }
        if (!has_next) break;
#pragma unroll
        for (int a = 0; a < 2; ++a)
#pragma unroll
            for (int b = 0; b < 2; ++b)
#pragma unroll
                for (int m = 0; m < 4; ++m)
#pragma unroll
                    for (int n = 0; n < 2; ++n) acc[a][b][m][n] = (f32x4){0.f, 0.f, 0.f, 0.f};
        cur = nxt; cA = nA; cB = nB; ++ui;
        if constexpr (ALIGN_EPI) { if (wr == 1) PG8_BAR; }
    }
    PG8_WAIT_V(0);
    if constexpr (!ALIGN_EPI) { if (wr == 0) PG8_BAR; }
    PG8_BAR;
    if constexpr (Epi::AFTER_DRAIN) { E.fused(acc, cur, wr, wc, fr, fq, lds, wid, lane); S.done(cur); }
#undef PG8_SA
#undef PG8_SB
#undef PG8_STAGE
#undef PG8_LDA
#undef PG8_LDB
#undef PG8_MMA
#undef PG8_WAIT_V
#undef PG8_WAIT_L
#undef PG8_BAR
#undef PG8_SCHED
}
}

namespace att {
typedef unsigned short bf16_t;
typedef short bf16x8 __attribute__((ext_vector_type(8)));
typedef short s16x4 __attribute__((ext_vector_type(4)));
typedef float f32x16 __attribute__((ext_vector_type(16)));
typedef float f32x4 __attribute__((ext_vector_type(4)));
typedef unsigned u32x4 __attribute__((ext_vector_type(4)));
constexpr int NW = 8, QBLK = 32, KVBLK = 64, QB = NW * QBLK, D = 128;
constexpr int SHM_V = KVBLK * D * 2, SHM_K = KVBLK * D * 2;
constexpr int OFF_WS = 2 * SHM_V + 2 * SHM_K, OFF_BK = OFF_WS + NW * 64 * 4, ATT_LDS = OFF_BK + 8192;
constexpr float SCALE = 0.08838834764831845f, THR = 8.f;
constexpr int WBIG = 1 << 30;
#define KSWZ(row, colB) ((row) * 256 + ((colB) ^ (((row) & 7) << 4)))
#define SBAR() __builtin_amdgcn_sched_barrier(0)
__device__ __forceinline__ int v_st(int k, int c) { const int kk = (k & ~0xC) | ((k & 4) << 1) | ((k & 8) >> 1); return ((kk >> 3) * 4 + (c >> 5)) * 512 + ((kk & 7) * 32 + (c & 31)) * 2; }
__device__ __forceinline__ int v_rd_base(int lane) { return ((lane & 3) << 3) | (((lane >> 2) & 3) << 6) | (((lane >> 4) & 1) << 5) | (((lane >> 5) & 1) << 8); }
constexpr int v_rd_off(int d0, int ks, int half) { return d0 * 512 + ks * 4096 + half * 2048; }
__device__ __forceinline__ int crow(int r, int hi) { return (r & 3) + 8 * (r >> 2) + 4 * hi; }
__device__ __forceinline__ unsigned cvtpk(float lo, float hi) { unsigned r; asm volatile("v_cvt_pk_bf16_f32 %0, %1, %2" : "=v"(r) : "v"(lo), "v"(hi)); return r; }
__device__ __forceinline__ bf16x8 load8(const bf16_t* p) { return *reinterpret_cast<const bf16x8*>(p); }
__device__ __forceinline__ void mask_tile(f32x16& p0, f32x16& p1, int dq, unsigned W) {
    const float NEG = -__builtin_inff();
#pragma unroll
    for (int r = 0; r < 16; ++r) { const int c = (r & 3) + 8 * (r >> 2);
        if ((unsigned)(dq - c) >= W) p0[r] = NEG;
        if ((unsigned)(dq - c - 32) >= W) p1[r] = NEG; }
}
__device__ __forceinline__ void partialSM(f32x16& p0, f32x16& p1, float& m_reg, float& mn, float& alpha) {
    float pmax = p0[0]; for (int r = 1; r < 16; ++r) pmax = fmaxf(pmax, p0[r]); for (int r = 0; r < 16; ++r) pmax = fmaxf(pmax, p1[r]);
    { auto rr = __builtin_amdgcn_permlane32_swap(__float_as_uint(pmax), __float_as_uint(pmax), false, false);
      pmax = fmaxf(__uint_as_float(rr[0]), __uint_as_float(rr[1])); }
    constexpr float C2 = 1.4426950408889634f * SCALE;
    if (__builtin_expect(__all((pmax - m_reg) * SCALE <= THR), 1)) { mn = m_reg; alpha = 1.f; }
    else { mn = fmaxf(m_reg, pmax); alpha = __builtin_amdgcn_exp2f((m_reg - mn) * C2); m_reg = mn; }
    const float mnL = -mn * C2;
    for (int r = 0; r < 16; ++r) p0[r] = fmaf(p0[r], C2, mnL); for (int r = 0; r < 16; ++r) p1[r] = fmaf(p1[r], C2, mnL);
    for (int r = 0; r < 16; ++r) p0[r] = __builtin_amdgcn_exp2f(p0[r]);
}
__device__ __forceinline__ void finishSM(f32x16& p0, f32x16& p1, float alpha, float& l_reg, bf16x8& pa0, bf16x8& pa1, bf16x8& pa2, bf16x8& pa3) {
    for (int r = 0; r < 16; ++r) p1[r] = __builtin_amdgcn_exp2f(p1[r]);
    float ps = 0; for (int r = 0; r < 16; ++r) ps += p0[r]; for (int r = 0; r < 16; ++r) ps += p1[r];
    { auto rr = __builtin_amdgcn_permlane32_swap(__float_as_uint(ps), __float_as_uint(ps), false, false);
      ps = __uint_as_float(rr[0]) + __uint_as_float(rr[1]); }
    l_reg = l_reg * alpha + ps;
#define PK4(P, B_, OUT) do { unsigned a0 = cvtpk(P[B_+0], P[B_+1]), a1 = cvtpk(P[B_+2], P[B_+3]);                          \
        unsigned b0 = cvtpk(P[B_+4], P[B_+5]), b1 = cvtpk(P[B_+6], P[B_+7]);                                             \
        auto r0 = __builtin_amdgcn_permlane32_swap(a0, b0, false, false); auto r1 = __builtin_amdgcn_permlane32_swap(a1, b1, false, false); \
        u32x4 w = {r0[0], r1[0], r0[1], r1[1]}; OUT = *reinterpret_cast<bf16x8*>(&w); } while (0)
    PK4(p0, 0, pa0); PK4(p0, 8, pa1); PK4(p1, 0, pa2); PK4(p1, 8, pa3);
#undef PK4
}
template <int KB>
__device__ __forceinline__ void qkt(f32x16& p0, f32x16& p1, const char* K_lds, int r32, int hi, const bf16x8* qr, const float* bb) {
#pragma unroll
    for (int g = 0; g < 4; ++g) { const f32x4 b0 = *(const f32x4*)(bb + 8 * g), b1 = *(const f32x4*)(bb + 32 + 8 * g);
#pragma unroll
        for (int i = 0; i < 4; ++i) { p0[4 * g + i] = b0[i]; p1[4 * g + i] = b1[i]; } }
    const char* kb[4];
#pragma unroll
    for (int dd = 0; dd < 4; ++dd) kb[dd] = K_lds + KB * SHM_K + KSWZ(r32, (dd * 16 + hi * 8) * 2);
#pragma unroll
    for (int d0 = 0; d0 < 8; ++d0) { const char* a = kb[d0 & 3] + (d0 >> 2) * 128;
        bf16x8 b0 = *reinterpret_cast<const bf16x8*>(a);
        bf16x8 b1 = *reinterpret_cast<const bf16x8*>(a + 32 * 256);
        p0 = __builtin_amdgcn_mfma_f32_32x32x16_bf16(b0, qr[d0], p0, 0, 0, 0);
        p1 = __builtin_amdgcn_mfma_f32_32x32x16_bf16(b1, qr[d0], p1, 0, 0, 0); }
}
template <int VB>
__device__ __forceinline__ void pv_tile(f32x16* o, int vb0, bf16x8 pa0, bf16x8 pa1, bf16x8 pa2, bf16x8 pa3) {
#define TRRD(dst, off) asm volatile("ds_read_b64_tr_b16 %0, %1 offset:%2" : "=&v"(dst) : "v"(vb0), "i"(off) : "memory")
#define PV_D0(d0) do { s16x4 l0, l1, l2, l3, h0, h1, h2, h3; constexpr int b_ = VB * SHM_V + v_rd_off(d0, 0, 0);   \
        TRRD(l0, b_); TRRD(h0, b_ + 2048); TRRD(l1, b_ + 4096); TRRD(h1, b_ + 6144); TRRD(l2, b_ + 8192); TRRD(h2, b_ + 10240); TRRD(l3, b_ + 12288); TRRD(h3, b_ + 14336); \
        asm volatile("s_waitcnt lgkmcnt(0)" ::: "memory"); SBAR();   \
        o[d0] = __builtin_amdgcn_mfma_f32_32x32x16_bf16(pa0, (bf16x8){l0[0], l0[1], l0[2], l0[3], h0[0], h0[1], h0[2], h0[3]}, o[d0], 0, 0, 0);   \
        o[d0] = __builtin_amdgcn_mfma_f32_32x32x16_bf16(pa1, (bf16x8){l1[0], l1[1], l1[2], l1[3], h1[0], h1[1], h1[2], h1[3]}, o[d0], 0, 0, 0);   \
        o[d0] = __builtin_amdgcn_mfma_f32_32x32x16_bf16(pa2, (bf16x8){l2[0], l2[1], l2[2], l2[3], h2[0], h2[1], h2[2], h2[3]}, o[d0], 0, 0, 0);   \
        o[d0] = __builtin_amdgcn_mfma_f32_32x32x16_bf16(pa3, (bf16x8){l3[0], l3[1], l3[2], l3[3], h3[0], h3[1], h3[2], h3[3]}, o[d0], 0, 0, 0); } while (0)
    PV_D0(0); PV_D0(1); PV_D0(2); PV_D0(3);
#undef PV_D0
#undef TRRD
}
constexpr int QP = 4608;
struct Blk { bf16_t* Q; const bf16_t* K; const float* fcum; int voff, goff, P0, skv, kvpitch; };
struct Seam { bf16x8 qr[8]; bf16x8 st_v0, st_v1, st_k0, st_k1; };
#define ROW(p, pitch, k0, rr) ((p) + (size_t)((k0) + (rr)) * (pitch) + sc)
#define VMW() asm volatile("s_waitcnt vmcnt(0)" ::: "memory")
#define VMWN(n) asm volatile("s_waitcnt vmcnt(%0)" :: "i"(n) : "memory")
#define SLOAD_H(Kp, Vp, pitch, k0) do { S.st_v0 = load8(ROW(Vp, pitch, k0, sr)); S.st_v1 = load8(ROW(Vp, pitch, k0, 32 + sr));              \
                         S.st_k0 = load8(ROW(Kp, pitch, k0, sr)); S.st_k1 = load8(ROW(Kp, pitch, k0, 32 + sr)); } while (0)
#define SWRITE_HK(bf) do { *(bf16x8*)(K_lds + (bf) * SHM_K + kws) = S.st_k0; *(bf16x8*)(K_lds + (bf) * SHM_K + kws + 32 * 256) = S.st_k1; } while (0)
#define SWRITE_HV(bf) do { *(bf16x8*)(V_lds + (bf) * SHM_V + vst0) = S.st_v0; *(bf16x8*)(V_lds + (bf) * SHM_V + vst1) = S.st_v1; } while (0)
#define SWRITE_H(bf) do { SWRITE_HV(bf); SWRITE_HK(bf); } while (0)
__device__ __forceinline__ void prime(const Blk& cur, char* lds, Seam& S, int wid) {
    int lane = (int)__builtin_amdgcn_mbcnt_hi(~0u, __builtin_amdgcn_mbcnt_lo(~0u, 0u)); asm volatile("" : "+v"(lane));
    const int tid = wid * 64 + lane, r32 = lane & 31, hi = lane >> 5;
    const int sr = tid >> 4, sc = (tid & 15) * 8, kws = KSWZ(sr, sc * 2); char* K_lds = lds + 2 * SHM_V;
    for (int d0 = 0; d0 < 8; ++d0) S.qr[d0] = load8(cur.Q + (size_t)(wid * QBLK + r32) * QP + d0 * 16 + hi * 8);
    SLOAD_H(cur.K, cur.K + cur.voff, cur.kvpitch, 0); VMW(); SWRITE_HK(0);
    __syncthreads();
}
__device__ __forceinline__ void block(const Blk& cur, const Blk& nxt, char* lds, Seam& S, int wid) {
    int lane = (int)__builtin_amdgcn_mbcnt_hi(~0u, __builtin_amdgcn_mbcnt_lo(~0u, 0u)); asm volatile("" : "+v"(lane));
    const int tid = wid * 64 + lane, r32 = lane & 31, hi = lane >> 5;
    constexpr int W = WBIG;
    int j_hi = (cur.P0 + QB - 1) / KVBLK + 1; if (j_hi > cur.skv / KVBLK) j_hi = cur.skv / KVBLK;
    const int NT = j_hi;
    const int qlo = cur.P0 + wid * QBLK, qm = qlo + r32 - 4 * hi;
    char* V_lds = lds; char* K_lds = lds + 2 * SHM_V;
    float* ws = (float*)(lds + OFF_WS) + wid * 64; float* li_l = ws, * al_l = ws + 32;
    float* bkl = (float*)(lds + OFF_BK);
    { const int nkeys = NT * KVBLK;
      for (int k = tid; k < nkeys; k += NW * 64) bkl[k] = cur.fcum ? -cur.fcum[k] * (1.f / SCALE) : 0.f;
      __syncthreads(); }
    float m_reg = -1e30f, l_reg = 0; f32x16 o[4] = {};
    const int sr = tid >> 4, sc = (tid & 15) * 8, vst0 = v_st(sr, sc), vst1 = v_st(32 + sr, sc), kws = KSWZ(sr, sc * 2);
    const int vb0 = (int)(uintptr_t)V_lds + v_rd_base(lane);
    const bf16_t* Kh = cur.K; const bf16_t* Vh = cur.K + cur.voff; const int kvp = cur.kvpitch;
#define RESC(a) do { if (__any((a) < 1.f)) { if (hi == 0) al_l[r32] = (a); asm volatile("s_waitcnt lgkmcnt(0)" ::: "memory");              \
                     for (int d_ = 0; d_ < 4; ++d_) for (int r = 0; r < 16; ++r) o[d_][r] *= al_l[crow(r, hi)]; } } while (0)
#define KBASE(t) ((t) * KVBLK)
#define MASKT(P0_, P1_, t) do { const int kb_ = KBASE(t); if (kb_ + KVBLK - 1 > qlo) mask_tile(P0_, P1_, qm - kb_, (unsigned)W); } while (0)
#define BB(t) (bkl + KBASE(t) + 4 * hi)
    constexpr int NQL = 8;
#define SEAM_K0() do { VMWN(NQL); SWRITE_HK(0); SBAR(); } while (0)
    f32x16 pA0, pA1, pB0, pB1; float mnA, mnB, alA, alB; bf16x8 pa0, pa1, pa2, pa3;
    SWRITE_HV(0); SBAR();
    if (NT > 1) { SLOAD_H(Kh, Vh, kvp, KBASE(1)); }
    SBAR(); qkt<0>(pA0, pA1, K_lds, r32, hi, S.qr, BB(0));
    MASKT(pA0, pA1, 0); partialSM(pA0, pA1, m_reg, mnA, alA);
    if (NT > 1) { VMW(); SWRITE_H(1); }
    __syncthreads();
#define HALF_STEP(PX0, PX1, mnX, alX, PY0, PY1, alY, t, KB, VB, SB) do {                                                      \
        SBAR(); qkt<KB>(PX0, PX1, K_lds, r32, hi, S.qr, BB(t));                                                                      \
        finishSM(PY0, PY1, alY, l_reg, pa0, pa1, pa2, pa3); SBAR();                                                           \
        if ((t) + 1 < NT) { SLOAD_H(Kh, Vh, kvp, KBASE((t) + 1)); SBAR(); }                                                   \
        pv_tile<VB>(o, vb0, pa0, pa1, pa2, pa3); MASKT(PX0, PX1, (t)); partialSM(PX0, PX1, m_reg, mnX, alX);   \
        __syncthreads();                                                                                                      \
        if ((t) + 1 < NT) { VMW(); SWRITE_H(SB); }                                                                            \
        RESC(alX); __syncthreads(); } while (0)
    for (int t = 1; t + 1 < NT; t += 2) {
        HALF_STEP(pB0, pB1, mnB, alB, pA0, pA1, alA, t, 1, 0, 0);
        HALF_STEP(pA0, pA1, mnA, alA, pB0, pB1, alB, t + 1, 0, 1, 1);
    }
    const bool even = (NT & 1) == 0;
    if (even) { SBAR(); qkt<1>(pB0, pB1, K_lds, r32, hi, S.qr, BB(NT - 1)); SBAR(); }
    SLOAD_H(nxt.K, nxt.K + nxt.voff, nxt.kvpitch, 0); SBAR();
#pragma unroll
    for (int d0 = 0; d0 < 8; ++d0) S.qr[d0] = load8(nxt.Q + (size_t)(wid * QBLK + r32) * QP + d0 * 16 + hi * 8);
    SBAR();
    finishSM(pA0, pA1, alA, l_reg, pa0, pa1, pa2, pa3); SBAR();
    pv_tile<0>(o, vb0, pa0, pa1, pa2, pa3);
    if (even) { MASKT(pB0, pB1, NT - 1); partialSM(pB0, pB1, m_reg, mnB, alB); __syncthreads(); RESC(alB);
        finishSM(pB0, pB1, alB, l_reg, pa0, pa1, pa2, pa3); SBAR(); pv_tile<1>(o, vb0, pa0, pa1, pa2, pa3); }
    SBAR(); SEAM_K0();
    if (hi == 0) li_l[r32] = l_reg; asm volatile("s_waitcnt lgkmcnt(0)" ::: "memory");
    float rli[16];
#pragma unroll
    for (int r = 0; r < 16; ++r) rli[r] = __builtin_amdgcn_rcpf(li_l[crow(r, hi)]);
    bf16_t* Ow = cur.Q + (size_t)(wid * QBLK + 4 * hi) * QP + r32; const int goff = cur.goff;
#pragma unroll
    for (int r = 0; r < 16; ++r) { const int ro = ((r & 3) + 8 * (r >> 2)) * QP;
#pragma unroll
        for (int d0 = 0; d0 < 4; ++d0) { float v = o[d0][r] * rli[r];
            if (goff) { const float g = __uint_as_float((unsigned)Ow[goff + ro + d0 * 32] << 16); v *= __builtin_amdgcn_rcpf(1.f + __expf(-g)); }
            const float vn = dppf<0xB1>(v);
            if ((r32 & 1) == 0) *(unsigned*)(Ow + ro + d0 * 32) = cvtpk(v, vn); } }
    __syncthreads();
#undef RESC
#undef KBASE
#undef MASKT
#undef BB
#undef SEAM_K0
#undef HALF_STEP
}
#undef ROW
#undef VMW
#undef VMWN
#undef SLOAD_H
#undef SWRITE_HK
#undef SWRITE_HV
#undef SWRITE_H
#undef KSWZ
#undef SBAR
template <class Src> __device__ __forceinline__ void phase(char* lds, const Src& src, int wid) {
    Blk cur, nxt; if (!src(0, cur)) return;
    Seam S; prime(cur, lds, S, wid);
    for (int n = 0;; ++n) { const bool more = src(n + 1, nxt); if (!more) nxt = cur; block(cur, nxt, lds, S, wid); if (!more) break; cur = nxt; }
}
}

constexpr int NWAVES = 8;
#ifndef MK_LAUNCH_PER_PHASE
#define MK_LAUNCH_PER_PHASE 0
#endif
constexpr int N_PHASES = 13;

constexpr size_t KiB = 1u << 10, MiB = 1u << 20;
constexpr size_t WS_CTL = 0, CTL_ZERO_BYTES = 1 * MiB;
constexpr size_t WS_WIN0 = 1 * MiB, WS_WIN1 = WS_WIN0 + (size_t)N_IN * DM * 2;
constexpr size_t WS_WOUT0 = 20 * MiB, WS_WOUT1 = 23 * MiB;
constexpr size_t WS_WM1_0 = 26 * MiB, WS_WM1_1 = 34 * MiB, WS_WM2_0 = 42 * MiB, WS_WM2_1 = 50 * MiB;
constexpr size_t WS_WMKV = 58 * MiB;
constexpr size_t WS_PROJ = 60 * MiB;
constexpr size_t WS_XB = 204 * MiB;
constexpr size_t WS_SSQ = 236 * MiB;
constexpr size_t WS_AB = 245 * MiB;
constexpr size_t WS_MEMKV = 246 * MiB;
constexpr size_t WS_XSQ = 250 * MiB;
constexpr size_t WS_FCUM = 251 * MiB;
constexpr size_t WS_MSSQ = 251 * MiB + 512 * KiB;
constexpr size_t WS_MSQ = 251 * MiB + 768 * KiB;
constexpr size_t WS_END = 252 * MiB;
static_assert(WS_WIN1 + (size_t)N_IN * DM * 2 <= WS_WOUT0 && WS_PROJ + (size_t)MROWS * PW * 2 <= WS_XB && WS_SSQ + (size_t)36 * MROWS * 16 <= WS_AB, "d_ws map");
constexpr size_t DO_MEMB = 0;
constexpr int CW_BAR = 4096;

constexpr int LDS_BYTES = 155648;
constexpr int MISC_OFF = LDS_BYTES - 256;

#define GAS __attribute__((address_space(1)))
#define LAS __attribute__((address_space(3)))
typedef unsigned short bf16;
typedef unsigned v4u __attribute__((ext_vector_type(4)));
typedef float f32x4 __attribute__((ext_vector_type(4)));
typedef short bf16x8 __attribute__((ext_vector_type(8)));
typedef GAS unsigned gu32;
typedef GAS unsigned long long gu64;
#define RLX_AGENT __ATOMIC_RELAXED, __HIP_MEMORY_SCOPE_AGENT
#define LDS_WAIT() asm volatile("s_waitcnt lgkmcnt(0)" ::: "memory")
#define VM_WAIT() asm volatile("s_waitcnt vmcnt(0)" ::: "memory")
__device__ __forceinline__ unsigned long long rt() { return __builtin_amdgcn_s_memrealtime(); }
__device__ __forceinline__ unsigned f2bf(float f) { unsigned u = __builtin_bit_cast(unsigned, f); return (u + 0x7fffu + ((u >> 16) & 1u)) >> 16; }
__device__ __forceinline__ unsigned pk2(float lo, float hi) { return f2bf(lo) | (f2bf(hi) << 16); }

#define XB_TMO      128
#define XB_XCNT(j)  (256  + 64 * (j))
#define XB_XSUB(j)  (1280 + 64 * (j))
#define XB_XGEN(j)  (2304 + 64 * (j))
#define XB_TOP      3328
#define XB_TOPGEN   3392
#define XCD_BAR_WORDS 3456
#define XB_SPIN_CAP (1u << 18)

__device__ __forceinline__ unsigned xb_ld(unsigned* p)              { return __hip_atomic_load(p, __ATOMIC_RELAXED, __HIP_MEMORY_SCOPE_AGENT); }
__device__ __forceinline__ unsigned xb_add(unsigned* p, unsigned v) { return __hip_atomic_fetch_add(p, v, __ATOMIC_RELAXED, __HIP_MEMORY_SCOPE_AGENT); }
__device__ __forceinline__ unsigned xb_xcc_id() { return (unsigned)__builtin_amdgcn_s_getreg((3 << 11) | 20) & 0xFu; }
#define XB_SPIN(cond, bar) do { unsigned _sp = 0; while (cond) { __builtin_amdgcn_s_sleep(1); \
    if ((++_sp & 255u) == 0u) { if (xb_ld(&(bar)[XB_TMO])) break; if (_sp > XB_SPIN_CAP) { atomicAdd(&(bar)[XB_TMO], 1u); break; } } } } while (0)

struct XcdBarrier {
    unsigned* bar; unsigned x; int wv;
    volatile LAS unsigned* st;
};

__device__ __forceinline__ XcdBarrier xcd_barrier_post(unsigned* bar, volatile LAS unsigned* st) {
    XcdBarrier b; b.bar = bar; b.x = xb_xcc_id(); b.st = st;
    if (threadIdx.x == 0) (void)xb_add(&bar[XB_XCNT(b.x)], 1u);
    return b;
}
__device__ __forceinline__ void xcd_barrier_complete(unsigned* bar, unsigned x, unsigned& nloc, unsigned& nx) {
    const unsigned G = gridDim.x * gridDim.y * gridDim.z;
    unsigned sum, cnt, mine, sp = 0u;
    for (;;) {
        sum = 0u; cnt = 0u; mine = 0u;
#pragma unroll
        for (unsigned j = 0; j < 16; ++j) { const unsigned c = xb_ld(&bar[XB_XCNT(j)]); sum += c; cnt += (c > 0u) ? 1u : 0u; mine = (j == x) ? c : mine; }
        if (sum == G) break;
        __builtin_amdgcn_s_sleep(1);
        if ((++sp & 255u) == 0u) { if (xb_ld(&bar[XB_TMO])) break; if (sp > XB_SPIN_CAP) { atomicAdd(&bar[XB_TMO], 1u); break; } }
    }
    nloc = mine > 0u ? mine : 1u; nx = cnt > 0u ? cnt : 1u;
}

__device__ __forceinline__ void xcd_barrier(const XcdBarrier& b) {
    asm volatile("s_waitcnt vmcnt(0)" ::: "memory");
    __syncthreads();
    if (b.wv == 0 && (int)__builtin_amdgcn_mbcnt_hi(~0u, __builtin_amdgcn_mbcnt_lo(~0u, 0u)) == 0) {
        unsigned* bar = b.bar;
        __builtin_amdgcn_s_waitcnt(0);
        unsigned nloc = b.st[0], nx = b.st[1];
        if (nloc == 0u) { xcd_barrier_complete(bar, b.x, nloc, nx); b.st[0] = nloc; b.st[1] = nx; }
        const unsigned old = xb_add(&bar[XB_XSUB(b.x)], 1u);
        const unsigned gen = old / nloc;
        if (old + 1u == (gen + 1u) * nloc) {
            __builtin_amdgcn_fence(__ATOMIC_RELEASE, "agent");
            asm volatile("s_waitcnt vmcnt(0)" ::: "memory");
            const unsigned og = xb_add(&bar[XB_TOP], 1u);
            const unsigned tg = og / nx;
            if (og + 1u == (tg + 1u) * nx) xb_add(&bar[XB_TOPGEN], 1u);
            else XB_SPIN(xb_ld(&bar[XB_TOPGEN]) == tg, bar);
            __builtin_amdgcn_fence(__ATOMIC_ACQUIRE, "agent");
            xb_add(&bar[XB_XGEN(b.x)], 1u);
            asm volatile("s_waitcnt vmcnt(0)" ::: "memory");
        } else {
            XB_SPIN(xb_ld(&bar[XB_XGEN(b.x)]) == gen, bar);
            __builtin_amdgcn_fence(__ATOMIC_ACQUIRE, "agent");
            asm volatile("s_waitcnt vmcnt(0)" ::: "memory");
        }
    }
    __syncthreads();
}


__device__ __forceinline__ float bflo(unsigned u) { return __builtin_bit_cast(float, u << 16); }
__device__ __forceinline__ float bfhi(unsigned u) { return __builtin_bit_cast(float, u & 0xffff0000u); }
typedef float f32x2_t __attribute__((ext_vector_type(2))); typedef __bf16 bf16x2_t __attribute__((ext_vector_type(2)));
__device__ __forceinline__ unsigned pkbf(float lo, float hi) { const f32x2_t v = {lo, hi}; const bf16x2_t b = __builtin_convertvector(v, bf16x2_t); return __builtin_bit_cast(unsigned, b); }
__device__ __forceinline__ float wave_sum(float v) { return add_xor32(add_xor16(row16_sum(v))); }
__device__ __forceinline__ float wave_max(float v) {
#pragma unroll
    for (int o = 1; o < 64; o <<= 1) v = fmaxf(v, __shfl_xor(v, o));
    return v;
}

struct Args { const float* in[20]; float* out; unsigned char* ws; int ph_lo, ph_hi, li, pad; };
enum { I_X = 0, I_MEM, I_MEMNW, I_WMKV, I_MEMKNW, I_NORM1, I_DNWIN, I_DNCONV, I_DNALOG, I_DNDT, I_DNONW, I_FOXWIN, I_FOXFB, I_FOXQNW, I_FOXKNW, I_MEMQNW, I_WOUT, I_NORM2, I_WM1, I_WM2 };

struct Frame {
    LAS unsigned char* lds;
    int G, bid, wv;
    const float* const* in; float* out; unsigned char* ws;
};


struct Tix { int tid, lane, wave; };
__device__ __forceinline__ int lane_id() { int x = (int)__builtin_amdgcn_mbcnt_hi(~0u, __builtin_amdgcn_mbcnt_lo(~0u, 0u)); asm volatile("" : "+v"(x)); return x; }
__device__ __forceinline__ Tix tix(int wv) { Tix t; t.lane = lane_id(); t.wave = wv; t.tid = wv * 64 + t.lane; return t; }
struct TSeg { const float* W; int K, ldw, src0, ncols; bf16* WT; int dst0; const float* scale; };
__device__ __forceinline__ TSeg get_seg(const Frame& F, int s) {
    TSeg t; t.scale = nullptr; t.src0 = 0; t.dst0 = 0;
    if (s < 12) {
        const int l = s / 6, j = s % 6;
        t.W = l ? F.in[I_FOXWIN] : F.in[I_DNWIN]; t.K = DM; t.ldw = l ? FOX_IN : DN_IN; t.WT = (bf16*)(F.ws + (l ? WS_WIN1 : WS_WIN0)); t.scale = F.in[I_NORM1] + l * DM;
        const int qm0 = l ? 4104 : 4112, nsc = l ? 8 : 16;
        t.ncols = 1024;
        if (j == 0) { t.src0 = 1024; t.dst0 = PC_K; } else if (j == 1) { t.src0 = 2048; t.dst0 = PC_V; } else if (j == 2) { t.src0 = 3072; t.dst0 = PC_Z; }
        else if (j == 3) { t.src0 = 0; t.dst0 = PC_Q; } else if (j == 4) { t.src0 = qm0; t.dst0 = PC_QM; t.ncols = 512; } else { t.src0 = 4096; t.dst0 = PC_AB; t.ncols = nsc; }
    } else if (s < 14) { const int l = s - 12; t.W = F.in[I_WOUT] + (size_t)l * OUT_IN * DM; t.K = OUT_IN; t.ldw = DM; t.ncols = DM; t.WT = (bf16*)(F.ws + (l ? WS_WOUT1 : WS_WOUT0)); }
    else if (s < 16) { const int l = s - 14; t.W = F.in[I_WM1] + (size_t)l * DM * FF; t.K = DM; t.ldw = FF; t.ncols = FF; t.WT = (bf16*)(F.ws + (l ? WS_WM1_1 : WS_WM1_0)); t.scale = F.in[I_NORM2] + l * DM; }
    else if (s < 18) { const int l = s - 16; t.W = F.in[I_WM2] + (size_t)l * FF * DM; t.K = FF; t.ldw = DM; t.ncols = DM; t.WT = (bf16*)(F.ws + (l ? WS_WM2_1 : WS_WM2_0)); }
    else { t.W = F.in[I_WMKV]; t.K = DM; t.ldw = DM; t.ncols = DM; t.WT = (bf16*)(F.ws + WS_WMKV); t.scale = F.in[I_MEMNW]; }
    return t;
}
__device__ __forceinline__ int seg_items(const TSeg& t) { return (t.K / 64) * ((t.ncols + 63) / 64); }
__device__ __forceinline__ void tr_load(const TSeg& t, int item, int lane, f32x4 (&v)[16]) {
    const int nblk = (t.ncols + 63) / 64, kb = item / nblk, nb = item - kb * nblk, k0 = 64 * kb, n0 = 64 * nb;
    const int n4 = (lane & 15) * 4, kr = lane >> 4; const bool ok = (n0 + n4) < t.ncols;
    const float* p = t.W + (size_t)(k0 + kr) * t.ldw + t.src0 + n0 + n4;
#pragma unroll
    for (int i = 0; i < 16; ++i) v[i] = ok ? *(const f32x4*)(p + (size_t)(4 * i) * t.ldw) : (f32x4){0.f, 0.f, 0.f, 0.f};
}
__device__ __forceinline__ void tr_store(const TSeg& t, int item, int lane, const f32x4 (&v)[16], LAS float* scr) {
    const int nblk = (t.ncols + 63) / 64, kb = item / nblk, nb = item - kb * nblk, k0 = 64 * kb, n0 = 64 * nb;
    const int n4 = (lane & 15) * 4, kr = lane >> 4;
#pragma unroll
    for (int i = 0; i < 16; ++i) *(LAS f32x4*)(scr + (4 * i + kr) * 68 + n4) = v[i];
    LDS_WAIT(); asm volatile("" ::: "memory");
    const int c = lane & 7; f32x4 s0 = {1.f, 1.f, 1.f, 1.f}, s1 = s0;
    if (t.scale) { s0 = *(const f32x4*)(t.scale + k0 + 8 * c); s1 = *(const f32x4*)(t.scale + k0 + 8 * c + 4); }
#pragma unroll
    for (int j = 0; j < 8; ++j) { const int n = (lane >> 3) + 8 * j; const LAS float* q = scr + (8 * c) * 68 + n;
        v4u o; o.x = pkbf(q[0 * 68] * s0[0], q[1 * 68] * s0[1]); o.y = pkbf(q[2 * 68] * s0[2], q[3 * 68] * s0[3]); o.z = pkbf(q[4 * 68] * s1[0], q[5 * 68] * s1[1]); o.w = pkbf(q[6 * 68] * s1[2], q[7 * 68] * s1[3]);
        if (n0 + n < t.ncols) *(v4u*)(t.WT + (size_t)(t.dst0 + n0 + n) * t.K + k0 + 8 * c) = o; }
    LDS_WAIT(); asm volatile("" ::: "memory");
}
template <int NR> __device__ __forceinline__ void rows_to_bf16(int lane, const float* x, bf16* o, float* sq) {
    f32x4 v[NR][4];
#pragma unroll
    for (int r = 0; r < NR; ++r)
#pragma unroll
        for (int j = 0; j < 4; ++j) v[r][j] = ((const f32x4*)(x + (size_t)r * DM))[lane + 64 * j];
#pragma unroll
    for (int r = 0; r < NR; ++r) { float s = 0.f;
#pragma unroll
        for (int j = 0; j < 4; ++j) s += (v[r][j].x * v[r][j].x + v[r][j].y * v[r][j].y) + (v[r][j].z * v[r][j].z + v[r][j].w * v[r][j].w);
        s = wave_sum(s);
        unsigned long long* o8 = (unsigned long long*)(o + (size_t)r * DM) + lane;
#pragma unroll
        for (int j = 0; j < 4; ++j) o8[64 * j] = (unsigned long long)pkbf(v[r][j].x, v[r][j].y) | ((unsigned long long)pkbf(v[r][j].z, v[r][j].w) << 32);
        if (lane < 16) sq[(size_t)r * 16 + lane] = lane == 0 ? s : 0.f; }
}
__device__ __forceinline__ void p0_prologue(const Frame& F) {
    const Tix T = tix(F.wv);
    LAS float* scr = (LAS float*)(F.lds + T.wave * 17408);
    const int gw = F.bid * NWAVES + T.wave, NGW = F.G * NWAVES;
    for (int m = gw * 4; m < MROWS; m += NGW * 4) rows_to_bf16<4>(T.lane, F.in[I_X] + (size_t)m * DM, (bf16*)(F.ws + WS_XB) + (size_t)m * DM, (float*)(F.ws + WS_XSQ) + (size_t)m * 16);
    for (int m = gw; m < MMEM; m += NGW) rows_to_bf16<1>(T.lane, F.in[I_MEM] + (size_t)m * DM, (bf16*)((unsigned char*)F.out + DO_MEMB) + (size_t)m * DM, (float*)(F.ws + WS_MSQ) + (size_t)m * 16);
    int base = 0;
#pragma unroll
    for (int s = 0; s < 19; ++s) {
        const TSeg t = get_seg(F, s); const int n = seg_items(t);
        int it = gw - (base % NGW); if (it < 0) it += NGW;
        for (; it < n; it += NGW) { f32x4 v[16]; tr_load(t, it, T.lane, v); tr_store(t, it, T.lane, v, scr); }
        base += n;
    }
}

typedef short dn_bf16x8 __attribute__((ext_vector_type(8)));
typedef unsigned dn_u32x2 __attribute__((ext_vector_type(2)));
__device__ __forceinline__ f32x4 mfma16(dn_bf16x8 a, dn_bf16x8 b, f32x4 c) { return __builtin_amdgcn_mfma_f32_16x16x32_bf16(a, b, c, 0, 0, 0); }
__device__ __forceinline__ f32x4 mfma4(float a, float b, f32x4 c) { return __builtin_amdgcn_mfma_f32_16x16x4f32(a, b, c, 0, 0, 0); }
__device__ __forceinline__ dn_bf16x8 pack8f(f32x4 x, f32x4 y) { v4u w; w.x = pkbf(x[0], x[1]); w.y = pkbf(x[2], x[3]); w.z = pkbf(y[0], y[1]); w.w = pkbf(y[2], y[3]); return __builtin_bit_cast(dn_bf16x8, w); }
__device__ __forceinline__ dn_u32x2 pack4f(f32x4 x) { dn_u32x2 w; w.x = pkbf(x[0], x[1]); w.y = pkbf(x[2], x[3]); return w; }
__device__ __forceinline__ unsigned short bf1(float x) { return (unsigned short)(pkbf(x, 0.f) & 0xffffu); }
constexpr size_t DO_QKS = 4 * MiB, DO_HALO = 20 * MiB, DO_EGL = 27 * MiB;
constexpr int P_RAW = 0, P_GB = 51712, P_QH = 53248, P_KH = 70656, P_VBT = 88064, P_KBGT = 106496, P_QKL = 124928, P_END = 134144;
constexpr int P_AT = 0, P_TB = 17408, P_PS = 26624, P_PS2 = 29184;
struct DnPre { v4u P[7]; float ga, gb; f32x4 cw[3][4]; };
__device__ __forceinline__ void dn_prep_load(const Frame& F, int u, DnPre& R) {
    const Tix T = tix(F.wv); const int tid = T.tid, lane = T.lane;
    const int bh = u >> 5, c = u & 31, b = bh >> 3, h = bh & 7; const size_t row0 = (size_t)b * SEQ + c * 64; const int gch = b * 32 + c;
    const bf16* proj = (const bf16*)(F.ws + WS_PROJ); const float* AB = (const float*)(F.ws + WS_AB); const bf16* halo = (const bf16*)((unsigned char*)F.out + DO_HALO);
#pragma unroll
    for (int j = 0; j < 7; ++j) { const int id = tid + 512 * j; v4u val = {0u, 0u, 0u, 0u};
        if (id < 67 * 48) { const int r = id / 48, rem = id - r * 48, seg = rem >> 4, ch = rem & 15;
            const int col = (seg == 0 ? PC_Q : seg == 1 ? PC_K : PC_V) + h * HD + ch * 8;
            if (r >= 3) val = *(const v4u*)(proj + (row0 + r - 3) * PW + col);
            else if (c > 0) val = *(const v4u*)(halo + ((size_t)(gch - 1) * 3 + r) * PW + col); }
        R.P[j] = val; }
    R.ga = AB[(row0 + lane) * 16 + h]; R.gb = AB[(row0 + lane) * 16 + 8 + h];
    const float* convw = F.in[I_DNCONV]; const int c4 = lane & 31;
#pragma unroll
    for (int seg = 0; seg < 3; ++seg)
#pragma unroll
        for (int j = 0; j < 4; ++j) R.cw[seg][j] = *(const f32x4*)(convw + j * 3072 + seg * 1024 + h * HD + 4 * c4);
}
__device__ __forceinline__ void dn_prep_unit(const Frame& F, int u, int u_next, DnPre& R) {
    const Tix T = tix(F.wv); const int tid = T.tid, lane = T.lane, wave = T.wave, m = lane & 15, g = lane >> 4;
    const int bh = u >> 5, c = u & 31, b = bh >> 3, h = bh & 7; const size_t row0 = (size_t)b * SEQ + c * 64;
    bf16* proj = (bf16*)(F.ws + WS_PROJ);
    bf16* xbimg = (bf16*)(F.ws + WS_XB) + (size_t)u * 8192; bf16* qks = (bf16*)((unsigned char*)F.out + DO_QKS) + (size_t)u * 4096; float* egl = (float*)((unsigned char*)F.out + DO_EGL);
    LAS unsigned char* L = F.lds; LAS float* GB = (LAS float*)(L + P_GB);
#pragma unroll
    for (int j = 0; j < 7; ++j) { const int id = tid + 512 * j;
        if (id < 67 * 48) { const int r = id / 48, rem = id - r * 48, seg = rem >> 4, ch = rem & 15; *(LAS v4u*)(L + P_RAW + r * 768 + seg * 256 + ch * 16) = R.P[j]; } }
    if (wave == 0) { const float a = R.ga, bb = R.gb;
        const float x = a + F.in[I_DNDT][h], sp = fmaxf(x, 0.f) + log1pf(__expf(-fabsf(x)));
        const float gt = -__expf(F.in[I_DNALOG][h]) * sp, beta = __builtin_amdgcn_rcpf(1.f + __expf(-bb));
        float gc = gt;
#pragma unroll
        for (int o = 1; o < 64; o <<= 1) { const float t = __shfl_up(gc, o); if (lane >= o) gc += t; }
        const float gl = __shfl(gc, 63);
        GB[lane] = gc; GB[64 + lane] = beta; GB[128 + lane] = beta * __expf(gc); GB[192 + lane] = __expf(gl - gc); GB[256 + lane] = __expf(gc);
        if (lane == 0) egl[u] = __expf(gl); }
    f32x4 cw[3][4];
#pragma unroll
    for (int seg = 0; seg < 3; ++seg)
#pragma unroll
        for (int j = 0; j < 4; ++j) cw[seg][j] = R.cw[seg][j];
    __syncthreads();
    if (u_next >= 0) dn_prep_load(F, u_next, R);
    { const int hf = lane >> 5, c4 = lane & 31;
#pragma unroll
      for (int jj = 0; jj < 12; ++jj) { constexpr int dummy_ = 0; (void)dummy_; const int seg = jj >> 2;
        const int wi = wave + 8 * jj, i = 2 * (wi & 31) + hf;
        f32x4 y = {0.f, 0.f, 0.f, 0.f};
#pragma unroll
        for (int j = 0; j < 4; ++j) { const f32x4 w = cw[seg][j];
            const dn_u32x2 xx = *(const LAS dn_u32x2*)(L + P_RAW + (i + j) * 768 + seg * 256 + c4 * 8);
            y[0] += w[0] * bflo(xx.x); y[1] += w[1] * bfhi(xx.x); y[2] += w[2] * bflo(xx.y); y[3] += w[3] * bfhi(xx.y); }
        f32x4 s;
#pragma unroll
        for (int e = 0; e < 4; ++e) s[e] = y[e] * __builtin_amdgcn_rcpf(1.f + __expf(-y[e]));
        if (seg < 2) { float ss = (s[0] * s[0] + s[1] * s[1]) + (s[2] * s[2] + s[3] * s[3]);
            ss = add_xor16(row16_sum(ss));
            const float r = rsqrtf(ss + EPS) * (seg == 0 ? QSCALE : 1.f);
            s = s * r;
            *(LAS dn_u32x2*)(L + (seg == 0 ? P_QH : P_KH) + i * 272 + c4 * 8) = pack4f(s);
            if (seg == 0) { const int cc = c4 & 7, p0 = cc < 4 ? 8 * cc : 8 * (cc - 4) + 4;
                *(dn_u32x2*)(proj + (row0 + i) * PW + PC_Q + h * HD + 32 * (c4 >> 3) + p0) = pack4f(s * GB[256 + i]); }
            else { const float bge = GB[128 + i];
#pragma unroll
                for (int e = 0; e < 4; ++e) *(LAS unsigned short*)(L + P_KBGT + (4 * c4 + e) * 144 + i * 2) = bf1(s[e] * bge); } }
        else { const float be = GB[64 + i];
#pragma unroll
            for (int e = 0; e < 4; ++e) *(LAS unsigned short*)(L + P_VBT + (4 * c4 + e) * 144 + i * 2) = bf1(s[e] * be); } } }
    __syncthreads();
    LAS float* AT = (LAS float*)(L + P_AT);
#pragma unroll
    for (int q = 0; q < 2; ++q) { const int tt = wave + 8 * q, it = tt >> 2, jt = tt & 3;
        f32x4 kk = {0.f, 0.f, 0.f, 0.f}, qk = {0.f, 0.f, 0.f, 0.f};
        if (jt <= it) {
#pragma unroll
            for (int kq = 0; kq < 4; ++kq) { const dn_bf16x8 bk = *(const LAS dn_bf16x8*)(L + P_KH + (16 * jt + m) * 272 + (32 * kq + 8 * g) * 2);
                const dn_bf16x8 ak = *(const LAS dn_bf16x8*)(L + P_KH + (16 * it + m) * 272 + (32 * kq + 8 * g) * 2), aq = *(const LAS dn_bf16x8*)(L + P_QH + (16 * it + m) * 272 + (32 * kq + 8 * g) * 2);
                kk = mfma16(ak, bk, kk); qk = mfma16(aq, bk, qk); } }
        const int j = 16 * jt + m, jl = j & 31, p = jl < 16 ? 8 * (jl >> 2) + (jl & 3) : 8 * ((jl - 16) >> 2) + 4 + (jl & 3);
        const float gcj = GB[j];
#pragma unroll
        for (int r = 0; r < 4; ++r) { const int i = 16 * it + 4 * g + r; const float dec = i >= j ? __expf(GB[i] - gcj) : 0.f;
            AT[i * 68 + j] = i > j ? GB[64 + i] * kk[r] * dec : 0.f;
            *(LAS unsigned short*)(L + P_QKL + i * 144 + (32 * (j >> 5) + p) * 2) = bf1(qk[r] * dec); } }
    __syncthreads();
    if (wave >= 4) { const int t4 = tid - 256;
        for (int id = t4; id < 1024; id += 256) { const int k = id >> 3, sp = (id >> 2) & 1, gg = id & 3; float o8[8];
#pragma unroll
            for (int j = 0; j < 8; ++j) { const int cc = 32 * sp + (j < 4 ? 4 * gg + j : 16 + 4 * gg + j - 4);
                o8[j] = bflo((unsigned)*(const LAS unsigned short*)(L + P_KH + cc * 272 + k * 2)) * GB[192 + cc]; }
            v4u w; w.x = pkbf(o8[0], o8[1]); w.y = pkbf(o8[2], o8[3]); w.z = pkbf(o8[4], o8[5]); w.w = pkbf(o8[6], o8[7]);
            *(v4u*)(proj + (row0 + (k >> 1)) * PW + PC_K + h * HD + (k & 1) * 64 + 32 * sp + 8 * gg) = w; }
        for (int id = t4; id < 512; id += 256) { const int i = id >> 3, j8 = (id & 7) * 8;
            *(v4u*)(qks + i * 64 + j8) = *(const LAS v4u*)(L + P_QKL + i * 144 + j8 * 2); } }
    if (wave == 0) { const int bb = g, j = m; float X[16];
        X[0] = j == 0 ? 1.f : 0.f;
#pragma unroll
        for (int i = 1; i < 16; ++i) { const LAS float* Lr = AT + (16 * bb + i) * 68 + 16 * bb; float Lv[16];
#pragma unroll
            for (int q = 0; q < (i + 3) / 4; ++q) { const f32x4 t = *(const LAS f32x4*)(Lr + 4 * q); Lv[4 * q] = t[0]; Lv[4 * q + 1] = t[1]; Lv[4 * q + 2] = t[2]; Lv[4 * q + 3] = t[3]; }
            float acc = i == j ? 1.f : 0.f;
#pragma unroll
            for (int mm = 0; mm < i; ++mm) acc -= Lv[mm] * X[mm];
            X[i] = acc; }
#pragma unroll
        for (int i = 0; i < 16; ++i) AT[(16 * bb + i) * 68 + 16 * bb + j] = X[i]; }
    __syncthreads();
    if (wave < 2) { const int lo = 2 * wave, hi = 2 * wave + 1; LAS float* PS = (LAS float*)(L + P_PS) + wave * 320;
        f32x4 acc = {0.f, 0.f, 0.f, 0.f};
#pragma unroll
        for (int s = 0; s < 4; ++s) acc = mfma4(AT[(16 * hi + m) * 68 + 16 * lo + 4 * s + g], AT[(16 * lo + 4 * s + g) * 68 + 16 * lo + m], acc);
#pragma unroll
        for (int r = 0; r < 4; ++r) PS[(4 * g + r) * 20 + m] = acc[r];
        LDS_WAIT();
        f32x4 acc2 = {0.f, 0.f, 0.f, 0.f};
#pragma unroll
        for (int s = 0; s < 4; ++s) acc2 = mfma4(AT[(16 * hi + m) * 68 + 16 * hi + 4 * s + g], PS[(4 * s + g) * 20 + m], acc2);
#pragma unroll
        for (int r = 0; r < 4; ++r) AT[(16 * hi + 4 * g + r) * 68 + 16 * lo + m] = -acc2[r]; }
    __syncthreads();
    { LAS float* PS2 = (LAS float*)(L + P_PS2); const int ti = (wave >> 1) & 1, tj = wave & 1;
      if (wave < 4) { f32x4 acc = {0.f, 0.f, 0.f, 0.f};
#pragma unroll
          for (int s = 0; s < 8; ++s) acc = mfma4(AT[(32 + 16 * ti + m) * 68 + 4 * s + g], AT[(4 * s + g) * 68 + 16 * tj + m], acc);
#pragma unroll
          for (int r = 0; r < 4; ++r) PS2[(16 * ti + 4 * g + r) * 36 + 16 * tj + m] = acc[r]; }
      __syncthreads();
      if (wave < 4) { f32x4 acc = {0.f, 0.f, 0.f, 0.f};
#pragma unroll
          for (int s = 0; s < 8; ++s) acc = mfma4(AT[(32 + 16 * ti + m) * 68 + 32 + 4 * s + g], PS2[(4 * s + g) * 36 + 16 * tj + m], acc);
#pragma unroll
          for (int r = 0; r < 4; ++r) AT[(32 + 16 * ti + 4 * g + r) * 68 + 16 * tj + m] = -acc[r]; } }
    __syncthreads();
    { const int i = tid >> 3, j0 = (tid & 7) * 8; const f32x4 t0 = *(const LAS f32x4*)(AT + i * 68 + j0), t1 = *(const LAS f32x4*)(AT + i * 68 + j0 + 4);
      v4u w; w.x = pkbf(t0[0], t0[1]); w.y = pkbf(t0[2], t0[3]); w.z = pkbf(t1[0], t1[1]); w.w = pkbf(t1[2], t1[3]);
      *(LAS v4u*)(L + P_TB + i * 144 + j0 * 2) = w; }
    __syncthreads();
#pragma unroll
    for (int q = 0; q < 8; ++q) { const int tt = wave + 8 * q; f32x4 acc = {0.f, 0.f, 0.f, 0.f};
        if (tt < 32) { const int ct = tt >> 3, nt = tt & 7;
#pragma unroll
            for (int sp = 0; sp < 2; ++sp) acc = mfma16(*(const LAS dn_bf16x8*)(L + P_TB + (16 * ct + m) * 144 + (32 * sp + 8 * g) * 2), *(const LAS dn_bf16x8*)(L + P_VBT + (16 * nt + m) * 144 + (32 * sp + 8 * g) * 2), acc);
            const int v = 16 * nt + m;
            *(dn_u32x2*)(proj + (row0 + (v >> 1)) * PW + PC_V + h * HD + (v & 1) * 64 + 16 * ct + 4 * g) = pack4f(acc); }
        else { const int t2 = tt - 32, kt = t2 >> 2, ct = t2 & 3;
#pragma unroll
            for (int sp = 0; sp < 2; ++sp) acc = mfma16(*(const LAS dn_bf16x8*)(L + P_KBGT + (16 * kt + m) * 144 + (32 * sp + 8 * g) * 2), *(const LAS dn_bf16x8*)(L + P_TB + (16 * ct + m) * 144 + (32 * sp + 8 * g) * 2), acc);
            *(dn_u32x2*)(xbimg + (16 * ct + m) * 128 + 32 * (kt >> 1) + 8 * g + 4 * (kt & 1)) = pack4f(-acc); } }
    __syncthreads();
}
constexpr int S_WN = 0, S_QG = 17408, S_KDT = 34816, S_QKM = 53248, S_UT = 62464, S_OB = 80896, S_PSQ = 114688, S_END = 116736;
__device__ __forceinline__ void dn_scan_unit(const Frame& F, int bh) {
    const Tix T = tix(F.wv); const int tid = T.tid, lane = T.lane, wave = T.wave, m = lane & 15, g = lane >> 4, n0 = 16 * wave;
    const int b = bh >> 3, h = bh & 7;
    bf16* proj = (bf16*)(F.ws + WS_PROJ); const bf16* xbi = (const bf16*)(F.ws + WS_XB); const bf16* qks = (const bf16*)((unsigned char*)F.out + DO_QKS); const float* egl = (const float*)((unsigned char*)F.out + DO_EGL);
    const float* onw = F.in[I_DNONW];
    LAS unsigned char* L = F.lds;
    f32x4 Sacc[8];
#pragma unroll
    for (int kt = 0; kt < 8; ++kt) Sacc[kt] = (f32x4){0.f, 0.f, 0.f, 0.f};
    v4u R[9];
#define DN_LOAD(cc) do { const size_t r0_ = (size_t)b * SEQ + (cc) * 64; const size_t u_ = (size_t)bh * 32 + (cc);                                         \
        _Pragma("unroll") for (int j_ = 0; j_ < 2; ++j_) { const int q_ = tid + 512 * j_;                                                                  \
            R[j_] = *(const v4u*)(xbi + u_ * 8192 + q_ * 8);                                                                                                \
            R[2 + j_] = *(const v4u*)(proj + (r0_ + (q_ >> 4)) * PW + PC_Q + h * HD + (q_ & 15) * 8);                                                       \
            R[4 + j_] = *(const v4u*)(proj + (r0_ + (q_ >> 4)) * PW + PC_K + h * HD + ((q_ >> 3) & 1) * 64 + (q_ & 7) * 8);                                 \
            R[6 + j_] = *(const v4u*)(proj + (r0_ + (q_ >> 4)) * PW + PC_V + h * HD + ((q_ >> 3) & 1) * 64 + (q_ & 7) * 8); }                               \
        R[8] = *(const v4u*)(qks + u_ * 4096 + tid * 8); } while (0)
#define DN_WRITE() do { _Pragma("unroll") for (int j_ = 0; j_ < 2; ++j_) { const int q_ = tid + 512 * j_;                                                  \
            *(LAS v4u*)(L + S_WN + (q_ >> 4) * 272 + (q_ & 15) * 16) = R[j_]; *(LAS v4u*)(L + S_QG + (q_ >> 4) * 272 + (q_ & 15) * 16) = R[2 + j_];          \
            *(LAS v4u*)(L + S_KDT + (q_ >> 3) * 144 + (q_ & 7) * 16) = R[4 + j_]; *(LAS v4u*)(L + S_UT + (q_ >> 3) * 144 + (q_ & 7) * 16) = R[6 + j_]; }   \
        *(LAS v4u*)(L + S_QKM + (tid >> 3) * 144 + (tid & 7) * 16) = R[8]; } while (0)
    const int fr_ = tid >> 3, fp_ = tid & 7;
    f32x4 w4[4];
#pragma unroll
    for (int q = 0; q < 4; ++q) w4[q] = *(const f32x4*)(onw + fp_ * 16 + 4 * q);
    const unsigned* eglu = (const unsigned*)egl + (size_t)bh * 32;
    float eg_next = __uint_as_float(__hip_atomic_load(eglu, __ATOMIC_RELAXED, __HIP_MEMORY_SCOPE_AGENT));
    DN_LOAD(0); DN_WRITE();
    __syncthreads();
    LAS float* OB = (LAS float*)(L + S_OB); LAS float* PSQ = (LAS float*)(L + S_PSQ);
    for (int c = 0; c < SEQ / 64; ++c) {
        const size_t row0 = (size_t)b * SEQ + c * 64;
        const float eg = eg_next;
        if (c + 1 < SEQ / 64) { eg_next = __uint_as_float(__hip_atomic_load(eglu + c + 1, __ATOMIC_RELAXED, __HIP_MEMORY_SCOPE_AGENT)); DN_LOAD(c + 1); }
        const v4u z0 = *(const v4u*)(proj + (row0 + fr_) * PW + PC_Z + h * HD + fp_ * 16), z1 = *(const v4u*)(proj + (row0 + fr_) * PW + PC_Z + h * HD + fp_ * 16 + 8);
        dn_bf16x8 SB[4];
#pragma unroll
        for (int s = 0; s < 4; ++s) SB[s] = pack8f(Sacc[2 * s], Sacc[2 * s + 1]);
        f32x4 VN[4], O[4];
#pragma unroll
        for (int ct = 0; ct < 4; ++ct) { const dn_u32x2 uu = *(const LAS dn_u32x2*)(L + S_UT + (n0 + m) * 144 + (16 * ct + 4 * g) * 2);
            VN[ct] = (f32x4){bflo(uu.x), bfhi(uu.x), bflo(uu.y), bfhi(uu.y)}; O[ct] = (f32x4){0.f, 0.f, 0.f, 0.f};
#pragma unroll
            for (int s = 0; s < 4; ++s) { VN[ct] = mfma16(*(const LAS dn_bf16x8*)(L + S_WN + (16 * ct + m) * 272 + (32 * s + 8 * g) * 2), SB[s], VN[ct]);
                O[ct] = mfma16(*(const LAS dn_bf16x8*)(L + S_QG + (16 * ct + m) * 272 + (32 * s + 8 * g) * 2), SB[s], O[ct]); } }
        dn_bf16x8 VNB[2];
#pragma unroll
        for (int sp = 0; sp < 2; ++sp) VNB[sp] = pack8f(VN[2 * sp], VN[2 * sp + 1]);
#pragma unroll
        for (int ct = 0; ct < 4; ++ct)
#pragma unroll
            for (int sp = 0; sp < 2; ++sp) O[ct] = mfma16(*(const LAS dn_bf16x8*)(L + S_QKM + (16 * ct + m) * 144 + (32 * sp + 8 * g) * 2), VNB[sp], O[ct]);
#pragma unroll
        for (int kt = 0; kt < 8; ++kt) { Sacc[kt] = Sacc[kt] * eg;
#pragma unroll
            for (int sp = 0; sp < 2; ++sp) Sacc[kt] = mfma16(*(const LAS dn_bf16x8*)(L + S_KDT + (16 * kt + m) * 144 + (32 * sp + 8 * g) * 2), VNB[sp], Sacc[kt]); }
#pragma unroll
        for (int ct = 0; ct < 4; ++ct)
#pragma unroll
            for (int r = 0; r < 4; ++r) { const float x = O[ct][r]; OB[(16 * ct + 4 * g + r) * 132 + n0 + m] = x;
                const float ss = row16_sum(x * x);
                if (m == 0) PSQ[wave * 64 + 16 * ct + 4 * g + r] = ss; }
        __syncthreads();
        if (c + 1 < SEQ / 64) DN_WRITE();
        { float ss = 0.f;
#pragma unroll
          for (int w = 0; w < 8; ++w) ss += PSQ[w * 64 + fr_];
          const float rn = rsqrtf(ss * (1.f / 128.f) + EPS);
          f32x4 o4[4];
#pragma unroll
          for (int q = 0; q < 4; ++q) o4[q] = *(const LAS f32x4*)(OB + fr_ * 132 + fp_ * 16 + 4 * q);
          const unsigned zz[8] = {z0.x, z0.y, z0.z, z0.w, z1.x, z1.y, z1.z, z1.w}; unsigned ow[8];
#pragma unroll
          for (int q = 0; q < 8; ++q) { const float za = bflo(zz[q]), zb = bfhi(zz[q]);
              const float a = o4[q >> 1][2 * (q & 1)] * rn * w4[q >> 1][2 * (q & 1)] * (za * __builtin_amdgcn_rcpf(1.f + __expf(-za)));
              const float bq = o4[q >> 1][2 * (q & 1) + 1] * rn * w4[q >> 1][2 * (q & 1) + 1] * (zb * __builtin_amdgcn_rcpf(1.f + __expf(-zb)));
              ow[q] = pkbf(a, bq); }
          bf16* dst = proj + (row0 + fr_) * PW + PC_Q + h * HD + fp_ * 16;
          *(v4u*)dst = (v4u){ow[0], ow[1], ow[2], ow[3]}; *(v4u*)(dst + 8) = (v4u){ow[4], ow[5], ow[6], ow[7]}; }
        __syncthreads();
    }
#undef DN_LOAD
#undef DN_WRITE
}
__device__ __forceinline__ void norm_heads(int lane, bf16* rowp, int nheads, const float* ssq, size_t hb_stride, const float* w) {
    if (lane < 8 * nheads) { const int head = lane >> 3, d0 = (lane & 7) * 16;
        const f32x4 s4 = *(const f32x4*)(ssq + (size_t)head * hb_stride);
        const float r = rsqrtf(((s4[0] + s4[1]) + (s4[2] + s4[3])) * (1.f / 128.f) + EPS);
        bf16* p = rowp + head * HD + d0;
        const v4u a = *(const v4u*)p, b = *(const v4u*)(p + 8);
        const f32x4 w0 = *(const f32x4*)(w + d0), w1 = *(const f32x4*)(w + d0 + 4), w2 = *(const f32x4*)(w + d0 + 8), w3 = *(const f32x4*)(w + d0 + 12);
        v4u oa, ob;
        oa.x = pkbf(bflo(a.x) * r * w0[0], bfhi(a.x) * r * w0[1]); oa.y = pkbf(bflo(a.y) * r * w0[2], bfhi(a.y) * r * w0[3]);
        oa.z = pkbf(bflo(a.z) * r * w1[0], bfhi(a.z) * r * w1[1]); oa.w = pkbf(bflo(a.w) * r * w1[2], bfhi(a.w) * r * w1[3]);
        ob.x = pkbf(bflo(b.x) * r * w2[0], bfhi(b.x) * r * w2[1]); ob.y = pkbf(bflo(b.y) * r * w2[2], bfhi(b.y) * r * w2[3]);
        ob.z = pkbf(bflo(b.z) * r * w3[0], bfhi(b.z) * r * w3[1]); ob.w = pkbf(bflo(b.w) * r * w3[2], bfhi(b.w) * r * w3[3]);
        *(v4u*)p = oa; *(v4u*)(p + 8) = ob; }
}
__device__ __forceinline__ void norm_pass(const Frame& F, int layer) {
    const Tix T = tix(F.wv); const int gw = F.bid * NWAVES + T.wave, NGW = F.G * NWAVES;
    bf16* proj = (bf16*)(F.ws + WS_PROJ); const float* ssq = (const float*)(F.ws + WS_SSQ); const size_t hbs = (size_t)MROWS * 4;
    for (int m = gw; m < MROWS; m += NGW) {
        if (layer == 1) { norm_heads(T.lane, proj + (size_t)m * PW + PC_K, 8, ssq + (size_t)m * 4, hbs, F.in[I_FOXKNW]);
                          norm_heads(T.lane, proj + (size_t)m * PW + PC_Q, 8, ssq + 24 * hbs + (size_t)m * 4, hbs, F.in[I_FOXQNW]); }
        norm_heads(T.lane, proj + (size_t)m * PW + PC_QM, 4, ssq + 32 * hbs + (size_t)m * 4, hbs, F.in[I_MEMQNW] + layer * HD);
    }
    if (layer == 0) for (int m = gw; m < MMEM; m += NGW)
        norm_heads(T.lane, (bf16*)(F.ws + WS_MEMKV) + (size_t)m * DM, 4, (const float*)(F.ws + WS_MSSQ) + (size_t)m * 4, (size_t)MMEM * 4, F.in[I_MEMKNW]);
}
__device__ __forceinline__ void fox_blk(const Frame& F, int it, int j, att::Blk& k) {
    const int bh = it >> 2, y = it & 3, qb = j == 0 ? y : 7 - y, b = bh >> 3, h = bh & 7; const size_t row0 = (size_t)b * SEQ + qb * 256;
    bf16* proj = (bf16*)(F.ws + WS_PROJ);
    k.Q = proj + row0 * PW + PC_Q + h * HD; k.K = proj + (size_t)b * SEQ * PW + PC_K + h * HD; k.voff = PC_V - PC_K; k.goff = PC_Z - PC_Q;
    k.fcum = (const float*)(F.ws + WS_FCUM) + (size_t)bh * SEQ; k.P0 = qb * 256; k.skv = SEQ; k.kvpitch = PW;
}
__device__ __forceinline__ void mem_blk(const Frame& F, int idx, att::Blk& k) {
    const int b = idx >> 5, hm = (idx >> 3) & 3, qb = idx & 7; const size_t row0 = (size_t)b * SEQ + qb * 256;
    bf16* proj = (bf16*)(F.ws + WS_PROJ); const bf16* mkv = (const bf16*)(F.ws + WS_MEMKV);
    static_assert(att::QP == PW, "attention Q pitch");
    k.Q = proj + row0 * PW + PC_QM + hm * HD; k.K = mkv + (size_t)b * NMEM * DM + hm * HD; k.voff = 512; k.goff = 0;
    k.fcum = nullptr; k.P0 = 1 << 20; k.skv = NMEM; k.kvpitch = DM;
}
struct SrcL1 { const Frame* F; int vcu;
    __device__ __forceinline__ bool operator()(int n, att::Blk& k) const { const int it = vcu + (n / 3) * F->G, j = n % 3; if (it >= 256) return false;
        if (j < 2) fox_blk(*F, it, j, k); else mem_blk(*F, it, k); return true; } };
struct SrcL0 { const Frame* F; int first, stride;
    __device__ __forceinline__ bool operator()(int n, att::Blk& k) const { const int idx = first + n * stride; if (idx >= 256) return false; mem_blk(*F, idx, k); return true; } };
__device__ __forceinline__ void fcum_unit(const Frame& F, int bh) {
    const Tix T = tix(F.wv); const int b = bh >> 3, h = bh & 7, tid = T.tid, lane = T.lane, wave = T.wave;
    const float* AB = (const float*)(F.ws + WS_AB); const float fb = F.in[I_FOXFB][h];
    LAS float* wt = (LAS float*)F.lds;
    float f[4];
#pragma unroll
    for (int e = 0; e < 4; ++e) { const float x = AB[((size_t)b * SEQ + tid * 4 + e) * 16 + h] + fb; f[e] = fminf(x, 0.f) - log1pf(__expf(-fabsf(x))); }
    f[1] += f[0]; f[2] += f[1]; f[3] += f[2];
    float sc = f[3];
#pragma unroll
    for (int o = 1; o < 64; o <<= 1) { const float t = __shfl_up(sc, o); if (lane >= o) sc += t; }
    __syncthreads();
    if (lane == 63) wt[wave] = sc;
    __syncthreads();
    float off = sc - f[3];
    for (int w = 0; w < wave; ++w) off += wt[w];
    float* out = (float*)(F.ws + WS_FCUM) + (size_t)bh * SEQ + tid * 4;
    *(f32x4*)out = (f32x4){f[0] + off, f[1] + off, f[2] + off, f[3] + off};
    __syncthreads();
}

#define IN(k) (lo <= (k) && (k) < hi)
#define SEAM(k) do { if (IN(k) && IN((k) + 1)) xcd_barrier(bar); } while (0)
template <int layer> __device__ __forceinline__ void layer_body(const Frame& F, const XcdBarrier& bar, int lo, int hi, unsigned char* lds) {
    bf16* proj = (bf16*)(F.ws + WS_PROJ); bf16* xb = (bf16*)(F.ws + WS_XB); float* xsq = (float*)(F.ws + WS_XSQ);
    float* ssq = (float*)(F.ws + WS_SSQ); float* ab = (float*)(F.ws + WS_AB);

        const int pb = 1 + (layer ? 6 : 0);
        if (IN(pb)) {
            pg8::Gemm g{xb, (const bf16*)(F.ws + (layer ? WS_WIN1 : WS_WIN0)), MROWS, N_IN, DM, DM}; pg8::StaticOrder S; S.init(MROWS, N_IN, F.G, F.bid);
            pg8::EpiProj<true, false, layer == 0> E{proj, PW, xsq, ssq, MROWS, ab, 18, (bf16*)((unsigned char*)F.out + DO_HALO)};
            pg8::gemm_phase<pg8::EpiProj<true, false, layer == 0>, pg8::StaticOrder, true, true>(F.lds, g, S, E, F.wv);
            if (layer == 0) {
                pg8::Gemm g2{(const bf16*)((unsigned char*)F.out + DO_MEMB), (const bf16*)(F.ws + WS_WMKV), MMEM, DM, DM, DM}; pg8::StaticOrder S2; S2.init(MMEM, DM, F.G, F.G - 1 - F.bid);
                pg8::EpiProj<true, false> E2{(bf16*)(F.ws + WS_MEMKV), DM, (const float*)(F.ws + WS_MSQ), (float*)(F.ws + WS_MSSQ), MMEM, nullptr, 4, nullptr};
                pg8::gemm_phase<pg8::EpiProj<true, false>, pg8::StaticOrder, true, true>(F.lds, g2, S2, E2, F.wv);
            }
        }
        SEAM(pb);
        const int pm = pb + 2;
        if (IN(pb + 1)) { if (layer == 1) for (int bh = F.bid; bh < 64; bh += F.G) fcum_unit(F, bh);
                          norm_pass(F, layer);
                          if (layer == 0) { constexpr int NU = BATCH * NH * (SEQ / 64); DnPre R; int u = F.bid; if (u < NU) dn_prep_load(F, u, R);
                              for (; u < NU; u += F.G) dn_prep_unit(F, u, u + F.G < NU ? u + F.G : -1, R); } }
        SEAM(pb + 1);
        if (IN(pm)) {
            if (layer == 0) {
                if (F.G > 64) { if (F.bid < 64) dn_scan_unit(F, F.bid); else { const SrcL0 src{&F, F.bid - 64, F.G - 64}; att::phase((char*)lds, src, F.wv); } }
                else { for (int bh = F.bid; bh < 64; bh += F.G) dn_scan_unit(F, bh); const SrcL0 src{&F, F.bid, F.G}; att::phase((char*)lds, src, F.wv); }
            } else {
                const int vcu = (F.G % 8 == 0) ? (F.bid % 8) * (F.G / 8) + F.bid / 8 : F.bid;
                const SrcL1 src{&F, vcu}; att::phase((char*)lds, src, F.wv);
            }
            __syncthreads();
        }
        SEAM(pm);
        if (IN(pm + 1)) {
            pg8::Gemm g{proj + PC_Q, (const bf16*)(F.ws + (layer ? WS_WOUT1 : WS_WOUT0)), MROWS, DM, OUT_IN, PW}; pg8::StaticOrder S; S.init(MROWS, DM, F.G, F.bid);
            pg8::EpiRes E{layer ? (const float*)F.out : F.in[I_X], F.out, xb, xsq};
            pg8::gemm_phase<pg8::EpiRes, pg8::StaticOrder, true, true>(F.lds, g, S, E, F.wv);
        }
        SEAM(pm + 1);
        if (IN(pm + 2)) {
            pg8::Gemm g{xb, (const bf16*)(F.ws + (layer ? WS_WM1_1 : WS_WM1_0)), MROWS, FF, DM, DM}; pg8::StaticOrder S; S.init(MROWS, FF, F.G, F.bid);
            pg8::EpiProj<false, true> E{proj, FF, xsq, nullptr, 0, nullptr, 16, nullptr};
            pg8::gemm_phase<pg8::EpiProj<false, true>, pg8::StaticOrder, true, true>(F.lds, g, S, E, F.wv);
        }
        SEAM(pm + 2);
        if (IN(pm + 3)) {
            pg8::Gemm g{proj, (const bf16*)(F.ws + (layer ? WS_WM2_1 : WS_WM2_0)), MROWS, DM, FF, FF}; pg8::StaticOrder S; S.init(MROWS, DM, F.G, F.bid);
            pg8::EpiRes E{(const float*)F.out, F.out, xb, xsq};
            pg8::gemm_phase<pg8::EpiRes, pg8::StaticOrder, true, true>(F.lds, g, S, E, F.wv);
        }
        SEAM(pm + 3);
    }
#undef IN
#undef SEAM
__global__ void __launch_bounds__(NWAVES * 64, 2) hyb_fwd(Args args) {
    extern __shared__ __attribute__((aligned(16))) unsigned char lds[];
    Frame F;
    F.lds = (LAS unsigned char*)lds;
    F.G = gridDim.x; F.bid = blockIdx.x; F.in = args.in; F.out = args.out; F.ws = args.ws; F.wv = __builtin_amdgcn_readfirstlane((int)threadIdx.x >> 6);
    volatile LAS unsigned* MISC = (volatile LAS unsigned*)(F.lds + MISC_OFF);
    gu32* ctl = (gu32*)(args.ws + WS_CTL);
    for (int u = threadIdx.x; u < (LDS_BYTES - MISC_OFF) / 4; u += NWAVES * 64) ((LAS unsigned*)(F.lds + MISC_OFF))[u] = 0u;
    __syncthreads();
    XcdBarrier bar; bar.bar = (unsigned*)(ctl + CW_BAR) + args.li * XCD_BAR_WORDS; bar.x = 0; bar.st = nullptr; bar.wv = F.wv;
    if (!MK_LAUNCH_PER_PHASE) { bar = xcd_barrier_post((unsigned*)(ctl + CW_BAR) + args.li * XCD_BAR_WORDS, MISC + 8); bar.wv = F.wv; }
    const int lo = args.ph_lo, hi = args.ph_hi;
#define IN(k) (lo <= (k) && (k) < hi)
#define SEAM(k) do { if (IN(k) && IN((k) + 1)) xcd_barrier(bar); } while (0)
    bf16* proj = (bf16*)(F.ws + WS_PROJ); bf16* xb = (bf16*)(F.ws + WS_XB); float* xsq = (float*)(F.ws + WS_XSQ);
    float* ssq = (float*)(F.ws + WS_SSQ); float* ab = (float*)(F.ws + WS_AB);

    if (IN(0)) { p0_prologue(F); } SEAM(0);

    layer_body<0>(F, bar, lo, hi, lds);
    layer_body<1>(F, bar, lo, hi, lds);
#undef IN
#undef SEAM
}

extern "C" void kernel_launch(void* const* d_in, const int* in_sizes, int n_in, void* d_out, int out_size, void* d_ws, size_t ws_size, hipStream_t stream) {
    static int grid = 0;
    if (grid == 0) {
        if (n_in != 20 || in_sizes[0] != MROWS * DM || out_size != MROWS * DM || ws_size < WS_END) {
            fprintf(stderr, "kernel_launch: shape/workspace mismatch (n_in %d, in0 %d, out %d, ws %zu; need ws >= %zu); nothing launched\n", n_in, n_in > 0 ? in_sizes[0] : -1, out_size, ws_size, (size_t)WS_END); grid = -1; return; }
        int dev = 0, cus = 0, per_cu = 0;
        if (hipGetDevice(&dev) != hipSuccess || hipDeviceGetAttribute(&cus, hipDeviceAttributeMultiprocessorCount, dev) != hipSuccess) { fprintf(stderr, "kernel_launch: device query failed\n"); grid = -1; return; }
        if (hipFuncSetAttribute((const void*)hyb_fwd, hipFuncAttributeMaxDynamicSharedMemorySize, LDS_BYTES) != hipSuccess) { fprintf(stderr, "kernel_launch: hipFuncSetAttribute failed\n"); grid = -1; return; }
        if (hipOccupancyMaxActiveBlocksPerMultiprocessor(&per_cu, (const void*)hyb_fwd, NWAVES * 64, LDS_BYTES) != hipSuccess || per_cu < 1) {
            fprintf(stderr, "kernel_launch: occupancy query reports %d workgroups per CU; nothing launched\n", per_cu); (void)hipGetLastError(); grid = -1; return; }
        grid = cus;
    }
    if (grid < 0) return;
    if (hipMemsetAsync((char*)d_ws + WS_CTL, 0, CTL_ZERO_BYTES, stream) != hipSuccess) { fprintf(stderr, "kernel_launch: memset failed\n"); return; }
    Args a{};
    for (int i = 0; i < 20; ++i) a.in[i] = (const float*)d_in[i];
    a.out = (float*)d_out; a.ws = (unsigned char*)d_ws;
#if MK_LAUNCH_PER_PHASE
    for (int p = 0; p < N_PHASES; ++p) { a.ph_lo = p; a.ph_hi = p + 1; a.li = 0; hipLaunchKernelGGL(hyb_fwd, dim3(grid), dim3(NWAVES * 64), LDS_BYTES, stream, a); }
#else
    a.ph_lo = 0; a.ph_hi = N_PHASES; a.li = 0;
    hipLaunchKernelGGL(hyb_fwd, dim3(grid), dim3(NWAVES * 64), LDS_BYTES, stream, a);
#endif
    const hipError_t le = hipPeekAtLastError();
    if (le != hipSuccess) fprintf(stderr, "kernel_launch: launch failed: %s\n", hipGetErrorName(le));
}
```

```cpp
#include <hip/hip_runtime.h>
#include <cstdio>
#include <cstdint>

constexpr int BATCH = 8, SEQ = 2048, DM = 1024, MROWS = BATCH * SEQ;
constexpr int NMEM = 256, MMEM = BATCH * NMEM;
constexpr int HD = 128, NH = 8, NMH = 4, FF = 4096;
constexpr int PW = 4608;
constexpr int PC_K = 0, PC_V = 1024, PC_Z = 2048, PC_Q = 3072, PC_QM = 4096, PC_AB = 4608;
constexpr int N_IN = 4864;
constexpr int DN_IN = 4624, FOX_IN = 4616, OUT_IN = 1536;
constexpr float EPS = 1e-6f;
constexpr float QSCALE = 0.08838834764831845f;

__device__ __forceinline__ int lane_id_v() { int x; asm volatile("v_mbcnt_lo_u32_b32 %0, -1, 0\n\tv_mbcnt_hi_u32_b32 %0, -1, %0" : "=v"(x)); return x; }
template <int CTRL> __device__ __forceinline__ float dppf(float x) { return __builtin_bit_cast(float, __builtin_amdgcn_update_dpp(0, __builtin_bit_cast(int, x), CTRL, 0xf, 0xf, true)); }
__device__ __forceinline__ float row16_sum(float x) { x += dppf<0xB1>(x); x += dppf<0x4E>(x); x += dppf<0x141>(x); x += dppf<0x140>(x); return x; }
__device__ __forceinline__ float add_xor16(float x) { auto r = __builtin_amdgcn_permlane16_swap(__float_as_uint(x), __float_as_uint(x), false, false); return __uint_as_float(r[0]) + __uint_as_float(r[1]); }
__device__ __forceinline__ float add_xor32(float x) { auto r = __builtin_amdgcn_permlane32_swap(__float_as_uint(x), __float_as_uint(x), false, false); return __uint_as_float(r[0]) + __uint_as_float(r[1]); }
namespace pg8 {
#define PG8_LAS __attribute__((address_space(3)))
typedef unsigned short bf16_t;
typedef short bf16x8 __attribute__((ext_vector_type(8)));
typedef float f32x4 __attribute__((ext_vector_type(4)));
typedef unsigned u32x4 __attribute__((ext_vector_type(4)));
constexpr int BM = 256, BK = 64, HALF = 128, HTB = HALF * BK * 2  , STAGE_BYTES = 8 * HTB, NXCD = 8, WGM = 8;

__host__ __device__ __forceinline__ int lds_byte(int r, int c) { const int st = (r >> 4) * 2 + (c >> 5), rr = r & 15, cc = c & 31, ob = rr * 64 + cc * 2; return st * 1024 + (ob ^ (((ob >> 9) & 1) << 5)); }
__host__ __device__ __forceinline__ void stage_rc(int b, int& R, int& C) { const int st = b / 1024, sb = b % 1024, swz = sb ^ (((sb >> 9) & 1) << 5); R = (st >> 1) * 16 + swz / 64; C = (st & 1) * 32 + (swz % 64) / 2; }
__host__ __device__ __forceinline__ int perm32(int rho) { const int n = rho >> 4, i = rho & 15; return 8 * (i >> 2) + 4 * n + (i & 3); }

struct Unit { int pm, pn; };
struct Gemm { const bf16_t* A; const bf16_t* Bt; int M, N, K, lda; };

struct StaticOrder {
    int nM, nN, nwg, G, c;
    __host__ __device__ void init(int M, int N, int G_, int c_) { nM = M / BM; nN = N / BM; nwg = nM * nN; G = G_; c = c_; }
    __host__ __device__ bool next(int i, Unit& u) const {
        const long L = (long)i * G + c; if (L >= nwg) return false;
        int wgid = (int)L; { const int q = nwg / NXCD, r = nwg % NXCD, xcd = wgid % NXCD, off = wgid / NXCD; wgid = (xcd < r ? xcd * (q + 1) : r * (q + 1) + (xcd - r) * q) + off; }
        const int nig = WGM * nN, gid = wgid / nig, fm = gid * WGM, gsz = (nM - fm) < WGM ? (nM - fm) : WGM;
        u.pm = fm + ((wgid % nig) % gsz); u.pn = (wgid % nig) / gsz; return true;
    }
    __device__ __forceinline__ void a_ready(const Unit&) const {}
    __device__ __forceinline__ void done(const Unit&) const {}
};


__device__ __forceinline__ unsigned cvt_pk_bf16(float lo, float hi) { unsigned r; asm volatile("v_cvt_pk_bf16_f32 %0, %1, %2" : "=v"(r) : "v"(lo), "v"(hi)); return r; }

constexpr int EPI_XCH = 131072, EPI_RS = 139264;
template <bool NORM, bool RELU2, bool HALO = false> struct EpiProj {
    static constexpr bool PERM = true, AFTER_DRAIN = false, USE_RS = true;
    bf16_t* O; int ldc; const float* xsq; float* ab; int n_main; bf16_t* halo;
    int nlo0, nhi0; const float* nw0; int nlo1, nhi1; const float* nw1; int nlo2, nhi2; const float* nw2;
    __device__ __forceinline__ void rs_load(const Unit& u, int tid, f32x4 (&q)[4]) const { const float* p = xsq + (size_t)(u.pm * BM + tid) * 16;
#pragma unroll
        for (int i = 0; i < 4; ++i) q[i] = *(const f32x4*)(p + 4 * i); }
    __device__ __forceinline__ void rs_store(const f32x4 (&q)[4], PG8_LAS unsigned char* lds, int parity, int tid) const {
        const f32x4 t = (q[0] + q[1]) + (q[2] + q[3]);
        ((PG8_LAS float*)(lds + EPI_RS))[parity * 256 + tid] = rsqrtf(((t[0] + t[1]) + (t[2] + t[3])) * (1.0f / 1024.0f) + 1e-6f); }
    __device__ __forceinline__ void operator()(const f32x4 (&acc)[2][2][4][2], const Unit& u, int wr, int wc, int fr, int fq, PG8_LAS unsigned char* lds, int parity) const {
        const int rl0 = wr * 64 + fr, row0 = u.pm * BM + rl0, colt = u.pn * BM;
        const bool is_ab = u.pn >= n_main;
        const PG8_LAS float* RS = (const PG8_LAS float*)(lds + EPI_RS) + parity * 256;
        const float* nw = nullptr;
        if (NORM) { if (u.pn >= nlo0 && u.pn < nhi0) nw = nw0; else if (u.pn >= nlo1 && u.pn < nhi1) nw = nw1; else if (u.pn >= nlo2 && u.pn < nhi2) nw = nw2; }
        f32x4 w0 = {1.f, 1.f, 1.f, 1.f}, w1 = w0;
        if (NORM && nw != nullptr) {
            w0 = *(const f32x4*)(nw + wc * 32 + 8 * fq); w1 = *(const f32x4*)(nw + wc * 32 + 8 * fq + 4);
            PG8_LAS float* X = (PG8_LAS float*)(lds + EPI_XCH);
#pragma unroll
            for (int ai = 0; ai < 2; ++ai)
#pragma unroll
                for (int m = 0; m < 4; ++m) { const int rl = rl0 + ai * HALF + m * 16; const float rstd = RS[rl];
#pragma unroll
                    for (int bj = 0; bj < 2; ++bj) { const f32x4 v0 = acc[ai][bj][m][0] * rstd, v1 = acc[ai][bj][m][1] * rstd;
                        float ss = ((v0[0] * v0[0] + v0[1] * v0[1]) + (v0[2] * v0[2] + v0[3] * v0[3])) + ((v1[0] * v1[0] + v1[1] * v1[1]) + (v1[2] * v1[2] + v1[3] * v1[3]));
                        ss = add_xor32(add_xor16(ss));
                        if (fq == 0) X[(bj * 256 + rl) * 4 + wc] = ss; } }
            asm volatile("s_waitcnt lgkmcnt(0)" ::: "memory"); __builtin_amdgcn_s_barrier(); asm volatile("" ::: "memory");
        }
#pragma unroll
        for (int ai = 0; ai < 2; ++ai)
#pragma unroll
            for (int m = 0; m < 4; ++m) {
                const int rl = rl0 + ai * HALF + m * 16, r = row0 + ai * HALF + m * 16;
                const float rstd = RS[rl];
                if (!is_ab) {
#pragma unroll
                    for (int bj = 0; bj < 2; ++bj) {
                        float sc = rstd;
                        if (NORM && nw != nullptr) { const f32x4 p4 = *(const PG8_LAS f32x4*)((const PG8_LAS float*)(lds + EPI_XCH) + (bj * 256 + rl) * 4);
                            sc = rstd * rsqrtf(((p4[0] + p4[1]) + (p4[2] + p4[3])) * (1.0f / 128.0f) + 1e-6f); }
                        f32x4 v0 = acc[ai][bj][m][0] * sc * w0, v1 = acc[ai][bj][m][1] * sc * w1;
                        if (RELU2) {
#pragma unroll
                            for (int e = 0; e < 4; ++e) { const float a = fmaxf(v0[e], 0.f), b = fmaxf(v1[e], 0.f); v0[e] = a * a; v1[e] = b * b; }
                        }
                        u32x4 w; w.x = cvt_pk_bf16(v0[0], v0[1]); w.y = cvt_pk_bf16(v0[2], v0[3]); w.z = cvt_pk_bf16(v1[0], v1[1]); w.w = cvt_pk_bf16(v1[2], v1[3]);
                        *(u32x4*)(O + (size_t)r * ldc + colt + bj * HALF + wc * 32 + 8 * fq) = w;
                        if (HALO && m == 3 && fr >= 13) *(u32x4*)(halo + ((size_t)(r >> 6) * 3 + ((r & 63) - 61)) * ldc + colt + bj * HALF + wc * 32 + 8 * fq) = w;
                    }
                } else if (ab != nullptr && wc == 0 && fq < 2) {
                    float* p = ab + (size_t)r * 16 + 8 * fq;
                    *(f32x4*)p = acc[ai][0][m][0] * rstd; *(f32x4*)(p + 4) = acc[ai][0][m][1] * rstd;
                }
            }
    }
};
struct EpiRes {
    static constexpr bool PERM = true, AFTER_DRAIN = false, USE_RS = false;
    const float* xold; float* xnew; bf16_t* xb; float* xsq;
    __device__ __forceinline__ void operator()(const f32x4 (&acc)[2][2][4][2], const Unit& u, int wr, int wc, int fr, int fq, PG8_LAS unsigned char*, int) const {
        const int row0 = u.pm * BM + wr * 64 + fr, colt = u.pn * BM;
#pragma unroll
        for (int ai = 0; ai < 2; ++ai)
#pragma unroll
            for (int m = 0; m < 4; ++m) {
                const int r = row0 + ai * HALF + m * 16; float ss = 0.f;
#pragma unroll
                for (int bj = 0; bj < 2; ++bj) {
                    const size_t off = (size_t)r * 1024 + colt + bj * HALF + wc * 32 + 8 * fq;
                    const f32x4 v0 = acc[ai][bj][m][0] + *(const f32x4*)(xold + off), v1 = acc[ai][bj][m][1] + *(const f32x4*)(xold + off + 4);
                    *(f32x4*)(xnew + off) = v0; *(f32x4*)(xnew + off + 4) = v1;
                    ss += ((v0[0] * v0[0] + v0[1] * v0[1]) + (v0[2] * v0[2] + v0[3] * v0[3])) + ((v1[0] * v1[0] + v1[1] * v1[1]) + (v1[2] * v1[2] + v1[3] * v1[3]));
                    u32x4 w; w.x = cvt_pk_bf16(v0[0], v0[1]); w.y = cvt_pk_bf16(v0[2], v0[3]); w.z = cvt_pk_bf16(v1[0], v1[1]); w.w = cvt_pk_bf16(v1[2], v1[3]);
                    *(u32x4*)(xb + off) = w;
                }
                ss = add_xor32(add_xor16(ss));
                if (fq == 0) xsq[(size_t)r * 16 + u.pn * 4 + wc] = ss;
            }
    }
};

template <class Epi, class Sched, bool ALIGN_EPI = false, bool SP2 = false>
__device__ __forceinline__ void gemm_phase(PG8_LAS unsigned char* lds, const Gemm g, const Sched& S, const Epi& E, int wid) {
    const int lane = lane_id_v();
    const int tid = wid * 64 + lane, wr = wid >> 2, wc = wid & 3, fr = lane & 15, fq = lane >> 4;
    const int K = g.K, nt = K / BK;
    unsigned voffA[2], voffB[2];
#pragma unroll
    for (int i = 0; i < 2; ++i) { int R, C; stage_rc(tid * 16 + i * 8192, R, C); const int Rb = Epi::PERM ? ((R & ~31) + perm32(R & 31)) : R;
        voffA[i] = (unsigned)(R * g.lda + C) * 2u; voffB[i] = (unsigned)(Rb * K + C) * 2u; }
    const size_t kstep = (size_t)(BK * 2);
    const size_t hstepA = (size_t)HALF * g.lda * 2, hstepB = (size_t)HALF * K * 2;
    const size_t tstepA = 2 * hstepA, tstepB = 2 * hstepB;
    const unsigned ldsw = (unsigned)wid * 1024u;
    const int aoff = lds_byte(wr * 64 + fr, fq * 8), boff = lds_byte(wc * 32 + fr, fq * 8);
#define PG8_SA(b, h) (((b) * 2 + (h)) * HTB)
#define PG8_SB(b, h) ((4 + (b) * 2 + (h)) * HTB)
#define PG8_STAGE(bufoff, gbase, voff) do { _Pragma("unroll") for (int _i = 0; _i < 2; ++_i) \
        __builtin_amdgcn_global_load_lds((const unsigned*)((const char*)(gbase) + (voff)[_i]), (PG8_LAS unsigned*)(lds + (bufoff) + ldsw + _i * 8192), 16, 0, 0); } while (0)
#define PG8_LDA(dst, b, h) do { _Pragma("unroll") for (int m = 0; m < 4; ++m) _Pragma("unroll") for (int k = 0; k < 2; ++k) dst[m][k] = *(const PG8_LAS bf16x8*)(lds + PG8_SA(b, h) + aoff + m * 2048 + k * 1024); } while (0)
#define PG8_LDB(dst, b, h) do { _Pragma("unroll") for (int n = 0; n < 2; ++n) _Pragma("unroll") for (int k = 0; k < 2; ++k) dst[n][k] = *(const PG8_LAS bf16x8*)(lds + PG8_SB(b, h) + boff + n * 2048 + k * 1024); } while (0)
#define PG8_MMA(ai, bj, At, Bt) do { __builtin_amdgcn_s_setprio(1); _Pragma("unroll") for (int m = 0; m < 4; ++m) _Pragma("unroll") for (int n = 0; n < 2; ++n) _Pragma("unroll") for (int k = 0; k < 2; ++k) \
        acc[ai][bj][m][n] = __builtin_amdgcn_mfma_f32_16x16x32_bf16(Bt[n][k], At[m][k], acc[ai][bj][m][n], 0, 0, 0); __builtin_amdgcn_s_setprio(0); } while (0)
#define PG8_WAIT_V(n) asm volatile("s_waitcnt vmcnt(" #n ")" ::: "memory")
#define PG8_WAIT_L(n) asm volatile("s_waitcnt lgkmcnt(" #n ")" ::: "memory")
#define PG8_BAR __builtin_amdgcn_s_barrier()
#define PG8_SCHED __builtin_amdgcn_sched_barrier(0)
    Unit cur, nxt; int ui = 0;
    if (!S.next(0, cur)) return;
    f32x4 acc[2][2][4][2];
#pragma unroll
    for (int a = 0; a < 2; ++a)
#pragma unroll
        for (int b = 0; b < 2; ++b)
#pragma unroll
            for (int m = 0; m < 4; ++m)
#pragma unroll
                for (int n = 0; n < 2; ++n) acc[a][b][m][n] = (f32x4){0.f, 0.f, 0.f, 0.f};
    bf16x8 At[4][2], B0[2][2], B1[2][2];
    const char* cA = (const char*)g.A + (size_t)cur.pm * tstepA; const char* cB = (const char*)g.Bt + (size_t)cur.pn * tstepB;
    S.a_ready(cur);
    if constexpr (Epi::USE_RS) { if (tid < 256) { f32x4 rq[4]; E.rs_load(cur, tid, rq); E.rs_store(rq, lds, 0, tid); } }
    if constexpr (SP2) {
        PG8_STAGE(PG8_SB(0, 0), cB, voffB); PG8_STAGE(PG8_SB(0, 1), cB + hstepB, voffB); PG8_STAGE(PG8_SA(0, 0), cA, voffA); PG8_STAGE(PG8_SA(0, 1), cA + hstepA, voffA);
        if (wr == 1) PG8_BAR;
        PG8_WAIT_V(2); PG8_BAR;
        PG8_STAGE(PG8_SB(1, 0), cB + kstep, voffB); PG8_STAGE(PG8_SA(1, 0), cA + kstep, voffA); PG8_STAGE(PG8_SB(1, 1), cB + hstepB + kstep, voffB);
        PG8_WAIT_V(6); PG8_BAR;
    } else {
        PG8_STAGE(PG8_SB(0, 0), cB, voffB); PG8_STAGE(PG8_SA(0, 0), cA, voffA); PG8_STAGE(PG8_SB(0, 1), cB + hstepB, voffB); PG8_STAGE(PG8_SA(0, 1), cA + hstepA, voffA);
        if (wr == 1) PG8_BAR;
        PG8_WAIT_V(4); PG8_BAR;
        PG8_STAGE(PG8_SB(1, 0), cB + kstep, voffB); PG8_STAGE(PG8_SA(1, 0), cA + kstep, voffA); PG8_STAGE(PG8_SB(1, 1), cB + hstepB + kstep, voffB);
        PG8_WAIT_V(6); PG8_BAR;
    }
    for (;;) {
        const bool has_next = S.next(ui + 1, nxt);
        const char* nA = has_next ? (const char*)g.A + (size_t)nxt.pm * tstepA : cA; const char* nB = has_next ? (const char*)g.Bt + (size_t)nxt.pn * tstepB : cB;
        for (int t = 0; t < nt; t += 2) {
            const bool last = (t == nt - 2);
            const char* a1 = cA + (size_t)(t + 1) * kstep;
            const char* a2 = last ? nA : cA + (size_t)(t + 2) * kstep; const char* b2 = last ? nB : cB + (size_t)(t + 2) * kstep;
            const char* a3 = a2 + kstep; const char* b3 = b2 + kstep;
            if (last && has_next) S.a_ready(nxt);
            if constexpr (SP2) {
            PG8_LDB(B0, 0, 0); PG8_LDB(B1, 0, 1); PG8_SCHED; PG8_LDA(At, 0, 0); PG8_STAGE(PG8_SA(1, 1), a1 + hstepA, voffA);
            PG8_WAIT_V(8); PG8_WAIT_L(0); PG8_BAR; PG8_MMA(0, 0, At, B0); PG8_MMA(0, 1, At, B1); PG8_BAR; PG8_SCHED;
            PG8_LDA(At, 0, 1); PG8_STAGE(PG8_SB(0, 0), b2, voffB); PG8_STAGE(PG8_SB(0, 1), b2 + hstepB, voffB); PG8_STAGE(PG8_SA(0, 0), a2, voffA);
            PG8_WAIT_V(8); PG8_WAIT_L(0); PG8_BAR; PG8_MMA(1, 0, At, B0); PG8_MMA(1, 1, At, B1); PG8_BAR; PG8_SCHED;
            PG8_LDB(B0, 1, 0); PG8_LDB(B1, 1, 1); PG8_SCHED; PG8_LDA(At, 1, 0); PG8_STAGE(PG8_SA(0, 1), a2 + hstepA, voffA);
            PG8_WAIT_V(8); PG8_WAIT_L(0); PG8_BAR; PG8_MMA(0, 0, At, B0); PG8_MMA(0, 1, At, B1); PG8_BAR; PG8_SCHED;
            PG8_LDA(At, 1, 1); PG8_STAGE(PG8_SB(1, 0), b3, voffB); PG8_STAGE(PG8_SB(1, 1), b3 + hstepB, voffB); PG8_STAGE(PG8_SA(1, 0), a3, voffA);
            PG8_WAIT_V(8); PG8_WAIT_L(0); PG8_BAR; PG8_MMA(1, 0, At, B0); PG8_MMA(1, 1, At, B1); PG8_BAR; PG8_SCHED;
            } else {
            PG8_LDB(B0, 0, 0); PG8_SCHED; PG8_LDA(At, 0, 0); PG8_STAGE(PG8_SA(1, 1), a1 + hstepA, voffA);
            PG8_WAIT_L(8); PG8_BAR; PG8_WAIT_L(0); PG8_MMA(0, 0, At, B0); PG8_BAR; PG8_SCHED;
            PG8_LDB(B1, 0, 1); PG8_STAGE(PG8_SB(0, 0), b2, voffB);
            PG8_BAR; PG8_WAIT_L(0); PG8_MMA(0, 1, At, B1); PG8_BAR;
            PG8_LDA(At, 0, 1); PG8_STAGE(PG8_SA(0, 0), a2, voffA);
            PG8_BAR; PG8_WAIT_L(0); PG8_MMA(1, 0, At, B0); PG8_BAR; PG8_SCHED;
            PG8_STAGE(PG8_SB(0, 1), b2 + hstepB, voffB);
            PG8_WAIT_V(6); PG8_BAR; PG8_MMA(1, 1, At, B1); PG8_BAR;
            PG8_LDB(B0, 1, 0); PG8_SCHED; PG8_LDA(At, 1, 0); PG8_STAGE(PG8_SA(0, 1), a2 + hstepA, voffA);
            PG8_WAIT_L(8); PG8_BAR; PG8_WAIT_L(0); PG8_MMA(0, 0, At, B0); PG8_BAR; PG8_SCHED;
            PG8_LDB(B1, 1, 1); PG8_STAGE(PG8_SB(1, 0), b3, voffB);
            PG8_BAR; PG8_WAIT_L(0); PG8_MMA(0, 1, At, B1); PG8_BAR;
            PG8_LDA(At, 1, 1); PG8_STAGE(PG8_SA(1, 0), a3, voffA);
            PG8_BAR; PG8_WAIT_L(0); PG8_MMA(1, 0, At, B0); PG8_BAR; PG8_SCHED;
            PG8_STAGE(PG8_SB(1, 1), b3 + hstepB, voffB);
            PG8_WAIT_V(6); PG8_BAR; PG8_MMA(1, 1, At, B1); PG8_BAR;
            }
        }
        if constexpr (ALIGN_EPI) { if (wr == 0) PG8_BAR; }
        if constexpr (Epi::USE_RS) {
            f32x4 rq[4]; if (has_next && tid < 256) E.rs_load(nxt, tid, rq);
            E(acc, cur, wr, wc, fr, fq, lds, ui & 1);
            if (has_next && tid < 256) E.rs_store(rq, lds, (ui + 1) & 1, tid);
        } else { E(acc, cur, wr, wc, fr, fq, lds, ui & 1); }
        S.done(cur);
        if (!has_next) break;
#pragma unroll
        for (int a = 0; a < 2; ++a)
#pragma unroll
            for (int b = 0; b < 2; ++b)
#pragma unroll
                for (int m = 0; m < 4; ++m)
#pragma unroll
                    for (int n = 0; n < 2; ++n) acc[a][b][m][n] = (f32x4){0.f, 0.f, 0.f, 0.f};
        cur = nxt; cA = nA; cB = nB; ++ui;
        if constexpr (ALIGN_EPI) { if (wr == 1) PG8_BAR; }
    }
    PG8_WAIT_V(0);
    if constexpr (!ALIGN_EPI) { if (wr == 0) PG8_BAR; }
    PG8_BAR;
    if constexpr (Epi::AFTER_DRAIN) { E.fused(acc, cur, wr, wc, fr, fq, lds, wid, lane); S.done(cur); }
#undef PG8_SA
#undef PG8_SB
#undef PG8_STAGE
#undef PG8_LDA
#undef PG8_LDB
#undef PG8_MMA
#undef PG8_WAIT_V
#undef PG8_WAIT_L
#undef PG8_BAR
#undef PG8_SCHED
}
}

namespace att {
typedef unsigned short bf16_t;
typedef short bf16x8 __attribute__((ext_vector_type(8)));
typedef short s16x4 __attribute__((ext_vector_type(4)));
typedef float f32x16 __attribute__((ext_vector_type(16)));
typedef float f32x4 __attribute__((ext_vector_type(4)));
typedef unsigned u32x4 __attribute__((ext_vector_type(4)));
constexpr int NW = 8, QBLK = 32, KVBLK = 64, QB = NW * QBLK, D = 128;
constexpr int SHM_V = KVBLK * D * 2, SHM_K = KVBLK * D * 2;
constexpr int OFF_WS = 2 * SHM_V + 2 * SHM_K, OFF_BK = OFF_WS + NW * 64 * 4, ATT_LDS = OFF_BK + 8192;
constexpr float SCALE = 0.08838834764831845f, THR = 8.f;
constexpr int WBIG = 1 << 30;
#define KSWZ(row, colB) ((row) * 256 + ((colB) ^ (((row) & 7) << 4)))
#define SBAR() __builtin_amdgcn_sched_barrier(0)
__device__ __forceinline__ int v_st(int k, int c) { const int kk = (k & ~0xC) | ((k & 4) << 1) | ((k & 8) >> 1); return ((kk >> 3) * 4 + (c >> 5)) * 512 + ((kk & 7) * 32 + (c & 31)) * 2; }
__device__ __forceinline__ int v_rd_base(int lane) { return ((lane & 3) << 3) | (((lane >> 2) & 3) << 6) | (((lane >> 4) & 1) << 5) | (((lane >> 5) & 1) << 8); }
constexpr int v_rd_off(int d0, int ks, int half) { return d0 * 512 + ks * 4096 + half * 2048; }
__device__ __forceinline__ int crow(int r, int hi) { return (r & 3) + 8 * (r >> 2) + 4 * hi; }
__device__ __forceinline__ unsigned cvtpk(float lo, float hi) { unsigned r; asm volatile("v_cvt_pk_bf16_f32 %0, %1, %2" : "=v"(r) : "v"(lo), "v"(hi)); return r; }
__device__ __forceinline__ bf16x8 load8(const bf16_t* p) { return *reinterpret_cast<const bf16x8*>(p); }
__device__ __forceinline__ void mask_tile(f32x16& p0, f32x16& p1, int dq, unsigned W) {
    const float NEG = -__builtin_inff();
#pragma unroll
    for (int r = 0; r < 16; ++r) { const int c = (r & 3) + 8 * (r >> 2);
        if ((unsigned)(dq - c) >= W) p0[r] = NEG;
        if ((unsigned)(dq - c - 32) >= W) p1[r] = NEG; }
}
__device__ __forceinline__ void partialSM(f32x16& p0, f32x16& p1, float& m_reg, float& mn, float& alpha) {
    float pmax = p0[0]; for (int r = 1; r < 16; ++r) pmax = fmaxf(pmax, p0[r]); for (int r = 0; r < 16; ++r) pmax = fmaxf(pmax, p1[r]);
    { auto rr = __builtin_amdgcn_permlane32_swap(__float_as_uint(pmax), __float_as_uint(pmax), false, false);
      pmax = fmaxf(__uint_as_float(rr[0]), __uint_as_float(rr[1])); }
    constexpr float C2 = 1.4426950408889634f * SCALE;
    if (__builtin_expect(__all((pmax - m_reg) * SCALE <= THR), 1)) { mn = m_reg; alpha = 1.f; }
    else { mn = fmaxf(m_reg, pmax); alpha = __builtin_amdgcn_exp2f((m_reg - mn) * C2); m_reg = mn; }
    const float mnL = -mn * C2;
    for (int r = 0; r < 16; ++r) p0[r] = fmaf(p0[r], C2, mnL); for (int r = 0; r < 16; ++r) p1[r] = fmaf(p1[r], C2, mnL);
    for (int r = 0; r < 16; ++r) p0[r] = __builtin_amdgcn_exp2f(p0[r]);
}
__device__ __forceinline__ void finishSM(f32x16& p0, f32x16& p1, float alpha, float& l_reg, bf16x8& pa0, bf16x8& pa1, bf16x8& pa2, bf16x8& pa3) {
    for (int r = 0; r < 16; ++r) p1[r] = __builtin_amdgcn_exp2f(p1[r]);
    float ps = 0; for (int r = 0; r < 16; ++r) ps += p0[r]; for (int r = 0; r < 16; ++r) ps += p1[r];
    { auto rr = __builtin_amdgcn_permlane32_swap(__float_as_uint(ps), __float_as_uint(ps), false, false);
      ps = __uint_as_float(rr[0]) + __uint_as_float(rr[1]); }
    l_reg = l_reg * alpha + ps;
#define PK4(P, B_, OUT) do { unsigned a0 = cvtpk(P[B_+0], P[B_+1]), a1 = cvtpk(P[B_+2], P[B_+3]);                          \
        unsigned b0 = cvtpk(P[B_+4], P[B_+5]), b1 = cvtpk(P[B_+6], P[B_+7]);                                             \
        auto r0 = __builtin_amdgcn_permlane32_swap(a0, b0, false, false); auto r1 = __builtin_amdgcn_permlane32_swap(a1, b1, false, false); \
        u32x4 w = {r0[0], r1[0], r0[1], r1[1]}; OUT = *reinterpret_cast<bf16x8*>(&w); } while (0)
    PK4(p0, 0, pa0); PK4(p0, 8, pa1); PK4(p1, 0, pa2); PK4(p1, 8, pa3);
#undef PK4
}
template <int KB>
__device__ __forceinline__ void qkt(f32x16& p0, f32x16& p1, const char* K_lds, int r32, int hi, const bf16x8* qr, const float* bb) {
#pragma unroll
    for (int g = 0; g < 4; ++g) { const f32x4 b0 = *(const f32x4*)(bb + 8 * g), b1 = *(const f32x4*)(bb + 32 + 8 * g);
#pragma unroll
        for (int i = 0; i < 4; ++i) { p0[4 * g + i] = b0[i]; p1[4 * g + i] = b1[i]; } }
    const char* kb[4];
#pragma unroll
    for (int dd = 0; dd < 4; ++dd) kb[dd] = K_lds + KB * SHM_K + KSWZ(r32, (dd * 16 + hi * 8) * 2);
#pragma unroll
    for (int d0 = 0; d0 < 8; ++d0) { const char* a = kb[d0 & 3] + (d0 >> 2) * 128;
        bf16x8 b0 = *reinterpret_cast<const bf16x8*>(a);
        bf16x8 b1 = *reinterpret_cast<const bf16x8*>(a + 32 * 256);
        p0 = __builtin_amdgcn_mfma_f32_32x32x16_bf16(b0, qr[d0], p0, 0, 0, 0);
        p1 = __builtin_amdgcn_mfma_f32_32x32x16_bf16(b1, qr[d0], p1, 0, 0, 0); }
}
template <int VB>
__device__ __forceinline__ void pv_tile(f32x16* o, int vb0, bf16x8 pa0, bf16x8 pa1, bf16x8 pa2, bf16x8 pa3) {
#define TRRD(dst, off) asm volatile("ds_read_b64_tr_b16 %0, %1 offset:%2" : "=&v"(dst) : "v"(vb0), "i"(off) : "memory")
#define PV_D0(d0) do { s16x4 l0, l1, l2, l3, h0, h1, h2, h3; constexpr int b_ = VB * SHM_V + v_rd_off(d0, 0, 0);   \
        TRRD(l0, b_); TRRD(h0, b_ + 2048); TRRD(l1, b_ + 4096); TRRD(h1, b_ + 6144); TRRD(l2, b_ + 8192); TRRD(h2, b_ + 10240); TRRD(l3, b_ + 12288); TRRD(h3, b_ + 14336); \
        asm volatile("s_waitcnt lgkmcnt(0)" ::: "memory"); SBAR();   \
        o[d0] = __builtin_amdgcn_mfma_f32_32x32x16_bf16(pa0, (bf16x8){l0[0], l0[1], l0[2], l0[3], h0[0], h0[1], h0[2], h0[3]}, o[d0], 0, 0, 0);   \
        o[d0] = __builtin_amdgcn_mfma_f32_32x32x16_bf16(pa1, (bf16x8){l1[0], l1[1], l1[2], l1[3], h1[0], h1[1], h1[2], h1[3]}, o[d0], 0, 0, 0);   \
        o[d0] = __builtin_amdgcn_mfma_f32_32x32x16_bf16(pa2, (bf16x8){l2[0], l2[1], l2[2], l2[3], h2[0], h2[1], h2[2], h2[3]}, o[d0], 0, 0, 0);   \
        o[d0] = __builtin_amdgcn_mfma_f32_32x32x16_bf16(pa3, (bf16x8){l3[0], l3[1], l3[2], l3[3], h3[0], h3[1], h3[2], h3[3]}, o[d0], 0, 0, 0); } while (0)
    PV_D0(0); PV_D0(1); PV_D0(2); PV_D0(3);
#undef PV_D0
#undef TRRD
}
constexpr int QP = 4608;
struct Blk { bf16_t* Q; const bf16_t* K; const float* flog; float fb; int voff, goff, P0, skv, kvpitch; };
struct Seam { bf16x8 qr[8]; bf16x8 st_v0, st_v1, st_k0, st_k1; };
#define ROW(p, pitch, k0, rr) ((p) + (size_t)((k0) + (rr)) * (pitch) + sc)
#define VMW() asm volatile("s_waitcnt vmcnt(0)" ::: "memory")
#define VMWN(n) asm volatile("s_waitcnt vmcnt(%0)" :: "i"(n) : "memory")
#define SLOAD_H(Kp, Vp, pitch, k0) do { S.st_v0 = load8(ROW(Vp, pitch, k0, sr)); S.st_v1 = load8(ROW(Vp, pitch, k0, 32 + sr));              \
                         S.st_k0 = load8(ROW(Kp, pitch, k0, sr)); S.st_k1 = load8(ROW(Kp, pitch, k0, 32 + sr)); } while (0)
#define SWRITE_HK(bf) do { *(bf16x8*)(K_lds + (bf) * SHM_K + kws) = S.st_k0; *(bf16x8*)(K_lds + (bf) * SHM_K + kws + 32 * 256) = S.st_k1; } while (0)
#define SWRITE_HV(bf) do { *(bf16x8*)(V_lds + (bf) * SHM_V + vst0) = S.st_v0; *(bf16x8*)(V_lds + (bf) * SHM_V + vst1) = S.st_v1; } while (0)
#define SWRITE_H(bf) do { SWRITE_HV(bf); SWRITE_HK(bf); } while (0)
__device__ __forceinline__ void prime(const Blk& cur, char* lds, Seam& S, int wid) {
    const int lane = lane_id_v();
    const int tid = wid * 64 + lane, r32 = lane & 31, hi = lane >> 5;
    const int sr = tid >> 4, sc = (tid & 15) * 8, kws = KSWZ(sr, sc * 2); char* K_lds = lds + 2 * SHM_V;
    for (int d0 = 0; d0 < 8; ++d0) S.qr[d0] = load8(cur.Q + (size_t)(wid * QBLK + r32) * QP + d0 * 16 + hi * 8);
    SLOAD_H(cur.K, cur.K + cur.voff, cur.kvpitch, 0); VMW(); SWRITE_HK(0);
    __syncthreads();
}
__device__ __forceinline__ void block(const Blk& cur, const Blk& nxt, char* lds, Seam& S, int wid) {
    const int lane = lane_id_v();
    const int tid = wid * 64 + lane, r32 = lane & 31, hi = lane >> 5;
    constexpr int W = WBIG;
    int j_hi = (cur.P0 + QB - 1) / KVBLK + 1; if (j_hi > cur.skv / KVBLK) j_hi = cur.skv / KVBLK;
    const int NT = j_hi;
    const int qlo = cur.P0 + wid * QBLK, qm = qlo + r32 - 4 * hi;
    char* V_lds = lds; char* K_lds = lds + 2 * SHM_V;
    float* ws = (float*)(lds + OFF_WS) + wid * 64; float* li_l = ws, * al_l = ws + 32;
    float* bkl = (float*)(lds + OFF_BK);
    { const int nkeys = NT * KVBLK;
      if (cur.flog) { const int k0 = 4 * tid; float f[4];
#pragma unroll
          for (int e = 0; e < 4; ++e) { float x = 0.f; if (k0 + e < nkeys) x = cur.flog[(size_t)(k0 + e) * 16] + cur.fb;
              f[e] = k0 + e < nkeys ? fminf(x, 0.f) - log1pf(__expf(-fabsf(x))) : 0.f; }
          f[1] += f[0]; f[2] += f[1]; f[3] += f[2];
          float sc = f[3];
#pragma unroll
          for (int o_ = 1; o_ < 64; o_ <<= 1) { const float t_ = __shfl_up(sc, o_); if (lane >= o_) sc += t_; }
          if (lane == 63) ws[0] = sc;
          __syncthreads();
          float off = sc - f[3];
          for (int w_ = 0; w_ < wid; ++w_) off += ((const float*)(lds + OFF_WS))[w_ * 64];
#pragma unroll
          for (int e = 0; e < 4; ++e) if (k0 + e < nkeys) bkl[k0 + e] = -(f[e] + off) * (1.f / SCALE); }
      else for (int k = tid; k < nkeys; k += NW * 64) bkl[k] = 0.f;
      __syncthreads(); }
    float m_reg = -1e30f, l_reg = 0; f32x16 o[4] = {};
    const int sr = tid >> 4, sc = (tid & 15) * 8, vst0 = v_st(sr, sc), vst1 = v_st(32 + sr, sc), kws = KSWZ(sr, sc * 2);
    const int vb0 = (int)(uintptr_t)V_lds + v_rd_base(lane);
    const bf16_t* Kh = cur.K; const bf16_t* Vh = cur.K + cur.voff; const int kvp = cur.kvpitch;
#define RESC(a) do { if (__any((a) < 1.f)) { if (hi == 0) al_l[r32] = (a); asm volatile("s_waitcnt lgkmcnt(0)" ::: "memory");              \
                     for (int d_ = 0; d_ < 4; ++d_) for (int r = 0; r < 16; ++r) o[d_][r] *= al_l[crow(r, hi)]; } } while (0)
#define KBASE(t) ((t) * KVBLK)
#define MASKT(P0_, P1_, t) do { const int kb_ = KBASE(t); if (kb_ + KVBLK - 1 > qlo) mask_tile(P0_, P1_, qm - kb_, (unsigned)W); } while (0)
#define BB(t) (bkl + KBASE(t) + 4 * hi)
    constexpr int NQL = 8;
#define SEAM_K0() do { VMWN(NQL); SWRITE_HK(0); SBAR(); } while (0)
    f32x16 pA0, pA1, pB0, pB1; float mnA, mnB, alA, alB; bf16x8 pa0, pa1, pa2, pa3;
    SWRITE_HV(0); SBAR();
    if (NT > 1) { SLOAD_H(Kh, Vh, kvp, KBASE(1)); }
    SBAR(); qkt<0>(pA0, pA1, K_lds, r32, hi, S.qr, BB(0));
    MASKT(pA0, pA1, 0); partialSM(pA0, pA1, m_reg, mnA, alA);
    if (NT > 1) { VMW(); SWRITE_H(1); }
    __syncthreads();
#define HALF_STEP(PX0, PX1, mnX, alX, PY0, PY1, alY, t, KB, VB, SB) do {                                                      \
        SBAR(); qkt<KB>(PX0, PX1, K_lds, r32, hi, S.qr, BB(t));                                                                      \
        finishSM(PY0, PY1, alY, l_reg, pa0, pa1, pa2, pa3); SBAR();                                                           \
        if ((t) + 1 < NT) { SLOAD_H(Kh, Vh, kvp, KBASE((t) + 1)); SBAR(); }                                                   \
        pv_tile<VB>(o, vb0, pa0, pa1, pa2, pa3); MASKT(PX0, PX1, (t)); partialSM(PX0, PX1, m_reg, mnX, alX);   \
        __syncthreads();                                                                                                      \
        if ((t) + 1 < NT) { VMW(); SWRITE_H(SB); }                                                                            \
        RESC(alX); __syncthreads(); } while (0)
    for (int t = 1; t + 1 < NT; t += 2) {
        HALF_STEP(pB0, pB1, mnB, alB, pA0, pA1, alA, t, 1, 0, 0);
        HALF_STEP(pA0, pA1, mnA, alA, pB0, pB1, alB, t + 1, 0, 1, 1);
    }
    const bool even = (NT & 1) == 0;
    if (even) { SBAR(); qkt<1>(pB0, pB1, K_lds, r32, hi, S.qr, BB(NT - 1)); SBAR(); }
    SLOAD_H(nxt.K, nxt.K + nxt.voff, nxt.kvpitch, 0); SBAR();
#pragma unroll
    for (int d0 = 0; d0 < 8; ++d0) S.qr[d0] = load8(nxt.Q + (size_t)(wid * QBLK + r32) * QP + d0 * 16 + hi * 8);
    SBAR();
    finishSM(pA0, pA1, alA, l_reg, pa0, pa1, pa2, pa3); SBAR();
    pv_tile<0>(o, vb0, pa0, pa1, pa2, pa3);
    if (even) { MASKT(pB0, pB1, NT - 1); partialSM(pB0, pB1, m_reg, mnB, alB); __syncthreads(); RESC(alB);
        finishSM(pB0, pB1, alB, l_reg, pa0, pa1, pa2, pa3); SBAR(); pv_tile<1>(o, vb0, pa0, pa1, pa2, pa3); }
    SBAR(); SEAM_K0();
    if (hi == 0) li_l[r32] = l_reg; asm volatile("s_waitcnt lgkmcnt(0)" ::: "memory");
    float rli[16];
#pragma unroll
    for (int r = 0; r < 16; ++r) rli[r] = __builtin_amdgcn_rcpf(li_l[crow(r, hi)]);
    bf16_t* Ow = cur.Q + (size_t)(wid * QBLK + 4 * hi) * QP + r32; const int goff = cur.goff;
#pragma unroll
    for (int r = 0; r < 16; ++r) { const int ro = ((r & 3) + 8 * (r >> 2)) * QP;
#pragma unroll
        for (int d0 = 0; d0 < 4; ++d0) { float v = o[d0][r] * rli[r];
            if (goff) { const float g = __uint_as_float((unsigned)Ow[goff + ro + d0 * 32] << 16); v *= __builtin_amdgcn_rcpf(1.f + __expf(-g)); }
            const float vn = dppf<0xB1>(v);
            if ((r32 & 1) == 0) *(unsigned*)(Ow + ro + d0 * 32) = cvtpk(v, vn); } }
    __syncthreads();
#undef RESC
#undef KBASE
#undef MASKT
#undef BB
#undef SEAM_K0
#undef HALF_STEP
}
#undef ROW
#undef VMW
#undef VMWN
#undef SLOAD_H
#undef SWRITE_HK
#undef SWRITE_HV
#undef SWRITE_H
#undef KSWZ
#undef SBAR
template <class Src> __device__ __forceinline__ void phase(char* lds, const Src& src, int wid) {
    Blk cur, nxt; if (!src(0, cur)) return;
    Seam S; prime(cur, lds, S, wid);
    for (int n = 0;; ++n) { const bool more = src(n + 1, nxt); if (!more) nxt = cur; block(cur, nxt, lds, S, wid); if (!more) break; cur = nxt; }
}
}

constexpr int NWAVES = 8;
#ifndef MK_LAUNCH_PER_PHASE
#define MK_LAUNCH_PER_PHASE 0
#endif
constexpr int N_PHASES = 12;

constexpr size_t KiB = 1u << 10, MiB = 1u << 20;
constexpr size_t WS_CTL = 0, CTL_ZERO_BYTES = 1 * MiB;
constexpr size_t WS_WIN0 = 1 * MiB, WS_WIN1 = WS_WIN0 + (size_t)N_IN * DM * 2;
constexpr size_t WS_WOUT0 = 20 * MiB, WS_WOUT1 = 23 * MiB;
constexpr size_t WS_WM1_0 = 26 * MiB, WS_WM1_1 = 34 * MiB, WS_WM2_0 = 42 * MiB, WS_WM2_1 = 50 * MiB;
constexpr size_t WS_WMKV = 58 * MiB;
constexpr size_t WS_PROJ = 60 * MiB;
constexpr size_t WS_XB = 204 * MiB;
constexpr size_t WS_SSQ = 236 * MiB;
constexpr size_t WS_AB = 245 * MiB;
constexpr size_t WS_MEMKV = 246 * MiB;
constexpr size_t WS_XSQ = 250 * MiB;
constexpr size_t WS_FCUM = 251 * MiB;
constexpr size_t WS_MSSQ = 251 * MiB + 512 * KiB;
constexpr size_t WS_MSQ = 251 * MiB + 768 * KiB;
constexpr size_t WS_END = 252 * MiB;
static_assert(WS_WIN1 + (size_t)N_IN * DM * 2 <= WS_WOUT0 && WS_PROJ + (size_t)MROWS * PW * 2 <= WS_XB && WS_SSQ + (size_t)36 * MROWS * 16 <= WS_AB, "d_ws map");
constexpr size_t DO_MEMB = 0;
constexpr int CW_BAR = 4096;

constexpr int LDS_BYTES = 155648;
constexpr int MISC_OFF = LDS_BYTES - 256;

#define GAS __attribute__((address_space(1)))
#define LAS __attribute__((address_space(3)))
typedef unsigned short bf16;
typedef unsigned v4u __attribute__((ext_vector_type(4)));
typedef float f32x4 __attribute__((ext_vector_type(4)));
typedef short bf16x8 __attribute__((ext_vector_type(8)));
typedef GAS unsigned gu32;
typedef GAS unsigned long long gu64;
#define RLX_AGENT __ATOMIC_RELAXED, __HIP_MEMORY_SCOPE_AGENT
#define LDS_WAIT() asm volatile("s_waitcnt lgkmcnt(0)" ::: "memory")
#define VM_WAIT() asm volatile("s_waitcnt vmcnt(0)" ::: "memory")
__device__ __forceinline__ unsigned long long rt() { return __builtin_amdgcn_s_memrealtime(); }
__device__ __forceinline__ unsigned f2bf(float f) { unsigned u = __builtin_bit_cast(unsigned, f); return (u + 0x7fffu + ((u >> 16) & 1u)) >> 16; }
__device__ __forceinline__ unsigned pk2(float lo, float hi) { return f2bf(lo) | (f2bf(hi) << 16); }

#define XB_TMO      128
#define XB_XCNT(j)  (256  + 64 * (j))
#define XB_XSUB(j)  (1280 + 64 * (j))
#define XB_XGEN(j)  (2304 + 64 * (j))
#define XB_TOP      3328
#define XB_TOPGEN   3392
#define XCD_BAR_WORDS 3456
#define XB_SPIN_CAP (1u << 18)

__device__ __forceinline__ unsigned xb_ld(unsigned* p)              { return __hip_atomic_load(p, __ATOMIC_RELAXED, __HIP_MEMORY_SCOPE_AGENT); }
__device__ __forceinline__ unsigned xb_add(unsigned* p, unsigned v) { return __hip_atomic_fetch_add(p, v, __ATOMIC_RELAXED, __HIP_MEMORY_SCOPE_AGENT); }
__device__ __forceinline__ unsigned xb_xcc_id() { return (unsigned)__builtin_amdgcn_s_getreg((3 << 11) | 20) & 0xFu; }
#define XB_SPIN(cond, bar) do { unsigned _sp = 0; while (cond) { __builtin_amdgcn_s_sleep(1); \
    if ((++_sp & 255u) == 0u) { if (xb_ld(&(bar)[XB_TMO])) break; if (_sp > XB_SPIN_CAP) { atomicAdd(&(bar)[XB_TMO], 1u); break; } } } } while (0)

struct XcdBarrier {
    unsigned* bar; unsigned x; int wv;
    volatile LAS unsigned* st;
};

__device__ __forceinline__ XcdBarrier xcd_barrier_post(unsigned* bar, volatile LAS unsigned* st) {
    XcdBarrier b; b.bar = bar; b.x = xb_xcc_id(); b.st = st;
    if (threadIdx.x == 0) (void)xb_add(&bar[XB_XCNT(b.x)], 1u);
    return b;
}
__device__ __forceinline__ void xcd_barrier_complete(unsigned* bar, unsigned x, unsigned& nloc, unsigned& nx) {
    const unsigned G = gridDim.x * gridDim.y * gridDim.z;
    unsigned sum, cnt, mine, sp = 0u;
    for (;;) {
        sum = 0u; cnt = 0u; mine = 0u;
#pragma unroll
        for (unsigned j = 0; j < 16; ++j) { const unsigned c = xb_ld(&bar[XB_XCNT(j)]); sum += c; cnt += (c > 0u) ? 1u : 0u; mine = (j == x) ? c : mine; }
        if (sum == G) break;
        __builtin_amdgcn_s_sleep(1);
        if ((++sp & 255u) == 0u) { if (xb_ld(&bar[XB_TMO])) break; if (sp > XB_SPIN_CAP) { atomicAdd(&bar[XB_TMO], 1u); break; } }
    }
    nloc = mine > 0u ? mine : 1u; nx = cnt > 0u ? cnt : 1u;
}

__device__ __forceinline__ void xcd_barrier(const XcdBarrier& b) {
    asm volatile("s_waitcnt vmcnt(0)" ::: "memory");
    __syncthreads();
    if (b.wv == 0 && lane_id_v() == 0) {
        unsigned* bar = b.bar;
        __builtin_amdgcn_s_waitcnt(0);
        unsigned nloc = b.st[0], nx = b.st[1];
        if (nloc == 0u) { xcd_barrier_complete(bar, b.x, nloc, nx); b.st[0] = nloc; b.st[1] = nx; }
        const unsigned old = xb_add(&bar[XB_XSUB(b.x)], 1u);
        const unsigned gen = old / nloc;
        if (old + 1u == (gen + 1u) * nloc) {
            __builtin_amdgcn_fence(__ATOMIC_RELEASE, "agent");
            asm volatile("s_waitcnt vmcnt(0)" ::: "memory");
            const unsigned og = xb_add(&bar[XB_TOP], 1u);
            const unsigned tg = og / nx;
            if (og + 1u == (tg + 1u) * nx) xb_add(&bar[XB_TOPGEN], 1u);
            else XB_SPIN(xb_ld(&bar[XB_TOPGEN]) == tg, bar);
            __builtin_amdgcn_fence(__ATOMIC_ACQUIRE, "agent");
            xb_add(&bar[XB_XGEN(b.x)], 1u);
            asm volatile("s_waitcnt vmcnt(0)" ::: "memory");
        } else {
            XB_SPIN(xb_ld(&bar[XB_XGEN(b.x)]) == gen, bar);
            __builtin_amdgcn_fence(__ATOMIC_ACQUIRE, "agent");
            asm volatile("s_waitcnt vmcnt(0)" ::: "memory");
        }
    }
    __syncthreads();
}


__device__ __forceinline__ float bflo(unsigned u) { return __builtin_bit_cast(float, u << 16); }
__device__ __forceinline__ float bfhi(unsigned u) { return __builtin_bit_cast(float, u & 0xffff0000u); }
typedef float f32x2_t __attribute__((ext_vector_type(2))); typedef __bf16 bf16x2_t __attribute__((ext_vector_type(2)));
__device__ __forceinline__ unsigned pkbf(float lo, float hi) { const f32x2_t v = {lo, hi}; const bf16x2_t b = __builtin_convertvector(v, bf16x2_t); return __builtin_bit_cast(unsigned, b); }
__device__ __forceinline__ float wave_sum(float v) { return add_xor32(add_xor16(row16_sum(v))); }
__device__ __forceinline__ float wave_max(float v) {
#pragma unroll
    for (int o = 1; o < 64; o <<= 1) v = fmaxf(v, __shfl_xor(v, o));
    return v;
}

struct Args { const float* in[20]; float* out; unsigned char* ws; int ph_lo, ph_hi, li, pad; };
enum { I_X = 0, I_MEM, I_MEMNW, I_WMKV, I_MEMKNW, I_NORM1, I_DNWIN, I_DNCONV, I_DNALOG, I_DNDT, I_DNONW, I_FOXWIN, I_FOXFB, I_FOXQNW, I_FOXKNW, I_MEMQNW, I_WOUT, I_NORM2, I_WM1, I_WM2 };

struct Frame {
    LAS unsigned char* lds;
    int G, bid, wv;
    const float* const* in; float* out; unsigned char* ws;
};


struct Tix { int tid, lane, wave; };
__device__ __forceinline__ int lane_id() { return lane_id_v(); }
__device__ __forceinline__ Tix tix(int wv) { Tix t; t.lane = lane_id(); t.wave = wv; t.tid = wv * 64 + t.lane; return t; }
struct TSeg { const float* W; int K, ldw, src0, ncols; bf16* WT; int dst0; const float* scale; };
__device__ __forceinline__ TSeg get_seg(const Frame& F, int s) {
    TSeg t; t.scale = nullptr; t.src0 = 0; t.dst0 = 0;
    if (s < 12) {
        const int l = s / 6, j = s % 6;
        t.W = l ? F.in[I_FOXWIN] : F.in[I_DNWIN]; t.K = DM; t.ldw = l ? FOX_IN : DN_IN; t.WT = (bf16*)(F.ws + (l ? WS_WIN1 : WS_WIN0)); t.scale = F.in[I_NORM1] + l * DM;
        const int qm0 = l ? 4104 : 4112, nsc = l ? 8 : 16;
        t.ncols = 1024;
        if (j == 0) { t.src0 = 1024; t.dst0 = PC_K; } else if (j == 1) { t.src0 = 2048; t.dst0 = PC_V; } else if (j == 2) { t.src0 = 3072; t.dst0 = PC_Z; }
        else if (j == 3) { t.src0 = 0; t.dst0 = PC_Q; } else if (j == 4) { t.src0 = qm0; t.dst0 = PC_QM; t.ncols = 512; } else { t.src0 = 4096; t.dst0 = PC_AB; t.ncols = nsc; }
    } else if (s < 14) { const int l = s - 12; t.W = F.in[I_WOUT] + (size_t)l * OUT_IN * DM; t.K = OUT_IN; t.ldw = DM; t.ncols = DM; t.WT = (bf16*)(F.ws + (l ? WS_WOUT1 : WS_WOUT0)); }
    else if (s < 16) { const int l = s - 14; t.W = F.in[I_WM1] + (size_t)l * DM * FF; t.K = DM; t.ldw = FF; t.ncols = FF; t.WT = (bf16*)(F.ws + (l ? WS_WM1_1 : WS_WM1_0)); t.scale = F.in[I_NORM2] + l * DM; }
    else if (s < 18) { const int l = s - 16; t.W = F.in[I_WM2] + (size_t)l * FF * DM; t.K = FF; t.ldw = DM; t.ncols = DM; t.WT = (bf16*)(F.ws + (l ? WS_WM2_1 : WS_WM2_0)); }
    else { t.W = F.in[I_WMKV]; t.K = DM; t.ldw = DM; t.ncols = DM; t.WT = (bf16*)(F.ws + WS_WMKV); t.scale = F.in[I_MEMNW]; }
    return t;
}
__device__ __forceinline__ int seg_items(const TSeg& t) { return (t.K / 64) * ((t.ncols + 63) / 64); }
__device__ __forceinline__ void tr_load(const TSeg& t, int item, int lane, f32x4 (&v)[16]) {
    const int nblk = (t.ncols + 63) / 64, kb = item / nblk, nb = item - kb * nblk, k0 = 64 * kb, n0 = 64 * nb;
    const int n4 = (lane & 15) * 4, kr = lane >> 4; const bool ok = (n0 + n4) < t.ncols;
    const float* p = t.W + (size_t)(k0 + kr) * t.ldw + t.src0 + n0 + n4;
#pragma unroll
    for (int i = 0; i < 16; ++i) v[i] = ok ? *(const f32x4*)(p + (size_t)(4 * i) * t.ldw) : (f32x4){0.f, 0.f, 0.f, 0.f};
}
__device__ __forceinline__ void tr_store(const TSeg& t, int item, int lane, const f32x4 (&v)[16], LAS float* scr) {
    const int nblk = (t.ncols + 63) / 64, kb = item / nblk, nb = item - kb * nblk, k0 = 64 * kb, n0 = 64 * nb;
    const int n4 = (lane & 15) * 4, kr = lane >> 4;
#pragma unroll
    for (int i = 0; i < 16; ++i) *(LAS f32x4*)(scr + (4 * i + kr) * 68 + n4) = v[i];
    LDS_WAIT(); asm volatile("" ::: "memory");
    const int c = lane & 7; f32x4 s0 = {1.f, 1.f, 1.f, 1.f}, s1 = s0;
    if (t.scale) { s0 = *(const f32x4*)(t.scale + k0 + 8 * c); s1 = *(const f32x4*)(t.scale + k0 + 8 * c + 4); }
#pragma unroll
    for (int j = 0; j < 8; ++j) { const int n = (lane >> 3) + 8 * j; const LAS float* q = scr + (8 * c) * 68 + n;
        v4u o; o.x = pkbf(q[0 * 68] * s0[0], q[1 * 68] * s0[1]); o.y = pkbf(q[2 * 68] * s0[2], q[3 * 68] * s0[3]); o.z = pkbf(q[4 * 68] * s1[0], q[5 * 68] * s1[1]); o.w = pkbf(q[6 * 68] * s1[2], q[7 * 68] * s1[3]);
        if (n0 + n < t.ncols) *(v4u*)(t.WT + (size_t)(t.dst0 + n0 + n) * t.K + k0 + 8 * c) = o; }
    LDS_WAIT(); asm volatile("" ::: "memory");
}
template <int NR> __device__ __forceinline__ void rows_to_bf16(int lane, const float* x, bf16* o, float* sq) {
    f32x4 v[NR][4];
#pragma unroll
    for (int r = 0; r < NR; ++r)
#pragma unroll
        for (int j = 0; j < 4; ++j) v[r][j] = ((const f32x4*)(x + (size_t)r * DM))[lane + 64 * j];
#pragma unroll
    for (int r = 0; r < NR; ++r) { float s = 0.f;
#pragma unroll
        for (int j = 0; j < 4; ++j) s += (v[r][j].x * v[r][j].x + v[r][j].y * v[r][j].y) + (v[r][j].z * v[r][j].z + v[r][j].w * v[r][j].w);
        s = wave_sum(s);
        unsigned long long* o8 = (unsigned long long*)(o + (size_t)r * DM) + lane;
#pragma unroll
        for (int j = 0; j < 4; ++j) o8[64 * j] = (unsigned long long)pkbf(v[r][j].x, v[r][j].y) | ((unsigned long long)pkbf(v[r][j].z, v[r][j].w) << 32);
        if (lane < 16) sq[(size_t)r * 16 + lane] = lane == 0 ? s : 0.f; }
}
template <int S0, int S1> __device__ __forceinline__ void convert_weights(const Frame& F, LAS float* scr, int lane, int gw, int NGW, int base) {
#pragma unroll
    for (int s = S0; s < S1; ++s) {
        const TSeg t = get_seg(F, s); const int n = seg_items(t);
        int it = gw - (base % NGW); if (it < 0) it += NGW;
        for (; it < n; it += NGW) { f32x4 v[16]; tr_load(t, it, lane, v); tr_store(t, it, lane, v, scr); }
        base += n;
    }
}
__device__ __forceinline__ void p0_prologue(const Frame& F) {
    const Tix T = tix(F.wv);
    LAS float* scr = (LAS float*)(F.lds + T.wave * 17408);
    const int gw = F.bid * NWAVES + T.wave, NGW = F.G * NWAVES;
    for (int m = gw * 4; m < MROWS; m += NGW * 4) rows_to_bf16<4>(T.lane, F.in[I_X] + (size_t)m * DM, (bf16*)(F.ws + WS_XB) + (size_t)m * DM, (float*)(F.ws + WS_XSQ) + (size_t)m * 16);
    for (int m = gw; m < MMEM; m += NGW) rows_to_bf16<1>(T.lane, F.in[I_MEM] + (size_t)m * DM, (bf16*)((unsigned char*)F.out + DO_MEMB) + (size_t)m * DM, (float*)(F.ws + WS_MSQ) + (size_t)m * 16);
    convert_weights<0, 6>(F, scr, T.lane, gw, NGW, 0);
    convert_weights<18, 19>(F, scr, T.lane, gw, NGW, 1168);
}

typedef short dn_bf16x8 __attribute__((ext_vector_type(8)));
typedef unsigned dn_u32x2 __attribute__((ext_vector_type(2)));
__device__ __forceinline__ f32x4 mfma16(dn_bf16x8 a, dn_bf16x8 b, f32x4 c) { return __builtin_amdgcn_mfma_f32_16x16x32_bf16(a, b, c, 0, 0, 0); }
__device__ __forceinline__ f32x4 mfma4(float a, float b, f32x4 c) { return __builtin_amdgcn_mfma_f32_16x16x4f32(a, b, c, 0, 0, 0); }
__device__ __forceinline__ dn_bf16x8 pack8f(f32x4 x, f32x4 y) { v4u w; w.x = pkbf(x[0], x[1]); w.y = pkbf(x[2], x[3]); w.z = pkbf(y[0], y[1]); w.w = pkbf(y[2], y[3]); return __builtin_bit_cast(dn_bf16x8, w); }
__device__ __forceinline__ dn_u32x2 pack4f(f32x4 x) { dn_u32x2 w; w.x = pkbf(x[0], x[1]); w.y = pkbf(x[2], x[3]); return w; }
__device__ __forceinline__ unsigned short bf1(float x) { return (unsigned short)(pkbf(x, 0.f) & 0xffffu); }
constexpr size_t DO_QKS = 4 * MiB, DO_HALO = 20 * MiB, DO_EGL = 27 * MiB;
constexpr int P_RAW = 0, P_GB = 51712, P_QH = 53248, P_KH = 70656, P_VBT = 88064, P_KBGT = 106496, P_QKL = 124928, P_END = 134144;
constexpr int P_AT = 0, P_TB = 17408, P_PS = 26624, P_PS2 = 29184;
struct DnPre { v4u P[7]; v4u Z[2]; float ga, gb; f32x4 cw[3][4]; };
__device__ __forceinline__ void dn_prep_load(const Frame& F, int u, DnPre& R) {
    const Tix T = tix(F.wv); const int tid = T.tid, lane = T.lane;
    const int bh = u >> 5, c = u & 31, b = bh >> 3, h = bh & 7; const size_t row0 = (size_t)b * SEQ + c * 64; const int gch = b * 32 + c;
    const bf16* proj = (const bf16*)(F.ws + WS_PROJ); const float* AB = (const float*)(F.ws + WS_AB); const bf16* halo = (const bf16*)((unsigned char*)F.out + DO_HALO);
#pragma unroll
    for (int j = 0; j < 7; ++j) { const int id = tid + 512 * j; v4u val = {0u, 0u, 0u, 0u};
        if (id < 67 * 48) { const int r = id / 48, rem = id - r * 48, seg = rem >> 4, ch = rem & 15;
            const int col = (seg == 0 ? PC_Q : seg == 1 ? PC_K : PC_V) + h * HD + ch * 8;
            if (r >= 3) val = *(const v4u*)(proj + (row0 + r - 3) * PW + col);
            else if (c > 0) val = *(const v4u*)(halo + ((size_t)(gch - 1) * 3 + r) * PW + col); }
        R.P[j] = val; }
    R.ga = AB[(row0 + lane) * 16 + h]; R.gb = AB[(row0 + lane) * 16 + 8 + h];
    { const bf16* zp = proj + (row0 + (tid >> 3)) * PW + PC_Z + h * HD + (tid & 7) * 16; R.Z[0] = *(const v4u*)zp; R.Z[1] = *(const v4u*)(zp + 8); }
    const float* convw = F.in[I_DNCONV]; const int c4 = lane & 31;
#pragma unroll
    for (int seg = 0; seg < 3; ++seg)
#pragma unroll
        for (int j = 0; j < 4; ++j) R.cw[seg][j] = *(const f32x4*)(convw + j * 3072 + seg * 1024 + h * HD + 4 * c4);
}
__device__ __forceinline__ void dn_prep_unit(const Frame& F, int u, int u_next, DnPre& R) {
    const Tix T = tix(F.wv); const int tid = T.tid, lane = T.lane, wave = T.wave, m = lane & 15, g = lane >> 4;
    const int bh = u >> 5, c = u & 31, b = bh >> 3, h = bh & 7; const size_t row0 = (size_t)b * SEQ + c * 64;
    bf16* proj = (bf16*)(F.ws + WS_PROJ);
    bf16* xbimg = (bf16*)(F.ws + WS_XB) + (size_t)u * 8192; bf16* qks = (bf16*)((unsigned char*)F.out + DO_QKS) + (size_t)u * 4096; float* egl = (float*)((unsigned char*)F.out + DO_EGL);
    LAS unsigned char* L = F.lds; LAS float* GB = (LAS float*)(L + P_GB);
#pragma unroll
    for (int j = 0; j < 7; ++j) { const int id = tid + 512 * j;
        if (id < 67 * 48) { const int r = id / 48, rem = id - r * 48, seg = rem >> 4, ch = rem & 15; *(LAS v4u*)(L + P_RAW + r * 768 + seg * 256 + ch * 16) = R.P[j]; } }
    if (wave == 0) { const float a = R.ga, bb = R.gb;
        const float x = a + F.in[I_DNDT][h], sp = fmaxf(x, 0.f) + log1pf(__expf(-fabsf(x)));
        const float gt = -__expf(F.in[I_DNALOG][h]) * sp, beta = __builtin_amdgcn_rcpf(1.f + __expf(-bb));
        float gc = gt;
#pragma unroll
        for (int o = 1; o < 64; o <<= 1) { const float t = __shfl_up(gc, o); if (lane >= o) gc += t; }
        const float gl = __shfl(gc, 63);
        GB[lane] = gc; GB[64 + lane] = beta; GB[128 + lane] = beta * __expf(gc); GB[192 + lane] = __expf(gl - gc); GB[256 + lane] = __expf(gc);
        if (lane == 0) egl[u] = __expf(gl); }
    f32x4 cw[3][4];
#pragma unroll
    for (int seg = 0; seg < 3; ++seg)
#pragma unroll
        for (int j = 0; j < 4; ++j) cw[seg][j] = R.cw[seg][j];
    { const float* onw = F.in[I_DNONW] + (tid & 7) * 16; const unsigned zz[8] = {R.Z[0].x, R.Z[0].y, R.Z[0].z, R.Z[0].w, R.Z[1].x, R.Z[1].y, R.Z[1].z, R.Z[1].w}; unsigned ow[8];
#pragma unroll
      for (int q = 0; q < 8; ++q) { const float za = bflo(zz[q]), zb = bfhi(zz[q]);
          ow[q] = pkbf(za * __builtin_amdgcn_rcpf(1.f + __expf(-za)) * onw[2 * q], zb * __builtin_amdgcn_rcpf(1.f + __expf(-zb)) * onw[2 * q + 1]); }
      bf16* zp = proj + (row0 + (tid >> 3)) * PW + PC_Z + h * HD + (tid & 7) * 16;
      *(v4u*)zp = (v4u){ow[0], ow[1], ow[2], ow[3]}; *(v4u*)(zp + 8) = (v4u){ow[4], ow[5], ow[6], ow[7]}; }
    __syncthreads();
    if (u_next >= 0) dn_prep_load(F, u_next, R);
    { const int hf = lane >> 5, c4 = lane & 31;
#pragma unroll
      for (int jj = 0; jj < 12; ++jj) { constexpr int dummy_ = 0; (void)dummy_; const int seg = jj >> 2;
        const int wi = wave + 8 * jj, i = 2 * (wi & 31) + hf;
        f32x4 y = {0.f, 0.f, 0.f, 0.f};
#pragma unroll
        for (int j = 0; j < 4; ++j) { const f32x4 w = cw[seg][j];
            const dn_u32x2 xx = *(const LAS dn_u32x2*)(L + P_RAW + (i + j) * 768 + seg * 256 + c4 * 8);
            y[0] += w[0] * bflo(xx.x); y[1] += w[1] * bfhi(xx.x); y[2] += w[2] * bflo(xx.y); y[3] += w[3] * bfhi(xx.y); }
        f32x4 s;
#pragma unroll
        for (int e = 0; e < 4; ++e) s[e] = y[e] * __builtin_amdgcn_rcpf(1.f + __expf(-y[e]));
        if (seg < 2) { float ss = (s[0] * s[0] + s[1] * s[1]) + (s[2] * s[2] + s[3] * s[3]);
            ss = add_xor16(row16_sum(ss));
            const float r = rsqrtf(ss + EPS) * (seg == 0 ? QSCALE : 1.f);
            s = s * r;
            *(LAS dn_u32x2*)(L + (seg == 0 ? P_QH : P_KH) + i * 272 + c4 * 8) = pack4f(s);
            if (seg == 0) { const int cc = c4 & 7, p0 = cc < 4 ? 8 * cc : 8 * (cc - 4) + 4;
                *(dn_u32x2*)(proj + (row0 + i) * PW + PC_Q + h * HD + 32 * (c4 >> 3) + p0) = pack4f(s * GB[256 + i]); }
            else { const float bge = GB[128 + i];
#pragma unroll
                for (int e = 0; e < 4; ++e) *(LAS unsigned short*)(L + P_KBGT + (4 * c4 + e) * 144 + i * 2) = bf1(s[e] * bge); } }
        else { const float be = GB[64 + i];
#pragma unroll
            for (int e = 0; e < 4; ++e) *(LAS unsigned short*)(L + P_VBT + (4 * c4 + e) * 144 + i * 2) = bf1(s[e] * be); } } }
    __syncthreads();
    LAS float* AT = (LAS float*)(L + P_AT);
#pragma unroll
    for (int q = 0; q < 2; ++q) { const int tt = wave + 8 * q, it = tt >> 2, jt = tt & 3;
        f32x4 kk = {0.f, 0.f, 0.f, 0.f}, qk = {0.f, 0.f, 0.f, 0.f};
        if (jt <= it) {
#pragma unroll
            for (int kq = 0; kq < 4; ++kq) { const dn_bf16x8 bk = *(const LAS dn_bf16x8*)(L + P_KH + (16 * jt + m) * 272 + (32 * kq + 8 * g) * 2);
                const dn_bf16x8 ak = *(const LAS dn_bf16x8*)(L + P_KH + (16 * it + m) * 272 + (32 * kq + 8 * g) * 2), aq = *(const LAS dn_bf16x8*)(L + P_QH + (16 * it + m) * 272 + (32 * kq + 8 * g) * 2);
                kk = mfma16(ak, bk, kk); qk = mfma16(aq, bk, qk); } }
        const int j = 16 * jt + m, jl = j & 31, p = jl < 16 ? 8 * (jl >> 2) + (jl & 3) : 8 * ((jl - 16) >> 2) + 4 + (jl & 3);
        const float gcj = GB[j];
#pragma unroll
        for (int r = 0; r < 4; ++r) { const int i = 16 * it + 4 * g + r; const float dec = i >= j ? __expf(GB[i] - gcj) : 0.f;
            AT[i * 68 + j] = i > j ? GB[64 + i] * kk[r] * dec : 0.f;
            *(LAS unsigned short*)(L + P_QKL + i * 144 + (32 * (j >> 5) + p) * 2) = bf1(qk[r] * dec); } }
    __syncthreads();
    if (wave >= 4) { const int t4 = tid - 256;
        for (int id = t4; id < 1024; id += 256) { const int k = id >> 3, sp = (id >> 2) & 1, gg = id & 3; float o8[8];
#pragma unroll
            for (int j = 0; j < 8; ++j) { const int cc = 32 * sp + (j < 4 ? 4 * gg + j : 16 + 4 * gg + j - 4);
                o8[j] = bflo((unsigned)*(const LAS unsigned short*)(L + P_KH + cc * 272 + k * 2)) * GB[192 + cc]; }
            v4u w; w.x = pkbf(o8[0], o8[1]); w.y = pkbf(o8[2], o8[3]); w.z = pkbf(o8[4], o8[5]); w.w = pkbf(o8[6], o8[7]);
            *(v4u*)(proj + (row0 + (k >> 1)) * PW + PC_K + h * HD + (k & 1) * 64 + 32 * sp + 8 * gg) = w; }
        for (int id = t4; id < 512; id += 256) { const int i = id >> 3, j8 = (id & 7) * 8;
            *(v4u*)(qks + i * 64 + j8) = *(const LAS v4u*)(L + P_QKL + i * 144 + j8 * 2); } }
    if (wave == 0) { const int bb = g, j = m; float X[16];
        X[0] = j == 0 ? 1.f : 0.f;
#pragma unroll
        for (int i = 1; i < 16; ++i) { const LAS float* Lr = AT + (16 * bb + i) * 68 + 16 * bb; float Lv[16];
#pragma unroll
            for (int q = 0; q < (i + 3) / 4; ++q) { const f32x4 t = *(const LAS f32x4*)(Lr + 4 * q); Lv[4 * q] = t[0]; Lv[4 * q + 1] = t[1]; Lv[4 * q + 2] = t[2]; Lv[4 * q + 3] = t[3]; }
            float acc = i == j ? 1.f : 0.f;
#pragma unroll
            for (int mm = 0; mm < i; ++mm) acc -= Lv[mm] * X[mm];
            X[i] = acc; }
#pragma unroll
        for (int i = 0; i < 16; ++i) AT[(16 * bb + i) * 68 + 16 * bb + j] = X[i]; }
    __syncthreads();
    if (wave < 2) { const int lo = 2 * wave, hi = 2 * wave + 1; LAS float* PS = (LAS float*)(L + P_PS) + wave * 320;
        f32x4 acc = {0.f, 0.f, 0.f, 0.f};
#pragma unroll
        for (int s = 0; s < 4; ++s) acc = mfma4(AT[(16 * hi + m) * 68 + 16 * lo + 4 * s + g], AT[(16 * lo + 4 * s + g) * 68 + 16 * lo + m], acc);
#pragma unroll
        for (int r = 0; r < 4; ++r) PS[(4 * g + r) * 20 + m] = acc[r];
        LDS_WAIT();
        f32x4 acc2 = {0.f, 0.f, 0.f, 0.f};
#pragma unroll
        for (int s = 0; s < 4; ++s) acc2 = mfma4(AT[(16 * hi + m) * 68 + 16 * hi + 4 * s + g], PS[(4 * s + g) * 20 + m], acc2);
#pragma unroll
        for (int r = 0; r < 4; ++r) AT[(16 * hi + 4 * g + r) * 68 + 16 * lo + m] = -acc2[r]; }
    __syncthreads();
    { LAS float* PS2 = (LAS float*)(L + P_PS2); const int ti = (wave >> 1) & 1, tj = wave & 1;
      if (wave < 4) { f32x4 acc = {0.f, 0.f, 0.f, 0.f};
#pragma unroll
          for (int s = 0; s < 8; ++s) acc = mfma4(AT[(32 + 16 * ti + m) * 68 + 4 * s + g], AT[(4 * s + g) * 68 + 16 * tj + m], acc);
#pragma unroll
          for (int r = 0; r < 4; ++r) PS2[(16 * ti + 4 * g + r) * 36 + 16 * tj + m] = acc[r]; }
      __syncthreads();
      if (wave < 4) { f32x4 acc = {0.f, 0.f, 0.f, 0.f};
#pragma unroll
          for (int s = 0; s < 8; ++s) acc = mfma4(AT[(32 + 16 * ti + m) * 68 + 32 + 4 * s + g], PS2[(4 * s + g) * 36 + 16 * tj + m], acc);
#pragma unroll
          for (int r = 0; r < 4; ++r) AT[(32 + 16 * ti + 4 * g + r) * 68 + 16 * tj + m] = -acc[r]; } }
    __syncthreads();
    { const int i = tid >> 3, j0 = (tid & 7) * 8; const f32x4 t0 = *(const LAS f32x4*)(AT + i * 68 + j0), t1 = *(const LAS f32x4*)(AT + i * 68 + j0 + 4);
      v4u w; w.x = pkbf(t0[0], t0[1]); w.y = pkbf(t0[2], t0[3]); w.z = pkbf(t1[0], t1[1]); w.w = pkbf(t1[2], t1[3]);
      *(LAS v4u*)(L + P_TB + i * 144 + j0 * 2) = w; }
    __syncthreads();
#pragma unroll
    for (int q = 0; q < 8; ++q) { const int tt = wave + 8 * q; f32x4 acc = {0.f, 0.f, 0.f, 0.f};
        if (tt < 32) { const int ct = tt >> 3, nt = tt & 7;
#pragma unroll
            for (int sp = 0; sp < 2; ++sp) acc = mfma16(*(const LAS dn_bf16x8*)(L + P_TB + (16 * ct + m) * 144 + (32 * sp + 8 * g) * 2), *(const LAS dn_bf16x8*)(L + P_VBT + (16 * nt + m) * 144 + (32 * sp + 8 * g) * 2), acc);
            const int v = 16 * nt + m;
            *(dn_u32x2*)(proj + (row0 + (v >> 1)) * PW + PC_V + h * HD + (v & 1) * 64 + 16 * ct + 4 * g) = pack4f(acc); }
        else { const int t2 = tt - 32, kt = t2 >> 2, ct = t2 & 3;
#pragma unroll
            for (int sp = 0; sp < 2; ++sp) acc = mfma16(*(const LAS dn_bf16x8*)(L + P_KBGT + (16 * kt + m) * 144 + (32 * sp + 8 * g) * 2), *(const LAS dn_bf16x8*)(L + P_TB + (16 * ct + m) * 144 + (32 * sp + 8 * g) * 2), acc);
            *(dn_u32x2*)(xbimg + (16 * ct + m) * 128 + 32 * (kt >> 1) + 8 * g + 4 * (kt & 1)) = pack4f(-acc); } }
    __syncthreads();
}
constexpr int S_WN = 0, S_QG = 17408, S_KDT = 34816, S_QKM = 53248, S_UT = 62464, S_OB = 80896, S_PSQ = 114688, S_ONW = 116736, S_Z = 117248, S_END = 152064;
static_assert(S_END <= MISC_OFF, "scan LDS map");
__device__ __forceinline__ void dn_scan_unit(const Frame& F, int bh) {
    const Tix T = tix(F.wv); const int tid = T.tid, lane = T.lane, wave = T.wave, m = lane & 15, g = lane >> 4, n0 = 32 * wave;
    const int b = bh >> 3, h = bh & 7;
    bf16* proj = (bf16*)(F.ws + WS_PROJ); const bf16* xbi = (const bf16*)(F.ws + WS_XB); const bf16* qks = (const bf16*)((unsigned char*)F.out + DO_QKS); const float* egl = (const float*)((unsigned char*)F.out + DO_EGL);
    LAS unsigned char* L = F.lds;
    LAS float* OB = (LAS float*)(L + S_OB);
    constexpr int NC = SEQ / 64;
#define WGBAR() do { asm volatile("s_waitcnt lgkmcnt(0)" ::: "memory"); __builtin_amdgcn_s_barrier(); asm volatile("" ::: "memory"); } while (0)
    if (wave >= 4) {
        const int ht = tid - 256;
        const unsigned lo_lin = (unsigned)ht * 16u;
        const unsigned lo_qg = (unsigned)(((ht >> 4) * PW + (ht & 15) * 8) * 2);
        const unsigned lo_kv = (unsigned)(((ht >> 4) * PW + ((ht >> 3) & 1) * 64 + (ht & 7) * 8) * 2);
        const unsigned ld_a = (unsigned)((ht >> 4) * 272 + (ht & 15) * 16), ld_b = (unsigned)((ht >> 3) * 144 + (ht & 7) * 16);
        const unsigned lo_fin = (unsigned)(((ht >> 2) * PW + (ht & 3) * 32) * 2);
        v4u RP[12], RQ[10];
#define DN_LOAD_P(cc) do { const size_t r0_ = (size_t)b * SEQ + (cc) * 64; const size_t u_ = (size_t)bh * 32 + (cc);               \
        _Pragma("unroll") for (int j_ = 0; j_ < 4; ++j_) {                                                                                                \
            RP[j_] = *(const v4u*)((const char*)(xbi + u_ * 8192 + 2048 * j_) + lo_lin);                                                                    \
            RP[4 + j_] = *(const v4u*)((const char*)(proj + (r0_ + 16 * j_) * PW + PC_Q + h * HD) + lo_qg);                                                 \
            RP[8 + j_] = *(const v4u*)((const char*)(proj + (r0_ + 16 * j_) * PW + PC_V + h * HD) + lo_kv); } } while (0)
#define DN_LOAD_Q(cc) do { const size_t r0_ = (size_t)b * SEQ + (cc) * 64; const size_t u_ = (size_t)bh * 32 + (cc);     \
        _Pragma("unroll") for (int j_ = 0; j_ < 4; ++j_) {                                                                                                \
            RQ[j_] = *(const v4u*)((const char*)(proj + (r0_ + 16 * j_) * PW + PC_K + h * HD) + lo_kv);                                                     \
            RQ[4 + j_] = *(const v4u*)((const char*)(proj + (r0_ + 16 * j_) * PW + PC_Z + h * HD) + lo_qg); }                                               \
        _Pragma("unroll") for (int j_ = 0; j_ < 2; ++j_) RQ[8 + j_] = *(const v4u*)((const char*)(qks + u_ * 4096 + 2048 * j_) + lo_lin); } while (0)
#define DN_WRITE_P() do { _Pragma("unroll") for (int j_ = 0; j_ < 4; ++j_) {                                                                               \
            *(LAS v4u*)(L + S_WN + ld_a + j_ * 4352) = RP[j_]; *(LAS v4u*)(L + S_QG + ld_a + j_ * 4352) = RP[4 + j_]; *(LAS v4u*)(L + S_UT + ld_b + j_ * 4608) = RP[8 + j_]; } } while (0)
#define DN_WRITE_Q(cc) do { _Pragma("unroll") for (int j_ = 0; j_ < 4; ++j_) { *(LAS v4u*)(L + S_KDT + ld_b + j_ * 4608) = RQ[j_];                         \
            *(LAS v4u*)(L + S_Z + ((cc) & 1) * 17408 + ld_a + j_ * 4352) = RQ[4 + j_]; }                                                                    \
        _Pragma("unroll") for (int j_ = 0; j_ < 2; ++j_) *(LAS v4u*)(L + S_QKM + ld_b + j_ * 4608) = RQ[8 + j_]; } while (0)
#define DN_FINAL(cc) do { const int fr_ = ht >> 2, fc_ = (ht & 3) * 32; float ss_ = 0.f;     \
        _Pragma("unroll") for (int p_ = 0; p_ < 8; ++p_) { const f32x4 o_ = *(const LAS f32x4*)(OB + fr_ * 132 + fc_ + 4 * p_);                              \
            ss_ += (o_[0] * o_[0] + o_[1] * o_[1]) + (o_[2] * o_[2] + o_[3] * o_[3]); }                                                                     \
        ss_ += dppf<0xB1>(ss_); ss_ += dppf<0x4E>(ss_);                                                                                                     \
        const float rn_ = rsqrtf(ss_ * (1.f / 128.f) + EPS);                                                                                               \
        bf16* dst_ = (bf16*)((char*)(proj + ((size_t)b * SEQ + (cc) * 64) * PW + PC_Q + h * HD) + lo_fin);              \
        _Pragma("unroll") for (int p_ = 0; p_ < 4; ++p_) {                                                                                                 \
            const f32x4 oa_ = *(const LAS f32x4*)(OB + fr_ * 132 + fc_ + 8 * p_), ob_ = *(const LAS f32x4*)(OB + fr_ * 132 + fc_ + 8 * p_ + 4);             \
            const v4u z_ = *(const LAS v4u*)(L + S_Z + ((cc) & 1) * 17408 + fr_ * 272 + (fc_ + 8 * p_) * 2);                                                \
            v4u w_; w_.x = pkbf(oa_[0] * rn_ * bflo(z_.x), oa_[1] * rn_ * bfhi(z_.x)); w_.y = pkbf(oa_[2] * rn_ * bflo(z_.y), oa_[3] * rn_ * bfhi(z_.y));   \
            w_.z = pkbf(ob_[0] * rn_ * bflo(z_.z), ob_[1] * rn_ * bfhi(z_.z)); w_.w = pkbf(ob_[2] * rn_ * bflo(z_.w), ob_[3] * rn_ * bfhi(z_.w));           \
            *(v4u*)(dst_ + 8 * p_) = w_; } } while (0)
        DN_LOAD_P(0); DN_LOAD_Q(0); DN_WRITE_P(); DN_WRITE_Q(0); DN_LOAD_P(1); DN_LOAD_Q(1);
        WGBAR();
        for (int c = 0; c < NC; ++c) {
            if (c > 0) { DN_FINAL(c - 1); DN_WRITE_Q(c); if (c + 1 < NC) DN_LOAD_Q(c + 1); }
            WGBAR();
            if (c + 1 < NC) { DN_WRITE_P(); if (c + 2 < NC) DN_LOAD_P(c + 2); }
            WGBAR();
        }
        DN_FINAL(NC - 1);
#undef DN_LOAD_P
#undef DN_LOAD_Q
#undef DN_WRITE_P
#undef DN_WRITE_Q
#undef DN_FINAL
    } else {
        f32x4 Sacc[2][8];
#pragma unroll
        for (int kt = 0; kt < 8; ++kt) { Sacc[0][kt] = (f32x4){0.f, 0.f, 0.f, 0.f}; Sacc[1][kt] = (f32x4){0.f, 0.f, 0.f, 0.f}; }
        const unsigned* eglu = (const unsigned*)egl + (size_t)bh * 32;
        float eg_next = __uint_as_float(__hip_atomic_load(eglu, __ATOMIC_RELAXED, __HIP_MEMORY_SCOPE_AGENT));
        const LAS unsigned char* fa = L + m * 272 + g * 16;
        const LAS unsigned char* fb = L + m * 144 + g * 16;
#define SBAR() __builtin_amdgcn_sched_barrier(0)
#define LD_A(X, base, ct) do { _Pragma("unroll") for (int s_ = 0; s_ < 4; ++s_) X[s_] = *(const LAS dn_bf16x8*)(fa + (base) + (ct) * 4352 + s_ * 64); } while (0)
#define LD_B(X, base, i0) do { _Pragma("unroll") for (int s_ = 0; s_ < 4; ++s_) X[s_] = *(const LAS dn_bf16x8*)(fb + (base) + ((i0) + (s_ >> 1)) * 2304 + (s_ & 1) * 64); } while (0)
        WGBAR();
        for (int c = 0; c < NC; ++c) {
            const float eg = eg_next;
            if (c + 1 < NC) eg_next = __uint_as_float(__hip_atomic_load(eglu + c + 1, __ATOMIC_RELAXED, __HIP_MEMORY_SCOPE_AGENT));
            dn_bf16x8 SB[2][4], X0[4], X1[4];
            LD_A(X0, S_WN, 0);
#pragma unroll
            for (int sl = 0; sl < 2; ++sl)
#pragma unroll
                for (int s = 0; s < 4; ++s) SB[sl][s] = pack8f(Sacc[sl][2 * s], Sacc[sl][2 * s + 1]);
            f32x4 VN[2][4], O[2][4];
#pragma unroll
            for (int ct = 0; ct < 4; ++ct)
#pragma unroll
                for (int sl = 0; sl < 2; ++sl) { const dn_u32x2 uu = *(const LAS dn_u32x2*)(L + S_UT + (n0 + 16 * sl + m) * 144 + (16 * ct + 4 * g) * 2);
                    VN[sl][ct] = (f32x4){bflo(uu.x), bfhi(uu.x), bflo(uu.y), bfhi(uu.y)}; O[sl][ct] = (f32x4){0.f, 0.f, 0.f, 0.f}; }
#pragma unroll
            for (int ct = 0; ct < 4; ++ct) {
                SBAR(); LD_A(X1, S_QG, ct); SBAR();
#pragma unroll
                for (int s = 0; s < 4; ++s) { VN[0][ct] = mfma16(X0[s], SB[0][s], VN[0][ct]); VN[1][ct] = mfma16(X0[s], SB[1][s], VN[1][ct]); }
                SBAR(); if (ct < 3) LD_A(X0, S_WN, ct + 1); SBAR();
#pragma unroll
                for (int s = 0; s < 4; ++s) { O[0][ct] = mfma16(X1[s], SB[0][s], O[0][ct]); O[1][ct] = mfma16(X1[s], SB[1][s], O[1][ct]); }
            }
            dn_bf16x8 VNB[2][2];
#pragma unroll
            for (int sl = 0; sl < 2; ++sl)
#pragma unroll
                for (int sp = 0; sp < 2; ++sp) VNB[sl][sp] = pack8f(VN[sl][2 * sp], VN[sl][2 * sp + 1]);
            WGBAR();
            SBAR(); LD_B(X0, S_QKM, 0); LD_B(X1, S_QKM, 2); SBAR();
#pragma unroll
            for (int s = 0; s < 4; ++s) { O[0][s >> 1] = mfma16(X0[s], VNB[0][s & 1], O[0][s >> 1]); O[1][s >> 1] = mfma16(X0[s], VNB[1][s & 1], O[1][s >> 1]); }
            SBAR(); LD_B(X0, S_KDT, 0); SBAR();
#pragma unroll
            for (int s = 0; s < 4; ++s) { O[0][2 + (s >> 1)] = mfma16(X1[s], VNB[0][s & 1], O[0][2 + (s >> 1)]); O[1][2 + (s >> 1)] = mfma16(X1[s], VNB[1][s & 1], O[1][2 + (s >> 1)]); }
#pragma unroll
            for (int kt = 0; kt < 8; ++kt) { Sacc[0][kt] = Sacc[0][kt] * eg; Sacc[1][kt] = Sacc[1][kt] * eg; }
#pragma unroll
            for (int q = 0; q < 4; ++q) {
                if (q & 1) { SBAR(); if (q < 3) LD_B(X0, S_KDT, 2 * q + 2); SBAR();
#pragma unroll
                    for (int s = 0; s < 4; ++s) { Sacc[0][2 * q + (s >> 1)] = mfma16(X1[s], VNB[0][s & 1], Sacc[0][2 * q + (s >> 1)]); Sacc[1][2 * q + (s >> 1)] = mfma16(X1[s], VNB[1][s & 1], Sacc[1][2 * q + (s >> 1)]); } }
                else { SBAR(); LD_B(X1, S_KDT, 2 * q + 2); SBAR();
#pragma unroll
                    for (int s = 0; s < 4; ++s) { Sacc[0][2 * q + (s >> 1)] = mfma16(X0[s], VNB[0][s & 1], Sacc[0][2 * q + (s >> 1)]); Sacc[1][2 * q + (s >> 1)] = mfma16(X0[s], VNB[1][s & 1], Sacc[1][2 * q + (s >> 1)]); } }
            }
#pragma unroll
            for (int sl = 0; sl < 2; ++sl)
#pragma unroll
                for (int ct = 0; ct < 4; ++ct)
#pragma unroll
                    for (int r = 0; r < 4; ++r) OB[(16 * ct + 4 * g + r) * 132 + n0 + 16 * sl + m] = O[sl][ct][r];
            WGBAR();
        }
#undef SBAR
#undef LD_A
#undef LD_B
    }
#undef WGBAR
}
__device__ __forceinline__ void fox_blk(const Frame& F, int it, int j, att::Blk& k) {
    const int bh = it >> 2, y = it & 3, qb = j == 0 ? y : 7 - y, b = bh >> 3, h = bh & 7; const size_t row0 = (size_t)b * SEQ + qb * 256;
    bf16* proj = (bf16*)(F.ws + WS_PROJ);
    k.Q = proj + row0 * PW + PC_Q + h * HD; k.K = proj + (size_t)b * SEQ * PW + PC_K + h * HD; k.voff = PC_V - PC_K; k.goff = PC_Z - PC_Q;
    k.flog = (const float*)(F.ws + WS_AB) + (size_t)b * SEQ * 16 + h; k.fb = F.in[I_FOXFB][h]; k.P0 = qb * 256; k.skv = SEQ; k.kvpitch = PW;
}
__device__ __forceinline__ void mem_blk(const Frame& F, int idx, att::Blk& k) {
    const int b = idx >> 5, hm = (idx >> 3) & 3, qb = idx & 7; const size_t row0 = (size_t)b * SEQ + qb * 256;
    bf16* proj = (bf16*)(F.ws + WS_PROJ); const bf16* mkv = (const bf16*)(F.ws + WS_MEMKV);
    static_assert(att::QP == PW, "attention Q pitch");
    k.Q = proj + row0 * PW + PC_QM + hm * HD; k.K = mkv + (size_t)b * NMEM * DM + hm * HD; k.voff = 512; k.goff = 0;
    k.flog = nullptr; k.fb = 0.f; k.P0 = 1 << 20; k.skv = NMEM; k.kvpitch = DM;
}
struct SrcL1 { const Frame* F; int vcu;
    __device__ __forceinline__ bool operator()(int n, att::Blk& k) const { const int it = vcu + (n / 3) * F->G, j = n % 3; if (it >= 256) return false;
        if (j < 2) fox_blk(*F, it, j, k); else mem_blk(*F, it, k); return true; } };
struct SrcL0 { const Frame* F; int first, stride;
    __device__ __forceinline__ bool operator()(int n, att::Blk& k) const { const int idx = first + n * stride; if (idx >= 256) return false; mem_blk(*F, idx, k); return true; } };
#define IN(k) (lo <= (k) && (k) < hi)
#define SEAM(k) do { if (IN(k) && IN((k) + 1)) xcd_barrier(bar); } while (0)
template <int layer> __device__ __forceinline__ void layer_body(const Frame& F, const XcdBarrier& bar, int lo, int hi, unsigned char* lds) {
    bf16* proj = (bf16*)(F.ws + WS_PROJ); bf16* xb = (bf16*)(F.ws + WS_XB); float* xsq = (float*)(F.ws + WS_XSQ);
    float* ab = (float*)(F.ws + WS_AB);

        const int pb = 1 + (layer ? 6 : 0);
        if (IN(pb)) {
            pg8::Gemm g{xb, (const bf16*)(F.ws + (layer ? WS_WIN1 : WS_WIN0)), MROWS, N_IN, DM, DM}; pg8::StaticOrder S; S.init(MROWS, N_IN, F.G, F.bid);
            const float* nk = layer ? F.in[I_FOXKNW] : nullptr; const float* nq = layer ? F.in[I_FOXQNW] : nullptr;
            pg8::EpiProj<true, false, layer == 0> E{proj, PW, xsq, ab, 18, (bf16*)((unsigned char*)F.out + DO_HALO), 0, layer ? 4 : 0, nk, 12, layer ? 16 : 12, nq, 16, 18, F.in[I_MEMQNW] + layer * HD};
            pg8::gemm_phase<pg8::EpiProj<true, false, layer == 0>, pg8::StaticOrder, true, true>(F.lds, g, S, E, F.wv);
            if (layer == 0) {
                pg8::Gemm g2{(const bf16*)((unsigned char*)F.out + DO_MEMB), (const bf16*)(F.ws + WS_WMKV), MMEM, DM, DM, DM}; pg8::StaticOrder S2; S2.init(MMEM, DM, F.G, F.G - 1 - F.bid);
                pg8::EpiProj<true, false> E2{(bf16*)(F.ws + WS_MEMKV), DM, (const float*)(F.ws + WS_MSQ), nullptr, 4, nullptr, 0, 2, F.in[I_MEMKNW], 0, 0, nullptr, 0, 0, nullptr};
                pg8::gemm_phase<pg8::EpiProj<true, false>, pg8::StaticOrder, true, true>(F.lds, g2, S2, E2, F.wv);
            }
        }
        SEAM(pb);
        const int pm = pb + (layer ? 1 : 2);
        if (layer == 0) {
            if (IN(pb + 1)) { constexpr int NU = BATCH * NH * (SEQ / 64); DnPre R; int u = F.bid; if (u < NU) dn_prep_load(F, u, R);
                              for (; u < NU; u += F.G) dn_prep_unit(F, u, u + F.G < NU ? u + F.G : -1, R); }
            SEAM(pb + 1);
        }
        if (IN(pm)) {
            if (layer == 0) {
                if (F.bid < 64) dn_scan_unit(F, F.bid);
                else { const SrcL0 src{&F, F.bid - 64, F.G - 64}; att::phase((char*)lds, src, F.wv);
                       __syncthreads();
                       const Tix T = tix(F.wv); convert_weights<6, 18>(F, (LAS float*)(F.lds + T.wave * 17408), T.lane, (F.bid - 64) * NWAVES + T.wave, (F.G - 64) * NWAVES, 0); }
            } else {
                const int vcu = (F.G % 8 == 0) ? (F.bid % 8) * (F.G / 8) + F.bid / 8 : F.bid;
                const SrcL1 src{&F, vcu}; att::phase((char*)lds, src, F.wv);
            }
            __syncthreads();
        }
        SEAM(pm);
        if (IN(pm + 1)) {
            pg8::Gemm g{proj + PC_Q, (const bf16*)(F.ws + (layer ? WS_WOUT1 : WS_WOUT0)), MROWS, DM, OUT_IN, PW}; pg8::StaticOrder S; S.init(MROWS, DM, F.G, F.bid);
            pg8::EpiRes E{layer ? (const float*)F.out : F.in[I_X], F.out, xb, xsq};
            pg8::gemm_phase<pg8::EpiRes, pg8::StaticOrder, true, true>(F.lds, g, S, E, F.wv);
        }
        SEAM(pm + 1);
        if (IN(pm + 2)) {
            pg8::Gemm g{xb, (const bf16*)(F.ws + (layer ? WS_WM1_1 : WS_WM1_0)), MROWS, FF, DM, DM}; pg8::StaticOrder S; S.init(MROWS, FF, F.G, F.bid);
            pg8::EpiProj<false, true> E{proj, FF, xsq, nullptr, 16, nullptr, 0, 0, nullptr, 0, 0, nullptr, 0, 0, nullptr};
            pg8::gemm_phase<pg8::EpiProj<false, true>, pg8::StaticOrder, true, true>(F.lds, g, S, E, F.wv);
        }
        SEAM(pm + 2);
        if (IN(pm + 3)) {
            pg8::Gemm g{proj, (const bf16*)(F.ws + (layer ? WS_WM2_1 : WS_WM2_0)), MROWS, DM, FF, FF}; pg8::StaticOrder S; S.init(MROWS, DM, F.G, F.bid);
            pg8::EpiRes E{(const float*)F.out, F.out, xb, xsq};
            pg8::gemm_phase<pg8::EpiRes, pg8::StaticOrder, true, true>(F.lds, g, S, E, F.wv);
        }
        SEAM(pm + 3);
    }
#undef IN
#undef SEAM
__global__ void __launch_bounds__(NWAVES * 64, 2) hyb_fwd(Args args) {
    extern __shared__ __attribute__((aligned(16))) unsigned char lds[];
    Frame F;
    F.lds = (LAS unsigned char*)lds;
    F.G = gridDim.x; F.bid = blockIdx.x; F.in = args.in; F.out = args.out; F.ws = args.ws; F.wv = __builtin_amdgcn_readfirstlane((int)threadIdx.x >> 6);
    volatile LAS unsigned* MISC = (volatile LAS unsigned*)(F.lds + MISC_OFF);
    gu32* ctl = (gu32*)(args.ws + WS_CTL);
    for (int u = threadIdx.x; u < (LDS_BYTES - MISC_OFF) / 4; u += NWAVES * 64) ((LAS unsigned*)(F.lds + MISC_OFF))[u] = 0u;
    __syncthreads();
    XcdBarrier bar; bar.bar = (unsigned*)(ctl + CW_BAR) + args.li * XCD_BAR_WORDS; bar.x = 0; bar.st = nullptr; bar.wv = F.wv;
    if (!MK_LAUNCH_PER_PHASE) { bar = xcd_barrier_post((unsigned*)(ctl + CW_BAR) + args.li * XCD_BAR_WORDS, MISC + 8); bar.wv = F.wv; }
    const int lo = args.ph_lo, hi = args.ph_hi;
#define IN(k) (lo <= (k) && (k) < hi)
#define SEAM(k) do { if (IN(k) && IN((k) + 1)) xcd_barrier(bar); } while (0)
    bf16* proj = (bf16*)(F.ws + WS_PROJ); bf16* xb = (bf16*)(F.ws + WS_XB); float* xsq = (float*)(F.ws + WS_XSQ);
    float* ab = (float*)(F.ws + WS_AB);

    if (IN(0)) { p0_prologue(F); } SEAM(0);

    layer_body<0>(F, bar, lo, hi, lds);
    layer_body<1>(F, bar, lo, hi, lds);
#undef IN
#undef SEAM
}

extern "C" void kernel_launch(void* const* d_in, const int* in_sizes, int n_in, void* d_out, int out_size, void* d_ws, size_t ws_size, hipStream_t stream) {
    static int grid = 0;
    if (grid == 0) {
        if (n_in != 20 || in_sizes[0] != MROWS * DM || out_size != MROWS * DM || ws_size < WS_END) {
            fprintf(stderr, "kernel_launch: shape/workspace mismatch (n_in %d, in0 %d, out %d, ws %zu; need ws >= %zu); nothing launched\n", n_in, n_in > 0 ? in_sizes[0] : -1, out_size, ws_size, (size_t)WS_END); grid = -1; return; }
        int dev = 0, cus = 0, per_cu = 0;
        if (hipGetDevice(&dev) != hipSuccess || hipDeviceGetAttribute(&cus, hipDeviceAttributeMultiprocessorCount, dev) != hipSuccess) { fprintf(stderr, "kernel_launch: device query failed\n"); grid = -1; return; }
        if (hipFuncSetAttribute((const void*)hyb_fwd, hipFuncAttributeMaxDynamicSharedMemorySize, LDS_BYTES) != hipSuccess) { fprintf(stderr, "kernel_launch: hipFuncSetAttribute failed\n"); grid = -1; return; }
        if (hipOccupancyMaxActiveBlocksPerMultiprocessor(&per_cu, (const void*)hyb_fwd, NWAVES * 64, LDS_BYTES) != hipSuccess || per_cu < 1) {
            fprintf(stderr, "kernel_launch: occupancy query reports %d workgroups per CU; nothing launched\n", per_cu); (void)hipGetLastError(); grid = -1; return; }
        if (cus < 128) { fprintf(stderr, "kernel_launch: %d CUs; this kernel's phase program needs at least 128 workgroups; nothing launched\n", cus); grid = -1; return; }
        grid = cus;
    }
    if (grid < 0) return;
    if (hipMemsetAsync((char*)d_ws + WS_CTL, 0, CTL_ZERO_BYTES, stream) != hipSuccess) { fprintf(stderr, "kernel_launch: memset failed\n"); return; }
    Args a{};
    for (int i = 0; i < 20; ++i) a.in[i] = (const float*)d_in[i];
    a.out = (float*)d_out; a.ws = (unsigned char*)d_ws;
#if MK_LAUNCH_PER_PHASE
    for (int p = 0; p < N_PHASES; ++p) { a.ph_lo = p; a.ph_hi = p + 1; a.li = 0; hipLaunchKernelGGL(hyb_fwd, dim3(grid), dim3(NWAVES * 64), LDS_BYTES, stream, a); }
#else
    a.ph_lo = 0; a.ph_hi = N_PHASES; a.li = 0;
    hipLaunchKernelGGL(hyb_fwd, dim3(grid), dim3(NWAVES * 64), LDS_BYTES, stream, a);
#endif
    const hipError_t le = hipPeekAtLastError();
    if (le != hipSuccess) fprintf(stderr, "kernel_launch: launch failed: %s\n", hipGetErrorName(le));
}
```

```cpp
#include <hip/hip_runtime.h>
#include <cstdio>
#include <cstdint>

constexpr int BATCH = 8, SEQ = 2048, DM = 1024, MROWS = BATCH * SEQ;
constexpr int NMEM = 256, MMEM = BATCH * NMEM;
constexpr int HD = 128, NH = 8, NMH = 4, FF = 4096;
constexpr int PW = 4608;
constexpr int PC_K = 0, PC_V = 1024, PC_Z = 2048, PC_Q = 3072, PC_QM = 4096, PC_AB = 4608;
constexpr int N_IN = 4864;
constexpr int DN_IN = 4624, FOX_IN = 4616, OUT_IN = 1536;
constexpr float EPS = 1e-6f;
constexpr float QSCALE = 0.08838834764831845f;

__device__ __forceinline__ int lane_id_v() { int x; asm volatile("v_mbcnt_lo_u32_b32 %0, -1, 0\n\tv_mbcnt_hi_u32_b32 %0, -1, %0" : "=v"(x)); return x; }
template <int CTRL> __device__ __forceinline__ float dppf(float x) { return __builtin_bit_cast(float, __builtin_amdgcn_update_dpp(0, __builtin_bit_cast(int, x), CTRL, 0xf, 0xf, true)); }
__device__ __forceinline__ float row16_sum(float x) { x += dppf<0xB1>(x); x += dppf<0x4E>(x); x += dppf<0x141>(x); x += dppf<0x140>(x); return x; }
__device__ __forceinline__ float add_xor16(float x) { auto r = __builtin_amdgcn_permlane16_swap(__float_as_uint(x), __float_as_uint(x), false, false); return __uint_as_float(r[0]) + __uint_as_float(r[1]); }
__device__ __forceinline__ float add_xor32(float x) { auto r = __builtin_amdgcn_permlane32_swap(__float_as_uint(x), __float_as_uint(x), false, false); return __uint_as_float(r[0]) + __uint_as_float(r[1]); }
namespace pg8 {
#define PG8_LAS __attribute__((address_space(3)))
typedef unsigned short bf16_t;
typedef short bf16x8 __attribute__((ext_vector_type(8)));
typedef float f32x4 __attribute__((ext_vector_type(4)));
typedef unsigned u32x4 __attribute__((ext_vector_type(4)));
constexpr int BM = 256, BK = 64, HALF = 128, HTB = HALF * BK * 2  , STAGE_BYTES = 8 * HTB, NXCD = 8, WGM = 8;

__host__ __device__ __forceinline__ int lds_byte(int r, int c) { const int st = (r >> 4) * 2 + (c >> 5), rr = r & 15, cc = c & 31, ob = rr * 64 + cc * 2; return st * 1024 + (ob ^ (((ob >> 9) & 1) << 5)); }
__host__ __device__ __forceinline__ void stage_rc(int b, int& R, int& C) { const int st = b / 1024, sb = b % 1024, swz = sb ^ (((sb >> 9) & 1) << 5); R = (st >> 1) * 16 + swz / 64; C = (st & 1) * 32 + (swz % 64) / 2; }
__host__ __device__ __forceinline__ int perm32(int rho) { const int n = rho >> 4, i = rho & 15; return 8 * (i >> 2) + 4 * n + (i & 3); }

struct Unit { int pm, pn; };
struct Gemm { const bf16_t* A; const bf16_t* Bt; int M, N, K, lda; };

struct StaticOrder {
    int nM, nN, nwg, G, c;
    __host__ __device__ void init(int M, int N, int G_, int c_) { nM = M / BM; nN = N / BM; nwg = nM * nN; G = G_; c = c_; }
    __host__ __device__ bool next(int i, Unit& u) const {
        const long L = (long)i * G + c; if (L >= nwg) return false;
        int wgid = (int)L; { const int q = nwg / NXCD, r = nwg % NXCD, xcd = wgid % NXCD, off = wgid / NXCD; wgid = (xcd < r ? xcd * (q + 1) : r * (q + 1) + (xcd - r) * q) + off; }
        const int nig = WGM * nN, gid = wgid / nig, fm = gid * WGM, gsz = (nM - fm) < WGM ? (nM - fm) : WGM;
        u.pm = fm + ((wgid % nig) % gsz); u.pn = (wgid % nig) / gsz; return true;
    }
    __device__ __forceinline__ void a_ready(const Unit&) const {}
    __device__ __forceinline__ void done(const Unit&) const {}
};


__device__ __forceinline__ unsigned cvt_pk_bf16(float lo, float hi) { unsigned r; asm volatile("v_cvt_pk_bf16_f32 %0, %1, %2" : "=v"(r) : "v"(lo), "v"(hi)); return r; }

constexpr int EPI_XCH = 131072, EPI_RS = 139264;
template <bool NORM, bool RELU2, bool HALO = false> struct EpiProj {
    static constexpr bool PERM = true, AFTER_DRAIN = false, USE_RS = true, ACC_INIT = false;
    bf16_t* O; int ldc; const float* xsq; float* ab; int n_main; bf16_t* halo;
    int nlo0, nhi0; const float* nw0; int nlo1, nhi1; const float* nw1; int nlo2, nhi2; const float* nw2;
    __device__ __forceinline__ void rs_load(const Unit& u, int tid, f32x4 (&q)[4]) const { const float* p = xsq + (size_t)(u.pm * BM + tid) * 16;
#pragma unroll
        for (int i = 0; i < 4; ++i) q[i] = *(const f32x4*)(p + 4 * i); }
    __device__ __forceinline__ void rs_store(const f32x4 (&q)[4], PG8_LAS unsigned char* lds, int parity, int tid) const {
        const f32x4 t = (q[0] + q[1]) + (q[2] + q[3]);
        ((PG8_LAS float*)(lds + EPI_RS))[parity * 256 + tid] = rsqrtf(((t[0] + t[1]) + (t[2] + t[3])) * (1.0f / 1024.0f) + 1e-6f); }
    __device__ __forceinline__ void operator()(const f32x4 (&acc)[2][2][4][2], const Unit& u, int wr, int wc, int fr, int fq, PG8_LAS unsigned char* lds, int parity) const {
        const int rl0 = wr * 64 + fr, row0 = u.pm * BM + rl0, colt = u.pn * BM;
        const bool is_ab = u.pn >= n_main;
        const PG8_LAS float* RS = (const PG8_LAS float*)(lds + EPI_RS) + parity * 256;
        const float* nw = nullptr;
        if (NORM) { if (u.pn >= nlo0 && u.pn < nhi0) nw = nw0; else if (u.pn >= nlo1 && u.pn < nhi1) nw = nw1; else if (u.pn >= nlo2 && u.pn < nhi2) nw = nw2; }
        f32x4 w0 = {1.f, 1.f, 1.f, 1.f}, w1 = w0;
        if (NORM && nw != nullptr) {
            w0 = *(const f32x4*)(nw + wc * 32 + 8 * fq); w1 = *(const f32x4*)(nw + wc * 32 + 8 * fq + 4);
            PG8_LAS float* X = (PG8_LAS float*)(lds + EPI_XCH);
#pragma unroll
            for (int ai = 0; ai < 2; ++ai)
#pragma unroll
                for (int m = 0; m < 4; ++m) { const int rl = rl0 + ai * HALF + m * 16; const float rstd = RS[rl];
#pragma unroll
                    for (int bj = 0; bj < 2; ++bj) { const f32x4 v0 = acc[ai][bj][m][0] * rstd, v1 = acc[ai][bj][m][1] * rstd;
                        float ss = ((v0[0] * v0[0] + v0[1] * v0[1]) + (v0[2] * v0[2] + v0[3] * v0[3])) + ((v1[0] * v1[0] + v1[1] * v1[1]) + (v1[2] * v1[2] + v1[3] * v1[3]));
                        ss = add_xor32(add_xor16(ss));
                        if (fq == 0) X[(bj * 256 + rl) * 4 + wc] = ss; } }
            asm volatile("s_waitcnt lgkmcnt(0)" ::: "memory"); __builtin_amdgcn_s_barrier(); asm volatile("" ::: "memory");
        }
#pragma unroll
        for (int ai = 0; ai < 2; ++ai)
#pragma unroll
            for (int m = 0; m < 4; ++m) {
                const int rl = rl0 + ai * HALF + m * 16, r = row0 + ai * HALF + m * 16;
                const float rstd = RS[rl];
                if (!is_ab) {
#pragma unroll
                    for (int bj = 0; bj < 2; ++bj) {
                        float sc = rstd;
                        if (NORM && nw != nullptr) { const f32x4 p4 = *(const PG8_LAS f32x4*)((const PG8_LAS float*)(lds + EPI_XCH) + (bj * 256 + rl) * 4);
                            sc = rstd * rsqrtf(((p4[0] + p4[1]) + (p4[2] + p4[3])) * (1.0f / 128.0f) + 1e-6f); }
                        f32x4 v0 = acc[ai][bj][m][0] * sc * w0, v1 = acc[ai][bj][m][1] * sc * w1;
                        if (RELU2) {
#pragma unroll
                            for (int e = 0; e < 4; ++e) { const float a = fmaxf(v0[e], 0.f), b = fmaxf(v1[e], 0.f); v0[e] = a * a; v1[e] = b * b; }
                        }
                        u32x4 w; w.x = cvt_pk_bf16(v0[0], v0[1]); w.y = cvt_pk_bf16(v0[2], v0[3]); w.z = cvt_pk_bf16(v1[0], v1[1]); w.w = cvt_pk_bf16(v1[2], v1[3]);
                        *(u32x4*)(O + (size_t)r * ldc + colt + bj * HALF + wc * 32 + 8 * fq) = w;
                        if (HALO && m == 3 && fr >= 13) *(u32x4*)(halo + ((size_t)(r >> 6) * 3 + ((r & 63) - 61)) * ldc + colt + bj * HALF + wc * 32 + 8 * fq) = w;
                    }
                } else if (ab != nullptr && wc == 0 && fq < 2) {
                    float* p = ab + (size_t)r * 16 + 8 * fq;
                    *(f32x4*)p = acc[ai][0][m][0] * rstd; *(f32x4*)(p + 4) = acc[ai][0][m][1] * rstd;
                }
            }
    }
};
struct EpiRes {
    static constexpr bool PERM = true, AFTER_DRAIN = false, USE_RS = false, ACC_INIT = true;
    const float* xold; float* xnew; bf16_t* xb; float* xsq;
    __device__ __forceinline__ void init(f32x4 (&acc)[2][2][4][2], const Unit& u, int wr, int wc, int fr, int fq) const {
        const int row0 = u.pm * BM + wr * 64 + fr, colt = u.pn * BM;
#pragma unroll
        for (int ai = 0; ai < 2; ++ai)
#pragma unroll
            for (int m = 0; m < 4; ++m)
#pragma unroll
                for (int bj = 0; bj < 2; ++bj) { const float* p = xold + (size_t)(row0 + ai * HALF + m * 16) * 1024 + colt + bj * HALF + wc * 32 + 8 * fq;
                    acc[ai][bj][m][0] = *(const f32x4*)p; acc[ai][bj][m][1] = *(const f32x4*)(p + 4); }
    }
    __device__ __forceinline__ void operator()(const f32x4 (&acc)[2][2][4][2], const Unit& u, int wr, int wc, int fr, int fq, PG8_LAS unsigned char*, int) const {
        const int row0 = u.pm * BM + wr * 64 + fr, colt = u.pn * BM;
#pragma unroll
        for (int ai = 0; ai < 2; ++ai)
#pragma unroll
            for (int m = 0; m < 4; ++m) {
                const int r = row0 + ai * HALF + m * 16; float ss = 0.f;
#pragma unroll
                for (int bj = 0; bj < 2; ++bj) {
                    const size_t off = (size_t)r * 1024 + colt + bj * HALF + wc * 32 + 8 * fq;
                    const f32x4 v0 = acc[ai][bj][m][0], v1 = acc[ai][bj][m][1];
                    *(f32x4*)(xnew + off) = v0; *(f32x4*)(xnew + off + 4) = v1;
                    ss += ((v0[0] * v0[0] + v0[1] * v0[1]) + (v0[2] * v0[2] + v0[3] * v0[3])) + ((v1[0] * v1[0] + v1[1] * v1[1]) + (v1[2] * v1[2] + v1[3] * v1[3]));
                    u32x4 w; w.x = cvt_pk_bf16(v0[0], v0[1]); w.y = cvt_pk_bf16(v0[2], v0[3]); w.z = cvt_pk_bf16(v1[0], v1[1]); w.w = cvt_pk_bf16(v1[2], v1[3]);
                    *(u32x4*)(xb + off) = w;
                }
                ss = add_xor32(add_xor16(ss));
                if (fq == 0) xsq[(size_t)r * 16 + u.pn * 4 + wc] = ss;
            }
    }
};

template <class Epi, class Sched, bool ALIGN_EPI = false, bool SP2 = false>
__device__ __forceinline__ void gemm_phase(PG8_LAS unsigned char* lds, const Gemm g, const Sched& S, const Epi& E, int wid) {
    const int lane = lane_id_v();
    const int tid = wid * 64 + lane, wr = wid >> 2, wc = wid & 3, fr = lane & 15, fq = lane >> 4;
    const int K = g.K, nt = K / BK;
    unsigned voffA[2], voffB[2];
#pragma unroll
    for (int i = 0; i < 2; ++i) { int R, C; stage_rc(tid * 16 + i * 8192, R, C); const int Rb = Epi::PERM ? ((R & ~31) + perm32(R & 31)) : R;
        voffA[i] = (unsigned)(R * g.lda + C) * 2u; voffB[i] = (unsigned)(Rb * K + C) * 2u; }
    const size_t kstep = (size_t)(BK * 2);
    const size_t hstepA = (size_t)HALF * g.lda * 2, hstepB = (size_t)HALF * K * 2;
    const size_t tstepA = 2 * hstepA, tstepB = 2 * hstepB;
    const unsigned ldsw = (unsigned)wid * 1024u;
    const int aoff = lds_byte(wr * 64 + fr, fq * 8), boff = lds_byte(wc * 32 + fr, fq * 8);
#define PG8_SA(b, h) (((b) * 2 + (h)) * HTB)
#define PG8_SB(b, h) ((4 + (b) * 2 + (h)) * HTB)
#define PG8_STAGE(bufoff, gbase, voff) do { _Pragma("unroll") for (int _i = 0; _i < 2; ++_i) \
        __builtin_amdgcn_global_load_lds((const unsigned*)((const char*)(gbase) + (voff)[_i]), (PG8_LAS unsigned*)(lds + (bufoff) + ldsw + _i * 8192), 16, 0, 0); } while (0)
#define PG8_LDA(dst, b, h) do { _Pragma("unroll") for (int m = 0; m < 4; ++m) _Pragma("unroll") for (int k = 0; k < 2; ++k) dst[m][k] = *(const PG8_LAS bf16x8*)(lds + PG8_SA(b, h) + aoff + m * 2048 + k * 1024); } while (0)
#define PG8_LDB(dst, b, h) do { _Pragma("unroll") for (int n = 0; n < 2; ++n) _Pragma("unroll") for (int k = 0; k < 2; ++k) dst[n][k] = *(const PG8_LAS bf16x8*)(lds + PG8_SB(b, h) + boff + n * 2048 + k * 1024); } while (0)
#define PG8_MMA(ai, bj, At, Bt) do { __builtin_amdgcn_s_setprio(1); _Pragma("unroll") for (int m = 0; m < 4; ++m) _Pragma("unroll") for (int n = 0; n < 2; ++n) _Pragma("unroll") for (int k = 0; k < 2; ++k) \
        acc[ai][bj][m][n] = __builtin_amdgcn_mfma_f32_16x16x32_bf16(Bt[n][k], At[m][k], acc[ai][bj][m][n], 0, 0, 0); __builtin_amdgcn_s_setprio(0); } while (0)
#define PG8_WAIT_V(n) asm volatile("s_waitcnt vmcnt(" #n ")" ::: "memory")
#define PG8_WAIT_L(n) asm volatile("s_waitcnt lgkmcnt(" #n ")" ::: "memory")
#define PG8_BAR __builtin_amdgcn_s_barrier()
#define PG8_SCHED __builtin_amdgcn_sched_barrier(0)
    Unit cur, nxt; int ui = 0;
    if (!S.next(0, cur)) return;
    f32x4 acc[2][2][4][2];
    if constexpr (Epi::ACC_INIT) E.init(acc, cur, wr, wc, fr, fq);
    else {
#pragma unroll
    for (int a = 0; a < 2; ++a)
#pragma unroll
        for (int b = 0; b < 2; ++b)
#pragma unroll
            for (int m = 0; m < 4; ++m)
#pragma unroll
                for (int n = 0; n < 2; ++n) acc[a][b][m][n] = (f32x4){0.f, 0.f, 0.f, 0.f};
    }
    bf16x8 At[4][2], B0[2][2], B1[2][2];
    const char* cA = (const char*)g.A + (size_t)cur.pm * tstepA; const char* cB = (const char*)g.Bt + (size_t)cur.pn * tstepB;
    S.a_ready(cur);
    if constexpr (Epi::USE_RS) { if (tid < 256) { f32x4 rq[4]; E.rs_load(cur, tid, rq); E.rs_store(rq, lds, 0, tid); } }
    if constexpr (SP2) {
        PG8_STAGE(PG8_SB(0, 0), cB, voffB); PG8_STAGE(PG8_SB(0, 1), cB + hstepB, voffB); PG8_STAGE(PG8_SA(0, 0), cA, voffA); PG8_STAGE(PG8_SA(0, 1), cA + hstepA, voffA);
        if (wr == 1) PG8_BAR;
        PG8_WAIT_V(2); PG8_BAR;
        PG8_STAGE(PG8_SB(1, 0), cB + kstep, voffB); PG8_STAGE(PG8_SA(1, 0), cA + kstep, voffA); PG8_STAGE(PG8_SB(1, 1), cB + hstepB + kstep, voffB);
        PG8_WAIT_V(6); PG8_BAR;
    } else {
        PG8_STAGE(PG8_SB(0, 0), cB, voffB); PG8_STAGE(PG8_SA(0, 0), cA, voffA); PG8_STAGE(PG8_SB(0, 1), cB + hstepB, voffB); PG8_STAGE(PG8_SA(0, 1), cA + hstepA, voffA);
        if (wr == 1) PG8_BAR;
        PG8_WAIT_V(4); PG8_BAR;
        PG8_STAGE(PG8_SB(1, 0), cB + kstep, voffB); PG8_STAGE(PG8_SA(1, 0), cA + kstep, voffA); PG8_STAGE(PG8_SB(1, 1), cB + hstepB + kstep, voffB);
        PG8_WAIT_V(6); PG8_BAR;
    }
    for (;;) {
        const bool has_next = S.next(ui + 1, nxt);
        const char* nA = has_next ? (const char*)g.A + (size_t)nxt.pm * tstepA : cA; const char* nB = has_next ? (const char*)g.Bt + (size_t)nxt.pn * tstepB : cB;
        for (int t = 0; t < nt; t += 2) {
            const bool last = (t == nt - 2);
            const char* a1 = cA + (size_t)(t + 1) * kstep;
            const char* a2 = last ? nA : cA + (size_t)(t + 2) * kstep; const char* b2 = last ? nB : cB + (size_t)(t + 2) * kstep;
            const char* a3 = a2 + kstep; const char* b3 = b2 + kstep;
            if (last && has_next) S.a_ready(nxt);
            if constexpr (SP2) {
            PG8_LDB(B0, 0, 0); PG8_LDB(B1, 0, 1); PG8_SCHED; PG8_LDA(At, 0, 0); PG8_STAGE(PG8_SA(1, 1), a1 + hstepA, voffA);
            PG8_WAIT_V(8); PG8_WAIT_L(0); PG8_BAR; PG8_MMA(0, 0, At, B0); PG8_MMA(0, 1, At, B1); PG8_BAR; PG8_SCHED;
            PG8_LDA(At, 0, 1); PG8_STAGE(PG8_SB(0, 0), b2, voffB); PG8_STAGE(PG8_SB(0, 1), b2 + hstepB, voffB); PG8_STAGE(PG8_SA(0, 0), a2, voffA);
            PG8_WAIT_V(8); PG8_WAIT_L(0); PG8_BAR; PG8_MMA(1, 0, At, B0); PG8_MMA(1, 1, At, B1); PG8_BAR; PG8_SCHED;
            PG8_LDB(B0, 1, 0); PG8_LDB(B1, 1, 1); PG8_SCHED; PG8_LDA(At, 1, 0); PG8_STAGE(PG8_SA(0, 1), a2 + hstepA, voffA);
            PG8_WAIT_V(8); PG8_WAIT_L(0); PG8_BAR; PG8_MMA(0, 0, At, B0); PG8_MMA(0, 1, At, B1); PG8_BAR; PG8_SCHED;
            PG8_LDA(At, 1, 1); PG8_STAGE(PG8_SB(1, 0), b3, voffB); PG8_STAGE(PG8_SB(1, 1), b3 + hstepB, voffB); PG8_STAGE(PG8_SA(1, 0), a3, voffA);
            PG8_WAIT_V(8); PG8_WAIT_L(0); PG8_BAR; PG8_MMA(1, 0, At, B0); PG8_MMA(1, 1, At, B1); PG8_BAR; PG8_SCHED;
            } else {
            PG8_LDB(B0, 0, 0); PG8_SCHED; PG8_LDA(At, 0, 0); PG8_STAGE(PG8_SA(1, 1), a1 + hstepA, voffA);
            PG8_WAIT_L(8); PG8_BAR; PG8_WAIT_L(0); PG8_MMA(0, 0, At, B0); PG8_BAR; PG8_SCHED;
            PG8_LDB(B1, 0, 1); PG8_STAGE(PG8_SB(0, 0), b2, voffB);
            PG8_BAR; PG8_WAIT_L(0); PG8_MMA(0, 1, At, B1); PG8_BAR;
            PG8_LDA(At, 0, 1); PG8_STAGE(PG8_SA(0, 0), a2, voffA);
            PG8_BAR; PG8_WAIT_L(0); PG8_MMA(1, 0, At, B0); PG8_BAR; PG8_SCHED;
            PG8_STAGE(PG8_SB(0, 1), b2 + hstepB, voffB);
            PG8_WAIT_V(6); PG8_BAR; PG8_MMA(1, 1, At, B1); PG8_BAR;
            PG8_LDB(B0, 1, 0); PG8_SCHED; PG8_LDA(At, 1, 0); PG8_STAGE(PG8_SA(0, 1), a2 + hstepA, voffA);
            PG8_WAIT_L(8); PG8_BAR; PG8_WAIT_L(0); PG8_MMA(0, 0, At, B0); PG8_BAR; PG8_SCHED;
            PG8_LDB(B1, 1, 1); PG8_STAGE(PG8_SB(1, 0), b3, voffB);
            PG8_BAR; PG8_WAIT_L(0); PG8_MMA(0, 1, At, B1); PG8_BAR;
            PG8_LDA(At, 1, 1); PG8_STAGE(PG8_SA(1, 0), a3, voffA);
            PG8_BAR; PG8_WAIT_L(0); PG8_MMA(1, 0, At, B0); PG8_BAR; PG8_SCHED;
            PG8_STAGE(PG8_SB(1, 1), b3 + hstepB, voffB);
            PG8_WAIT_V(6); PG8_BAR; PG8_MMA(1, 1, At, B1); PG8_BAR;
            }
        }
        if constexpr (ALIGN_EPI) { if (wr == 0) PG8_BAR; }
        if constexpr (Epi::USE_RS) {
            f32x4 rq[4]; if (has_next && tid < 256) E.rs_load(nxt, tid, rq);
            E(acc, cur, wr, wc, fr, fq, lds, ui & 1);
            if (has_next && tid < 256) E.rs_store(rq, lds, (ui + 1) & 1, tid);
        } else { E(acc, cur, wr, wc, fr, fq, lds, ui & 1); }
        S.done(cur);
        if (!has_next) break;
        if constexpr (Epi::ACC_INIT) E.init(acc, nxt, wr, wc, fr, fq);
        else {
#pragma unroll
        for (int a = 0; a < 2; ++a)
#pragma unroll
            for (int b = 0; b < 2; ++b)
#pragma unroll
                for (int m = 0; m < 4; ++m)
#pragma unroll
                    for (int n = 0; n < 2; ++n) acc[a][b][m][n] = (f32x4){0.f, 0.f, 0.f, 0.f};
        }
        cur = nxt; cA = nA; cB = nB; ++ui;
        if constexpr (ALIGN_EPI) { if (wr == 1) PG8_BAR; }
    }
    PG8_WAIT_V(0);
    if constexpr (!ALIGN_EPI) { if (wr == 0) PG8_BAR; }
    PG8_BAR;
    if constexpr (Epi::AFTER_DRAIN) { E.fused(acc, cur, wr, wc, fr, fq, lds, wid, lane); S.done(cur); }
#undef PG8_SA
#undef PG8_SB
#undef PG8_STAGE
#undef PG8_LDA
#undef PG8_LDB
#undef PG8_MMA
#undef PG8_WAIT_V
#undef PG8_WAIT_L
#undef PG8_BAR
#undef PG8_SCHED
}
}

namespace att {
typedef unsigned short bf16_t;
typedef short bf16x8 __attribute__((ext_vector_type(8)));
typedef short s16x4 __attribute__((ext_vector_type(4)));
typedef float f32x16 __attribute__((ext_vector_type(16)));
typedef float f32x4 __attribute__((ext_vector_type(4)));
typedef unsigned u32x4 __attribute__((ext_vector_type(4)));
constexpr int NW = 8, QBLK = 32, KVBLK = 64, QB = NW * QBLK, D = 128;
constexpr int SHM_V = KVBLK * D * 2, SHM_K = KVBLK * D * 2;
constexpr int OFF_WS = 2 * SHM_V + 2 * SHM_K, OFF_BK = OFF_WS + NW * 64 * 4, ATT_LDS = OFF_BK + 8192;
constexpr float SCALE = 0.08838834764831845f, THR = 8.f;
constexpr int WBIG = 1 << 30;
#define KSWZ(row, colB) ((row) * 256 + ((colB) ^ (((row) & 7) << 4)))
#define SBAR() __builtin_amdgcn_sched_barrier(0)
__device__ __forceinline__ int v_st(int k, int c) { const int kk = (k & ~0xC) | ((k & 4) << 1) | ((k & 8) >> 1); return ((kk >> 3) * 4 + (c >> 5)) * 512 + ((kk & 7) * 32 + (c & 31)) * 2; }
__device__ __forceinline__ int v_rd_base(int lane) { return ((lane & 3) << 3) | (((lane >> 2) & 3) << 6) | (((lane >> 4) & 1) << 5) | (((lane >> 5) & 1) << 8); }
constexpr int v_rd_off(int d0, int ks, int half) { return d0 * 512 + ks * 4096 + half * 2048; }
__device__ __forceinline__ int crow(int r, int hi) { return (r & 3) + 8 * (r >> 2) + 4 * hi; }
__device__ __forceinline__ unsigned cvtpk(float lo, float hi) { unsigned r; asm volatile("v_cvt_pk_bf16_f32 %0, %1, %2" : "=v"(r) : "v"(lo), "v"(hi)); return r; }
__device__ __forceinline__ bf16x8 load8(const bf16_t* p) { return *reinterpret_cast<const bf16x8*>(p); }
__device__ __forceinline__ void mask_tile(f32x16& p0, f32x16& p1, int dq, unsigned W) {
    const float NEG = -__builtin_inff();
#pragma unroll
    for (int r = 0; r < 16; ++r) { const int c = (r & 3) + 8 * (r >> 2);
        if ((unsigned)(dq - c) >= W) p0[r] = NEG;
        if ((unsigned)(dq - c - 32) >= W) p1[r] = NEG; }
}
__device__ __forceinline__ void partialSM(f32x16& p0, f32x16& p1, float& m_reg, float& mn, float& alpha) {
    float pmax = p0[0]; for (int r = 1; r < 16; ++r) pmax = fmaxf(pmax, p0[r]); for (int r = 0; r < 16; ++r) pmax = fmaxf(pmax, p1[r]);
    { auto rr = __builtin_amdgcn_permlane32_swap(__float_as_uint(pmax), __float_as_uint(pmax), false, false);
      pmax = fmaxf(__uint_as_float(rr[0]), __uint_as_float(rr[1])); }
    constexpr float C2 = 1.4426950408889634f * SCALE;
    if (__builtin_expect(__all((pmax - m_reg) * SCALE <= THR), 1)) { mn = m_reg; alpha = 1.f; }
    else { mn = fmaxf(m_reg, pmax); alpha = __builtin_amdgcn_exp2f((m_reg - mn) * C2); m_reg = mn; }
    const float mnL = -mn * C2;
    for (int r = 0; r < 16; ++r) p0[r] = fmaf(p0[r], C2, mnL); for (int r = 0; r < 16; ++r) p1[r] = fmaf(p1[r], C2, mnL);
    for (int r = 0; r < 16; ++r) p0[r] = __builtin_amdgcn_exp2f(p0[r]);
}
__device__ __forceinline__ void finishSM(f32x16& p0, f32x16& p1, float alpha, float& l_reg, bf16x8& pa0, bf16x8& pa1, bf16x8& pa2, bf16x8& pa3) {
    for (int r = 0; r < 16; ++r) p1[r] = __builtin_amdgcn_exp2f(p1[r]);
    float ps = 0; for (int r = 0; r < 16; ++r) ps += p0[r]; for (int r = 0; r < 16; ++r) ps += p1[r];
    { auto rr = __builtin_amdgcn_permlane32_swap(__float_as_uint(ps), __float_as_uint(ps), false, false);
      ps = __uint_as_float(rr[0]) + __uint_as_float(rr[1]); }
    l_reg = l_reg * alpha + ps;
#define PK4(P, B_, OUT) do { unsigned a0 = cvtpk(P[B_+0], P[B_+1]), a1 = cvtpk(P[B_+2], P[B_+3]);                          \
        unsigned b0 = cvtpk(P[B_+4], P[B_+5]), b1 = cvtpk(P[B_+6], P[B_+7]);                                             \
        auto r0 = __builtin_amdgcn_permlane32_swap(a0, b0, false, false); auto r1 = __builtin_amdgcn_permlane32_swap(a1, b1, false, false); \
        u32x4 w = {r0[0], r1[0], r0[1], r1[1]}; OUT = *reinterpret_cast<bf16x8*>(&w); } while (0)
    PK4(p0, 0, pa0); PK4(p0, 8, pa1); PK4(p1, 0, pa2); PK4(p1, 8, pa3);
#undef PK4
}
template <int KB>
__device__ __forceinline__ void qkt(f32x16& p0, f32x16& p1, const char* K_lds, int r32, int hi, const bf16x8* qr, const float* bb) {
#pragma unroll
    for (int g = 0; g < 4; ++g) { const f32x4 b0 = *(const f32x4*)(bb + 8 * g), b1 = *(const f32x4*)(bb + 32 + 8 * g);
#pragma unroll
        for (int i = 0; i < 4; ++i) { p0[4 * g + i] = b0[i]; p1[4 * g + i] = b1[i]; } }
    const char* kb[4];
#pragma unroll
    for (int dd = 0; dd < 4; ++dd) kb[dd] = K_lds + KB * SHM_K + KSWZ(r32, (dd * 16 + hi * 8) * 2);
#pragma unroll
    for (int d0 = 0; d0 < 8; ++d0) { const char* a = kb[d0 & 3] + (d0 >> 2) * 128;
        bf16x8 b0 = *reinterpret_cast<const bf16x8*>(a);
        bf16x8 b1 = *reinterpret_cast<const bf16x8*>(a + 32 * 256);
        p0 = __builtin_amdgcn_mfma_f32_32x32x16_bf16(b0, qr[d0], p0, 0, 0, 0);
        p1 = __builtin_amdgcn_mfma_f32_32x32x16_bf16(b1, qr[d0], p1, 0, 0, 0); }
}
template <int VB>
__device__ __forceinline__ void pv_tile(f32x16* o, int vb0, bf16x8 pa0, bf16x8 pa1, bf16x8 pa2, bf16x8 pa3) {
#define TRRD(dst, off) asm volatile("ds_read_b64_tr_b16 %0, %1 offset:%2" : "=&v"(dst) : "v"(vb0), "i"(off) : "memory")
#define PV_D0(d0) do { s16x4 l0, l1, l2, l3, h0, h1, h2, h3; constexpr int b_ = VB * SHM_V + v_rd_off(d0, 0, 0);   \
        TRRD(l0, b_); TRRD(h0, b_ + 2048); TRRD(l1, b_ + 4096); TRRD(h1, b_ + 6144); TRRD(l2, b_ + 8192); TRRD(h2, b_ + 10240); TRRD(l3, b_ + 12288); TRRD(h3, b_ + 14336); \
        asm volatile("s_waitcnt lgkmcnt(0)" ::: "memory"); SBAR();   \
        o[d0] = __builtin_amdgcn_mfma_f32_32x32x16_bf16(pa0, (bf16x8){l0[0], l0[1], l0[2], l0[3], h0[0], h0[1], h0[2], h0[3]}, o[d0], 0, 0, 0);   \
        o[d0] = __builtin_amdgcn_mfma_f32_32x32x16_bf16(pa1, (bf16x8){l1[0], l1[1], l1[2], l1[3], h1[0], h1[1], h1[2], h1[3]}, o[d0], 0, 0, 0);   \
        o[d0] = __builtin_amdgcn_mfma_f32_32x32x16_bf16(pa2, (bf16x8){l2[0], l2[1], l2[2], l2[3], h2[0], h2[1], h2[2], h2[3]}, o[d0], 0, 0, 0);   \
        o[d0] = __builtin_amdgcn_mfma_f32_32x32x16_bf16(pa3, (bf16x8){l3[0], l3[1], l3[2], l3[3], h3[0], h3[1], h3[2], h3[3]}, o[d0], 0, 0, 0); } while (0)
    PV_D0(0); PV_D0(1); PV_D0(2); PV_D0(3);
#undef PV_D0
#undef TRRD
}
constexpr int QP = 4608;
struct Blk { bf16_t* Q; const bf16_t* K; const float* flog; float fb; int voff, goff, P0, skv, kvpitch; };
struct Seam { bf16x8 qr[8]; bf16x8 st_v0, st_v1, st_k0, st_k1; };
#define ROW(p, pitch, k0, rr) ((p) + (size_t)((k0) + (rr)) * (pitch) + sc)
#define VMW() asm volatile("s_waitcnt vmcnt(0)" ::: "memory")
#define VMWN(n) asm volatile("s_waitcnt vmcnt(%0)" :: "i"(n) : "memory")
#define SLOAD_H(Kp, Vp, pitch, k0) do { S.st_v0 = load8(ROW(Vp, pitch, k0, sr)); S.st_v1 = load8(ROW(Vp, pitch, k0, 32 + sr));              \
                         S.st_k0 = load8(ROW(Kp, pitch, k0, sr)); S.st_k1 = load8(ROW(Kp, pitch, k0, 32 + sr)); } while (0)
#define SWRITE_HK(bf) do { *(bf16x8*)(K_lds + (bf) * SHM_K + kws) = S.st_k0; *(bf16x8*)(K_lds + (bf) * SHM_K + kws + 32 * 256) = S.st_k1; } while (0)
#define SWRITE_HV(bf) do { *(bf16x8*)(V_lds + (bf) * SHM_V + vst0) = S.st_v0; *(bf16x8*)(V_lds + (bf) * SHM_V + vst1) = S.st_v1; } while (0)
#define SWRITE_H(bf) do { SWRITE_HV(bf); SWRITE_HK(bf); } while (0)
__device__ __forceinline__ void prime(const Blk& cur, char* lds, Seam& S, int wid) {
    const int lane = lane_id_v();
    const int tid = wid * 64 + lane, r32 = lane & 31, hi = lane >> 5;
    const int sr = tid >> 4, sc = (tid & 15) * 8, kws = KSWZ(sr, sc * 2); char* K_lds = lds + 2 * SHM_V;
    for (int d0 = 0; d0 < 8; ++d0) S.qr[d0] = load8(cur.Q + (size_t)(wid * QBLK + r32) * QP + d0 * 16 + hi * 8);
    SLOAD_H(cur.K, cur.K + cur.voff, cur.kvpitch, 0); VMW(); SWRITE_HK(0);
    __syncthreads();
}
__device__ __forceinline__ void block(const Blk& cur, const Blk& nxt, char* lds, Seam& S, int wid) {
    const int lane = lane_id_v();
    const int tid = wid * 64 + lane, r32 = lane & 31, hi = lane >> 5;
    constexpr int W = WBIG;
    int j_hi = (cur.P0 + QB - 1) / KVBLK + 1; if (j_hi > cur.skv / KVBLK) j_hi = cur.skv / KVBLK;
    const int NT = j_hi;
    const int qlo = cur.P0 + wid * QBLK, qm = qlo + r32 - 4 * hi;
    char* V_lds = lds; char* K_lds = lds + 2 * SHM_V;
    float* ws = (float*)(lds + OFF_WS) + wid * 64; float* li_l = ws, * al_l = ws + 32;
    float* bkl = (float*)(lds + OFF_BK);
    { const int nkeys = NT * KVBLK;
      if (cur.flog) { const int k0 = 4 * tid; float f[4];
#pragma unroll
          for (int e = 0; e < 4; ++e) { float x = 0.f; if (k0 + e < nkeys) x = cur.flog[(size_t)(k0 + e) * 16] + cur.fb;
              f[e] = k0 + e < nkeys ? fminf(x, 0.f) - log1pf(__expf(-fabsf(x))) : 0.f; }
          f[1] += f[0]; f[2] += f[1]; f[3] += f[2];
          float sc = f[3];
#pragma unroll
          for (int o_ = 1; o_ < 64; o_ <<= 1) { const float t_ = __shfl_up(sc, o_); if (lane >= o_) sc += t_; }
          if (lane == 63) ws[0] = sc;
          __syncthreads();
          float off = sc - f[3];
          for (int w_ = 0; w_ < wid; ++w_) off += ((const float*)(lds + OFF_WS))[w_ * 64];
#pragma unroll
          for (int e = 0; e < 4; ++e) if (k0 + e < nkeys) bkl[k0 + e] = -(f[e] + off) * (1.f / SCALE); }
      else for (int k = tid; k < nkeys; k += NW * 64) bkl[k] = 0.f;
      __syncthreads(); }
    float m_reg = -1e30f, l_reg = 0; f32x16 o[4] = {};
    const int sr = tid >> 4, sc = (tid & 15) * 8, vst0 = v_st(sr, sc), vst1 = v_st(32 + sr, sc), kws = KSWZ(sr, sc * 2);
    const int vb0 = (int)(uintptr_t)V_lds + v_rd_base(lane);
    const bf16_t* Kh = cur.K; const bf16_t* Vh = cur.K + cur.voff; const int kvp = cur.kvpitch;
#define RESC(a) do { if (__any((a) < 1.f)) { if (hi == 0) al_l[r32] = (a); asm volatile("s_waitcnt lgkmcnt(0)" ::: "memory");              \
                     for (int d_ = 0; d_ < 4; ++d_) for (int r = 0; r < 16; ++r) o[d_][r] *= al_l[crow(r, hi)]; } } while (0)
#define KBASE(t) ((t) * KVBLK)
#define MASKT(P0_, P1_, t) do { const int kb_ = KBASE(t); if (kb_ + KVBLK - 1 > qlo) mask_tile(P0_, P1_, qm - kb_, (unsigned)W); } while (0)
#define BB(t) (bkl + KBASE(t) + 4 * hi)
    constexpr int NQL = 8;
#define SEAM_K0() do { VMWN(NQL); SWRITE_HK(0); SBAR(); } while (0)
    f32x16 pA0, pA1, pB0, pB1; float mnA, mnB, alA, alB; bf16x8 pa0, pa1, pa2, pa3;
    SWRITE_HV(0); SBAR();
    if (NT > 1) { SLOAD_H(Kh, Vh, kvp, KBASE(1)); }
    SBAR(); qkt<0>(pA0, pA1, K_lds, r32, hi, S.qr, BB(0));
    MASKT(pA0, pA1, 0); partialSM(pA0, pA1, m_reg, mnA, alA);
    if (NT > 1) { VMW(); SWRITE_H(1); }
    __syncthreads();
#define HALF_STEP(PX0, PX1, mnX, alX, PY0, PY1, alY, t, KB, VB, SB) do {                                                      \
        SBAR(); qkt<KB>(PX0, PX1, K_lds, r32, hi, S.qr, BB(t));                                                                      \
        finishSM(PY0, PY1, alY, l_reg, pa0, pa1, pa2, pa3); SBAR();                                                           \
        if ((t) + 1 < NT) { SLOAD_H(Kh, Vh, kvp, KBASE((t) + 1)); SBAR(); }                                                   \
        pv_tile<VB>(o, vb0, pa0, pa1, pa2, pa3); MASKT(PX0, PX1, (t)); partialSM(PX0, PX1, m_reg, mnX, alX);   \
        __syncthreads();                                                                                                      \
        if ((t) + 1 < NT) { VMW(); SWRITE_H(SB); }                                                                            \
        RESC(alX); __syncthreads(); } while (0)
    for (int t = 1; t + 1 < NT; t += 2) {
        HALF_STEP(pB0, pB1, mnB, alB, pA0, pA1, alA, t, 1, 0, 0);
        HALF_STEP(pA0, pA1, mnA, alA, pB0, pB1, alB, t + 1, 0, 1, 1);
    }
    const bool even = (NT & 1) == 0;
    if (even) { SBAR(); qkt<1>(pB0, pB1, K_lds, r32, hi, S.qr, BB(NT - 1)); SBAR(); }
    SLOAD_H(nxt.K, nxt.K + nxt.voff, nxt.kvpitch, 0); SBAR();
#pragma unroll
    for (int d0 = 0; d0 < 8; ++d0) S.qr[d0] = load8(nxt.Q + (size_t)(wid * QBLK + r32) * QP + d0 * 16 + hi * 8);
    SBAR();
    finishSM(pA0, pA1, alA, l_reg, pa0, pa1, pa2, pa3); SBAR();
    pv_tile<0>(o, vb0, pa0, pa1, pa2, pa3);
    if (even) { MASKT(pB0, pB1, NT - 1); partialSM(pB0, pB1, m_reg, mnB, alB); __syncthreads(); RESC(alB);
        finishSM(pB0, pB1, alB, l_reg, pa0, pa1, pa2, pa3); SBAR(); pv_tile<1>(o, vb0, pa0, pa1, pa2, pa3); }
    SBAR(); SEAM_K0();
    if (hi == 0) li_l[r32] = l_reg; asm volatile("s_waitcnt lgkmcnt(0)" ::: "memory");
    float rli[16];
#pragma unroll
    for (int r = 0; r < 16; ++r) rli[r] = __builtin_amdgcn_rcpf(li_l[crow(r, hi)]);
    bf16_t* Ow = cur.Q + (size_t)(wid * QBLK + 4 * hi) * QP + r32; const int goff = cur.goff;
#pragma unroll
    for (int r = 0; r < 16; ++r) { const int ro = ((r & 3) + 8 * (r >> 2)) * QP;
#pragma unroll
        for (int d0 = 0; d0 < 4; ++d0) { float v = o[d0][r] * rli[r];
            if (goff) { const float g = __uint_as_float((unsigned)Ow[goff + ro + d0 * 32] << 16); v *= __builtin_amdgcn_rcpf(1.f + __expf(-g)); }
            const float vn = dppf<0xB1>(v);
            if ((r32 & 1) == 0) *(unsigned*)(Ow + ro + d0 * 32) = cvtpk(v, vn); } }
    __syncthreads();
#undef RESC
#undef KBASE
#undef MASKT
#undef BB
#undef SEAM_K0
#undef HALF_STEP
}
#undef ROW
#undef VMW
#undef VMWN
#undef SLOAD_H
#undef SWRITE_HK
#undef SWRITE_HV
#undef SWRITE_H
#undef KSWZ
#undef SBAR
template <class Src> __device__ __forceinline__ void phase(char* lds, const Src& src, int wid) {
    Blk cur, nxt; if (!src(0, cur)) return;
    Seam S; prime(cur, lds, S, wid);
    for (int n = 0;; ++n) { const bool more = src(n + 1, nxt); if (!more) nxt = cur; block(cur, nxt, lds, S, wid); if (!more) break; cur = nxt; }
}
}

constexpr int NWAVES = 8;
#ifndef MK_LAUNCH_PER_PHASE
#define MK_LAUNCH_PER_PHASE 0
#endif
constexpr int N_PHASES = 12;

constexpr size_t KiB = 1u << 10, MiB = 1u << 20;
constexpr size_t WS_CTL = 0, CTL_ZERO_BYTES = 1 * MiB;
constexpr size_t WS_WIN0 = 1 * MiB, WS_WIN1 = WS_WIN0 + (size_t)N_IN * DM * 2;
constexpr size_t WS_WOUT0 = 20 * MiB, WS_WOUT1 = 23 * MiB;
constexpr size_t WS_WM1_0 = 26 * MiB, WS_WM1_1 = 34 * MiB, WS_WM2_0 = 42 * MiB, WS_WM2_1 = 50 * MiB;
constexpr size_t WS_WMKV = 58 * MiB;
constexpr size_t WS_PROJ = 60 * MiB;
constexpr size_t WS_XB = 204 * MiB;
constexpr size_t WS_SSQ = 236 * MiB;
constexpr size_t WS_AB = 245 * MiB;
constexpr size_t WS_MEMKV = 246 * MiB;
constexpr size_t WS_XSQ = 250 * MiB;
constexpr size_t WS_FCUM = 251 * MiB;
constexpr size_t WS_MSSQ = 251 * MiB + 512 * KiB;
constexpr size_t WS_MSQ = 251 * MiB + 768 * KiB;
constexpr size_t WS_END = 252 * MiB;
static_assert(WS_WIN1 + (size_t)N_IN * DM * 2 <= WS_WOUT0 && WS_PROJ + (size_t)MROWS * PW * 2 <= WS_XB && WS_SSQ + (size_t)36 * MROWS * 16 <= WS_AB, "d_ws map");
constexpr size_t DO_MEMB = 0;
constexpr int CW_BAR = 4096;

constexpr int LDS_BYTES = 155648;
constexpr int MISC_OFF = LDS_BYTES - 256;

#define GAS __attribute__((address_space(1)))
#define LAS __attribute__((address_space(3)))
typedef unsigned short bf16;
typedef unsigned v4u __attribute__((ext_vector_type(4)));
typedef float f32x4 __attribute__((ext_vector_type(4)));
typedef short bf16x8 __attribute__((ext_vector_type(8)));
typedef GAS unsigned gu32;
typedef GAS unsigned long long gu64;
#define RLX_AGENT __ATOMIC_RELAXED, __HIP_MEMORY_SCOPE_AGENT
#define LDS_WAIT() asm volatile("s_waitcnt lgkmcnt(0)" ::: "memory")
#define VM_WAIT() asm volatile("s_waitcnt vmcnt(0)" ::: "memory")
__device__ __forceinline__ unsigned long long rt() { return __builtin_amdgcn_s_memrealtime(); }
__device__ __forceinline__ unsigned f2bf(float f) { unsigned u = __builtin_bit_cast(unsigned, f); return (u + 0x7fffu + ((u >> 16) & 1u)) >> 16; }
__device__ __forceinline__ unsigned pk2(float lo, float hi) { return f2bf(lo) | (f2bf(hi) << 16); }

#define XB_TMO      128
#define XB_XCNT(j)  (256  + 64 * (j))
#define XB_XSUB(j)  (1280 + 64 * (j))
#define XB_XGEN(j)  (2304 + 64 * (j))
#define XB_TOP      3328
#define XB_TOPGEN   3392
#define XCD_BAR_WORDS 3456
#define XB_SPIN_CAP (1u << 18)

__device__ __forceinline__ unsigned xb_ld(unsigned* p)              { return __hip_atomic_load(p, __ATOMIC_RELAXED, __HIP_MEMORY_SCOPE_AGENT); }
__device__ __forceinline__ unsigned xb_add(unsigned* p, unsigned v) { return __hip_atomic_fetch_add(p, v, __ATOMIC_RELAXED, __HIP_MEMORY_SCOPE_AGENT); }
__device__ __forceinline__ unsigned xb_xcc_id() { return (unsigned)__builtin_amdgcn_s_getreg((3 << 11) | 20) & 0xFu; }
#define XB_SPIN(cond, bar) do { unsigned _sp = 0; while (cond) { __builtin_amdgcn_s_sleep(1); \
    if ((++_sp & 255u) == 0u) { if (xb_ld(&(bar)[XB_TMO])) break; if (_sp > XB_SPIN_CAP) { atomicAdd(&(bar)[XB_TMO], 1u); break; } } } } while (0)

struct XcdBarrier {
    unsigned* bar; unsigned x; int wv;
    volatile LAS unsigned* st;
};

__device__ __forceinline__ XcdBarrier xcd_barrier_post(unsigned* bar, volatile LAS unsigned* st) {
    XcdBarrier b; b.bar = bar; b.x = xb_xcc_id(); b.st = st;
    if (threadIdx.x == 0) (void)xb_add(&bar[XB_XCNT(b.x)], 1u);
    return b;
}
__device__ __forceinline__ void xcd_barrier_complete(unsigned* bar, unsigned x, unsigned& nloc, unsigned& nx) {
    const unsigned G = gridDim.x * gridDim.y * gridDim.z;
    unsigned sum, cnt, mine, sp = 0u;
    for (;;) {
        sum = 0u; cnt = 0u; mine = 0u;
#pragma unroll
        for (unsigned j = 0; j < 16; ++j) { const unsigned c = xb_ld(&bar[XB_XCNT(j)]); sum += c; cnt += (c > 0u) ? 1u : 0u; mine = (j == x) ? c : mine; }
        if (sum == G) break;
        __builtin_amdgcn_s_sleep(1);
        if ((++sp & 255u) == 0u) { if (xb_ld(&bar[XB_TMO])) break; if (sp > XB_SPIN_CAP) { atomicAdd(&bar[XB_TMO], 1u); break; } }
    }
    nloc = mine > 0u ? mine : 1u; nx = cnt > 0u ? cnt : 1u;
}

__device__ __forceinline__ void xcd_barrier(const XcdBarrier& b) {
    asm volatile("s_waitcnt vmcnt(0)" ::: "memory");
    __syncthreads();
    if (b.wv == 0 && lane_id_v() == 0) {
        unsigned* bar = b.bar;
        __builtin_amdgcn_s_waitcnt(0);
        unsigned nloc = b.st[0], nx = b.st[1];
        if (nloc == 0u) { xcd_barrier_complete(bar, b.x, nloc, nx); b.st[0] = nloc; b.st[1] = nx; }
        const unsigned old = xb_add(&bar[XB_XSUB(b.x)], 1u);
        const unsigned gen = old / nloc;
        if (old + 1u == (gen + 1u) * nloc) {
            __builtin_amdgcn_fence(__ATOMIC_RELEASE, "agent");
            asm volatile("s_waitcnt vmcnt(0)" ::: "memory");
            const unsigned og = xb_add(&bar[XB_TOP], 1u);
            const unsigned tg = og / nx;
            if (og + 1u == (tg + 1u) * nx) xb_add(&bar[XB_TOPGEN], 1u);
            else XB_SPIN(xb_ld(&bar[XB_TOPGEN]) == tg, bar);
            __builtin_amdgcn_fence(__ATOMIC_ACQUIRE, "agent");
            xb_add(&bar[XB_XGEN(b.x)], 1u);
            asm volatile("s_waitcnt vmcnt(0)" ::: "memory");
        } else {
            XB_SPIN(xb_ld(&bar[XB_XGEN(b.x)]) == gen, bar);
            __builtin_amdgcn_fence(__ATOMIC_ACQUIRE, "agent");
            asm volatile("s_waitcnt vmcnt(0)" ::: "memory");
        }
    }
    __syncthreads();
}


__device__ __forceinline__ float bflo(unsigned u) { return __builtin_bit_cast(float, u << 16); }
__device__ __forceinline__ float bfhi(unsigned u) { return __builtin_bit_cast(float, u & 0xffff0000u); }
typedef float f32x2_t __attribute__((ext_vector_type(2))); typedef __bf16 bf16x2_t __attribute__((ext_vector_type(2)));
__device__ __forceinline__ unsigned pkbf(float lo, float hi) { const f32x2_t v = {lo, hi}; const bf16x2_t b = __builtin_convertvector(v, bf16x2_t); return __builtin_bit_cast(unsigned, b); }
__device__ __forceinline__ float wave_sum(float v) { return add_xor32(add_xor16(row16_sum(v))); }
__device__ __forceinline__ float wave_max(float v) {
#pragma unroll
    for (int o = 1; o < 64; o <<= 1) v = fmaxf(v, __shfl_xor(v, o));
    return v;
}

struct Args { const float* in[20]; float* out; unsigned char* ws; int ph_lo, ph_hi, li, pad; };
enum { I_X = 0, I_MEM, I_MEMNW, I_WMKV, I_MEMKNW, I_NORM1, I_DNWIN, I_DNCONV, I_DNALOG, I_DNDT, I_DNONW, I_FOXWIN, I_FOXFB, I_FOXQNW, I_FOXKNW, I_MEMQNW, I_WOUT, I_NORM2, I_WM1, I_WM2 };

struct Frame {
    LAS unsigned char* lds;
    int G, bid, wv;
    const float* const* in; float* out; unsigned char* ws;
};


constexpr int CW_XCC = 32768, CW_BAD = 33792, CW_GRP = 65536;
struct GrpBar { unsigned* cnt; unsigned* tmo; int wv; bool on; };
__device__ __forceinline__ void grp_barrier(const GrpBar& gb, int seam) {
    asm volatile("s_waitcnt vmcnt(0)" ::: "memory");
    __syncthreads();
    if (gb.wv == 0 && lane_id_v() == 0) { unsigned* p = gb.cnt + seam * 64;
        (void)__hip_atomic_fetch_add(p, 1u, __ATOMIC_RELAXED, __HIP_MEMORY_SCOPE_AGENT);
        unsigned sp = 0;
        while (__hip_atomic_load(p, __ATOMIC_RELAXED, __HIP_MEMORY_SCOPE_AGENT) < 4u) { __builtin_amdgcn_s_sleep(1); if (++sp > (1u << 22)) { atomicAdd(gb.tmo, 1u); break; } }
        __builtin_amdgcn_fence(__ATOMIC_ACQUIRE, "agent");
        asm volatile("s_waitcnt vmcnt(0)" ::: "memory"); }
    __syncthreads();
}
struct Tix { int tid, lane, wave; };
__device__ __forceinline__ int lane_id() { return lane_id_v(); }
__device__ __forceinline__ Tix tix(int wv) { Tix t; t.lane = lane_id(); t.wave = wv; t.tid = wv * 64 + t.lane; return t; }
struct TSeg { const float* W; int K, ldw, src0, ncols; bf16* WT; int dst0; const float* scale; };
__device__ __forceinline__ TSeg get_seg(const Frame& F, int s) {
    TSeg t; t.scale = nullptr; t.src0 = 0; t.dst0 = 0;
    if (s < 12) {
        const int l = s / 6, j = s % 6;
        t.W = l ? F.in[I_FOXWIN] : F.in[I_DNWIN]; t.K = DM; t.ldw = l ? FOX_IN : DN_IN; t.WT = (bf16*)(F.ws + (l ? WS_WIN1 : WS_WIN0)); t.scale = F.in[I_NORM1] + l * DM;
        const int qm0 = l ? 4104 : 4112, nsc = l ? 8 : 16;
        t.ncols = 1024;
        if (j == 0) { t.src0 = 1024; t.dst0 = PC_K; } else if (j == 1) { t.src0 = 2048; t.dst0 = PC_V; } else if (j == 2) { t.src0 = 3072; t.dst0 = PC_Z; }
        else if (j == 3) { t.src0 = 0; t.dst0 = PC_Q; } else if (j == 4) { t.src0 = qm0; t.dst0 = PC_QM; t.ncols = 512; } else { t.src0 = 4096; t.dst0 = PC_AB; t.ncols = nsc; }
    } else if (s < 14) { const int l = s - 12; t.W = F.in[I_WOUT] + (size_t)l * OUT_IN * DM; t.K = OUT_IN; t.ldw = DM; t.ncols = DM; t.WT = (bf16*)(F.ws + (l ? WS_WOUT1 : WS_WOUT0)); }
    else if (s < 16) { const int l = s - 14; t.W = F.in[I_WM1] + (size_t)l * DM * FF; t.K = DM; t.ldw = FF; t.ncols = FF; t.WT = (bf16*)(F.ws + (l ? WS_WM1_1 : WS_WM1_0)); t.scale = F.in[I_NORM2] + l * DM; }
    else if (s < 18) { const int l = s - 16; t.W = F.in[I_WM2] + (size_t)l * FF * DM; t.K = FF; t.ldw = DM; t.ncols = DM; t.WT = (bf16*)(F.ws + (l ? WS_WM2_1 : WS_WM2_0)); }
    else { t.W = F.in[I_WMKV]; t.K = DM; t.ldw = DM; t.ncols = DM; t.WT = (bf16*)(F.ws + WS_WMKV); t.scale = F.in[I_MEMNW]; }
    return t;
}
__device__ __forceinline__ int seg_items(const TSeg& t) { return (t.K / 64) * ((t.ncols + 63) / 64); }
__device__ __forceinline__ void tr_load(const TSeg& t, int item, int lane, f32x4 (&v)[16]) {
    const int nblk = (t.ncols + 63) / 64, kb = item / nblk, nb = item - kb * nblk, k0 = 64 * kb, n0 = 64 * nb;
    const int n4 = (lane & 15) * 4, kr = lane >> 4; const bool ok = (n0 + n4) < t.ncols;
    const float* p = t.W + (size_t)(k0 + kr) * t.ldw + t.src0 + n0 + n4;
#pragma unroll
    for (int i = 0; i < 16; ++i) v[i] = ok ? *(const f32x4*)(p + (size_t)(4 * i) * t.ldw) : (f32x4){0.f, 0.f, 0.f, 0.f};
}
__device__ __forceinline__ void tr_store(const TSeg& t, int item, int lane, const f32x4 (&v)[16], LAS float* scr) {
    const int nblk = (t.ncols + 63) / 64, kb = item / nblk, nb = item - kb * nblk, k0 = 64 * kb, n0 = 64 * nb;
    const int n4 = (lane & 15) * 4, kr = lane >> 4;
#pragma unroll
    for (int i = 0; i < 16; ++i) *(LAS f32x4*)(scr + (4 * i + kr) * 68 + n4) = v[i];
    LDS_WAIT(); asm volatile("" ::: "memory");
    const int c = lane & 7; f32x4 s0 = {1.f, 1.f, 1.f, 1.f}, s1 = s0;
    if (t.scale) { s0 = *(const f32x4*)(t.scale + k0 + 8 * c); s1 = *(const f32x4*)(t.scale + k0 + 8 * c + 4); }
#pragma unroll
    for (int j = 0; j < 8; ++j) { const int n = (lane >> 3) + 8 * j; const LAS float* q = scr + (8 * c) * 68 + n;
        v4u o; o.x = pkbf(q[0 * 68] * s0[0], q[1 * 68] * s0[1]); o.y = pkbf(q[2 * 68] * s0[2], q[3 * 68] * s0[3]); o.z = pkbf(q[4 * 68] * s1[0], q[5 * 68] * s1[1]); o.w = pkbf(q[6 * 68] * s1[2], q[7 * 68] * s1[3]);
        if (n0 + n < t.ncols) *(v4u*)(t.WT + (size_t)(t.dst0 + n0 + n) * t.K + k0 + 8 * c) = o; }
    LDS_WAIT(); asm volatile("" ::: "memory");
}
template <int NR> __device__ __forceinline__ void rows_to_bf16(int lane, const float* x, bf16* o, float* sq) {
    f32x4 v[NR][4];
#pragma unroll
    for (int r = 0; r < NR; ++r)
#pragma unroll
        for (int j = 0; j < 4; ++j) v[r][j] = ((const f32x4*)(x + (size_t)r * DM))[lane + 64 * j];
#pragma unroll
    for (int r = 0; r < NR; ++r) { float s = 0.f;
#pragma unroll
        for (int j = 0; j < 4; ++j) s += (v[r][j].x * v[r][j].x + v[r][j].y * v[r][j].y) + (v[r][j].z * v[r][j].z + v[r][j].w * v[r][j].w);
        s = wave_sum(s);
        unsigned long long* o8 = (unsigned long long*)(o + (size_t)r * DM) + lane;
#pragma unroll
        for (int j = 0; j < 4; ++j) o8[64 * j] = (unsigned long long)pkbf(v[r][j].x, v[r][j].y) | ((unsigned long long)pkbf(v[r][j].z, v[r][j].w) << 32);
        if (lane < 16) sq[(size_t)r * 16 + lane] = lane == 0 ? s : 0.f; }
}
template <int S0, int S1> __device__ __forceinline__ void convert_weights(const Frame& F, LAS float* scr, int lane, int gw, int NGW, int base) {
#pragma unroll
    for (int s = S0; s < S1; ++s) {
        const TSeg t = get_seg(F, s); const int n = seg_items(t);
        int it = gw - (base % NGW); if (it < 0) it += NGW;
        for (; it < n; it += NGW) { f32x4 v[16]; tr_load(t, it, lane, v); tr_store(t, it, lane, v, scr); }
        base += n;
    }
}
__device__ __forceinline__ void p0_prologue(const Frame& F) {
    const Tix T = tix(F.wv);
    LAS float* scr = (LAS float*)(F.lds + T.wave * 17408);
    const int gw = F.bid * NWAVES + T.wave, NGW = F.G * NWAVES;
    for (int m = gw * 4; m < MROWS; m += NGW * 4) rows_to_bf16<4>(T.lane, F.in[I_X] + (size_t)m * DM, (bf16*)(F.ws + WS_XB) + (size_t)m * DM, (float*)(F.ws + WS_XSQ) + (size_t)m * 16);
    for (int m = gw; m < MMEM; m += NGW) rows_to_bf16<1>(T.lane, F.in[I_MEM] + (size_t)m * DM, (bf16*)((unsigned char*)F.out + DO_MEMB) + (size_t)m * DM, (float*)(F.ws + WS_MSQ) + (size_t)m * 16);
    convert_weights<0, 6>(F, scr, T.lane, gw, NGW, 0);
    convert_weights<18, 19>(F, scr, T.lane, gw, NGW, 1168);
}

typedef short dn_bf16x8 __attribute__((ext_vector_type(8)));
typedef unsigned dn_u32x2 __attribute__((ext_vector_type(2)));
__device__ __forceinline__ f32x4 mfma16(dn_bf16x8 a, dn_bf16x8 b, f32x4 c) { return __builtin_amdgcn_mfma_f32_16x16x32_bf16(a, b, c, 0, 0, 0); }
__device__ __forceinline__ f32x4 mfma4(float a, float b, f32x4 c) { return __builtin_amdgcn_mfma_f32_16x16x4f32(a, b, c, 0, 0, 0); }
__device__ __forceinline__ dn_bf16x8 pack8f(f32x4 x, f32x4 y) { v4u w; w.x = pkbf(x[0], x[1]); w.y = pkbf(x[2], x[3]); w.z = pkbf(y[0], y[1]); w.w = pkbf(y[2], y[3]); return __builtin_bit_cast(dn_bf16x8, w); }
__device__ __forceinline__ dn_u32x2 pack4f(f32x4 x) { dn_u32x2 w; w.x = pkbf(x[0], x[1]); w.y = pkbf(x[2], x[3]); return w; }
__device__ __forceinline__ unsigned short bf1(float x) { return (unsigned short)(pkbf(x, 0.f) & 0xffffu); }
constexpr size_t DO_QKS = 4 * MiB, DO_HALO = 20 * MiB, DO_EGL = 27 * MiB;
constexpr int P_RAW = 0, P_GB = 51712, P_QH = 53248, P_KH = 70656, P_VBT = 88064, P_KBGT = 106496, P_QKL = 124928, P_END = 134144;
constexpr int P_AT = 0, P_TB = 17408, P_PS = 26624, P_PS2 = 29184;
struct DnPre { v4u P[7]; v4u Z[2]; float ga, gb; f32x4 cw[3][4]; };
__device__ __forceinline__ void dn_prep_load(const Frame& F, int u, DnPre& R) {
    const Tix T = tix(F.wv); const int tid = T.tid, lane = T.lane;
    const int bh = u >> 5, c = u & 31, b = bh >> 3, h = bh & 7; const size_t row0 = (size_t)b * SEQ + c * 64; const int gch = b * 32 + c;
    const bf16* proj = (const bf16*)(F.ws + WS_PROJ); const float* AB = (const float*)(F.ws + WS_AB); const bf16* halo = (const bf16*)((unsigned char*)F.out + DO_HALO);
#pragma unroll
    for (int j = 0; j < 7; ++j) { const int id = tid + 512 * j; v4u val = {0u, 0u, 0u, 0u};
        if (id < 67 * 48) { const int r = id / 48, rem = id - r * 48, seg = rem >> 4, ch = rem & 15;
            const int col = (seg == 0 ? PC_Q : seg == 1 ? PC_K : PC_V) + h * HD + ch * 8;
            if (r >= 3) val = *(const v4u*)(proj + (row0 + r - 3) * PW + col);
            else if (c > 0) val = *(const v4u*)(halo + ((size_t)(gch - 1) * 3 + r) * PW + col); }
        R.P[j] = val; }
    R.ga = AB[(row0 + lane) * 16 + h]; R.gb = AB[(row0 + lane) * 16 + 8 + h];
    { const bf16* zp = proj + (row0 + (tid >> 3)) * PW + PC_Z + h * HD + (tid & 7) * 16; R.Z[0] = *(const v4u*)zp; R.Z[1] = *(const v4u*)(zp + 8); }
    const float* convw = F.in[I_DNCONV]; const int c4 = lane & 31;
#pragma unroll
    for (int seg = 0; seg < 3; ++seg)
#pragma unroll
        for (int j = 0; j < 4; ++j) R.cw[seg][j] = *(const f32x4*)(convw + j * 3072 + seg * 1024 + h * HD + 4 * c4);
}
__device__ __forceinline__ void dn_prep_unit(const Frame& F, int u, int u_next, DnPre& R) {
    const Tix T = tix(F.wv); const int tid = T.tid, lane = T.lane, wave = T.wave, m = lane & 15, g = lane >> 4;
    const int bh = u >> 5, c = u & 31, b = bh >> 3, h = bh & 7; const size_t row0 = (size_t)b * SEQ + c * 64;
    bf16* proj = (bf16*)(F.ws + WS_PROJ);
    bf16* xbimg = (bf16*)(F.ws + WS_XB) + (size_t)u * 8192; bf16* qks = (bf16*)((unsigned char*)F.out + DO_QKS) + (size_t)u * 4096; float* egl = (float*)((unsigned char*)F.out + DO_EGL);
    LAS unsigned char* L = F.lds; LAS float* GB = (LAS float*)(L + P_GB);
#pragma unroll
    for (int j = 0; j < 7; ++j) { const int id = tid + 512 * j;
        if (id < 67 * 48) { const int r = id / 48, rem = id - r * 48, seg = rem >> 4, ch = rem & 15; *(LAS v4u*)(L + P_RAW + r * 768 + seg * 256 + ch * 16) = R.P[j]; } }
    if (wave == 0) { const float a = R.ga, bb = R.gb;
        const float x = a + F.in[I_DNDT][h], sp = fmaxf(x, 0.f) + log1pf(__expf(-fabsf(x)));
        const float gt = -__expf(F.in[I_DNALOG][h]) * sp, beta = __builtin_amdgcn_rcpf(1.f + __expf(-bb));
        float gc = gt;
#pragma unroll
        for (int o = 1; o < 64; o <<= 1) { const float t = __shfl_up(gc, o); if (lane >= o) gc += t; }
        const float gl = __shfl(gc, 63);
        GB[lane] = gc; GB[64 + lane] = beta; GB[128 + lane] = beta * __expf(gc); GB[192 + lane] = __expf(gl - gc); GB[256 + lane] = __expf(gc);
        if (lane == 0) egl[u] = __expf(gl); }
    f32x4 cw[3][4];
#pragma unroll
    for (int seg = 0; seg < 3; ++seg)
#pragma unroll
        for (int j = 0; j < 4; ++j) cw[seg][j] = R.cw[seg][j];
    { const float* onw = F.in[I_DNONW] + (tid & 7) * 16; const unsigned zz[8] = {R.Z[0].x, R.Z[0].y, R.Z[0].z, R.Z[0].w, R.Z[1].x, R.Z[1].y, R.Z[1].z, R.Z[1].w}; unsigned ow[8];
#pragma unroll
      for (int q = 0; q < 8; ++q) { const float za = bflo(zz[q]), zb = bfhi(zz[q]);
          ow[q] = pkbf(za * __builtin_amdgcn_rcpf(1.f + __expf(-za)) * onw[2 * q], zb * __builtin_amdgcn_rcpf(1.f + __expf(-zb)) * onw[2 * q + 1]); }
      bf16* zp = proj + (row0 + (tid >> 3)) * PW + PC_Z + h * HD + (tid & 7) * 16;
      *(v4u*)zp = (v4u){ow[0], ow[1], ow[2], ow[3]}; *(v4u*)(zp + 8) = (v4u){ow[4], ow[5], ow[6], ow[7]}; }
    __syncthreads();
    if (u_next >= 0) dn_prep_load(F, u_next, R);
    { const int hf = lane >> 5, c4 = lane & 31;
#pragma unroll
      for (int jj = 0; jj < 12; ++jj) { constexpr int dummy_ = 0; (void)dummy_; const int seg = jj >> 2;
        const int wi = wave + 8 * jj, i = 2 * (wi & 31) + hf;
        f32x4 y = {0.f, 0.f, 0.f, 0.f};
#pragma unroll
        for (int j = 0; j < 4; ++j) { const f32x4 w = cw[seg][j];
            const dn_u32x2 xx = *(const LAS dn_u32x2*)(L + P_RAW + (i + j) * 768 + seg * 256 + c4 * 8);
            y[0] += w[0] * bflo(xx.x); y[1] += w[1] * bfhi(xx.x); y[2] += w[2] * bflo(xx.y); y[3] += w[3] * bfhi(xx.y); }
        f32x4 s;
#pragma unroll
        for (int e = 0; e < 4; ++e) s[e] = y[e] * __builtin_amdgcn_rcpf(1.f + __expf(-y[e]));
        if (seg < 2) { float ss = (s[0] * s[0] + s[1] * s[1]) + (s[2] * s[2] + s[3] * s[3]);
            ss = add_xor16(row16_sum(ss));
            const float r = rsqrtf(ss + EPS) * (seg == 0 ? QSCALE : 1.f);
            s = s * r;
            *(LAS dn_u32x2*)(L + (seg == 0 ? P_QH : P_KH) + i * 272 + c4 * 8) = pack4f(s);
            if (seg == 0) { const int cc = c4 & 7, p0 = cc < 4 ? 8 * cc : 8 * (cc - 4) + 4;
                *(dn_u32x2*)(proj + (row0 + i) * PW + PC_Q + h * HD + 32 * (c4 >> 3) + p0) = pack4f(s * GB[256 + i]); }
            else { const float bge = GB[128 + i];
#pragma unroll
                for (int e = 0; e < 4; ++e) *(LAS unsigned short*)(L + P_KBGT + (4 * c4 + e) * 144 + i * 2) = bf1(s[e] * bge); } }
        else { const float be = GB[64 + i];
#pragma unroll
            for (int e = 0; e < 4; ++e) *(LAS unsigned short*)(L + P_VBT + (4 * c4 + e) * 144 + i * 2) = bf1(s[e] * be); } } }
    __syncthreads();
    LAS float* AT = (LAS float*)(L + P_AT);
#pragma unroll
    for (int q = 0; q < 2; ++q) { const int tt = wave + 8 * q, it = tt >> 2, jt = tt & 3;
        f32x4 kk = {0.f, 0.f, 0.f, 0.f}, qk = {0.f, 0.f, 0.f, 0.f};
        if (jt <= it) {
#pragma unroll
            for (int kq = 0; kq < 4; ++kq) { const dn_bf16x8 bk = *(const LAS dn_bf16x8*)(L + P_KH + (16 * jt + m) * 272 + (32 * kq + 8 * g) * 2);
                const dn_bf16x8 ak = *(const LAS dn_bf16x8*)(L + P_KH + (16 * it + m) * 272 + (32 * kq + 8 * g) * 2), aq = *(const LAS dn_bf16x8*)(L + P_QH + (16 * it + m) * 272 + (32 * kq + 8 * g) * 2);
                kk = mfma16(ak, bk, kk); qk = mfma16(aq, bk, qk); } }
        const int j = 16 * jt + m, jl = j & 31, p = jl < 16 ? 8 * (jl >> 2) + (jl & 3) : 8 * ((jl - 16) >> 2) + 4 + (jl & 3);
        const float gcj = GB[j];
#pragma unroll
        for (int r = 0; r < 4; ++r) { const int i = 16 * it + 4 * g + r; const float dec = i >= j ? __expf(GB[i] - gcj) : 0.f;
            AT[i * 68 + j] = i > j ? GB[64 + i] * kk[r] * dec : 0.f;
            *(LAS unsigned short*)(L + P_QKL + i * 144 + (32 * (j >> 5) + p) * 2) = bf1(qk[r] * dec); } }
    __syncthreads();
    if (wave >= 4) { const int t4 = tid - 256;
        for (int id = t4; id < 1024; id += 256) { const int k = id >> 3, sp = (id >> 2) & 1, gg = id & 3; float o8[8];
#pragma unroll
            for (int j = 0; j < 8; ++j) { const int cc = 32 * sp + (j < 4 ? 4 * gg + j : 16 + 4 * gg + j - 4);
                o8[j] = bflo((unsigned)*(const LAS unsigned short*)(L + P_KH + cc * 272 + k * 2)) * GB[192 + cc]; }
            v4u w; w.x = pkbf(o8[0], o8[1]); w.y = pkbf(o8[2], o8[3]); w.z = pkbf(o8[4], o8[5]); w.w = pkbf(o8[6], o8[7]);
            *(v4u*)(proj + (row0 + (k >> 1)) * PW + PC_K + h * HD + (k & 1) * 64 + 32 * sp + 8 * gg) = w; }
        for (int id = t4; id < 512; id += 256) { const int i = id >> 3, j8 = (id & 7) * 8;
            *(v4u*)(qks + i * 64 + j8) = *(const LAS v4u*)(L + P_QKL + i * 144 + j8 * 2); } }
    if (wave == 0) { const int bb = g, j = m; float X[16];
        X[0] = j == 0 ? 1.f : 0.f;
#pragma unroll
        for (int i = 1; i < 16; ++i) { const LAS float* Lr = AT + (16 * bb + i) * 68 + 16 * bb; float Lv[16];
#pragma unroll
            for (int q = 0; q < (i + 3) / 4; ++q) { const f32x4 t = *(const LAS f32x4*)(Lr + 4 * q); Lv[4 * q] = t[0]; Lv[4 * q + 1] = t[1]; Lv[4 * q + 2] = t[2]; Lv[4 * q + 3] = t[3]; }
            float acc = i == j ? 1.f : 0.f;
#pragma unroll
            for (int mm = 0; mm < i; ++mm) acc -= Lv[mm] * X[mm];
            X[i] = acc; }
#pragma unroll
        for (int i = 0; i < 16; ++i) AT[(16 * bb + i) * 68 + 16 * bb + j] = X[i]; }
    __syncthreads();
    if (wave < 2) { const int lo = 2 * wave, hi = 2 * wave + 1; LAS float* PS = (LAS float*)(L + P_PS) + wave * 320;
        f32x4 acc = {0.f, 0.f, 0.f, 0.f};
#pragma unroll
        for (int s = 0; s < 4; ++s) acc = mfma4(AT[(16 * hi + m) * 68 + 16 * lo + 4 * s + g], AT[(16 * lo + 4 * s + g) * 68 + 16 * lo + m], acc);
#pragma unroll
        for (int r = 0; r < 4; ++r) PS[(4 * g + r) * 20 + m] = acc[r];
        LDS_WAIT();
        f32x4 acc2 = {0.f, 0.f, 0.f, 0.f};
#pragma unroll
        for (int s = 0; s < 4; ++s) acc2 = mfma4(AT[(16 * hi + m) * 68 + 16 * hi + 4 * s + g], PS[(4 * s + g) * 20 + m], acc2);
#pragma unroll
        for (int r = 0; r < 4; ++r) AT[(16 * hi + 4 * g + r) * 68 + 16 * lo + m] = -acc2[r]; }
    __syncthreads();
    { LAS float* PS2 = (LAS float*)(L + P_PS2); const int ti = (wave >> 1) & 1, tj = wave & 1;
      if (wave < 4) { f32x4 acc = {0.f, 0.f, 0.f, 0.f};
#pragma unroll
          for (int s = 0; s < 8; ++s) acc = mfma4(AT[(32 + 16 * ti + m) * 68 + 4 * s + g], AT[(4 * s + g) * 68 + 16 * tj + m], acc);
#pragma unroll
          for (int r = 0; r < 4; ++r) PS2[(16 * ti + 4 * g + r) * 36 + 16 * tj + m] = acc[r]; }
      __syncthreads();
      if (wave < 4) { f32x4 acc = {0.f, 0.f, 0.f, 0.f};
#pragma unroll
          for (int s = 0; s < 8; ++s) acc = mfma4(AT[(32 + 16 * ti + m) * 68 + 32 + 4 * s + g], PS2[(4 * s + g) * 36 + 16 * tj + m], acc);
#pragma unroll
          for (int r = 0; r < 4; ++r) AT[(32 + 16 * ti + 4 * g + r) * 68 + 16 * tj + m] = -acc[r]; } }
    __syncthreads();
    { const int i = tid >> 3, j0 = (tid & 7) * 8; const f32x4 t0 = *(const LAS f32x4*)(AT + i * 68 + j0), t1 = *(const LAS f32x4*)(AT + i * 68 + j0 + 4);
      v4u w; w.x = pkbf(t0[0], t0[1]); w.y = pkbf(t0[2], t0[3]); w.z = pkbf(t1[0], t1[1]); w.w = pkbf(t1[2], t1[3]);
      *(LAS v4u*)(L + P_TB + i * 144 + j0 * 2) = w; }
    __syncthreads();
#pragma unroll
    for (int q = 0; q < 8; ++q) { const int tt = wave + 8 * q; f32x4 acc = {0.f, 0.f, 0.f, 0.f};
        if (tt < 32) { const int ct = tt >> 3, nt = tt & 7;
#pragma unroll
            for (int sp = 0; sp < 2; ++sp) acc = mfma16(*(const LAS dn_bf16x8*)(L + P_TB + (16 * ct + m) * 144 + (32 * sp + 8 * g) * 2), *(const LAS dn_bf16x8*)(L + P_VBT + (16 * nt + m) * 144 + (32 * sp + 8 * g) * 2), acc);
            const int v = 16 * nt + m;
            *(dn_u32x2*)(proj + (row0 + (v >> 1)) * PW + PC_V + h * HD + (v & 1) * 64 + 16 * ct + 4 * g) = pack4f(acc); }
        else { const int t2 = tt - 32, kt = t2 >> 2, ct = t2 & 3;
#pragma unroll
            for (int sp = 0; sp < 2; ++sp) acc = mfma16(*(const LAS dn_bf16x8*)(L + P_KBGT + (16 * kt + m) * 144 + (32 * sp + 8 * g) * 2), *(const LAS dn_bf16x8*)(L + P_TB + (16 * ct + m) * 144 + (32 * sp + 8 * g) * 2), acc);
            *(dn_u32x2*)(xbimg + (16 * ct + m) * 128 + 32 * (kt >> 1) + 8 * g + 4 * (kt & 1)) = pack4f(-acc); } }
    __syncthreads();
}
constexpr int S_WN = 0, S_QG = 17408, S_KDT = 34816, S_QKM = 53248, S_UT = 62464, S_OB = 80896, S_PSQ = 114688, S_ONW = 116736, S_Z = 117248, S_END = 152064;
static_assert(S_END <= MISC_OFF, "scan LDS map");
__device__ __forceinline__ void dn_scan_unit(const Frame& F, int bh) {
    const Tix T = tix(F.wv); const int tid = T.tid, lane = T.lane, wave = T.wave, m = lane & 15, g = lane >> 4, n0 = 32 * wave;
    const int b = bh >> 3, h = bh & 7;
    bf16* proj = (bf16*)(F.ws + WS_PROJ); const bf16* xbi = (const bf16*)(F.ws + WS_XB); const bf16* qks = (const bf16*)((unsigned char*)F.out + DO_QKS); const float* egl = (const float*)((unsigned char*)F.out + DO_EGL);
    LAS unsigned char* L = F.lds;
    LAS float* OB = (LAS float*)(L + S_OB);
    constexpr int NC = SEQ / 64;
#define WGBAR() do { asm volatile("s_waitcnt lgkmcnt(0)" ::: "memory"); __builtin_amdgcn_s_barrier(); asm volatile("" ::: "memory"); } while (0)
    if (wave >= 4) {
        const int ht = tid - 256;
        const unsigned lo_lin = (unsigned)ht * 16u;
        const unsigned lo_qg = (unsigned)(((ht >> 4) * PW + (ht & 15) * 8) * 2);
        const unsigned lo_kv = (unsigned)(((ht >> 4) * PW + ((ht >> 3) & 1) * 64 + (ht & 7) * 8) * 2);
        const unsigned ld_a = (unsigned)((ht >> 4) * 272 + (ht & 15) * 16), ld_b = (unsigned)((ht >> 3) * 144 + (ht & 7) * 16);
        const unsigned lo_fin = (unsigned)(((ht >> 2) * PW + (ht & 3) * 32) * 2);
        v4u RP[12], RQ[10];
#define DN_LOAD_P(cc) do { const size_t r0_ = (size_t)b * SEQ + (cc) * 64; const size_t u_ = (size_t)bh * 32 + (cc);               \
        _Pragma("unroll") for (int j_ = 0; j_ < 4; ++j_) {                                                                                                \
            RP[j_] = *(const v4u*)((const char*)(xbi + u_ * 8192 + 2048 * j_) + lo_lin);                                                                    \
            RP[4 + j_] = *(const v4u*)((const char*)(proj + (r0_ + 16 * j_) * PW + PC_Q + h * HD) + lo_qg);                                                 \
            RP[8 + j_] = *(const v4u*)((const char*)(proj + (r0_ + 16 * j_) * PW + PC_V + h * HD) + lo_kv); } } while (0)
#define DN_LOAD_Q(cc) do { const size_t r0_ = (size_t)b * SEQ + (cc) * 64; const size_t u_ = (size_t)bh * 32 + (cc);     \
        _Pragma("unroll") for (int j_ = 0; j_ < 4; ++j_) {                                                                                                \
            RQ[j_] = *(const v4u*)((const char*)(proj + (r0_ + 16 * j_) * PW + PC_K + h * HD) + lo_kv);                                                     \
            RQ[4 + j_] = *(const v4u*)((const char*)(proj + (r0_ + 16 * j_) * PW + PC_Z + h * HD) + lo_qg); }                                               \
        _Pragma("unroll") for (int j_ = 0; j_ < 2; ++j_) RQ[8 + j_] = *(const v4u*)((const char*)(qks + u_ * 4096 + 2048 * j_) + lo_lin); } while (0)
#define DN_WRITE_P() do { _Pragma("unroll") for (int j_ = 0; j_ < 4; ++j_) {                                                                               \
            *(LAS v4u*)(L + S_WN + ld_a + j_ * 4352) = RP[j_]; *(LAS v4u*)(L + S_QG + ld_a + j_ * 4352) = RP[4 + j_]; *(LAS v4u*)(L + S_UT + ld_b + j_ * 4608) = RP[8 + j_]; } } while (0)
#define DN_WRITE_Q(cc) do { _Pragma("unroll") for (int j_ = 0; j_ < 4; ++j_) { *(LAS v4u*)(L + S_KDT + ld_b + j_ * 4608) = RQ[j_];                         \
            *(LAS v4u*)(L + S_Z + ((cc) & 1) * 17408 + ld_a + j_ * 4352) = RQ[4 + j_]; }                                                                    \
        _Pragma("unroll") for (int j_ = 0; j_ < 2; ++j_) *(LAS v4u*)(L + S_QKM + ld_b + j_ * 4608) = RQ[8 + j_]; } while (0)
#define DN_FINAL(cc) do { const int fr_ = ht >> 2, fc_ = (ht & 3) * 32; float ss_ = 0.f;     \
        _Pragma("unroll") for (int p_ = 0; p_ < 8; ++p_) { const f32x4 o_ = *(const LAS f32x4*)(OB + fr_ * 132 + fc_ + 4 * p_);                              \
            ss_ += (o_[0] * o_[0] + o_[1] * o_[1]) + (o_[2] * o_[2] + o_[3] * o_[3]); }                                                                     \
        ss_ += dppf<0xB1>(ss_); ss_ += dppf<0x4E>(ss_);                                                                                                     \
        const float rn_ = rsqrtf(ss_ * (1.f / 128.f) + EPS);                                                                                               \
        bf16* dst_ = (bf16*)((char*)(proj + ((size_t)b * SEQ + (cc) * 64) * PW + PC_Q + h * HD) + lo_fin);              \
        _Pragma("unroll") for (int p_ = 0; p_ < 4; ++p_) {                                                                                                 \
            const f32x4 oa_ = *(const LAS f32x4*)(OB + fr_ * 132 + fc_ + 8 * p_), ob_ = *(const LAS f32x4*)(OB + fr_ * 132 + fc_ + 8 * p_ + 4);             \
            const v4u z_ = *(const LAS v4u*)(L + S_Z + ((cc) & 1) * 17408 + fr_ * 272 + (fc_ + 8 * p_) * 2);                                                \
            v4u w_; w_.x = pkbf(oa_[0] * rn_ * bflo(z_.x), oa_[1] * rn_ * bfhi(z_.x)); w_.y = pkbf(oa_[2] * rn_ * bflo(z_.y), oa_[3] * rn_ * bfhi(z_.y));   \
            w_.z = pkbf(ob_[0] * rn_ * bflo(z_.z), ob_[1] * rn_ * bfhi(z_.z)); w_.w = pkbf(ob_[2] * rn_ * bflo(z_.w), ob_[3] * rn_ * bfhi(z_.w));           \
            *(v4u*)(dst_ + 8 * p_) = w_; } } while (0)
        DN_LOAD_P(0); DN_LOAD_Q(0); DN_WRITE_P(); DN_WRITE_Q(0); DN_LOAD_P(1); DN_LOAD_Q(1);
        WGBAR();
        for (int c = 0; c < NC; ++c) {
            if (c > 0) { DN_FINAL(c - 1); DN_WRITE_Q(c); if (c + 1 < NC) DN_LOAD_Q(c + 1); }
            WGBAR();
            if (c + 1 < NC) { DN_WRITE_P(); if (c + 2 < NC) DN_LOAD_P(c + 2); }
            WGBAR();
        }
        DN_FINAL(NC - 1);
#undef DN_LOAD_P
#undef DN_LOAD_Q
#undef DN_WRITE_P
#undef DN_WRITE_Q
#undef DN_FINAL
    } else {
        f32x4 Sacc[2][8];
#pragma unroll
        for (int kt = 0; kt < 8; ++kt) { Sacc[0][kt] = (f32x4){0.f, 0.f, 0.f, 0.f}; Sacc[1][kt] = (f32x4){0.f, 0.f, 0.f, 0.f}; }
        const unsigned* eglu = (const unsigned*)egl + (size_t)bh * 32;
        float eg_next = __uint_as_float(__hip_atomic_load(eglu, __ATOMIC_RELAXED, __HIP_MEMORY_SCOPE_AGENT));
        const LAS unsigned char* fa = L + m * 272 + g * 16;
        const LAS unsigned char* fb = L + m * 144 + g * 16;
#define SBAR() __builtin_amdgcn_sched_barrier(0)
#define LD_A(X, base, ct) do { _Pragma("unroll") for (int s_ = 0; s_ < 4; ++s_) X[s_] = *(const LAS dn_bf16x8*)(fa + (base) + (ct) * 4352 + s_ * 64); } while (0)
#define LD_B(X, base, i0) do { _Pragma("unroll") for (int s_ = 0; s_ < 4; ++s_) X[s_] = *(const LAS dn_bf16x8*)(fb + (base) + ((i0) + (s_ >> 1)) * 2304 + (s_ & 1) * 64); } while (0)
        WGBAR();
        for (int c = 0; c < NC; ++c) {
            const float eg = eg_next;
            if (c + 1 < NC) eg_next = __uint_as_float(__hip_atomic_load(eglu + c + 1, __ATOMIC_RELAXED, __HIP_MEMORY_SCOPE_AGENT));
            dn_bf16x8 SB[2][4], X0[4], X1[4];
            LD_A(X0, S_WN, 0);
#pragma unroll
            for (int sl = 0; sl < 2; ++sl)
#pragma unroll
                for (int s = 0; s < 4; ++s) SB[sl][s] = pack8f(Sacc[sl][2 * s], Sacc[sl][2 * s + 1]);
            f32x4 VN[2][4], O[2][4];
#pragma unroll
            for (int ct = 0; ct < 4; ++ct)
#pragma unroll
                for (int sl = 0; sl < 2; ++sl) { const dn_u32x2 uu = *(const LAS dn_u32x2*)(L + S_UT + (n0 + 16 * sl + m) * 144 + (16 * ct + 4 * g) * 2);
                    VN[sl][ct] = (f32x4){bflo(uu.x), bfhi(uu.x), bflo(uu.y), bfhi(uu.y)}; O[sl][ct] = (f32x4){0.f, 0.f, 0.f, 0.f}; }
#pragma unroll
            for (int ct = 0; ct < 4; ++ct) {
                SBAR(); LD_A(X1, S_QG, ct); SBAR();
#pragma unroll
                for (int s = 0; s < 4; ++s) { VN[0][ct] = mfma16(X0[s], SB[0][s], VN[0][ct]); VN[1][ct] = mfma16(X0[s], SB[1][s], VN[1][ct]); }
                SBAR(); if (ct < 3) LD_A(X0, S_WN, ct + 1); SBAR();
#pragma unroll
                for (int s = 0; s < 4; ++s) { O[0][ct] = mfma16(X1[s], SB[0][s], O[0][ct]); O[1][ct] = mfma16(X1[s], SB[1][s], O[1][ct]); }
            }
            dn_bf16x8 VNB[2][2];
#pragma unroll
            for (int sl = 0; sl < 2; ++sl)
#pragma unroll
                for (int sp = 0; sp < 2; ++sp) VNB[sl][sp] = pack8f(VN[sl][2 * sp], VN[sl][2 * sp + 1]);
            WGBAR();
            SBAR(); LD_B(X0, S_QKM, 0); LD_B(X1, S_QKM, 2); SBAR();
#pragma unroll
            for (int s = 0; s < 4; ++s) { O[0][s >> 1] = mfma16(X0[s], VNB[0][s & 1], O[0][s >> 1]); O[1][s >> 1] = mfma16(X0[s], VNB[1][s & 1], O[1][s >> 1]); }
            SBAR(); LD_B(X0, S_KDT, 0); SBAR();
#pragma unroll
            for (int s = 0; s < 4; ++s) { O[0][2 + (s >> 1)] = mfma16(X1[s], VNB[0][s & 1], O[0][2 + (s >> 1)]); O[1][2 + (s >> 1)] = mfma16(X1[s], VNB[1][s & 1], O[1][2 + (s >> 1)]); }
#pragma unroll
            for (int kt = 0; kt < 8; ++kt) { Sacc[0][kt] = Sacc[0][kt] * eg; Sacc[1][kt] = Sacc[1][kt] * eg; }
#pragma unroll
            for (int q = 0; q < 4; ++q) {
                if (q & 1) { SBAR(); if (q < 3) LD_B(X0, S_KDT, 2 * q + 2); SBAR();
#pragma unroll
                    for (int s = 0; s < 4; ++s) { Sacc[0][2 * q + (s >> 1)] = mfma16(X1[s], VNB[0][s & 1], Sacc[0][2 * q + (s >> 1)]); Sacc[1][2 * q + (s >> 1)] = mfma16(X1[s], VNB[1][s & 1], Sacc[1][2 * q + (s >> 1)]); } }
                else { SBAR(); LD_B(X1, S_KDT, 2 * q + 2); SBAR();
#pragma unroll
                    for (int s = 0; s < 4; ++s) { Sacc[0][2 * q + (s >> 1)] = mfma16(X0[s], VNB[0][s & 1], Sacc[0][2 * q + (s >> 1)]); Sacc[1][2 * q + (s >> 1)] = mfma16(X0[s], VNB[1][s & 1], Sacc[1][2 * q + (s >> 1)]); } }
            }
#pragma unroll
            for (int sl = 0; sl < 2; ++sl)
#pragma unroll
                for (int ct = 0; ct < 4; ++ct)
#pragma unroll
                    for (int r = 0; r < 4; ++r) OB[(16 * ct + 4 * g + r) * 132 + n0 + 16 * sl + m] = O[sl][ct][r];
            WGBAR();
        }
#undef SBAR
#undef LD_A
#undef LD_B
    }
#undef WGBAR
}
__device__ __forceinline__ void fox_blk(const Frame& F, int it, int j, att::Blk& k) {
    const int bh = it >> 2, y = it & 3, qb = j == 0 ? y : 7 - y, b = bh >> 3, h = bh & 7; const size_t row0 = (size_t)b * SEQ + qb * 256;
    bf16* proj = (bf16*)(F.ws + WS_PROJ);
    k.Q = proj + row0 * PW + PC_Q + h * HD; k.K = proj + (size_t)b * SEQ * PW + PC_K + h * HD; k.voff = PC_V - PC_K; k.goff = PC_Z - PC_Q;
    k.flog = (const float*)(F.ws + WS_AB) + (size_t)b * SEQ * 16 + h; k.fb = F.in[I_FOXFB][h]; k.P0 = qb * 256; k.skv = SEQ; k.kvpitch = PW;
}
__device__ __forceinline__ void mem_blk(const Frame& F, int idx, att::Blk& k) {
    const int b = idx >> 5, hm = (idx >> 3) & 3, qb = idx & 7; const size_t row0 = (size_t)b * SEQ + qb * 256;
    bf16* proj = (bf16*)(F.ws + WS_PROJ); const bf16* mkv = (const bf16*)(F.ws + WS_MEMKV);
    static_assert(att::QP == PW, "attention Q pitch");
    k.Q = proj + row0 * PW + PC_QM + hm * HD; k.K = mkv + (size_t)b * NMEM * DM + hm * HD; k.voff = 512; k.goff = 0;
    k.flog = nullptr; k.fb = 0.f; k.P0 = 1 << 20; k.skv = NMEM; k.kvpitch = DM;
}
struct SrcL1 { const Frame* F; int vcu;
    __device__ __forceinline__ bool operator()(int n, att::Blk& k) const { const int it = vcu + (n / 3) * F->G, j = n % 3; if (it >= 256) return false;
        if (j < 2) fox_blk(*F, it, j, k); else mem_blk(*F, it, k); return true; } };
struct SrcL0 { const Frame* F; int first, stride;
    __device__ __forceinline__ bool operator()(int n, att::Blk& k) const { const int idx = first + n * stride; if (idx >= 256) return false; mem_blk(*F, idx, k); return true; } };
#define IN(k) (lo <= (k) && (k) < hi)
#define SEAM(k) do { if (IN(k) && IN((k) + 1)) xcd_barrier(bar); } while (0)
#define SEAMG(k, s_) do { if (IN(k) && IN((k) + 1)) { if (gb.on) grp_barrier(gb, (s_)); else xcd_barrier(bar); } } while (0)
template <int layer> __device__ __forceinline__ void layer_body(const Frame& F, const XcdBarrier& bar, GrpBar& gb, bool grp_try, int lo, int hi, unsigned char* lds) {
    bf16* proj = (bf16*)(F.ws + WS_PROJ); bf16* xb = (bf16*)(F.ws + WS_XB); float* xsq = (float*)(F.ws + WS_XSQ);
    float* ab = (float*)(F.ws + WS_AB);

        const int pb = 1 + (layer ? 6 : 0);
        if (IN(pb)) {
            pg8::Gemm g{xb, (const bf16*)(F.ws + (layer ? WS_WIN1 : WS_WIN0)), MROWS, N_IN, DM, DM}; pg8::StaticOrder S; S.init(MROWS, N_IN, F.G, F.bid);
            const float* nk = layer ? F.in[I_FOXKNW] : nullptr; const float* nq = layer ? F.in[I_FOXQNW] : nullptr;
            pg8::EpiProj<true, false, layer == 0> E{proj, PW, xsq, ab, 18, (bf16*)((unsigned char*)F.out + DO_HALO), 0, layer ? 4 : 0, nk, 12, layer ? 16 : 12, nq, 16, 18, F.in[I_MEMQNW] + layer * HD};
            pg8::gemm_phase<pg8::EpiProj<true, false, layer == 0>, pg8::StaticOrder, true, true>(F.lds, g, S, E, F.wv);
            if (layer == 0) {
                pg8::Gemm g2{(const bf16*)((unsigned char*)F.out + DO_MEMB), (const bf16*)(F.ws + WS_WMKV), MMEM, DM, DM, DM}; pg8::StaticOrder S2; S2.init(MMEM, DM, F.G, F.G - 1 - F.bid);
                pg8::EpiProj<true, false> E2{(bf16*)(F.ws + WS_MEMKV), DM, (const float*)(F.ws + WS_MSQ), nullptr, 4, nullptr, 0, 2, F.in[I_MEMKNW], 0, 0, nullptr, 0, 0, nullptr};
                pg8::gemm_phase<pg8::EpiProj<true, false>, pg8::StaticOrder, true, true>(F.lds, g2, S2, E2, F.wv);
            }
        }
        SEAM(pb);
        if (layer == 0 && grp_try) gb.on = __hip_atomic_load((unsigned*)((gu32*)(F.ws + WS_CTL) + CW_BAD), __ATOMIC_RELAXED, __HIP_MEMORY_SCOPE_AGENT) == 0u;
        const int pm = pb + (layer ? 1 : 2);
        if (layer == 0) {
            if (IN(pb + 1)) { constexpr int NU = BATCH * NH * (SEQ / 64); DnPre R; int u = F.bid; if (u < NU) dn_prep_load(F, u, R);
                              for (; u < NU; u += F.G) dn_prep_unit(F, u, u + F.G < NU ? u + F.G : -1, R); }
            SEAM(pb + 1);
        }
        if (IN(pm)) {
            if (layer == 0) {
                if (F.bid < 64) dn_scan_unit(F, F.bid);
                else { const SrcL0 src{&F, F.bid - 64, F.G - 64}; att::phase((char*)lds, src, F.wv);
                       __syncthreads();
                       const Tix T = tix(F.wv); convert_weights<6, 18>(F, (LAS float*)(F.lds + T.wave * 17408), T.lane, (F.bid - 64) * NWAVES + T.wave, (F.G - 64) * NWAVES, 0); }
            } else {
                const int vcu = (F.G % 8 == 0) ? (F.bid % 8) * (F.G / 8) + F.bid / 8 : F.bid;
                const SrcL1 src{&F, vcu}; att::phase((char*)lds, src, F.wv);
            }
            __syncthreads();
        }
        SEAM(pm);
        if (IN(pm + 1)) {
            pg8::Gemm g{proj + PC_Q, (const bf16*)(F.ws + (layer ? WS_WOUT1 : WS_WOUT0)), MROWS, DM, OUT_IN, PW}; pg8::StaticOrder S; S.init(MROWS, DM, F.G, F.bid);
            pg8::EpiRes E{layer ? (const float*)F.out : F.in[I_X], F.out, xb, xsq};
            pg8::gemm_phase<pg8::EpiRes, pg8::StaticOrder, true, true>(F.lds, g, S, E, F.wv);
        }
        SEAMG(pm + 1, layer * 3 + 0);
        if (IN(pm + 2)) {
            pg8::Gemm g{xb, (const bf16*)(F.ws + (layer ? WS_WM1_1 : WS_WM1_0)), MROWS, FF, DM, DM}; pg8::StaticOrder S; S.init(MROWS, FF, F.G, F.bid);
            pg8::EpiProj<false, true> E{proj, FF, xsq, nullptr, 16, nullptr, 0, 0, nullptr, 0, 0, nullptr, 0, 0, nullptr};
            pg8::gemm_phase<pg8::EpiProj<false, true>, pg8::StaticOrder, true, true>(F.lds, g, S, E, F.wv);
        }
        SEAMG(pm + 2, layer * 3 + 1);
        if (IN(pm + 3)) {
            pg8::Gemm g{proj, (const bf16*)(F.ws + (layer ? WS_WM2_1 : WS_WM2_0)), MROWS, DM, FF, FF}; pg8::StaticOrder S; S.init(MROWS, DM, F.G, F.bid);
            pg8::EpiRes E{(const float*)F.out, F.out, xb, xsq};
            pg8::gemm_phase<pg8::EpiRes, pg8::StaticOrder, true, true>(F.lds, g, S, E, F.wv);
        }
        if (layer == 0) SEAMG(pm + 3, 2); else SEAM(pm + 3);
    }
#undef IN
#undef SEAM
#undef SEAMG
__global__ void __launch_bounds__(NWAVES * 64, 2) hyb_fwd(Args args) {
    extern __shared__ __attribute__((aligned(16))) unsigned char lds[];
    Frame F;
    F.lds = (LAS unsigned char*)lds;
    F.G = gridDim.x; F.bid = blockIdx.x; F.in = args.in; F.out = args.out; F.ws = args.ws; F.wv = __builtin_amdgcn_readfirstlane((int)threadIdx.x >> 6);
    volatile LAS unsigned* MISC = (volatile LAS unsigned*)(F.lds + MISC_OFF);
    gu32* ctl = (gu32*)(args.ws + WS_CTL);
    for (int u = threadIdx.x; u < (LDS_BYTES - MISC_OFF) / 4; u += NWAVES * 64) ((LAS unsigned*)(F.lds + MISC_OFF))[u] = 0u;
    __syncthreads();
    XcdBarrier bar; bar.bar = (unsigned*)(ctl + CW_BAR) + args.li * XCD_BAR_WORDS; bar.x = 0; bar.st = nullptr; bar.wv = F.wv;
    if (!MK_LAUNCH_PER_PHASE) { bar = xcd_barrier_post((unsigned*)(ctl + CW_BAR) + args.li * XCD_BAR_WORDS, MISC + 8); bar.wv = F.wv; }
    const int lo = args.ph_lo, hi = args.ph_hi;
#define IN(k) (lo <= (k) && (k) < hi)
#define SEAM(k) do { if (IN(k) && IN((k) + 1)) xcd_barrier(bar); } while (0)
    bf16* proj = (bf16*)(F.ws + WS_PROJ); bf16* xb = (bf16*)(F.ws + WS_XB); float* xsq = (float*)(F.ws + WS_XSQ);
    float* ab = (float*)(F.ws + WS_AB);

    GrpBar gb; gb.cnt = (unsigned*)(ctl + CW_GRP) + (size_t)(F.bid & 63) * 8 * 64; gb.tmo = (unsigned*)(ctl + CW_BAR) + XB_TMO; gb.wv = F.wv; gb.on = false;
    const bool grp_try = !MK_LAUNCH_PER_PHASE && F.G == 256 && lo == 0 && hi == N_PHASES;
    if (grp_try && F.wv == 0 && lane_id() == 0) __hip_atomic_store((unsigned*)(ctl + CW_XCC) + F.bid, xb_xcc_id() + 1u, __ATOMIC_RELAXED, __HIP_MEMORY_SCOPE_AGENT);
    if (IN(0)) { p0_prologue(F); } SEAM(0);
    if (grp_try && F.wv == 0 && lane_id() == 0) { const unsigned mine = xb_xcc_id() + 1u; bool same = true;
        for (int k = 1; k < 4; ++k) same = same && __hip_atomic_load((unsigned*)(ctl + CW_XCC) + ((F.bid + 64 * k) & 255), __ATOMIC_RELAXED, __HIP_MEMORY_SCOPE_AGENT) == mine;
        if (!same) atomicAdd((unsigned*)(ctl + CW_BAD), 1u); }

    layer_body<0>(F, bar, gb, grp_try, lo, hi, lds);
    layer_body<1>(F, bar, gb, grp_try, lo, hi, lds);
#undef IN
#undef SEAM
}

extern "C" void kernel_launch(void* const* d_in, const int* in_sizes, int n_in, void* d_out, int out_size, void* d_ws, size_t ws_size, hipStream_t stream) {
    static int grid = 0;
    if (grid == 0) {
        if (n_in != 20 || in_sizes[0] != MROWS * DM || out_size != MROWS * DM || ws_size < WS_END) {
            fprintf(stderr, "kernel_launch: shape/workspace mismatch (n_in %d, in0 %d, out %d, ws %zu; need ws >= %zu); nothing launched\n", n_in, n_in > 0 ? in_sizes[0] : -1, out_size, ws_size, (size_t)WS_END); grid = -1; return; }
        int dev = 0, cus = 0, per_cu = 0;
        if (hipGetDevice(&dev) != hipSuccess || hipDeviceGetAttribute(&cus, hipDeviceAttributeMultiprocessorCount, dev) != hipSuccess) { fprintf(stderr, "kernel_launch: device query failed\n"); grid = -1; return; }
        if (hipFuncSetAttribute((const void*)hyb_fwd, hipFuncAttributeMaxDynamicSharedMemorySize, LDS_BYTES) != hipSuccess) { fprintf(stderr, "kernel_launch: hipFuncSetAttribute failed\n"); grid = -1; return; }
        if (hipOccupancyMaxActiveBlocksPerMultiprocessor(&per_cu, (const void*)hyb_fwd, NWAVES * 64, LDS_BYTES) != hipSuccess || per_cu < 1) {
            fprintf(stderr, "kernel_launch: occupancy query reports %d workgroups per CU; nothing launched\n", per_cu); (void)hipGetLastError(); grid = -1; return; }
        if (cus < 128) { fprintf(stderr, "kernel_launch: %d CUs; this kernel's phase program needs at least 128 workgroups; nothing launched\n", cus); grid = -1; return; }
        grid = cus;
    }
    if (grid < 0) return;
    if (hipMemsetAsync((char*)d_ws + WS_CTL, 0, CTL_ZERO_BYTES, stream) != hipSuccess) { fprintf(stderr, "kernel_launch: memset failed\n"); return; }
    Args a{};
    for (int i = 0; i < 20; ++i) a.in[i] = (const float*)d_in[i];
    a.out = (float*)d_out; a.ws = (unsigned char*)d_ws;
#if MK_LAUNCH_PER_PHASE
    for (int p = 0; p < N_PHASES; ++p) { a.ph_lo = p; a.ph_hi = p + 1; a.li = 0; hipLaunchKernelGGL(hyb_fwd, dim3(grid), dim3(NWAVES * 64), LDS_BYTES, stream, a); }
#else
    a.ph_lo = 0; a.ph_hi = N_PHASES; a.li = 0;
    hipLaunchKernelGGL(hyb_fwd, dim3(grid), dim3(NWAVES * 64), LDS_BYTES, stream, a);
#endif
    const hipError_t le = hipPeekAtLastError();
    if (le != hipSuccess) fprintf(stderr, "kernel_launch: launch failed: %s\n", hipGetErrorName(le));
}
```

```cpp
#include <hip/hip_runtime.h>
#include <cstdio>
#include <cstdint>

constexpr int BATCH = 8, SEQ = 2048, DM = 1024, MROWS = BATCH * SEQ;
constexpr int NMEM = 256, MMEM = BATCH * NMEM;
constexpr int HD = 128, NH = 8, NMH = 4, FF = 4096;
constexpr int PW = 4608;
constexpr int PC_K = 0, PC_V = 1024, PC_Z = 2048, PC_Q = 3072, PC_QM = 4096, PC_AB = 4608;
constexpr int N_IN = 4864;
constexpr int DN_IN = 4624, FOX_IN = 4616, OUT_IN = 1536;
constexpr float EPS = 1e-6f;
constexpr float QSCALE = 0.08838834764831845f;

__device__ __forceinline__ int lane_id_v() { int x; asm volatile("v_mbcnt_lo_u32_b32 %0, -1, 0\n\tv_mbcnt_hi_u32_b32 %0, -1, %0" : "=v"(x)); return x; }
template <int CTRL> __device__ __forceinline__ float dppf(float x) { return __builtin_bit_cast(float, __builtin_amdgcn_update_dpp(0, __builtin_bit_cast(int, x), CTRL, 0xf, 0xf, true)); }
__device__ __forceinline__ float row16_sum(float x) { x += dppf<0xB1>(x); x += dppf<0x4E>(x); x += dppf<0x141>(x); x += dppf<0x140>(x); return x; }
__device__ __forceinline__ float add_xor16(float x) { auto r = __builtin_amdgcn_permlane16_swap(__float_as_uint(x), __float_as_uint(x), false, false); return __uint_as_float(r[0]) + __uint_as_float(r[1]); }
__device__ __forceinline__ float add_xor32(float x) { auto r = __builtin_amdgcn_permlane32_swap(__float_as_uint(x), __float_as_uint(x), false, false); return __uint_as_float(r[0]) + __uint_as_float(r[1]); }
namespace pg8 {
#define PG8_LAS __attribute__((address_space(3)))
typedef unsigned short bf16_t;
typedef short bf16x8 __attribute__((ext_vector_type(8)));
typedef float f32x4 __attribute__((ext_vector_type(4)));
typedef unsigned u32x4 __attribute__((ext_vector_type(4)));
constexpr int BM = 256, BK = 64, HALF = 128, HTB = HALF * BK * 2  , STAGE_BYTES = 8 * HTB, NXCD = 8, WGM = 8;

__host__ __device__ __forceinline__ int lds_byte(int r, int c) { const int st = (r >> 4) * 2 + (c >> 5), rr = r & 15, cc = c & 31, ob = rr * 64 + cc * 2; return st * 1024 + (ob ^ (((ob >> 9) & 1) << 5)); }
__host__ __device__ __forceinline__ void stage_rc(int b, int& R, int& C) { const int st = b / 1024, sb = b % 1024, swz = sb ^ (((sb >> 9) & 1) << 5); R = (st >> 1) * 16 + swz / 64; C = (st & 1) * 32 + (swz % 64) / 2; }
__host__ __device__ __forceinline__ int perm32(int rho) { const int n = rho >> 4, i = rho & 15; return 8 * (i >> 2) + 4 * n + (i & 3); }

struct Unit { int pm, pn; };
struct Gemm { const bf16_t* A; const bf16_t* Bt; int M, N, K, lda; };

struct StaticOrder {
    int nM, nN, nwg, G, c;
    __host__ __device__ void init(int M, int N, int G_, int c_) { nM = M / BM; nN = N / BM; nwg = nM * nN; G = G_; c = c_; }
    __host__ __device__ bool next(int i, Unit& u) const {
        const long L = (long)i * G + c; if (L >= nwg) return false;
        int wgid = (int)L; { const int q = nwg / NXCD, r = nwg % NXCD, xcd = wgid % NXCD, off = wgid / NXCD; wgid = (xcd < r ? xcd * (q + 1) : r * (q + 1) + (xcd - r) * q) + off; }
        const int nig = WGM * nN, gid = wgid / nig, fm = gid * WGM, gsz = (nM - fm) < WGM ? (nM - fm) : WGM;
        u.pm = fm + ((wgid % nig) % gsz); u.pn = (wgid % nig) / gsz; return true;
    }
    __device__ __forceinline__ void a_ready(const Unit&) const {}
    __device__ __forceinline__ void done(const Unit&) const {}
};


__device__ __forceinline__ unsigned cvt_pk_bf16(float lo, float hi) { unsigned r; asm volatile("v_cvt_pk_bf16_f32 %0, %1, %2" : "=v"(r) : "v"(lo), "v"(hi)); return r; }

constexpr int EPI_XCH = 131072, EPI_RS = 139264;
template <bool NORM, bool RELU2, bool HALO = false> struct EpiProj {
    static constexpr bool PERM = true, AFTER_DRAIN = false, USE_RS = true, ACC_INIT = false;
    bf16_t* O; int ldc; const float* xsq; float* ab; int n_main; bf16_t* halo;
    int nlo0, nhi0; const float* nw0; int nlo1, nhi1; const float* nw1; int nlo2, nhi2; const float* nw2;
    __device__ __forceinline__ void rs_load(const Unit& u, int tid, f32x4 (&q)[4]) const { const float* p = xsq + (size_t)(u.pm * BM + tid) * 16;
#pragma unroll
        for (int i = 0; i < 4; ++i) q[i] = *(const f32x4*)(p + 4 * i); }
    __device__ __forceinline__ void rs_store(const f32x4 (&q)[4], PG8_LAS unsigned char* lds, int parity, int tid) const {
        const f32x4 t = (q[0] + q[1]) + (q[2] + q[3]);
        ((PG8_LAS float*)(lds + EPI_RS))[parity * 256 + tid] = rsqrtf(((t[0] + t[1]) + (t[2] + t[3])) * (1.0f / 1024.0f) + 1e-6f); }
    __device__ __forceinline__ void operator()(const f32x4 (&acc)[2][2][4][2], const Unit& u, int wr, int wc, int fr, int fq, PG8_LAS unsigned char* lds, int parity) const {
        const int rl0 = wr * 64 + fr, row0 = u.pm * BM + rl0, colt = u.pn * BM;
        const bool is_ab = u.pn >= n_main;
        const PG8_LAS float* RS = (const PG8_LAS float*)(lds + EPI_RS) + parity * 256;
        const float* nw = nullptr;
        if (NORM) { if (u.pn >= nlo0 && u.pn < nhi0) nw = nw0; else if (u.pn >= nlo1 && u.pn < nhi1) nw = nw1; else if (u.pn >= nlo2 && u.pn < nhi2) nw = nw2; }
        f32x4 w0 = {1.f, 1.f, 1.f, 1.f}, w1 = w0;
        if (NORM && nw != nullptr) {
            w0 = *(const f32x4*)(nw + wc * 32 + 8 * fq); w1 = *(const f32x4*)(nw + wc * 32 + 8 * fq + 4);
            PG8_LAS float* X = (PG8_LAS float*)(lds + EPI_XCH);
#pragma unroll
            for (int ai = 0; ai < 2; ++ai)
#pragma unroll
                for (int m = 0; m < 4; ++m) { const int rl = rl0 + ai * HALF + m * 16; const float rstd = RS[rl];
#pragma unroll
                    for (int bj = 0; bj < 2; ++bj) { const f32x4 v0 = acc[ai][bj][m][0] * rstd, v1 = acc[ai][bj][m][1] * rstd;
                        float ss = ((v0[0] * v0[0] + v0[1] * v0[1]) + (v0[2] * v0[2] + v0[3] * v0[3])) + ((v1[0] * v1[0] + v1[1] * v1[1]) + (v1[2] * v1[2] + v1[3] * v1[3]));
                        ss = add_xor32(add_xor16(ss));
                        if (fq == 0) X[(bj * 256 + rl) * 4 + wc] = ss; } }
            asm volatile("s_waitcnt lgkmcnt(0)" ::: "memory"); __builtin_amdgcn_s_barrier(); asm volatile("" ::: "memory");
        }
#pragma unroll
        for (int ai = 0; ai < 2; ++ai)
#pragma unroll
            for (int m = 0; m < 4; ++m) {
                const int rl = rl0 + ai * HALF + m * 16, r = row0 + ai * HALF + m * 16;
                const float rstd = RS[rl];
                if (!is_ab) {
#pragma unroll
                    for (int bj = 0; bj < 2; ++bj) {
                        float sc = rstd;
                        if (NORM && nw != nullptr) { const f32x4 p4 = *(const PG8_LAS f32x4*)((const PG8_LAS float*)(lds + EPI_XCH) + (bj * 256 + rl) * 4);
                            sc = rstd * rsqrtf(((p4[0] + p4[1]) + (p4[2] + p4[3])) * (1.0f / 128.0f) + 1e-6f); }
                        f32x4 v0 = acc[ai][bj][m][0] * sc * w0, v1 = acc[ai][bj][m][1] * sc * w1;
                        if (RELU2) {
#pragma unroll
                            for (int e = 0; e < 4; ++e) { const float a = fmaxf(v0[e], 0.f), b = fmaxf(v1[e], 0.f); v0[e] = a * a; v1[e] = b * b; }
                        }
                        u32x4 w; w.x = cvt_pk_bf16(v0[0], v0[1]); w.y = cvt_pk_bf16(v0[2], v0[3]); w.z = cvt_pk_bf16(v1[0], v1[1]); w.w = cvt_pk_bf16(v1[2], v1[3]);
                        *(u32x4*)(O + (size_t)r * ldc + colt + bj * HALF + wc * 32 + 8 * fq) = w;
                        if (HALO && m == 3 && fr >= 13) *(u32x4*)(halo + ((size_t)(r >> 6) * 3 + ((r & 63) - 61)) * ldc + colt + bj * HALF + wc * 32 + 8 * fq) = w;
                    }
                } else if (ab != nullptr && wc == 0 && fq < 2) {
                    float* p = ab + (size_t)r * 16 + 8 * fq;
                    *(f32x4*)p = acc[ai][0][m][0] * rstd; *(f32x4*)(p + 4) = acc[ai][0][m][1] * rstd;
                }
            }
    }
};
template <bool LAST = false> struct EpiRes {
    static constexpr bool PERM = true, AFTER_DRAIN = false, USE_RS = false, ACC_INIT = true;
    const float* xold; float* xnew; bf16_t* xb; float* xsq;
    __device__ __forceinline__ void init(f32x4 (&acc)[2][2][4][2], const Unit& u, int wr, int wc, int fr, int fq) const {
        const int row0 = u.pm * BM + wr * 64 + fr, colt = u.pn * BM;
#pragma unroll
        for (int ai = 0; ai < 2; ++ai)
#pragma unroll
            for (int m = 0; m < 4; ++m)
#pragma unroll
                for (int bj = 0; bj < 2; ++bj) { const float* p = xold + (size_t)(row0 + ai * HALF + m * 16) * 1024 + colt + bj * HALF + wc * 32 + 8 * fq;
                    acc[ai][bj][m][0] = *(const f32x4*)p; acc[ai][bj][m][1] = *(const f32x4*)(p + 4); }
    }
    __device__ __forceinline__ void operator()(const f32x4 (&acc)[2][2][4][2], const Unit& u, int wr, int wc, int fr, int fq, PG8_LAS unsigned char*, int) const {
        const int row0 = u.pm * BM + wr * 64 + fr, colt = u.pn * BM;
#pragma unroll
        for (int ai = 0; ai < 2; ++ai)
#pragma unroll
            for (int m = 0; m < 4; ++m) {
                const int r = row0 + ai * HALF + m * 16; float ss = 0.f;
#pragma unroll
                for (int bj = 0; bj < 2; ++bj) {
                    const size_t off = (size_t)r * 1024 + colt + bj * HALF + wc * 32 + 8 * fq;
                    const f32x4 v0 = acc[ai][bj][m][0], v1 = acc[ai][bj][m][1];
                    *(f32x4*)(xnew + off) = v0; *(f32x4*)(xnew + off + 4) = v1;
                    if (!LAST) {
                    ss += ((v0[0] * v0[0] + v0[1] * v0[1]) + (v0[2] * v0[2] + v0[3] * v0[3])) + ((v1[0] * v1[0] + v1[1] * v1[1]) + (v1[2] * v1[2] + v1[3] * v1[3]));
                    u32x4 w; w.x = cvt_pk_bf16(v0[0], v0[1]); w.y = cvt_pk_bf16(v0[2], v0[3]); w.z = cvt_pk_bf16(v1[0], v1[1]); w.w = cvt_pk_bf16(v1[2], v1[3]);
                    *(u32x4*)(xb + off) = w; }
                }
                if (!LAST) { ss = add_xor32(add_xor16(ss));
                if (fq == 0) xsq[(size_t)r * 16 + u.pn * 4 + wc] = ss; }
            }
    }
};

template <class Epi, class Sched, bool ALIGN_EPI = false, bool SP2 = false>
__device__ __forceinline__ void gemm_phase(PG8_LAS unsigned char* lds, const Gemm g, const Sched& S, const Epi& E, int wid) {
    const int lane = lane_id_v();
    const int tid = wid * 64 + lane, wr = wid >> 2, wc = wid & 3, fr = lane & 15, fq = lane >> 4;
    const int K = g.K, nt = K / BK;
    unsigned voffA[2], voffB[2];
#pragma unroll
    for (int i = 0; i < 2; ++i) { int R, C; stage_rc(tid * 16 + i * 8192, R, C); const int Rb = Epi::PERM ? ((R & ~31) + perm32(R & 31)) : R;
        voffA[i] = (unsigned)(R * g.lda + C) * 2u; voffB[i] = (unsigned)(Rb * K + C) * 2u; }
    const size_t kstep = (size_t)(BK * 2);
    const size_t hstepA = (size_t)HALF * g.lda * 2, hstepB = (size_t)HALF * K * 2;
    const size_t tstepA = 2 * hstepA, tstepB = 2 * hstepB;
    const unsigned ldsw = (unsigned)wid * 1024u;
    const int aoff = lds_byte(wr * 64 + fr, fq * 8), boff = lds_byte(wc * 32 + fr, fq * 8);
#define PG8_SA(b, h) (((b) * 2 + (h)) * HTB)
#define PG8_SB(b, h) ((4 + (b) * 2 + (h)) * HTB)
#define PG8_STAGE(bufoff, gbase, voff) do { _Pragma("unroll") for (int _i = 0; _i < 2; ++_i) \
        __builtin_amdgcn_global_load_lds((const unsigned*)((const char*)(gbase) + (voff)[_i]), (PG8_LAS unsigned*)(lds + (bufoff) + ldsw + _i * 8192), 16, 0, 0); } while (0)
#define PG8_LDA(dst, b, h) do { _Pragma("unroll") for (int m = 0; m < 4; ++m) _Pragma("unroll") for (int k = 0; k < 2; ++k) dst[m][k] = *(const PG8_LAS bf16x8*)(lds + PG8_SA(b, h) + aoff + m * 2048 + k * 1024); } while (0)
#define PG8_LDB(dst, b, h) do { _Pragma("unroll") for (int n = 0; n < 2; ++n) _Pragma("unroll") for (int k = 0; k < 2; ++k) dst[n][k] = *(const PG8_LAS bf16x8*)(lds + PG8_SB(b, h) + boff + n * 2048 + k * 1024); } while (0)
#define PG8_MMA(ai, bj, At, Bt) do { __builtin_amdgcn_s_setprio(1); _Pragma("unroll") for (int m = 0; m < 4; ++m) _Pragma("unroll") for (int n = 0; n < 2; ++n) _Pragma("unroll") for (int k = 0; k < 2; ++k) \
        acc[ai][bj][m][n] = __builtin_amdgcn_mfma_f32_16x16x32_bf16(Bt[n][k], At[m][k], acc[ai][bj][m][n], 0, 0, 0); __builtin_amdgcn_s_setprio(0); } while (0)
#define PG8_WAIT_V(n) asm volatile("s_waitcnt vmcnt(" #n ")" ::: "memory")
#define PG8_WAIT_L(n) asm volatile("s_waitcnt lgkmcnt(" #n ")" ::: "memory")
#define PG8_BAR __builtin_amdgcn_s_barrier()
#define PG8_SCHED __builtin_amdgcn_sched_barrier(0)
    Unit cur, nxt; int ui = 0;
    if (!S.next(0, cur)) return;
    f32x4 acc[2][2][4][2];
    if constexpr (Epi::ACC_INIT) E.init(acc, cur, wr, wc, fr, fq);
    else {
#pragma unroll
    for (int a = 0; a < 2; ++a)
#pragma unroll
        for (int b = 0; b < 2; ++b)
#pragma unroll
            for (int m = 0; m < 4; ++m)
#pragma unroll
                for (int n = 0; n < 2; ++n) acc[a][b][m][n] = (f32x4){0.f, 0.f, 0.f, 0.f};
    }
    bf16x8 At[4][2], B0[2][2], B1[2][2];
    const char* cA = (const char*)g.A + (size_t)cur.pm * tstepA; const char* cB = (const char*)g.Bt + (size_t)cur.pn * tstepB;
    S.a_ready(cur);
    if constexpr (Epi::USE_RS) { if (tid < 256) { f32x4 rq[4]; E.rs_load(cur, tid, rq); E.rs_store(rq, lds, 0, tid); } }
    if constexpr (SP2) {
        PG8_STAGE(PG8_SB(0, 0), cB, voffB); PG8_STAGE(PG8_SB(0, 1), cB + hstepB, voffB); PG8_STAGE(PG8_SA(0, 0), cA, voffA); PG8_STAGE(PG8_SA(0, 1), cA + hstepA, voffA);
        if (wr == 1) PG8_BAR;
        PG8_WAIT_V(2); PG8_BAR;
        PG8_STAGE(PG8_SB(1, 0), cB + kstep, voffB); PG8_STAGE(PG8_SA(1, 0), cA + kstep, voffA); PG8_STAGE(PG8_SB(1, 1), cB + hstepB + kstep, voffB);
        PG8_WAIT_V(6); PG8_BAR;
    } else {
        PG8_STAGE(PG8_SB(0, 0), cB, voffB); PG8_STAGE(PG8_SA(0, 0), cA, voffA); PG8_STAGE(PG8_SB(0, 1), cB + hstepB, voffB); PG8_STAGE(PG8_SA(0, 1), cA + hstepA, voffA);
        if (wr == 1) PG8_BAR;
        PG8_WAIT_V(4); PG8_BAR;
        PG8_STAGE(PG8_SB(1, 0), cB + kstep, voffB); PG8_STAGE(PG8_SA(1, 0), cA + kstep, voffA); PG8_STAGE(PG8_SB(1, 1), cB + hstepB + kstep, voffB);
        PG8_WAIT_V(6); PG8_BAR;
    }
    for (;;) {
        const bool has_next = S.next(ui + 1, nxt);
        const char* nA = has_next ? (const char*)g.A + (size_t)nxt.pm * tstepA : cA; const char* nB = has_next ? (const char*)g.Bt + (size_t)nxt.pn * tstepB : cB;
        for (int t = 0; t < nt; t += 2) {
            const bool last = (t == nt - 2);
            const char* a1 = cA + (size_t)(t + 1) * kstep;
            const char* a2 = last ? nA : cA + (size_t)(t + 2) * kstep; const char* b2 = last ? nB : cB + (size_t)(t + 2) * kstep;
            const char* a3 = a2 + kstep; const char* b3 = b2 + kstep;
            if (last && has_next) S.a_ready(nxt);
            if constexpr (SP2) {
            PG8_LDB(B0, 0, 0); PG8_LDB(B1, 0, 1); PG8_SCHED; PG8_LDA(At, 0, 0); PG8_STAGE(PG8_SA(1, 1), a1 + hstepA, voffA);
            PG8_WAIT_V(8); PG8_WAIT_L(0); PG8_BAR; PG8_MMA(0, 0, At, B0); PG8_MMA(0, 1, At, B1); PG8_BAR; PG8_SCHED;
            PG8_LDA(At, 0, 1); PG8_STAGE(PG8_SB(0, 0), b2, voffB); PG8_STAGE(PG8_SB(0, 1), b2 + hstepB, voffB); PG8_STAGE(PG8_SA(0, 0), a2, voffA);
            PG8_WAIT_V(8); PG8_WAIT_L(0); PG8_BAR; PG8_MMA(1, 0, At, B0); PG8_MMA(1, 1, At, B1); PG8_BAR; PG8_SCHED;
            PG8_LDB(B0, 1, 0); PG8_LDB(B1, 1, 1); PG8_SCHED; PG8_LDA(At, 1, 0); PG8_STAGE(PG8_SA(0, 1), a2 + hstepA, voffA);
            PG8_WAIT_V(8); PG8_WAIT_L(0); PG8_BAR; PG8_MMA(0, 0, At, B0); PG8_MMA(0, 1, At, B1); PG8_BAR; PG8_SCHED;
            PG8_LDA(At, 1, 1); PG8_STAGE(PG8_SB(1, 0), b3, voffB); PG8_STAGE(PG8_SB(1, 1), b3 + hstepB, voffB); PG8_STAGE(PG8_SA(1, 0), a3, voffA);
            PG8_WAIT_V(8); PG8_WAIT_L(0); PG8_BAR; PG8_MMA(1, 0, At, B0); PG8_MMA(1, 1, At, B1); PG8_BAR; PG8_SCHED;
            } else {
            PG8_LDB(B0, 0, 0); PG8_SCHED; PG8_LDA(At, 0, 0); PG8_STAGE(PG8_SA(1, 1), a1 + hstepA, voffA);
            PG8_WAIT_L(8); PG8_BAR; PG8_WAIT_L(0); PG8_MMA(0, 0, At, B0); PG8_BAR; PG8_SCHED;
            PG8_LDB(B1, 0, 1); PG8_STAGE(PG8_SB(0, 0), b2, voffB);
            PG8_BAR; PG8_WAIT_L(0); PG8_MMA(0, 1, At, B1); PG8_BAR;
            PG8_LDA(At, 0, 1); PG8_STAGE(PG8_SA(0, 0), a2, voffA);
            PG8_BAR; PG8_WAIT_L(0); PG8_MMA(1, 0, At, B0); PG8_BAR; PG8_SCHED;
            PG8_STAGE(PG8_SB(0, 1), b2 + hstepB, voffB);
            PG8_WAIT_V(6); PG8_BAR; PG8_MMA(1, 1, At, B1); PG8_BAR;
            PG8_LDB(B0, 1, 0); PG8_SCHED; PG8_LDA(At, 1, 0); PG8_STAGE(PG8_SA(0, 1), a2 + hstepA, voffA);
            PG8_WAIT_L(8); PG8_BAR; PG8_WAIT_L(0); PG8_MMA(0, 0, At, B0); PG8_BAR; PG8_SCHED;
            PG8_LDB(B1, 1, 1); PG8_STAGE(PG8_SB(1, 0), b3, voffB);
            PG8_BAR; PG8_WAIT_L(0); PG8_MMA(0, 1, At, B1); PG8_BAR;
            PG8_LDA(At, 1, 1); PG8_STAGE(PG8_SA(1, 0), a3, voffA);
            PG8_BAR; PG8_WAIT_L(0); PG8_MMA(1, 0, At, B0); PG8_BAR; PG8_SCHED;
            PG8_STAGE(PG8_SB(1, 1), b3 + hstepB, voffB);
            PG8_WAIT_V(6); PG8_BAR; PG8_MMA(1, 1, At, B1); PG8_BAR;
            }
        }
        if constexpr (ALIGN_EPI) { if (wr == 0) PG8_BAR; }
        if constexpr (Epi::USE_RS) {
            f32x4 rq[4]; if (has_next && tid < 256) E.rs_load(nxt, tid, rq);
            E(acc, cur, wr, wc, fr, fq, lds, ui & 1);
            if (has_next && tid < 256) E.rs_store(rq, lds, (ui + 1) & 1, tid);
        } else { E(acc, cur, wr, wc, fr, fq, lds, ui & 1); }
        S.done(cur);
        if (!has_next) break;
        if constexpr (Epi::ACC_INIT) E.init(acc, nxt, wr, wc, fr, fq);
        else {
#pragma unroll
        for (int a = 0; a < 2; ++a)
#pragma unroll
            for (int b = 0; b < 2; ++b)
#pragma unroll
                for (int m = 0; m < 4; ++m)
#pragma unroll
                    for (int n = 0; n < 2; ++n) acc[a][b][m][n] = (f32x4){0.f, 0.f, 0.f, 0.f};
        }
        cur = nxt; cA = nA; cB = nB; ++ui;
        if constexpr (ALIGN_EPI) { if (wr == 1) PG8_BAR; }
    }
    PG8_WAIT_V(0);
    if constexpr (!ALIGN_EPI) { if (wr == 0) PG8_BAR; }
    PG8_BAR;
    if constexpr (Epi::AFTER_DRAIN) { E.fused(acc, cur, wr, wc, fr, fq, lds, wid, lane); S.done(cur); }
#undef PG8_SA
#undef PG8_SB
#undef PG8_STAGE
#undef PG8_LDA
#undef PG8_LDB
#undef PG8_MMA
#undef PG8_WAIT_V
#undef PG8_WAIT_L
#undef PG8_BAR
#undef PG8_SCHED
}
}

namespace att {
typedef unsigned short bf16_t;
typedef short bf16x8 __attribute__((ext_vector_type(8)));
typedef short s16x4 __attribute__((ext_vector_type(4)));
typedef float f32x16 __attribute__((ext_vector_type(16)));
typedef float f32x4 __attribute__((ext_vector_type(4)));
typedef unsigned u32x4 __attribute__((ext_vector_type(4)));
constexpr int NW = 8, QBLK = 32, KVBLK = 64, QB = NW * QBLK, D = 128;
constexpr int SHM_V = KVBLK * D * 2, SHM_K = KVBLK * D * 2;
constexpr int OFF_WS = 2 * SHM_V + 2 * SHM_K, OFF_BK = OFF_WS + NW * 64 * 4, ATT_LDS = OFF_BK + 8192;
constexpr float SCALE = 0.08838834764831845f, THR = 8.f;
constexpr int WBIG = 1 << 30;
#define KSWZ(row, colB) ((row) * 256 + ((colB) ^ (((row) & 7) << 4)))
#define SBAR() __builtin_amdgcn_sched_barrier(0)
__device__ __forceinline__ int v_st(int k, int c) { const int kk = (k & ~0xC) | ((k & 4) << 1) | ((k & 8) >> 1); return ((kk >> 3) * 4 + (c >> 5)) * 512 + ((kk & 7) * 32 + (c & 31)) * 2; }
__device__ __forceinline__ int v_rd_base(int lane) { return ((lane & 3) << 3) | (((lane >> 2) & 3) << 6) | (((lane >> 4) & 1) << 5) | (((lane >> 5) & 1) << 8); }
constexpr int v_rd_off(int d0, int ks, int half) { return d0 * 512 + ks * 4096 + half * 2048; }
__device__ __forceinline__ int crow(int r, int hi) { return (r & 3) + 8 * (r >> 2) + 4 * hi; }
__device__ __forceinline__ unsigned cvtpk(float lo, float hi) { unsigned r; asm volatile("v_cvt_pk_bf16_f32 %0, %1, %2" : "=v"(r) : "v"(lo), "v"(hi)); return r; }
__device__ __forceinline__ bf16x8 load8(const bf16_t* p) { return *reinterpret_cast<const bf16x8*>(p); }
__device__ __forceinline__ void mask_tile(f32x16& p0, f32x16& p1, int dq, unsigned W) {
    const float NEG = -__builtin_inff();
#pragma unroll
    for (int r = 0; r < 16; ++r) { const int c = (r & 3) + 8 * (r >> 2);
        if ((unsigned)(dq - c) >= W) p0[r] = NEG;
        if ((unsigned)(dq - c - 32) >= W) p1[r] = NEG; }
}
__device__ __forceinline__ void partialSM(f32x16& p0, f32x16& p1, float& m_reg, float& mn, float& alpha) {
    float pmax = p0[0]; for (int r = 1; r < 16; ++r) pmax = fmaxf(pmax, p0[r]); for (int r = 0; r < 16; ++r) pmax = fmaxf(pmax, p1[r]);
    { auto rr = __builtin_amdgcn_permlane32_swap(__float_as_uint(pmax), __float_as_uint(pmax), false, false);
      pmax = fmaxf(__uint_as_float(rr[0]), __uint_as_float(rr[1])); }
    constexpr float C2 = 1.4426950408889634f * SCALE;
    if (__builtin_expect(__all((pmax - m_reg) * SCALE <= THR), 1)) { mn = m_reg; alpha = 1.f; }
    else { mn = fmaxf(m_reg, pmax); alpha = __builtin_amdgcn_exp2f((m_reg - mn) * C2); m_reg = mn; }
    const float mnL = -mn * C2;
    for (int r = 0; r < 16; ++r) p0[r] = fmaf(p0[r], C2, mnL); for (int r = 0; r < 16; ++r) p1[r] = fmaf(p1[r], C2, mnL);
    for (int r = 0; r < 16; ++r) p0[r] = __builtin_amdgcn_exp2f(p0[r]);
}
__device__ __forceinline__ void finishSM(f32x16& p0, f32x16& p1, float alpha, float& l_reg, bf16x8& pa0, bf16x8& pa1, bf16x8& pa2, bf16x8& pa3) {
    for (int r = 0; r < 16; ++r) p1[r] = __builtin_amdgcn_exp2f(p1[r]);
    float ps = 0; for (int r = 0; r < 16; ++r) ps += p0[r]; for (int r = 0; r < 16; ++r) ps += p1[r];
    { auto rr = __builtin_amdgcn_permlane32_swap(__float_as_uint(ps), __float_as_uint(ps), false, false);
      ps = __uint_as_float(rr[0]) + __uint_as_float(rr[1]); }
    l_reg = l_reg * alpha + ps;
#define PK4(P, B_, OUT) do { unsigned a0 = cvtpk(P[B_+0], P[B_+1]), a1 = cvtpk(P[B_+2], P[B_+3]);                          \
        unsigned b0 = cvtpk(P[B_+4], P[B_+5]), b1 = cvtpk(P[B_+6], P[B_+7]);                                             \
        auto r0 = __builtin_amdgcn_permlane32_swap(a0, b0, false, false); auto r1 = __builtin_amdgcn_permlane32_swap(a1, b1, false, false); \
        u32x4 w = {r0[0], r1[0], r0[1], r1[1]}; OUT = *reinterpret_cast<bf16x8*>(&w); } while (0)
    PK4(p0, 0, pa0); PK4(p0, 8, pa1); PK4(p1, 0, pa2); PK4(p1, 8, pa3);
#undef PK4
}
template <int KB>
__device__ __forceinline__ void qkt(f32x16& p0, f32x16& p1, const char* K_lds, int r32, int hi, const bf16x8* qr, const float* bb) {
#pragma unroll
    for (int g = 0; g < 4; ++g) { const f32x4 b0 = *(const f32x4*)(bb + 8 * g), b1 = *(const f32x4*)(bb + 32 + 8 * g);
#pragma unroll
        for (int i = 0; i < 4; ++i) { p0[4 * g + i] = b0[i]; p1[4 * g + i] = b1[i]; } }
    const char* kb[4];
#pragma unroll
    for (int dd = 0; dd < 4; ++dd) kb[dd] = K_lds + KB * SHM_K + KSWZ(r32, (dd * 16 + hi * 8) * 2);
#pragma unroll
    for (int d0 = 0; d0 < 8; ++d0) { const char* a = kb[d0 & 3] + (d0 >> 2) * 128;
        bf16x8 b0 = *reinterpret_cast<const bf16x8*>(a);
        bf16x8 b1 = *reinterpret_cast<const bf16x8*>(a + 32 * 256);
        p0 = __builtin_amdgcn_mfma_f32_32x32x16_bf16(b0, qr[d0], p0, 0, 0, 0);
        p1 = __builtin_amdgcn_mfma_f32_32x32x16_bf16(b1, qr[d0], p1, 0, 0, 0); }
}
template <int VB>
__device__ __forceinline__ void pv_tile(f32x16* o, int vb0, bf16x8 pa0, bf16x8 pa1, bf16x8 pa2, bf16x8 pa3) {
#define TRRD(dst, off) asm volatile("ds_read_b64_tr_b16 %0, %1 offset:%2" : "=&v"(dst) : "v"(vb0), "i"(off) : "memory")
#define PV_D0(d0) do { s16x4 l0, l1, l2, l3, h0, h1, h2, h3; constexpr int b_ = VB * SHM_V + v_rd_off(d0, 0, 0);   \
        TRRD(l0, b_); TRRD(h0, b_ + 2048); TRRD(l1, b_ + 4096); TRRD(h1, b_ + 6144); TRRD(l2, b_ + 8192); TRRD(h2, b_ + 10240); TRRD(l3, b_ + 12288); TRRD(h3, b_ + 14336); \
        asm volatile("s_waitcnt lgkmcnt(0)" ::: "memory"); SBAR();   \
        o[d0] = __builtin_amdgcn_mfma_f32_32x32x16_bf16(pa0, (bf16x8){l0[0], l0[1], l0[2], l0[3], h0[0], h0[1], h0[2], h0[3]}, o[d0], 0, 0, 0);   \
        o[d0] = __builtin_amdgcn_mfma_f32_32x32x16_bf16(pa1, (bf16x8){l1[0], l1[1], l1[2], l1[3], h1[0], h1[1], h1[2], h1[3]}, o[d0], 0, 0, 0);   \
        o[d0] = __builtin_amdgcn_mfma_f32_32x32x16_bf16(pa2, (bf16x8){l2[0], l2[1], l2[2], l2[3], h2[0], h2[1], h2[2], h2[3]}, o[d0], 0, 0, 0);   \
        o[d0] = __builtin_amdgcn_mfma_f32_32x32x16_bf16(pa3, (bf16x8){l3[0], l3[1], l3[2], l3[3], h3[0], h3[1], h3[2], h3[3]}, o[d0], 0, 0, 0); } while (0)
    PV_D0(0); PV_D0(1); PV_D0(2); PV_D0(3);
#undef PV_D0
#undef TRRD
}
constexpr int QP = 4608;
struct Blk { bf16_t* Q; const bf16_t* K; const float* flog; float fb; int voff, goff, P0, skv, kvpitch; };
struct Seam { bf16x8 qr[8]; bf16x8 st_v0, st_v1, st_k0, st_k1; };
#define ROW(p, pitch, k0, rr) ((p) + (size_t)((k0) + (rr)) * (pitch) + sc)
#define VMW() asm volatile("s_waitcnt vmcnt(0)" ::: "memory")
#define VMWN(n) asm volatile("s_waitcnt vmcnt(%0)" :: "i"(n) : "memory")
#define SLOAD_H(Kp, Vp, pitch, k0) do { S.st_v0 = load8(ROW(Vp, pitch, k0, sr)); S.st_v1 = load8(ROW(Vp, pitch, k0, 32 + sr));              \
                         S.st_k0 = load8(ROW(Kp, pitch, k0, sr)); S.st_k1 = load8(ROW(Kp, pitch, k0, 32 + sr)); } while (0)
#define SWRITE_HK(bf) do { *(bf16x8*)(K_lds + (bf) * SHM_K + kws) = S.st_k0; *(bf16x8*)(K_lds + (bf) * SHM_K + kws + 32 * 256) = S.st_k1; } while (0)
#define SWRITE_HV(bf) do { *(bf16x8*)(V_lds + (bf) * SHM_V + vst0) = S.st_v0; *(bf16x8*)(V_lds + (bf) * SHM_V + vst1) = S.st_v1; } while (0)
#define SWRITE_H(bf) do { SWRITE_HV(bf); SWRITE_HK(bf); } while (0)
__device__ __forceinline__ void prime(const Blk& cur, char* lds, Seam& S, int wid) {
    const int lane = lane_id_v();
    const int tid = wid * 64 + lane, r32 = lane & 31, hi = lane >> 5;
    const int sr = tid >> 4, sc = (tid & 15) * 8, kws = KSWZ(sr, sc * 2); char* K_lds = lds + 2 * SHM_V;
    for (int d0 = 0; d0 < 8; ++d0) S.qr[d0] = load8(cur.Q + (size_t)(wid * QBLK + r32) * QP + d0 * 16 + hi * 8);
    SLOAD_H(cur.K, cur.K + cur.voff, cur.kvpitch, 0); VMW(); SWRITE_HK(0);
    __syncthreads();
}
__device__ __forceinline__ void block(const Blk& cur, const Blk& nxt, char* lds, Seam& S, int wid) {
    const int lane = lane_id_v();
    const int tid = wid * 64 + lane, r32 = lane & 31, hi = lane >> 5;
    constexpr int W = WBIG;
    int j_hi = (cur.P0 + QB - 1) / KVBLK + 1; if (j_hi > cur.skv / KVBLK) j_hi = cur.skv / KVBLK;
    const int NT = j_hi;
    const int qlo = cur.P0 + wid * QBLK, qm = qlo + r32 - 4 * hi;
    char* V_lds = lds; char* K_lds = lds + 2 * SHM_V;
    float* ws = (float*)(lds + OFF_WS) + wid * 64; float* li_l = ws, * al_l = ws + 32;
    float* bkl = (float*)(lds + OFF_BK);
    { const int nkeys = NT * KVBLK;
      if (cur.flog) { const int k0 = 4 * tid; float f[4];
#pragma unroll
          for (int e = 0; e < 4; ++e) { float x = 0.f; if (k0 + e < nkeys) x = cur.flog[(size_t)(k0 + e) * 16] + cur.fb;
              f[e] = k0 + e < nkeys ? fminf(x, 0.f) - log1pf(__expf(-fabsf(x))) : 0.f; }
          f[1] += f[0]; f[2] += f[1]; f[3] += f[2];
          float sc = f[3];
#pragma unroll
          for (int o_ = 1; o_ < 64; o_ <<= 1) { const float t_ = __shfl_up(sc, o_); if (lane >= o_) sc += t_; }
          if (lane == 63) ws[0] = sc;
          __syncthreads();
          float off = sc - f[3];
          for (int w_ = 0; w_ < wid; ++w_) off += ((const float*)(lds + OFF_WS))[w_ * 64];
#pragma unroll
          for (int e = 0; e < 4; ++e) if (k0 + e < nkeys) bkl[k0 + e] = -(f[e] + off) * (1.f / SCALE); }
      else for (int k = tid; k < nkeys; k += NW * 64) bkl[k] = 0.f;
      __syncthreads(); }
    float m_reg = -1e30f, l_reg = 0; f32x16 o[4] = {};
    const int sr = tid >> 4, sc = (tid & 15) * 8, vst0 = v_st(sr, sc), vst1 = v_st(32 + sr, sc), kws = KSWZ(sr, sc * 2);
    const int vb0 = (int)(uintptr_t)V_lds + v_rd_base(lane);
    const bf16_t* Kh = cur.K; const bf16_t* Vh = cur.K + cur.voff; const int kvp = cur.kvpitch;
#define RESC(a) do { if (__any((a) < 1.f)) { if (hi == 0) al_l[r32] = (a); asm volatile("s_waitcnt lgkmcnt(0)" ::: "memory");              \
                     for (int d_ = 0; d_ < 4; ++d_) for (int r = 0; r < 16; ++r) o[d_][r] *= al_l[crow(r, hi)]; } } while (0)
#define KBASE(t) ((t) * KVBLK)
#define MASKT(P0_, P1_, t) do { const int kb_ = KBASE(t); if (kb_ + KVBLK - 1 > qlo) mask_tile(P0_, P1_, qm - kb_, (unsigned)W); } while (0)
#define BB(t) (bkl + KBASE(t) + 4 * hi)
    constexpr int NQL = 8;
#define SEAM_K0() do { VMWN(NQL); SWRITE_HK(0); SBAR(); } while (0)
    f32x16 pA0, pA1, pB0, pB1; float mnA, mnB, alA, alB; bf16x8 pa0, pa1, pa2, pa3;
    SWRITE_HV(0); SBAR();
    if (NT > 1) { SLOAD_H(Kh, Vh, kvp, KBASE(1)); }
    SBAR(); qkt<0>(pA0, pA1, K_lds, r32, hi, S.qr, BB(0));
    MASKT(pA0, pA1, 0); partialSM(pA0, pA1, m_reg, mnA, alA);
    if (NT > 1) { VMW(); SWRITE_H(1); }
    __syncthreads();
#define HALF_STEP(PX0, PX1, mnX, alX, PY0, PY1, alY, t, KB, VB, SB) do {                                                      \
        SBAR(); qkt<KB>(PX0, PX1, K_lds, r32, hi, S.qr, BB(t));                                                                      \
        finishSM(PY0, PY1, alY, l_reg, pa0, pa1, pa2, pa3); SBAR();                                                           \
        if ((t) + 1 < NT) { SLOAD_H(Kh, Vh, kvp, KBASE((t) + 1)); SBAR(); }                                                   \
        pv_tile<VB>(o, vb0, pa0, pa1, pa2, pa3); MASKT(PX0, PX1, (t)); partialSM(PX0, PX1, m_reg, mnX, alX);   \
        __syncthreads();                                                                                                      \
        if ((t) + 1 < NT) { VMW(); SWRITE_H(SB); }                                                                            \
        RESC(alX); __syncthreads(); } while (0)
    for (int t = 1; t + 1 < NT; t += 2) {
        HALF_STEP(pB0, pB1, mnB, alB, pA0, pA1, alA, t, 1, 0, 0);
        HALF_STEP(pA0, pA1, mnA, alA, pB0, pB1, alB, t + 1, 0, 1, 1);
    }
    const bool even = (NT & 1) == 0;
    if (even) { SBAR(); qkt<1>(pB0, pB1, K_lds, r32, hi, S.qr, BB(NT - 1)); SBAR(); }
    SLOAD_H(nxt.K, nxt.K + nxt.voff, nxt.kvpitch, 0); SBAR();
#pragma unroll
    for (int d0 = 0; d0 < 8; ++d0) S.qr[d0] = load8(nxt.Q + (size_t)(wid * QBLK + r32) * QP + d0 * 16 + hi * 8);
    SBAR();
    finishSM(pA0, pA1, alA, l_reg, pa0, pa1, pa2, pa3); SBAR();
    pv_tile<0>(o, vb0, pa0, pa1, pa2, pa3);
    if (even) { MASKT(pB0, pB1, NT - 1); partialSM(pB0, pB1, m_reg, mnB, alB); __syncthreads(); RESC(alB);
        finishSM(pB0, pB1, alB, l_reg, pa0, pa1, pa2, pa3); SBAR(); pv_tile<1>(o, vb0, pa0, pa1, pa2, pa3); }
    SBAR(); SEAM_K0();
    if (hi == 0) li_l[r32] = l_reg; asm volatile("s_waitcnt lgkmcnt(0)" ::: "memory");
    float rli[16];
#pragma unroll
    for (int r = 0; r < 16; ++r) rli[r] = __builtin_amdgcn_rcpf(li_l[crow(r, hi)]);
    bf16_t* Ow = cur.Q + (size_t)(wid * QBLK + 4 * hi) * QP + r32; const int goff = cur.goff;
#pragma unroll
    for (int r = 0; r < 16; ++r) { const int ro = ((r & 3) + 8 * (r >> 2)) * QP;
#pragma unroll
        for (int d0 = 0; d0 < 4; ++d0) { float v = o[d0][r] * rli[r];
            if (goff) { const float g = __uint_as_float((unsigned)Ow[goff + ro + d0 * 32] << 16); v *= __builtin_amdgcn_rcpf(1.f + __expf(-g)); }
            const float vn = dppf<0xB1>(v);
            if ((r32 & 1) == 0) *(unsigned*)(Ow + ro + d0 * 32) = cvtpk(v, vn); } }
    __syncthreads();
#undef RESC
#undef KBASE
#undef MASKT
#undef BB
#undef SEAM_K0
#undef HALF_STEP
}
#undef ROW
#undef VMW
#undef VMWN
#undef SLOAD_H
#undef SWRITE_HK
#undef SWRITE_HV
#undef SWRITE_H
#undef KSWZ
#undef SBAR
template <class Src> __device__ __forceinline__ void phase(char* lds, const Src& src, int wid) {
    Blk cur, nxt; if (!src(0, cur)) return;
    Seam S; prime(cur, lds, S, wid);
    for (int n = 0;; ++n) { const bool more = src(n + 1, nxt); if (!more) nxt = cur; block(cur, nxt, lds, S, wid); if (!more) break; cur = nxt; }
}
}

constexpr int NWAVES = 8;
#ifndef MK_LAUNCH_PER_PHASE
#define MK_LAUNCH_PER_PHASE 0
#endif
constexpr int N_PHASES = 12;

constexpr size_t KiB = 1u << 10, MiB = 1u << 20;
constexpr size_t WS_CTL = 0, CTL_ZERO_BYTES = 1 * MiB;
constexpr size_t WS_WIN0 = 1 * MiB, WS_WIN1 = WS_WIN0 + (size_t)N_IN * DM * 2;
constexpr size_t WS_WOUT0 = 20 * MiB, WS_WOUT1 = 23 * MiB;
constexpr size_t WS_WM1_0 = 26 * MiB, WS_WM1_1 = 34 * MiB, WS_WM2_0 = 42 * MiB, WS_WM2_1 = 50 * MiB;
constexpr size_t WS_WMKV = 58 * MiB;
constexpr size_t WS_PROJ = 60 * MiB;
constexpr size_t WS_XB = 204 * MiB;
constexpr size_t WS_SSQ = 236 * MiB;
constexpr size_t WS_AB = 245 * MiB;
constexpr size_t WS_MEMKV = 246 * MiB;
constexpr size_t WS_XSQ = 250 * MiB;
constexpr size_t WS_FCUM = 251 * MiB;
constexpr size_t WS_MSSQ = 251 * MiB + 512 * KiB;
constexpr size_t WS_MSQ = 251 * MiB + 768 * KiB;
constexpr size_t WS_END = 252 * MiB;
static_assert(WS_WIN1 + (size_t)N_IN * DM * 2 <= WS_WOUT0 && WS_PROJ + (size_t)MROWS * PW * 2 <= WS_XB && WS_SSQ + (size_t)36 * MROWS * 16 <= WS_AB, "d_ws map");
constexpr size_t DO_MEMB = 0;
constexpr int CW_BAR = 4096;

constexpr int LDS_BYTES = 155648;
constexpr int MISC_OFF = LDS_BYTES - 256;

#define GAS __attribute__((address_space(1)))
#define LAS __attribute__((address_space(3)))
typedef unsigned short bf16;
typedef unsigned v4u __attribute__((ext_vector_type(4)));
typedef float f32x4 __attribute__((ext_vector_type(4)));
typedef short bf16x8 __attribute__((ext_vector_type(8)));
typedef GAS unsigned gu32;
typedef GAS unsigned long long gu64;
#define RLX_AGENT __ATOMIC_RELAXED, __HIP_MEMORY_SCOPE_AGENT
#define LDS_WAIT() asm volatile("s_waitcnt lgkmcnt(0)" ::: "memory")
#define VM_WAIT() asm volatile("s_waitcnt vmcnt(0)" ::: "memory")
__device__ __forceinline__ unsigned long long rt() { return __builtin_amdgcn_s_memrealtime(); }
__device__ __forceinline__ unsigned f2bf(float f) { unsigned u = __builtin_bit_cast(unsigned, f); return (u + 0x7fffu + ((u >> 16) & 1u)) >> 16; }
__device__ __forceinline__ unsigned pk2(float lo, float hi) { return f2bf(lo) | (f2bf(hi) << 16); }

#define XB_TMO      128
#define XB_XCNT(j)  (256  + 64 * (j))
#define XB_XSUB(j)  (1280 + 64 * (j))
#define XB_XGEN(j)  (2304 + 64 * (j))
#define XB_TOP      3328
#define XB_TOPGEN   3392
#define XCD_BAR_WORDS 3456
#define XB_SPIN_CAP (1u << 18)

__device__ __forceinline__ unsigned xb_ld(unsigned* p)              { return __hip_atomic_load(p, __ATOMIC_RELAXED, __HIP_MEMORY_SCOPE_AGENT); }
__device__ __forceinline__ unsigned xb_add(unsigned* p, unsigned v) { return __hip_atomic_fetch_add(p, v, __ATOMIC_RELAXED, __HIP_MEMORY_SCOPE_AGENT); }
__device__ __forceinline__ unsigned xb_xcc_id() { return (unsigned)__builtin_amdgcn_s_getreg((3 << 11) | 20) & 0xFu; }
#define XB_SPIN(cond, bar) do { unsigned _sp = 0; while (cond) { __builtin_amdgcn_s_sleep(1); \
    if ((++_sp & 255u) == 0u) { if (xb_ld(&(bar)[XB_TMO])) break; if (_sp > XB_SPIN_CAP) { atomicAdd(&(bar)[XB_TMO], 1u); break; } } } } while (0)

struct XcdBarrier {
    unsigned* bar; unsigned x; int wv;
    volatile LAS unsigned* st;
};

__device__ __forceinline__ XcdBarrier xcd_barrier_post(unsigned* bar, volatile LAS unsigned* st) {
    XcdBarrier b; b.bar = bar; b.x = xb_xcc_id(); b.st = st;
    if (threadIdx.x == 0) (void)xb_add(&bar[XB_XCNT(b.x)], 1u);
    return b;
}
__device__ __forceinline__ void xcd_barrier_complete(unsigned* bar, unsigned x, unsigned& nloc, unsigned& nx) {
    const unsigned G = gridDim.x * gridDim.y * gridDim.z;
    unsigned sum, cnt, mine, sp = 0u;
    for (;;) {
        sum = 0u; cnt = 0u; mine = 0u;
#pragma unroll
        for (unsigned j = 0; j < 16; ++j) { const unsigned c = xb_ld(&bar[XB_XCNT(j)]); sum += c; cnt += (c > 0u) ? 1u : 0u; mine = (j == x) ? c : mine; }
        if (sum == G) break;
        __builtin_amdgcn_s_sleep(1);
        if ((++sp & 255u) == 0u) { if (xb_ld(&bar[XB_TMO])) break; if (sp > XB_SPIN_CAP) { atomicAdd(&bar[XB_TMO], 1u); break; } }
    }
    nloc = mine > 0u ? mine : 1u; nx = cnt > 0u ? cnt : 1u;
}

__device__ __forceinline__ void xcd_barrier(const XcdBarrier& b) {
    asm volatile("s_waitcnt vmcnt(0)" ::: "memory");
    __syncthreads();
    if (b.wv == 0 && lane_id_v() == 0) {
        unsigned* bar = b.bar;
        __builtin_amdgcn_s_waitcnt(0);
        unsigned nloc = b.st[0], nx = b.st[1];
        if (nloc == 0u) { xcd_barrier_complete(bar, b.x, nloc, nx); b.st[0] = nloc; b.st[1] = nx; }
        const unsigned old = xb_add(&bar[XB_XSUB(b.x)], 1u);
        const unsigned gen = old / nloc;
        if (old + 1u == (gen + 1u) * nloc) {
            __builtin_amdgcn_fence(__ATOMIC_RELEASE, "agent");
            asm volatile("s_waitcnt vmcnt(0)" ::: "memory");
            const unsigned og = xb_add(&bar[XB_TOP], 1u);
            const unsigned tg = og / nx;
            if (og + 1u == (tg + 1u) * nx) xb_add(&bar[XB_TOPGEN], 1u);
            else XB_SPIN(xb_ld(&bar[XB_TOPGEN]) == tg, bar);
            __builtin_amdgcn_fence(__ATOMIC_ACQUIRE, "agent");
            xb_add(&bar[XB_XGEN(b.x)], 1u);
            asm volatile("s_waitcnt vmcnt(0)" ::: "memory");
        } else {
            XB_SPIN(xb_ld(&bar[XB_XGEN(b.x)]) == gen, bar);
            __builtin_amdgcn_fence(__ATOMIC_ACQUIRE, "agent");
            asm volatile("s_waitcnt vmcnt(0)" ::: "memory");
        }
    }
    __syncthreads();
}


__device__ __forceinline__ float bflo(unsigned u) { return __builtin_bit_cast(float, u << 16); }
__device__ __forceinline__ float bfhi(unsigned u) { return __builtin_bit_cast(float, u & 0xffff0000u); }
typedef float f32x2_t __attribute__((ext_vector_type(2))); typedef __bf16 bf16x2_t __attribute__((ext_vector_type(2)));
__device__ __forceinline__ unsigned pkbf(float lo, float hi) { const f32x2_t v = {lo, hi}; const bf16x2_t b = __builtin_convertvector(v, bf16x2_t); return __builtin_bit_cast(unsigned, b); }
__device__ __forceinline__ float wave_sum(float v) { return add_xor32(add_xor16(row16_sum(v))); }
__device__ __forceinline__ float wave_max(float v) {
#pragma unroll
    for (int o = 1; o < 64; o <<= 1) v = fmaxf(v, __shfl_xor(v, o));
    return v;
}

struct Args { const float* in[20]; float* out; unsigned char* ws; int ph_lo, ph_hi, li, pad; };
enum { I_X = 0, I_MEM, I_MEMNW, I_WMKV, I_MEMKNW, I_NORM1, I_DNWIN, I_DNCONV, I_DNALOG, I_DNDT, I_DNONW, I_FOXWIN, I_FOXFB, I_FOXQNW, I_FOXKNW, I_MEMQNW, I_WOUT, I_NORM2, I_WM1, I_WM2 };

struct Frame {
    LAS unsigned char* lds;
    int G, bid, wv;
    const float* const* in; float* out; unsigned char* ws;
};


constexpr int CW_XCC = 32768, CW_BAD = 33792, CW_GRP = 65536;
struct GrpBar { unsigned* cnt; unsigned* tmo; int wv; bool on; };
__device__ __forceinline__ void grp_barrier(const GrpBar& gb, int seam) {
    asm volatile("s_waitcnt vmcnt(0)" ::: "memory");
    __syncthreads();
    if (gb.wv == 0 && lane_id_v() == 0) { unsigned* p = gb.cnt + seam * 64;
        (void)__hip_atomic_fetch_add(p, 1u, __ATOMIC_RELAXED, __HIP_MEMORY_SCOPE_AGENT);
        unsigned sp = 0;
        while (__hip_atomic_load(p, __ATOMIC_RELAXED, __HIP_MEMORY_SCOPE_AGENT) < 4u) { __builtin_amdgcn_s_sleep(1); if (++sp > (1u << 22)) { atomicAdd(gb.tmo, 1u); break; } }
        __builtin_amdgcn_fence(__ATOMIC_ACQUIRE, "agent");
        asm volatile("s_waitcnt vmcnt(0)" ::: "memory"); }
    __syncthreads();
}
struct Tix { int tid, lane, wave; };
__device__ __forceinline__ int lane_id() { return lane_id_v(); }
__device__ __forceinline__ Tix tix(int wv) { Tix t; t.lane = lane_id(); t.wave = wv; t.tid = wv * 64 + t.lane; return t; }
struct TSeg { const float* W; int K, ldw, src0, ncols; bf16* WT; int dst0; const float* scale; };
__device__ __forceinline__ TSeg get_seg(const Frame& F, int s) {
    TSeg t; t.scale = nullptr; t.src0 = 0; t.dst0 = 0;
    if (s < 12) {
        const int l = s / 6, j = s % 6;
        t.W = l ? F.in[I_FOXWIN] : F.in[I_DNWIN]; t.K = DM; t.ldw = l ? FOX_IN : DN_IN; t.WT = (bf16*)(F.ws + (l ? WS_WIN1 : WS_WIN0)); t.scale = F.in[I_NORM1] + l * DM;
        const int qm0 = l ? 4104 : 4112, nsc = l ? 8 : 16;
        t.ncols = 1024;
        if (j == 0) { t.src0 = 1024; t.dst0 = PC_K; } else if (j == 1) { t.src0 = 2048; t.dst0 = PC_V; } else if (j == 2) { t.src0 = 3072; t.dst0 = PC_Z; }
        else if (j == 3) { t.src0 = 0; t.dst0 = PC_Q; } else if (j == 4) { t.src0 = qm0; t.dst0 = PC_QM; t.ncols = 512; } else { t.src0 = 4096; t.dst0 = PC_AB; t.ncols = nsc; }
    } else if (s < 14) { const int l = s - 12; t.W = F.in[I_WOUT] + (size_t)l * OUT_IN * DM; t.K = OUT_IN; t.ldw = DM; t.ncols = DM; t.WT = (bf16*)(F.ws + (l ? WS_WOUT1 : WS_WOUT0)); }
    else if (s < 16) { const int l = s - 14; t.W = F.in[I_WM1] + (size_t)l * DM * FF; t.K = DM; t.ldw = FF; t.ncols = FF; t.WT = (bf16*)(F.ws + (l ? WS_WM1_1 : WS_WM1_0)); t.scale = F.in[I_NORM2] + l * DM; }
    else if (s < 18) { const int l = s - 16; t.W = F.in[I_WM2] + (size_t)l * FF * DM; t.K = FF; t.ldw = DM; t.ncols = DM; t.WT = (bf16*)(F.ws + (l ? WS_WM2_1 : WS_WM2_0)); }
    else { t.W = F.in[I_WMKV]; t.K = DM; t.ldw = DM; t.ncols = DM; t.WT = (bf16*)(F.ws + WS_WMKV); t.scale = F.in[I_MEMNW]; }
    return t;
}
__device__ __forceinline__ int seg_items(const TSeg& t) { return (t.K / 64) * ((t.ncols + 63) / 64); }
__device__ __forceinline__ void tr_load(const TSeg& t, int item, int lane, f32x4 (&v)[16]) {
    const int nblk = (t.ncols + 63) / 64, kb = item / nblk, nb = item - kb * nblk, k0 = 64 * kb, n0 = 64 * nb;
    const int n4 = (lane & 15) * 4, kr = lane >> 4; const bool ok = (n0 + n4) < t.ncols;
    const float* p = t.W + (size_t)(k0 + kr) * t.ldw + t.src0 + n0 + n4;
#pragma unroll
    for (int i = 0; i < 16; ++i) v[i] = ok ? *(const f32x4*)(p + (size_t)(4 * i) * t.ldw) : (f32x4){0.f, 0.f, 0.f, 0.f};
}
__device__ __forceinline__ void tr_store(const TSeg& t, int item, int lane, const f32x4 (&v)[16], LAS float* scr) {
    const int nblk = (t.ncols + 63) / 64, kb = item / nblk, nb = item - kb * nblk, k0 = 64 * kb, n0 = 64 * nb;
    const int n4 = (lane & 15) * 4, kr = lane >> 4;
#pragma unroll
    for (int i = 0; i < 16; ++i) *(LAS f32x4*)(scr + (4 * i + kr) * 68 + n4) = v[i];
    LDS_WAIT(); asm volatile("" ::: "memory");
    const int c = lane & 7; f32x4 s0 = {1.f, 1.f, 1.f, 1.f}, s1 = s0;
    if (t.scale) { s0 = *(const f32x4*)(t.scale + k0 + 8 * c); s1 = *(const f32x4*)(t.scale + k0 + 8 * c + 4); }
#pragma unroll
    for (int j = 0; j < 8; ++j) { const int n = (lane >> 3) + 8 * j; const LAS float* q = scr + (8 * c) * 68 + n;
        v4u o; o.x = pkbf(q[0 * 68] * s0[0], q[1 * 68] * s0[1]); o.y = pkbf(q[2 * 68] * s0[2], q[3 * 68] * s0[3]); o.z = pkbf(q[4 * 68] * s1[0], q[5 * 68] * s1[1]); o.w = pkbf(q[6 * 68] * s1[2], q[7 * 68] * s1[3]);
        if (n0 + n < t.ncols) *(v4u*)(t.WT + (size_t)(t.dst0 + n0 + n) * t.K + k0 + 8 * c) = o; }
    LDS_WAIT(); asm volatile("" ::: "memory");
}
template <int NR> __device__ __forceinline__ void rows_to_bf16(int lane, const float* x, bf16* o, float* sq) {
    f32x4 v[NR][4];
#pragma unroll
    for (int r = 0; r < NR; ++r)
#pragma unroll
        for (int j = 0; j < 4; ++j) v[r][j] = ((const f32x4*)(x + (size_t)r * DM))[lane + 64 * j];
#pragma unroll
    for (int r = 0; r < NR; ++r) { float s = 0.f;
#pragma unroll
        for (int j = 0; j < 4; ++j) s += (v[r][j].x * v[r][j].x + v[r][j].y * v[r][j].y) + (v[r][j].z * v[r][j].z + v[r][j].w * v[r][j].w);
        s = wave_sum(s);
        unsigned long long* o8 = (unsigned long long*)(o + (size_t)r * DM) + lane;
#pragma unroll
        for (int j = 0; j < 4; ++j) o8[64 * j] = (unsigned long long)pkbf(v[r][j].x, v[r][j].y) | ((unsigned long long)pkbf(v[r][j].z, v[r][j].w) << 32);
        if (lane < 16) sq[(size_t)r * 16 + lane] = lane == 0 ? s : 0.f; }
}
template <int S0, int S1> __device__ __forceinline__ void convert_weights(const Frame& F, LAS float* scr, int lane, int gw, int NGW, int base) {
#pragma unroll
    for (int s = S0; s < S1; ++s) {
        const TSeg t = get_seg(F, s); const int n = seg_items(t);
        int it = gw - (base % NGW); if (it < 0) it += NGW;
        for (; it < n; it += NGW) { f32x4 v[16]; tr_load(t, it, lane, v); tr_store(t, it, lane, v, scr); }
        base += n;
    }
}
__device__ __forceinline__ void p0_prologue(const Frame& F) {
    const Tix T = tix(F.wv);
    LAS float* scr = (LAS float*)(F.lds + T.wave * 17408);
    const int gw = F.bid * NWAVES + T.wave, NGW = F.G * NWAVES;
    for (int m = gw * 4; m < MROWS; m += NGW * 4) rows_to_bf16<4>(T.lane, F.in[I_X] + (size_t)m * DM, (bf16*)(F.ws + WS_XB) + (size_t)m * DM, (float*)(F.ws + WS_XSQ) + (size_t)m * 16);
    for (int m = gw; m < MMEM; m += NGW) rows_to_bf16<1>(T.lane, F.in[I_MEM] + (size_t)m * DM, (bf16*)((unsigned char*)F.out + DO_MEMB) + (size_t)m * DM, (float*)(F.ws + WS_MSQ) + (size_t)m * 16);
    convert_weights<0, 6>(F, scr, T.lane, gw, NGW, 0);
    convert_weights<18, 19>(F, scr, T.lane, gw, NGW, 1168);
}

typedef short dn_bf16x8 __attribute__((ext_vector_type(8)));
typedef unsigned dn_u32x2 __attribute__((ext_vector_type(2)));
__device__ __forceinline__ f32x4 mfma16(dn_bf16x8 a, dn_bf16x8 b, f32x4 c) { return __builtin_amdgcn_mfma_f32_16x16x32_bf16(a, b, c, 0, 0, 0); }
__device__ __forceinline__ f32x4 mfma4(float a, float b, f32x4 c) { return __builtin_amdgcn_mfma_f32_16x16x4f32(a, b, c, 0, 0, 0); }
__device__ __forceinline__ dn_bf16x8 pack8f(f32x4 x, f32x4 y) { v4u w; w.x = pkbf(x[0], x[1]); w.y = pkbf(x[2], x[3]); w.z = pkbf(y[0], y[1]); w.w = pkbf(y[2], y[3]); return __builtin_bit_cast(dn_bf16x8, w); }
__device__ __forceinline__ dn_u32x2 pack4f(f32x4 x) { dn_u32x2 w; w.x = pkbf(x[0], x[1]); w.y = pkbf(x[2], x[3]); return w; }
__device__ __forceinline__ unsigned short bf1(float x) { return (unsigned short)(pkbf(x, 0.f) & 0xffffu); }
constexpr size_t DO_QKS = 4 * MiB, DO_HALO = 20 * MiB, DO_EGL = 27 * MiB;
constexpr int P_RAW = 0, P_GB = 51712, P_QH = 53248, P_KH = 70656, P_VBT = 88064, P_KBGT = 106496, P_QKL = 124928, P_END = 134144;
constexpr int P_AT = 0, P_TB = 17408, P_PS = 26624, P_PS2 = 29184;
struct DnPre { v4u P[7]; v4u Z[2]; float ga, gb; f32x4 cw[3][4]; };
__device__ __forceinline__ void dn_prep_load(const Frame& F, int u, DnPre& R) {
    const Tix T = tix(F.wv); const int tid = T.tid, lane = T.lane;
    const int bh = u >> 5, c = u & 31, b = bh >> 3, h = bh & 7; const size_t row0 = (size_t)b * SEQ + c * 64; const int gch = b * 32 + c;
    const bf16* proj = (const bf16*)(F.ws + WS_PROJ); const float* AB = (const float*)(F.ws + WS_AB); const bf16* halo = (const bf16*)((unsigned char*)F.out + DO_HALO);
#pragma unroll
    for (int j = 0; j < 7; ++j) { const int id = tid + 512 * j; v4u val = {0u, 0u, 0u, 0u};
        if (id < 67 * 48) { const int r = id / 48, rem = id - r * 48, seg = rem >> 4, ch = rem & 15;
            const int col = (seg == 0 ? PC_Q : seg == 1 ? PC_K : PC_V) + h * HD + ch * 8;
            if (r >= 3) val = *(const v4u*)(proj + (row0 + r - 3) * PW + col);
            else if (c > 0) val = *(const v4u*)(halo + ((size_t)(gch - 1) * 3 + r) * PW + col); }
        R.P[j] = val; }
    R.ga = AB[(row0 + lane) * 16 + h]; R.gb = AB[(row0 + lane) * 16 + 8 + h];
    { const bf16* zp = proj + (row0 + (tid >> 3)) * PW + PC_Z + h * HD + (tid & 7) * 16; R.Z[0] = *(const v4u*)zp; R.Z[1] = *(const v4u*)(zp + 8); }
    const float* convw = F.in[I_DNCONV]; const int c4 = lane & 31;
#pragma unroll
    for (int seg = 0; seg < 3; ++seg)
#pragma unroll
        for (int j = 0; j < 4; ++j) R.cw[seg][j] = *(const f32x4*)(convw + j * 3072 + seg * 1024 + h * HD + 4 * c4);
}
__device__ __forceinline__ void dn_prep_unit(const Frame& F, int u, int u_next, DnPre& R) {
    const Tix T = tix(F.wv); const int tid = T.tid, lane = T.lane, wave = T.wave, m = lane & 15, g = lane >> 4;
    const int bh = u >> 5, c = u & 31, b = bh >> 3, h = bh & 7; const size_t row0 = (size_t)b * SEQ + c * 64;
    bf16* proj = (bf16*)(F.ws + WS_PROJ);
    bf16* xbimg = (bf16*)(F.ws + WS_XB) + (size_t)u * 8192; bf16* qks = (bf16*)((unsigned char*)F.out + DO_QKS) + (size_t)u * 4096; float* egl = (float*)((unsigned char*)F.out + DO_EGL);
    LAS unsigned char* L = F.lds; LAS float* GB = (LAS float*)(L + P_GB);
#pragma unroll
    for (int j = 0; j < 7; ++j) { const int id = tid + 512 * j;
        if (id < 67 * 48) { const int r = id / 48, rem = id - r * 48, seg = rem >> 4, ch = rem & 15; *(LAS v4u*)(L + P_RAW + r * 768 + seg * 256 + ch * 16) = R.P[j]; } }
    if (wave == 0) { const float a = R.ga, bb = R.gb;
        const float x = a + F.in[I_DNDT][h], sp = fmaxf(x, 0.f) + log1pf(__expf(-fabsf(x)));
        const float gt = -__expf(F.in[I_DNALOG][h]) * sp, beta = __builtin_amdgcn_rcpf(1.f + __expf(-bb));
        float gc = gt;
#pragma unroll
        for (int o = 1; o < 64; o <<= 1) { const float t = __shfl_up(gc, o); if (lane >= o) gc += t; }
        const float gl = __shfl(gc, 63);
        GB[lane] = gc; GB[64 + lane] = beta; GB[128 + lane] = beta * __expf(gc); GB[192 + lane] = __expf(gl - gc); GB[256 + lane] = __expf(gc);
        if (lane == 0) egl[u] = __expf(gl); }
    f32x4 cw[3][4];
#pragma unroll
    for (int seg = 0; seg < 3; ++seg)
#pragma unroll
        for (int j = 0; j < 4; ++j) cw[seg][j] = R.cw[seg][j];
    { const float* onw = F.in[I_DNONW] + (tid & 7) * 16; const unsigned zz[8] = {R.Z[0].x, R.Z[0].y, R.Z[0].z, R.Z[0].w, R.Z[1].x, R.Z[1].y, R.Z[1].z, R.Z[1].w}; unsigned ow[8];
#pragma unroll
      for (int q = 0; q < 8; ++q) { const float za = bflo(zz[q]), zb = bfhi(zz[q]);
          ow[q] = pkbf(za * __builtin_amdgcn_rcpf(1.f + __expf(-za)) * onw[2 * q], zb * __builtin_amdgcn_rcpf(1.f + __expf(-zb)) * onw[2 * q + 1]); }
      bf16* zp = proj + (row0 + (tid >> 3)) * PW + PC_Z + h * HD + (tid & 7) * 16;
      *(v4u*)zp = (v4u){ow[0], ow[1], ow[2], ow[3]}; *(v4u*)(zp + 8) = (v4u){ow[4], ow[5], ow[6], ow[7]}; }
    __syncthreads();
    if (u_next >= 0) dn_prep_load(F, u_next, R);
    { const int hf = lane >> 5, c4 = lane & 31;
#pragma unroll
      for (int jj = 0; jj < 12; ++jj) { constexpr int dummy_ = 0; (void)dummy_; const int seg = jj >> 2;
        const int wi = wave + 8 * jj, i = 2 * (wi & 31) + hf;
        f32x4 y = {0.f, 0.f, 0.f, 0.f};
#pragma unroll
        for (int j = 0; j < 4; ++j) { const f32x4 w = cw[seg][j];
            const dn_u32x2 xx = *(const LAS dn_u32x2*)(L + P_RAW + (i + j) * 768 + seg * 256 + c4 * 8);
            y[0] += w[0] * bflo(xx.x); y[1] += w[1] * bfhi(xx.x); y[2] += w[2] * bflo(xx.y); y[3] += w[3] * bfhi(xx.y); }
        f32x4 s;
#pragma unroll
        for (int e = 0; e < 4; ++e) s[e] = y[e] * __builtin_amdgcn_rcpf(1.f + __expf(-y[e]));
        if (seg < 2) { float ss = (s[0] * s[0] + s[1] * s[1]) + (s[2] * s[2] + s[3] * s[3]);
            ss = add_xor16(row16_sum(ss));
            const float r = rsqrtf(ss + EPS) * (seg == 0 ? QSCALE : 1.f);
            s = s * r;
            *(LAS dn_u32x2*)(L + (seg == 0 ? P_QH : P_KH) + i * 272 + c4 * 8) = pack4f(s);
            if (seg == 0) { const int cc = c4 & 7, p0 = cc < 4 ? 8 * cc : 8 * (cc - 4) + 4;
                *(dn_u32x2*)(proj + (row0 + i) * PW + PC_Q + h * HD + 32 * (c4 >> 3) + p0) = pack4f(s * GB[256 + i]); }
            else { const float bge = GB[128 + i];
#pragma unroll
                for (int e = 0; e < 4; ++e) *(LAS unsigned short*)(L + P_KBGT + (4 * c4 + e) * 144 + i * 2) = bf1(s[e] * bge); } }
        else { const float be = GB[64 + i];
#pragma unroll
            for (int e = 0; e < 4; ++e) *(LAS unsigned short*)(L + P_VBT + (4 * c4 + e) * 144 + i * 2) = bf1(s[e] * be); } } }
    __syncthreads();
    LAS float* AT = (LAS float*)(L + P_AT);
#pragma unroll
    for (int q = 0; q < 2; ++q) { const int tt = wave + 8 * q, it = tt >> 2, jt = tt & 3;
        f32x4 kk = {0.f, 0.f, 0.f, 0.f}, qk = {0.f, 0.f, 0.f, 0.f};
        if (jt <= it) {
#pragma unroll
            for (int kq = 0; kq < 4; ++kq) { const dn_bf16x8 bk = *(const LAS dn_bf16x8*)(L + P_KH + (16 * jt + m) * 272 + (32 * kq + 8 * g) * 2);
                const dn_bf16x8 ak = *(const LAS dn_bf16x8*)(L + P_KH + (16 * it + m) * 272 + (32 * kq + 8 * g) * 2), aq = *(const LAS dn_bf16x8*)(L + P_QH + (16 * it + m) * 272 + (32 * kq + 8 * g) * 2);
                kk = mfma16(ak, bk, kk); qk = mfma16(aq, bk, qk); } }
        const int j = 16 * jt + m, jl = j & 31, p = jl < 16 ? 8 * (jl >> 2) + (jl & 3) : 8 * ((jl - 16) >> 2) + 4 + (jl & 3);
        const float gcj = GB[j];
#pragma unroll
        for (int r = 0; r < 4; ++r) { const int i = 16 * it + 4 * g + r; const float dec = i >= j ? __expf(GB[i] - gcj) : 0.f;
            AT[i * 68 + j] = i > j ? GB[64 + i] * kk[r] * dec : 0.f;
            *(LAS unsigned short*)(L + P_QKL + i * 144 + (32 * (j >> 5) + p) * 2) = bf1(qk[r] * dec); } }
    __syncthreads();
    if (wave >= 4) { const int t4 = tid - 256;
        for (int id = t4; id < 1024; id += 256) { const int k = id >> 3, sp = (id >> 2) & 1, gg = id & 3; float o8[8];
#pragma unroll
            for (int j = 0; j < 8; ++j) { const int cc = 32 * sp + (j < 4 ? 4 * gg + j : 16 + 4 * gg + j - 4);
                o8[j] = bflo((unsigned)*(const LAS unsigned short*)(L + P_KH + cc * 272 + k * 2)) * GB[192 + cc]; }
            v4u w; w.x = pkbf(o8[0], o8[1]); w.y = pkbf(o8[2], o8[3]); w.z = pkbf(o8[4], o8[5]); w.w = pkbf(o8[6], o8[7]);
            *(v4u*)(proj + (row0 + (k >> 1)) * PW + PC_K + h * HD + (k & 1) * 64 + 32 * sp + 8 * gg) = w; }
        for (int id = t4; id < 512; id += 256) { const int i = id >> 3, j8 = (id & 7) * 8;
            *(v4u*)(qks + i * 64 + j8) = *(const LAS v4u*)(L + P_QKL + i * 144 + j8 * 2); } }
    if (wave == 0) { const int bb = g, j = m; float X[16];
        X[0] = j == 0 ? 1.f : 0.f;
#pragma unroll
        for (int i = 1; i < 16; ++i) { const LAS float* Lr = AT + (16 * bb + i) * 68 + 16 * bb; float Lv[16];
#pragma unroll
            for (int q = 0; q < (i + 3) / 4; ++q) { const f32x4 t = *(const LAS f32x4*)(Lr + 4 * q); Lv[4 * q] = t[0]; Lv[4 * q + 1] = t[1]; Lv[4 * q + 2] = t[2]; Lv[4 * q + 3] = t[3]; }
            float acc = i == j ? 1.f : 0.f;
#pragma unroll
            for (int mm = 0; mm < i; ++mm) acc -= Lv[mm] * X[mm];
            X[i] = acc; }
#pragma unroll
        for (int i = 0; i < 16; ++i) AT[(16 * bb + i) * 68 + 16 * bb + j] = X[i]; }
    __syncthreads();
    if (wave < 2) { const int lo = 2 * wave, hi = 2 * wave + 1; LAS float* PS = (LAS float*)(L + P_PS) + wave * 320;
        f32x4 acc = {0.f, 0.f, 0.f, 0.f};
#pragma unroll
        for (int s = 0; s < 4; ++s) acc = mfma4(AT[(16 * hi + m) * 68 + 16 * lo + 4 * s + g], AT[(16 * lo + 4 * s + g) * 68 + 16 * lo + m], acc);
#pragma unroll
        for (int r = 0; r < 4; ++r) PS[(4 * g + r) * 20 + m] = acc[r];
        LDS_WAIT();
        f32x4 acc2 = {0.f, 0.f, 0.f, 0.f};
#pragma unroll
        for (int s = 0; s < 4; ++s) acc2 = mfma4(AT[(16 * hi + m) * 68 + 16 * hi + 4 * s + g], PS[(4 * s + g) * 20 + m], acc2);
#pragma unroll
        for (int r = 0; r < 4; ++r) AT[(16 * hi + 4 * g + r) * 68 + 16 * lo + m] = -acc2[r]; }
    __syncthreads();
    { LAS float* PS2 = (LAS float*)(L + P_PS2); const int ti = (wave >> 1) & 1, tj = wave & 1;
      if (wave < 4) { f32x4 acc = {0.f, 0.f, 0.f, 0.f};
#pragma unroll
          for (int s = 0; s < 8; ++s) acc = mfma4(AT[(32 + 16 * ti + m) * 68 + 4 * s + g], AT[(4 * s + g) * 68 + 16 * tj + m], acc);
#pragma unroll
          for (int r = 0; r < 4; ++r) PS2[(16 * ti + 4 * g + r) * 36 + 16 * tj + m] = acc[r]; }
      __syncthreads();
      if (wave < 4) { f32x4 acc = {0.f, 0.f, 0.f, 0.f};
#pragma unroll
          for (int s = 0; s < 8; ++s) acc = mfma4(AT[(32 + 16 * ti + m) * 68 + 32 + 4 * s + g], PS2[(4 * s + g) * 36 + 16 * tj + m], acc);
#pragma unroll
          for (int r = 0; r < 4; ++r) AT[(32 + 16 * ti + 4 * g + r) * 68 + 16 * tj + m] = -acc[r]; } }
    __syncthreads();
    { const int i = tid >> 3, j0 = (tid & 7) * 8; const f32x4 t0 = *(const LAS f32x4*)(AT + i * 68 + j0), t1 = *(const LAS f32x4*)(AT + i * 68 + j0 + 4);
      v4u w; w.x = pkbf(t0[0], t0[1]); w.y = pkbf(t0[2], t0[3]); w.z = pkbf(t1[0], t1[1]); w.w = pkbf(t1[2], t1[3]);
      *(LAS v4u*)(L + P_TB + i * 144 + j0 * 2) = w; }
    __syncthreads();
#pragma unroll
    for (int q = 0; q < 8; ++q) { const int tt = wave + 8 * q; f32x4 acc = {0.f, 0.f, 0.f, 0.f};
        if (tt < 32) { const int ct = tt >> 3, nt = tt & 7;
#pragma unroll
            for (int sp = 0; sp < 2; ++sp) acc = mfma16(*(const LAS dn_bf16x8*)(L + P_TB + (16 * ct + m) * 144 + (32 * sp + 8 * g) * 2), *(const LAS dn_bf16x8*)(L + P_VBT + (16 * nt + m) * 144 + (32 * sp + 8 * g) * 2), acc);
            const int v = 16 * nt + m;
            *(dn_u32x2*)(proj + (row0 + (v >> 1)) * PW + PC_V + h * HD + (v & 1) * 64 + 16 * ct + 4 * g) = pack4f(acc); }
        else { const int t2 = tt - 32, kt = t2 >> 2, ct = t2 & 3;
#pragma unroll
            for (int sp = 0; sp < 2; ++sp) acc = mfma16(*(const LAS dn_bf16x8*)(L + P_KBGT + (16 * kt + m) * 144 + (32 * sp + 8 * g) * 2), *(const LAS dn_bf16x8*)(L + P_TB + (16 * ct + m) * 144 + (32 * sp + 8 * g) * 2), acc);
            *(dn_u32x2*)(xbimg + (16 * ct + m) * 128 + 32 * (kt >> 1) + 8 * g + 4 * (kt & 1)) = pack4f(-acc); } }
    __syncthreads();
}
constexpr int S_WN = 0, S_QG = 17408, S_KDT = 34816, S_QKM = 53248, S_UT = 62464, S_OB = 80896, S_PSQ = 114688, S_ONW = 116736, S_Z = 117248, S_END = 152064;
static_assert(S_END <= MISC_OFF, "scan LDS map");
__device__ __forceinline__ void dn_scan_unit(const Frame& F, int bh) {
    const Tix T = tix(F.wv); const int tid = T.tid, lane = T.lane, wave = T.wave, m = lane & 15, g = lane >> 4, n0 = 32 * wave;
    const int b = bh >> 3, h = bh & 7;
    bf16* proj = (bf16*)(F.ws + WS_PROJ); const bf16* xbi = (const bf16*)(F.ws + WS_XB); const bf16* qks = (const bf16*)((unsigned char*)F.out + DO_QKS); const float* egl = (const float*)((unsigned char*)F.out + DO_EGL);
    LAS unsigned char* L = F.lds;
    LAS float* OB = (LAS float*)(L + S_OB);
    constexpr int NC = SEQ / 64;
#define WGBAR() do { asm volatile("s_waitcnt lgkmcnt(0)" ::: "memory"); __builtin_amdgcn_s_barrier(); asm volatile("" ::: "memory"); } while (0)
    if (wave >= 4) {
        const int ht = tid - 256;
        const unsigned lo_lin = (unsigned)ht * 16u;
        const unsigned lo_qg = (unsigned)(((ht >> 4) * PW + (ht & 15) * 8) * 2);
        const unsigned lo_kv = (unsigned)(((ht >> 4) * PW + ((ht >> 3) & 1) * 64 + (ht & 7) * 8) * 2);
        const unsigned ld_a = (unsigned)((ht >> 4) * 272 + (ht & 15) * 16), ld_b = (unsigned)((ht >> 3) * 144 + (ht & 7) * 16);
        const unsigned lo_fin = (unsigned)(((ht >> 2) * PW + (ht & 3) * 32) * 2);
        v4u RP[12], RQ[10];
#define DN_LOAD_P(cc) do { const size_t r0_ = (size_t)b * SEQ + (cc) * 64; const size_t u_ = (size_t)bh * 32 + (cc);               \
        _Pragma("unroll") for (int j_ = 0; j_ < 4; ++j_) {                                                                                                \
            RP[j_] = *(const v4u*)((const char*)(xbi + u_ * 8192 + 2048 * j_) + lo_lin);                                                                    \
            RP[4 + j_] = *(const v4u*)((const char*)(proj + (r0_ + 16 * j_) * PW + PC_Q + h * HD) + lo_qg);                                                 \
            RP[8 + j_] = *(const v4u*)((const char*)(proj + (r0_ + 16 * j_) * PW + PC_V + h * HD) + lo_kv); } } while (0)
#define DN_LOAD_Q(cc) do { const size_t r0_ = (size_t)b * SEQ + (cc) * 64; const size_t u_ = (size_t)bh * 32 + (cc);     \
        _Pragma("unroll") for (int j_ = 0; j_ < 4; ++j_) {                                                                                                \
            RQ[j_] = *(const v4u*)((const char*)(proj + (r0_ + 16 * j_) * PW + PC_K + h * HD) + lo_kv);                                                     \
            RQ[4 + j_] = *(const v4u*)((const char*)(proj + (r0_ + 16 * j_) * PW + PC_Z + h * HD) + lo_qg); }                                               \
        _Pragma("unroll") for (int j_ = 0; j_ < 2; ++j_) RQ[8 + j_] = *(const v4u*)((const char*)(qks + u_ * 4096 + 2048 * j_) + lo_lin); } while (0)
#define DN_WRITE_P() do { _Pragma("unroll") for (int j_ = 0; j_ < 4; ++j_) {                                                                               \
            *(LAS v4u*)(L + S_WN + ld_a + j_ * 4352) = RP[j_]; *(LAS v4u*)(L + S_QG + ld_a + j_ * 4352) = RP[4 + j_]; *(LAS v4u*)(L + S_UT + ld_b + j_ * 4608) = RP[8 + j_]; } } while (0)
#define DN_WRITE_Q(cc) do { _Pragma("unroll") for (int j_ = 0; j_ < 4; ++j_) { *(LAS v4u*)(L + S_KDT + ld_b + j_ * 4608) = RQ[j_];                         \
            *(LAS v4u*)(L + S_Z + ((cc) & 1) * 17408 + ld_a + j_ * 4352) = RQ[4 + j_]; }                                                                    \
        _Pragma("unroll") for (int j_ = 0; j_ < 2; ++j_) *(LAS v4u*)(L + S_QKM + ld_b + j_ * 4608) = RQ[8 + j_]; } while (0)
#define DN_FINAL(cc) do { const int fr_ = ht >> 2, fc_ = (ht & 3) * 32; float ss_ = 0.f;     \
        _Pragma("unroll") for (int p_ = 0; p_ < 8; ++p_) { const f32x4 o_ = *(const LAS f32x4*)(OB + fr_ * 132 + fc_ + 4 * p_);                              \
            ss_ += (o_[0] * o_[0] + o_[1] * o_[1]) + (o_[2] * o_[2] + o_[3] * o_[3]); }                                                                     \
        ss_ += dppf<0xB1>(ss_); ss_ += dppf<0x4E>(ss_);                                                                                                     \
        const float rn_ = rsqrtf(ss_ * (1.f / 128.f) + EPS);                                                                                               \
        bf16* dst_ = (bf16*)((char*)(proj + ((size_t)b * SEQ + (cc) * 64) * PW + PC_Q + h * HD) + lo_fin);              \
        _Pragma("unroll") for (int p_ = 0; p_ < 4; ++p_) {                                                                                                 \
            const f32x4 oa_ = *(const LAS f32x4*)(OB + fr_ * 132 + fc_ + 8 * p_), ob_ = *(const LAS f32x4*)(OB + fr_ * 132 + fc_ + 8 * p_ + 4);             \
            const v4u z_ = *(const LAS v4u*)(L + S_Z + ((cc) & 1) * 17408 + fr_ * 272 + (fc_ + 8 * p_) * 2);                                                \
            v4u w_; w_.x = pkbf(oa_[0] * rn_ * bflo(z_.x), oa_[1] * rn_ * bfhi(z_.x)); w_.y = pkbf(oa_[2] * rn_ * bflo(z_.y), oa_[3] * rn_ * bfhi(z_.y));   \
            w_.z = pkbf(ob_[0] * rn_ * bflo(z_.z), ob_[1] * rn_ * bfhi(z_.z)); w_.w = pkbf(ob_[2] * rn_ * bflo(z_.w), ob_[3] * rn_ * bfhi(z_.w));           \
            *(v4u*)(dst_ + 8 * p_) = w_; } } while (0)
        DN_LOAD_P(0); DN_LOAD_Q(0); DN_WRITE_P(); DN_WRITE_Q(0); DN_LOAD_P(1); DN_LOAD_Q(1);
        WGBAR();
        for (int c = 0; c < NC; ++c) {
            if (c > 0) { DN_FINAL(c - 1); DN_WRITE_Q(c); if (c + 1 < NC) DN_LOAD_Q(c + 1); }
            WGBAR();
            if (c + 1 < NC) { DN_WRITE_P(); if (c + 2 < NC) DN_LOAD_P(c + 2); }
            WGBAR();
        }
        DN_FINAL(NC - 1);
#undef DN_LOAD_P
#undef DN_LOAD_Q
#undef DN_WRITE_P
#undef DN_WRITE_Q
#undef DN_FINAL
    } else {
        f32x4 Sacc[2][8];
#pragma unroll
        for (int kt = 0; kt < 8; ++kt) { Sacc[0][kt] = (f32x4){0.f, 0.f, 0.f, 0.f}; Sacc[1][kt] = (f32x4){0.f, 0.f, 0.f, 0.f}; }
        const unsigned* eglu = (const unsigned*)egl + (size_t)bh * 32;
        float eg_next = __uint_as_float(__hip_atomic_load(eglu, __ATOMIC_RELAXED, __HIP_MEMORY_SCOPE_AGENT));
        const LAS unsigned char* fa = L + m * 272 + g * 16;
        const LAS unsigned char* fb = L + m * 144 + g * 16;
#define SBAR() __builtin_amdgcn_sched_barrier(0)
#define LD_A(X, base, ct) do { _Pragma("unroll") for (int s_ = 0; s_ < 4; ++s_) X[s_] = *(const LAS dn_bf16x8*)(fa + (base) + (ct) * 4352 + s_ * 64); } while (0)
#define LD_B(X, base, i0) do { _Pragma("unroll") for (int s_ = 0; s_ < 4; ++s_) X[s_] = *(const LAS dn_bf16x8*)(fb + (base) + ((i0) + (s_ >> 1)) * 2304 + (s_ & 1) * 64); } while (0)
        WGBAR();
        for (int c = 0; c < NC; ++c) {
            const float eg = eg_next;
            if (c + 1 < NC) eg_next = __uint_as_float(__hip_atomic_load(eglu + c + 1, __ATOMIC_RELAXED, __HIP_MEMORY_SCOPE_AGENT));
            dn_bf16x8 SB[2][4], X0[4], X1[4];
            LD_A(X0, S_WN, 0);
#pragma unroll
            for (int sl = 0; sl < 2; ++sl)
#pragma unroll
                for (int s = 0; s < 4; ++s) SB[sl][s] = pack8f(Sacc[sl][2 * s], Sacc[sl][2 * s + 1]);
            f32x4 VN[2][4], O[2][4];
#pragma unroll
            for (int ct = 0; ct < 4; ++ct)
#pragma unroll
                for (int sl = 0; sl < 2; ++sl) { const dn_u32x2 uu = *(const LAS dn_u32x2*)(L + S_UT + (n0 + 16 * sl + m) * 144 + (16 * ct + 4 * g) * 2);
                    VN[sl][ct] = (f32x4){bflo(uu.x), bfhi(uu.x), bflo(uu.y), bfhi(uu.y)}; O[sl][ct] = (f32x4){0.f, 0.f, 0.f, 0.f}; }
#pragma unroll
            for (int ct = 0; ct < 4; ++ct) {
                SBAR(); LD_A(X1, S_QG, ct); SBAR();
#pragma unroll
                for (int s = 0; s < 4; ++s) { VN[0][ct] = mfma16(X0[s], SB[0][s], VN[0][ct]); VN[1][ct] = mfma16(X0[s], SB[1][s], VN[1][ct]); }
                SBAR(); if (ct < 3) LD_A(X0, S_WN, ct + 1); SBAR();
#pragma unroll
                for (int s = 0; s < 4; ++s) { O[0][ct] = mfma16(X1[s], SB[0][s], O[0][ct]); O[1][ct] = mfma16(X1[s], SB[1][s], O[1][ct]); }
            }
            dn_bf16x8 VNB[2][2];
#pragma unroll
            for (int sl = 0; sl < 2; ++sl)
#pragma unroll
                for (int sp = 0; sp < 2; ++sp) VNB[sl][sp] = pack8f(VN[sl][2 * sp], VN[sl][2 * sp + 1]);
            WGBAR();
            SBAR(); LD_B(X0, S_QKM, 0); LD_B(X1, S_QKM, 2); SBAR();
#pragma unroll
            for (int s = 0; s < 4; ++s) { O[0][s >> 1] = mfma16(X0[s], VNB[0][s & 1], O[0][s >> 1]); O[1][s >> 1] = mfma16(X0[s], VNB[1][s & 1], O[1][s >> 1]); }
            SBAR(); LD_B(X0, S_KDT, 0); SBAR();
#pragma unroll
            for (int s = 0; s < 4; ++s) { O[0][2 + (s >> 1)] = mfma16(X1[s], VNB[0][s & 1], O[0][2 + (s >> 1)]); O[1][2 + (s >> 1)] = mfma16(X1[s], VNB[1][s & 1], O[1][2 + (s >> 1)]); }
#pragma unroll
            for (int kt = 0; kt < 8; ++kt) { Sacc[0][kt] = Sacc[0][kt] * eg; Sacc[1][kt] = Sacc[1][kt] * eg; }
#pragma unroll
            for (int q = 0; q < 4; ++q) {
                if (q & 1) { SBAR(); if (q < 3) LD_B(X0, S_KDT, 2 * q + 2); SBAR();
#pragma unroll
                    for (int s = 0; s < 4; ++s) { Sacc[0][2 * q + (s >> 1)] = mfma16(X1[s], VNB[0][s & 1], Sacc[0][2 * q + (s >> 1)]); Sacc[1][2 * q + (s >> 1)] = mfma16(X1[s], VNB[1][s & 1], Sacc[1][2 * q + (s >> 1)]); } }
                else { SBAR(); LD_B(X1, S_KDT, 2 * q + 2); SBAR();
#pragma unroll
                    for (int s = 0; s < 4; ++s) { Sacc[0][2 * q + (s >> 1)] = mfma16(X0[s], VNB[0][s & 1], Sacc[0][2 * q + (s >> 1)]); Sacc[1][2 * q + (s >> 1)] = mfma16(X0[s], VNB[1][s & 1], Sacc[1][2 * q + (s >> 1)]); } }
            }
#pragma unroll
            for (int sl = 0; sl < 2; ++sl)
#pragma unroll
                for (int ct = 0; ct < 4; ++ct)
#pragma unroll
                    for (int r = 0; r < 4; ++r) OB[(16 * ct + 4 * g + r) * 132 + n0 + 16 * sl + m] = O[sl][ct][r];
            WGBAR();
        }
#undef SBAR
#undef LD_A
#undef LD_B
    }
#undef WGBAR
}
__device__ __forceinline__ void fox_blk(const Frame& F, int it, int j, att::Blk& k) {
    const int bh = it >> 2, y = it & 3, qb = j == 0 ? y : 7 - y, b = bh >> 3, h = bh & 7; const size_t row0 = (size_t)b * SEQ + qb * 256;
    bf16* proj = (bf16*)(F.ws + WS_PROJ);
    k.Q = proj + row0 * PW + PC_Q + h * HD; k.K = proj + (size_t)b * SEQ * PW + PC_K + h * HD; k.voff = PC_V - PC_K; k.goff = PC_Z - PC_Q;
    k.flog = (const float*)(F.ws + WS_AB) + (size_t)b * SEQ * 16 + h; k.fb = F.in[I_FOXFB][h]; k.P0 = qb * 256; k.skv = SEQ; k.kvpitch = PW;
}
__device__ __forceinline__ void mem_blk(const Frame& F, int idx, att::Blk& k) {
    const int b = idx >> 5, hm = (idx >> 3) & 3, qb = idx & 7; const size_t row0 = (size_t)b * SEQ + qb * 256;
    bf16* proj = (bf16*)(F.ws + WS_PROJ); const bf16* mkv = (const bf16*)(F.ws + WS_MEMKV);
    static_assert(att::QP == PW, "attention Q pitch");
    k.Q = proj + row0 * PW + PC_QM + hm * HD; k.K = mkv + (size_t)b * NMEM * DM + hm * HD; k.voff = 512; k.goff = 0;
    k.flog = nullptr; k.fb = 0.f; k.P0 = 1 << 20; k.skv = NMEM; k.kvpitch = DM;
}
struct SrcL1 { const Frame* F; int vcu;
    __device__ __forceinline__ bool operator()(int n, att::Blk& k) const { const int it = vcu + (n / 3) * F->G, j = n % 3; if (it >= 256) return false;
        if (j < 2) fox_blk(*F, it, j, k); else mem_blk(*F, it, k); return true; } };
struct SrcL0 { const Frame* F; int first, stride;
    __device__ __forceinline__ bool operator()(int n, att::Blk& k) const { const int idx = first + n * stride; if (idx >= 256) return false; mem_blk(*F, idx, k); return true; } };
#define IN(k) (lo <= (k) && (k) < hi)
#define SEAM(k) do { if (IN(k) && IN((k) + 1)) xcd_barrier(bar); } while (0)
#define SEAMG(k, s_) do { if (IN(k) && IN((k) + 1)) { if (gb.on) grp_barrier(gb, (s_)); else xcd_barrier(bar); } } while (0)
template <int layer> __device__ __forceinline__ void layer_body(const Frame& F, const XcdBarrier& bar, GrpBar& gb, bool grp_try, int lo, int hi, unsigned char* lds) {
    bf16* proj = (bf16*)(F.ws + WS_PROJ); bf16* xb = (bf16*)(F.ws + WS_XB); float* xsq = (float*)(F.ws + WS_XSQ);
    float* ab = (float*)(F.ws + WS_AB);

        const int pb = 1 + (layer ? 6 : 0);
        if (IN(pb)) {
            pg8::Gemm g{xb, (const bf16*)(F.ws + (layer ? WS_WIN1 : WS_WIN0)), MROWS, N_IN, DM, DM}; pg8::StaticOrder S; S.init(MROWS, N_IN, F.G, F.bid);
            const float* nk = layer ? F.in[I_FOXKNW] : nullptr; const float* nq = layer ? F.in[I_FOXQNW] : nullptr;
            pg8::EpiProj<true, false, layer == 0> E{proj, PW, xsq, ab, 18, (bf16*)((unsigned char*)F.out + DO_HALO), 0, layer ? 4 : 0, nk, 12, layer ? 16 : 12, nq, 16, 18, F.in[I_MEMQNW] + layer * HD};
            pg8::gemm_phase<pg8::EpiProj<true, false, layer == 0>, pg8::StaticOrder, true, true>(F.lds, g, S, E, F.wv);
            if (layer == 0) {
                pg8::Gemm g2{(const bf16*)((unsigned char*)F.out + DO_MEMB), (const bf16*)(F.ws + WS_WMKV), MMEM, DM, DM, DM}; pg8::StaticOrder S2; S2.init(MMEM, DM, F.G, F.G - 1 - F.bid);
                pg8::EpiProj<true, false> E2{(bf16*)(F.ws + WS_MEMKV), DM, (const float*)(F.ws + WS_MSQ), nullptr, 4, nullptr, 0, 2, F.in[I_MEMKNW], 0, 0, nullptr, 0, 0, nullptr};
                pg8::gemm_phase<pg8::EpiProj<true, false>, pg8::StaticOrder, true, true>(F.lds, g2, S2, E2, F.wv);
            }
        }
        SEAM(pb);
        if (layer == 0 && grp_try) gb.on = __hip_atomic_load((unsigned*)((gu32*)(F.ws + WS_CTL) + CW_BAD), __ATOMIC_RELAXED, __HIP_MEMORY_SCOPE_AGENT) == 0u;
        const int pm = pb + (layer ? 1 : 2);
        if (layer == 0) {
            if (IN(pb + 1)) { constexpr int NU = BATCH * NH * (SEQ / 64); DnPre R; int u = F.bid; if (u < NU) dn_prep_load(F, u, R);
                              for (; u < NU; u += F.G) dn_prep_unit(F, u, u + F.G < NU ? u + F.G : -1, R); }
            SEAM(pb + 1);
        }
        if (IN(pm)) {
            if (layer == 0) {
                if (F.bid < 64) dn_scan_unit(F, F.bid);
                else { const SrcL0 src{&F, F.bid - 64, F.G - 64}; att::phase((char*)lds, src, F.wv);
                       __syncthreads();
                       const Tix T = tix(F.wv); convert_weights<6, 18>(F, (LAS float*)(F.lds + T.wave * 17408), T.lane, (F.bid - 64) * NWAVES + T.wave, (F.G - 64) * NWAVES, 0); }
            } else {
                const int vcu = (F.G % 8 == 0) ? (F.bid % 8) * (F.G / 8) + F.bid / 8 : F.bid;
                const SrcL1 src{&F, vcu}; att::phase((char*)lds, src, F.wv);
            }
            __syncthreads();
        }
        SEAM(pm);
        if (IN(pm + 1)) {
            pg8::Gemm g{proj + PC_Q, (const bf16*)(F.ws + (layer ? WS_WOUT1 : WS_WOUT0)), MROWS, DM, OUT_IN, PW}; pg8::StaticOrder S; S.init(MROWS, DM, F.G, F.bid);
            pg8::EpiRes<false> E{layer ? (const float*)F.out : F.in[I_X], F.out, xb, xsq};
            pg8::gemm_phase<pg8::EpiRes<false>, pg8::StaticOrder, true, true>(F.lds, g, S, E, F.wv);
        }
        SEAMG(pm + 1, layer * 3 + 0);
        if (IN(pm + 2)) {
            pg8::Gemm g{xb, (const bf16*)(F.ws + (layer ? WS_WM1_1 : WS_WM1_0)), MROWS, FF, DM, DM}; pg8::StaticOrder S; S.init(MROWS, FF, F.G, F.bid);
            pg8::EpiProj<false, true> E{proj, FF, xsq, nullptr, 16, nullptr, 0, 0, nullptr, 0, 0, nullptr, 0, 0, nullptr};
            pg8::gemm_phase<pg8::EpiProj<false, true>, pg8::StaticOrder, true, true>(F.lds, g, S, E, F.wv);
        }
        SEAMG(pm + 2, layer * 3 + 1);
        if (IN(pm + 3)) {
            pg8::Gemm g{proj, (const bf16*)(F.ws + (layer ? WS_WM2_1 : WS_WM2_0)), MROWS, DM, FF, FF}; pg8::StaticOrder S; S.init(MROWS, DM, F.G, F.bid);
            pg8::EpiRes<layer == 1> E{(const float*)F.out, F.out, xb, xsq};
            pg8::gemm_phase<pg8::EpiRes<layer == 1>, pg8::StaticOrder, true, true>(F.lds, g, S, E, F.wv);
        }
        if (layer == 0) SEAMG(pm + 3, 2); else SEAM(pm + 3);
    }
#undef IN
#undef SEAM
#undef SEAMG
__global__ void __launch_bounds__(NWAVES * 64, 2) hyb_fwd(Args args) {
    extern __shared__ __attribute__((aligned(16))) unsigned char lds[];
    Frame F;
    F.lds = (LAS unsigned char*)lds;
    F.G = gridDim.x; F.bid = blockIdx.x; F.in = args.in; F.out = args.out; F.ws = args.ws; F.wv = __builtin_amdgcn_readfirstlane((int)threadIdx.x >> 6);
    volatile LAS unsigned* MISC = (volatile LAS unsigned*)(F.lds + MISC_OFF);
    gu32* ctl = (gu32*)(args.ws + WS_CTL);
    for (int u = threadIdx.x; u < (LDS_BYTES - MISC_OFF) / 4; u += NWAVES * 64) ((LAS unsigned*)(F.lds + MISC_OFF))[u] = 0u;
    __syncthreads();
    XcdBarrier bar; bar.bar = (unsigned*)(ctl + CW_BAR) + args.li * XCD_BAR_WORDS; bar.x = 0; bar.st = nullptr; bar.wv = F.wv;
    if (!MK_LAUNCH_PER_PHASE) { bar = xcd_barrier_post((unsigned*)(ctl + CW_BAR) + args.li * XCD_BAR_WORDS, MISC + 8); bar.wv = F.wv; }
    const int lo = args.ph_lo, hi = args.ph_hi;
#define IN(k) (lo <= (k) && (k) < hi)
#define SEAM(k) do { if (IN(k) && IN((k) + 1)) xcd_barrier(bar); } while (0)
    bf16* proj = (bf16*)(F.ws + WS_PROJ); bf16* xb = (bf16*)(F.ws + WS_XB); float* xsq = (float*)(F.ws + WS_XSQ);
    float* ab = (float*)(F.ws + WS_AB);

    GrpBar gb; gb.cnt = (unsigned*)(ctl + CW_GRP) + (size_t)(F.bid & 63) * 8 * 64; gb.tmo = (unsigned*)(ctl + CW_BAR) + XB_TMO; gb.wv = F.wv; gb.on = false;
    const bool grp_try = !MK_LAUNCH_PER_PHASE && F.G == 256 && lo == 0 && hi == N_PHASES;
    if (grp_try && F.wv == 0 && lane_id() == 0) __hip_atomic_store((unsigned*)(ctl + CW_XCC) + F.bid, xb_xcc_id() + 1u, __ATOMIC_RELAXED, __HIP_MEMORY_SCOPE_AGENT);
    if (IN(0)) { p0_prologue(F); } SEAM(0);
    if (grp_try && F.wv == 0 && lane_id() == 0) { const unsigned mine = xb_xcc_id() + 1u; bool same = true;
        for (int k = 1; k < 4; ++k) same = same && __hip_atomic_load((unsigned*)(ctl + CW_XCC) + ((F.bid + 64 * k) & 255), __ATOMIC_RELAXED, __HIP_MEMORY_SCOPE_AGENT) == mine;
        if (!same) atomicAdd((unsigned*)(ctl + CW_BAD), 1u); }

    layer_body<0>(F, bar, gb, grp_try, lo, hi, lds);
    layer_body<1>(F, bar, gb, grp_try, lo, hi, lds);
#undef IN
#undef SEAM
}

extern "C" void kernel_launch(void* const* d_in, const int* in_sizes, int n_in, void* d_out, int out_size, void* d_ws, size_t ws_size, hipStream_t stream) {
    static int grid = 0;
    if (grid == 0) {
        if (n_in != 20 || in_sizes[0] != MROWS * DM || out_size != MROWS * DM || ws_size < WS_END) {
            fprintf(stderr, "kernel_launch: shape/workspace mismatch (n_in %d, in0 %d, out %d, ws %zu; need ws >= %zu); nothing launched\n", n_in, n_in > 0 ? in_sizes[0] : -1, out_size, ws_size, (size_t)WS_END); grid = -1; return; }
        int dev = 0, cus = 0, per_cu = 0;
        if (hipGetDevice(&dev) != hipSuccess || hipDeviceGetAttribute(&cus, hipDeviceAttributeMultiprocessorCount, dev) != hipSuccess) { fprintf(stderr, "kernel_launch: device query failed\n"); grid = -1; return; }
        if (hipFuncSetAttribute((const void*)hyb_fwd, hipFuncAttributeMaxDynamicSharedMemorySize, LDS_BYTES) != hipSuccess) { fprintf(stderr, "kernel_launch: hipFuncSetAttribute failed\n"); grid = -1; return; }
        if (hipOccupancyMaxActiveBlocksPerMultiprocessor(&per_cu, (const void*)hyb_fwd, NWAVES * 64, LDS_BYTES) != hipSuccess || per_cu < 1) {
            fprintf(stderr, "kernel_launch: occupancy query reports %d workgroups per CU; nothing launched\n", per_cu); (void)hipGetLastError(); grid = -1; return; }
        if (cus < 128) { fprintf(stderr, "kernel_launch: %d CUs; this kernel's phase program needs at least 128 workgroups; nothing launched\n", cus); grid = -1; return; }
        grid = cus;
    }
    if (grid < 0) return;
    if (hipMemsetAsync((char*)d_ws + WS_CTL, 0, CTL_ZERO_BYTES, stream) != hipSuccess) { fprintf(stderr, "kernel_launch: memset failed\n"); return; }
    Args a{};
    for (int i = 0; i < 20; ++i) a.in[i] = (const float*)d_in[i];
    a.out = (float*)d_out; a.ws = (unsigned char*)d_ws;
#if MK_LAUNCH_PER_PHASE
    for (int p = 0; p < N_PHASES; ++p) { a.ph_lo = p; a.ph_hi = p + 1; a.li = 0; hipLaunchKernelGGL(hyb_fwd, dim3(grid), dim3(NWAVES * 64), LDS_BYTES, stream, a); }
#else
    a.ph_lo = 0; a.ph_hi = N_PHASES; a.li = 0;
    hipLaunchKernelGGL(hyb_fwd, dim3(grid), dim3(NWAVES * 64), LDS_BYTES, stream, a);
#endif
    const hipError_t le = hipPeekAtLastError();
    if (le != hipSuccess) fprintf(stderr, "kernel_launch: launch failed: %s\n", hipGetErrorName(le));
}
```

```cpp
#include <hip/hip_runtime.h>
#include <cstdio>
#include <cstdint>

constexpr int BATCH = 8, SEQ = 2048, DM = 1024, MROWS = BATCH * SEQ;
constexpr int NMEM = 256, MMEM = BATCH * NMEM;
constexpr int HD = 128, NH = 8, NMH = 4, FF = 4096;
constexpr int PW = 4608;
constexpr int PC_K = 0, PC_V = 1024, PC_Z = 2048, PC_Q = 3072, PC_QM = 4096, PC_AB = 4608;
constexpr int N_IN = 4864;
constexpr int DN_IN = 4624, FOX_IN = 4616, OUT_IN = 1536;
constexpr float EPS = 1e-6f;
constexpr float QSCALE = 0.08838834764831845f;

__device__ __forceinline__ int lane_id_v() { int x; asm volatile("v_mbcnt_lo_u32_b32 %0, -1, 0\n\tv_mbcnt_hi_u32_b32 %0, -1, %0" : "=v"(x)); return x; }
template <int CTRL> __device__ __forceinline__ float dppf(float x) { return __builtin_bit_cast(float, __builtin_amdgcn_update_dpp(0, __builtin_bit_cast(int, x), CTRL, 0xf, 0xf, true)); }
__device__ __forceinline__ float row16_sum(float x) { x += dppf<0xB1>(x); x += dppf<0x4E>(x); x += dppf<0x141>(x); x += dppf<0x140>(x); return x; }
__device__ __forceinline__ float add_xor16(float x) { auto r = __builtin_amdgcn_permlane16_swap(__float_as_uint(x), __float_as_uint(x), false, false); return __uint_as_float(r[0]) + __uint_as_float(r[1]); }
__device__ __forceinline__ float add_xor32(float x) { auto r = __builtin_amdgcn_permlane32_swap(__float_as_uint(x), __float_as_uint(x), false, false); return __uint_as_float(r[0]) + __uint_as_float(r[1]); }
namespace pg8 {
#define PG8_LAS __attribute__((address_space(3)))
typedef unsigned short bf16_t;
typedef short bf16x8 __attribute__((ext_vector_type(8)));
typedef float f32x4 __attribute__((ext_vector_type(4)));
typedef unsigned u32x4 __attribute__((ext_vector_type(4)));
constexpr int BM = 256, BK = 64, HALF = 128, HTB = HALF * BK * 2  , STAGE_BYTES = 8 * HTB, NXCD = 8, WGM = 8;

__host__ __device__ __forceinline__ int lds_byte(int r, int c) { const int st = (r >> 4) * 2 + (c >> 5), rr = r & 15, cc = c & 31, ob = rr * 64 + cc * 2; return st * 1024 + (ob ^ (((ob >> 9) & 1) << 5)); }
__host__ __device__ __forceinline__ void stage_rc(int b, int& R, int& C) { const int st = b / 1024, sb = b % 1024, swz = sb ^ (((sb >> 9) & 1) << 5); R = (st >> 1) * 16 + swz / 64; C = (st & 1) * 32 + (swz % 64) / 2; }
__host__ __device__ __forceinline__ int perm32(int rho) { const int n = rho >> 4, i = rho & 15; return 8 * (i >> 2) + 4 * n + (i & 3); }

struct Unit { int pm, pn; };
struct Gemm { const bf16_t* A; const bf16_t* Bt; int M, N, K, lda; };

struct StaticOrder {
    int nM, nN, nwg, G, c;
    __host__ __device__ void init(int M, int N, int G_, int c_) { nM = M / BM; nN = N / BM; nwg = nM * nN; G = G_; c = c_; }
    __host__ __device__ bool next(int i, Unit& u) const {
        const long L = (long)i * G + c; if (L >= nwg) return false;
        int wgid = (int)L; { const int q = nwg / NXCD, r = nwg % NXCD, xcd = wgid % NXCD, off = wgid / NXCD; wgid = (xcd < r ? xcd * (q + 1) : r * (q + 1) + (xcd - r) * q) + off; }
        const int nig = WGM * nN, gid = wgid / nig, fm = gid * WGM, gsz = (nM - fm) < WGM ? (nM - fm) : WGM;
        u.pm = fm + ((wgid % nig) % gsz); u.pn = (wgid % nig) / gsz; return true;
    }
    __device__ __forceinline__ void a_ready(const Unit&) const {}
    __device__ __forceinline__ void done(const Unit&) const {}
};


__device__ __forceinline__ unsigned cvt_pk_bf16(float lo, float hi) { unsigned r; asm volatile("v_cvt_pk_bf16_f32 %0, %1, %2" : "=v"(r) : "v"(lo), "v"(hi)); return r; }

constexpr int EPI_XCH = 131072, EPI_RS = 139264;
template <bool NORM, bool RELU2, bool HALO = false> struct EpiProj {
    static constexpr bool PERM = true, AFTER_DRAIN = false, USE_RS = true, ACC_INIT = false;
    bf16_t* O; int ldc; const float* xsq; float* ab; int n_main; bf16_t* halo;
    int nlo0, nhi0; const float* nw0; int nlo1, nhi1; const float* nw1; int nlo2, nhi2; const float* nw2;
    __device__ __forceinline__ void rs_load(const Unit& u, int tid, f32x4 (&q)[4]) const { const float* p = xsq + (size_t)(u.pm * BM + tid) * 16;
#pragma unroll
        for (int i = 0; i < 4; ++i) q[i] = *(const f32x4*)(p + 4 * i); }
    __device__ __forceinline__ void rs_store(const f32x4 (&q)[4], PG8_LAS unsigned char* lds, int parity, int tid) const {
        const f32x4 t = (q[0] + q[1]) + (q[2] + q[3]);
        ((PG8_LAS float*)(lds + EPI_RS))[parity * 256 + tid] = rsqrtf(((t[0] + t[1]) + (t[2] + t[3])) * (1.0f / 1024.0f) + 1e-6f); }
    __device__ __forceinline__ void operator()(const f32x4 (&acc)[2][2][4][2], const Unit& u, int wr, int wc, int fr, int fq, PG8_LAS unsigned char* lds, int parity) const {
        const int rl0 = wr * 64 + fr, row0 = u.pm * BM + rl0, colt = u.pn * BM;
        const bool is_ab = u.pn >= n_main;
        const PG8_LAS float* RS = (const PG8_LAS float*)(lds + EPI_RS) + parity * 256;
        const float* nw = nullptr;
        if (NORM) { if (u.pn >= nlo0 && u.pn < nhi0) nw = nw0; else if (u.pn >= nlo1 && u.pn < nhi1) nw = nw1; else if (u.pn >= nlo2 && u.pn < nhi2) nw = nw2; }
        f32x4 w0 = {1.f, 1.f, 1.f, 1.f}, w1 = w0;
        if (NORM && nw != nullptr) {
            w0 = *(const f32x4*)(nw + wc * 32 + 8 * fq); w1 = *(const f32x4*)(nw + wc * 32 + 8 * fq + 4);
            PG8_LAS float* X = (PG8_LAS float*)(lds + EPI_XCH);
#pragma unroll
            for (int ai = 0; ai < 2; ++ai)
#pragma unroll
                for (int m = 0; m < 4; ++m) { const int rl = rl0 + ai * HALF + m * 16; const float rstd = RS[rl];
#pragma unroll
                    for (int bj = 0; bj < 2; ++bj) { const f32x4 v0 = acc[ai][bj][m][0] * rstd, v1 = acc[ai][bj][m][1] * rstd;
                        float ss = ((v0[0] * v0[0] + v0[1] * v0[1]) + (v0[2] * v0[2] + v0[3] * v0[3])) + ((v1[0] * v1[0] + v1[1] * v1[1]) + (v1[2] * v1[2] + v1[3] * v1[3]));
                        ss = add_xor32(add_xor16(ss));
                        if (fq == 0) X[(bj * 256 + rl) * 4 + wc] = ss; } }
            asm volatile("s_waitcnt lgkmcnt(0)" ::: "memory"); __builtin_amdgcn_s_barrier(); asm volatile("" ::: "memory");
        }
#pragma unroll
        for (int ai = 0; ai < 2; ++ai)
#pragma unroll
            for (int m = 0; m < 4; ++m) {
                const int rl = rl0 + ai * HALF + m * 16, r = row0 + ai * HALF + m * 16;
                const float rstd = RS[rl];
                if (!is_ab) {
#pragma unroll
                    for (int bj = 0; bj < 2; ++bj) {
                        float sc = rstd;
                        if (NORM && nw != nullptr) { const f32x4 p4 = *(const PG8_LAS f32x4*)((const PG8_LAS float*)(lds + EPI_XCH) + (bj * 256 + rl) * 4);
                            sc = rstd * rsqrtf(((p4[0] + p4[1]) + (p4[2] + p4[3])) * (1.0f / 128.0f) + 1e-6f); }
                        f32x4 v0 = acc[ai][bj][m][0] * sc * w0, v1 = acc[ai][bj][m][1] * sc * w1;
                        if (RELU2) {
#pragma unroll
                            for (int e = 0; e < 4; ++e) { const float a = fmaxf(v0[e], 0.f), b = fmaxf(v1[e], 0.f); v0[e] = a * a; v1[e] = b * b; }
                        }
                        u32x4 w; w.x = cvt_pk_bf16(v0[0], v0[1]); w.y = cvt_pk_bf16(v0[2], v0[3]); w.z = cvt_pk_bf16(v1[0], v1[1]); w.w = cvt_pk_bf16(v1[2], v1[3]);
                        *(u32x4*)(O + (size_t)r * ldc + colt + bj * HALF + wc * 32 + 8 * fq) = w;
                        if (HALO && m == 3 && fr >= 13) *(u32x4*)(halo + ((size_t)(r >> 6) * 3 + ((r & 63) - 61)) * ldc + colt + bj * HALF + wc * 32 + 8 * fq) = w;
                    }
                } else if (ab != nullptr && wc == 0 && fq < 2) {
                    float* p = ab + (size_t)r * 16 + 8 * fq;
                    *(f32x4*)p = acc[ai][0][m][0] * rstd; *(f32x4*)(p + 4) = acc[ai][0][m][1] * rstd;
                }
            }
    }
};
template <bool LAST = false, bool INIT_F32 = false> struct EpiRes {
    static constexpr bool PERM = true, AFTER_DRAIN = false, USE_RS = false, ACC_INIT = true;
    bf16_t* xb; float* xout; float* xsq; const float* xin;
    __device__ __forceinline__ void init(f32x4 (&acc)[2][2][4][2], const Unit& u, int wr, int wc, int fr, int fq) const {
        const int row0 = u.pm * BM + wr * 64 + fr, colt = u.pn * BM;
#pragma unroll
        for (int ai = 0; ai < 2; ++ai)
#pragma unroll
            for (int m = 0; m < 4; ++m)
#pragma unroll
                for (int bj = 0; bj < 2; ++bj) { const size_t off = (size_t)(row0 + ai * HALF + m * 16) * 1024 + colt + bj * HALF + wc * 32 + 8 * fq;
                    if (INIT_F32) { acc[ai][bj][m][0] = *(const f32x4*)(xin + off); acc[ai][bj][m][1] = *(const f32x4*)(xin + off + 4); continue; }
                    const u32x4 w = *(const u32x4*)(xb + off);
                    acc[ai][bj][m][0] = (f32x4){__uint_as_float(w.x << 16), __uint_as_float(w.x & 0xffff0000u), __uint_as_float(w.y << 16), __uint_as_float(w.y & 0xffff0000u)};
                    acc[ai][bj][m][1] = (f32x4){__uint_as_float(w.z << 16), __uint_as_float(w.z & 0xffff0000u), __uint_as_float(w.w << 16), __uint_as_float(w.w & 0xffff0000u)}; }
    }
    __device__ __forceinline__ void operator()(const f32x4 (&acc)[2][2][4][2], const Unit& u, int wr, int wc, int fr, int fq, PG8_LAS unsigned char*, int) const {
        const int row0 = u.pm * BM + wr * 64 + fr, colt = u.pn * BM;
#pragma unroll
        for (int ai = 0; ai < 2; ++ai)
#pragma unroll
            for (int m = 0; m < 4; ++m) {
                const int r = row0 + ai * HALF + m * 16; float ss = 0.f;
#pragma unroll
                for (int bj = 0; bj < 2; ++bj) {
                    const size_t off = (size_t)r * 1024 + colt + bj * HALF + wc * 32 + 8 * fq;
                    const f32x4 v0 = acc[ai][bj][m][0], v1 = acc[ai][bj][m][1];
                    if (LAST) { *(f32x4*)(xout + off) = v0; *(f32x4*)(xout + off + 4) = v1; }
                    else {
                    ss += ((v0[0] * v0[0] + v0[1] * v0[1]) + (v0[2] * v0[2] + v0[3] * v0[3])) + ((v1[0] * v1[0] + v1[1] * v1[1]) + (v1[2] * v1[2] + v1[3] * v1[3]));
                    u32x4 w; w.x = cvt_pk_bf16(v0[0], v0[1]); w.y = cvt_pk_bf16(v0[2], v0[3]); w.z = cvt_pk_bf16(v1[0], v1[1]); w.w = cvt_pk_bf16(v1[2], v1[3]);
                    *(u32x4*)(xb + off) = w; }
                }
                if (!LAST) { ss = add_xor32(add_xor16(ss));
                if (fq == 0) xsq[(size_t)r * 16 + u.pn * 4 + wc] = ss; }
            }
    }
};

template <class Epi, class Sched, bool ALIGN_EPI = false, bool SP2 = false>
__device__ __forceinline__ void gemm_phase(PG8_LAS unsigned char* lds, const Gemm g, const Sched& S, const Epi& E, int wid) {
    const int lane = lane_id_v();
    const int tid = wid * 64 + lane, wr = wid >> 2, wc = wid & 3, fr = lane & 15, fq = lane >> 4;
    const int K = g.K, nt = K / BK;
    unsigned voffA[2], voffB[2];
#pragma unroll
    for (int i = 0; i < 2; ++i) { int R, C; stage_rc(tid * 16 + i * 8192, R, C); const int Rb = Epi::PERM ? ((R & ~31) + perm32(R & 31)) : R;
        voffA[i] = (unsigned)(R * g.lda + C) * 2u; voffB[i] = (unsigned)(Rb * K + C) * 2u; }
    const size_t kstep = (size_t)(BK * 2);
    const size_t hstepA = (size_t)HALF * g.lda * 2, hstepB = (size_t)HALF * K * 2;
    const size_t tstepA = 2 * hstepA, tstepB = 2 * hstepB;
    const unsigned ldsw = (unsigned)wid * 1024u;
    const int aoff = lds_byte(wr * 64 + fr, fq * 8), boff = lds_byte(wc * 32 + fr, fq * 8);
#define PG8_SA(b, h) (((b) * 2 + (h)) * HTB)
#define PG8_SB(b, h) ((4 + (b) * 2 + (h)) * HTB)
#define PG8_STAGE(bufoff, gbase, voff) do { _Pragma("unroll") for (int _i = 0; _i < 2; ++_i) \
        __builtin_amdgcn_global_load_lds((const unsigned*)((const char*)(gbase) + (voff)[_i]), (PG8_LAS unsigned*)(lds + (bufoff) + ldsw + _i * 8192), 16, 0, 0); } while (0)
#define PG8_LDA(dst, b, h) do { _Pragma("unroll") for (int m = 0; m < 4; ++m) _Pragma("unroll") for (int k = 0; k < 2; ++k) dst[m][k] = *(const PG8_LAS bf16x8*)(lds + PG8_SA(b, h) + aoff + m * 2048 + k * 1024); } while (0)
#define PG8_LDB(dst, b, h) do { _Pragma("unroll") for (int n = 0; n < 2; ++n) _Pragma("unroll") for (int k = 0; k < 2; ++k) dst[n][k] = *(const PG8_LAS bf16x8*)(lds + PG8_SB(b, h) + boff + n * 2048 + k * 1024); } while (0)
#define PG8_MMA(ai, bj, At, Bt) do { __builtin_amdgcn_s_setprio(1); _Pragma("unroll") for (int m = 0; m < 4; ++m) _Pragma("unroll") for (int n = 0; n < 2; ++n) _Pragma("unroll") for (int k = 0; k < 2; ++k) \
        acc[ai][bj][m][n] = __builtin_amdgcn_mfma_f32_16x16x32_bf16(Bt[n][k], At[m][k], acc[ai][bj][m][n], 0, 0, 0); __builtin_amdgcn_s_setprio(0); } while (0)
#define PG8_WAIT_V(n) asm volatile("s_waitcnt vmcnt(" #n ")" ::: "memory")
#define PG8_WAIT_L(n) asm volatile("s_waitcnt lgkmcnt(" #n ")" ::: "memory")
#define PG8_BAR __builtin_amdgcn_s_barrier()
#define PG8_SCHED __builtin_amdgcn_sched_barrier(0)
    Unit cur, nxt; int ui = 0;
    if (!S.next(0, cur)) return;
    f32x4 acc[2][2][4][2];
    if constexpr (Epi::ACC_INIT) E.init(acc, cur, wr, wc, fr, fq);
    else {
#pragma unroll
    for (int a = 0; a < 2; ++a)
#pragma unroll
        for (int b = 0; b < 2; ++b)
#pragma unroll
            for (int m = 0; m < 4; ++m)
#pragma unroll
                for (int n = 0; n < 2; ++n) acc[a][b][m][n] = (f32x4){0.f, 0.f, 0.f, 0.f};
    }
    bf16x8 At[4][2], B0[2][2], B1[2][2];
    const char* cA = (const char*)g.A + (size_t)cur.pm * tstepA; const char* cB = (const char*)g.Bt + (size_t)cur.pn * tstepB;
    S.a_ready(cur);
    if constexpr (Epi::USE_RS) { if (tid < 256) { f32x4 rq[4]; E.rs_load(cur, tid, rq); E.rs_store(rq, lds, 0, tid); } }
    if constexpr (SP2) {
        PG8_STAGE(PG8_SB(0, 0), cB, voffB); PG8_STAGE(PG8_SB(0, 1), cB + hstepB, voffB); PG8_STAGE(PG8_SA(0, 0), cA, voffA); PG8_STAGE(PG8_SA(0, 1), cA + hstepA, voffA);
        if (wr == 1) PG8_BAR;
        PG8_WAIT_V(2); PG8_BAR;
        PG8_STAGE(PG8_SB(1, 0), cB + kstep, voffB); PG8_STAGE(PG8_SA(1, 0), cA + kstep, voffA); PG8_STAGE(PG8_SB(1, 1), cB + hstepB + kstep, voffB);
        PG8_WAIT_V(6); PG8_BAR;
    } else {
        PG8_STAGE(PG8_SB(0, 0), cB, voffB); PG8_STAGE(PG8_SA(0, 0), cA, voffA); PG8_STAGE(PG8_SB(0, 1), cB + hstepB, voffB); PG8_STAGE(PG8_SA(0, 1), cA + hstepA, voffA);
        if (wr == 1) PG8_BAR;
        PG8_WAIT_V(4); PG8_BAR;
        PG8_STAGE(PG8_SB(1, 0), cB + kstep, voffB); PG8_STAGE(PG8_SA(1, 0), cA + kstep, voffA); PG8_STAGE(PG8_SB(1, 1), cB + hstepB + kstep, voffB);
        PG8_WAIT_V(6); PG8_BAR;
    }
    for (;;) {
        const bool has_next = S.next(ui + 1, nxt);
        const char* nA = has_next ? (const char*)g.A + (size_t)nxt.pm * tstepA : cA; const char* nB = has_next ? (const char*)g.Bt + (size_t)nxt.pn * tstepB : cB;
        for (int t = 0; t < nt; t += 2) {
            const bool last = (t == nt - 2);
            const char* a1 = cA + (size_t)(t + 1) * kstep;
            const char* a2 = last ? nA : cA + (size_t)(t + 2) * kstep; const char* b2 = last ? nB : cB + (size_t)(t + 2) * kstep;
            const char* a3 = a2 + kstep; const char* b3 = b2 + kstep;
            if (last && has_next) S.a_ready(nxt);
            if constexpr (SP2) {
            PG8_LDB(B0, 0, 0); PG8_LDB(B1, 0, 1); PG8_SCHED; PG8_LDA(At, 0, 0); PG8_STAGE(PG8_SA(1, 1), a1 + hstepA, voffA);
            PG8_WAIT_V(8); PG8_WAIT_L(0); PG8_BAR; PG8_MMA(0, 0, At, B0); PG8_MMA(0, 1, At, B1); PG8_BAR; PG8_SCHED;
            PG8_LDA(At, 0, 1); PG8_STAGE(PG8_SB(0, 0), b2, voffB); PG8_STAGE(PG8_SB(0, 1), b2 + hstepB, voffB); PG8_STAGE(PG8_SA(0, 0), a2, voffA);
            PG8_WAIT_V(8); PG8_WAIT_L(0); PG8_BAR; PG8_MMA(1, 0, At, B0); PG8_MMA(1, 1, At, B1); PG8_BAR; PG8_SCHED;
            PG8_LDB(B0, 1, 0); PG8_LDB(B1, 1, 1); PG8_SCHED; PG8_LDA(At, 1, 0); PG8_STAGE(PG8_SA(0, 1), a2 + hstepA, voffA);
            PG8_WAIT_V(8); PG8_WAIT_L(0); PG8_BAR; PG8_MMA(0, 0, At, B0); PG8_MMA(0, 1, At, B1); PG8_BAR; PG8_SCHED;
            PG8_LDA(At, 1, 1); PG8_STAGE(PG8_SB(1, 0), b3, voffB); PG8_STAGE(PG8_SB(1, 1), b3 + hstepB, voffB); PG8_STAGE(PG8_SA(1, 0), a3, voffA);
            PG8_WAIT_V(8); PG8_WAIT_L(0); PG8_BAR; PG8_MMA(1, 0, At, B0); PG8_MMA(1, 1, At, B1); PG8_BAR; PG8_SCHED;
            } else {
            PG8_LDB(B0, 0, 0); PG8_SCHED; PG8_LDA(At, 0, 0); PG8_STAGE(PG8_SA(1, 1), a1 + hstepA, voffA);
            PG8_WAIT_L(8); PG8_BAR; PG8_WAIT_L(0); PG8_MMA(0, 0, At, B0); PG8_BAR; PG8_SCHED;
            PG8_LDB(B1, 0, 1); PG8_STAGE(PG8_SB(0, 0), b2, voffB);
            PG8_BAR; PG8_WAIT_L(0); PG8_MMA(0, 1, At, B1); PG8_BAR;
            PG8_LDA(At, 0, 1); PG8_STAGE(PG8_SA(0, 0), a2, voffA);
            PG8_BAR; PG8_WAIT_L(0); PG8_MMA(1, 0, At, B0); PG8_BAR; PG8_SCHED;
            PG8_STAGE(PG8_SB(0, 1), b2 + hstepB, voffB);
            PG8_WAIT_V(6); PG8_BAR; PG8_MMA(1, 1, At, B1); PG8_BAR;
            PG8_LDB(B0, 1, 0); PG8_SCHED; PG8_LDA(At, 1, 0); PG8_STAGE(PG8_SA(0, 1), a2 + hstepA, voffA);
            PG8_WAIT_L(8); PG8_BAR; PG8_WAIT_L(0); PG8_MMA(0, 0, At, B0); PG8_BAR; PG8_SCHED;
            PG8_LDB(B1, 1, 1); PG8_STAGE(PG8_SB(1, 0), b3, voffB);
            PG8_BAR; PG8_WAIT_L(0); PG8_MMA(0, 1, At, B1); PG8_BAR;
            PG8_LDA(At, 1, 1); PG8_STAGE(PG8_SA(1, 0), a3, voffA);
            PG8_BAR; PG8_WAIT_L(0); PG8_MMA(1, 0, At, B0); PG8_BAR; PG8_SCHED;
            PG8_STAGE(PG8_SB(1, 1), b3 + hstepB, voffB);
            PG8_WAIT_V(6); PG8_BAR; PG8_MMA(1, 1, At, B1); PG8_BAR;
            }
        }
        if constexpr (ALIGN_EPI) { if (wr == 0) PG8_BAR; }
        if constexpr (Epi::USE_RS) {
            f32x4 rq[4]; if (has_next && tid < 256) E.rs_load(nxt, tid, rq);
            E(acc, cur, wr, wc, fr, fq, lds, ui & 1);
            if (has_next && tid < 256) E.rs_store(rq, lds, (ui + 1) & 1, tid);
        } else { E(acc, cur, wr, wc, fr, fq, lds, ui & 1); }
        S.done(cur);
        if (!has_next) break;
        if constexpr (Epi::ACC_INIT) E.init(acc, nxt, wr, wc, fr, fq);
        else {
#pragma unroll
        for (int a = 0; a < 2; ++a)
#pragma unroll
            for (int b = 0; b < 2; ++b)
#pragma unroll
                for (int m = 0; m < 4; ++m)
#pragma unroll
                    for (int n = 0; n < 2; ++n) acc[a][b][m][n] = (f32x4){0.f, 0.f, 0.f, 0.f};
        }
        cur = nxt; cA = nA; cB = nB; ++ui;
        if constexpr (ALIGN_EPI) { if (wr == 1) PG8_BAR; }
    }
    PG8_WAIT_V(0);
    if constexpr (!ALIGN_EPI) { if (wr == 0) PG8_BAR; }
    PG8_BAR;
    if constexpr (Epi::AFTER_DRAIN) { E.fused(acc, cur, wr, wc, fr, fq, lds, wid, lane); S.done(cur); }
#undef PG8_SA
#undef PG8_SB
#undef PG8_STAGE
#undef PG8_LDA
#undef PG8_LDB
#undef PG8_MMA
#undef PG8_WAIT_V
#undef PG8_WAIT_L
#undef PG8_BAR
#undef PG8_SCHED
}
}

namespace att {
typedef unsigned short bf16_t;
typedef short bf16x8 __attribute__((ext_vector_type(8)));
typedef short s16x4 __attribute__((ext_vector_type(4)));
typedef float f32x16 __attribute__((ext_vector_type(16)));
typedef float f32x4 __attribute__((ext_vector_type(4)));
typedef unsigned u32x4 __attribute__((ext_vector_type(4)));
constexpr int NW = 8, QBLK = 32, KVBLK = 64, QB = NW * QBLK, D = 128;
constexpr int SHM_V = KVBLK * D * 2, SHM_K = KVBLK * D * 2;
constexpr int OFF_WS = 2 * SHM_V + 2 * SHM_K, OFF_BK = OFF_WS + NW * 64 * 4, ATT_LDS = OFF_BK + 8192;
constexpr float SCALE = 0.08838834764831845f, THR = 8.f;
constexpr int WBIG = 1 << 30;
#define KSWZ(row, colB) ((row) * 256 + ((colB) ^ (((row) & 7) << 4)))
#define SBAR() __builtin_amdgcn_sched_barrier(0)
__device__ __forceinline__ int v_st(int k, int c) { const int kk = (k & ~0xC) | ((k & 4) << 1) | ((k & 8) >> 1); return ((kk >> 3) * 4 + (c >> 5)) * 512 + ((kk & 7) * 32 + (c & 31)) * 2; }
__device__ __forceinline__ int v_rd_base(int lane) { return ((lane & 3) << 3) | (((lane >> 2) & 3) << 6) | (((lane >> 4) & 1) << 5) | (((lane >> 5) & 1) << 8); }
constexpr int v_rd_off(int d0, int ks, int half) { return d0 * 512 + ks * 4096 + half * 2048; }
__device__ __forceinline__ int crow(int r, int hi) { return (r & 3) + 8 * (r >> 2) + 4 * hi; }
__device__ __forceinline__ unsigned cvtpk(float lo, float hi) { unsigned r; asm volatile("v_cvt_pk_bf16_f32 %0, %1, %2" : "=v"(r) : "v"(lo), "v"(hi)); return r; }
__device__ __forceinline__ bf16x8 load8(const bf16_t* p) { return *reinterpret_cast<const bf16x8*>(p); }
__device__ __forceinline__ void mask_tile(f32x16& p0, f32x16& p1, int dq, unsigned W) {
    const float NEG = -__builtin_inff();
#pragma unroll
    for (int r = 0; r < 16; ++r) { const int c = (r & 3) + 8 * (r >> 2);
        if ((unsigned)(dq - c) >= W) p0[r] = NEG;
        if ((unsigned)(dq - c - 32) >= W) p1[r] = NEG; }
}
__device__ __forceinline__ void partialSM(f32x16& p0, f32x16& p1, float& m_reg, float& mn, float& alpha) {
    float pmax = p0[0]; for (int r = 1; r < 16; ++r) pmax = fmaxf(pmax, p0[r]); for (int r = 0; r < 16; ++r) pmax = fmaxf(pmax, p1[r]);
    { auto rr = __builtin_amdgcn_permlane32_swap(__float_as_uint(pmax), __float_as_uint(pmax), false, false);
      pmax = fmaxf(__uint_as_float(rr[0]), __uint_as_float(rr[1])); }
    constexpr float C2 = 1.4426950408889634f * SCALE;
    if (__builtin_expect(__all((pmax - m_reg) * SCALE <= THR), 1)) { mn = m_reg; alpha = 1.f; }
    else { mn = fmaxf(m_reg, pmax); alpha = __builtin_amdgcn_exp2f((m_reg - mn) * C2); m_reg = mn; }
    const float mnL = -mn * C2;
    for (int r = 0; r < 16; ++r) p0[r] = fmaf(p0[r], C2, mnL); for (int r = 0; r < 16; ++r) p1[r] = fmaf(p1[r], C2, mnL);
    for (int r = 0; r < 16; ++r) p0[r] = __builtin_amdgcn_exp2f(p0[r]);
}
__device__ __forceinline__ void finishSM(f32x16& p0, f32x16& p1, float alpha, float& l_reg, bf16x8& pa0, bf16x8& pa1, bf16x8& pa2, bf16x8& pa3) {
    for (int r = 0; r < 16; ++r) p1[r] = __builtin_amdgcn_exp2f(p1[r]);
    float ps = 0; for (int r = 0; r < 16; ++r) ps += p0[r]; for (int r = 0; r < 16; ++r) ps += p1[r];
    { auto rr = __builtin_amdgcn_permlane32_swap(__float_as_uint(ps), __float_as_uint(ps), false, false);
      ps = __uint_as_float(rr[0]) + __uint_as_float(rr[1]); }
    l_reg = l_reg * alpha + ps;
#define PK4(P, B_, OUT) do { unsigned a0 = cvtpk(P[B_+0], P[B_+1]), a1 = cvtpk(P[B_+2], P[B_+3]);                          \
        unsigned b0 = cvtpk(P[B_+4], P[B_+5]), b1 = cvtpk(P[B_+6], P[B_+7]);                                             \
        auto r0 = __builtin_amdgcn_permlane32_swap(a0, b0, false, false); auto r1 = __builtin_amdgcn_permlane32_swap(a1, b1, false, false); \
        u32x4 w = {r0[0], r1[0], r0[1], r1[1]}; OUT = *reinterpret_cast<bf16x8*>(&w); } while (0)
    PK4(p0, 0, pa0); PK4(p0, 8, pa1); PK4(p1, 0, pa2); PK4(p1, 8, pa3);
#undef PK4
}
template <int KB>
__device__ __forceinline__ void qkt(f32x16& p0, f32x16& p1, const char* K_lds, int r32, int hi, const bf16x8* qr, const float* bb) {
#pragma unroll
    for (int g = 0; g < 4; ++g) { const f32x4 b0 = *(const f32x4*)(bb + 8 * g), b1 = *(const f32x4*)(bb + 32 + 8 * g);
#pragma unroll
        for (int i = 0; i < 4; ++i) { p0[4 * g + i] = b0[i]; p1[4 * g + i] = b1[i]; } }
    const char* kb[4];
#pragma unroll
    for (int dd = 0; dd < 4; ++dd) kb[dd] = K_lds + KB * SHM_K + KSWZ(r32, (dd * 16 + hi * 8) * 2);
#pragma unroll
    for (int d0 = 0; d0 < 8; ++d0) { const char* a = kb[d0 & 3] + (d0 >> 2) * 128;
        bf16x8 b0 = *reinterpret_cast<const bf16x8*>(a);
        bf16x8 b1 = *reinterpret_cast<const bf16x8*>(a + 32 * 256);
        p0 = __builtin_amdgcn_mfma_f32_32x32x16_bf16(b0, qr[d0], p0, 0, 0, 0);
        p1 = __builtin_amdgcn_mfma_f32_32x32x16_bf16(b1, qr[d0], p1, 0, 0, 0); }
}
template <int VB>
__device__ __forceinline__ void pv_tile(f32x16* o, int vb0, bf16x8 pa0, bf16x8 pa1, bf16x8 pa2, bf16x8 pa3) {
#define TRRD(dst, off) asm volatile("ds_read_b64_tr_b16 %0, %1 offset:%2" : "=&v"(dst) : "v"(vb0), "i"(off) : "memory")
#define PV_D0(d0) do { s16x4 l0, l1, l2, l3, h0, h1, h2, h3; constexpr int b_ = VB * SHM_V + v_rd_off(d0, 0, 0);   \
        TRRD(l0, b_); TRRD(h0, b_ + 2048); TRRD(l1, b_ + 4096); TRRD(h1, b_ + 6144); TRRD(l2, b_ + 8192); TRRD(h2, b_ + 10240); TRRD(l3, b_ + 12288); TRRD(h3, b_ + 14336); \
        asm volatile("s_waitcnt lgkmcnt(0)" ::: "memory"); SBAR();   \
        o[d0] = __builtin_amdgcn_mfma_f32_32x32x16_bf16(pa0, (bf16x8){l0[0], l0[1], l0[2], l0[3], h0[0], h0[1], h0[2], h0[3]}, o[d0], 0, 0, 0);   \
        o[d0] = __builtin_amdgcn_mfma_f32_32x32x16_bf16(pa1, (bf16x8){l1[0], l1[1], l1[2], l1[3], h1[0], h1[1], h1[2], h1[3]}, o[d0], 0, 0, 0);   \
        o[d0] = __builtin_amdgcn_mfma_f32_32x32x16_bf16(pa2, (bf16x8){l2[0], l2[1], l2[2], l2[3], h2[0], h2[1], h2[2], h2[3]}, o[d0], 0, 0, 0);   \
        o[d0] = __builtin_amdgcn_mfma_f32_32x32x16_bf16(pa3, (bf16x8){l3[0], l3[1], l3[2], l3[3], h3[0], h3[1], h3[2], h3[3]}, o[d0], 0, 0, 0); } while (0)
    PV_D0(0); PV_D0(1); PV_D0(2); PV_D0(3);
#undef PV_D0
#undef TRRD
}
constexpr int QP = 4608;
struct Blk { bf16_t* Q; const bf16_t* K; const float* flog; float fb; int voff, goff, P0, skv, kvpitch; };
struct Seam { bf16x8 qr[8]; bf16x8 st_v0, st_v1, st_k0, st_k1; };
#define ROW(p, pitch, k0, rr) ((p) + (size_t)((k0) + (rr)) * (pitch) + sc)
#define VMW() asm volatile("s_waitcnt vmcnt(0)" ::: "memory")
#define VMWN(n) asm volatile("s_waitcnt vmcnt(%0)" :: "i"(n) : "memory")
#define SLOAD_H(Kp, Vp, pitch, k0) do { S.st_v0 = load8(ROW(Vp, pitch, k0, sr)); S.st_v1 = load8(ROW(Vp, pitch, k0, 32 + sr));              \
                         S.st_k0 = load8(ROW(Kp, pitch, k0, sr)); S.st_k1 = load8(ROW(Kp, pitch, k0, 32 + sr)); } while (0)
#define SWRITE_HK(bf) do { *(bf16x8*)(K_lds + (bf) * SHM_K + kws) = S.st_k0; *(bf16x8*)(K_lds + (bf) * SHM_K + kws + 32 * 256) = S.st_k1; } while (0)
#define SWRITE_HV(bf) do { *(bf16x8*)(V_lds + (bf) * SHM_V + vst0) = S.st_v0; *(bf16x8*)(V_lds + (bf) * SHM_V + vst1) = S.st_v1; } while (0)
#define SWRITE_H(bf) do { SWRITE_HV(bf); SWRITE_HK(bf); } while (0)
__device__ __forceinline__ void prime(const Blk& cur, char* lds, Seam& S, int wid) {
    const int lane = lane_id_v();
    const int tid = wid * 64 + lane, r32 = lane & 31, hi = lane >> 5;
    const int sr = tid >> 4, sc = (tid & 15) * 8, kws = KSWZ(sr, sc * 2); char* K_lds = lds + 2 * SHM_V;
    for (int d0 = 0; d0 < 8; ++d0) S.qr[d0] = load8(cur.Q + (size_t)(wid * QBLK + r32) * QP + d0 * 16 + hi * 8);
    SLOAD_H(cur.K, cur.K + cur.voff, cur.kvpitch, 0); VMW(); SWRITE_HK(0);
    __syncthreads();
}
__device__ __forceinline__ void block(const Blk& cur, const Blk& nxt, char* lds, Seam& S, int wid) {
    const int lane = lane_id_v();
    const int tid = wid * 64 + lane, r32 = lane & 31, hi = lane >> 5;
    constexpr int W = WBIG;
    int j_hi = (cur.P0 + QB - 1) / KVBLK + 1; if (j_hi > cur.skv / KVBLK) j_hi = cur.skv / KVBLK;
    const int NT = j_hi;
    const int qlo = cur.P0 + wid * QBLK, qm = qlo + r32 - 4 * hi;
    char* V_lds = lds; char* K_lds = lds + 2 * SHM_V;
    float* ws = (float*)(lds + OFF_WS) + wid * 64; float* li_l = ws, * al_l = ws + 32;
    float* bkl = (float*)(lds + OFF_BK);
    { const int nkeys = NT * KVBLK;
      if (cur.flog) { const int k0 = 4 * tid; float f[4];
#pragma unroll
          for (int e = 0; e < 4; ++e) { float x = 0.f; if (k0 + e < nkeys) x = cur.flog[(size_t)(k0 + e) * 16] + cur.fb;
              f[e] = k0 + e < nkeys ? fminf(x, 0.f) - log1pf(__expf(-fabsf(x))) : 0.f; }
          f[1] += f[0]; f[2] += f[1]; f[3] += f[2];
          float sc = f[3];
#pragma unroll
          for (int o_ = 1; o_ < 64; o_ <<= 1) { const float t_ = __shfl_up(sc, o_); if (lane >= o_) sc += t_; }
          if (lane == 63) ws[0] = sc;
          __syncthreads();
          float off = sc - f[3];
          for (int w_ = 0; w_ < wid; ++w_) off += ((const float*)(lds + OFF_WS))[w_ * 64];
#pragma unroll
          for (int e = 0; e < 4; ++e) if (k0 + e < nkeys) bkl[k0 + e] = -(f[e] + off) * (1.f / SCALE); }
      else for (int k = tid; k < nkeys; k += NW * 64) bkl[k] = 0.f;
      __syncthreads(); }
    float m_reg = -1e30f, l_reg = 0; f32x16 o[4] = {};
    const int sr = tid >> 4, sc = (tid & 15) * 8, vst0 = v_st(sr, sc), vst1 = v_st(32 + sr, sc), kws = KSWZ(sr, sc * 2);
    const int vb0 = (int)(uintptr_t)V_lds + v_rd_base(lane);
    const bf16_t* Kh = cur.K; const bf16_t* Vh = cur.K + cur.voff; const int kvp = cur.kvpitch;
#define RESC(a) do { if (__any((a) < 1.f)) { if (hi == 0) al_l[r32] = (a); asm volatile("s_waitcnt lgkmcnt(0)" ::: "memory");              \
                     for (int d_ = 0; d_ < 4; ++d_) for (int r = 0; r < 16; ++r) o[d_][r] *= al_l[crow(r, hi)]; } } while (0)
#define KBASE(t) ((t) * KVBLK)
#define MASKT(P0_, P1_, t) do { const int kb_ = KBASE(t); if (kb_ + KVBLK - 1 > qlo) mask_tile(P0_, P1_, qm - kb_, (unsigned)W); } while (0)
#define BB(t) (bkl + KBASE(t) + 4 * hi)
    constexpr int NQL = 8;
#define SEAM_K0() do { VMWN(NQL); SWRITE_HK(0); SBAR(); } while (0)
    f32x16 pA0, pA1, pB0, pB1; float mnA, mnB, alA, alB; bf16x8 pa0, pa1, pa2, pa3;
    SWRITE_HV(0); SBAR();
    if (NT > 1) { SLOAD_H(Kh, Vh, kvp, KBASE(1)); }
    SBAR(); qkt<0>(pA0, pA1, K_lds, r32, hi, S.qr, BB(0));
    MASKT(pA0, pA1, 0); partialSM(pA0, pA1, m_reg, mnA, alA);
    if (NT > 1) { VMW(); SWRITE_H(1); }
    __syncthreads();
#define HALF_STEP(PX0, PX1, mnX, alX, PY0, PY1, alY, t, KB, VB, SB) do {                                                      \
        SBAR(); qkt<KB>(PX0, PX1, K_lds, r32, hi, S.qr, BB(t));                                                                      \
        finishSM(PY0, PY1, alY, l_reg, pa0, pa1, pa2, pa3); SBAR();                                                           \
        if ((t) + 1 < NT) { SLOAD_H(Kh, Vh, kvp, KBASE((t) + 1)); SBAR(); }                                                   \
        pv_tile<VB>(o, vb0, pa0, pa1, pa2, pa3); MASKT(PX0, PX1, (t)); partialSM(PX0, PX1, m_reg, mnX, alX);   \
        __syncthreads();                                                                                                      \
        if ((t) + 1 < NT) { VMW(); SWRITE_H(SB); }                                                                            \
        RESC(alX); __syncthreads(); } while (0)
    for (int t = 1; t + 1 < NT; t += 2) {
        HALF_STEP(pB0, pB1, mnB, alB, pA0, pA1, alA, t, 1, 0, 0);
        HALF_STEP(pA0, pA1, mnA, alA, pB0, pB1, alB, t + 1, 0, 1, 1);
    }
    const bool even = (NT & 1) == 0;
    if (even) { SBAR(); qkt<1>(pB0, pB1, K_lds, r32, hi, S.qr, BB(NT - 1)); SBAR(); }
    SLOAD_H(nxt.K, nxt.K + nxt.voff, nxt.kvpitch, 0); SBAR();
#pragma unroll
    for (int d0 = 0; d0 < 8; ++d0) S.qr[d0] = load8(nxt.Q + (size_t)(wid * QBLK + r32) * QP + d0 * 16 + hi * 8);
    SBAR();
    finishSM(pA0, pA1, alA, l_reg, pa0, pa1, pa2, pa3); SBAR();
    pv_tile<0>(o, vb0, pa0, pa1, pa2, pa3);
    if (even) { MASKT(pB0, pB1, NT - 1); partialSM(pB0, pB1, m_reg, mnB, alB); __syncthreads(); RESC(alB);
        finishSM(pB0, pB1, alB, l_reg, pa0, pa1, pa2, pa3); SBAR(); pv_tile<1>(o, vb0, pa0, pa1, pa2, pa3); }
    SBAR(); SEAM_K0();
    if (hi == 0) li_l[r32] = l_reg; asm volatile("s_waitcnt lgkmcnt(0)" ::: "memory");
    float rli[16];
#pragma unroll
    for (int r = 0; r < 16; ++r) rli[r] = __builtin_amdgcn_rcpf(li_l[crow(r, hi)]);
    bf16_t* Ow = cur.Q + (size_t)(wid * QBLK + 4 * hi) * QP + r32; const int goff = cur.goff;
#pragma unroll
    for (int r = 0; r < 16; ++r) { const int ro = ((r & 3) + 8 * (r >> 2)) * QP;
#pragma unroll
        for (int d0 = 0; d0 < 4; ++d0) { float v = o[d0][r] * rli[r];
            if (goff) { const float g = __uint_as_float((unsigned)Ow[goff + ro + d0 * 32] << 16); v *= __builtin_amdgcn_rcpf(1.f + __expf(-g)); }
            const float vn = dppf<0xB1>(v);
            if ((r32 & 1) == 0) *(unsigned*)(Ow + ro + d0 * 32) = cvtpk(v, vn); } }
    __syncthreads();
#undef RESC
#undef KBASE
#undef MASKT
#undef BB
#undef SEAM_K0
#undef HALF_STEP
}
#undef ROW
#undef VMW
#undef VMWN
#undef SLOAD_H
#undef SWRITE_HK
#undef SWRITE_HV
#undef SWRITE_H
#undef KSWZ
#undef SBAR
template <class Src> __device__ __forceinline__ void phase(char* lds, const Src& src, int wid) {
    Blk cur, nxt; if (!src(0, cur)) return;
    Seam S; prime(cur, lds, S, wid);
    for (int n = 0;; ++n) { const bool more = src(n + 1, nxt); if (!more) nxt = cur; block(cur, nxt, lds, S, wid); if (!more) break; cur = nxt; }
}
}

constexpr int NWAVES = 8;
#ifndef MK_LAUNCH_PER_PHASE
#define MK_LAUNCH_PER_PHASE 0
#endif
constexpr int N_PHASES = 12;

constexpr size_t KiB = 1u << 10, MiB = 1u << 20;
constexpr size_t WS_CTL = 0, CTL_ZERO_BYTES = 1 * MiB;
constexpr size_t WS_WIN0 = 1 * MiB, WS_WIN1 = WS_WIN0 + (size_t)N_IN * DM * 2;
constexpr size_t WS_WOUT0 = 20 * MiB, WS_WOUT1 = 23 * MiB;
constexpr size_t WS_WM1_0 = 26 * MiB, WS_WM1_1 = 34 * MiB, WS_WM2_0 = 42 * MiB, WS_WM2_1 = 50 * MiB;
constexpr size_t WS_WMKV = 58 * MiB;
constexpr size_t WS_PROJ = 60 * MiB;
constexpr size_t WS_XB = 204 * MiB;
constexpr size_t WS_SSQ = 236 * MiB;
constexpr size_t WS_AB = 245 * MiB;
constexpr size_t WS_MEMKV = 246 * MiB;
constexpr size_t WS_XSQ = 250 * MiB;
constexpr size_t WS_FCUM = 251 * MiB;
constexpr size_t WS_MSSQ = 251 * MiB + 512 * KiB;
constexpr size_t WS_MSQ = 251 * MiB + 768 * KiB;
constexpr size_t WS_END = 252 * MiB;
static_assert(WS_WIN1 + (size_t)N_IN * DM * 2 <= WS_WOUT0 && WS_PROJ + (size_t)MROWS * PW * 2 <= WS_XB && WS_SSQ + (size_t)36 * MROWS * 16 <= WS_AB, "d_ws map");
constexpr size_t DO_MEMB = 0;
constexpr int CW_BAR = 4096;

constexpr int LDS_BYTES = 155648;
constexpr int MISC_OFF = LDS_BYTES - 256;

#define GAS __attribute__((address_space(1)))
#define LAS __attribute__((address_space(3)))
typedef unsigned short bf16;
typedef unsigned v4u __attribute__((ext_vector_type(4)));
typedef float f32x4 __attribute__((ext_vector_type(4)));
typedef short bf16x8 __attribute__((ext_vector_type(8)));
typedef GAS unsigned gu32;
typedef GAS unsigned long long gu64;
#define RLX_AGENT __ATOMIC_RELAXED, __HIP_MEMORY_SCOPE_AGENT
#define LDS_WAIT() asm volatile("s_waitcnt lgkmcnt(0)" ::: "memory")
#define VM_WAIT() asm volatile("s_waitcnt vmcnt(0)" ::: "memory")
__device__ __forceinline__ unsigned long long rt() { return __builtin_amdgcn_s_memrealtime(); }
__device__ __forceinline__ unsigned f2bf(float f) { unsigned u = __builtin_bit_cast(unsigned, f); return (u + 0x7fffu + ((u >> 16) & 1u)) >> 16; }
__device__ __forceinline__ unsigned pk2(float lo, float hi) { return f2bf(lo) | (f2bf(hi) << 16); }

#define XB_TMO      128
#define XB_XCNT(j)  (256  + 64 * (j))
#define XB_XSUB(j)  (1280 + 64 * (j))
#define XB_XGEN(j)  (2304 + 64 * (j))
#define XB_TOP      3328
#define XB_TOPGEN   3392
#define XCD_BAR_WORDS 3456
#define XB_SPIN_CAP (1u << 18)

__device__ __forceinline__ unsigned xb_ld(unsigned* p)              { return __hip_atomic_load(p, __ATOMIC_RELAXED, __HIP_MEMORY_SCOPE_AGENT); }
__device__ __forceinline__ unsigned xb_add(unsigned* p, unsigned v) { return __hip_atomic_fetch_add(p, v, __ATOMIC_RELAXED, __HIP_MEMORY_SCOPE_AGENT); }
__device__ __forceinline__ unsigned xb_xcc_id() { return (unsigned)__builtin_amdgcn_s_getreg((3 << 11) | 20) & 0xFu; }
#define XB_SPIN(cond, bar) do { unsigned _sp = 0; while (cond) { __builtin_amdgcn_s_sleep(1); \
    if ((++_sp & 255u) == 0u) { if (xb_ld(&(bar)[XB_TMO])) break; if (_sp > XB_SPIN_CAP) { atomicAdd(&(bar)[XB_TMO], 1u); break; } } } } while (0)

struct XcdBarrier {
    unsigned* bar; unsigned x; int wv;
    volatile LAS unsigned* st;
};

__device__ __forceinline__ XcdBarrier xcd_barrier_post(unsigned* bar, volatile LAS unsigned* st) {
    XcdBarrier b; b.bar = bar; b.x = xb_xcc_id(); b.st = st;
    if (threadIdx.x == 0) (void)xb_add(&bar[XB_XCNT(b.x)], 1u);
    return b;
}
__device__ __forceinline__ void xcd_barrier_complete(unsigned* bar, unsigned x, unsigned& nloc, unsigned& nx) {
    const unsigned G = gridDim.x * gridDim.y * gridDim.z;
    unsigned sum, cnt, mine, sp = 0u;
    for (;;) {
        sum = 0u; cnt = 0u; mine = 0u;
#pragma unroll
        for (unsigned j = 0; j < 16; ++j) { const unsigned c = xb_ld(&bar[XB_XCNT(j)]); sum += c; cnt += (c > 0u) ? 1u : 0u; mine = (j == x) ? c : mine; }
        if (sum == G) break;
        __builtin_amdgcn_s_sleep(1);
        if ((++sp & 255u) == 0u) { if (xb_ld(&bar[XB_TMO])) break; if (sp > XB_SPIN_CAP) { atomicAdd(&bar[XB_TMO], 1u); break; } }
    }
    nloc = mine > 0u ? mine : 1u; nx = cnt > 0u ? cnt : 1u;
}

__device__ __forceinline__ void xcd_barrier(const XcdBarrier& b) {
    asm volatile("s_waitcnt vmcnt(0)" ::: "memory");
    __syncthreads();
    if (b.wv == 0 && lane_id_v() == 0) {
        unsigned* bar = b.bar;
        __builtin_amdgcn_s_waitcnt(0);
        unsigned nloc = b.st[0], nx = b.st[1];
        if (nloc == 0u) { xcd_barrier_complete(bar, b.x, nloc, nx); b.st[0] = nloc; b.st[1] = nx; }
        const unsigned old = xb_add(&bar[XB_XSUB(b.x)], 1u);
        const unsigned gen = old / nloc;
        if (old + 1u == (gen + 1u) * nloc) {
            __builtin_amdgcn_fence(__ATOMIC_RELEASE, "agent");
            asm volatile("s_waitcnt vmcnt(0)" ::: "memory");
            const unsigned og = xb_add(&bar[XB_TOP], 1u);
            const unsigned tg = og / nx;
            if (og + 1u == (tg + 1u) * nx) xb_add(&bar[XB_TOPGEN], 1u);
            else XB_SPIN(xb_ld(&bar[XB_TOPGEN]) == tg, bar);
            __builtin_amdgcn_fence(__ATOMIC_ACQUIRE, "agent");
            xb_add(&bar[XB_XGEN(b.x)], 1u);
            asm volatile("s_waitcnt vmcnt(0)" ::: "memory");
        } else {
            XB_SPIN(xb_ld(&bar[XB_XGEN(b.x)]) == gen, bar);
            __builtin_amdgcn_fence(__ATOMIC_ACQUIRE, "agent");
            asm volatile("s_waitcnt vmcnt(0)" ::: "memory");
        }
    }
    __syncthreads();
}


__device__ __forceinline__ float bflo(unsigned u) { return __builtin_bit_cast(float, u << 16); }
__device__ __forceinline__ float bfhi(unsigned u) { return __builtin_bit_cast(float, u & 0xffff0000u); }
typedef float f32x2_t __attribute__((ext_vector_type(2))); typedef __bf16 bf16x2_t __attribute__((ext_vector_type(2)));
__device__ __forceinline__ unsigned pkbf(float lo, float hi) { const f32x2_t v = {lo, hi}; const bf16x2_t b = __builtin_convertvector(v, bf16x2_t); return __builtin_bit_cast(unsigned, b); }
__device__ __forceinline__ float wave_sum(float v) { return add_xor32(add_xor16(row16_sum(v))); }
__device__ __forceinline__ float wave_max(float v) {
#pragma unroll
    for (int o = 1; o < 64; o <<= 1) v = fmaxf(v, __shfl_xor(v, o));
    return v;
}

struct Args { const float* in[20]; float* out; unsigned char* ws; int ph_lo, ph_hi, li, pad; };
enum { I_X = 0, I_MEM, I_MEMNW, I_WMKV, I_MEMKNW, I_NORM1, I_DNWIN, I_DNCONV, I_DNALOG, I_DNDT, I_DNONW, I_FOXWIN, I_FOXFB, I_FOXQNW, I_FOXKNW, I_MEMQNW, I_WOUT, I_NORM2, I_WM1, I_WM2 };

struct Frame {
    LAS unsigned char* lds;
    int G, bid, wv;
    const float* const* in; float* out; unsigned char* ws;
};


constexpr int CW_XCC = 32768, CW_BAD = 33792, CW_GRP = 65536;
struct GrpBar { unsigned* cnt; unsigned* tmo; int wv; bool on; };
__device__ __forceinline__ void grp_barrier(const GrpBar& gb, int seam) {
    asm volatile("s_waitcnt vmcnt(0)" ::: "memory");
    __syncthreads();
    if (gb.wv == 0 && lane_id_v() == 0) { unsigned* p = gb.cnt + seam * 64;
        (void)__hip_atomic_fetch_add(p, 1u, __ATOMIC_RELAXED, __HIP_MEMORY_SCOPE_AGENT);
        unsigned sp = 0;
        while (__hip_atomic_load(p, __ATOMIC_RELAXED, __HIP_MEMORY_SCOPE_AGENT) < 4u) { __builtin_amdgcn_s_sleep(1); if (++sp > (1u << 22)) { atomicAdd(gb.tmo, 1u); break; } }
        __builtin_amdgcn_fence(__ATOMIC_ACQUIRE, "agent");
        asm volatile("s_waitcnt vmcnt(0)" ::: "memory"); }
    __syncthreads();
}
struct Tix { int tid, lane, wave; };
__device__ __forceinline__ int lane_id() { return lane_id_v(); }
__device__ __forceinline__ Tix tix(int wv) { Tix t; t.lane = lane_id(); t.wave = wv; t.tid = wv * 64 + t.lane; return t; }
struct TSeg { const float* W; int K, ldw, src0, ncols; bf16* WT; int dst0; const float* scale; };
__device__ __forceinline__ TSeg get_seg(const Frame& F, int s) {
    TSeg t; t.scale = nullptr; t.src0 = 0; t.dst0 = 0;
    if (s < 12) {
        const int l = s / 6, j = s % 6;
        t.W = l ? F.in[I_FOXWIN] : F.in[I_DNWIN]; t.K = DM; t.ldw = l ? FOX_IN : DN_IN; t.WT = (bf16*)(F.ws + (l ? WS_WIN1 : WS_WIN0)); t.scale = F.in[I_NORM1] + l * DM;
        const int qm0 = l ? 4104 : 4112, nsc = l ? 8 : 16;
        t.ncols = 1024;
        if (j == 0) { t.src0 = 1024; t.dst0 = PC_K; } else if (j == 1) { t.src0 = 2048; t.dst0 = PC_V; } else if (j == 2) { t.src0 = 3072; t.dst0 = PC_Z; }
        else if (j == 3) { t.src0 = 0; t.dst0 = PC_Q; } else if (j == 4) { t.src0 = qm0; t.dst0 = PC_QM; t.ncols = 512; } else { t.src0 = 4096; t.dst0 = PC_AB; t.ncols = nsc; }
    } else if (s < 14) { const int l = s - 12; t.W = F.in[I_WOUT] + (size_t)l * OUT_IN * DM; t.K = OUT_IN; t.ldw = DM; t.ncols = DM; t.WT = (bf16*)(F.ws + (l ? WS_WOUT1 : WS_WOUT0)); }
    else if (s < 16) { const int l = s - 14; t.W = F.in[I_WM1] + (size_t)l * DM * FF; t.K = DM; t.ldw = FF; t.ncols = FF; t.WT = (bf16*)(F.ws + (l ? WS_WM1_1 : WS_WM1_0)); t.scale = F.in[I_NORM2] + l * DM; }
    else if (s < 18) { const int l = s - 16; t.W = F.in[I_WM2] + (size_t)l * FF * DM; t.K = FF; t.ldw = DM; t.ncols = DM; t.WT = (bf16*)(F.ws + (l ? WS_WM2_1 : WS_WM2_0)); }
    else { t.W = F.in[I_WMKV]; t.K = DM; t.ldw = DM; t.ncols = DM; t.WT = (bf16*)(F.ws + WS_WMKV); t.scale = F.in[I_MEMNW]; }
    return t;
}
__device__ __forceinline__ int seg_items(const TSeg& t) { return (t.K / 64) * ((t.ncols + 63) / 64); }
__device__ __forceinline__ void tr_load(const TSeg& t, int item, int lane, f32x4 (&v)[16]) {
    const int nblk = (t.ncols + 63) / 64, kb = item / nblk, nb = item - kb * nblk, k0 = 64 * kb, n0 = 64 * nb;
    const int n4 = (lane & 15) * 4, kr = lane >> 4; const bool ok = (n0 + n4) < t.ncols;
    const float* p = t.W + (size_t)(k0 + kr) * t.ldw + t.src0 + n0 + n4;
#pragma unroll
    for (int i = 0; i < 16; ++i) v[i] = ok ? *(const f32x4*)(p + (size_t)(4 * i) * t.ldw) : (f32x4){0.f, 0.f, 0.f, 0.f};
}
__device__ __forceinline__ void tr_store(const TSeg& t, int item, int lane, const f32x4 (&v)[16], LAS float* scr) {
    const int nblk = (t.ncols + 63) / 64, kb = item / nblk, nb = item - kb * nblk, k0 = 64 * kb, n0 = 64 * nb;
    const int n4 = (lane & 15) * 4, kr = lane >> 4;
#pragma unroll
    for (int i = 0; i < 16; ++i) *(LAS f32x4*)(scr + (4 * i + kr) * 68 + n4) = v[i];
    LDS_WAIT(); asm volatile("" ::: "memory");
    const int c = lane & 7; f32x4 s0 = {1.f, 1.f, 1.f, 1.f}, s1 = s0;
    if (t.scale) { s0 = *(const f32x4*)(t.scale + k0 + 8 * c); s1 = *(const f32x4*)(t.scale + k0 + 8 * c + 4); }
#pragma unroll
    for (int j = 0; j < 8; ++j) { const int n = (lane >> 3) + 8 * j; const LAS float* q = scr + (8 * c) * 68 + n;
        v4u o; o.x = pkbf(q[0 * 68] * s0[0], q[1 * 68] * s0[1]); o.y = pkbf(q[2 * 68] * s0[2], q[3 * 68] * s0[3]); o.z = pkbf(q[4 * 68] * s1[0], q[5 * 68] * s1[1]); o.w = pkbf(q[6 * 68] * s1[2], q[7 * 68] * s1[3]);
        if (n0 + n < t.ncols) *(v4u*)(t.WT + (size_t)(t.dst0 + n0 + n) * t.K + k0 + 8 * c) = o; }
    LDS_WAIT(); asm volatile("" ::: "memory");
}
template <int NR> __device__ __forceinline__ void rows_to_bf16(int lane, const float* x, bf16* o, float* sq) {
    f32x4 v[NR][4];
#pragma unroll
    for (int r = 0; r < NR; ++r)
#pragma unroll
        for (int j = 0; j < 4; ++j) v[r][j] = ((const f32x4*)(x + (size_t)r * DM))[lane + 64 * j];
#pragma unroll
    for (int r = 0; r < NR; ++r) { float s = 0.f;
#pragma unroll
        for (int j = 0; j < 4; ++j) s += (v[r][j].x * v[r][j].x + v[r][j].y * v[r][j].y) + (v[r][j].z * v[r][j].z + v[r][j].w * v[r][j].w);
        s = wave_sum(s);
        unsigned long long* o8 = (unsigned long long*)(o + (size_t)r * DM) + lane;
#pragma unroll
        for (int j = 0; j < 4; ++j) o8[64 * j] = (unsigned long long)pkbf(v[r][j].x, v[r][j].y) | ((unsigned long long)pkbf(v[r][j].z, v[r][j].w) << 32);
        if (lane < 16) sq[(size_t)r * 16 + lane] = lane == 0 ? s : 0.f; }
}
template <int S0, int S1> __device__ __forceinline__ void convert_weights(const Frame& F, LAS float* scr, int lane, int gw, int NGW, int base) {
#pragma unroll
    for (int s = S0; s < S1; ++s) {
        const TSeg t = get_seg(F, s); const int n = seg_items(t);
        int it = gw - (base % NGW); if (it < 0) it += NGW;
        for (; it < n; it += NGW) { f32x4 v[16]; tr_load(t, it, lane, v); tr_store(t, it, lane, v, scr); }
        base += n;
    }
}
__device__ __forceinline__ void p0_prologue(const Frame& F) {
    const Tix T = tix(F.wv);
    LAS float* scr = (LAS float*)(F.lds + T.wave * 17408);
    const int gw = F.bid * NWAVES + T.wave, NGW = F.G * NWAVES;
    for (int m = gw * 4; m < MROWS; m += NGW * 4) rows_to_bf16<4>(T.lane, F.in[I_X] + (size_t)m * DM, (bf16*)(F.ws + WS_XB) + (size_t)m * DM, (float*)(F.ws + WS_XSQ) + (size_t)m * 16);
    for (int m = gw; m < MMEM; m += NGW) rows_to_bf16<1>(T.lane, F.in[I_MEM] + (size_t)m * DM, (bf16*)((unsigned char*)F.out + DO_MEMB) + (size_t)m * DM, (float*)(F.ws + WS_MSQ) + (size_t)m * 16);
    convert_weights<0, 6>(F, scr, T.lane, gw, NGW, 0);
    convert_weights<18, 19>(F, scr, T.lane, gw, NGW, 1168);
}

typedef short dn_bf16x8 __attribute__((ext_vector_type(8)));
typedef unsigned dn_u32x2 __attribute__((ext_vector_type(2)));
__device__ __forceinline__ f32x4 mfma16(dn_bf16x8 a, dn_bf16x8 b, f32x4 c) { return __builtin_amdgcn_mfma_f32_16x16x32_bf16(a, b, c, 0, 0, 0); }
__device__ __forceinline__ f32x4 mfma4(float a, float b, f32x4 c) { return __builtin_amdgcn_mfma_f32_16x16x4f32(a, b, c, 0, 0, 0); }
__device__ __forceinline__ dn_bf16x8 pack8f(f32x4 x, f32x4 y) { v4u w; w.x = pkbf(x[0], x[1]); w.y = pkbf(x[2], x[3]); w.z = pkbf(y[0], y[1]); w.w = pkbf(y[2], y[3]); return __builtin_bit_cast(dn_bf16x8, w); }
__device__ __forceinline__ dn_u32x2 pack4f(f32x4 x) { dn_u32x2 w; w.x = pkbf(x[0], x[1]); w.y = pkbf(x[2], x[3]); return w; }
__device__ __forceinline__ unsigned short bf1(float x) { return (unsigned short)(pkbf(x, 0.f) & 0xffffu); }
constexpr size_t DO_QKS = 4 * MiB, DO_HALO = 20 * MiB, DO_EGL = 27 * MiB;
constexpr int P_RAW = 0, P_GB = 51712, P_QH = 53248, P_KH = 70656, P_VBT = 88064, P_KBGT = 106496, P_QKL = 124928, P_END = 134144;
constexpr int P_AT = 0, P_TB = 17408, P_PS = 26624, P_PS2 = 29184;
struct DnPre { v4u P[7]; v4u Z[2]; float ga, gb; f32x4 cw[3][4]; };
__device__ __forceinline__ void dn_prep_load(const Frame& F, int u, DnPre& R) {
    const Tix T = tix(F.wv); const int tid = T.tid, lane = T.lane;
    const int bh = u >> 5, c = u & 31, b = bh >> 3, h = bh & 7; const size_t row0 = (size_t)b * SEQ + c * 64; const int gch = b * 32 + c;
    const bf16* proj = (const bf16*)(F.ws + WS_PROJ); const float* AB = (const float*)(F.ws + WS_AB); const bf16* halo = (const bf16*)((unsigned char*)F.out + DO_HALO);
#pragma unroll
    for (int j = 0; j < 7; ++j) { const int id = tid + 512 * j; v4u val = {0u, 0u, 0u, 0u};
        if (id < 67 * 48) { const int r = id / 48, rem = id - r * 48, seg = rem >> 4, ch = rem & 15;
            const int col = (seg == 0 ? PC_Q : seg == 1 ? PC_K : PC_V) + h * HD + ch * 8;
            if (r >= 3) val = *(const v4u*)(proj + (row0 + r - 3) * PW + col);
            else if (c > 0) val = *(const v4u*)(halo + ((size_t)(gch - 1) * 3 + r) * PW + col); }
        R.P[j] = val; }
    R.ga = AB[(row0 + lane) * 16 + h]; R.gb = AB[(row0 + lane) * 16 + 8 + h];
    { const bf16* zp = proj + (row0 + (tid >> 3)) * PW + PC_Z + h * HD + (tid & 7) * 16; R.Z[0] = *(const v4u*)zp; R.Z[1] = *(const v4u*)(zp + 8); }
    const float* convw = F.in[I_DNCONV]; const int c4 = lane & 31;
#pragma unroll
    for (int seg = 0; seg < 3; ++seg)
#pragma unroll
        for (int j = 0; j < 4; ++j) R.cw[seg][j] = *(const f32x4*)(convw + j * 3072 + seg * 1024 + h * HD + 4 * c4);
}
__device__ __forceinline__ void dn_prep_unit(const Frame& F, int u, int u_next, DnPre& R) {
    const Tix T = tix(F.wv); const int tid = T.tid, lane = T.lane, wave = T.wave, m = lane & 15, g = lane >> 4;
    const int bh = u >> 5, c = u & 31, b = bh >> 3, h = bh & 7; const size_t row0 = (size_t)b * SEQ + c * 64;
    bf16* proj = (bf16*)(F.ws + WS_PROJ);
    bf16* xbimg = (bf16*)(F.ws + WS_XB) + (size_t)u * 8192; bf16* qks = (bf16*)((unsigned char*)F.out + DO_QKS) + (size_t)u * 4096; float* egl = (float*)((unsigned char*)F.out + DO_EGL);
    LAS unsigned char* L = F.lds; LAS float* GB = (LAS float*)(L + P_GB);
#pragma unroll
    for (int j = 0; j < 7; ++j) { const int id = tid + 512 * j;
        if (id < 67 * 48) { const int r = id / 48, rem = id - r * 48, seg = rem >> 4, ch = rem & 15; *(LAS v4u*)(L + P_RAW + r * 768 + seg * 256 + ch * 16) = R.P[j]; } }
    if (wave == 0) { const float a = R.ga, bb = R.gb;
        const float x = a + F.in[I_DNDT][h], sp = fmaxf(x, 0.f) + log1pf(__expf(-fabsf(x)));
        const float gt = -__expf(F.in[I_DNALOG][h]) * sp, beta = __builtin_amdgcn_rcpf(1.f + __expf(-bb));
        float gc = gt;
#pragma unroll
        for (int o = 1; o < 64; o <<= 1) { const float t = __shfl_up(gc, o); if (lane >= o) gc += t; }
        const float gl = __shfl(gc, 63);
        GB[lane] = gc; GB[64 + lane] = beta; GB[128 + lane] = beta * __expf(gc); GB[192 + lane] = __expf(gl - gc); GB[256 + lane] = __expf(gc);
        if (lane == 0) egl[u] = __expf(gl); }
    f32x4 cw[3][4];
#pragma unroll
    for (int seg = 0; seg < 3; ++seg)
#pragma unroll
        for (int j = 0; j < 4; ++j) cw[seg][j] = R.cw[seg][j];
    { const float* onw = F.in[I_DNONW] + (tid & 7) * 16; const unsigned zz[8] = {R.Z[0].x, R.Z[0].y, R.Z[0].z, R.Z[0].w, R.Z[1].x, R.Z[1].y, R.Z[1].z, R.Z[1].w}; unsigned ow[8];
#pragma unroll
      for (int q = 0; q < 8; ++q) { const float za = bflo(zz[q]), zb = bfhi(zz[q]);
          ow[q] = pkbf(za * __builtin_amdgcn_rcpf(1.f + __expf(-za)) * onw[2 * q], zb * __builtin_amdgcn_rcpf(1.f + __expf(-zb)) * onw[2 * q + 1]); }
      bf16* zp = proj + (row0 + (tid >> 3)) * PW + PC_Z + h * HD + (tid & 7) * 16;
      *(v4u*)zp = (v4u){ow[0], ow[1], ow[2], ow[3]}; *(v4u*)(zp + 8) = (v4u){ow[4], ow[5], ow[6], ow[7]}; }
    __syncthreads();
    if (u_next >= 0) dn_prep_load(F, u_next, R);
    { const int hf = lane >> 5, c4 = lane & 31;
#pragma unroll
      for (int jj = 0; jj < 12; ++jj) { constexpr int dummy_ = 0; (void)dummy_; const int seg = jj >> 2;
        const int wi = wave + 8 * jj, i = 2 * (wi & 31) + hf;
        f32x4 y = {0.f, 0.f, 0.f, 0.f};
#pragma unroll
        for (int j = 0; j < 4; ++j) { const f32x4 w = cw[seg][j];
            const dn_u32x2 xx = *(const LAS dn_u32x2*)(L + P_RAW + (i + j) * 768 + seg * 256 + c4 * 8);
            y[0] += w[0] * bflo(xx.x); y[1] += w[1] * bfhi(xx.x); y[2] += w[2] * bflo(xx.y); y[3] += w[3] * bfhi(xx.y); }
        f32x4 s;
#pragma unroll
        for (int e = 0; e < 4; ++e) s[e] = y[e] * __builtin_amdgcn_rcpf(1.f + __expf(-y[e]));
        if (seg < 2) { float ss = (s[0] * s[0] + s[1] * s[1]) + (s[2] * s[2] + s[3] * s[3]);
            ss = add_xor16(row16_sum(ss));
            const float r = rsqrtf(ss + EPS) * (seg == 0 ? QSCALE : 1.f);
            s = s * r;
            *(LAS dn_u32x2*)(L + (seg == 0 ? P_QH : P_KH) + i * 272 + c4 * 8) = pack4f(s);
            if (seg == 0) { const int cc = c4 & 7, p0 = cc < 4 ? 8 * cc : 8 * (cc - 4) + 4;
                *(dn_u32x2*)(proj + (row0 + i) * PW + PC_Q + h * HD + 32 * (c4 >> 3) + p0) = pack4f(s * GB[256 + i]); }
            else { const float bge = GB[128 + i];
#pragma unroll
                for (int e = 0; e < 4; ++e) *(LAS unsigned short*)(L + P_KBGT + (4 * c4 + e) * 144 + i * 2) = bf1(s[e] * bge); } }
        else { const float be = GB[64 + i];
#pragma unroll
            for (int e = 0; e < 4; ++e) *(LAS unsigned short*)(L + P_VBT + (4 * c4 + e) * 144 + i * 2) = bf1(s[e] * be); } } }
    __syncthreads();
    LAS float* AT = (LAS float*)(L + P_AT);
#pragma unroll
    for (int q = 0; q < 2; ++q) { const int tt = wave + 8 * q, it = tt >> 2, jt = tt & 3;
        f32x4 kk = {0.f, 0.f, 0.f, 0.f}, qk = {0.f, 0.f, 0.f, 0.f};
        if (jt <= it) {
#pragma unroll
            for (int kq = 0; kq < 4; ++kq) { const dn_bf16x8 bk = *(const LAS dn_bf16x8*)(L + P_KH + (16 * jt + m) * 272 + (32 * kq + 8 * g) * 2);
                const dn_bf16x8 ak = *(const LAS dn_bf16x8*)(L + P_KH + (16 * it + m) * 272 + (32 * kq + 8 * g) * 2), aq = *(const LAS dn_bf16x8*)(L + P_QH + (16 * it + m) * 272 + (32 * kq + 8 * g) * 2);
                kk = mfma16(ak, bk, kk); qk = mfma16(aq, bk, qk); } }
        const int j = 16 * jt + m, jl = j & 31, p = jl < 16 ? 8 * (jl >> 2) + (jl & 3) : 8 * ((jl - 16) >> 2) + 4 + (jl & 3);
        const float gcj = GB[j];
#pragma unroll
        for (int r = 0; r < 4; ++r) { const int i = 16 * it + 4 * g + r; const float dec = i >= j ? __expf(GB[i] - gcj) : 0.f;
            AT[i * 68 + j] = i > j ? GB[64 + i] * kk[r] * dec : 0.f;
            *(LAS unsigned short*)(L + P_QKL + i * 144 + (32 * (j >> 5) + p) * 2) = bf1(qk[r] * dec); } }
    __syncthreads();
    if (wave >= 4) { const int t4 = tid - 256;
        for (int id = t4; id < 1024; id += 256) { const int k = id >> 3, sp = (id >> 2) & 1, gg = id & 3; float o8[8];
#pragma unroll
            for (int j = 0; j < 8; ++j) { const int cc = 32 * sp + (j < 4 ? 4 * gg + j : 16 + 4 * gg + j - 4);
                o8[j] = bflo((unsigned)*(const LAS unsigned short*)(L + P_KH + cc * 272 + k * 2)) * GB[192 + cc]; }
            v4u w; w.x = pkbf(o8[0], o8[1]); w.y = pkbf(o8[2], o8[3]); w.z = pkbf(o8[4], o8[5]); w.w = pkbf(o8[6], o8[7]);
            *(v4u*)(proj + (row0 + (k >> 1)) * PW + PC_K + h * HD + (k & 1) * 64 + 32 * sp + 8 * gg) = w; }
        for (int id = t4; id < 512; id += 256) { const int i = id >> 3, j8 = (id & 7) * 8;
            *(v4u*)(qks + i * 64 + j8) = *(const LAS v4u*)(L + P_QKL + i * 144 + j8 * 2); } }
    if (wave == 0) { const int bb = g, j = m; float X[16];
        X[0] = j == 0 ? 1.f : 0.f;
#pragma unroll
        for (int i = 1; i < 16; ++i) { const LAS float* Lr = AT + (16 * bb + i) * 68 + 16 * bb; float Lv[16];
#pragma unroll
            for (int q = 0; q < (i + 3) / 4; ++q) { const f32x4 t = *(const LAS f32x4*)(Lr + 4 * q); Lv[4 * q] = t[0]; Lv[4 * q + 1] = t[1]; Lv[4 * q + 2] = t[2]; Lv[4 * q + 3] = t[3]; }
            float acc = i == j ? 1.f : 0.f;
#pragma unroll
            for (int mm = 0; mm < i; ++mm) acc -= Lv[mm] * X[mm];
            X[i] = acc; }
#pragma unroll
        for (int i = 0; i < 16; ++i) AT[(16 * bb + i) * 68 + 16 * bb + j] = X[i]; }
    __syncthreads();
    if (wave < 2) { const int lo = 2 * wave, hi = 2 * wave + 1; LAS float* PS = (LAS float*)(L + P_PS) + wave * 320;
        f32x4 acc = {0.f, 0.f, 0.f, 0.f};
#pragma unroll
        for (int s = 0; s < 4; ++s) acc = mfma4(AT[(16 * hi + m) * 68 + 16 * lo + 4 * s + g], AT[(16 * lo + 4 * s + g) * 68 + 16 * lo + m], acc);
#pragma unroll
        for (int r = 0; r < 4; ++r) PS[(4 * g + r) * 20 + m] = acc[r];
        LDS_WAIT();
        f32x4 acc2 = {0.f, 0.f, 0.f, 0.f};
#pragma unroll
        for (int s = 0; s < 4; ++s) acc2 = mfma4(AT[(16 * hi + m) * 68 + 16 * hi + 4 * s + g], PS[(4 * s + g) * 20 + m], acc2);
#pragma unroll
        for (int r = 0; r < 4; ++r) AT[(16 * hi + 4 * g + r) * 68 + 16 * lo + m] = -acc2[r]; }
    __syncthreads();
    { LAS float* PS2 = (LAS float*)(L + P_PS2); const int ti = (wave >> 1) & 1, tj = wave & 1;
      if (wave < 4) { f32x4 acc = {0.f, 0.f, 0.f, 0.f};
#pragma unroll
          for (int s = 0; s < 8; ++s) acc = mfma4(AT[(32 + 16 * ti + m) * 68 + 4 * s + g], AT[(4 * s + g) * 68 + 16 * tj + m], acc);
#pragma unroll
          for (int r = 0; r < 4; ++r) PS2[(16 * ti + 4 * g + r) * 36 + 16 * tj + m] = acc[r]; }
      __syncthreads();
      if (wave < 4) { f32x4 acc = {0.f, 0.f, 0.f, 0.f};
#pragma unroll
          for (int s = 0; s < 8; ++s) acc = mfma4(AT[(32 + 16 * ti + m) * 68 + 32 + 4 * s + g], PS2[(4 * s + g) * 36 + 16 * tj + m], acc);
#pragma unroll
          for (int r = 0; r < 4; ++r) AT[(32 + 16 * ti + 4 * g + r) * 68 + 16 * tj + m] = -acc[r]; } }
    __syncthreads();
    { const int i = tid >> 3, j0 = (tid & 7) * 8; const f32x4 t0 = *(const LAS f32x4*)(AT + i * 68 + j0), t1 = *(const LAS f32x4*)(AT + i * 68 + j0 + 4);
      v4u w; w.x = pkbf(t0[0], t0[1]); w.y = pkbf(t0[2], t0[3]); w.z = pkbf(t1[0], t1[1]); w.w = pkbf(t1[2], t1[3]);
      *(LAS v4u*)(L + P_TB + i * 144 + j0 * 2) = w; }
    __syncthreads();
#pragma unroll
    for (int q = 0; q < 8; ++q) { const int tt = wave + 8 * q; f32x4 acc = {0.f, 0.f, 0.f, 0.f};
        if (tt < 32) { const int ct = tt >> 3, nt = tt & 7;
#pragma unroll
            for (int sp = 0; sp < 2; ++sp) acc = mfma16(*(const LAS dn_bf16x8*)(L + P_TB + (16 * ct + m) * 144 + (32 * sp + 8 * g) * 2), *(const LAS dn_bf16x8*)(L + P_VBT + (16 * nt + m) * 144 + (32 * sp + 8 * g) * 2), acc);
            const int v = 16 * nt + m;
            *(dn_u32x2*)(proj + (row0 + (v >> 1)) * PW + PC_V + h * HD + (v & 1) * 64 + 16 * ct + 4 * g) = pack4f(acc); }
        else { const int t2 = tt - 32, kt = t2 >> 2, ct = t2 & 3;
#pragma unroll
            for (int sp = 0; sp < 2; ++sp) acc = mfma16(*(const LAS dn_bf16x8*)(L + P_KBGT + (16 * kt + m) * 144 + (32 * sp + 8 * g) * 2), *(const LAS dn_bf16x8*)(L + P_TB + (16 * ct + m) * 144 + (32 * sp + 8 * g) * 2), acc);
            *(dn_u32x2*)(xbimg + (16 * ct + m) * 128 + 32 * (kt >> 1) + 8 * g + 4 * (kt & 1)) = pack4f(-acc); } }
    __syncthreads();
}
constexpr int S_WN = 0, S_QG = 17408, S_KDT = 34816, S_QKM = 53248, S_UT = 62464, S_OB = 80896, S_PSQ = 114688, S_ONW = 116736, S_Z = 117248, S_END = 152064;
static_assert(S_END <= MISC_OFF, "scan LDS map");
__device__ __forceinline__ void dn_scan_unit(const Frame& F, int bh) {
    const Tix T = tix(F.wv); const int tid = T.tid, lane = T.lane, wave = T.wave, m = lane & 15, g = lane >> 4, n0 = 32 * wave;
    const int b = bh >> 3, h = bh & 7;
    bf16* proj = (bf16*)(F.ws + WS_PROJ); const bf16* xbi = (const bf16*)(F.ws + WS_XB); const bf16* qks = (const bf16*)((unsigned char*)F.out + DO_QKS); const float* egl = (const float*)((unsigned char*)F.out + DO_EGL);
    LAS unsigned char* L = F.lds;
    LAS float* OB = (LAS float*)(L + S_OB);
    constexpr int NC = SEQ / 64;
#define WGBAR() do { asm volatile("s_waitcnt lgkmcnt(0)" ::: "memory"); __builtin_amdgcn_s_barrier(); asm volatile("" ::: "memory"); } while (0)
    if (wave >= 4) {
        const int ht = tid - 256;
        const unsigned lo_lin = (unsigned)ht * 16u;
        const unsigned lo_qg = (unsigned)(((ht >> 4) * PW + (ht & 15) * 8) * 2);
        const unsigned lo_kv = (unsigned)(((ht >> 4) * PW + ((ht >> 3) & 1) * 64 + (ht & 7) * 8) * 2);
        const unsigned ld_a = (unsigned)((ht >> 4) * 272 + (ht & 15) * 16), ld_b = (unsigned)((ht >> 3) * 144 + (ht & 7) * 16);
        const unsigned lo_fin = (unsigned)(((ht >> 2) * PW + (ht & 3) * 32) * 2);
        v4u RP[12], RQ[10];
#define DN_LOAD_P(cc) do { const size_t r0_ = (size_t)b * SEQ + (cc) * 64; const size_t u_ = (size_t)bh * 32 + (cc);               \
        _Pragma("unroll") for (int j_ = 0; j_ < 4; ++j_) {                                                                                                \
            RP[j_] = *(const v4u*)((const char*)(xbi + u_ * 8192 + 2048 * j_) + lo_lin);                                                                    \
            RP[4 + j_] = *(const v4u*)((const char*)(proj + (r0_ + 16 * j_) * PW + PC_Q + h * HD) + lo_qg);                                                 \
            RP[8 + j_] = *(const v4u*)((const char*)(proj + (r0_ + 16 * j_) * PW + PC_V + h * HD) + lo_kv); } } while (0)
#define DN_LOAD_Q(cc) do { const size_t r0_ = (size_t)b * SEQ + (cc) * 64; const size_t u_ = (size_t)bh * 32 + (cc);     \
        _Pragma("unroll") for (int j_ = 0; j_ < 4; ++j_) {                                                                                                \
            RQ[j_] = *(const v4u*)((const char*)(proj + (r0_ + 16 * j_) * PW + PC_K + h * HD) + lo_kv);                                                     \
            RQ[4 + j_] = *(const v4u*)((const char*)(proj + (r0_ + 16 * j_) * PW + PC_Z + h * HD) + lo_qg); }                                               \
        _Pragma("unroll") for (int j_ = 0; j_ < 2; ++j_) RQ[8 + j_] = *(const v4u*)((const char*)(qks + u_ * 4096 + 2048 * j_) + lo_lin); } while (0)
#define DN_WRITE_P() do { _Pragma("unroll") for (int j_ = 0; j_ < 4; ++j_) {                                                                               \
            *(LAS v4u*)(L + S_WN + ld_a + j_ * 4352) = RP[j_]; *(LAS v4u*)(L + S_QG + ld_a + j_ * 4352) = RP[4 + j_]; *(LAS v4u*)(L + S_UT + ld_b + j_ * 4608) = RP[8 + j_]; } } while (0)
#define DN_WRITE_Q(cc) do { _Pragma("unroll") for (int j_ = 0; j_ < 4; ++j_) { *(LAS v4u*)(L + S_KDT + ld_b + j_ * 4608) = RQ[j_];                         \
            *(LAS v4u*)(L + S_Z + ((cc) & 1) * 17408 + ld_a + j_ * 4352) = RQ[4 + j_]; }                                                                    \
        _Pragma("unroll") for (int j_ = 0; j_ < 2; ++j_) *(LAS v4u*)(L + S_QKM + ld_b + j_ * 4608) = RQ[8 + j_]; } while (0)
#define DN_FINAL(cc) do { const int fr_ = ht >> 2, fc_ = (ht & 3) * 32; float ss_ = 0.f;     \
        _Pragma("unroll") for (int p_ = 0; p_ < 8; ++p_) { const f32x4 o_ = *(const LAS f32x4*)(OB + fr_ * 132 + fc_ + 4 * p_);                              \
            ss_ += (o_[0] * o_[0] + o_[1] * o_[1]) + (o_[2] * o_[2] + o_[3] * o_[3]); }                                                                     \
        ss_ += dppf<0xB1>(ss_); ss_ += dppf<0x4E>(ss_);                                                                                                     \
        const float rn_ = rsqrtf(ss_ * (1.f / 128.f) + EPS);                                                                                               \
        bf16* dst_ = (bf16*)((char*)(proj + ((size_t)b * SEQ + (cc) * 64) * PW + PC_Q + h * HD) + lo_fin);              \
        _Pragma("unroll") for (int p_ = 0; p_ < 4; ++p_) {                                                                                                 \
            const f32x4 oa_ = *(const LAS f32x4*)(OB + fr_ * 132 + fc_ + 8 * p_), ob_ = *(const LAS f32x4*)(OB + fr_ * 132 + fc_ + 8 * p_ + 4);             \
            const v4u z_ = *(const LAS v4u*)(L + S_Z + ((cc) & 1) * 17408 + fr_ * 272 + (fc_ + 8 * p_) * 2);                                                \
            v4u w_; w_.x = pkbf(oa_[0] * rn_ * bflo(z_.x), oa_[1] * rn_ * bfhi(z_.x)); w_.y = pkbf(oa_[2] * rn_ * bflo(z_.y), oa_[3] * rn_ * bfhi(z_.y));   \
            w_.z = pkbf(ob_[0] * rn_ * bflo(z_.z), ob_[1] * rn_ * bfhi(z_.z)); w_.w = pkbf(ob_[2] * rn_ * bflo(z_.w), ob_[3] * rn_ * bfhi(z_.w));           \
            *(v4u*)(dst_ + 8 * p_) = w_; } } while (0)
        DN_LOAD_P(0); DN_LOAD_Q(0); DN_WRITE_P(); DN_WRITE_Q(0); DN_LOAD_P(1); DN_LOAD_Q(1);
        WGBAR();
        for (int c = 0; c < NC; ++c) {
            if (c > 0) { DN_FINAL(c - 1); DN_WRITE_Q(c); if (c + 1 < NC) DN_LOAD_Q(c + 1); }
            WGBAR();
            if (c + 1 < NC) { DN_WRITE_P(); if (c + 2 < NC) DN_LOAD_P(c + 2); }
            WGBAR();
        }
        DN_FINAL(NC - 1);
#undef DN_LOAD_P
#undef DN_LOAD_Q
#undef DN_WRITE_P
#undef DN_WRITE_Q
#undef DN_FINAL
    } else {
        f32x4 Sacc[2][8];
#pragma unroll
        for (int kt = 0; kt < 8; ++kt) { Sacc[0][kt] = (f32x4){0.f, 0.f, 0.f, 0.f}; Sacc[1][kt] = (f32x4){0.f, 0.f, 0.f, 0.f}; }
        const unsigned* eglu = (const unsigned*)egl + (size_t)bh * 32;
        float eg_next = __uint_as_float(__hip_atomic_load(eglu, __ATOMIC_RELAXED, __HIP_MEMORY_SCOPE_AGENT));
        const LAS unsigned char* fa = L + m * 272 + g * 16;
        const LAS unsigned char* fb = L + m * 144 + g * 16;
#define SBAR() __builtin_amdgcn_sched_barrier(0)
#define LD_A(X, base, ct) do { _Pragma("unroll") for (int s_ = 0; s_ < 4; ++s_) X[s_] = *(const LAS dn_bf16x8*)(fa + (base) + (ct) * 4352 + s_ * 64); } while (0)
#define LD_B(X, base, i0) do { _Pragma("unroll") for (int s_ = 0; s_ < 4; ++s_) X[s_] = *(const LAS dn_bf16x8*)(fb + (base) + ((i0) + (s_ >> 1)) * 2304 + (s_ & 1) * 64); } while (0)
        WGBAR();
        for (int c = 0; c < NC; ++c) {
            const float eg = eg_next;
            if (c + 1 < NC) eg_next = __uint_as_float(__hip_atomic_load(eglu + c + 1, __ATOMIC_RELAXED, __HIP_MEMORY_SCOPE_AGENT));
            dn_bf16x8 SB[2][4], X0[4], X1[4];
            LD_A(X0, S_WN, 0);
#pragma unroll
            for (int sl = 0; sl < 2; ++sl)
#pragma unroll
                for (int s = 0; s < 4; ++s) SB[sl][s] = pack8f(Sacc[sl][2 * s], Sacc[sl][2 * s + 1]);
            f32x4 VN[2][4], O[2][4];
#pragma unroll
            for (int ct = 0; ct < 4; ++ct)
#pragma unroll
                for (int sl = 0; sl < 2; ++sl) { const dn_u32x2 uu = *(const LAS dn_u32x2*)(L + S_UT + (n0 + 16 * sl + m) * 144 + (16 * ct + 4 * g) * 2);
                    VN[sl][ct] = (f32x4){bflo(uu.x), bfhi(uu.x), bflo(uu.y), bfhi(uu.y)}; O[sl][ct] = (f32x4){0.f, 0.f, 0.f, 0.f}; }
#pragma unroll
            for (int ct = 0; ct < 4; ++ct) {
                SBAR(); LD_A(X1, S_QG, ct); SBAR();
#pragma unroll
                for (int s = 0; s < 4; ++s) { VN[0][ct] = mfma16(X0[s], SB[0][s], VN[0][ct]); VN[1][ct] = mfma16(X0[s], SB[1][s], VN[1][ct]); }
                SBAR(); if (ct < 3) LD_A(X0, S_WN, ct + 1); SBAR();
#pragma unroll
                for (int s = 0; s < 4; ++s) { O[0][ct] = mfma16(X1[s], SB[0][s], O[0][ct]); O[1][ct] = mfma16(X1[s], SB[1][s], O[1][ct]); }
            }
            dn_bf16x8 VNB[2][2];
#pragma unroll
            for (int sl = 0; sl < 2; ++sl)
#pragma unroll
                for (int sp = 0; sp < 2; ++sp) VNB[sl][sp] = pack8f(VN[sl][2 * sp], VN[sl][2 * sp + 1]);
            WGBAR();
            SBAR(); LD_B(X0, S_QKM, 0); LD_B(X1, S_QKM, 2); SBAR();
#pragma unroll
            for (int s = 0; s < 4; ++s) { O[0][s >> 1] = mfma16(X0[s], VNB[0][s & 1], O[0][s >> 1]); O[1][s >> 1] = mfma16(X0[s], VNB[1][s & 1], O[1][s >> 1]); }
            SBAR(); LD_B(X0, S_KDT, 0); SBAR();
#pragma unroll
            for (int s = 0; s < 4; ++s) { O[0][2 + (s >> 1)] = mfma16(X1[s], VNB[0][s & 1], O[0][2 + (s >> 1)]); O[1][2 + (s >> 1)] = mfma16(X1[s], VNB[1][s & 1], O[1][2 + (s >> 1)]); }
#pragma unroll
            for (int kt = 0; kt < 8; ++kt) { Sacc[0][kt] = Sacc[0][kt] * eg; Sacc[1][kt] = Sacc[1][kt] * eg; }
#pragma unroll
            for (int q = 0; q < 4; ++q) {
                if (q & 1) { SBAR(); if (q < 3) LD_B(X0, S_KDT, 2 * q + 2); SBAR();
#pragma unroll
                    for (int s = 0; s < 4; ++s) { Sacc[0][2 * q + (s >> 1)] = mfma16(X1[s], VNB[0][s & 1], Sacc[0][2 * q + (s >> 1)]); Sacc[1][2 * q + (s >> 1)] = mfma16(X1[s], VNB[1][s & 1], Sacc[1][2 * q + (s >> 1)]); } }
                else { SBAR(); LD_B(X1, S_KDT, 2 * q + 2); SBAR();
#pragma unroll
                    for (int s = 0; s < 4; ++s) { Sacc[0][2 * q + (s >> 1)] = mfma16(X0[s], VNB[0][s & 1], Sacc[0][2 * q + (s >> 1)]); Sacc[1][2 * q + (s >> 1)] = mfma16(X0[s], VNB[1][s & 1], Sacc[1][2 * q + (s >> 1)]); } }
            }
#pragma unroll
            for (int sl = 0; sl < 2; ++sl)
#pragma unroll
                for (int ct = 0; ct < 4; ++ct)
#pragma unroll
                    for (int r = 0; r < 4; ++r) OB[(16 * ct + 4 * g + r) * 132 + n0 + 16 * sl + m] = O[sl][ct][r];
            WGBAR();
        }
#undef SBAR
#undef LD_A
#undef LD_B
    }
#undef WGBAR
}
__device__ __forceinline__ void fox_blk(const Frame& F, int it, int j, att::Blk& k) {
    const int bh = it >> 2, y = it & 3, qb = j == 0 ? y : 7 - y, b = bh >> 3, h = bh & 7; const size_t row0 = (size_t)b * SEQ + qb * 256;
    bf16* proj = (bf16*)(F.ws + WS_PROJ);
    k.Q = proj + row0 * PW + PC_Q + h * HD; k.K = proj + (size_t)b * SEQ * PW + PC_K + h * HD; k.voff = PC_V - PC_K; k.goff = PC_Z - PC_Q;
    k.flog = (const float*)(F.ws + WS_AB) + (size_t)b * SEQ * 16 + h; k.fb = F.in[I_FOXFB][h]; k.P0 = qb * 256; k.skv = SEQ; k.kvpitch = PW;
}
__device__ __forceinline__ void mem_blk(const Frame& F, int idx, att::Blk& k) {
    const int b = idx >> 5, hm = (idx >> 3) & 3, qb = idx & 7; const size_t row0 = (size_t)b * SEQ + qb * 256;
    bf16* proj = (bf16*)(F.ws + WS_PROJ); const bf16* mkv = (const bf16*)(F.ws + WS_MEMKV);
    static_assert(att::QP == PW, "attention Q pitch");
    k.Q = proj + row0 * PW + PC_QM + hm * HD; k.K = mkv + (size_t)b * NMEM * DM + hm * HD; k.voff = 512; k.goff = 0;
    k.flog = nullptr; k.fb = 0.f; k.P0 = 1 << 20; k.skv = NMEM; k.kvpitch = DM;
}
struct SrcL1 { const Frame* F; int vcu;
    __device__ __forceinline__ bool operator()(int n, att::Blk& k) const { const int it = vcu + (n / 3) * F->G, j = n % 3; if (it >= 256) return false;
        if (j < 2) fox_blk(*F, it, j, k); else mem_blk(*F, it, k); return true; } };
struct SrcL0 { const Frame* F; int first, stride;
    __device__ __forceinline__ bool operator()(int n, att::Blk& k) const { const int idx = first + n * stride; if (idx >= 256) return false; mem_blk(*F, idx, k); return true; } };
#define IN(k) (lo <= (k) && (k) < hi)
#define SEAM(k) do { if (IN(k) && IN((k) + 1)) xcd_barrier(bar); } while (0)
#define SEAMG(k, s_) do { if (IN(k) && IN((k) + 1)) { if (gb.on) grp_barrier(gb, (s_)); else xcd_barrier(bar); } } while (0)
template <int layer> __device__ __forceinline__ void layer_body(const Frame& F, const XcdBarrier& bar, GrpBar& gb, bool grp_try, int lo, int hi, unsigned char* lds) {
    bf16* proj = (bf16*)(F.ws + WS_PROJ); bf16* xb = (bf16*)(F.ws + WS_XB); float* xsq = (float*)(F.ws + WS_XSQ);
    float* ab = (float*)(F.ws + WS_AB);

        const int pb = 1 + (layer ? 6 : 0);
        if (IN(pb)) {
            pg8::Gemm g{xb, (const bf16*)(F.ws + (layer ? WS_WIN1 : WS_WIN0)), MROWS, N_IN, DM, DM}; pg8::StaticOrder S; S.init(MROWS, N_IN, F.G, F.bid);
            const float* nk = layer ? F.in[I_FOXKNW] : nullptr; const float* nq = layer ? F.in[I_FOXQNW] : nullptr;
            pg8::EpiProj<true, false, layer == 0> E{proj, PW, xsq, ab, 18, (bf16*)((unsigned char*)F.out + DO_HALO), 0, layer ? 4 : 0, nk, 12, layer ? 16 : 12, nq, 16, 18, F.in[I_MEMQNW] + layer * HD};
            pg8::gemm_phase<pg8::EpiProj<true, false, layer == 0>, pg8::StaticOrder, true, true>(F.lds, g, S, E, F.wv);
            if (layer == 0) {
                pg8::Gemm g2{(const bf16*)((unsigned char*)F.out + DO_MEMB), (const bf16*)(F.ws + WS_WMKV), MMEM, DM, DM, DM}; pg8::StaticOrder S2; S2.init(MMEM, DM, F.G, F.G - 1 - F.bid);
                pg8::EpiProj<true, false> E2{(bf16*)(F.ws + WS_MEMKV), DM, (const float*)(F.ws + WS_MSQ), nullptr, 4, nullptr, 0, 2, F.in[I_MEMKNW], 0, 0, nullptr, 0, 0, nullptr};
                pg8::gemm_phase<pg8::EpiProj<true, false>, pg8::StaticOrder, true, true>(F.lds, g2, S2, E2, F.wv);
            }
        }
        SEAM(pb);
        if (layer == 0 && grp_try) gb.on = __hip_atomic_load((unsigned*)((gu32*)(F.ws + WS_CTL) + CW_BAD), __ATOMIC_RELAXED, __HIP_MEMORY_SCOPE_AGENT) == 0u;
        const int pm = pb + (layer ? 1 : 2);
        if (layer == 0) {
            if (IN(pb + 1)) { constexpr int NU = BATCH * NH * (SEQ / 64); DnPre R; int u = F.bid; if (u < NU) dn_prep_load(F, u, R);
                              for (; u < NU; u += F.G) dn_prep_unit(F, u, u + F.G < NU ? u + F.G : -1, R); }
            SEAM(pb + 1);
        }
        if (IN(pm)) {
            if (layer == 0) {
                if (F.bid < 64) dn_scan_unit(F, F.bid);
                else { const SrcL0 src{&F, F.bid - 64, F.G - 64}; att::phase((char*)lds, src, F.wv);
                       __syncthreads();
                       const Tix T = tix(F.wv); convert_weights<6, 18>(F, (LAS float*)(F.lds + T.wave * 17408), T.lane, (F.bid - 64) * NWAVES + T.wave, (F.G - 64) * NWAVES, 0); }
            } else {
                const int vcu = (F.G % 8 == 0) ? (F.bid % 8) * (F.G / 8) + F.bid / 8 : F.bid;
                const SrcL1 src{&F, vcu}; att::phase((char*)lds, src, F.wv);
            }
            __syncthreads();
        }
        SEAM(pm);
        if (IN(pm + 1)) {
            pg8::Gemm g{proj + PC_Q, (const bf16*)(F.ws + (layer ? WS_WOUT1 : WS_WOUT0)), MROWS, DM, OUT_IN, PW}; pg8::StaticOrder S; S.init(MROWS, DM, F.G, F.bid);
            pg8::EpiRes<false, layer == 0> E{xb, F.out, xsq, F.in[I_X]};
            pg8::gemm_phase<pg8::EpiRes<false, layer == 0>, pg8::StaticOrder, true, true>(F.lds, g, S, E, F.wv);
        }
        SEAMG(pm + 1, layer * 3 + 0);
        if (IN(pm + 2)) {
            pg8::Gemm g{xb, (const bf16*)(F.ws + (layer ? WS_WM1_1 : WS_WM1_0)), MROWS, FF, DM, DM}; pg8::StaticOrder S; S.init(MROWS, FF, F.G, F.bid);
            pg8::EpiProj<false, true> E{proj, FF, xsq, nullptr, 16, nullptr, 0, 0, nullptr, 0, 0, nullptr, 0, 0, nullptr};
            pg8::gemm_phase<pg8::EpiProj<false, true>, pg8::StaticOrder, true, true>(F.lds, g, S, E, F.wv);
        }
        SEAMG(pm + 2, layer * 3 + 1);
        if (IN(pm + 3)) {
            pg8::Gemm g{proj, (const bf16*)(F.ws + (layer ? WS_WM2_1 : WS_WM2_0)), MROWS, DM, FF, FF}; pg8::StaticOrder S; S.init(MROWS, DM, F.G, F.bid);
            pg8::EpiRes<layer == 1> E{xb, F.out, xsq, nullptr};
            pg8::gemm_phase<pg8::EpiRes<layer == 1>, pg8::StaticOrder, true, true>(F.lds, g, S, E, F.wv);
        }
        if (layer == 0) SEAMG(pm + 3, 2); else SEAM(pm + 3);
    }
#undef IN
#undef SEAM
#undef SEAMG
__global__ void __launch_bounds__(NWAVES * 64, 2) hyb_fwd(Args args) {
    extern __shared__ __attribute__((aligned(16))) unsigned char lds[];
    Frame F;
    F.lds = (LAS unsigned char*)lds;
    F.G = gridDim.x; F.bid = blockIdx.x; F.in = args.in; F.out = args.out; F.ws = args.ws; F.wv = __builtin_amdgcn_readfirstlane((int)threadIdx.x >> 6);
    volatile LAS unsigned* MISC = (volatile LAS unsigned*)(F.lds + MISC_OFF);
    gu32* ctl = (gu32*)(args.ws + WS_CTL);
    for (int u = threadIdx.x; u < (LDS_BYTES - MISC_OFF) / 4; u += NWAVES * 64) ((LAS unsigned*)(F.lds + MISC_OFF))[u] = 0u;
    __syncthreads();
    XcdBarrier bar; bar.bar = (unsigned*)(ctl + CW_BAR) + args.li * XCD_BAR_WORDS; bar.x = 0; bar.st = nullptr; bar.wv = F.wv;
    if (!MK_LAUNCH_PER_PHASE) { bar = xcd_barrier_post((unsigned*)(ctl + CW_BAR) + args.li * XCD_BAR_WORDS, MISC + 8); bar.wv = F.wv; }
    const int lo = args.ph_lo, hi = args.ph_hi;
#define IN(k) (lo <= (k) && (k) < hi)
#define SEAM(k) do { if (IN(k) && IN((k) + 1)) xcd_barrier(bar); } while (0)
    bf16* proj = (bf16*)(F.ws + WS_PROJ); bf16* xb = (bf16*)(F.ws + WS_XB); float* xsq = (float*)(F.ws + WS_XSQ);
    float* ab = (float*)(F.ws + WS_AB);

    GrpBar gb; gb.cnt = (unsigned*)(ctl + CW_GRP) + (size_t)(F.bid & 63) * 8 * 64; gb.tmo = (unsigned*)(ctl + CW_BAR) + XB_TMO; gb.wv = F.wv; gb.on = false;
    const bool grp_try = !MK_LAUNCH_PER_PHASE && F.G == 256 && lo == 0 && hi == N_PHASES;
    if (grp_try && F.wv == 0 && lane_id() == 0) __hip_atomic_store((unsigned*)(ctl + CW_XCC) + F.bid, xb_xcc_id() + 1u, __ATOMIC_RELAXED, __HIP_MEMORY_SCOPE_AGENT);
    if (IN(0)) { p0_prologue(F); } SEAM(0);
    if (grp_try && F.wv == 0 && lane_id() == 0) { const unsigned mine = xb_xcc_id() + 1u; bool same = true;
        for (int k = 1; k < 4; ++k) same = same && __hip_atomic_load((unsigned*)(ctl + CW_XCC) + ((F.bid + 64 * k) & 255), __ATOMIC_RELAXED, __HIP_MEMORY_SCOPE_AGENT) == mine;
        if (!same) atomicAdd((unsigned*)(ctl + CW_BAD), 1u); }

    layer_body<0>(F, bar, gb, grp_try, lo, hi, lds);
    layer_body<1>(F, bar, gb, grp_try, lo, hi, lds);
#undef IN
#undef SEAM
}

extern "C" void kernel_launch(void* const* d_in, const int* in_sizes, int n_in, void* d_out, int out_size, void* d_ws, size_t ws_size, hipStream_t stream) {
    static int grid = 0;
    if (grid == 0) {
        if (n_in != 20 || in_sizes[0] != MROWS * DM || out_size != MROWS * DM || ws_size < WS_END) {
            fprintf(stderr, "kernel_launch: shape/workspace mismatch (n_in %d, in0 %d, out %d, ws %zu; need ws >= %zu); nothing launched\n", n_in, n_in > 0 ? in_sizes[0] : -1, out_size, ws_size, (size_t)WS_END); grid = -1; return; }
        int dev = 0, cus = 0, per_cu = 0;
        if (hipGetDevice(&dev) != hipSuccess || hipDeviceGetAttribute(&cus, hipDeviceAttributeMultiprocessorCount, dev) != hipSuccess) { fprintf(stderr, "kernel_launch: device query failed\n"); grid = -1; return; }
        if (hipFuncSetAttribute((const void*)hyb_fwd, hipFuncAttributeMaxDynamicSharedMemorySize, LDS_BYTES) != hipSuccess) { fprintf(stderr, "kernel_launch: hipFuncSetAttribute failed\n"); grid = -1; return; }
        if (hipOccupancyMaxActiveBlocksPerMultiprocessor(&per_cu, (const void*)hyb_fwd, NWAVES * 64, LDS_BYTES) != hipSuccess || per_cu < 1) {
            fprintf(stderr, "kernel_launch: occupancy query reports %d workgroups per CU; nothing launched\n", per_cu); (void)hipGetLastError(); grid = -1; return; }
        if (cus < 128) { fprintf(stderr, "kernel_launch: %d CUs; this kernel's phase program needs at least 128 workgroups; nothing launched\n", cus); grid = -1; return; }
        grid = cus;
    }
    if (grid < 0) return;
    if (hipMemsetAsync((char*)d_ws + WS_CTL, 0, CTL_ZERO_BYTES, stream) != hipSuccess) { fprintf(stderr, "kernel_launch: memset failed\n"); return; }
    Args a{};
    for (int i = 0; i < 20; ++i) a.in[i] = (const float*)d_in[i];
    a.out = (float*)d_out; a.ws = (unsigned char*)d_ws;
#if MK_LAUNCH_PER_PHASE
    for (int p = 0; p < N_PHASES; ++p) { a.ph_lo = p; a.ph_hi = p + 1; a.li = 0; hipLaunchKernelGGL(hyb_fwd, dim3(grid), dim3(NWAVES * 64), LDS_BYTES, stream, a); }
#else
    a.ph_lo = 0; a.ph_hi = N_PHASES; a.li = 0;
    hipLaunchKernelGGL(hyb_fwd, dim3(grid), dim3(NWAVES * 64), LDS_BYTES, stream, a);
#endif
    const hipError_t le = hipPeekAtLastError();
    if (le != hipSuccess) fprintf(stderr, "kernel_launch: launch failed: %s\n", hipGetErrorName(le));
}
```

```cpp
#include <hip/hip_runtime.h>
#include <cstdio>
#include <cstdint>

constexpr int BATCH = 8, SEQ = 2048, DM = 1024, MROWS = BATCH * SEQ;
constexpr int NMEM = 256, MMEM = BATCH * NMEM;
constexpr int HD = 128, NH = 8, NMH = 4, FF = 4096;
constexpr int PW = 4608;
constexpr int PC_K = 0, PC_V = 1024, PC_Z = 2048, PC_Q = 3072, PC_QM = 4096, PC_AB = 4608;
constexpr int N_IN = 4864;
constexpr int DN_IN = 4624, FOX_IN = 4616, OUT_IN = 1536;
constexpr float EPS = 1e-6f;
constexpr float QSCALE = 0.08838834764831845f;

__device__ __forceinline__ int lane_id_v() { int x; asm volatile("v_mbcnt_lo_u32_b32 %0, -1, 0\n\tv_mbcnt_hi_u32_b32 %0, -1, %0" : "=v"(x)); return x; }
template <int CTRL> __device__ __forceinline__ float dppf(float x) { return __builtin_bit_cast(float, __builtin_amdgcn_update_dpp(0, __builtin_bit_cast(int, x), CTRL, 0xf, 0xf, true)); }
__device__ __forceinline__ float row16_sum(float x) { x += dppf<0xB1>(x); x += dppf<0x4E>(x); x += dppf<0x141>(x); x += dppf<0x140>(x); return x; }
__device__ __forceinline__ float add_xor16(float x) { auto r = __builtin_amdgcn_permlane16_swap(__float_as_uint(x), __float_as_uint(x), false, false); return __uint_as_float(r[0]) + __uint_as_float(r[1]); }
__device__ __forceinline__ float add_xor32(float x) { auto r = __builtin_amdgcn_permlane32_swap(__float_as_uint(x), __float_as_uint(x), false, false); return __uint_as_float(r[0]) + __uint_as_float(r[1]); }
namespace pg8 {
#define PG8_LAS __attribute__((address_space(3)))
typedef unsigned short bf16_t;
typedef short bf16x8 __attribute__((ext_vector_type(8)));
typedef float f32x4 __attribute__((ext_vector_type(4)));
typedef unsigned u32x4 __attribute__((ext_vector_type(4)));
constexpr int BM = 256, BK = 64, HALF = 128, HTB = HALF * BK * 2  , STAGE_BYTES = 8 * HTB, NXCD = 8, WGM = 8;

__host__ __device__ __forceinline__ int lds_byte(int r, int c) { const int st = (r >> 4) * 2 + (c >> 5), rr = r & 15, cc = c & 31, ob = rr * 64 + cc * 2; return st * 1024 + (ob ^ (((ob >> 9) & 1) << 5)); }
__host__ __device__ __forceinline__ void stage_rc(int b, int& R, int& C) { const int st = b / 1024, sb = b % 1024, swz = sb ^ (((sb >> 9) & 1) << 5); R = (st >> 1) * 16 + swz / 64; C = (st & 1) * 32 + (swz % 64) / 2; }
__host__ __device__ __forceinline__ int perm32(int rho) { const int n = rho >> 4, i = rho & 15; return 8 * (i >> 2) + 4 * n + (i & 3); }

struct Unit { int pm, pn; };
struct Gemm { const bf16_t* A; const bf16_t* Bt; int M, N, K, lda; };

struct StaticOrder {
    int nM, nN, nwg, G, c;
    __host__ __device__ void init(int M, int N, int G_, int c_) { nM = M / BM; nN = N / BM; nwg = nM * nN; G = G_; c = c_; }
    __host__ __device__ bool next(int i, Unit& u) const {
        const long L = (long)i * G + c; if (L >= nwg) return false;
        int wgid = (int)L; { const int q = nwg / NXCD, r = nwg % NXCD, xcd = wgid % NXCD, off = wgid / NXCD; wgid = (xcd < r ? xcd * (q + 1) : r * (q + 1) + (xcd - r) * q) + off; }
        const int nig = WGM * nN, gid = wgid / nig, fm = gid * WGM, gsz = (nM - fm) < WGM ? (nM - fm) : WGM;
        u.pm = fm + ((wgid % nig) % gsz); u.pn = (wgid % nig) / gsz; return true;
    }
    __device__ __forceinline__ void a_ready(const Unit&) const {}
    __device__ __forceinline__ void done(const Unit&) const {}
};


__device__ __forceinline__ unsigned cvt_pk_bf16(float lo, float hi) { unsigned r; asm volatile("v_cvt_pk_bf16_f32 %0, %1, %2" : "=v"(r) : "v"(lo), "v"(hi)); return r; }

constexpr int EPI_XCH = 131072, EPI_RS = 139264;
template <bool NORM, bool RELU2, bool HALO = false> struct EpiProj {
    static constexpr bool PERM = true, AFTER_DRAIN = false, USE_RS = true, ACC_INIT = false;
    bf16_t* O; int ldc; const float* xsq; float* ab; int n_main; bf16_t* halo;
    int nlo0, nhi0; const float* nw0; int nlo1, nhi1; const float* nw1; int nlo2, nhi2; const float* nw2;
    int zlo, zhi, zmode; const float* zw;
    __device__ __forceinline__ void rs_load(const Unit& u, int tid, f32x4 (&q)[4]) const { const float* p = xsq + (size_t)(u.pm * BM + tid) * 16;
#pragma unroll
        for (int i = 0; i < 4; ++i) q[i] = *(const f32x4*)(p + 4 * i); }
    __device__ __forceinline__ void rs_store(const f32x4 (&q)[4], PG8_LAS unsigned char* lds, int parity, int tid) const {
        const f32x4 t = (q[0] + q[1]) + (q[2] + q[3]);
        ((PG8_LAS float*)(lds + EPI_RS))[parity * 256 + tid] = rsqrtf(((t[0] + t[1]) + (t[2] + t[3])) * (1.0f / 1024.0f) + 1e-6f); }
    __device__ __forceinline__ void operator()(const f32x4 (&acc)[2][2][4][2], const Unit& u, int wr, int wc, int fr, int fq, PG8_LAS unsigned char* lds, int parity) const {
        const int rl0 = wr * 64 + fr, row0 = u.pm * BM + rl0, colt = u.pn * BM;
        const bool is_ab = u.pn >= n_main;
        const PG8_LAS float* RS = (const PG8_LAS float*)(lds + EPI_RS) + parity * 256;
        const float* nw = nullptr;
        if (NORM) { if (u.pn >= nlo0 && u.pn < nhi0) nw = nw0; else if (u.pn >= nlo1 && u.pn < nhi1) nw = nw1; else if (u.pn >= nlo2 && u.pn < nhi2) nw = nw2; }
        f32x4 w0 = {1.f, 1.f, 1.f, 1.f}, w1 = w0;
        const int zm = (NORM && u.pn >= zlo && u.pn < zhi) ? zmode : 0;
        if (zm == 1) { w0 = *(const f32x4*)(zw + wc * 32 + 8 * fq); w1 = *(const f32x4*)(zw + wc * 32 + 8 * fq + 4); }
        if (NORM && nw != nullptr) {
            w0 = *(const f32x4*)(nw + wc * 32 + 8 * fq); w1 = *(const f32x4*)(nw + wc * 32 + 8 * fq + 4);
            PG8_LAS float* X = (PG8_LAS float*)(lds + EPI_XCH);
#pragma unroll
            for (int ai = 0; ai < 2; ++ai)
#pragma unroll
                for (int m = 0; m < 4; ++m) { const int rl = rl0 + ai * HALF + m * 16; const float rstd = RS[rl];
#pragma unroll
                    for (int bj = 0; bj < 2; ++bj) { const f32x4 v0 = acc[ai][bj][m][0] * rstd, v1 = acc[ai][bj][m][1] * rstd;
                        float ss = ((v0[0] * v0[0] + v0[1] * v0[1]) + (v0[2] * v0[2] + v0[3] * v0[3])) + ((v1[0] * v1[0] + v1[1] * v1[1]) + (v1[2] * v1[2] + v1[3] * v1[3]));
                        ss = add_xor32(add_xor16(ss));
                        if (fq == 0) X[(bj * 256 + rl) * 4 + wc] = ss; } }
            asm volatile("s_waitcnt lgkmcnt(0)" ::: "memory"); __builtin_amdgcn_s_barrier(); asm volatile("" ::: "memory");
        }
#pragma unroll
        for (int ai = 0; ai < 2; ++ai)
#pragma unroll
            for (int m = 0; m < 4; ++m) {
                const int rl = rl0 + ai * HALF + m * 16, r = row0 + ai * HALF + m * 16;
                const float rstd = RS[rl];
                if (!is_ab) {
#pragma unroll
                    for (int bj = 0; bj < 2; ++bj) {
                        float sc = rstd;
                        if (NORM && nw != nullptr) { const f32x4 p4 = *(const PG8_LAS f32x4*)((const PG8_LAS float*)(lds + EPI_XCH) + (bj * 256 + rl) * 4);
                            sc = rstd * rsqrtf(((p4[0] + p4[1]) + (p4[2] + p4[3])) * (1.0f / 128.0f) + 1e-6f); }
                        f32x4 v0 = acc[ai][bj][m][0] * sc, v1 = acc[ai][bj][m][1] * sc;
                        if (zm != 0) {
#pragma unroll
                            for (int e = 0; e < 4; ++e) { const float s0 = __builtin_amdgcn_rcpf(1.f + __expf(-v0[e])), s1 = __builtin_amdgcn_rcpf(1.f + __expf(-v1[e]));
                                v0[e] = zm == 1 ? v0[e] * s0 : s0; v1[e] = zm == 1 ? v1[e] * s1 : s1; } }
                        v0 = v0 * w0; v1 = v1 * w1;
                        if (RELU2) {
#pragma unroll
                            for (int e = 0; e < 4; ++e) { const float a = fmaxf(v0[e], 0.f), b = fmaxf(v1[e], 0.f); v0[e] = a * a; v1[e] = b * b; }
                        }
                        u32x4 w; w.x = cvt_pk_bf16(v0[0], v0[1]); w.y = cvt_pk_bf16(v0[2], v0[3]); w.z = cvt_pk_bf16(v1[0], v1[1]); w.w = cvt_pk_bf16(v1[2], v1[3]);
                        *(u32x4*)(O + (size_t)r * ldc + colt + bj * HALF + wc * 32 + 8 * fq) = w;
                        if (HALO && m == 3 && fr >= 13) *(u32x4*)(halo + ((size_t)(r >> 6) * 3 + ((r & 63) - 61)) * ldc + colt + bj * HALF + wc * 32 + 8 * fq) = w;
                    }
                } else if (ab != nullptr && wc == 0 && fq < 2) {
                    float* p = ab + (size_t)r * 16 + 8 * fq;
                    *(f32x4*)p = acc[ai][0][m][0] * rstd; *(f32x4*)(p + 4) = acc[ai][0][m][1] * rstd;
                }
            }
    }
};
template <bool LAST = false, bool INIT_F32 = false> struct EpiRes {
    static constexpr bool PERM = true, AFTER_DRAIN = false, USE_RS = false, ACC_INIT = true;
    bf16_t* xb; float* xout; float* xsq; const float* xin;
    __device__ __forceinline__ void init(f32x4 (&acc)[2][2][4][2], const Unit& u, int wr, int wc, int fr, int fq) const {
        const int row0 = u.pm * BM + wr * 64 + fr, colt = u.pn * BM;
#pragma unroll
        for (int ai = 0; ai < 2; ++ai)
#pragma unroll
            for (int m = 0; m < 4; ++m)
#pragma unroll
                for (int bj = 0; bj < 2; ++bj) { const size_t off = (size_t)(row0 + ai * HALF + m * 16) * 1024 + colt + bj * HALF + wc * 32 + 8 * fq;
                    if (INIT_F32) { acc[ai][bj][m][0] = *(const f32x4*)(xin + off); acc[ai][bj][m][1] = *(const f32x4*)(xin + off + 4); continue; }
                    const u32x4 w = *(const u32x4*)(xb + off);
                    acc[ai][bj][m][0] = (f32x4){__uint_as_float(w.x << 16), __uint_as_float(w.x & 0xffff0000u), __uint_as_float(w.y << 16), __uint_as_float(w.y & 0xffff0000u)};
                    acc[ai][bj][m][1] = (f32x4){__uint_as_float(w.z << 16), __uint_as_float(w.z & 0xffff0000u), __uint_as_float(w.w << 16), __uint_as_float(w.w & 0xffff0000u)}; }
    }
    __device__ __forceinline__ void operator()(const f32x4 (&acc)[2][2][4][2], const Unit& u, int wr, int wc, int fr, int fq, PG8_LAS unsigned char*, int) const {
        const int row0 = u.pm * BM + wr * 64 + fr, colt = u.pn * BM;
#pragma unroll
        for (int ai = 0; ai < 2; ++ai)
#pragma unroll
            for (int m = 0; m < 4; ++m) {
                const int r = row0 + ai * HALF + m * 16; float ss = 0.f;
#pragma unroll
                for (int bj = 0; bj < 2; ++bj) {
                    const size_t off = (size_t)r * 1024 + colt + bj * HALF + wc * 32 + 8 * fq;
                    const f32x4 v0 = acc[ai][bj][m][0], v1 = acc[ai][bj][m][1];
                    if (LAST) { *(f32x4*)(xout + off) = v0; *(f32x4*)(xout + off + 4) = v1; }
                    else {
                    ss += ((v0[0] * v0[0] + v0[1] * v0[1]) + (v0[2] * v0[2] + v0[3] * v0[3])) + ((v1[0] * v1[0] + v1[1] * v1[1]) + (v1[2] * v1[2] + v1[3] * v1[3]));
                    u32x4 w; w.x = cvt_pk_bf16(v0[0], v0[1]); w.y = cvt_pk_bf16(v0[2], v0[3]); w.z = cvt_pk_bf16(v1[0], v1[1]); w.w = cvt_pk_bf16(v1[2], v1[3]);
                    *(u32x4*)(xb + off) = w; }
                }
                if (!LAST) { ss = add_xor32(add_xor16(ss));
                if (fq == 0) xsq[(size_t)r * 16 + u.pn * 4 + wc] = ss; }
            }
    }
};

template <class Epi, class Sched, bool ALIGN_EPI = false, bool SP2 = false>
__device__ __forceinline__ void gemm_phase(PG8_LAS unsigned char* lds, const Gemm g, const Sched& S, const Epi& E, int wid) {
    const int lane = lane_id_v();
    const int tid = wid * 64 + lane, wr = wid >> 2, wc = wid & 3, fr = lane & 15, fq = lane >> 4;
    const int K = g.K, nt = K / BK;
    unsigned voffA[2], voffB[2];
#pragma unroll
    for (int i = 0; i < 2; ++i) { int R, C; stage_rc(tid * 16 + i * 8192, R, C); const int Rb = Epi::PERM ? ((R & ~31) + perm32(R & 31)) : R;
        voffA[i] = (unsigned)(R * g.lda + C) * 2u; voffB[i] = (unsigned)(Rb * K + C) * 2u; }
    const size_t kstep = (size_t)(BK * 2);
    const size_t hstepA = (size_t)HALF * g.lda * 2, hstepB = (size_t)HALF * K * 2;
    const size_t tstepA = 2 * hstepA, tstepB = 2 * hstepB;
    const unsigned ldsw = (unsigned)wid * 1024u;
    const int aoff = lds_byte(wr * 64 + fr, fq * 8), boff = lds_byte(wc * 32 + fr, fq * 8);
#define PG8_SA(b, h) (((b) * 2 + (h)) * HTB)
#define PG8_SB(b, h) ((4 + (b) * 2 + (h)) * HTB)
#define PG8_STAGE(bufoff, gbase, voff) do { _Pragma("unroll") for (int _i = 0; _i < 2; ++_i) \
        __builtin_amdgcn_global_load_lds((const unsigned*)((const char*)(gbase) + (voff)[_i]), (PG8_LAS unsigned*)(lds + (bufoff) + ldsw + _i * 8192), 16, 0, 0); } while (0)
#define PG8_LDA(dst, b, h) do { _Pragma("unroll") for (int m = 0; m < 4; ++m) _Pragma("unroll") for (int k = 0; k < 2; ++k) dst[m][k] = *(const PG8_LAS bf16x8*)(lds + PG8_SA(b, h) + aoff + m * 2048 + k * 1024); } while (0)
#define PG8_LDB(dst, b, h) do { _Pragma("unroll") for (int n = 0; n < 2; ++n) _Pragma("unroll") for (int k = 0; k < 2; ++k) dst[n][k] = *(const PG8_LAS bf16x8*)(lds + PG8_SB(b, h) + boff + n * 2048 + k * 1024); } while (0)
#define PG8_MMA(ai, bj, At, Bt) do { __builtin_amdgcn_s_setprio(1); _Pragma("unroll") for (int m = 0; m < 4; ++m) _Pragma("unroll") for (int n = 0; n < 2; ++n) _Pragma("unroll") for (int k = 0; k < 2; ++k) \
        acc[ai][bj][m][n] = __builtin_amdgcn_mfma_f32_16x16x32_bf16(Bt[n][k], At[m][k], acc[ai][bj][m][n], 0, 0, 0); __builtin_amdgcn_s_setprio(0); } while (0)
#define PG8_WAIT_V(n) asm volatile("s_waitcnt vmcnt(" #n ")" ::: "memory")
#define PG8_WAIT_L(n) asm volatile("s_waitcnt lgkmcnt(" #n ")" ::: "memory")
#define PG8_BAR __builtin_amdgcn_s_barrier()
#define PG8_SCHED __builtin_amdgcn_sched_barrier(0)
    Unit cur, nxt; int ui = 0;
    if (!S.next(0, cur)) return;
    f32x4 acc[2][2][4][2];
    if constexpr (Epi::ACC_INIT) E.init(acc, cur, wr, wc, fr, fq);
    else {
#pragma unroll
    for (int a = 0; a < 2; ++a)
#pragma unroll
        for (int b = 0; b < 2; ++b)
#pragma unroll
            for (int m = 0; m < 4; ++m)
#pragma unroll
                for (int n = 0; n < 2; ++n) acc[a][b][m][n] = (f32x4){0.f, 0.f, 0.f, 0.f};
    }
    bf16x8 At[4][2], B0[2][2], B1[2][2];
    const char* cA = (const char*)g.A + (size_t)cur.pm * tstepA; const char* cB = (const char*)g.Bt + (size_t)cur.pn * tstepB;
    S.a_ready(cur);
    if constexpr (Epi::USE_RS) { if (tid < 256) { f32x4 rq[4]; E.rs_load(cur, tid, rq); E.rs_store(rq, lds, 0, tid); } }
    if constexpr (SP2) {
        PG8_STAGE(PG8_SB(0, 0), cB, voffB); PG8_STAGE(PG8_SB(0, 1), cB + hstepB, voffB); PG8_STAGE(PG8_SA(0, 0), cA, voffA); PG8_STAGE(PG8_SA(0, 1), cA + hstepA, voffA);
        if (wr == 1) PG8_BAR;
        PG8_WAIT_V(2); PG8_BAR;
        PG8_STAGE(PG8_SB(1, 0), cB + kstep, voffB); PG8_STAGE(PG8_SA(1, 0), cA + kstep, voffA); PG8_STAGE(PG8_SB(1, 1), cB + hstepB + kstep, voffB);
        PG8_WAIT_V(6); PG8_BAR;
    } else {
        PG8_STAGE(PG8_SB(0, 0), cB, voffB); PG8_STAGE(PG8_SA(0, 0), cA, voffA); PG8_STAGE(PG8_SB(0, 1), cB + hstepB, voffB); PG8_STAGE(PG8_SA(0, 1), cA + hstepA, voffA);
        if (wr == 1) PG8_BAR;
        PG8_WAIT_V(4); PG8_BAR;
        PG8_STAGE(PG8_SB(1, 0), cB + kstep, voffB); PG8_STAGE(PG8_SA(1, 0), cA + kstep, voffA); PG8_STAGE(PG8_SB(1, 1), cB + hstepB + kstep, voffB);
        PG8_WAIT_V(6); PG8_BAR;
    }
    for (;;) {
        const bool has_next = S.next(ui + 1, nxt);
        const char* nA = has_next ? (const char*)g.A + (size_t)nxt.pm * tstepA : cA; const char* nB = has_next ? (const char*)g.Bt + (size_t)nxt.pn * tstepB : cB;
        for (int t = 0; t < nt; t += 2) {
            const bool last = (t == nt - 2);
            const char* a1 = cA + (size_t)(t + 1) * kstep;
            const char* a2 = last ? nA : cA + (size_t)(t + 2) * kstep; const char* b2 = last ? nB : cB + (size_t)(t + 2) * kstep;
            const char* a3 = a2 + kstep; const char* b3 = b2 + kstep;
            if (last && has_next) S.a_ready(nxt);
            if constexpr (SP2) {
            PG8_LDB(B0, 0, 0); PG8_LDB(B1, 0, 1); PG8_SCHED; PG8_LDA(At, 0, 0); PG8_STAGE(PG8_SA(1, 1), a1 + hstepA, voffA);
            PG8_WAIT_V(8); PG8_WAIT_L(0); PG8_BAR; PG8_MMA(0, 0, At, B0); PG8_MMA(0, 1, At, B1); PG8_BAR; PG8_SCHED;
            PG8_LDA(At, 0, 1); PG8_STAGE(PG8_SB(0, 0), b2, voffB); PG8_STAGE(PG8_SB(0, 1), b2 + hstepB, voffB); PG8_STAGE(PG8_SA(0, 0), a2, voffA);
            PG8_WAIT_V(8); PG8_WAIT_L(0); PG8_BAR; PG8_MMA(1, 0, At, B0); PG8_MMA(1, 1, At, B1); PG8_BAR; PG8_SCHED;
            PG8_LDB(B0, 1, 0); PG8_LDB(B1, 1, 1); PG8_SCHED; PG8_LDA(At, 1, 0); PG8_STAGE(PG8_SA(0, 1), a2 + hstepA, voffA);
            PG8_WAIT_V(8); PG8_WAIT_L(0); PG8_BAR; PG8_MMA(0, 0, At, B0); PG8_MMA(0, 1, At, B1); PG8_BAR; PG8_SCHED;
            PG8_LDA(At, 1, 1); PG8_STAGE(PG8_SB(1, 0), b3, voffB); PG8_STAGE(PG8_SB(1, 1), b3 + hstepB, voffB); PG8_STAGE(PG8_SA(1, 0), a3, voffA);
            PG8_WAIT_V(8); PG8_WAIT_L(0); PG8_BAR; PG8_MMA(1, 0, At, B0); PG8_MMA(1, 1, At, B1); PG8_BAR; PG8_SCHED;
            } else {
            PG8_LDB(B0, 0, 0); PG8_SCHED; PG8_LDA(At, 0, 0); PG8_STAGE(PG8_SA(1, 1), a1 + hstepA, voffA);
            PG8_WAIT_L(8); PG8_BAR; PG8_WAIT_L(0); PG8_MMA(0, 0, At, B0); PG8_BAR; PG8_SCHED;
            PG8_LDB(B1, 0, 1); PG8_STAGE(PG8_SB(0, 0), b2, voffB);
            PG8_BAR; PG8_WAIT_L(0); PG8_MMA(0, 1, At, B1); PG8_BAR;
            PG8_LDA(At, 0, 1); PG8_STAGE(PG8_SA(0, 0), a2, voffA);
            PG8_BAR; PG8_WAIT_L(0); PG8_MMA(1, 0, At, B0); PG8_BAR; PG8_SCHED;
            PG8_STAGE(PG8_SB(0, 1), b2 + hstepB, voffB);
            PG8_WAIT_V(6); PG8_BAR; PG8_MMA(1, 1, At, B1); PG8_BAR;
            PG8_LDB(B0, 1, 0); PG8_SCHED; PG8_LDA(At, 1, 0); PG8_STAGE(PG8_SA(0, 1), a2 + hstepA, voffA);
            PG8_WAIT_L(8); PG8_BAR; PG8_WAIT_L(0); PG8_MMA(0, 0, At, B0); PG8_BAR; PG8_SCHED;
            PG8_LDB(B1, 1, 1); PG8_STAGE(PG8_SB(1, 0), b3, voffB);
            PG8_BAR; PG8_WAIT_L(0); PG8_MMA(0, 1, At, B1); PG8_BAR;
            PG8_LDA(At, 1, 1); PG8_STAGE(PG8_SA(1, 0), a3, voffA);
            PG8_BAR; PG8_WAIT_L(0); PG8_MMA(1, 0, At, B0); PG8_BAR; PG8_SCHED;
            PG8_STAGE(PG8_SB(1, 1), b3 + hstepB, voffB);
            PG8_WAIT_V(6); PG8_BAR; PG8_MMA(1, 1, At, B1); PG8_BAR;
            }
        }
        if constexpr (ALIGN_EPI) { if (wr == 0) PG8_BAR; }
        if constexpr (Epi::USE_RS) {
            f32x4 rq[4]; if (has_next && wid < 4) E.rs_load(nxt, wid * 64 + lane_id_v(), rq);
            E(acc, cur, wr, wc, fr, fq, lds, ui & 1);
            if (has_next && wid < 4) E.rs_store(rq, lds, (ui + 1) & 1, wid * 64 + lane_id_v());
        } else { E(acc, cur, wr, wc, fr, fq, lds, ui & 1); }
        S.done(cur);
        if (!has_next) break;
        if constexpr (Epi::ACC_INIT) E.init(acc, nxt, wr, wc, fr, fq);
        else {
#pragma unroll
        for (int a = 0; a < 2; ++a)
#pragma unroll
            for (int b = 0; b < 2; ++b)
#pragma unroll
                for (int m = 0; m < 4; ++m)
#pragma unroll
                    for (int n = 0; n < 2; ++n) acc[a][b][m][n] = (f32x4){0.f, 0.f, 0.f, 0.f};
        }
        cur = nxt; cA = nA; cB = nB; ++ui;
        if constexpr (ALIGN_EPI) { if (wr == 1) PG8_BAR; }
    }
    PG8_WAIT_V(0);
    if constexpr (!ALIGN_EPI) { if (wr == 0) PG8_BAR; }
    PG8_BAR;
    if constexpr (Epi::AFTER_DRAIN) { E.fused(acc, cur, wr, wc, fr, fq, lds, wid, lane); S.done(cur); }
#undef PG8_SA
#undef PG8_SB
#undef PG8_STAGE
#undef PG8_LDA
#undef PG8_LDB
#undef PG8_MMA
#undef PG8_WAIT_V
#undef PG8_WAIT_L
#undef PG8_BAR
#undef PG8_SCHED
}
}

namespace att {
typedef unsigned short bf16_t;
typedef short bf16x8 __attribute__((ext_vector_type(8)));
typedef short s16x4 __attribute__((ext_vector_type(4)));
typedef float f32x16 __attribute__((ext_vector_type(16)));
typedef float f32x4 __attribute__((ext_vector_type(4)));
typedef unsigned u32x4 __attribute__((ext_vector_type(4)));
constexpr int NW = 8, QBLK = 32, KVBLK = 64, QB = NW * QBLK, D = 128;
constexpr int SHM_V = KVBLK * D * 2, SHM_K = KVBLK * D * 2;
constexpr int OFF_WS = 2 * SHM_V + 2 * SHM_K, OFF_BK = OFF_WS + NW * 64 * 4, ATT_LDS = OFF_BK + 8192;
constexpr float SCALE = 0.08838834764831845f, THR = 8.f;
constexpr int WBIG = 1 << 30;
#define KSWZ(row, colB) ((row) * 256 + ((colB) ^ (((row) & 7) << 4)))
#define SBAR() __builtin_amdgcn_sched_barrier(0)
__device__ __forceinline__ int v_st(int k, int c) { const int kk = (k & ~0xC) | ((k & 4) << 1) | ((k & 8) >> 1); return ((kk >> 3) * 4 + (c >> 5)) * 512 + ((kk & 7) * 32 + (c & 31)) * 2; }
__device__ __forceinline__ int v_rd_base(int lane) { return ((lane & 3) << 3) | (((lane >> 2) & 3) << 6) | (((lane >> 4) & 1) << 5) | (((lane >> 5) & 1) << 8); }
constexpr int v_rd_off(int d0, int ks, int half) { return d0 * 512 + ks * 4096 + half * 2048; }
__device__ __forceinline__ int crow(int r, int hi) { return (r & 3) + 8 * (r >> 2) + 4 * hi; }
__device__ __forceinline__ unsigned cvtpk(float lo, float hi) { unsigned r; asm volatile("v_cvt_pk_bf16_f32 %0, %1, %2" : "=v"(r) : "v"(lo), "v"(hi)); return r; }
__device__ __forceinline__ bf16x8 load8(const bf16_t* p) { return *reinterpret_cast<const bf16x8*>(p); }
__device__ __forceinline__ void mask_tile(f32x16& p0, f32x16& p1, int dq, unsigned W) {
    const float NEG = -__builtin_inff();
#pragma unroll
    for (int r = 0; r < 16; ++r) { const int c = (r & 3) + 8 * (r >> 2);
        if ((unsigned)(dq - c) >= W) p0[r] = NEG;
        if ((unsigned)(dq - c - 32) >= W) p1[r] = NEG; }
}
__device__ __forceinline__ void partialSM(f32x16& p0, f32x16& p1, float& m_reg, float& mn, float& alpha) {
    float pmax = p0[0]; for (int r = 1; r < 16; ++r) pmax = fmaxf(pmax, p0[r]); for (int r = 0; r < 16; ++r) pmax = fmaxf(pmax, p1[r]);
    { auto rr = __builtin_amdgcn_permlane32_swap(__float_as_uint(pmax), __float_as_uint(pmax), false, false);
      pmax = fmaxf(__uint_as_float(rr[0]), __uint_as_float(rr[1])); }
    constexpr float C2 = 1.4426950408889634f * SCALE;
    if (__builtin_expect(__all((pmax - m_reg) * SCALE <= THR), 1)) { mn = m_reg; alpha = 1.f; }
    else { mn = fmaxf(m_reg, pmax); alpha = __builtin_amdgcn_exp2f((m_reg - mn) * C2); m_reg = mn; }
    const float mnL = -mn * C2;
    for (int r = 0; r < 16; ++r) p0[r] = fmaf(p0[r], C2, mnL); for (int r = 0; r < 16; ++r) p1[r] = fmaf(p1[r], C2, mnL);
    for (int r = 0; r < 16; ++r) p0[r] = __builtin_amdgcn_exp2f(p0[r]);
}
__device__ __forceinline__ void finishSM(f32x16& p0, f32x16& p1, float alpha, float& l_reg, bf16x8& pa0, bf16x8& pa1, bf16x8& pa2, bf16x8& pa3) {
    for (int r = 0; r < 16; ++r) p1[r] = __builtin_amdgcn_exp2f(p1[r]);
    float ps = 0; for (int r = 0; r < 16; ++r) ps += p0[r]; for (int r = 0; r < 16; ++r) ps += p1[r];
    { auto rr = __builtin_amdgcn_permlane32_swap(__float_as_uint(ps), __float_as_uint(ps), false, false);
      ps = __uint_as_float(rr[0]) + __uint_as_float(rr[1]); }
    l_reg = l_reg * alpha + ps;
#define PK4(P, B_, OUT) do { unsigned a0 = cvtpk(P[B_+0], P[B_+1]), a1 = cvtpk(P[B_+2], P[B_+3]);                          \
        unsigned b0 = cvtpk(P[B_+4], P[B_+5]), b1 = cvtpk(P[B_+6], P[B_+7]);                                             \
        auto r0 = __builtin_amdgcn_permlane32_swap(a0, b0, false, false); auto r1 = __builtin_amdgcn_permlane32_swap(a1, b1, false, false); \
        u32x4 w = {r0[0], r1[0], r0[1], r1[1]}; OUT = *reinterpret_cast<bf16x8*>(&w); } while (0)
    PK4(p0, 0, pa0); PK4(p0, 8, pa1); PK4(p1, 0, pa2); PK4(p1, 8, pa3);
#undef PK4
}
template <int KB>
__device__ __forceinline__ void qkt(f32x16& p0, f32x16& p1, const char* K_lds, int r32, int hi, const bf16x8* qr, const float* bb) {
#pragma unroll
    for (int g = 0; g < 4; ++g) { const f32x4 b0 = *(const f32x4*)(bb + 8 * g), b1 = *(const f32x4*)(bb + 32 + 8 * g);
#pragma unroll
        for (int i = 0; i < 4; ++i) { p0[4 * g + i] = b0[i]; p1[4 * g + i] = b1[i]; } }
    const char* kb[4];
#pragma unroll
    for (int dd = 0; dd < 4; ++dd) kb[dd] = K_lds + KB * SHM_K + KSWZ(r32, (dd * 16 + hi * 8) * 2);
#pragma unroll
    for (int d0 = 0; d0 < 8; ++d0) { const char* a = kb[d0 & 3] + (d0 >> 2) * 128;
        bf16x8 b0 = *reinterpret_cast<const bf16x8*>(a);
        bf16x8 b1 = *reinterpret_cast<const bf16x8*>(a + 32 * 256);
        p0 = __builtin_amdgcn_mfma_f32_32x32x16_bf16(b0, qr[d0], p0, 0, 0, 0);
        p1 = __builtin_amdgcn_mfma_f32_32x32x16_bf16(b1, qr[d0], p1, 0, 0, 0); }
}
template <int VB>
__device__ __forceinline__ void pv_tile(f32x16* o, int vb0, bf16x8 pa0, bf16x8 pa1, bf16x8 pa2, bf16x8 pa3) {
#define TRRD(dst, off) asm volatile("ds_read_b64_tr_b16 %0, %1 offset:%2" : "=&v"(dst) : "v"(vb0), "i"(off) : "memory")
#define PV_D0(d0) do { s16x4 l0, l1, l2, l3, h0, h1, h2, h3; constexpr int b_ = VB * SHM_V + v_rd_off(d0, 0, 0);   \
        TRRD(l0, b_); TRRD(h0, b_ + 2048); TRRD(l1, b_ + 4096); TRRD(h1, b_ + 6144); TRRD(l2, b_ + 8192); TRRD(h2, b_ + 10240); TRRD(l3, b_ + 12288); TRRD(h3, b_ + 14336); \
        asm volatile("s_waitcnt lgkmcnt(0)" ::: "memory"); SBAR();   \
        o[d0] = __builtin_amdgcn_mfma_f32_32x32x16_bf16(pa0, (bf16x8){l0[0], l0[1], l0[2], l0[3], h0[0], h0[1], h0[2], h0[3]}, o[d0], 0, 0, 0);   \
        o[d0] = __builtin_amdgcn_mfma_f32_32x32x16_bf16(pa1, (bf16x8){l1[0], l1[1], l1[2], l1[3], h1[0], h1[1], h1[2], h1[3]}, o[d0], 0, 0, 0);   \
        o[d0] = __builtin_amdgcn_mfma_f32_32x32x16_bf16(pa2, (bf16x8){l2[0], l2[1], l2[2], l2[3], h2[0], h2[1], h2[2], h2[3]}, o[d0], 0, 0, 0);   \
        o[d0] = __builtin_amdgcn_mfma_f32_32x32x16_bf16(pa3, (bf16x8){l3[0], l3[1], l3[2], l3[3], h3[0], h3[1], h3[2], h3[3]}, o[d0], 0, 0, 0); } while (0)
    PV_D0(0); PV_D0(1); PV_D0(2); PV_D0(3);
#undef PV_D0
#undef TRRD
}
constexpr int QP = 4608;
struct Blk { bf16_t* Q; const bf16_t* K; const float* flog; float fb; int voff, goff, P0, skv, kvpitch; };
struct Seam { bf16x8 qr[8]; bf16x8 st_v0, st_v1, st_k0, st_k1; };
#define ROW(p, pitch, k0, rr) ((p) + (size_t)((k0) + (rr)) * (pitch) + sc)
#define VMW() asm volatile("s_waitcnt vmcnt(0)" ::: "memory")
#define VMWN(n) asm volatile("s_waitcnt vmcnt(%0)" :: "i"(n) : "memory")
#define SLOAD_H(Kp, Vp, pitch, k0) do { S.st_v0 = load8(ROW(Vp, pitch, k0, sr)); S.st_v1 = load8(ROW(Vp, pitch, k0, 32 + sr));              \
                         S.st_k0 = load8(ROW(Kp, pitch, k0, sr)); S.st_k1 = load8(ROW(Kp, pitch, k0, 32 + sr)); } while (0)
#define SWRITE_HK(bf) do { *(bf16x8*)(K_lds + (bf) * SHM_K + kws) = S.st_k0; *(bf16x8*)(K_lds + (bf) * SHM_K + kws + 32 * 256) = S.st_k1; } while (0)
#define SWRITE_HV(bf) do { *(bf16x8*)(V_lds + (bf) * SHM_V + vst0) = S.st_v0; *(bf16x8*)(V_lds + (bf) * SHM_V + vst1) = S.st_v1; } while (0)
#define SWRITE_H(bf) do { SWRITE_HV(bf); SWRITE_HK(bf); } while (0)
__device__ __forceinline__ void prime(const Blk& cur, char* lds, Seam& S, int wid) {
    const int lane = lane_id_v();
    const int tid = wid * 64 + lane, r32 = lane & 31, hi = lane >> 5;
    const int sr = tid >> 4, sc = (tid & 15) * 8, kws = KSWZ(sr, sc * 2); char* K_lds = lds + 2 * SHM_V;
    for (int d0 = 0; d0 < 8; ++d0) S.qr[d0] = load8(cur.Q + (size_t)(wid * QBLK + r32) * QP + d0 * 16 + hi * 8);
    SLOAD_H(cur.K, cur.K + cur.voff, cur.kvpitch, 0); VMW(); SWRITE_HK(0);
    __syncthreads();
}
__device__ __forceinline__ void block(const Blk& cur, const Blk& nxt, char* lds, Seam& S, int wid) {
    const int lane = lane_id_v();
    const int tid = wid * 64 + lane, r32 = lane & 31, hi = lane >> 5;
    constexpr int W = WBIG;
    int j_hi = (cur.P0 + QB - 1) / KVBLK + 1; if (j_hi > cur.skv / KVBLK) j_hi = cur.skv / KVBLK;
    const int NT = j_hi;
    const int qlo = cur.P0 + wid * QBLK, qm = qlo + r32 - 4 * hi;
    char* V_lds = lds; char* K_lds = lds + 2 * SHM_V;
    float* ws = (float*)(lds + OFF_WS) + wid * 64; float* li_l = ws, * al_l = ws + 32;
    float* bkl = (float*)(lds + OFF_BK);
    { const int nkeys = NT * KVBLK;
      if (cur.flog) { const int k0 = 4 * tid; float f[4];
#pragma unroll
          for (int e = 0; e < 4; ++e) { float x = 0.f; if (k0 + e < nkeys) x = cur.flog[(size_t)(k0 + e) * 16] + cur.fb;
              f[e] = k0 + e < nkeys ? fminf(x, 0.f) - log1pf(__expf(-fabsf(x))) : 0.f; }
          f[1] += f[0]; f[2] += f[1]; f[3] += f[2];
          float sc = f[3];
#pragma unroll
          for (int o_ = 1; o_ < 64; o_ <<= 1) { const float t_ = __shfl_up(sc, o_); if (lane >= o_) sc += t_; }
          if (lane == 63) ws[0] = sc;
          __syncthreads();
          float off = sc - f[3];
          for (int w_ = 0; w_ < wid; ++w_) off += ((const float*)(lds + OFF_WS))[w_ * 64];
#pragma unroll
          for (int e = 0; e < 4; ++e) if (k0 + e < nkeys) bkl[k0 + e] = -(f[e] + off) * (1.f / SCALE); }
      else for (int k = tid; k < nkeys; k += NW * 64) bkl[k] = 0.f;
      __syncthreads(); }
    float m_reg = -1e30f, l_reg = 0; f32x16 o[4] = {};
    const int sr = tid >> 4, sc = (tid & 15) * 8, vst0 = v_st(sr, sc), vst1 = v_st(32 + sr, sc), kws = KSWZ(sr, sc * 2);
    const int vb0 = (int)(uintptr_t)V_lds + v_rd_base(lane);
    const bf16_t* Kh = cur.K; const bf16_t* Vh = cur.K + cur.voff; const int kvp = cur.kvpitch;
#define RESC(a) do { if (__any((a) < 1.f)) { if (hi == 0) al_l[r32] = (a); asm volatile("s_waitcnt lgkmcnt(0)" ::: "memory");              \
                     for (int d_ = 0; d_ < 4; ++d_) for (int r = 0; r < 16; ++r) o[d_][r] *= al_l[crow(r, hi)]; } } while (0)
#define KBASE(t) ((t) * KVBLK)
#define MASKT(P0_, P1_, t) do { const int kb_ = KBASE(t); if (kb_ + KVBLK - 1 > qlo) mask_tile(P0_, P1_, qm - kb_, (unsigned)W); } while (0)
#define BB(t) (bkl + KBASE(t) + 4 * hi)
    constexpr int NQL = 8;
#define SEAM_K0() do { VMWN(NQL); SWRITE_HK(0); SBAR(); } while (0)
    f32x16 pA0, pA1, pB0, pB1; float mnA, mnB, alA, alB; bf16x8 pa0, pa1, pa2, pa3;
    SWRITE_HV(0); SBAR();
    if (NT > 1) { SLOAD_H(Kh, Vh, kvp, KBASE(1)); }
    SBAR(); qkt<0>(pA0, pA1, K_lds, r32, hi, S.qr, BB(0));
    MASKT(pA0, pA1, 0); partialSM(pA0, pA1, m_reg, mnA, alA);
    if (NT > 1) { VMW(); SWRITE_H(1); }
    __syncthreads();
#define HALF_STEP(PX0, PX1, mnX, alX, PY0, PY1, alY, t, KB, VB, SB) do {                                                      \
        SBAR(); qkt<KB>(PX0, PX1, K_lds, r32, hi, S.qr, BB(t));                                                                      \
        finishSM(PY0, PY1, alY, l_reg, pa0, pa1, pa2, pa3); SBAR();                                                           \
        if ((t) + 1 < NT) { SLOAD_H(Kh, Vh, kvp, KBASE((t) + 1)); SBAR(); }                                                   \
        pv_tile<VB>(o, vb0, pa0, pa1, pa2, pa3); MASKT(PX0, PX1, (t)); partialSM(PX0, PX1, m_reg, mnX, alX);   \
        __syncthreads();                                                                                                      \
        if ((t) + 1 < NT) { VMW(); SWRITE_H(SB); }                                                                            \
        RESC(alX); __syncthreads(); } while (0)
    for (int t = 1; t + 1 < NT; t += 2) {
        HALF_STEP(pB0, pB1, mnB, alB, pA0, pA1, alA, t, 1, 0, 0);
        HALF_STEP(pA0, pA1, mnA, alA, pB0, pB1, alB, t + 1, 0, 1, 1);
    }
    const bool even = (NT & 1) == 0;
    if (even) { SBAR(); qkt<1>(pB0, pB1, K_lds, r32, hi, S.qr, BB(NT - 1)); SBAR(); }
    SLOAD_H(nxt.K, nxt.K + nxt.voff, nxt.kvpitch, 0); SBAR();
#pragma unroll
    for (int d0 = 0; d0 < 8; ++d0) S.qr[d0] = load8(nxt.Q + (size_t)(wid * QBLK + r32) * QP + d0 * 16 + hi * 8);
    SBAR();
    finishSM(pA0, pA1, alA, l_reg, pa0, pa1, pa2, pa3); SBAR();
    pv_tile<0>(o, vb0, pa0, pa1, pa2, pa3);
    if (even) { MASKT(pB0, pB1, NT - 1); partialSM(pB0, pB1, m_reg, mnB, alB); __syncthreads(); RESC(alB);
        finishSM(pB0, pB1, alB, l_reg, pa0, pa1, pa2, pa3); SBAR(); pv_tile<1>(o, vb0, pa0, pa1, pa2, pa3); }
    SBAR(); SEAM_K0();
    if (hi == 0) li_l[r32] = l_reg; asm volatile("s_waitcnt lgkmcnt(0)" ::: "memory");
    float rli[16];
#pragma unroll
    for (int r = 0; r < 16; ++r) rli[r] = __builtin_amdgcn_rcpf(li_l[crow(r, hi)]);
    bf16_t* Ow = cur.Q + (size_t)(wid * QBLK + 4 * hi) * QP + r32; const int goff = cur.goff;
#pragma unroll
    for (int r = 0; r < 16; ++r) { const int ro = ((r & 3) + 8 * (r >> 2)) * QP;
#pragma unroll
        for (int d0 = 0; d0 < 4; ++d0) { float v = o[d0][r] * rli[r];
            if (goff) v *= __uint_as_float((unsigned)Ow[goff + ro + d0 * 32] << 16);
            const float vn = dppf<0xB1>(v);
            if ((r32 & 1) == 0) *(unsigned*)(Ow + ro + d0 * 32) = cvtpk(v, vn); } }
    __syncthreads();
#undef RESC
#undef KBASE
#undef MASKT
#undef BB
#undef SEAM_K0
#undef HALF_STEP
}
#undef ROW
#undef VMW
#undef VMWN
#undef SLOAD_H
#undef SWRITE_HK
#undef SWRITE_HV
#undef SWRITE_H
#undef KSWZ
#undef SBAR
template <class Src> __device__ __forceinline__ void phase(char* lds, const Src& src, int wid) {
    Blk cur, nxt; if (!src(0, cur)) return;
    Seam S; prime(cur, lds, S, wid);
    for (int n = 0;; ++n) { const bool more = src(n + 1, nxt); if (!more) nxt = cur; block(cur, nxt, lds, S, wid); if (!more) break; cur = nxt; }
}
}

constexpr int NWAVES = 8;
#ifndef MK_LAUNCH_PER_PHASE
#define MK_LAUNCH_PER_PHASE 0
#endif
constexpr int N_PHASES = 12;

constexpr size_t KiB = 1u << 10, MiB = 1u << 20;
constexpr size_t WS_CTL = 0, CTL_ZERO_BYTES = 1 * MiB;
constexpr size_t WS_WIN0 = 1 * MiB, WS_WIN1 = WS_WIN0 + (size_t)N_IN * DM * 2;
constexpr size_t WS_WOUT0 = 20 * MiB, WS_WOUT1 = 23 * MiB;
constexpr size_t WS_WM1_0 = 26 * MiB, WS_WM1_1 = 34 * MiB, WS_WM2_0 = 42 * MiB, WS_WM2_1 = 50 * MiB;
constexpr size_t WS_WMKV = 58 * MiB;
constexpr size_t WS_PROJ = 60 * MiB;
constexpr size_t WS_XB = 204 * MiB;
constexpr size_t WS_SSQ = 236 * MiB;
constexpr size_t WS_AB = 245 * MiB;
constexpr size_t WS_MEMKV = 246 * MiB;
constexpr size_t WS_XSQ = 250 * MiB;
constexpr size_t WS_FCUM = 251 * MiB;
constexpr size_t WS_MSSQ = 251 * MiB + 512 * KiB;
constexpr size_t WS_MSQ = 251 * MiB + 768 * KiB;
constexpr size_t WS_END = 252 * MiB;
static_assert(WS_WIN1 + (size_t)N_IN * DM * 2 <= WS_WOUT0 && WS_PROJ + (size_t)MROWS * PW * 2 <= WS_XB && WS_SSQ + (size_t)36 * MROWS * 16 <= WS_AB, "d_ws map");
constexpr size_t DO_MEMB = 0;
constexpr int CW_BAR = 4096;

constexpr int LDS_BYTES = 155648;
constexpr int MISC_OFF = LDS_BYTES - 256;

#define GAS __attribute__((address_space(1)))
#define LAS __attribute__((address_space(3)))
typedef unsigned short bf16;
typedef unsigned v4u __attribute__((ext_vector_type(4)));
typedef float f32x4 __attribute__((ext_vector_type(4)));
typedef short bf16x8 __attribute__((ext_vector_type(8)));
typedef GAS unsigned gu32;
typedef GAS unsigned long long gu64;
#define RLX_AGENT __ATOMIC_RELAXED, __HIP_MEMORY_SCOPE_AGENT
#define LDS_WAIT() asm volatile("s_waitcnt lgkmcnt(0)" ::: "memory")
#define VM_WAIT() asm volatile("s_waitcnt vmcnt(0)" ::: "memory")
__device__ __forceinline__ unsigned long long rt() { return __builtin_amdgcn_s_memrealtime(); }
__device__ __forceinline__ unsigned f2bf(float f) { unsigned u = __builtin_bit_cast(unsigned, f); return (u + 0x7fffu + ((u >> 16) & 1u)) >> 16; }
__device__ __forceinline__ unsigned pk2(float lo, float hi) { return f2bf(lo) | (f2bf(hi) << 16); }

#define XB_TMO      128
#define XB_XCNT(j)  (256  + 64 * (j))
#define XB_XSUB(j)  (1280 + 64 * (j))
#define XB_XGEN(j)  (2304 + 64 * (j))
#define XB_TOP      3328
#define XB_TOPGEN   3392
#define XCD_BAR_WORDS 3456
#define XB_SPIN_CAP (1u << 18)

__device__ __forceinline__ unsigned xb_ld(unsigned* p)              { return __hip_atomic_load(p, __ATOMIC_RELAXED, __HIP_MEMORY_SCOPE_AGENT); }
__device__ __forceinline__ unsigned xb_add(unsigned* p, unsigned v) { return __hip_atomic_fetch_add(p, v, __ATOMIC_RELAXED, __HIP_MEMORY_SCOPE_AGENT); }
__device__ __forceinline__ unsigned xb_xcc_id() { return (unsigned)__builtin_amdgcn_s_getreg((3 << 11) | 20) & 0xFu; }
#define XB_SPIN(cond, bar) do { unsigned _sp = 0; while (cond) { __builtin_amdgcn_s_sleep(1); \
    if ((++_sp & 255u) == 0u) { if (xb_ld(&(bar)[XB_TMO])) break; if (_sp > XB_SPIN_CAP) { atomicAdd(&(bar)[XB_TMO], 1u); break; } } } } while (0)

struct XcdBarrier {
    unsigned* bar; unsigned x; int wv;
    volatile LAS unsigned* st;
};

__device__ __forceinline__ XcdBarrier xcd_barrier_post(unsigned* bar, volatile LAS unsigned* st) {
    XcdBarrier b; b.bar = bar; b.x = xb_xcc_id(); b.st = st;
    if (threadIdx.x == 0) (void)xb_add(&bar[XB_XCNT(b.x)], 1u);
    return b;
}
__device__ __forceinline__ void xcd_barrier_complete(unsigned* bar, unsigned x, unsigned& nloc, unsigned& nx) {
    const unsigned G = gridDim.x * gridDim.y * gridDim.z;
    unsigned sum, cnt, mine, sp = 0u;
    for (;;) {
        sum = 0u; cnt = 0u; mine = 0u;
#pragma unroll
        for (unsigned j = 0; j < 16; ++j) { const unsigned c = xb_ld(&bar[XB_XCNT(j)]); sum += c; cnt += (c > 0u) ? 1u : 0u; mine = (j == x) ? c : mine; }
        if (sum == G) break;
        __builtin_amdgcn_s_sleep(1);
        if ((++sp & 255u) == 0u) { if (xb_ld(&bar[XB_TMO])) break; if (sp > XB_SPIN_CAP) { atomicAdd(&bar[XB_TMO], 1u); break; } }
    }
    nloc = mine > 0u ? mine : 1u; nx = cnt > 0u ? cnt : 1u;
}

__device__ __forceinline__ void xcd_barrier(const XcdBarrier& b) {
    asm volatile("s_waitcnt vmcnt(0)" ::: "memory");
    __syncthreads();
    if (b.wv == 0 && lane_id_v() == 0) {
        unsigned* bar = b.bar;
        __builtin_amdgcn_s_waitcnt(0);
        unsigned nloc = b.st[0], nx = b.st[1];
        if (nloc == 0u) { xcd_barrier_complete(bar, b.x, nloc, nx); b.st[0] = nloc; b.st[1] = nx; }
        const unsigned old = xb_add(&bar[XB_XSUB(b.x)], 1u);
        const unsigned gen = old / nloc;
        if (old + 1u == (gen + 1u) * nloc) {
            __builtin_amdgcn_fence(__ATOMIC_RELEASE, "agent");
            asm volatile("s_waitcnt vmcnt(0)" ::: "memory");
            const unsigned og = xb_add(&bar[XB_TOP], 1u);
            const unsigned tg = og / nx;
            if (og + 1u == (tg + 1u) * nx) xb_add(&bar[XB_TOPGEN], 1u);
            else XB_SPIN(xb_ld(&bar[XB_TOPGEN]) == tg, bar);
            __builtin_amdgcn_fence(__ATOMIC_ACQUIRE, "agent");
            xb_add(&bar[XB_XGEN(b.x)], 1u);
            asm volatile("s_waitcnt vmcnt(0)" ::: "memory");
        } else {
            XB_SPIN(xb_ld(&bar[XB_XGEN(b.x)]) == gen, bar);
            __builtin_amdgcn_fence(__ATOMIC_ACQUIRE, "agent");
            asm volatile("s_waitcnt vmcnt(0)" ::: "memory");
        }
    }
    __syncthreads();
}


__device__ __forceinline__ float bflo(unsigned u) { return __builtin_bit_cast(float, u << 16); }
__device__ __forceinline__ float bfhi(unsigned u) { return __builtin_bit_cast(float, u & 0xffff0000u); }
typedef float f32x2_t __attribute__((ext_vector_type(2))); typedef __bf16 bf16x2_t __attribute__((ext_vector_type(2)));
__device__ __forceinline__ unsigned pkbf(float lo, float hi) { const f32x2_t v = {lo, hi}; const bf16x2_t b = __builtin_convertvector(v, bf16x2_t); return __builtin_bit_cast(unsigned, b); }
__device__ __forceinline__ float wave_sum(float v) { return add_xor32(add_xor16(row16_sum(v))); }
__device__ __forceinline__ float wave_max(float v) {
#pragma unroll
    for (int o = 1; o < 64; o <<= 1) v = fmaxf(v, __shfl_xor(v, o));
    return v;
}

struct Args { const float* in[20]; float* out; unsigned char* ws; int ph_lo, ph_hi, li, pad; };
enum { I_X = 0, I_MEM, I_MEMNW, I_WMKV, I_MEMKNW, I_NORM1, I_DNWIN, I_DNCONV, I_DNALOG, I_DNDT, I_DNONW, I_FOXWIN, I_FOXFB, I_FOXQNW, I_FOXKNW, I_MEMQNW, I_WOUT, I_NORM2, I_WM1, I_WM2 };

struct Frame {
    LAS unsigned char* lds;
    int G, bid, wv;
    const float* const* in; float* out; unsigned char* ws;
};


constexpr int CW_XCC = 32768, CW_BAD = 33792, CW_GRP = 65536;
struct GrpBar { unsigned* cnt; unsigned* tmo; int wv; bool on; };
__device__ __forceinline__ void grp_barrier(const GrpBar& gb, int seam) {
    asm volatile("s_waitcnt vmcnt(0)" ::: "memory");
    __syncthreads();
    if (gb.wv == 0 && lane_id_v() == 0) { unsigned* p = gb.cnt + seam * 64;
        (void)__hip_atomic_fetch_add(p, 1u, __ATOMIC_RELAXED, __HIP_MEMORY_SCOPE_AGENT);
        unsigned sp = 0;
        while (__hip_atomic_load(p, __ATOMIC_RELAXED, __HIP_MEMORY_SCOPE_AGENT) < 4u) { __builtin_amdgcn_s_sleep(1); if (++sp > (1u << 22)) { atomicAdd(gb.tmo, 1u); break; } }
        __builtin_amdgcn_fence(__ATOMIC_ACQUIRE, "agent");
        asm volatile("s_waitcnt vmcnt(0)" ::: "memory"); }
    __syncthreads();
}
struct Tix { int tid, lane, wave; };
__device__ __forceinline__ int lane_id() { return lane_id_v(); }
__device__ __forceinline__ Tix tix(int wv) { Tix t; t.lane = lane_id(); t.wave = wv; t.tid = wv * 64 + t.lane; return t; }
struct TSeg { const float* W; int K, ldw, src0, ncols; bf16* WT; int dst0; const float* scale; };
__device__ __forceinline__ TSeg get_seg(const Frame& F, int s) {
    TSeg t; t.scale = nullptr; t.src0 = 0; t.dst0 = 0;
    if (s < 12) {
        const int l = s / 6, j = s % 6;
        t.W = l ? F.in[I_FOXWIN] : F.in[I_DNWIN]; t.K = DM; t.ldw = l ? FOX_IN : DN_IN; t.WT = (bf16*)(F.ws + (l ? WS_WIN1 : WS_WIN0)); t.scale = F.in[I_NORM1] + l * DM;
        const int qm0 = l ? 4104 : 4112, nsc = l ? 8 : 16;
        t.ncols = 1024;
        if (j == 0) { t.src0 = 1024; t.dst0 = PC_K; } else if (j == 1) { t.src0 = 2048; t.dst0 = PC_V; } else if (j == 2) { t.src0 = 3072; t.dst0 = PC_Z; }
        else if (j == 3) { t.src0 = 0; t.dst0 = PC_Q; } else if (j == 4) { t.src0 = qm0; t.dst0 = PC_QM; t.ncols = 512; } else { t.src0 = 4096; t.dst0 = PC_AB; t.ncols = nsc; }
    } else if (s < 14) { const int l = s - 12; t.W = F.in[I_WOUT] + (size_t)l * OUT_IN * DM; t.K = OUT_IN; t.ldw = DM; t.ncols = DM; t.WT = (bf16*)(F.ws + (l ? WS_WOUT1 : WS_WOUT0)); }
    else if (s < 16) { const int l = s - 14; t.W = F.in[I_WM1] + (size_t)l * DM * FF; t.K = DM; t.ldw = FF; t.ncols = FF; t.WT = (bf16*)(F.ws + (l ? WS_WM1_1 : WS_WM1_0)); t.scale = F.in[I_NORM2] + l * DM; }
    else if (s < 18) { const int l = s - 16; t.W = F.in[I_WM2] + (size_t)l * FF * DM; t.K = FF; t.ldw = DM; t.ncols = DM; t.WT = (bf16*)(F.ws + (l ? WS_WM2_1 : WS_WM2_0)); }
    else { t.W = F.in[I_WMKV]; t.K = DM; t.ldw = DM; t.ncols = DM; t.WT = (bf16*)(F.ws + WS_WMKV); t.scale = F.in[I_MEMNW]; }
    return t;
}
__device__ __forceinline__ int seg_items(const TSeg& t) { return (t.K / 64) * ((t.ncols + 63) / 64); }
__device__ __forceinline__ void tr_load(const TSeg& t, int item, int lane, f32x4 (&v)[16]) {
    const int nblk = (t.ncols + 63) / 64, kb = item / nblk, nb = item - kb * nblk, k0 = 64 * kb, n0 = 64 * nb;
    const int n4 = (lane & 15) * 4, kr = lane >> 4; const bool ok = (n0 + n4) < t.ncols;
    const float* p = t.W + (size_t)(k0 + kr) * t.ldw + t.src0 + n0 + n4;
#pragma unroll
    for (int i = 0; i < 16; ++i) v[i] = ok ? *(const f32x4*)(p + (size_t)(4 * i) * t.ldw) : (f32x4){0.f, 0.f, 0.f, 0.f};
}
__device__ __forceinline__ void tr_store(const TSeg& t, int item, int lane, const f32x4 (&v)[16], LAS float* scr) {
    const int nblk = (t.ncols + 63) / 64, kb = item / nblk, nb = item - kb * nblk, k0 = 64 * kb, n0 = 64 * nb;
    const int n4 = (lane & 15) * 4, kr = lane >> 4;
#pragma unroll
    for (int i = 0; i < 16; ++i) *(LAS f32x4*)(scr + (4 * i + kr) * 68 + n4) = v[i];
    LDS_WAIT(); asm volatile("" ::: "memory");
    const int c = lane & 7; f32x4 s0 = {1.f, 1.f, 1.f, 1.f}, s1 = s0;
    if (t.scale) { s0 = *(const f32x4*)(t.scale + k0 + 8 * c); s1 = *(const f32x4*)(t.scale + k0 + 8 * c + 4); }
#pragma unroll
    for (int j = 0; j < 8; ++j) { const int n = (lane >> 3) + 8 * j; const LAS float* q = scr + (8 * c) * 68 + n;
        v4u o; o.x = pkbf(q[0 * 68] * s0[0], q[1 * 68] * s0[1]); o.y = pkbf(q[2 * 68] * s0[2], q[3 * 68] * s0[3]); o.z = pkbf(q[4 * 68] * s1[0], q[5 * 68] * s1[1]); o.w = pkbf(q[6 * 68] * s1[2], q[7 * 68] * s1[3]);
        if (n0 + n < t.ncols) *(v4u*)(t.WT + (size_t)(t.dst0 + n0 + n) * t.K + k0 + 8 * c) = o; }
    LDS_WAIT(); asm volatile("" ::: "memory");
}
template <int NR> __device__ __forceinline__ void rows_to_bf16(int lane, const float* x, bf16* o, float* sq) {
    f32x4 v[NR][4];
#pragma unroll
    for (int r = 0; r < NR; ++r)
#pragma unroll
        for (int j = 0; j < 4; ++j) v[r][j] = ((const f32x4*)(x + (size_t)r * DM))[lane + 64 * j];
#pragma unroll
    for (int r = 0; r < NR; ++r) { float s = 0.f;
#pragma unroll
        for (int j = 0; j < 4; ++j) s += (v[r][j].x * v[r][j].x + v[r][j].y * v[r][j].y) + (v[r][j].z * v[r][j].z + v[r][j].w * v[r][j].w);
        s = wave_sum(s);
        unsigned long long* o8 = (unsigned long long*)(o + (size_t)r * DM) + lane;
#pragma unroll
        for (int j = 0; j < 4; ++j) o8[64 * j] = (unsigned long long)pkbf(v[r][j].x, v[r][j].y) | ((unsigned long long)pkbf(v[r][j].z, v[r][j].w) << 32);
        if (lane < 16) sq[(size_t)r * 16 + lane] = lane == 0 ? s : 0.f; }
}
template <int S0, int S1> __device__ __forceinline__ void convert_weights(const Frame& F, LAS float* scr, int lane, int gw, int NGW, int base) {
#pragma unroll
    for (int s = S0; s < S1; ++s) {
        const TSeg t = get_seg(F, s); const int n = seg_items(t);
        int it = gw - (base % NGW); if (it < 0) it += NGW;
        for (; it < n; it += NGW) { f32x4 v[16]; tr_load(t, it, lane, v); tr_store(t, it, lane, v, scr); }
        base += n;
    }
}
__device__ __forceinline__ void p0_prologue(const Frame& F) {
    const Tix T = tix(F.wv);
    LAS float* scr = (LAS float*)(F.lds + T.wave * 17408);
    const int gw = F.bid * NWAVES + T.wave, NGW = F.G * NWAVES;
    for (int m = gw * 4; m < MROWS; m += NGW * 4) rows_to_bf16<4>(T.lane, F.in[I_X] + (size_t)m * DM, (bf16*)(F.ws + WS_XB) + (size_t)m * DM, (float*)(F.ws + WS_XSQ) + (size_t)m * 16);
    for (int m = gw; m < MMEM; m += NGW) rows_to_bf16<1>(T.lane, F.in[I_MEM] + (size_t)m * DM, (bf16*)((unsigned char*)F.out + DO_MEMB) + (size_t)m * DM, (float*)(F.ws + WS_MSQ) + (size_t)m * 16);
    convert_weights<0, 6>(F, scr, T.lane, gw, NGW, 0);
    convert_weights<18, 19>(F, scr, T.lane, gw, NGW, 1168);
}

typedef short dn_bf16x8 __attribute__((ext_vector_type(8)));
typedef unsigned dn_u32x2 __attribute__((ext_vector_type(2)));
__device__ __forceinline__ f32x4 mfma16(dn_bf16x8 a, dn_bf16x8 b, f32x4 c) { return __builtin_amdgcn_mfma_f32_16x16x32_bf16(a, b, c, 0, 0, 0); }
__device__ __forceinline__ f32x4 mfma4(float a, float b, f32x4 c) { return __builtin_amdgcn_mfma_f32_16x16x4f32(a, b, c, 0, 0, 0); }
__device__ __forceinline__ dn_bf16x8 pack8f(f32x4 x, f32x4 y) { v4u w; w.x = pkbf(x[0], x[1]); w.y = pkbf(x[2], x[3]); w.z = pkbf(y[0], y[1]); w.w = pkbf(y[2], y[3]); return __builtin_bit_cast(dn_bf16x8, w); }
__device__ __forceinline__ dn_u32x2 pack4f(f32x4 x) { dn_u32x2 w; w.x = pkbf(x[0], x[1]); w.y = pkbf(x[2], x[3]); return w; }
__device__ __forceinline__ unsigned short bf1(float x) { return (unsigned short)(pkbf(x, 0.f) & 0xffffu); }
constexpr size_t DO_QKS = 4 * MiB, DO_HALO = 20 * MiB, DO_EGL = 27 * MiB;
constexpr int P_RAW = 0, P_GB = 51712, P_QH = 53248, P_KH = 70656, P_VBT = 88064, P_KBGT = 106496, P_QKL = 124928, P_END = 134144;
constexpr int P_AT = 0, P_TB = 17408, P_PS = 26624, P_PS2 = 29184;
struct DnPre { v4u P[7]; float ga, gb; f32x4 cw[3][4]; };
__device__ __forceinline__ void dn_prep_load(const Frame& F, int u, DnPre& R) {
    const Tix T = tix(F.wv); const int tid = T.tid, lane = T.lane;
    const int bh = u >> 5, c = u & 31, b = bh >> 3, h = bh & 7; const size_t row0 = (size_t)b * SEQ + c * 64; const int gch = b * 32 + c;
    const bf16* proj = (const bf16*)(F.ws + WS_PROJ); const float* AB = (const float*)(F.ws + WS_AB); const bf16* halo = (const bf16*)((unsigned char*)F.out + DO_HALO);
#pragma unroll
    for (int j = 0; j < 7; ++j) { const int id = tid + 512 * j; v4u val = {0u, 0u, 0u, 0u};
        if (id < 67 * 48) { const int r = id / 48, rem = id - r * 48, seg = rem >> 4, ch = rem & 15;
            const int col = (seg == 0 ? PC_Q : seg == 1 ? PC_K : PC_V) + h * HD + ch * 8;
            if (r >= 3) val = *(const v4u*)(proj + (row0 + r - 3) * PW + col);
            else if (c > 0) val = *(const v4u*)(halo + ((size_t)(gch - 1) * 3 + r) * PW + col); }
        R.P[j] = val; }
    R.ga = AB[(row0 + lane) * 16 + h]; R.gb = AB[(row0 + lane) * 16 + 8 + h];
    const float* convw = F.in[I_DNCONV]; const int c4 = lane & 31;
#pragma unroll
    for (int seg = 0; seg < 3; ++seg)
#pragma unroll
        for (int j = 0; j < 4; ++j) R.cw[seg][j] = *(const f32x4*)(convw + j * 3072 + seg * 1024 + h * HD + 4 * c4);
}
__device__ __forceinline__ void dn_prep_unit(const Frame& F, int u, int u_next, DnPre& R) {
    const Tix T = tix(F.wv); const int tid = T.tid, lane = T.lane, wave = T.wave, m = lane & 15, g = lane >> 4;
    const int bh = u >> 5, c = u & 31, b = bh >> 3, h = bh & 7; const size_t row0 = (size_t)b * SEQ + c * 64;
    bf16* proj = (bf16*)(F.ws + WS_PROJ);
    bf16* xbimg = (bf16*)(F.ws + WS_XB) + (size_t)u * 8192; bf16* qks = (bf16*)((unsigned char*)F.out + DO_QKS) + (size_t)u * 4096; float* egl = (float*)((unsigned char*)F.out + DO_EGL);
    LAS unsigned char* L = F.lds; LAS float* GB = (LAS float*)(L + P_GB);
#pragma unroll
    for (int j = 0; j < 7; ++j) { const int id = tid + 512 * j;
        if (id < 67 * 48) { const int r = id / 48, rem = id - r * 48, seg = rem >> 4, ch = rem & 15; *(LAS v4u*)(L + P_RAW + r * 768 + seg * 256 + ch * 16) = R.P[j]; } }
    if (wave == 0) { const float a = R.ga, bb = R.gb;
        const float x = a + F.in[I_DNDT][h], sp = fmaxf(x, 0.f) + log1pf(__expf(-fabsf(x)));
        const float gt = -__expf(F.in[I_DNALOG][h]) * sp, beta = __builtin_amdgcn_rcpf(1.f + __expf(-bb));
        float gc = gt;
#pragma unroll
        for (int o = 1; o < 64; o <<= 1) { const float t = __shfl_up(gc, o); if (lane >= o) gc += t; }
        const float gl = __shfl(gc, 63);
        GB[lane] = gc; GB[64 + lane] = beta; GB[128 + lane] = beta * __expf(gc); GB[192 + lane] = __expf(gl - gc); GB[256 + lane] = __expf(gc);
        if (lane == 0) egl[u] = __expf(gl); }
    f32x4 cw[3][4];
#pragma unroll
    for (int seg = 0; seg < 3; ++seg)
#pragma unroll
        for (int j = 0; j < 4; ++j) cw[seg][j] = R.cw[seg][j];
    __syncthreads();
    if (u_next >= 0) dn_prep_load(F, u_next, R);
    { const int hf = lane >> 5, c4 = lane & 31;
#pragma unroll
      for (int jj = 0; jj < 12; ++jj) { constexpr int dummy_ = 0; (void)dummy_; const int seg = jj >> 2;
        const int wi = wave + 8 * jj, i = 2 * (wi & 31) + hf;
        f32x4 y = {0.f, 0.f, 0.f, 0.f};
#pragma unroll
        for (int j = 0; j < 4; ++j) { const f32x4 w = cw[seg][j];
            const dn_u32x2 xx = *(const LAS dn_u32x2*)(L + P_RAW + (i + j) * 768 + seg * 256 + c4 * 8);
            y[0] += w[0] * bflo(xx.x); y[1] += w[1] * bfhi(xx.x); y[2] += w[2] * bflo(xx.y); y[3] += w[3] * bfhi(xx.y); }
        f32x4 s;
#pragma unroll
        for (int e = 0; e < 4; ++e) s[e] = y[e] * __builtin_amdgcn_rcpf(1.f + __expf(-y[e]));
        if (seg < 2) { float ss = (s[0] * s[0] + s[1] * s[1]) + (s[2] * s[2] + s[3] * s[3]);
            ss = add_xor16(row16_sum(ss));
            const float r = rsqrtf(ss + EPS) * (seg == 0 ? QSCALE : 1.f);
            s = s * r;
            *(LAS dn_u32x2*)(L + (seg == 0 ? P_QH : P_KH) + i * 272 + c4 * 8) = pack4f(s);
            if (seg == 0) { const int cc = c4 & 7, p0 = cc < 4 ? 8 * cc : 8 * (cc - 4) + 4;
                *(dn_u32x2*)(proj + (row0 + i) * PW + PC_Q + h * HD + 32 * (c4 >> 3) + p0) = pack4f(s * GB[256 + i]); }
            else { const float bge = GB[128 + i];
#pragma unroll
                for (int e = 0; e < 4; ++e) *(LAS unsigned short*)(L + P_KBGT + (4 * c4 + e) * 144 + i * 2) = bf1(s[e] * bge); } }
        else { const float be = GB[64 + i];
#pragma unroll
            for (int e = 0; e < 4; ++e) *(LAS unsigned short*)(L + P_VBT + (4 * c4 + e) * 144 + i * 2) = bf1(s[e] * be); } } }
    __syncthreads();
    LAS float* AT = (LAS float*)(L + P_AT);
#pragma unroll
    for (int q = 0; q < 2; ++q) { const int tt = wave + 8 * q, it = tt >> 2, jt = tt & 3;
        f32x4 kk = {0.f, 0.f, 0.f, 0.f}, qk = {0.f, 0.f, 0.f, 0.f};
        if (jt <= it) {
#pragma unroll
            for (int kq = 0; kq < 4; ++kq) { const dn_bf16x8 bk = *(const LAS dn_bf16x8*)(L + P_KH + (16 * jt + m) * 272 + (32 * kq + 8 * g) * 2);
                const dn_bf16x8 ak = *(const LAS dn_bf16x8*)(L + P_KH + (16 * it + m) * 272 + (32 * kq + 8 * g) * 2), aq = *(const LAS dn_bf16x8*)(L + P_QH + (16 * it + m) * 272 + (32 * kq + 8 * g) * 2);
                kk = mfma16(ak, bk, kk); qk = mfma16(aq, bk, qk); } }
        const int j = 16 * jt + m, jl = j & 31, p = jl < 16 ? 8 * (jl >> 2) + (jl & 3) : 8 * ((jl - 16) >> 2) + 4 + (jl & 3);
        const float gcj = GB[j];
#pragma unroll
        for (int r = 0; r < 4; ++r) { const int i = 16 * it + 4 * g + r; const float dec = i >= j ? __expf(GB[i] - gcj) : 0.f;
            AT[i * 68 + j] = i > j ? GB[64 + i] * kk[r] * dec : 0.f;
            *(LAS unsigned short*)(L + P_QKL + i * 144 + (32 * (j >> 5) + p) * 2) = bf1(qk[r] * dec); } }
    __syncthreads();
    if (wave >= 4) { const int t4 = tid - 256;
        for (int id = t4; id < 1024; id += 256) { const int k = id >> 3, sp = (id >> 2) & 1, gg = id & 3; float o8[8];
#pragma unroll
            for (int j = 0; j < 8; ++j) { const int cc = 32 * sp + (j < 4 ? 4 * gg + j : 16 + 4 * gg + j - 4);
                o8[j] = bflo((unsigned)*(const LAS unsigned short*)(L + P_KH + cc * 272 + k * 2)) * GB[192 + cc]; }
            v4u w; w.x = pkbf(o8[0], o8[1]); w.y = pkbf(o8[2], o8[3]); w.z = pkbf(o8[4], o8[5]); w.w = pkbf(o8[6], o8[7]);
            *(v4u*)(proj + (row0 + (k >> 1)) * PW + PC_K + h * HD + (k & 1) * 64 + 32 * sp + 8 * gg) = w; }
        for (int id = t4; id < 512; id += 256) { const int i = id >> 3, j8 = (id & 7) * 8;
            *(v4u*)(qks + i * 64 + j8) = *(const LAS v4u*)(L + P_QKL + i * 144 + j8 * 2); } }
    if (wave == 0) { const int bb = g, j = m; float X[16];
        X[0] = j == 0 ? 1.f : 0.f;
#pragma unroll
        for (int i = 1; i < 16; ++i) { const LAS float* Lr = AT + (16 * bb + i) * 68 + 16 * bb; float Lv[16];
#pragma unroll
            for (int q = 0; q < (i + 3) / 4; ++q) { const f32x4 t = *(const LAS f32x4*)(Lr + 4 * q); Lv[4 * q] = t[0]; Lv[4 * q + 1] = t[1]; Lv[4 * q + 2] = t[2]; Lv[4 * q + 3] = t[3]; }
            float acc = i == j ? 1.f : 0.f;
#pragma unroll
            for (int mm = 0; mm < i; ++mm) acc -= Lv[mm] * X[mm];
            X[i] = acc; }
#pragma unroll
        for (int i = 0; i < 16; ++i) AT[(16 * bb + i) * 68 + 16 * bb + j] = X[i]; }
    __syncthreads();
    if (wave < 2) { const int lo = 2 * wave, hi = 2 * wave + 1; LAS float* PS = (LAS float*)(L + P_PS) + wave * 320;
        f32x4 acc = {0.f, 0.f, 0.f, 0.f};
#pragma unroll
        for (int s = 0; s < 4; ++s) acc = mfma4(AT[(16 * hi + m) * 68 + 16 * lo + 4 * s + g], AT[(16 * lo + 4 * s + g) * 68 + 16 * lo + m], acc);
#pragma unroll
        for (int r = 0; r < 4; ++r) PS[(4 * g + r) * 20 + m] = acc[r];
        LDS_WAIT();
        f32x4 acc2 = {0.f, 0.f, 0.f, 0.f};
#pragma unroll
        for (int s = 0; s < 4; ++s) acc2 = mfma4(AT[(16 * hi + m) * 68 + 16 * hi + 4 * s + g], PS[(4 * s + g) * 20 + m], acc2);
#pragma unroll
        for (int r = 0; r < 4; ++r) AT[(16 * hi + 4 * g + r) * 68 + 16 * lo + m] = -acc2[r]; }
    __syncthreads();
    { LAS float* PS2 = (LAS float*)(L + P_PS2); const int ti = (wave >> 1) & 1, tj = wave & 1;
      if (wave < 4) { f32x4 acc = {0.f, 0.f, 0.f, 0.f};
#pragma unroll
          for (int s = 0; s < 8; ++s) acc = mfma4(AT[(32 + 16 * ti + m) * 68 + 4 * s + g], AT[(4 * s + g) * 68 + 16 * tj + m], acc);
#pragma unroll
          for (int r = 0; r < 4; ++r) PS2[(16 * ti + 4 * g + r) * 36 + 16 * tj + m] = acc[r]; }
      __syncthreads();
      if (wave < 4) { f32x4 acc = {0.f, 0.f, 0.f, 0.f};
#pragma unroll
          for (int s = 0; s < 8; ++s) acc = mfma4(AT[(32 + 16 * ti + m) * 68 + 32 + 4 * s + g], PS2[(4 * s + g) * 36 + 16 * tj + m], acc);
#pragma unroll
          for (int r = 0; r < 4; ++r) AT[(32 + 16 * ti + 4 * g + r) * 68 + 16 * tj + m] = -acc[r]; } }
    __syncthreads();
    { const int i = tid >> 3, j0 = (tid & 7) * 8; const f32x4 t0 = *(const LAS f32x4*)(AT + i * 68 + j0), t1 = *(const LAS f32x4*)(AT + i * 68 + j0 + 4);
      v4u w; w.x = pkbf(t0[0], t0[1]); w.y = pkbf(t0[2], t0[3]); w.z = pkbf(t1[0], t1[1]); w.w = pkbf(t1[2], t1[3]);
      *(LAS v4u*)(L + P_TB + i * 144 + j0 * 2) = w; }
    __syncthreads();
#pragma unroll
    for (int q = 0; q < 8; ++q) { const int tt = wave + 8 * q; f32x4 acc = {0.f, 0.f, 0.f, 0.f};
        if (tt < 32) { const int ct = tt >> 3, nt = tt & 7;
#pragma unroll
            for (int sp = 0; sp < 2; ++sp) acc = mfma16(*(const LAS dn_bf16x8*)(L + P_TB + (16 * ct + m) * 144 + (32 * sp + 8 * g) * 2), *(const LAS dn_bf16x8*)(L + P_VBT + (16 * nt + m) * 144 + (32 * sp + 8 * g) * 2), acc);
            const int v = 16 * nt + m;
            *(dn_u32x2*)(proj + (row0 + (v >> 1)) * PW + PC_V + h * HD + (v & 1) * 64 + 16 * ct + 4 * g) = pack4f(acc); }
        else { const int t2 = tt - 32, kt = t2 >> 2, ct = t2 & 3;
#pragma unroll
            for (int sp = 0; sp < 2; ++sp) acc = mfma16(*(const LAS dn_bf16x8*)(L + P_KBGT + (16 * kt + m) * 144 + (32 * sp + 8 * g) * 2), *(const LAS dn_bf16x8*)(L + P_TB + (16 * ct + m) * 144 + (32 * sp + 8 * g) * 2), acc);
            *(dn_u32x2*)(xbimg + (16 * ct + m) * 128 + 32 * (kt >> 1) + 8 * g + 4 * (kt & 1)) = pack4f(-acc); } }
    __syncthreads();
}
constexpr int S_WN = 0, S_QG = 17408, S_KDT = 34816, S_QKM = 53248, S_UT = 62464, S_OB = 80896, S_PSQ = 114688, S_ONW = 116736, S_Z = 117248, S_END = 152064;
static_assert(S_END <= MISC_OFF, "scan LDS map");
__device__ __forceinline__ void dn_scan_unit(const Frame& F, int bh) {
    const Tix T = tix(F.wv); const int tid = T.tid, lane = T.lane, wave = T.wave, m = lane & 15, g = lane >> 4, n0 = 32 * wave;
    const int b = bh >> 3, h = bh & 7;
    bf16* proj = (bf16*)(F.ws + WS_PROJ); const bf16* xbi = (const bf16*)(F.ws + WS_XB); const bf16* qks = (const bf16*)((unsigned char*)F.out + DO_QKS); const float* egl = (const float*)((unsigned char*)F.out + DO_EGL);
    LAS unsigned char* L = F.lds;
    LAS float* OB = (LAS float*)(L + S_OB);
    constexpr int NC = SEQ / 64;
#define WGBAR() do { asm volatile("s_waitcnt lgkmcnt(0)" ::: "memory"); __builtin_amdgcn_s_barrier(); asm volatile("" ::: "memory"); } while (0)
    if (wave >= 4) {
        const int ht = tid - 256;
        const unsigned lo_lin = (unsigned)ht * 16u;
        const unsigned lo_qg = (unsigned)(((ht >> 4) * PW + (ht & 15) * 8) * 2);
        const unsigned lo_kv = (unsigned)(((ht >> 4) * PW + ((ht >> 3) & 1) * 64 + (ht & 7) * 8) * 2);
        const unsigned ld_a = (unsigned)((ht >> 4) * 272 + (ht & 15) * 16), ld_b = (unsigned)((ht >> 3) * 144 + (ht & 7) * 16);
        const unsigned lo_fin = (unsigned)(((ht >> 2) * PW + (ht & 3) * 32) * 2);
        v4u RP[12], RQ[10];
#define DN_LOAD_P(cc) do { const size_t r0_ = (size_t)b * SEQ + (cc) * 64; const size_t u_ = (size_t)bh * 32 + (cc);               \
        _Pragma("unroll") for (int j_ = 0; j_ < 4; ++j_) {                                                                                                \
            RP[j_] = *(const v4u*)((const char*)(xbi + u_ * 8192 + 2048 * j_) + lo_lin);                                                                    \
            RP[4 + j_] = *(const v4u*)((const char*)(proj + (r0_ + 16 * j_) * PW + PC_Q + h * HD) + lo_qg);                                                 \
            RP[8 + j_] = *(const v4u*)((const char*)(proj + (r0_ + 16 * j_) * PW + PC_V + h * HD) + lo_kv); } } while (0)
#define DN_LOAD_Q(cc) do { const size_t r0_ = (size_t)b * SEQ + (cc) * 64; const size_t u_ = (size_t)bh * 32 + (cc);     \
        _Pragma("unroll") for (int j_ = 0; j_ < 4; ++j_) {                                                                                                \
            RQ[j_] = *(const v4u*)((const char*)(proj + (r0_ + 16 * j_) * PW + PC_K + h * HD) + lo_kv);                                                     \
            RQ[4 + j_] = *(const v4u*)((const char*)(proj + (r0_ + 16 * j_) * PW + PC_Z + h * HD) + lo_qg); }                                               \
        _Pragma("unroll") for (int j_ = 0; j_ < 2; ++j_) RQ[8 + j_] = *(const v4u*)((const char*)(qks + u_ * 4096 + 2048 * j_) + lo_lin); } while (0)
#define DN_WRITE_P() do { _Pragma("unroll") for (int j_ = 0; j_ < 4; ++j_) {                                                                               \
            *(LAS v4u*)(L + S_WN + ld_a + j_ * 4352) = RP[j_]; *(LAS v4u*)(L + S_QG + ld_a + j_ * 4352) = RP[4 + j_]; *(LAS v4u*)(L + S_UT + ld_b + j_ * 4608) = RP[8 + j_]; } } while (0)
#define DN_WRITE_Q(cc) do { _Pragma("unroll") for (int j_ = 0; j_ < 4; ++j_) { *(LAS v4u*)(L + S_KDT + ld_b + j_ * 4608) = RQ[j_];                         \
            *(LAS v4u*)(L + S_Z + ((cc) & 1) * 17408 + ld_a + j_ * 4352) = RQ[4 + j_]; }                                                                    \
        _Pragma("unroll") for (int j_ = 0; j_ < 2; ++j_) *(LAS v4u*)(L + S_QKM + ld_b + j_ * 4608) = RQ[8 + j_]; } while (0)
#define DN_FINAL(cc) do { const int fr_ = ht >> 2, fc_ = (ht & 3) * 32; float ss_ = 0.f;     \
        _Pragma("unroll") for (int p_ = 0; p_ < 8; ++p_) { const f32x4 o_ = *(const LAS f32x4*)(OB + fr_ * 132 + fc_ + 4 * p_);                              \
            ss_ += (o_[0] * o_[0] + o_[1] * o_[1]) + (o_[2] * o_[2] + o_[3] * o_[3]); }                                                                     \
        ss_ += dppf<0xB1>(ss_); ss_ += dppf<0x4E>(ss_);                                                                                                     \
        const float rn_ = rsqrtf(ss_ * (1.f / 128.f) + EPS);                                                                                               \
        bf16* dst_ = (bf16*)((char*)(proj + ((size_t)b * SEQ + (cc) * 64) * PW + PC_Q + h * HD) + lo_fin);              \
        _Pragma("unroll") for (int p_ = 0; p_ < 4; ++p_) {                                                                                                 \
            const f32x4 oa_ = *(const LAS f32x4*)(OB + fr_ * 132 + fc_ + 8 * p_), ob_ = *(const LAS f32x4*)(OB + fr_ * 132 + fc_ + 8 * p_ + 4);             \
            const v4u z_ = *(const LAS v4u*)(L + S_Z + ((cc) & 1) * 17408 + fr_ * 272 + (fc_ + 8 * p_) * 2);                                                \
            v4u w_; w_.x = pkbf(oa_[0] * rn_ * bflo(z_.x), oa_[1] * rn_ * bfhi(z_.x)); w_.y = pkbf(oa_[2] * rn_ * bflo(z_.y), oa_[3] * rn_ * bfhi(z_.y));   \
            w_.z = pkbf(ob_[0] * rn_ * bflo(z_.z), ob_[1] * rn_ * bfhi(z_.z)); w_.w = pkbf(ob_[2] * rn_ * bflo(z_.w), ob_[3] * rn_ * bfhi(z_.w));           \
            *(v4u*)(dst_ + 8 * p_) = w_; } } while (0)
        DN_LOAD_P(0); DN_LOAD_Q(0); DN_WRITE_P(); DN_WRITE_Q(0); DN_LOAD_P(1); DN_LOAD_Q(1);
        WGBAR();
        for (int c = 0; c < NC; ++c) {
            if (c > 0) { DN_FINAL(c - 1); DN_WRITE_Q(c); if (c + 1 < NC) DN_LOAD_Q(c + 1); }
            WGBAR();
            if (c + 1 < NC) { DN_WRITE_P(); if (c + 2 < NC) DN_LOAD_P(c + 2); }
            WGBAR();
        }
        DN_FINAL(NC - 1);
#undef DN_LOAD_P
#undef DN_LOAD_Q
#undef DN_WRITE_P
#undef DN_WRITE_Q
#undef DN_FINAL
    } else {
        f32x4 Sacc[2][8];
#pragma unroll
        for (int kt = 0; kt < 8; ++kt) { Sacc[0][kt] = (f32x4){0.f, 0.f, 0.f, 0.f}; Sacc[1][kt] = (f32x4){0.f, 0.f, 0.f, 0.f}; }
        const unsigned* eglu = (const unsigned*)egl + (size_t)bh * 32;
        float eg_next = __uint_as_float(__hip_atomic_load(eglu, __ATOMIC_RELAXED, __HIP_MEMORY_SCOPE_AGENT));
        const LAS unsigned char* fa = L + m * 272 + g * 16;
        const LAS unsigned char* fb = L + m * 144 + g * 16;
#define SBAR() __builtin_amdgcn_sched_barrier(0)
#define LD_A(X, base, ct) do { _Pragma("unroll") for (int s_ = 0; s_ < 4; ++s_) X[s_] = *(const LAS dn_bf16x8*)(fa + (base) + (ct) * 4352 + s_ * 64); } while (0)
#define LD_B(X, base, i0) do { _Pragma("unroll") for (int s_ = 0; s_ < 4; ++s_) X[s_] = *(const LAS dn_bf16x8*)(fb + (base) + ((i0) + (s_ >> 1)) * 2304 + (s_ & 1) * 64); } while (0)
        WGBAR();
        for (int c = 0; c < NC; ++c) {
            const float eg = eg_next;
            if (c + 1 < NC) eg_next = __uint_as_float(__hip_atomic_load(eglu + c + 1, __ATOMIC_RELAXED, __HIP_MEMORY_SCOPE_AGENT));
            dn_bf16x8 SB[2][4], X0[4], X1[4];
            LD_A(X0, S_WN, 0);
#pragma unroll
            for (int sl = 0; sl < 2; ++sl)
#pragma unroll
                for (int s = 0; s < 4; ++s) SB[sl][s] = pack8f(Sacc[sl][2 * s], Sacc[sl][2 * s + 1]);
            f32x4 VN[2][4], O[2][4];
#pragma unroll
            for (int ct = 0; ct < 4; ++ct)
#pragma unroll
                for (int sl = 0; sl < 2; ++sl) { const dn_u32x2 uu = *(const LAS dn_u32x2*)(L + S_UT + (n0 + 16 * sl + m) * 144 + (16 * ct + 4 * g) * 2);
                    VN[sl][ct] = (f32x4){bflo(uu.x), bfhi(uu.x), bflo(uu.y), bfhi(uu.y)}; O[sl][ct] = (f32x4){0.f, 0.f, 0.f, 0.f}; }
#pragma unroll
            for (int ct = 0; ct < 4; ++ct) {
                SBAR(); LD_A(X1, S_QG, ct); SBAR();
#pragma unroll
                for (int s = 0; s < 4; ++s) { VN[0][ct] = mfma16(X0[s], SB[0][s], VN[0][ct]); VN[1][ct] = mfma16(X0[s], SB[1][s], VN[1][ct]); }
                SBAR(); if (ct < 3) LD_A(X0, S_WN, ct + 1); SBAR();
#pragma unroll
                for (int s = 0; s < 4; ++s) { O[0][ct] = mfma16(X1[s], SB[0][s], O[0][ct]); O[1][ct] = mfma16(X1[s], SB[1][s], O[1][ct]); }
            }
            dn_bf16x8 VNB[2][2];
#pragma unroll
            for (int sl = 0; sl < 2; ++sl)
#pragma unroll
                for (int sp = 0; sp < 2; ++sp) VNB[sl][sp] = pack8f(VN[sl][2 * sp], VN[sl][2 * sp + 1]);
            WGBAR();
            SBAR(); LD_B(X0, S_QKM, 0); LD_B(X1, S_QKM, 2); SBAR();
#pragma unroll
            for (int s = 0; s < 4; ++s) { O[0][s >> 1] = mfma16(X0[s], VNB[0][s & 1], O[0][s >> 1]); O[1][s >> 1] = mfma16(X0[s], VNB[1][s & 1], O[1][s >> 1]); }
            SBAR(); LD_B(X0, S_KDT, 0); SBAR();
#pragma unroll
            for (int s = 0; s < 4; ++s) { O[0][2 + (s >> 1)] = mfma16(X1[s], VNB[0][s & 1], O[0][2 + (s >> 1)]); O[1][2 + (s >> 1)] = mfma16(X1[s], VNB[1][s & 1], O[1][2 + (s >> 1)]); }
#pragma unroll
            for (int kt = 0; kt < 8; ++kt) { Sacc[0][kt] = Sacc[0][kt] * eg; Sacc[1][kt] = Sacc[1][kt] * eg; }
#pragma unroll
            for (int q = 0; q < 4; ++q) {
                if (q & 1) { SBAR(); if (q < 3) LD_B(X0, S_KDT, 2 * q + 2); SBAR();
#pragma unroll
                    for (int s = 0; s < 4; ++s) { Sacc[0][2 * q + (s >> 1)] = mfma16(X1[s], VNB[0][s & 1], Sacc[0][2 * q + (s >> 1)]); Sacc[1][2 * q + (s >> 1)] = mfma16(X1[s], VNB[1][s & 1], Sacc[1][2 * q + (s >> 1)]); } }
                else { SBAR(); LD_B(X1, S_KDT, 2 * q + 2); SBAR();
#pragma unroll
                    for (int s = 0; s < 4; ++s) { Sacc[0][2 * q + (s >> 1)] = mfma16(X0[s], VNB[0][s & 1], Sacc[0][2 * q + (s >> 1)]); Sacc[1][2 * q + (s >> 1)] = mfma16(X0[s], VNB[1][s & 1], Sacc[1][2 * q + (s >> 1)]); } }
            }
#pragma unroll
            for (int sl = 0; sl < 2; ++sl)
#pragma unroll
                for (int ct = 0; ct < 4; ++ct)
#pragma unroll
                    for (int r = 0; r < 4; ++r) OB[(16 * ct + 4 * g + r) * 132 + n0 + 16 * sl + m] = O[sl][ct][r];
            WGBAR();
        }
#undef SBAR
#undef LD_A
#undef LD_B
    }
#undef WGBAR
}
__device__ __forceinline__ void fox_blk(const Frame& F, int it, int j, att::Blk& k) {
    const int bh = it >> 2, y = it & 3, qb = j == 0 ? y : 7 - y, b = bh >> 3, h = bh & 7; const size_t row0 = (size_t)b * SEQ + qb * 256;
    bf16* proj = (bf16*)(F.ws + WS_PROJ);
    k.Q = proj + row0 * PW + PC_Q + h * HD; k.K = proj + (size_t)b * SEQ * PW + PC_K + h * HD; k.voff = PC_V - PC_K; k.goff = PC_Z - PC_Q;
    k.flog = (const float*)(F.ws + WS_AB) + (size_t)b * SEQ * 16 + h; k.fb = F.in[I_FOXFB][h]; k.P0 = qb * 256; k.skv = SEQ; k.kvpitch = PW;
}
__device__ __forceinline__ void mem_blk(const Frame& F, int idx, att::Blk& k) {
    const int b = idx >> 5, hm = (idx >> 3) & 3, qb = idx & 7; const size_t row0 = (size_t)b * SEQ + qb * 256;
    bf16* proj = (bf16*)(F.ws + WS_PROJ); const bf16* mkv = (const bf16*)(F.ws + WS_MEMKV);
    static_assert(att::QP == PW, "attention Q pitch");
    k.Q = proj + row0 * PW + PC_QM + hm * HD; k.K = mkv + (size_t)b * NMEM * DM + hm * HD; k.voff = 512; k.goff = 0;
    k.flog = nullptr; k.fb = 0.f; k.P0 = 1 << 20; k.skv = NMEM; k.kvpitch = DM;
}
struct SrcL1 { const Frame* F; int vcu;
    __device__ __forceinline__ bool operator()(int n, att::Blk& k) const { const int it = vcu + (n / 3) * F->G, j = n % 3; if (it >= 256) return false;
        if (j < 2) fox_blk(*F, it, j, k); else mem_blk(*F, it, k); return true; } };
struct SrcL0 { const Frame* F; int first, stride;
    __device__ __forceinline__ bool operator()(int n, att::Blk& k) const { const int idx = first + n * stride; if (idx >= 256) return false; mem_blk(*F, idx, k); return true; } };
#define IN(k) (lo <= (k) && (k) < hi)
#define SEAM(k) do { if (IN(k) && IN((k) + 1)) xcd_barrier(bar); } while (0)
#define SEAMG(k, s_) do { if (IN(k) && IN((k) + 1)) { if (gb.on) grp_barrier(gb, (s_)); else xcd_barrier(bar); } } while (0)
template <int layer> __device__ __forceinline__ void layer_body(const Frame& F, const XcdBarrier& bar, GrpBar& gb, bool grp_try, int lo, int hi, unsigned char* lds) {
    bf16* proj = (bf16*)(F.ws + WS_PROJ); bf16* xb = (bf16*)(F.ws + WS_XB); float* xsq = (float*)(F.ws + WS_XSQ);
    float* ab = (float*)(F.ws + WS_AB);

        const int pb = 1 + (layer ? 6 : 0);
        if (IN(pb)) {
            pg8::Gemm g{xb, (const bf16*)(F.ws + (layer ? WS_WIN1 : WS_WIN0)), MROWS, N_IN, DM, DM}; pg8::StaticOrder S; S.init(MROWS, N_IN, F.G, F.bid);
            const float* nk = layer ? F.in[I_FOXKNW] : nullptr; const float* nq = layer ? F.in[I_FOXQNW] : nullptr;
            pg8::EpiProj<true, false, layer == 0> E{proj, PW, xsq, ab, 18, (bf16*)((unsigned char*)F.out + DO_HALO), 0, layer ? 4 : 0, nk, 12, layer ? 16 : 12, nq, 16, 18, F.in[I_MEMQNW] + layer * HD, 8, 12, layer ? 2 : 1, F.in[I_DNONW]};
            pg8::gemm_phase<pg8::EpiProj<true, false, layer == 0>, pg8::StaticOrder, true, true>(F.lds, g, S, E, F.wv);
            if (layer == 0) {
                pg8::Gemm g2{(const bf16*)((unsigned char*)F.out + DO_MEMB), (const bf16*)(F.ws + WS_WMKV), MMEM, DM, DM, DM}; pg8::StaticOrder S2; S2.init(MMEM, DM, F.G, F.G - 1 - F.bid);
                pg8::EpiProj<true, false> E2{(bf16*)(F.ws + WS_MEMKV), DM, (const float*)(F.ws + WS_MSQ), nullptr, 4, nullptr, 0, 2, F.in[I_MEMKNW], 0, 0, nullptr, 0, 0, nullptr, 0, 0, 0, nullptr};
                pg8::gemm_phase<pg8::EpiProj<true, false>, pg8::StaticOrder, true, true>(F.lds, g2, S2, E2, F.wv);
            }
        }
        SEAM(pb);
        if (layer == 0 && grp_try) gb.on = __hip_atomic_load((unsigned*)((gu32*)(F.ws + WS_CTL) + CW_BAD), __ATOMIC_RELAXED, __HIP_MEMORY_SCOPE_AGENT) == 0u;
        const int pm = pb + (layer ? 1 : 2);
        if (layer == 0) {
            if (IN(pb + 1)) { constexpr int NU = BATCH * NH * (SEQ / 64); DnPre R; int u = F.bid; if (u < NU) dn_prep_load(F, u, R);
                              for (; u < NU; u += F.G) dn_prep_unit(F, u, u + F.G < NU ? u + F.G : -1, R); }
            SEAM(pb + 1);
        }
        if (IN(pm)) {
            if (layer == 0) {
                if (F.bid < 64) dn_scan_unit(F, F.bid);
                else { const SrcL0 src{&F, F.bid - 64, F.G - 64}; att::phase((char*)lds, src, F.wv);
                       __syncthreads();
                       const Tix T = tix(F.wv); convert_weights<6, 18>(F, (LAS float*)(F.lds + T.wave * 17408), T.lane, (F.bid - 64) * NWAVES + T.wave, (F.G - 64) * NWAVES, 0); }
            } else {
                const int vcu = (F.G % 8 == 0) ? (F.bid % 8) * (F.G / 8) + F.bid / 8 : F.bid;
                const SrcL1 src{&F, vcu}; att::phase((char*)lds, src, F.wv);
            }
            __syncthreads();
        }
        SEAM(pm);
        if (IN(pm + 1)) {
            pg8::Gemm g{proj + PC_Q, (const bf16*)(F.ws + (layer ? WS_WOUT1 : WS_WOUT0)), MROWS, DM, OUT_IN, PW}; pg8::StaticOrder S; S.init(MROWS, DM, F.G, F.bid);
            pg8::EpiRes<false, layer == 0> E{xb, F.out, xsq, F.in[I_X]};
            pg8::gemm_phase<pg8::EpiRes<false, layer == 0>, pg8::StaticOrder, true, true>(F.lds, g, S, E, F.wv);
        }
        SEAMG(pm + 1, layer * 3 + 0);
        if (IN(pm + 2)) {
            pg8::Gemm g{xb, (const bf16*)(F.ws + (layer ? WS_WM1_1 : WS_WM1_0)), MROWS, FF, DM, DM}; pg8::StaticOrder S; S.init(MROWS, FF, F.G, F.bid);
            pg8::EpiProj<false, true> E{proj, FF, xsq, nullptr, 16, nullptr, 0, 0, nullptr, 0, 0, nullptr, 0, 0, nullptr, 0, 0, 0, nullptr};
            pg8::gemm_phase<pg8::EpiProj<false, true>, pg8::StaticOrder, true, true>(F.lds, g, S, E, F.wv);
        }
        SEAMG(pm + 2, layer * 3 + 1);
        if (IN(pm + 3)) {
            pg8::Gemm g{proj, (const bf16*)(F.ws + (layer ? WS_WM2_1 : WS_WM2_0)), MROWS, DM, FF, FF}; pg8::StaticOrder S; S.init(MROWS, DM, F.G, F.bid);
            pg8::EpiRes<layer == 1> E{xb, F.out, xsq, nullptr};
            pg8::gemm_phase<pg8::EpiRes<layer == 1>, pg8::StaticOrder, true, true>(F.lds, g, S, E, F.wv);
        }
        if (layer == 0) SEAMG(pm + 3, 2); else SEAM(pm + 3);
    }
#undef IN
#undef SEAM
#undef SEAMG
__global__ void __launch_bounds__(NWAVES * 64, 2) hyb_fwd(Args args) {
    extern __shared__ __attribute__((aligned(16))) unsigned char lds[];
    Frame F;
    F.lds = (LAS unsigned char*)lds;
    F.G = gridDim.x; F.bid = blockIdx.x; F.in = args.in; F.out = args.out; F.ws = args.ws; F.wv = __builtin_amdgcn_readfirstlane((int)threadIdx.x >> 6);
    volatile LAS unsigned* MISC = (volatile LAS unsigned*)(F.lds + MISC_OFF);
    gu32* ctl = (gu32*)(args.ws + WS_CTL);
    for (int u = threadIdx.x; u < (LDS_BYTES - MISC_OFF) / 4; u += NWAVES * 64) ((LAS unsigned*)(F.lds + MISC_OFF))[u] = 0u;
    __syncthreads();
    XcdBarrier bar; bar.bar = (unsigned*)(ctl + CW_BAR) + args.li * XCD_BAR_WORDS; bar.x = 0; bar.st = nullptr; bar.wv = F.wv;
    if (!MK_LAUNCH_PER_PHASE) { bar = xcd_barrier_post((unsigned*)(ctl + CW_BAR) + args.li * XCD_BAR_WORDS, MISC + 8); bar.wv = F.wv; }
    const int lo = args.ph_lo, hi = args.ph_hi;
#define IN(k) (lo <= (k) && (k) < hi)
#define SEAM(k) do { if (IN(k) && IN((k) + 1)) xcd_barrier(bar); } while (0)
    bf16* proj = (bf16*)(F.ws + WS_PROJ); bf16* xb = (bf16*)(F.ws + WS_XB); float* xsq = (float*)(F.ws + WS_XSQ);
    float* ab = (float*)(F.ws + WS_AB);

    GrpBar gb; gb.cnt = (unsigned*)(ctl + CW_GRP) + (size_t)(F.bid & 63) * 8 * 64; gb.tmo = (unsigned*)(ctl + CW_BAR) + XB_TMO; gb.wv = F.wv; gb.on = false;
    const bool grp_try = !MK_LAUNCH_PER_PHASE && F.G == 256 && lo == 0 && hi == N_PHASES;
    if (grp_try && F.wv == 0 && lane_id() == 0) __hip_atomic_store((unsigned*)(ctl + CW_XCC) + F.bid, xb_xcc_id() + 1u, __ATOMIC_RELAXED, __HIP_MEMORY_SCOPE_AGENT);
    if (IN(0)) { p0_prologue(F); } SEAM(0);
    if (grp_try && F.wv == 0 && lane_id() == 0) { const unsigned mine = xb_xcc_id() + 1u; bool same = true;
        for (int k = 1; k < 4; ++k) same = same && __hip_atomic_load((unsigned*)(ctl + CW_XCC) + ((F.bid + 64 * k) & 255), __ATOMIC_RELAXED, __HIP_MEMORY_SCOPE_AGENT) == mine;
        if (!same) atomicAdd((unsigned*)(ctl + CW_BAD), 1u); }

    layer_body<0>(F, bar, gb, grp_try, lo, hi, lds);
    layer_body<1>(F, bar, gb, grp_try, lo, hi, lds);
#undef IN
#undef SEAM
}

extern "C" void kernel_launch(void* const* d_in, const int* in_sizes, int n_in, void* d_out, int out_size, void* d_ws, size_t ws_size, hipStream_t stream) {
    static int grid = 0;
    if (grid == 0) {
        if (n_in != 20 || in_sizes[0] != MROWS * DM || out_size != MROWS * DM || ws_size < WS_END) {
            fprintf(stderr, "kernel_launch: shape/workspace mismatch (n_in %d, in0 %d, out %d, ws %zu; need ws >= %zu); nothing launched\n", n_in, n_in > 0 ? in_sizes[0] : -1, out_size, ws_size, (size_t)WS_END); grid = -1; return; }
        int dev = 0, cus = 0, per_cu = 0;
        if (hipGetDevice(&dev) != hipSuccess || hipDeviceGetAttribute(&cus, hipDeviceAttributeMultiprocessorCount, dev) != hipSuccess) { fprintf(stderr, "kernel_launch: device query failed\n"); grid = -1; return; }
        if (hipFuncSetAttribute((const void*)hyb_fwd, hipFuncAttributeMaxDynamicSharedMemorySize, LDS_BYTES) != hipSuccess) { fprintf(stderr, "kernel_launch: hipFuncSetAttribute failed\n"); grid = -1; return; }
        if (hipOccupancyMaxActiveBlocksPerMultiprocessor(&per_cu, (const void*)hyb_fwd, NWAVES * 64, LDS_BYTES) != hipSuccess || per_cu < 1) {
            fprintf(stderr, "kernel_launch: occupancy query reports %d workgroups per CU; nothing launched\n", per_cu); (void)hipGetLastError(); grid = -1; return; }
        if (cus < 128) { fprintf(stderr, "kernel_launch: %d CUs; this kernel's phase program needs at least 128 workgroups; nothing launched\n", cus); grid = -1; return; }
        grid = cus;
    }
    if (grid < 0) return;
    if (hipMemsetAsync((char*)d_ws + WS_CTL, 0, CTL_ZERO_BYTES, stream) != hipSuccess) { fprintf(stderr, "kernel_launch: memset failed\n"); return; }
    Args a{};
    for (int i = 0; i < 20; ++i) a.in[i] = (const float*)d_in[i];
    a.out = (float*)d_out; a.ws = (unsigned char*)d_ws;
#if MK_LAUNCH_PER_PHASE
    for (int p = 0; p < N_PHASES; ++p) { a.ph_lo = p; a.ph_hi = p + 1; a.li = 0; hipLaunchKernelGGL(hyb_fwd, dim3(grid), dim3(NWAVES * 64), LDS_BYTES, stream, a); }
#else
    a.ph_lo = 0; a.ph_hi = N_PHASES; a.li = 0;
    hipLaunchKernelGGL(hyb_fwd, dim3(grid), dim3(NWAVES * 64), LDS_BYTES, stream, a);
#endif
    const hipError_t le = hipPeekAtLastError();
    if (le != hipSuccess) fprintf(stderr, "kernel_launch: launch failed: %s\n", hipGetErrorName(le));
}
```

```cpp
#include <hip/hip_runtime.h>
#include <cstdio>
#include <cstdint>

constexpr int BATCH = 8, SEQ = 2048, DM = 1024, MROWS = BATCH * SEQ;
constexpr int NMEM = 256, MMEM = BATCH * NMEM;
constexpr int HD = 128, NH = 8, NMH = 4, FF = 4096;
constexpr int PW = 4608;
constexpr int PC_K = 0, PC_V = 1024, PC_Z = 2048, PC_Q = 3072, PC_QM = 4096, PC_AB = 4608;
constexpr int N_IN = 4864;
constexpr int DN_IN = 4624, FOX_IN = 4616, OUT_IN = 1536;
constexpr float EPS = 1e-6f;
constexpr float QSCALE = 0.08838834764831845f;

__device__ __forceinline__ int lane_id_v() { int x; asm volatile("v_mbcnt_lo_u32_b32 %0, -1, 0\n\tv_mbcnt_hi_u32_b32 %0, -1, %0" : "=v"(x)); return x; }
template <int CTRL> __device__ __forceinline__ float dppf(float x) { return __builtin_bit_cast(float, __builtin_amdgcn_update_dpp(0, __builtin_bit_cast(int, x), CTRL, 0xf, 0xf, true)); }
__device__ __forceinline__ float row16_sum(float x) { x += dppf<0xB1>(x); x += dppf<0x4E>(x); x += dppf<0x141>(x); x += dppf<0x140>(x); return x; }
__device__ __forceinline__ float add_xor16(float x) { auto r = __builtin_amdgcn_permlane16_swap(__float_as_uint(x), __float_as_uint(x), false, false); return __uint_as_float(r[0]) + __uint_as_float(r[1]); }
__device__ __forceinline__ float add_xor32(float x) { auto r = __builtin_amdgcn_permlane32_swap(__float_as_uint(x), __float_as_uint(x), false, false); return __uint_as_float(r[0]) + __uint_as_float(r[1]); }
namespace pg8 {
#define PG8_LAS __attribute__((address_space(3)))
typedef unsigned short bf16_t;
typedef short bf16x8 __attribute__((ext_vector_type(8)));
typedef float f32x4 __attribute__((ext_vector_type(4)));
typedef unsigned u32x4 __attribute__((ext_vector_type(4)));
constexpr int BM = 256, BK = 64, HALF = 128, HTB = HALF * BK * 2  , STAGE_BYTES = 8 * HTB, NXCD = 8, WGM = 8;

__host__ __device__ __forceinline__ int lds_byte(int r, int c) { const int st = (r >> 4) * 2 + (c >> 5), rr = r & 15, cc = c & 31, ob = rr * 64 + cc * 2; return st * 1024 + (ob ^ (((ob >> 9) & 1) << 5)); }
__host__ __device__ __forceinline__ void stage_rc(int b, int& R, int& C) { const int st = b / 1024, sb = b % 1024, swz = sb ^ (((sb >> 9) & 1) << 5); R = (st >> 1) * 16 + swz / 64; C = (st & 1) * 32 + (swz % 64) / 2; }
__host__ __device__ __forceinline__ int perm32(int rho) { const int n = rho >> 4, i = rho & 15; return 8 * (i >> 2) + 4 * n + (i & 3); }

struct Unit { int pm, pn; };
struct Gemm { const bf16_t* A; const bf16_t* Bt; int M, N, K, lda; };

struct StaticOrder {
    int nM, nN, nwg, G, c;
    __host__ __device__ void init(int M, int N, int G_, int c_) { nM = M / BM; nN = N / BM; nwg = nM * nN; G = G_; c = c_; }
    __host__ __device__ bool next(int i, Unit& u) const {
        const long L = (long)i * G + c; if (L >= nwg) return false;
        int wgid = (int)L; { const int q = nwg / NXCD, r = nwg % NXCD, xcd = wgid % NXCD, off = wgid / NXCD; wgid = (xcd < r ? xcd * (q + 1) : r * (q + 1) + (xcd - r) * q) + off; }
        const int nig = WGM * nN, gid = wgid / nig, fm = gid * WGM, gsz = (nM - fm) < WGM ? (nM - fm) : WGM;
        u.pm = fm + ((wgid % nig) % gsz); u.pn = (wgid % nig) / gsz; return true;
    }
    __device__ __forceinline__ void a_ready(const Unit&) const {}
    __device__ __forceinline__ void done(const Unit&) const {}
};
struct StrideUnits {
    int start, stride, total, qm;
    __device__ __forceinline__ bool next(int i, Unit& u) const { const int t = start + i * stride; if (t >= total) return false; const int x = t & 7, j = t >> 3;
        if (qm) { u.pm = 8 * x + (j >> 1); u.pn = 16 + (j & 1); } else { u.pm = x; u.pn = j; } return true; }
    __device__ __forceinline__ void a_ready(const Unit&) const {}
    __device__ __forceinline__ void done(const Unit&) const {}
};

__device__ __forceinline__ unsigned cvt_pk_bf16(float lo, float hi) { unsigned r; asm volatile("v_cvt_pk_bf16_f32 %0, %1, %2" : "=v"(r) : "v"(lo), "v"(hi)); return r; }

constexpr int EPI_XCH = 131072, EPI_RS = 139264;
template <bool NORM, bool RELU2, bool HALO = false> struct EpiProj {
    static constexpr bool PERM = true, AFTER_DRAIN = false, USE_RS = true, ACC_INIT = false;
    bf16_t* O; int ldc; const float* xsq; float* ab; int n_main; bf16_t* halo;
    int nlo0, nhi0; const float* nw0; int nlo1, nhi1; const float* nw1; int nlo2, nhi2; const float* nw2;
    int zlo, zhi, zmode; const float* zw;
    __device__ __forceinline__ void rs_load(const Unit& u, int tid, f32x4 (&q)[4]) const { const float* p = xsq + (size_t)(u.pm * BM + tid) * 16;
#pragma unroll
        for (int i = 0; i < 4; ++i) q[i] = *(const f32x4*)(p + 4 * i); }
    __device__ __forceinline__ void rs_store(const f32x4 (&q)[4], PG8_LAS unsigned char* lds, int parity, int tid) const {
        const f32x4 t = (q[0] + q[1]) + (q[2] + q[3]);
        ((PG8_LAS float*)(lds + EPI_RS))[parity * 256 + tid] = rsqrtf(((t[0] + t[1]) + (t[2] + t[3])) * (1.0f / 1024.0f) + 1e-6f); }
    __device__ __forceinline__ void operator()(const f32x4 (&acc)[2][2][4][2], const Unit& u, int wr, int wc, int fr, int fq, PG8_LAS unsigned char* lds, int parity) const {
        const int rl0 = wr * 64 + fr, row0 = u.pm * BM + rl0, colt = u.pn * BM;
        const bool is_ab = u.pn >= n_main;
        const PG8_LAS float* RS = (const PG8_LAS float*)(lds + EPI_RS) + parity * 256;
        const float* nw = nullptr;
        if (NORM) { if (u.pn >= nlo0 && u.pn < nhi0) nw = nw0; else if (u.pn >= nlo1 && u.pn < nhi1) nw = nw1; else if (u.pn >= nlo2 && u.pn < nhi2) nw = nw2; }
        f32x4 w0 = {1.f, 1.f, 1.f, 1.f}, w1 = w0;
        const int zm = (NORM && u.pn >= zlo && u.pn < zhi) ? zmode : 0;
        if (zm == 1) { w0 = *(const f32x4*)(zw + wc * 32 + 8 * fq); w1 = *(const f32x4*)(zw + wc * 32 + 8 * fq + 4); }
        if (NORM && nw != nullptr) {
            w0 = *(const f32x4*)(nw + wc * 32 + 8 * fq); w1 = *(const f32x4*)(nw + wc * 32 + 8 * fq + 4);
            PG8_LAS float* X = (PG8_LAS float*)(lds + EPI_XCH);
#pragma unroll
            for (int ai = 0; ai < 2; ++ai)
#pragma unroll
                for (int m = 0; m < 4; ++m) { const int rl = rl0 + ai * HALF + m * 16; const float rstd = RS[rl];
#pragma unroll
                    for (int bj = 0; bj < 2; ++bj) { const f32x4 v0 = acc[ai][bj][m][0] * rstd, v1 = acc[ai][bj][m][1] * rstd;
                        float ss = ((v0[0] * v0[0] + v0[1] * v0[1]) + (v0[2] * v0[2] + v0[3] * v0[3])) + ((v1[0] * v1[0] + v1[1] * v1[1]) + (v1[2] * v1[2] + v1[3] * v1[3]));
                        ss = add_xor32(add_xor16(ss));
                        if (fq == 0) X[(bj * 256 + rl) * 4 + wc] = ss; } }
            asm volatile("s_waitcnt lgkmcnt(0)" ::: "memory"); __builtin_amdgcn_s_barrier(); asm volatile("" ::: "memory");
        }
#pragma unroll
        for (int ai = 0; ai < 2; ++ai)
#pragma unroll
            for (int m = 0; m < 4; ++m) {
                const int rl = rl0 + ai * HALF + m * 16, r = row0 + ai * HALF + m * 16;
                const float rstd = RS[rl];
                if (!is_ab) {
#pragma unroll
                    for (int bj = 0; bj < 2; ++bj) {
                        float sc = rstd;
                        if (NORM && nw != nullptr) { const f32x4 p4 = *(const PG8_LAS f32x4*)((const PG8_LAS float*)(lds + EPI_XCH) + (bj * 256 + rl) * 4);
                            sc = rstd * rsqrtf(((p4[0] + p4[1]) + (p4[2] + p4[3])) * (1.0f / 128.0f) + 1e-6f); }
                        f32x4 v0 = acc[ai][bj][m][0] * sc, v1 = acc[ai][bj][m][1] * sc;
                        if (zm != 0) {
#pragma unroll
                            for (int e = 0; e < 4; ++e) { const float s0 = __builtin_amdgcn_rcpf(1.f + __expf(-v0[e])), s1 = __builtin_amdgcn_rcpf(1.f + __expf(-v1[e]));
                                v0[e] = zm == 1 ? v0[e] * s0 : s0; v1[e] = zm == 1 ? v1[e] * s1 : s1; } }
                        v0 = v0 * w0; v1 = v1 * w1;
                        if (RELU2) {
#pragma unroll
                            for (int e = 0; e < 4; ++e) { const float a = fmaxf(v0[e], 0.f), b = fmaxf(v1[e], 0.f); v0[e] = a * a; v1[e] = b * b; }
                        }
                        u32x4 w; w.x = cvt_pk_bf16(v0[0], v0[1]); w.y = cvt_pk_bf16(v0[2], v0[3]); w.z = cvt_pk_bf16(v1[0], v1[1]); w.w = cvt_pk_bf16(v1[2], v1[3]);
                        *(u32x4*)(O + (size_t)r * ldc + colt + bj * HALF + wc * 32 + 8 * fq) = w;
                        if (HALO && m == 3 && fr >= 13) *(u32x4*)(halo + ((size_t)(r >> 6) * 3 + ((r & 63) - 61)) * ldc + colt + bj * HALF + wc * 32 + 8 * fq) = w;
                    }
                } else if (ab != nullptr && wc == 0 && fq < 2) {
                    float* p = ab + (size_t)r * 16 + 8 * fq;
                    *(f32x4*)p = acc[ai][0][m][0] * rstd; *(f32x4*)(p + 4) = acc[ai][0][m][1] * rstd;
                }
            }
    }
};
template <bool LAST = false, bool INIT_F32 = false> struct EpiRes {
    static constexpr bool PERM = true, AFTER_DRAIN = false, USE_RS = false, ACC_INIT = true;
    bf16_t* xb; float* xout; float* xsq; const float* xin;
    __device__ __forceinline__ void init(f32x4 (&acc)[2][2][4][2], const Unit& u, int wr, int wc, int fr, int fq) const {
        const int row0 = u.pm * BM + wr * 64 + fr, colt = u.pn * BM;
#pragma unroll
        for (int ai = 0; ai < 2; ++ai)
#pragma unroll
            for (int m = 0; m < 4; ++m)
#pragma unroll
                for (int bj = 0; bj < 2; ++bj) { const size_t off = (size_t)(row0 + ai * HALF + m * 16) * 1024 + colt + bj * HALF + wc * 32 + 8 * fq;
                    if (INIT_F32) { acc[ai][bj][m][0] = *(const f32x4*)(xin + off); acc[ai][bj][m][1] = *(const f32x4*)(xin + off + 4); continue; }
                    const u32x4 w = *(const u32x4*)(xb + off);
                    acc[ai][bj][m][0] = (f32x4){__uint_as_float(w.x << 16), __uint_as_float(w.x & 0xffff0000u), __uint_as_float(w.y << 16), __uint_as_float(w.y & 0xffff0000u)};
                    acc[ai][bj][m][1] = (f32x4){__uint_as_float(w.z << 16), __uint_as_float(w.z & 0xffff0000u), __uint_as_float(w.w << 16), __uint_as_float(w.w & 0xffff0000u)}; }
    }
    __device__ __forceinline__ void operator()(const f32x4 (&acc)[2][2][4][2], const Unit& u, int wr, int wc, int fr, int fq, PG8_LAS unsigned char*, int) const {
        const int row0 = u.pm * BM + wr * 64 + fr, colt = u.pn * BM;
#pragma unroll
        for (int ai = 0; ai < 2; ++ai)
#pragma unroll
            for (int m = 0; m < 4; ++m) {
                const int r = row0 + ai * HALF + m * 16; float ss = 0.f;
#pragma unroll
                for (int bj = 0; bj < 2; ++bj) {
                    const size_t off = (size_t)r * 1024 + colt + bj * HALF + wc * 32 + 8 * fq;
                    const f32x4 v0 = acc[ai][bj][m][0], v1 = acc[ai][bj][m][1];
                    if (LAST) { *(f32x4*)(xout + off) = v0; *(f32x4*)(xout + off + 4) = v1; }
                    else {
                    ss += ((v0[0] * v0[0] + v0[1] * v0[1]) + (v0[2] * v0[2] + v0[3] * v0[3])) + ((v1[0] * v1[0] + v1[1] * v1[1]) + (v1[2] * v1[2] + v1[3] * v1[3]));
                    u32x4 w; w.x = cvt_pk_bf16(v0[0], v0[1]); w.y = cvt_pk_bf16(v0[2], v0[3]); w.z = cvt_pk_bf16(v1[0], v1[1]); w.w = cvt_pk_bf16(v1[2], v1[3]);
                    *(u32x4*)(xb + off) = w; }
                }
                if (!LAST) { ss = add_xor32(add_xor16(ss));
                if (fq == 0) xsq[(size_t)r * 16 + u.pn * 4 + wc] = ss; }
            }
    }
};

template <class Epi, class Sched, bool ALIGN_EPI = false, bool SP2 = false>
__device__ __forceinline__ void gemm_phase(PG8_LAS unsigned char* lds, const Gemm g, const Sched& S, const Epi& E, int wid) {
    const int lane = lane_id_v();
    const int tid = wid * 64 + lane, wr = wid >> 2, wc = wid & 3, fr = lane & 15, fq = lane >> 4;
    const int K = g.K, nt = K / BK;
    unsigned voffA[2], voffB[2];
#pragma unroll
    for (int i = 0; i < 2; ++i) { int R, C; stage_rc(tid * 16 + i * 8192, R, C); const int Rb = Epi::PERM ? ((R & ~31) + perm32(R & 31)) : R;
        voffA[i] = (unsigned)(R * g.lda + C) * 2u; voffB[i] = (unsigned)(Rb * K + C) * 2u; }
    const size_t kstep = (size_t)(BK * 2);
    const size_t hstepA = (size_t)HALF * g.lda * 2, hstepB = (size_t)HALF * K * 2;
    const size_t tstepA = 2 * hstepA, tstepB = 2 * hstepB;
    const unsigned ldsw = (unsigned)wid * 1024u;
    const int aoff = lds_byte(wr * 64 + fr, fq * 8), boff = lds_byte(wc * 32 + fr, fq * 8);
#define PG8_SA(b, h) (((b) * 2 + (h)) * HTB)
#define PG8_SB(b, h) ((4 + (b) * 2 + (h)) * HTB)
#define PG8_STAGE(bufoff, gbase, voff) do { _Pragma("unroll") for (int _i = 0; _i < 2; ++_i) \
        __builtin_amdgcn_global_load_lds((const unsigned*)((const char*)(gbase) + (voff)[_i]), (PG8_LAS unsigned*)(lds + (bufoff) + ldsw + _i * 8192), 16, 0, 0); } while (0)
#define PG8_LDA(dst, b, h) do { _Pragma("unroll") for (int m = 0; m < 4; ++m) _Pragma("unroll") for (int k = 0; k < 2; ++k) dst[m][k] = *(const PG8_LAS bf16x8*)(lds + PG8_SA(b, h) + aoff + m * 2048 + k * 1024); } while (0)
#define PG8_LDB(dst, b, h) do { _Pragma("unroll") for (int n = 0; n < 2; ++n) _Pragma("unroll") for (int k = 0; k < 2; ++k) dst[n][k] = *(const PG8_LAS bf16x8*)(lds + PG8_SB(b, h) + boff + n * 2048 + k * 1024); } while (0)
#define PG8_MMA(ai, bj, At, Bt) do { __builtin_amdgcn_s_setprio(1); _Pragma("unroll") for (int m = 0; m < 4; ++m) _Pragma("unroll") for (int n = 0; n < 2; ++n) _Pragma("unroll") for (int k = 0; k < 2; ++k) \
        acc[ai][bj][m][n] = __builtin_amdgcn_mfma_f32_16x16x32_bf16(Bt[n][k], At[m][k], acc[ai][bj][m][n], 0, 0, 0); __builtin_amdgcn_s_setprio(0); } while (0)
#define PG8_WAIT_V(n) asm volatile("s_waitcnt vmcnt(" #n ")" ::: "memory")
#define PG8_WAIT_L(n) asm volatile("s_waitcnt lgkmcnt(" #n ")" ::: "memory")
#define PG8_BAR __builtin_amdgcn_s_barrier()
#define PG8_SCHED __builtin_amdgcn_sched_barrier(0)
    Unit cur, nxt; int ui = 0;
    if (!S.next(0, cur)) return;
    f32x4 acc[2][2][4][2];
    if constexpr (Epi::ACC_INIT) E.init(acc, cur, wr, wc, fr, fq);
    else {
#pragma unroll
    for (int a = 0; a < 2; ++a)
#pragma unroll
        for (int b = 0; b < 2; ++b)
#pragma unroll
            for (int m = 0; m < 4; ++m)
#pragma unroll
                for (int n = 0; n < 2; ++n) acc[a][b][m][n] = (f32x4){0.f, 0.f, 0.f, 0.f};
    }
    bf16x8 At[4][2], B0[2][2], B1[2][2];
    const char* cA = (const char*)g.A + (size_t)cur.pm * tstepA; const char* cB = (const char*)g.Bt + (size_t)cur.pn * tstepB;
    S.a_ready(cur);
    if constexpr (Epi::USE_RS) { if (tid < 256) { f32x4 rq[4]; E.rs_load(cur, tid, rq); E.rs_store(rq, lds, 0, tid); } }
    if constexpr (SP2) {
        PG8_STAGE(PG8_SB(0, 0), cB, voffB); PG8_STAGE(PG8_SB(0, 1), cB + hstepB, voffB); PG8_STAGE(PG8_SA(0, 0), cA, voffA); PG8_STAGE(PG8_SA(0, 1), cA + hstepA, voffA);
        if (wr == 1) PG8_BAR;
        PG8_WAIT_V(2); PG8_BAR;
        PG8_STAGE(PG8_SB(1, 0), cB + kstep, voffB); PG8_STAGE(PG8_SA(1, 0), cA + kstep, voffA); PG8_STAGE(PG8_SB(1, 1), cB + hstepB + kstep, voffB);
        PG8_WAIT_V(6); PG8_BAR;
    } else {
        PG8_STAGE(PG8_SB(0, 0), cB, voffB); PG8_STAGE(PG8_SA(0, 0), cA, voffA); PG8_STAGE(PG8_SB(0, 1), cB + hstepB, voffB); PG8_STAGE(PG8_SA(0, 1), cA + hstepA, voffA);
        if (wr == 1) PG8_BAR;
        PG8_WAIT_V(4); PG8_BAR;
        PG8_STAGE(PG8_SB(1, 0), cB + kstep, voffB); PG8_STAGE(PG8_SA(1, 0), cA + kstep, voffA); PG8_STAGE(PG8_SB(1, 1), cB + hstepB + kstep, voffB);
        PG8_WAIT_V(6); PG8_BAR;
    }
    for (;;) {
        const bool has_next = S.next(ui + 1, nxt);
        const char* nA = has_next ? (const char*)g.A + (size_t)nxt.pm * tstepA : cA; const char* nB = has_next ? (const char*)g.Bt + (size_t)nxt.pn * tstepB : cB;
        for (int t = 0; t < nt; t += 2) {
            const bool last = (t == nt - 2);
            const char* a1 = cA + (size_t)(t + 1) * kstep;
            const char* a2 = last ? nA : cA + (size_t)(t + 2) * kstep; const char* b2 = last ? nB : cB + (size_t)(t + 2) * kstep;
            const char* a3 = a2 + kstep; const char* b3 = b2 + kstep;
            if (last && has_next) S.a_ready(nxt);
            if constexpr (SP2) {
            PG8_LDB(B0, 0, 0); PG8_LDB(B1, 0, 1); PG8_SCHED; PG8_LDA(At, 0, 0); PG8_STAGE(PG8_SA(1, 1), a1 + hstepA, voffA);
            PG8_WAIT_V(8); PG8_WAIT_L(0); PG8_BAR; PG8_MMA(0, 0, At, B0); PG8_MMA(0, 1, At, B1); PG8_BAR; PG8_SCHED;
            PG8_LDA(At, 0, 1); PG8_STAGE(PG8_SB(0, 0), b2, voffB); PG8_STAGE(PG8_SB(0, 1), b2 + hstepB, voffB); PG8_STAGE(PG8_SA(0, 0), a2, voffA);
            PG8_WAIT_V(8); PG8_WAIT_L(0); PG8_BAR; PG8_MMA(1, 0, At, B0); PG8_MMA(1, 1, At, B1); PG8_BAR; PG8_SCHED;
            PG8_LDB(B0, 1, 0); PG8_LDB(B1, 1, 1); PG8_SCHED; PG8_LDA(At, 1, 0); PG8_STAGE(PG8_SA(0, 1), a2 + hstepA, voffA);
            PG8_WAIT_V(8); PG8_WAIT_L(0); PG8_BAR; PG8_MMA(0, 0, At, B0); PG8_MMA(0, 1, At, B1); PG8_BAR; PG8_SCHED;
            PG8_LDA(At, 1, 1); PG8_STAGE(PG8_SB(1, 0), b3, voffB); PG8_STAGE(PG8_SB(1, 1), b3 + hstepB, voffB); PG8_STAGE(PG8_SA(1, 0), a3, voffA);
            PG8_WAIT_V(8); PG8_WAIT_L(0); PG8_BAR; PG8_MMA(1, 0, At, B0); PG8_MMA(1, 1, At, B1); PG8_BAR; PG8_SCHED;
            } else {
            PG8_LDB(B0, 0, 0); PG8_SCHED; PG8_LDA(At, 0, 0); PG8_STAGE(PG8_SA(1, 1), a1 + hstepA, voffA);
            PG8_WAIT_L(8); PG8_BAR; PG8_WAIT_L(0); PG8_MMA(0, 0, At, B0); PG8_BAR; PG8_SCHED;
            PG8_LDB(B1, 0, 1); PG8_STAGE(PG8_SB(0, 0), b2, voffB);
            PG8_BAR; PG8_WAIT_L(0); PG8_MMA(0, 1, At, B1); PG8_BAR;
            PG8_LDA(At, 0, 1); PG8_STAGE(PG8_SA(0, 0), a2, voffA);
            PG8_BAR; PG8_WAIT_L(0); PG8_MMA(1, 0, At, B0); PG8_BAR; PG8_SCHED;
            PG8_STAGE(PG8_SB(0, 1), b2 + hstepB, voffB);
            PG8_WAIT_V(6); PG8_BAR; PG8_MMA(1, 1, At, B1); PG8_BAR;
            PG8_LDB(B0, 1, 0); PG8_SCHED; PG8_LDA(At, 1, 0); PG8_STAGE(PG8_SA(0, 1), a2 + hstepA, voffA);
            PG8_WAIT_L(8); PG8_BAR; PG8_WAIT_L(0); PG8_MMA(0, 0, At, B0); PG8_BAR; PG8_SCHED;
            PG8_LDB(B1, 1, 1); PG8_STAGE(PG8_SB(1, 0), b3, voffB);
            PG8_BAR; PG8_WAIT_L(0); PG8_MMA(0, 1, At, B1); PG8_BAR;
            PG8_LDA(At, 1, 1); PG8_STAGE(PG8_SA(1, 0), a3, voffA);
            PG8_BAR; PG8_WAIT_L(0); PG8_MMA(1, 0, At, B0); PG8_BAR; PG8_SCHED;
            PG8_STAGE(PG8_SB(1, 1), b3 + hstepB, voffB);
            PG8_WAIT_V(6); PG8_BAR; PG8_MMA(1, 1, At, B1); PG8_BAR;
            }
        }
        if constexpr (ALIGN_EPI) { if (wr == 0) PG8_BAR; }
        if constexpr (Epi::USE_RS) {
            f32x4 rq[4]; if (has_next && wid < 4) E.rs_load(nxt, wid * 64 + lane_id_v(), rq);
            E(acc, cur, wr, wc, fr, fq, lds, ui & 1);
            if (has_next && wid < 4) E.rs_store(rq, lds, (ui + 1) & 1, wid * 64 + lane_id_v());
        } else { E(acc, cur, wr, wc, fr, fq, lds, ui & 1); }
        S.done(cur);
        if (!has_next) break;
        if constexpr (Epi::ACC_INIT) E.init(acc, nxt, wr, wc, fr, fq);
        else {
#pragma unroll
        for (int a = 0; a < 2; ++a)
#pragma unroll
            for (int b = 0; b < 2; ++b)
#pragma unroll
                for (int m = 0; m < 4; ++m)
#pragma unroll
                    for (int n = 0; n < 2; ++n) acc[a][b][m][n] = (f32x4){0.f, 0.f, 0.f, 0.f};
        }
        cur = nxt; cA = nA; cB = nB; ++ui;
        if constexpr (ALIGN_EPI) { if (wr == 1) PG8_BAR; }
    }
    PG8_WAIT_V(0);
    if constexpr (!ALIGN_EPI) { if (wr == 0) PG8_BAR; }
    PG8_BAR;
    if constexpr (Epi::AFTER_DRAIN) { E.fused(acc, cur, wr, wc, fr, fq, lds, wid, lane); S.done(cur); }
#undef PG8_SA
#undef PG8_SB
#undef PG8_STAGE
#undef PG8_LDA
#undef PG8_LDB
#undef PG8_MMA
#undef PG8_WAIT_V
#undef PG8_WAIT_L
#undef PG8_BAR
#undef PG8_SCHED
}
}

namespace att {
typedef unsigned short bf16_t;
typedef short bf16x8 __attribute__((ext_vector_type(8)));
typedef short s16x4 __attribute__((ext_vector_type(4)));
typedef float f32x16 __attribute__((ext_vector_type(16)));
typedef float f32x4 __attribute__((ext_vector_type(4)));
typedef unsigned u32x4 __attribute__((ext_vector_type(4)));
constexpr int NW = 8, QBLK = 32, KVBLK = 64, QB = NW * QBLK, D = 128;
constexpr int SHM_V = KVBLK * D * 2, SHM_K = KVBLK * D * 2;
constexpr int OFF_WS = 2 * SHM_V + 2 * SHM_K, OFF_BK = OFF_WS + NW * 64 * 4, ATT_LDS = OFF_BK + 8192;
constexpr float SCALE = 0.08838834764831845f, THR = 8.f;
constexpr int WBIG = 1 << 30;
#define KSWZ(row, colB) ((row) * 256 + ((colB) ^ (((row) & 7) << 4)))
#define SBAR() __builtin_amdgcn_sched_barrier(0)
__device__ __forceinline__ int v_st(int k, int c) { const int kk = (k & ~0xC) | ((k & 4) << 1) | ((k & 8) >> 1); return ((kk >> 3) * 4 + (c >> 5)) * 512 + ((kk & 7) * 32 + (c & 31)) * 2; }
__device__ __forceinline__ int v_rd_base(int lane) { return ((lane & 3) << 3) | (((lane >> 2) & 3) << 6) | (((lane >> 4) & 1) << 5) | (((lane >> 5) & 1) << 8); }
constexpr int v_rd_off(int d0, int ks, int half) { return d0 * 512 + ks * 4096 + half * 2048; }
__device__ __forceinline__ int crow(int r, int hi) { return (r & 3) + 8 * (r >> 2) + 4 * hi; }
__device__ __forceinline__ unsigned cvtpk(float lo, float hi) { unsigned r; asm volatile("v_cvt_pk_bf16_f32 %0, %1, %2" : "=v"(r) : "v"(lo), "v"(hi)); return r; }
__device__ __forceinline__ bf16x8 load8(const bf16_t* p) { return *reinterpret_cast<const bf16x8*>(p); }
__device__ __forceinline__ void mask_tile(f32x16& p0, f32x16& p1, int dq, unsigned W) {
    const float NEG = -__builtin_inff();
#pragma unroll
    for (int r = 0; r < 16; ++r) { const int c = (r & 3) + 8 * (r >> 2);
        if ((unsigned)(dq - c) >= W) p0[r] = NEG;
        if ((unsigned)(dq - c - 32) >= W) p1[r] = NEG; }
}
__device__ __forceinline__ void partialSM(f32x16& p0, f32x16& p1, float& m_reg, float& mn, float& alpha) {
    float pmax = p0[0]; for (int r = 1; r < 16; ++r) pmax = fmaxf(pmax, p0[r]); for (int r = 0; r < 16; ++r) pmax = fmaxf(pmax, p1[r]);
    { auto rr = __builtin_amdgcn_permlane32_swap(__float_as_uint(pmax), __float_as_uint(pmax), false, false);
      pmax = fmaxf(__uint_as_float(rr[0]), __uint_as_float(rr[1])); }
    constexpr float C2 = 1.4426950408889634f * SCALE;
    if (__builtin_expect(__all((pmax - m_reg) * SCALE <= THR), 1)) { mn = m_reg; alpha = 1.f; }
    else { mn = fmaxf(m_reg, pmax); alpha = __builtin_amdgcn_exp2f((m_reg - mn) * C2); m_reg = mn; }
    const float mnL = -mn * C2;
    for (int r = 0; r < 16; ++r) p0[r] = fmaf(p0[r], C2, mnL); for (int r = 0; r < 16; ++r) p1[r] = fmaf(p1[r], C2, mnL);
    for (int r = 0; r < 16; ++r) p0[r] = __builtin_amdgcn_exp2f(p0[r]);
}
__device__ __forceinline__ void finishSM(f32x16& p0, f32x16& p1, float alpha, float& l_reg, bf16x8& pa0, bf16x8& pa1, bf16x8& pa2, bf16x8& pa3) {
    for (int r = 0; r < 16; ++r) p1[r] = __builtin_amdgcn_exp2f(p1[r]);
    float ps = 0; for (int r = 0; r < 16; ++r) ps += p0[r]; for (int r = 0; r < 16; ++r) ps += p1[r];
    { auto rr = __builtin_amdgcn_permlane32_swap(__float_as_uint(ps), __float_as_uint(ps), false, false);
      ps = __uint_as_float(rr[0]) + __uint_as_float(rr[1]); }
    l_reg = l_reg * alpha + ps;
#define PK4(P, B_, OUT) do { unsigned a0 = cvtpk(P[B_+0], P[B_+1]), a1 = cvtpk(P[B_+2], P[B_+3]);                          \
        unsigned b0 = cvtpk(P[B_+4], P[B_+5]), b1 = cvtpk(P[B_+6], P[B_+7]);                                             \
        auto r0 = __builtin_amdgcn_permlane32_swap(a0, b0, false, false); auto r1 = __builtin_amdgcn_permlane32_swap(a1, b1, false, false); \
        u32x4 w = {r0[0], r1[0], r0[1], r1[1]}; OUT = *reinterpret_cast<bf16x8*>(&w); } while (0)
    PK4(p0, 0, pa0); PK4(p0, 8, pa1); PK4(p1, 0, pa2); PK4(p1, 8, pa3);
#undef PK4
}
template <int KB>
__device__ __forceinline__ void qkt(f32x16& p0, f32x16& p1, const char* K_lds, int r32, int hi, const bf16x8* qr, const float* bb) {
#pragma unroll
    for (int g = 0; g < 4; ++g) { const f32x4 b0 = *(const f32x4*)(bb + 8 * g), b1 = *(const f32x4*)(bb + 32 + 8 * g);
#pragma unroll
        for (int i = 0; i < 4; ++i) { p0[4 * g + i] = b0[i]; p1[4 * g + i] = b1[i]; } }
    const char* kb[4];
#pragma unroll
    for (int dd = 0; dd < 4; ++dd) kb[dd] = K_lds + KB * SHM_K + KSWZ(r32, (dd * 16 + hi * 8) * 2);
#pragma unroll
    for (int d0 = 0; d0 < 8; ++d0) { const char* a = kb[d0 & 3] + (d0 >> 2) * 128;
        bf16x8 b0 = *reinterpret_cast<const bf16x8*>(a);
        bf16x8 b1 = *reinterpret_cast<const bf16x8*>(a + 32 * 256);
        p0 = __builtin_amdgcn_mfma_f32_32x32x16_bf16(b0, qr[d0], p0, 0, 0, 0);
        p1 = __builtin_amdgcn_mfma_f32_32x32x16_bf16(b1, qr[d0], p1, 0, 0, 0); }
}
template <int VB>
__device__ __forceinline__ void pv_tile(f32x16* o, int vb0, bf16x8 pa0, bf16x8 pa1, bf16x8 pa2, bf16x8 pa3) {
#define TRRD(dst, off) asm volatile("ds_read_b64_tr_b16 %0, %1 offset:%2" : "=&v"(dst) : "v"(vb0), "i"(off) : "memory")
#define PV_D0(d0) do { s16x4 l0, l1, l2, l3, h0, h1, h2, h3; constexpr int b_ = VB * SHM_V + v_rd_off(d0, 0, 0);   \
        TRRD(l0, b_); TRRD(h0, b_ + 2048); TRRD(l1, b_ + 4096); TRRD(h1, b_ + 6144); TRRD(l2, b_ + 8192); TRRD(h2, b_ + 10240); TRRD(l3, b_ + 12288); TRRD(h3, b_ + 14336); \
        asm volatile("s_waitcnt lgkmcnt(0)" ::: "memory"); SBAR();   \
        o[d0] = __builtin_amdgcn_mfma_f32_32x32x16_bf16(pa0, (bf16x8){l0[0], l0[1], l0[2], l0[3], h0[0], h0[1], h0[2], h0[3]}, o[d0], 0, 0, 0);   \
        o[d0] = __builtin_amdgcn_mfma_f32_32x32x16_bf16(pa1, (bf16x8){l1[0], l1[1], l1[2], l1[3], h1[0], h1[1], h1[2], h1[3]}, o[d0], 0, 0, 0);   \
        o[d0] = __builtin_amdgcn_mfma_f32_32x32x16_bf16(pa2, (bf16x8){l2[0], l2[1], l2[2], l2[3], h2[0], h2[1], h2[2], h2[3]}, o[d0], 0, 0, 0);   \
        o[d0] = __builtin_amdgcn_mfma_f32_32x32x16_bf16(pa3, (bf16x8){l3[0], l3[1], l3[2], l3[3], h3[0], h3[1], h3[2], h3[3]}, o[d0], 0, 0, 0); } while (0)
    PV_D0(0); PV_D0(1); PV_D0(2); PV_D0(3);
#undef PV_D0
#undef TRRD
}
constexpr int QP = 4608;
struct Blk { bf16_t* Q; const bf16_t* K; const float* flog; float fb; int voff, goff, P0, skv, kvpitch; };
struct Seam { bf16x8 qr[8]; bf16x8 st_v0, st_v1, st_k0, st_k1; };
#define ROW(p, pitch, k0, rr) ((p) + (size_t)((k0) + (rr)) * (pitch) + sc)
#define VMW() asm volatile("s_waitcnt vmcnt(0)" ::: "memory")
#define VMWN(n) asm volatile("s_waitcnt vmcnt(%0)" :: "i"(n) : "memory")
#define SLOAD_H(Kp, Vp, pitch, k0) do { S.st_v0 = load8(ROW(Vp, pitch, k0, sr)); S.st_v1 = load8(ROW(Vp, pitch, k0, 32 + sr));              \
                         S.st_k0 = load8(ROW(Kp, pitch, k0, sr)); S.st_k1 = load8(ROW(Kp, pitch, k0, 32 + sr)); } while (0)
#define SWRITE_HK(bf) do { *(bf16x8*)(K_lds + (bf) * SHM_K + kws) = S.st_k0; *(bf16x8*)(K_lds + (bf) * SHM_K + kws + 32 * 256) = S.st_k1; } while (0)
#define SWRITE_HV(bf) do { *(bf16x8*)(V_lds + (bf) * SHM_V + vst0) = S.st_v0; *(bf16x8*)(V_lds + (bf) * SHM_V + vst1) = S.st_v1; } while (0)
#define SWRITE_H(bf) do { SWRITE_HV(bf); SWRITE_HK(bf); } while (0)
__device__ __forceinline__ void prime(const Blk& cur, char* lds, Seam& S, int wid) {
    const int lane = lane_id_v();
    const int tid = wid * 64 + lane, r32 = lane & 31, hi = lane >> 5;
    const int sr = tid >> 4, sc = (tid & 15) * 8, kws = KSWZ(sr, sc * 2); char* K_lds = lds + 2 * SHM_V;
    for (int d0 = 0; d0 < 8; ++d0) S.qr[d0] = load8(cur.Q + (size_t)(wid * QBLK + r32) * QP + d0 * 16 + hi * 8);
    SLOAD_H(cur.K, cur.K + cur.voff, cur.kvpitch, 0); VMW(); SWRITE_HK(0);
    __syncthreads();
}
__device__ __forceinline__ void block(const Blk& cur, const Blk& nxt, char* lds, Seam& S, int wid) {
    const int lane = lane_id_v();
    const int tid = wid * 64 + lane, r32 = lane & 31, hi = lane >> 5;
    constexpr int W = WBIG;
    int j_hi = (cur.P0 + QB - 1) / KVBLK + 1; if (j_hi > cur.skv / KVBLK) j_hi = cur.skv / KVBLK;
    const int NT = j_hi;
    const int qlo = cur.P0 + wid * QBLK, qm = qlo + r32 - 4 * hi;
    char* V_lds = lds; char* K_lds = lds + 2 * SHM_V;
    float* ws = (float*)(lds + OFF_WS) + wid * 64; float* li_l = ws, * al_l = ws + 32;
    float* bkl = (float*)(lds + OFF_BK);
    { const int nkeys = NT * KVBLK;
      if (cur.flog) { const int k0 = 4 * tid; float f[4];
#pragma unroll
          for (int e = 0; e < 4; ++e) { float x = 0.f; if (k0 + e < nkeys) x = cur.flog[(size_t)(k0 + e) * 16] + cur.fb;
              f[e] = k0 + e < nkeys ? fminf(x, 0.f) - log1pf(__expf(-fabsf(x))) : 0.f; }
          f[1] += f[0]; f[2] += f[1]; f[3] += f[2];
          float sc = f[3];
#pragma unroll
          for (int o_ = 1; o_ < 64; o_ <<= 1) { const float t_ = __shfl_up(sc, o_); if (lane >= o_) sc += t_; }
          if (lane == 63) ws[0] = sc;
          __syncthreads();
          float off = sc - f[3];
          for (int w_ = 0; w_ < wid; ++w_) off += ((const float*)(lds + OFF_WS))[w_ * 64];
#pragma unroll
          for (int e = 0; e < 4; ++e) if (k0 + e < nkeys) bkl[k0 + e] = -(f[e] + off) * (1.f / SCALE); }
      else for (int k = tid; k < nkeys; k += NW * 64) bkl[k] = 0.f;
      __syncthreads(); }
    float m_reg = -1e30f, l_reg = 0; f32x16 o[4] = {};
    const int sr = tid >> 4, sc = (tid & 15) * 8, vst0 = v_st(sr, sc), vst1 = v_st(32 + sr, sc), kws = KSWZ(sr, sc * 2);
    const int vb0 = (int)(uintptr_t)V_lds + v_rd_base(lane);
    const bf16_t* Kh = cur.K; const bf16_t* Vh = cur.K + cur.voff; const int kvp = cur.kvpitch;
#define RESC(a) do { if (__any((a) < 1.f)) { if (hi == 0) al_l[r32] = (a); asm volatile("s_waitcnt lgkmcnt(0)" ::: "memory");              \
                     for (int d_ = 0; d_ < 4; ++d_) for (int r = 0; r < 16; ++r) o[d_][r] *= al_l[crow(r, hi)]; } } while (0)
#define KBASE(t) ((t) * KVBLK)
#define MASKT(P0_, P1_, t) do { const int kb_ = KBASE(t); if (kb_ + KVBLK - 1 > qlo) mask_tile(P0_, P1_, qm - kb_, (unsigned)W); } while (0)
#define BB(t) (bkl + KBASE(t) + 4 * hi)
    constexpr int NQL = 8;
#define SEAM_K0() do { VMWN(NQL); SWRITE_HK(0); SBAR(); } while (0)
    f32x16 pA0, pA1, pB0, pB1; float mnA, mnB, alA, alB; bf16x8 pa0, pa1, pa2, pa3;
    SWRITE_HV(0); SBAR();
    if (NT > 1) { SLOAD_H(Kh, Vh, kvp, KBASE(1)); }
    SBAR(); qkt<0>(pA0, pA1, K_lds, r32, hi, S.qr, BB(0));
    MASKT(pA0, pA1, 0); partialSM(pA0, pA1, m_reg, mnA, alA);
    if (NT > 1) { VMW(); SWRITE_H(1); }
    __syncthreads();
#define HALF_STEP(PX0, PX1, mnX, alX, PY0, PY1, alY, t, KB, VB, SB) do {                                                      \
        SBAR(); qkt<KB>(PX0, PX1, K_lds, r32, hi, S.qr, BB(t));                                                                      \
        finishSM(PY0, PY1, alY, l_reg, pa0, pa1, pa2, pa3); SBAR();                                                           \
        if ((t) + 1 < NT) { SLOAD_H(Kh, Vh, kvp, KBASE((t) + 1)); SBAR(); }                                                   \
        pv_tile<VB>(o, vb0, pa0, pa1, pa2, pa3); MASKT(PX0, PX1, (t)); partialSM(PX0, PX1, m_reg, mnX, alX);   \
        __syncthreads();                                                                                                      \
        if ((t) + 1 < NT) { VMW(); SWRITE_H(SB); }                                                                            \
        RESC(alX); __syncthreads(); } while (0)
    for (int t = 1; t + 1 < NT; t += 2) {
        HALF_STEP(pB0, pB1, mnB, alB, pA0, pA1, alA, t, 1, 0, 0);
        HALF_STEP(pA0, pA1, mnA, alA, pB0, pB1, alB, t + 1, 0, 1, 1);
    }
    const bool even = (NT & 1) == 0;
    if (even) { SBAR(); qkt<1>(pB0, pB1, K_lds, r32, hi, S.qr, BB(NT - 1)); SBAR(); }
    SLOAD_H(nxt.K, nxt.K + nxt.voff, nxt.kvpitch, 0); SBAR();
#pragma unroll
    for (int d0 = 0; d0 < 8; ++d0) S.qr[d0] = load8(nxt.Q + (size_t)(wid * QBLK + r32) * QP + d0 * 16 + hi * 8);
    SBAR();
    finishSM(pA0, pA1, alA, l_reg, pa0, pa1, pa2, pa3); SBAR();
    pv_tile<0>(o, vb0, pa0, pa1, pa2, pa3);
    if (even) { MASKT(pB0, pB1, NT - 1); partialSM(pB0, pB1, m_reg, mnB, alB); __syncthreads(); RESC(alB);
        finishSM(pB0, pB1, alB, l_reg, pa0, pa1, pa2, pa3); SBAR(); pv_tile<1>(o, vb0, pa0, pa1, pa2, pa3); }
    SBAR(); SEAM_K0();
    if (hi == 0) li_l[r32] = l_reg; asm volatile("s_waitcnt lgkmcnt(0)" ::: "memory");
    float rli[16];
#pragma unroll
    for (int r = 0; r < 16; ++r) rli[r] = __builtin_amdgcn_rcpf(li_l[crow(r, hi)]);
    bf16_t* Ow = cur.Q + (size_t)(wid * QBLK + 4 * hi) * QP + r32; const int goff = cur.goff;
#pragma unroll
    for (int r = 0; r < 16; ++r) { const int ro = ((r & 3) + 8 * (r >> 2)) * QP;
#pragma unroll
        for (int d0 = 0; d0 < 4; ++d0) { float v = o[d0][r] * rli[r];
            if (goff) v *= __uint_as_float((unsigned)Ow[goff + ro + d0 * 32] << 16);
            const float vn = dppf<0xB1>(v);
            if ((r32 & 1) == 0) *(unsigned*)(Ow + ro + d0 * 32) = cvtpk(v, vn); } }
    __syncthreads();
#undef RESC
#undef KBASE
#undef MASKT
#undef BB
#undef SEAM_K0
#undef HALF_STEP
}
#undef ROW
#undef VMW
#undef VMWN
#undef SLOAD_H
#undef SWRITE_HK
#undef SWRITE_HV
#undef SWRITE_H
#undef KSWZ
#undef SBAR
template <class Src> __device__ __forceinline__ void phase(char* lds, const Src& src, int wid) {
    Blk cur, nxt; if (!src(0, cur)) return;
    Seam S; prime(cur, lds, S, wid);
    for (int n = 0;; ++n) { const bool more = src(n + 1, nxt); if (!more) nxt = cur; block(cur, nxt, lds, S, wid); if (!more) break; cur = nxt; }
}
}

constexpr int NWAVES = 8;
#ifndef MK_LAUNCH_PER_PHASE
#define MK_LAUNCH_PER_PHASE 0
#endif
constexpr int N_PHASES = 12;

constexpr size_t KiB = 1u << 10, MiB = 1u << 20;
constexpr size_t WS_CTL = 0, CTL_ZERO_BYTES = 1 * MiB;
constexpr size_t WS_WIN0 = 1 * MiB, WS_WIN1 = WS_WIN0 + (size_t)N_IN * DM * 2;
constexpr size_t WS_WOUT0 = 20 * MiB, WS_WOUT1 = 23 * MiB;
constexpr size_t WS_WM1_0 = 26 * MiB, WS_WM1_1 = 34 * MiB, WS_WM2_0 = 42 * MiB, WS_WM2_1 = 50 * MiB;
constexpr size_t WS_WMKV = 58 * MiB;
constexpr size_t WS_PROJ = 60 * MiB;
constexpr size_t WS_XB = 204 * MiB;
constexpr size_t WS_SSQ = 236 * MiB;
constexpr size_t WS_AB = 245 * MiB;
constexpr size_t WS_MEMKV = 246 * MiB;
constexpr size_t WS_XSQ = 250 * MiB;
constexpr size_t WS_FCUM = 251 * MiB;
constexpr size_t WS_MSSQ = 251 * MiB + 512 * KiB;
constexpr size_t WS_MSQ = 251 * MiB + 768 * KiB;
constexpr size_t WS_END = 252 * MiB;
static_assert(WS_WIN1 + (size_t)N_IN * DM * 2 <= WS_WOUT0 && WS_PROJ + (size_t)MROWS * PW * 2 <= WS_XB && WS_SSQ + (size_t)36 * MROWS * 16 <= WS_AB, "d_ws map");
constexpr size_t DO_MEMB = 0;
constexpr int CW_BAR = 4096;

constexpr int LDS_BYTES = 155648;
constexpr int MISC_OFF = LDS_BYTES - 256;

#define GAS __attribute__((address_space(1)))
#define LAS __attribute__((address_space(3)))
typedef unsigned short bf16;
typedef unsigned v4u __attribute__((ext_vector_type(4)));
typedef float f32x4 __attribute__((ext_vector_type(4)));
typedef short bf16x8 __attribute__((ext_vector_type(8)));
typedef GAS unsigned gu32;
typedef GAS unsigned long long gu64;
#define RLX_AGENT __ATOMIC_RELAXED, __HIP_MEMORY_SCOPE_AGENT
#define LDS_WAIT() asm volatile("s_waitcnt lgkmcnt(0)" ::: "memory")
#define VM_WAIT() asm volatile("s_waitcnt vmcnt(0)" ::: "memory")
__device__ __forceinline__ unsigned long long rt() { return __builtin_amdgcn_s_memrealtime(); }
__device__ __forceinline__ unsigned f2bf(float f) { unsigned u = __builtin_bit_cast(unsigned, f); return (u + 0x7fffu + ((u >> 16) & 1u)) >> 16; }
__device__ __forceinline__ unsigned pk2(float lo, float hi) { return f2bf(lo) | (f2bf(hi) << 16); }

#define XB_TMO      128
#define XB_XCNT(j)  (256  + 64 * (j))
#define XB_XSUB(j)  (1280 + 64 * (j))
#define XB_XGEN(j)  (2304 + 64 * (j))
#define XB_TOP      3328
#define XB_TOPGEN   3392
#define XCD_BAR_WORDS 3456
#define XB_SPIN_CAP (1u << 18)

__device__ __forceinline__ unsigned xb_ld(unsigned* p)              { return __hip_atomic_load(p, __ATOMIC_RELAXED, __HIP_MEMORY_SCOPE_AGENT); }
__device__ __forceinline__ unsigned xb_add(unsigned* p, unsigned v) { return __hip_atomic_fetch_add(p, v, __ATOMIC_RELAXED, __HIP_MEMORY_SCOPE_AGENT); }
__device__ __forceinline__ unsigned xb_xcc_id() { return (unsigned)__builtin_amdgcn_s_getreg((3 << 11) | 20) & 0xFu; }
#define XB_SPIN(cond, bar) do { unsigned _sp = 0; while (cond) { __builtin_amdgcn_s_sleep(1); \
    if ((++_sp & 255u) == 0u) { if (xb_ld(&(bar)[XB_TMO])) break; if (_sp > XB_SPIN_CAP) { atomicAdd(&(bar)[XB_TMO], 1u); break; } } } } while (0)

struct XcdBarrier {
    unsigned* bar; unsigned x; int wv;
    volatile LAS unsigned* st;
};

__device__ __forceinline__ XcdBarrier xcd_barrier_post(unsigned* bar, volatile LAS unsigned* st) {
    XcdBarrier b; b.bar = bar; b.x = xb_xcc_id(); b.st = st;
    if (threadIdx.x == 0) (void)xb_add(&bar[XB_XCNT(b.x)], 1u);
    return b;
}
__device__ __forceinline__ void xcd_barrier_complete(unsigned* bar, unsigned x, unsigned& nloc, unsigned& nx) {
    const unsigned G = gridDim.x * gridDim.y * gridDim.z;
    unsigned sum, cnt, mine, sp = 0u;
    for (;;) {
        sum = 0u; cnt = 0u; mine = 0u;
#pragma unroll
        for (unsigned j = 0; j < 16; ++j) { const unsigned c = xb_ld(&bar[XB_XCNT(j)]); sum += c; cnt += (c > 0u) ? 1u : 0u; mine = (j == x) ? c : mine; }
        if (sum == G) break;
        __builtin_amdgcn_s_sleep(1);
        if ((++sp & 255u) == 0u) { if (xb_ld(&bar[XB_TMO])) break; if (sp > XB_SPIN_CAP) { atomicAdd(&bar[XB_TMO], 1u); break; } }
    }
    nloc = mine > 0u ? mine : 1u; nx = cnt > 0u ? cnt : 1u;
}

__device__ __forceinline__ void xcd_barrier(const XcdBarrier& b) {
    asm volatile("s_waitcnt vmcnt(0)" ::: "memory");
    __syncthreads();
    if (b.wv == 0 && lane_id_v() == 0) {
        unsigned* bar = b.bar;
        __builtin_amdgcn_s_waitcnt(0);
        unsigned nloc = b.st[0], nx = b.st[1];
        if (nloc == 0u) { xcd_barrier_complete(bar, b.x, nloc, nx); b.st[0] = nloc; b.st[1] = nx; }
        const unsigned old = xb_add(&bar[XB_XSUB(b.x)], 1u);
        const unsigned gen = old / nloc;
        if (old + 1u == (gen + 1u) * nloc) {
            __builtin_amdgcn_fence(__ATOMIC_RELEASE, "agent");
            asm volatile("s_waitcnt vmcnt(0)" ::: "memory");
            const unsigned og = xb_add(&bar[XB_TOP], 1u);
            const unsigned tg = og / nx;
            if (og + 1u == (tg + 1u) * nx) xb_add(&bar[XB_TOPGEN], 1u);
            else XB_SPIN(xb_ld(&bar[XB_TOPGEN]) == tg, bar);
            __builtin_amdgcn_fence(__ATOMIC_ACQUIRE, "agent");
            xb_add(&bar[XB_XGEN(b.x)], 1u);
            asm volatile("s_waitcnt vmcnt(0)" ::: "memory");
        } else {
            XB_SPIN(xb_ld(&bar[XB_XGEN(b.x)]) == gen, bar);
            __builtin_amdgcn_fence(__ATOMIC_ACQUIRE, "agent");
            asm volatile("s_waitcnt vmcnt(0)" ::: "memory");
        }
    }
    __syncthreads();
}


__device__ __forceinline__ float bflo(unsigned u) { return __builtin_bit_cast(float, u << 16); }
__device__ __forceinline__ float bfhi(unsigned u) { return __builtin_bit_cast(float, u & 0xffff0000u); }
typedef float f32x2_t __attribute__((ext_vector_type(2))); typedef __bf16 bf16x2_t __attribute__((ext_vector_type(2)));
__device__ __forceinline__ unsigned pkbf(float lo, float hi) { const f32x2_t v = {lo, hi}; const bf16x2_t b = __builtin_convertvector(v, bf16x2_t); return __builtin_bit_cast(unsigned, b); }
__device__ __forceinline__ float wave_sum(float v) { return add_xor32(add_xor16(row16_sum(v))); }
__device__ __forceinline__ float wave_max(float v) {
#pragma unroll
    for (int o = 1; o < 64; o <<= 1) v = fmaxf(v, __shfl_xor(v, o));
    return v;
}

struct Args { const float* in[20]; float* out; unsigned char* ws; int ph_lo, ph_hi, li, pad; };
enum { I_X = 0, I_MEM, I_MEMNW, I_WMKV, I_MEMKNW, I_NORM1, I_DNWIN, I_DNCONV, I_DNALOG, I_DNDT, I_DNONW, I_FOXWIN, I_FOXFB, I_FOXQNW, I_FOXKNW, I_MEMQNW, I_WOUT, I_NORM2, I_WM1, I_WM2 };

struct Frame {
    LAS unsigned char* lds;
    int G, bid, wv;
    const float* const* in; float* out; unsigned char* ws;
};


constexpr int CW_XCC = 32768, CW_BAD = 33792, CW_GRP = 65536;
struct GrpBar { unsigned* cnt; unsigned* tmo; int wv; bool on; };
__device__ __forceinline__ void grp_barrier(const GrpBar& gb, int seam) {
    asm volatile("s_waitcnt vmcnt(0)" ::: "memory");
    __syncthreads();
    if (gb.wv == 0 && lane_id_v() == 0) { unsigned* p = gb.cnt + seam * 64;
        (void)__hip_atomic_fetch_add(p, 1u, __ATOMIC_RELAXED, __HIP_MEMORY_SCOPE_AGENT);
        unsigned sp = 0;
        while (__hip_atomic_load(p, __ATOMIC_RELAXED, __HIP_MEMORY_SCOPE_AGENT) < 4u) { __builtin_amdgcn_s_sleep(1); if (++sp > (1u << 22)) { atomicAdd(gb.tmo, 1u); break; } }
        __builtin_amdgcn_fence(__ATOMIC_ACQUIRE, "agent");
        asm volatile("s_waitcnt vmcnt(0)" ::: "memory"); }
    __syncthreads();
}
struct Tix { int tid, lane, wave; };
__device__ __forceinline__ int lane_id() { return lane_id_v(); }
__device__ __forceinline__ Tix tix(int wv) { Tix t; t.lane = lane_id(); t.wave = wv; t.tid = wv * 64 + t.lane; return t; }
struct TSeg { const float* W; int K, ldw, src0, ncols; bf16* WT; int dst0; const float* scale; };
__device__ __forceinline__ TSeg get_seg(const Frame& F, int s) {
    TSeg t; t.scale = nullptr; t.src0 = 0; t.dst0 = 0;
    if (s < 12) {
        const int l = s / 6, j = s % 6;
        t.W = l ? F.in[I_FOXWIN] : F.in[I_DNWIN]; t.K = DM; t.ldw = l ? FOX_IN : DN_IN; t.WT = (bf16*)(F.ws + (l ? WS_WIN1 : WS_WIN0)); t.scale = F.in[I_NORM1] + l * DM;
        const int qm0 = l ? 4104 : 4112, nsc = l ? 8 : 16;
        t.ncols = 1024;
        if (j == 0) { t.src0 = 1024; t.dst0 = PC_K; } else if (j == 1) { t.src0 = 2048; t.dst0 = PC_V; } else if (j == 2) { t.src0 = 3072; t.dst0 = PC_Z; }
        else if (j == 3) { t.src0 = 0; t.dst0 = PC_Q; } else if (j == 4) { t.src0 = qm0; t.dst0 = PC_QM; t.ncols = 512; } else { t.src0 = 4096; t.dst0 = PC_AB; t.ncols = nsc; }
    } else if (s < 14) { const int l = s - 12; t.W = F.in[I_WOUT] + (size_t)l * OUT_IN * DM; t.K = OUT_IN; t.ldw = DM; t.ncols = DM; t.WT = (bf16*)(F.ws + (l ? WS_WOUT1 : WS_WOUT0)); }
    else if (s < 16) { const int l = s - 14; t.W = F.in[I_WM1] + (size_t)l * DM * FF; t.K = DM; t.ldw = FF; t.ncols = FF; t.WT = (bf16*)(F.ws + (l ? WS_WM1_1 : WS_WM1_0)); t.scale = F.in[I_NORM2] + l * DM; }
    else if (s < 18) { const int l = s - 16; t.W = F.in[I_WM2] + (size_t)l * FF * DM; t.K = FF; t.ldw = DM; t.ncols = DM; t.WT = (bf16*)(F.ws + (l ? WS_WM2_1 : WS_WM2_0)); }
    else { t.W = F.in[I_WMKV]; t.K = DM; t.ldw = DM; t.ncols = DM; t.WT = (bf16*)(F.ws + WS_WMKV); t.scale = F.in[I_MEMNW]; }
    return t;
}
__device__ __forceinline__ int seg_items(const TSeg& t) { return (t.K / 64) * ((t.ncols + 63) / 64); }
__device__ __forceinline__ void tr_load(const TSeg& t, int item, int lane, f32x4 (&v)[16]) {
    const int nblk = (t.ncols + 63) / 64, kb = item / nblk, nb = item - kb * nblk, k0 = 64 * kb, n0 = 64 * nb;
    const int n4 = (lane & 15) * 4, kr = lane >> 4; const bool ok = (n0 + n4) < t.ncols;
    const float* p = t.W + (size_t)(k0 + kr) * t.ldw + t.src0 + n0 + n4;
#pragma unroll
    for (int i = 0; i < 16; ++i) v[i] = ok ? *(const f32x4*)(p + (size_t)(4 * i) * t.ldw) : (f32x4){0.f, 0.f, 0.f, 0.f};
}
__device__ __forceinline__ void tr_store(const TSeg& t, int item, int lane, const f32x4 (&v)[16], LAS float* scr) {
    const int nblk = (t.ncols + 63) / 64, kb = item / nblk, nb = item - kb * nblk, k0 = 64 * kb, n0 = 64 * nb;
    const int n4 = (lane & 15) * 4, kr = lane >> 4;
#pragma unroll
    for (int i = 0; i < 16; ++i) *(LAS f32x4*)(scr + (4 * i + kr) * 68 + n4) = v[i];
    LDS_WAIT(); asm volatile("" ::: "memory");
    const int c = lane & 7; f32x4 s0 = {1.f, 1.f, 1.f, 1.f}, s1 = s0;
    if (t.scale) { s0 = *(const f32x4*)(t.scale + k0 + 8 * c); s1 = *(const f32x4*)(t.scale + k0 + 8 * c + 4); }
#pragma unroll
    for (int j = 0; j < 8; ++j) { const int n = (lane >> 3) + 8 * j; const LAS float* q = scr + (8 * c) * 68 + n;
        v4u o; o.x = pkbf(q[0 * 68] * s0[0], q[1 * 68] * s0[1]); o.y = pkbf(q[2 * 68] * s0[2], q[3 * 68] * s0[3]); o.z = pkbf(q[4 * 68] * s1[0], q[5 * 68] * s1[1]); o.w = pkbf(q[6 * 68] * s1[2], q[7 * 68] * s1[3]);
        if (n0 + n < t.ncols) *(v4u*)(t.WT + (size_t)(t.dst0 + n0 + n) * t.K + k0 + 8 * c) = o; }
    LDS_WAIT(); asm volatile("" ::: "memory");
}
template <int NR> __device__ __forceinline__ void rows_to_bf16(int lane, const float* x, bf16* o, float* sq) {
    f32x4 v[NR][4];
#pragma unroll
    for (int r = 0; r < NR; ++r)
#pragma unroll
        for (int j = 0; j < 4; ++j) v[r][j] = ((const f32x4*)(x + (size_t)r * DM))[lane + 64 * j];
#pragma unroll
    for (int r = 0; r < NR; ++r) { float s = 0.f;
#pragma unroll
        for (int j = 0; j < 4; ++j) s += (v[r][j].x * v[r][j].x + v[r][j].y * v[r][j].y) + (v[r][j].z * v[r][j].z + v[r][j].w * v[r][j].w);
        s = wave_sum(s);
        unsigned long long* o8 = (unsigned long long*)(o + (size_t)r * DM) + lane;
#pragma unroll
        for (int j = 0; j < 4; ++j) o8[64 * j] = (unsigned long long)pkbf(v[r][j].x, v[r][j].y) | ((unsigned long long)pkbf(v[r][j].z, v[r][j].w) << 32);
        if (lane < 16) sq[(size_t)r * 16 + lane] = lane == 0 ? s : 0.f; }
}
template <int S0, int S1> __device__ __forceinline__ void convert_weights(const Frame& F, LAS float* scr, int lane, int gw, int NGW, int base) {
#pragma unroll
    for (int s = S0; s < S1; ++s) {
        const TSeg t = get_seg(F, s); const int n = seg_items(t);
        int it = gw - (base % NGW); if (it < 0) it += NGW;
        f32x4 va[16], vb[16];
        if (it < n) tr_load(t, it, lane, va);
        while (it < n) {
            int nx = it + NGW; if (nx < n) tr_load(t, nx, lane, vb);
            tr_store(t, it, lane, va, scr); it = nx; if (it >= n) break;
            nx = it + NGW; if (nx < n) tr_load(t, nx, lane, va);
            tr_store(t, it, lane, vb, scr); it = nx;
        }
        base += n;
    }
}
__device__ __forceinline__ void p0_prologue(const Frame& F) {
    const Tix T = tix(F.wv);
    LAS float* scr = (LAS float*)(F.lds + T.wave * 17408);
    const int gw = F.bid * NWAVES + T.wave, NGW = F.G * NWAVES;
    for (int m = gw * 4; m < MROWS; m += NGW * 4) rows_to_bf16<4>(T.lane, F.in[I_X] + (size_t)m * DM, (bf16*)(F.ws + WS_XB) + (size_t)m * DM, (float*)(F.ws + WS_XSQ) + (size_t)m * 16);
    for (int m = gw; m < MMEM; m += NGW) rows_to_bf16<1>(T.lane, F.in[I_MEM] + (size_t)m * DM, (bf16*)((unsigned char*)F.out + DO_MEMB) + (size_t)m * DM, (float*)(F.ws + WS_MSQ) + (size_t)m * 16);
    convert_weights<0, 6>(F, scr, T.lane, gw, NGW, 0);
    convert_weights<18, 19>(F, scr, T.lane, gw, NGW, 1168);
}

typedef short dn_bf16x8 __attribute__((ext_vector_type(8)));
typedef unsigned dn_u32x2 __attribute__((ext_vector_type(2)));
__device__ __forceinline__ f32x4 mfma16(dn_bf16x8 a, dn_bf16x8 b, f32x4 c) { return __builtin_amdgcn_mfma_f32_16x16x32_bf16(a, b, c, 0, 0, 0); }
__device__ __forceinline__ f32x4 mfma4(float a, float b, f32x4 c) { return __builtin_amdgcn_mfma_f32_16x16x4f32(a, b, c, 0, 0, 0); }
__device__ __forceinline__ dn_bf16x8 pack8f(f32x4 x, f32x4 y) { v4u w; w.x = pkbf(x[0], x[1]); w.y = pkbf(x[2], x[3]); w.z = pkbf(y[0], y[1]); w.w = pkbf(y[2], y[3]); return __builtin_bit_cast(dn_bf16x8, w); }
__device__ __forceinline__ dn_u32x2 pack4f(f32x4 x) { dn_u32x2 w; w.x = pkbf(x[0], x[1]); w.y = pkbf(x[2], x[3]); return w; }
__device__ __forceinline__ unsigned short bf1(float x) { return (unsigned short)(pkbf(x, 0.f) & 0xffffu); }
constexpr size_t DO_QKS = 4 * MiB, DO_HALO = 20 * MiB, DO_EGL = 27 * MiB, DO_WNEG = 28 * MiB;
constexpr int P_RAW = 0, P_GB = 51712, P_QH = 53248, P_KH = 70656, P_VBT = 88064, P_KBGT = 106496, P_QKL = 124928, P_END = 134144;
constexpr int P_AT = 0, P_TB = 17408, P_PS = 26624, P_PS2 = 29184;
struct DnPre { v4u P[7]; float ga, gb; f32x4 cw[3][4]; };
__device__ __forceinline__ void dn_prep_load(const Frame& F, int u, DnPre& R) {
    const Tix T = tix(F.wv); const int tid = T.tid, lane = T.lane;
    const int bh = u >> 5, c = u & 31, b = bh >> 3, h = bh & 7; const size_t row0 = (size_t)b * SEQ + c * 64; const int gch = b * 32 + c;
    const bf16* proj = (const bf16*)(F.ws + WS_PROJ); const float* AB = (const float*)(F.ws + WS_AB); const bf16* halo = (const bf16*)((unsigned char*)F.out + DO_HALO);
#pragma unroll
    for (int j = 0; j < 7; ++j) { const int id = tid + 512 * j; v4u val = {0u, 0u, 0u, 0u};
        if (id < 67 * 48) { const int r = id / 48, rem = id - r * 48, seg = rem >> 4, ch = rem & 15;
            const int col = (seg == 0 ? PC_Q : seg == 1 ? PC_K : PC_V) + h * HD + ch * 8;
            if (r >= 3) val = *(const v4u*)(proj + (row0 + r - 3) * PW + col);
            else if (c > 0) val = *(const v4u*)(halo + ((size_t)(gch - 1) * 3 + r) * PW + col); }
        R.P[j] = val; }
    R.ga = AB[(row0 + lane) * 16 + h]; R.gb = AB[(row0 + lane) * 16 + 8 + h];
    const float* convw = F.in[I_DNCONV]; const int c4 = lane & 31;
#pragma unroll
    for (int seg = 0; seg < 3; ++seg)
#pragma unroll
        for (int j = 0; j < 4; ++j) R.cw[seg][j] = *(const f32x4*)(convw + j * 3072 + seg * 1024 + h * HD + 4 * c4);
}
__device__ __forceinline__ void dn_prep_unit(const Frame& F, int u, int u_next, DnPre& R) {
    const Tix T = tix(F.wv); const int tid = T.tid, lane = T.lane, wave = T.wave, m = lane & 15, g = lane >> 4;
    const int bh = u >> 5, c = u & 31, b = bh >> 3, h = bh & 7; const size_t row0 = (size_t)b * SEQ + c * 64;
    bf16* proj = (bf16*)(F.ws + WS_PROJ);
    bf16* xbimg = (bf16*)((unsigned char*)F.out + DO_WNEG) + (size_t)u * 8192; bf16* qks = (bf16*)((unsigned char*)F.out + DO_QKS) + (size_t)u * 4096; float* egl = (float*)((unsigned char*)F.out + DO_EGL);
    LAS unsigned char* L = F.lds; LAS float* GB = (LAS float*)(L + P_GB);
#pragma unroll
    for (int j = 0; j < 7; ++j) { const int id = tid + 512 * j;
        if (id < 67 * 48) { const int r = id / 48, rem = id - r * 48, seg = rem >> 4, ch = rem & 15; *(LAS v4u*)(L + P_RAW + r * 768 + seg * 256 + ch * 16) = R.P[j]; } }
    if (wave == 0) { const float a = R.ga, bb = R.gb;
        const float x = a + F.in[I_DNDT][h], sp = fmaxf(x, 0.f) + log1pf(__expf(-fabsf(x)));
        const float gt = -__expf(F.in[I_DNALOG][h]) * sp, beta = __builtin_amdgcn_rcpf(1.f + __expf(-bb));
        float gc = gt;
#pragma unroll
        for (int o = 1; o < 64; o <<= 1) { const float t = __shfl_up(gc, o); if (lane >= o) gc += t; }
        const float gl = __shfl(gc, 63);
        GB[lane] = gc; GB[64 + lane] = beta; GB[128 + lane] = beta * __expf(gc); GB[192 + lane] = __expf(gl - gc); GB[256 + lane] = __expf(gc);
        if (lane == 0) egl[u] = __expf(gl); }
    f32x4 cw[3][4];
#pragma unroll
    for (int seg = 0; seg < 3; ++seg)
#pragma unroll
        for (int j = 0; j < 4; ++j) cw[seg][j] = R.cw[seg][j];
    __syncthreads();
    if (u_next >= 0) dn_prep_load(F, u_next, R);
    { const int hf = lane >> 5, c4 = lane & 31;
#pragma unroll
      for (int jj = 0; jj < 12; ++jj) { constexpr int dummy_ = 0; (void)dummy_; const int seg = jj >> 2;
        const int wi = wave + 8 * jj, i = 2 * (wi & 31) + hf;
        f32x4 y = {0.f, 0.f, 0.f, 0.f};
#pragma unroll
        for (int j = 0; j < 4; ++j) { const f32x4 w = cw[seg][j];
            const dn_u32x2 xx = *(const LAS dn_u32x2*)(L + P_RAW + (i + j) * 768 + seg * 256 + c4 * 8);
            y[0] += w[0] * bflo(xx.x); y[1] += w[1] * bfhi(xx.x); y[2] += w[2] * bflo(xx.y); y[3] += w[3] * bfhi(xx.y); }
        f32x4 s;
#pragma unroll
        for (int e = 0; e < 4; ++e) s[e] = y[e] * __builtin_amdgcn_rcpf(1.f + __expf(-y[e]));
        if (seg < 2) { float ss = (s[0] * s[0] + s[1] * s[1]) + (s[2] * s[2] + s[3] * s[3]);
            ss = add_xor16(row16_sum(ss));
            const float r = rsqrtf(ss + EPS) * (seg == 0 ? QSCALE : 1.f);
            s = s * r;
            *(LAS dn_u32x2*)(L + (seg == 0 ? P_QH : P_KH) + i * 272 + c4 * 8) = pack4f(s);
            if (seg == 0) { const int cc = c4 & 7, p0 = cc < 4 ? 8 * cc : 8 * (cc - 4) + 4;
                *(dn_u32x2*)(proj + (row0 + i) * PW + PC_Q + h * HD + 32 * (c4 >> 3) + p0) = pack4f(s * GB[256 + i]); }
            else { const float bge = GB[128 + i];
#pragma unroll
                for (int e = 0; e < 4; ++e) *(LAS unsigned short*)(L + P_KBGT + (4 * c4 + e) * 144 + i * 2) = bf1(s[e] * bge); } }
        else { const float be = GB[64 + i];
#pragma unroll
            for (int e = 0; e < 4; ++e) *(LAS unsigned short*)(L + P_VBT + (4 * c4 + e) * 144 + i * 2) = bf1(s[e] * be); } } }
    __syncthreads();
    LAS float* AT = (LAS float*)(L + P_AT);
#pragma unroll
    for (int q = 0; q < 2; ++q) { const int tt = wave + 8 * q, it = tt >> 2, jt = tt & 3;
        f32x4 kk = {0.f, 0.f, 0.f, 0.f}, qk = {0.f, 0.f, 0.f, 0.f};
        if (jt <= it) {
#pragma unroll
            for (int kq = 0; kq < 4; ++kq) { const dn_bf16x8 bk = *(const LAS dn_bf16x8*)(L + P_KH + (16 * jt + m) * 272 + (32 * kq + 8 * g) * 2);
                const dn_bf16x8 ak = *(const LAS dn_bf16x8*)(L + P_KH + (16 * it + m) * 272 + (32 * kq + 8 * g) * 2), aq = *(const LAS dn_bf16x8*)(L + P_QH + (16 * it + m) * 272 + (32 * kq + 8 * g) * 2);
                kk = mfma16(ak, bk, kk); qk = mfma16(aq, bk, qk); } }
        const int j = 16 * jt + m, jl = j & 31, p = jl < 16 ? 8 * (jl >> 2) + (jl & 3) : 8 * ((jl - 16) >> 2) + 4 + (jl & 3);
        const float gcj = GB[j];
#pragma unroll
        for (int r = 0; r < 4; ++r) { const int i = 16 * it + 4 * g + r; const float dec = i >= j ? __expf(GB[i] - gcj) : 0.f;
            AT[i * 68 + j] = i > j ? GB[64 + i] * kk[r] * dec : 0.f;
            *(LAS unsigned short*)(L + P_QKL + i * 144 + (32 * (j >> 5) + p) * 2) = bf1(qk[r] * dec); } }
    __syncthreads();
    if (wave >= 4) { const int t4 = tid - 256;
        for (int id = t4; id < 1024; id += 256) { const int k = id >> 3, sp = (id >> 2) & 1, gg = id & 3; float o8[8];
#pragma unroll
            for (int j = 0; j < 8; ++j) { const int cc = 32 * sp + (j < 4 ? 4 * gg + j : 16 + 4 * gg + j - 4);
                o8[j] = bflo((unsigned)*(const LAS unsigned short*)(L + P_KH + cc * 272 + k * 2)) * GB[192 + cc]; }
            v4u w; w.x = pkbf(o8[0], o8[1]); w.y = pkbf(o8[2], o8[3]); w.z = pkbf(o8[4], o8[5]); w.w = pkbf(o8[6], o8[7]);
            *(v4u*)(proj + (row0 + (k >> 1)) * PW + PC_K + h * HD + (k & 1) * 64 + 32 * sp + 8 * gg) = w; }
        for (int id = t4; id < 512; id += 256) { const int i = id >> 3, j8 = (id & 7) * 8;
            *(v4u*)(qks + i * 64 + j8) = *(const LAS v4u*)(L + P_QKL + i * 144 + j8 * 2); } }
    if (wave == 0) { const int bb = g, j = m; float X[16];
        X[0] = j == 0 ? 1.f : 0.f;
#pragma unroll
        for (int i = 1; i < 16; ++i) { const LAS float* Lr = AT + (16 * bb + i) * 68 + 16 * bb; float Lv[16];
#pragma unroll
            for (int q = 0; q < (i + 3) / 4; ++q) { const f32x4 t = *(const LAS f32x4*)(Lr + 4 * q); Lv[4 * q] = t[0]; Lv[4 * q + 1] = t[1]; Lv[4 * q + 2] = t[2]; Lv[4 * q + 3] = t[3]; }
            float acc = i == j ? 1.f : 0.f;
#pragma unroll
            for (int mm = 0; mm < i; ++mm) acc -= Lv[mm] * X[mm];
            X[i] = acc; }
#pragma unroll
        for (int i = 0; i < 16; ++i) AT[(16 * bb + i) * 68 + 16 * bb + j] = X[i]; }
    __syncthreads();
    if (wave < 2) { const int lo = 2 * wave, hi = 2 * wave + 1; LAS float* PS = (LAS float*)(L + P_PS) + wave * 320;
        f32x4 acc = {0.f, 0.f, 0.f, 0.f};
#pragma unroll
        for (int s = 0; s < 4; ++s) acc = mfma4(AT[(16 * hi + m) * 68 + 16 * lo + 4 * s + g], AT[(16 * lo + 4 * s + g) * 68 + 16 * lo + m], acc);
#pragma unroll
        for (int r = 0; r < 4; ++r) PS[(4 * g + r) * 20 + m] = acc[r];
        LDS_WAIT();
        f32x4 acc2 = {0.f, 0.f, 0.f, 0.f};
#pragma unroll
        for (int s = 0; s < 4; ++s) acc2 = mfma4(AT[(16 * hi + m) * 68 + 16 * hi + 4 * s + g], PS[(4 * s + g) * 20 + m], acc2);
#pragma unroll
        for (int r = 0; r < 4; ++r) AT[(16 * hi + 4 * g + r) * 68 + 16 * lo + m] = -acc2[r]; }
    __syncthreads();
    { LAS float* PS2 = (LAS float*)(L + P_PS2); const int ti = (wave >> 1) & 1, tj = wave & 1;
      if (wave < 4) { f32x4 acc = {0.f, 0.f, 0.f, 0.f};
#pragma unroll
          for (int s = 0; s < 8; ++s) acc = mfma4(AT[(32 + 16 * ti + m) * 68 + 4 * s + g], AT[(4 * s + g) * 68 + 16 * tj + m], acc);
#pragma unroll
          for (int r = 0; r < 4; ++r) PS2[(16 * ti + 4 * g + r) * 36 + 16 * tj + m] = acc[r]; }
      __syncthreads();
      if (wave < 4) { f32x4 acc = {0.f, 0.f, 0.f, 0.f};
#pragma unroll
          for (int s = 0; s < 8; ++s) acc = mfma4(AT[(32 + 16 * ti + m) * 68 + 32 + 4 * s + g], PS2[(4 * s + g) * 36 + 16 * tj + m], acc);
#pragma unroll
          for (int r = 0; r < 4; ++r) AT[(32 + 16 * ti + 4 * g + r) * 68 + 16 * tj + m] = -acc[r]; } }
    __syncthreads();
    { const int i = tid >> 3, j0 = (tid & 7) * 8; const f32x4 t0 = *(const LAS f32x4*)(AT + i * 68 + j0), t1 = *(const LAS f32x4*)(AT + i * 68 + j0 + 4);
      v4u w; w.x = pkbf(t0[0], t0[1]); w.y = pkbf(t0[2], t0[3]); w.z = pkbf(t1[0], t1[1]); w.w = pkbf(t1[2], t1[3]);
      *(LAS v4u*)(L + P_TB + i * 144 + j0 * 2) = w; }
    __syncthreads();
#pragma unroll
    for (int q = 0; q < 8; ++q) { const int tt = wave + 8 * q; f32x4 acc = {0.f, 0.f, 0.f, 0.f};
        if (tt < 32) { const int ct = tt >> 3, nt = tt & 7;
#pragma unroll
            for (int sp = 0; sp < 2; ++sp) acc = mfma16(*(const LAS dn_bf16x8*)(L + P_TB + (16 * ct + m) * 144 + (32 * sp + 8 * g) * 2), *(const LAS dn_bf16x8*)(L + P_VBT + (16 * nt + m) * 144 + (32 * sp + 8 * g) * 2), acc);
            const int v = 16 * nt + m;
            *(dn_u32x2*)(proj + (row0 + (v >> 1)) * PW + PC_V + h * HD + (v & 1) * 64 + 16 * ct + 4 * g) = pack4f(acc); }
        else { const int t2 = tt - 32, kt = t2 >> 2, ct = t2 & 3;
#pragma unroll
            for (int sp = 0; sp < 2; ++sp) acc = mfma16(*(const LAS dn_bf16x8*)(L + P_KBGT + (16 * kt + m) * 144 + (32 * sp + 8 * g) * 2), *(const LAS dn_bf16x8*)(L + P_TB + (16 * ct + m) * 144 + (32 * sp + 8 * g) * 2), acc);
            *(dn_u32x2*)(xbimg + (16 * ct + m) * 128 + 32 * (kt >> 1) + 8 * g + 4 * (kt & 1)) = pack4f(-acc); } }
    __syncthreads();
}
constexpr int S_WN = 0, S_QG = 17408, S_KDT = 34816, S_QKM = 53248, S_UT = 62464, S_OB = 80896, S_PSQ = 114688, S_ONW = 116736, S_Z = 117248, S_END = 152064;
static_assert(S_END <= MISC_OFF, "scan LDS map");
__device__ __forceinline__ void dn_scan_unit(const Frame& F, int bh) {
    const Tix T = tix(F.wv); const int tid = T.tid, lane = T.lane, wave = T.wave, m = lane & 15, g = lane >> 4, n0 = 32 * wave;
    const int b = bh >> 3, h = bh & 7;
    bf16* proj = (bf16*)(F.ws + WS_PROJ); const bf16* xbi = (const bf16*)((const unsigned char*)F.out + DO_WNEG); const bf16* qks = (const bf16*)((unsigned char*)F.out + DO_QKS); const float* egl = (const float*)((unsigned char*)F.out + DO_EGL);
    LAS unsigned char* L = F.lds;
    LAS float* OB = (LAS float*)(L + S_OB);
    constexpr int NC = SEQ / 64;
#define WGBAR() do { asm volatile("s_waitcnt lgkmcnt(0)" ::: "memory"); __builtin_amdgcn_s_barrier(); asm volatile("" ::: "memory"); } while (0)
    if (wave >= 4) {
        const int ht = tid - 256;
        const unsigned lo_lin = (unsigned)ht * 16u;
        const unsigned lo_qg = (unsigned)(((ht >> 4) * PW + (ht & 15) * 8) * 2);
        const unsigned lo_kv = (unsigned)(((ht >> 4) * PW + ((ht >> 3) & 1) * 64 + (ht & 7) * 8) * 2);
        const unsigned ld_a = (unsigned)((ht >> 4) * 272 + (ht & 15) * 16), ld_b = (unsigned)((ht >> 3) * 144 + (ht & 7) * 16);
        const unsigned lo_fin = (unsigned)(((ht >> 2) * PW + (ht & 3) * 32) * 2);
        v4u RP[12], RQ[10];
#define DN_LOAD_P(cc) do { const size_t r0_ = (size_t)b * SEQ + (cc) * 64; const size_t u_ = (size_t)bh * 32 + (cc);               \
        _Pragma("unroll") for (int j_ = 0; j_ < 4; ++j_) {                                                                                                \
            RP[j_] = *(const v4u*)((const char*)(xbi + u_ * 8192 + 2048 * j_) + lo_lin);                                                                    \
            RP[4 + j_] = *(const v4u*)((const char*)(proj + (r0_ + 16 * j_) * PW + PC_Q + h * HD) + lo_qg);                                                 \
            RP[8 + j_] = *(const v4u*)((const char*)(proj + (r0_ + 16 * j_) * PW + PC_V + h * HD) + lo_kv); } } while (0)
#define DN_LOAD_Q(cc) do { const size_t r0_ = (size_t)b * SEQ + (cc) * 64; const size_t u_ = (size_t)bh * 32 + (cc);     \
        _Pragma("unroll") for (int j_ = 0; j_ < 4; ++j_) {                                                                                                \
            RQ[j_] = *(const v4u*)((const char*)(proj + (r0_ + 16 * j_) * PW + PC_K + h * HD) + lo_kv);                                                     \
            RQ[4 + j_] = *(const v4u*)((const char*)(proj + (r0_ + 16 * j_) * PW + PC_Z + h * HD) + lo_qg); }                                               \
        _Pragma("unroll") for (int j_ = 0; j_ < 2; ++j_) RQ[8 + j_] = *(const v4u*)((const char*)(qks + u_ * 4096 + 2048 * j_) + lo_lin); } while (0)
#define DN_WRITE_P() do { _Pragma("unroll") for (int j_ = 0; j_ < 4; ++j_) {                                                                               \
            *(LAS v4u*)(L + S_WN + ld_a + j_ * 4352) = RP[j_]; *(LAS v4u*)(L + S_QG + ld_a + j_ * 4352) = RP[4 + j_]; *(LAS v4u*)(L + S_UT + ld_b + j_ * 4608) = RP[8 + j_]; } } while (0)
#define DN_WRITE_Q(cc) do { _Pragma("unroll") for (int j_ = 0; j_ < 4; ++j_) { *(LAS v4u*)(L + S_KDT + ld_b + j_ * 4608) = RQ[j_];                         \
            *(LAS v4u*)(L + S_Z + ((cc) & 1) * 17408 + ld_a + j_ * 4352) = RQ[4 + j_]; }                                                                    \
        _Pragma("unroll") for (int j_ = 0; j_ < 2; ++j_) *(LAS v4u*)(L + S_QKM + ld_b + j_ * 4608) = RQ[8 + j_]; } while (0)
#define DN_FINAL(cc) do { const int fr_ = ht >> 2, fc_ = (ht & 3) * 32; float ss_ = 0.f;     \
        _Pragma("unroll") for (int p_ = 0; p_ < 8; ++p_) { const f32x4 o_ = *(const LAS f32x4*)(OB + fr_ * 132 + fc_ + 4 * p_);                              \
            ss_ += (o_[0] * o_[0] + o_[1] * o_[1]) + (o_[2] * o_[2] + o_[3] * o_[3]); }                                                                     \
        ss_ += dppf<0xB1>(ss_); ss_ += dppf<0x4E>(ss_);                                                                                                     \
        const float rn_ = rsqrtf(ss_ * (1.f / 128.f) + EPS);                                                                                               \
        bf16* dst_ = (bf16*)((char*)(proj + ((size_t)b * SEQ + (cc) * 64) * PW + PC_Q + h * HD) + lo_fin);              \
        _Pragma("unroll") for (int p_ = 0; p_ < 4; ++p_) {                                                                                                 \
            const f32x4 oa_ = *(const LAS f32x4*)(OB + fr_ * 132 + fc_ + 8 * p_), ob_ = *(const LAS f32x4*)(OB + fr_ * 132 + fc_ + 8 * p_ + 4);             \
            const v4u z_ = *(const LAS v4u*)(L + S_Z + ((cc) & 1) * 17408 + fr_ * 272 + (fc_ + 8 * p_) * 2);                                                \
            v4u w_; w_.x = pkbf(oa_[0] * rn_ * bflo(z_.x), oa_[1] * rn_ * bfhi(z_.x)); w_.y = pkbf(oa_[2] * rn_ * bflo(z_.y), oa_[3] * rn_ * bfhi(z_.y));   \
            w_.z = pkbf(ob_[0] * rn_ * bflo(z_.z), ob_[1] * rn_ * bfhi(z_.z)); w_.w = pkbf(ob_[2] * rn_ * bflo(z_.w), ob_[3] * rn_ * bfhi(z_.w));           \
            *(v4u*)(dst_ + 8 * p_) = w_; } } while (0)
        DN_LOAD_P(0); DN_LOAD_Q(0); DN_WRITE_P(); DN_WRITE_Q(0); DN_LOAD_P(1); DN_LOAD_Q(1);
        WGBAR();
        for (int c = 0; c < NC; ++c) {
            if (c > 0) { DN_FINAL(c - 1); DN_WRITE_Q(c); if (c + 1 < NC) DN_LOAD_Q(c + 1); }
            WGBAR();
            if (c + 1 < NC) { DN_WRITE_P(); if (c + 2 < NC) DN_LOAD_P(c + 2); }
            WGBAR();
        }
        DN_FINAL(NC - 1);
#undef DN_LOAD_P
#undef DN_LOAD_Q
#undef DN_WRITE_P
#undef DN_WRITE_Q
#undef DN_FINAL
    } else {
        f32x4 Sacc[2][8];
#pragma unroll
        for (int kt = 0; kt < 8; ++kt) { Sacc[0][kt] = (f32x4){0.f, 0.f, 0.f, 0.f}; Sacc[1][kt] = (f32x4){0.f, 0.f, 0.f, 0.f}; }
        const unsigned* eglu = (const unsigned*)egl + (size_t)bh * 32;
        float eg_next = __uint_as_float(__hip_atomic_load(eglu, __ATOMIC_RELAXED, __HIP_MEMORY_SCOPE_AGENT));
        const LAS unsigned char* fa = L + m * 272 + g * 16;
        const LAS unsigned char* fb = L + m * 144 + g * 16;
#define SBAR() __builtin_amdgcn_sched_barrier(0)
#define LD_A(X, base, ct) do { _Pragma("unroll") for (int s_ = 0; s_ < 4; ++s_) X[s_] = *(const LAS dn_bf16x8*)(fa + (base) + (ct) * 4352 + s_ * 64); } while (0)
#define LD_B(X, base, i0) do { _Pragma("unroll") for (int s_ = 0; s_ < 4; ++s_) X[s_] = *(const LAS dn_bf16x8*)(fb + (base) + ((i0) + (s_ >> 1)) * 2304 + (s_ & 1) * 64); } while (0)
        WGBAR();
        for (int c = 0; c < NC; ++c) {
            const float eg = eg_next;
            if (c + 1 < NC) eg_next = __uint_as_float(__hip_atomic_load(eglu + c + 1, __ATOMIC_RELAXED, __HIP_MEMORY_SCOPE_AGENT));
            dn_bf16x8 SB[2][4], X0[4], X1[4];
            LD_A(X0, S_WN, 0);
#pragma unroll
            for (int sl = 0; sl < 2; ++sl)
#pragma unroll
                for (int s = 0; s < 4; ++s) SB[sl][s] = pack8f(Sacc[sl][2 * s], Sacc[sl][2 * s + 1]);
            f32x4 VN[2][4], O[2][4];
#pragma unroll
            for (int ct = 0; ct < 4; ++ct)
#pragma unroll
                for (int sl = 0; sl < 2; ++sl) { const dn_u32x2 uu = *(const LAS dn_u32x2*)(L + S_UT + (n0 + 16 * sl + m) * 144 + (16 * ct + 4 * g) * 2);
                    VN[sl][ct] = (f32x4){bflo(uu.x), bfhi(uu.x), bflo(uu.y), bfhi(uu.y)}; O[sl][ct] = (f32x4){0.f, 0.f, 0.f, 0.f}; }
#pragma unroll
            for (int ct = 0; ct < 4; ++ct) {
                SBAR(); LD_A(X1, S_QG, ct); SBAR();
#pragma unroll
                for (int s = 0; s < 4; ++s) { VN[0][ct] = mfma16(X0[s], SB[0][s], VN[0][ct]); VN[1][ct] = mfma16(X0[s], SB[1][s], VN[1][ct]); }
                SBAR(); if (ct < 3) LD_A(X0, S_WN, ct + 1); SBAR();
#pragma unroll
                for (int s = 0; s < 4; ++s) { O[0][ct] = mfma16(X1[s], SB[0][s], O[0][ct]); O[1][ct] = mfma16(X1[s], SB[1][s], O[1][ct]); }
            }
            dn_bf16x8 VNB[2][2];
#pragma unroll
            for (int sl = 0; sl < 2; ++sl)
#pragma unroll
                for (int sp = 0; sp < 2; ++sp) VNB[sl][sp] = pack8f(VN[sl][2 * sp], VN[sl][2 * sp + 1]);
            WGBAR();
            SBAR(); LD_B(X0, S_QKM, 0); LD_B(X1, S_QKM, 2); SBAR();
#pragma unroll
            for (int s = 0; s < 4; ++s) { O[0][s >> 1] = mfma16(X0[s], VNB[0][s & 1], O[0][s >> 1]); O[1][s >> 1] = mfma16(X0[s], VNB[1][s & 1], O[1][s >> 1]); }
            SBAR(); LD_B(X0, S_KDT, 0); SBAR();
#pragma unroll
            for (int s = 0; s < 4; ++s) { O[0][2 + (s >> 1)] = mfma16(X1[s], VNB[0][s & 1], O[0][2 + (s >> 1)]); O[1][2 + (s >> 1)] = mfma16(X1[s], VNB[1][s & 1], O[1][2 + (s >> 1)]); }
#pragma unroll
            for (int kt = 0; kt < 8; ++kt) { Sacc[0][kt] = Sacc[0][kt] * eg; Sacc[1][kt] = Sacc[1][kt] * eg; }
#pragma unroll
            for (int q = 0; q < 4; ++q) {
                if (q & 1) { SBAR(); if (q < 3) LD_B(X0, S_KDT, 2 * q + 2); SBAR();
#pragma unroll
                    for (int s = 0; s < 4; ++s) { Sacc[0][2 * q + (s >> 1)] = mfma16(X1[s], VNB[0][s & 1], Sacc[0][2 * q + (s >> 1)]); Sacc[1][2 * q + (s >> 1)] = mfma16(X1[s], VNB[1][s & 1], Sacc[1][2 * q + (s >> 1)]); } }
                else { SBAR(); LD_B(X1, S_KDT, 2 * q + 2); SBAR();
#pragma unroll
                    for (int s = 0; s < 4; ++s) { Sacc[0][2 * q + (s >> 1)] = mfma16(X0[s], VNB[0][s & 1], Sacc[0][2 * q + (s >> 1)]); Sacc[1][2 * q + (s >> 1)] = mfma16(X0[s], VNB[1][s & 1], Sacc[1][2 * q + (s >> 1)]); } }
            }
#pragma unroll
            for (int sl = 0; sl < 2; ++sl)
#pragma unroll
                for (int ct = 0; ct < 4; ++ct)
#pragma unroll
                    for (int r = 0; r < 4; ++r) OB[(16 * ct + 4 * g + r) * 132 + n0 + 16 * sl + m] = O[sl][ct][r];
            WGBAR();
        }
#undef SBAR
#undef LD_A
#undef LD_B
    }
#undef WGBAR
}
__device__ __forceinline__ void fox_blk(const Frame& F, int it, int j, att::Blk& k) {
    const int bh = it >> 2, y = it & 3, qb = j == 0 ? y : 7 - y, b = bh >> 3, h = bh & 7; const size_t row0 = (size_t)b * SEQ + qb * 256;
    bf16* proj = (bf16*)(F.ws + WS_PROJ);
    k.Q = proj + row0 * PW + PC_Q + h * HD; k.K = proj + (size_t)b * SEQ * PW + PC_K + h * HD; k.voff = PC_V - PC_K; k.goff = PC_Z - PC_Q;
    k.flog = (const float*)(F.ws + WS_AB) + (size_t)b * SEQ * 16 + h; k.fb = F.in[I_FOXFB][h]; k.P0 = qb * 256; k.skv = SEQ; k.kvpitch = PW;
}
__device__ __forceinline__ void mem_blk(const Frame& F, int idx, att::Blk& k) {
    const int b = idx >> 5, hm = (idx >> 3) & 3, qb = idx & 7; const size_t row0 = (size_t)b * SEQ + qb * 256;
    bf16* proj = (bf16*)(F.ws + WS_PROJ); const bf16* mkv = (const bf16*)(F.ws + WS_MEMKV);
    static_assert(att::QP == PW, "attention Q pitch");
    k.Q = proj + row0 * PW + PC_QM + hm * HD; k.K = mkv + (size_t)b * NMEM * DM + hm * HD; k.voff = 512; k.goff = 0;
    k.flog = nullptr; k.fb = 0.f; k.P0 = 1 << 20; k.skv = NMEM; k.kvpitch = DM;
}
struct SrcL1 { const Frame* F; int vcu;
    __device__ __forceinline__ bool operator()(int n, att::Blk& k) const { const int it = vcu + (n / 3) * F->G, j = n % 3; if (it >= 256) return false;
        if (j < 2) fox_blk(*F, it, j, k); else mem_blk(*F, it, k); return true; } };
struct SrcL0 { const Frame* F; int first, stride;
    __device__ __forceinline__ bool operator()(int n, att::Blk& k) const { const int idx = first + n * stride; if (idx >= 256) return false; mem_blk(*F, idx, k); return true; } };
__device__ __forceinline__ void narrow_ab_unit(const Frame& F, int pm) {
    const Tix T = tix(F.wv); const int lane = T.lane, wave = T.wave, m = lane & 15, g = lane >> 4;
    const bf16* A = (const bf16*)(F.ws + WS_XB) + (size_t)(pm * 256 + 32 * wave + m) * DM + 8 * g; const bf16* B = (const bf16*)(F.ws + WS_WIN0) + (size_t)(PC_AB + m) * DM + 8 * g;
    f32x4 acc0 = {0.f, 0.f, 0.f, 0.f}, acc1 = acc0;
#pragma unroll 8
    for (int s = 0; s < DM / 32; ++s) { const dn_bf16x8 b = *(const dn_bf16x8*)(B + 32 * s);
        acc0 = mfma16(*(const dn_bf16x8*)(A + 32 * s), b, acc0); acc1 = mfma16(*(const dn_bf16x8*)(A + (size_t)16 * DM + 32 * s), b, acc1); }
    const float* xsq = (const float*)(F.ws + WS_XSQ); float* ab = (float*)(F.ws + WS_AB);
#pragma unroll
    for (int rt = 0; rt < 2; ++rt)
#pragma unroll
        for (int r = 0; r < 4; ++r) { const size_t row = (size_t)pm * 256 + 32 * wave + 16 * rt + 4 * g + r; const float* q = xsq + row * 16;
            const f32x4 t = (*(const f32x4*)q + *(const f32x4*)(q + 4)) + (*(const f32x4*)(q + 8) + *(const f32x4*)(q + 12));
            ab[row * 16 + m] = (rt ? acc1[r] : acc0[r]) * rsqrtf(((t[0] + t[1]) + (t[2] + t[3])) * (1.0f / 1024.0f) + EPS); }
}
constexpr int CW_SHD = 196608;
__device__ __forceinline__ void shadow_barrier(const Frame& F, unsigned want) {
    asm volatile("s_waitcnt vmcnt(0)" ::: "memory");
    __syncthreads();
    if (F.wv == 0 && lane_id() == 0) { unsigned* p = (unsigned*)((gu32*)(F.ws + WS_CTL) + CW_SHD);
        __builtin_amdgcn_fence(__ATOMIC_RELEASE, "agent"); asm volatile("s_waitcnt vmcnt(0)" ::: "memory");
        (void)__hip_atomic_fetch_add(p, 1u, __ATOMIC_RELAXED, __HIP_MEMORY_SCOPE_AGENT);
        unsigned sp = 0;
        while (__hip_atomic_load(p, __ATOMIC_RELAXED, __HIP_MEMORY_SCOPE_AGENT) < want) { __builtin_amdgcn_s_sleep(2); if (++sp > (1u << 22)) { atomicAdd((unsigned*)((gu32*)(F.ws + WS_CTL) + CW_BAR) + XB_TMO, 1u); break; } }
        __builtin_amdgcn_fence(__ATOMIC_ACQUIRE, "agent"); asm volatile("s_waitcnt vmcnt(0)" ::: "memory"); }
    __syncthreads();
}
#define IN(k) (lo <= (k) && (k) < hi)
#define SEAM(k) do { if (IN(k) && IN((k) + 1)) xcd_barrier(bar); } while (0)
#define SEAMG(k, s_) do { if (IN(k) && IN((k) + 1)) { if (gb.on) grp_barrier(gb, (s_)); else xcd_barrier(bar); } } while (0)
template <int layer> __device__ __forceinline__ void layer_body(const Frame& F, const XcdBarrier& bar, GrpBar& gb, bool grp_try, int lo, int hi, unsigned char* lds) {
    bf16* proj = (bf16*)(F.ws + WS_PROJ); bf16* xb = (bf16*)(F.ws + WS_XB); float* xsq = (float*)(F.ws + WS_XSQ);
    float* ab = (float*)(F.ws + WS_AB);

        const int pb = 1 + (layer ? 6 : 0);
        if (IN(pb)) {
            pg8::Gemm g{xb, (const bf16*)(F.ws + (layer ? WS_WIN1 : WS_WIN0)), MROWS, layer ? N_IN : 4096, DM, DM}; pg8::StaticOrder S; S.init(MROWS, layer ? N_IN : 4096, F.G, F.bid);
            const float* nk = layer ? F.in[I_FOXKNW] : nullptr; const float* nq = layer ? F.in[I_FOXQNW] : nullptr;
            pg8::EpiProj<true, false, layer == 0> E{proj, PW, xsq, ab, 18, (bf16*)((unsigned char*)F.out + DO_HALO), 0, layer ? 4 : 0, nk, 12, layer ? 16 : 12, nq, 16, 18, F.in[I_MEMQNW] + layer * HD, 8, 12, layer ? 2 : 1, F.in[I_DNONW]};
            pg8::gemm_phase<pg8::EpiProj<true, false, layer == 0>, pg8::StaticOrder, true, true>(F.lds, g, S, E, F.wv);
            if (layer == 0 && F.bid < 64) { __syncthreads(); narrow_ab_unit(F, 8 * (F.bid & 7) + ((F.bid >> 3) & 7)); }
        }
        SEAM(pb);
        if (layer == 0 && grp_try) gb.on = __hip_atomic_load((unsigned*)((gu32*)(F.ws + WS_CTL) + CW_BAD), __ATOMIC_RELAXED, __HIP_MEMORY_SCOPE_AGENT) == 0u;
        const int pm = pb + (layer ? 1 : 2);
        if (layer == 0) {
            if (IN(pb + 1)) { constexpr int NU = BATCH * NH * (SEQ / 64); DnPre R; int u = F.bid; if (u < NU) dn_prep_load(F, u, R);
                              for (; u < NU; u += F.G) dn_prep_unit(F, u, u + F.G < NU ? u + F.G : -1, R); }
            SEAM(pb + 1);
        }
        if (IN(pm)) {
            if (layer == 0) {
                if (F.bid < 64) dn_scan_unit(F, F.bid);
                else {
                    { const pg8::StrideUnits Sq{F.bid - 64, F.G - 64, 128, 1};
                      pg8::Gemm g{xb, (const bf16*)(F.ws + WS_WIN0), MROWS, N_IN, DM, DM};
                      pg8::EpiProj<true, false> E{proj, PW, xsq, nullptr, 18, nullptr, 0, 0, nullptr, 0, 0, nullptr, 16, 18, F.in[I_MEMQNW], 0, 0, 0, nullptr};
                      pg8::gemm_phase<pg8::EpiProj<true, false>, pg8::StrideUnits, true, true>(F.lds, g, Sq, E, F.wv);
                      const pg8::StrideUnits Sm{F.G - 1 - F.bid, F.G - 64, 32, 0};
                      pg8::Gemm g2{(const bf16*)((unsigned char*)F.out + DO_MEMB), (const bf16*)(F.ws + WS_WMKV), MMEM, DM, DM, DM};
                      pg8::EpiProj<true, false> E2{(bf16*)(F.ws + WS_MEMKV), DM, (const float*)(F.ws + WS_MSQ), nullptr, 4, nullptr, 0, 2, F.in[I_MEMKNW], 0, 0, nullptr, 0, 0, nullptr, 0, 0, 0, nullptr};
                      pg8::gemm_phase<pg8::EpiProj<true, false>, pg8::StrideUnits, true, true>(F.lds, g2, Sm, E2, F.wv); }
                    shadow_barrier(F, (unsigned)(F.G - 64));
                    const SrcL0 src{&F, F.bid - 64, F.G - 64}; att::phase((char*)lds, src, F.wv);
                    __syncthreads();
                    const Tix T = tix(F.wv); convert_weights<6, 18>(F, (LAS float*)(F.lds + T.wave * 17408), T.lane, (F.bid - 64) * NWAVES + T.wave, (F.G - 64) * NWAVES, 0); }
            } else {
                const int vcu = (F.G % 8 == 0) ? (F.bid % 8) * (F.G / 8) + F.bid / 8 : F.bid;
                const SrcL1 src{&F, vcu}; att::phase((char*)lds, src, F.wv);
            }
            __syncthreads();
        }
        SEAM(pm);
        if (IN(pm + 1)) {
            pg8::Gemm g{proj + PC_Q, (const bf16*)(F.ws + (layer ? WS_WOUT1 : WS_WOUT0)), MROWS, DM, OUT_IN, PW}; pg8::StaticOrder S; S.init(MROWS, DM, F.G, F.bid);
            pg8::EpiRes<false> E{xb, F.out, xsq, nullptr};
            pg8::gemm_phase<pg8::EpiRes<false>, pg8::StaticOrder, true, true>(F.lds, g, S, E, F.wv);
        }
        SEAMG(pm + 1, layer * 3 + 0);
        if (IN(pm + 2)) {
            pg8::Gemm g{xb, (const bf16*)(F.ws + (layer ? WS_WM1_1 : WS_WM1_0)), MROWS, FF, DM, DM}; pg8::StaticOrder S; S.init(MROWS, FF, F.G, F.bid);
            pg8::EpiProj<false, true> E{proj, FF, xsq, nullptr, 16, nullptr, 0, 0, nullptr, 0, 0, nullptr, 0, 0, nullptr, 0, 0, 0, nullptr};
            pg8::gemm_phase<pg8::EpiProj<false, true>, pg8::StaticOrder, true, true>(F.lds, g, S, E, F.wv);
        }
        SEAMG(pm + 2, layer * 3 + 1);
        if (IN(pm + 3)) {
            pg8::Gemm g{proj, (const bf16*)(F.ws + (layer ? WS_WM2_1 : WS_WM2_0)), MROWS, DM, FF, FF}; pg8::StaticOrder S; S.init(MROWS, DM, F.G, F.bid);
            pg8::EpiRes<layer == 1> E{xb, F.out, xsq, nullptr};
            pg8::gemm_phase<pg8::EpiRes<layer == 1>, pg8::StaticOrder, true, true>(F.lds, g, S, E, F.wv);
        }
        if (layer == 0) SEAMG(pm + 3, 2); else SEAM(pm + 3);
    }
#undef IN
#undef SEAM
#undef SEAMG
__global__ void __launch_bounds__(NWAVES * 64, 2) hyb_fwd(Args args) {
    extern __shared__ __attribute__((aligned(16))) unsigned char lds[];
    Frame F;
    F.lds = (LAS unsigned char*)lds;
    F.G = gridDim.x; F.bid = blockIdx.x; F.in = args.in; F.out = args.out; F.ws = args.ws; F.wv = __builtin_amdgcn_readfirstlane((int)threadIdx.x >> 6);
    volatile LAS unsigned* MISC = (volatile LAS unsigned*)(F.lds + MISC_OFF);
    gu32* ctl = (gu32*)(args.ws + WS_CTL);
    for (int u = threadIdx.x; u < (LDS_BYTES - MISC_OFF) / 4; u += NWAVES * 64) ((LAS unsigned*)(F.lds + MISC_OFF))[u] = 0u;
    __syncthreads();
    XcdBarrier bar; bar.bar = (unsigned*)(ctl + CW_BAR) + args.li * XCD_BAR_WORDS; bar.x = 0; bar.st = nullptr; bar.wv = F.wv;
    if (!MK_LAUNCH_PER_PHASE) { bar = xcd_barrier_post((unsigned*)(ctl + CW_BAR) + args.li * XCD_BAR_WORDS, MISC + 8); bar.wv = F.wv; }
    const int lo = args.ph_lo, hi = args.ph_hi;
#define IN(k) (lo <= (k) && (k) < hi)
#define SEAM(k) do { if (IN(k) && IN((k) + 1)) xcd_barrier(bar); } while (0)
    bf16* proj = (bf16*)(F.ws + WS_PROJ); bf16* xb = (bf16*)(F.ws + WS_XB); float* xsq = (float*)(F.ws + WS_XSQ);
    float* ab = (float*)(F.ws + WS_AB);

    GrpBar gb; gb.cnt = (unsigned*)(ctl + CW_GRP) + (size_t)(F.bid & 63) * 8 * 64; gb.tmo = (unsigned*)(ctl + CW_BAR) + XB_TMO; gb.wv = F.wv; gb.on = false;
    const bool grp_try = !MK_LAUNCH_PER_PHASE && F.G == 256 && lo == 0 && hi == N_PHASES;
    if (grp_try && F.wv == 0 && lane_id() == 0) __hip_atomic_store((unsigned*)(ctl + CW_XCC) + F.bid, xb_xcc_id() + 1u, __ATOMIC_RELAXED, __HIP_MEMORY_SCOPE_AGENT);
    if (IN(0)) { p0_prologue(F); } SEAM(0);
    if (grp_try && F.wv == 0 && lane_id() == 0) { const unsigned mine = xb_xcc_id() + 1u; bool same = true;
        for (int k = 1; k < 4; ++k) same = same && __hip_atomic_load((unsigned*)(ctl + CW_XCC) + ((F.bid + 64 * k) & 255), __ATOMIC_RELAXED, __HIP_MEMORY_SCOPE_AGENT) == mine;
        if (!same) atomicAdd((unsigned*)(ctl + CW_BAD), 1u); }

    layer_body<0>(F, bar, gb, grp_try, lo, hi, lds);
    layer_body<1>(F, bar, gb, grp_try, lo, hi, lds);
#undef IN
#undef SEAM
}

extern "C" void kernel_launch(void* const* d_in, const int* in_sizes, int n_in, void* d_out, int out_size, void* d_ws, size_t ws_size, hipStream_t stream) {
    static int grid = 0;
    if (grid == 0) {
        if (n_in != 20 || in_sizes[0] != MROWS * DM || out_size != MROWS * DM || ws_size < WS_END) {
            fprintf(stderr, "kernel_launch: shape/workspace mismatch (n_in %d, in0 %d, out %d, ws %zu; need ws >= %zu); nothing launched\n", n_in, n_in > 0 ? in_sizes[0] : -1, out_size, ws_size, (size_t)WS_END); grid = -1; return; }
        int dev = 0, cus = 0, per_cu = 0;
        if (hipGetDevice(&dev) != hipSuccess || hipDeviceGetAttribute(&cus, hipDeviceAttributeMultiprocessorCount, dev) != hipSuccess) { fprintf(stderr, "kernel_launch: device query failed\n"); grid = -1; return; }
        if (hipFuncSetAttribute((const void*)hyb_fwd, hipFuncAttributeMaxDynamicSharedMemorySize, LDS_BYTES) != hipSuccess) { fprintf(stderr, "kernel_launch: hipFuncSetAttribute failed\n"); grid = -1; return; }
        if (hipOccupancyMaxActiveBlocksPerMultiprocessor(&per_cu, (const void*)hyb_fwd, NWAVES * 64, LDS_BYTES) != hipSuccess || per_cu < 1) {
            fprintf(stderr, "kernel_launch: occupancy query reports %d workgroups per CU; nothing launched\n", per_cu); (void)hipGetLastError(); grid = -1; return; }
        if (cus < 128) { fprintf(stderr, "kernel_launch: %d CUs; this kernel's phase program needs at least 128 workgroups; nothing launched\n", cus); grid = -1; return; }
        grid = cus;
    }
    if (grid < 0) return;
    if (hipMemsetAsync((char*)d_ws + WS_CTL, 0, CTL_ZERO_BYTES, stream) != hipSuccess) { fprintf(stderr, "kernel_launch: memset failed\n"); return; }
    Args a{};
    for (int i = 0; i < 20; ++i) a.in[i] = (const float*)d_in[i];
    a.out = (float*)d_out; a.ws = (unsigned char*)d_ws;
#if MK_LAUNCH_PER_PHASE
    for (int p = 0; p < N_PHASES; ++p) { a.ph_lo = p; a.ph_hi = p + 1; a.li = 0; hipLaunchKernelGGL(hyb_fwd, dim3(grid), dim3(NWAVES * 64), LDS_BYTES, stream, a); }
#else
    a.ph_lo = 0; a.ph_hi = N_PHASES; a.li = 0;
    hipLaunchKernelGGL(hyb_fwd, dim3(grid), dim3(NWAVES * 64), LDS_BYTES, stream, a);
#endif
    const hipError_t le = hipPeekAtLastError();
    if (le != hipSuccess) fprintf(stderr, "kernel_launch: launch failed: %s\n", hipGetErrorName(le));
}
```

```cpp
#include <hip/hip_runtime.h>
#include <cstdio>
#include <cstdint>
#include <type_traits>

constexpr int BATCH = 8, SEQ = 2048, DM = 1024, MROWS = BATCH * SEQ;
constexpr int NMEM = 256, MMEM = BATCH * NMEM;
constexpr int HD = 128, NH = 8, NMH = 4, FF = 4096;
constexpr int PW = 4608;
constexpr int PC_K = 0, PC_V = 1024, PC_Z = 2048, PC_Q = 3072, PC_QM = 4096, PC_AB = 4608;
constexpr int N_IN = 4864;
constexpr int DN_IN = 4624, FOX_IN = 4616, OUT_IN = 1536;
constexpr float EPS = 1e-6f;
constexpr float QSCALE = 0.08838834764831845f;

__device__ __forceinline__ int lane_id_v() { int x; asm volatile("v_mbcnt_lo_u32_b32 %0, -1, 0\n\tv_mbcnt_hi_u32_b32 %0, -1, %0" : "=v"(x)); return x; }
template <int CTRL> __device__ __forceinline__ float dppf(float x) { return __builtin_bit_cast(float, __builtin_amdgcn_update_dpp(0, __builtin_bit_cast(int, x), CTRL, 0xf, 0xf, true)); }
__device__ __forceinline__ float row16_sum(float x) { x += dppf<0xB1>(x); x += dppf<0x4E>(x); x += dppf<0x141>(x); x += dppf<0x140>(x); return x; }
__device__ __forceinline__ float add_xor16(float x) { auto r = __builtin_amdgcn_permlane16_swap(__float_as_uint(x), __float_as_uint(x), false, false); return __uint_as_float(r[0]) + __uint_as_float(r[1]); }
__device__ __forceinline__ float add_xor32(float x) { auto r = __builtin_amdgcn_permlane32_swap(__float_as_uint(x), __float_as_uint(x), false, false); return __uint_as_float(r[0]) + __uint_as_float(r[1]); }
namespace pg8 {
#define PG8_LAS __attribute__((address_space(3)))
typedef unsigned short bf16_t;
typedef short bf16x8 __attribute__((ext_vector_type(8)));
typedef float f32x4 __attribute__((ext_vector_type(4)));
typedef unsigned u32x4 __attribute__((ext_vector_type(4)));
constexpr int BM = 256, BK = 64, HALF = 128, HTB = HALF * BK * 2  , STAGE_BYTES = 8 * HTB, NXCD = 8, WGM = 8;

__host__ __device__ __forceinline__ int lds_byte(int r, int c) { const int st = (r >> 4) * 2 + (c >> 5), rr = r & 15, cc = c & 31, ob = rr * 64 + cc * 2; return st * 1024 + (ob ^ (((ob >> 9) & 1) << 5)); }
__host__ __device__ __forceinline__ void stage_rc(int b, int& R, int& C) { const int st = b / 1024, sb = b % 1024, swz = sb ^ (((sb >> 9) & 1) << 5); R = (st >> 1) * 16 + swz / 64; C = (st & 1) * 32 + (swz % 64) / 2; }
__host__ __device__ __forceinline__ int perm32(int rho) { const int n = rho >> 4, i = rho & 15; return 8 * (i >> 2) + 4 * n + (i & 3); }

struct Unit { int pm, pn; };
struct Gemm { const bf16_t* A; const bf16_t* Bt; int M, N, K, lda; };

struct StaticOrder {
    int nM, nN, nwg, G, c;
    __host__ __device__ void init(int M, int N, int G_, int c_) { nM = M / BM; nN = N / BM; nwg = nM * nN; G = G_; c = c_; }
    __host__ __device__ bool next(int i, Unit& u) const {
        const long L = (long)i * G + c; if (L >= nwg) return false;
        int wgid = (int)L; { const int q = nwg / NXCD, r = nwg % NXCD, xcd = wgid % NXCD, off = wgid / NXCD; wgid = (xcd < r ? xcd * (q + 1) : r * (q + 1) + (xcd - r) * q) + off; }
        const int nig = WGM * nN, gid = wgid / nig, fm = gid * WGM, gsz = (nM - fm) < WGM ? (nM - fm) : WGM;
        u.pm = fm + ((wgid % nig) % gsz); u.pn = (wgid % nig) / gsz; return true;
    }
    __device__ __forceinline__ void a_ready(const Unit&) const {}
    __device__ __forceinline__ void done(const Unit&) const {}
};
struct StrideUnits {
    int start, stride, total, qm;
    __device__ __forceinline__ bool next(int i, Unit& u) const { const int t = start + i * stride; if (t >= total) return false; const int x = t & 7, j = t >> 3;
        if (qm) { u.pm = 8 * x + (j >> 1); u.pn = 16 + (j & 1); } else { u.pm = x; u.pn = j; } return true; }
    __device__ __forceinline__ void a_ready(const Unit&) const {}
    __device__ __forceinline__ void done(const Unit&) const {}
};

__device__ __forceinline__ unsigned cvt_pk_bf16(float lo, float hi) { unsigned r; asm volatile("v_cvt_pk_bf16_f32 %0, %1, %2" : "=v"(r) : "v"(lo), "v"(hi)); return r; }

constexpr int EPI_XCH = 131072, EPI_RS = 139264;
template <bool NORM, bool RELU2, bool HALO = false> struct EpiProj {
    static constexpr bool PERM = true, AFTER_DRAIN = false, USE_RS = true, ACC_INIT = false;
    bf16_t* O; int ldc; const float* xsq; float* ab; int n_main; bf16_t* halo;
    int nlo0, nhi0; const float* nw0; int nlo1, nhi1; const float* nw1; int nlo2, nhi2; const float* nw2;
    int zlo, zhi, zmode; const float* zw;
    __device__ __forceinline__ void rs_load(const Unit& u, int tid, f32x4 (&q)[4]) const { const float* p = xsq + (size_t)(u.pm * BM + tid) * 16;
#pragma unroll
        for (int i = 0; i < 4; ++i) q[i] = *(const f32x4*)(p + 4 * i); }
    __device__ __forceinline__ void rs_store(const f32x4 (&q)[4], PG8_LAS unsigned char* lds, int parity, int tid) const {
        const f32x4 t = (q[0] + q[1]) + (q[2] + q[3]);
        ((PG8_LAS float*)(lds + EPI_RS))[parity * 256 + tid] = rsqrtf(((t[0] + t[1]) + (t[2] + t[3])) * (1.0f / 1024.0f) + 1e-6f); }
    __device__ __forceinline__ void operator()(const f32x4 (&acc)[2][2][4][2], const Unit& u, int wr, int wc, int fr, int fq, PG8_LAS unsigned char* lds, int parity) const {
        const int rl0 = wr * 64 + fr, row0 = u.pm * BM + rl0, colt = u.pn * BM;
        const bool is_ab = u.pn >= n_main;
        const PG8_LAS float* RS = (const PG8_LAS float*)(lds + EPI_RS) + parity * 256;
        const float* nw = nullptr;
        if (NORM) { if (u.pn >= nlo0 && u.pn < nhi0) nw = nw0; else if (u.pn >= nlo1 && u.pn < nhi1) nw = nw1; else if (u.pn >= nlo2 && u.pn < nhi2) nw = nw2; }
        f32x4 w0 = {1.f, 1.f, 1.f, 1.f}, w1 = w0;
        const int zm = (NORM && u.pn >= zlo && u.pn < zhi) ? zmode : 0;
        if (zm == 1) { w0 = *(const f32x4*)(zw + wc * 32 + 8 * fq); w1 = *(const f32x4*)(zw + wc * 32 + 8 * fq + 4); }
        if (NORM && nw != nullptr) {
            w0 = *(const f32x4*)(nw + wc * 32 + 8 * fq); w1 = *(const f32x4*)(nw + wc * 32 + 8 * fq + 4);
            PG8_LAS float* X = (PG8_LAS float*)(lds + EPI_XCH);
#pragma unroll
            for (int ai = 0; ai < 2; ++ai)
#pragma unroll
                for (int m = 0; m < 4; ++m) { const int rl = rl0 + ai * HALF + m * 16; const float rstd = RS[rl];
#pragma unroll
                    for (int bj = 0; bj < 2; ++bj) { const f32x4 v0 = acc[ai][bj][m][0] * rstd, v1 = acc[ai][bj][m][1] * rstd;
                        float ss = ((v0[0] * v0[0] + v0[1] * v0[1]) + (v0[2] * v0[2] + v0[3] * v0[3])) + ((v1[0] * v1[0] + v1[1] * v1[1]) + (v1[2] * v1[2] + v1[3] * v1[3]));
                        ss = add_xor32(add_xor16(ss));
                        if (fq == 0) X[(bj * 256 + rl) * 4 + wc] = ss; } }
            asm volatile("s_waitcnt lgkmcnt(0)" ::: "memory"); __builtin_amdgcn_s_barrier(); asm volatile("" ::: "memory");
        }
#pragma unroll
        for (int ai = 0; ai < 2; ++ai)
#pragma unroll
            for (int m = 0; m < 4; ++m) {
                const int rl = rl0 + ai * HALF + m * 16, r = row0 + ai * HALF + m * 16;
                const float rstd = RS[rl];
                if (!is_ab) {
#pragma unroll
                    for (int bj = 0; bj < 2; ++bj) {
                        float sc = rstd;
                        if (NORM && nw != nullptr) { const f32x4 p4 = *(const PG8_LAS f32x4*)((const PG8_LAS float*)(lds + EPI_XCH) + (bj * 256 + rl) * 4);
                            sc = rstd * rsqrtf(((p4[0] + p4[1]) + (p4[2] + p4[3])) * (1.0f / 128.0f) + 1e-6f); }
                        f32x4 v0 = acc[ai][bj][m][0] * sc, v1 = acc[ai][bj][m][1] * sc;
                        if (zm != 0) {
#pragma unroll
                            for (int e = 0; e < 4; ++e) { const float s0 = __builtin_amdgcn_rcpf(1.f + __expf(-v0[e])), s1 = __builtin_amdgcn_rcpf(1.f + __expf(-v1[e]));
                                v0[e] = zm == 1 ? v0[e] * s0 : s0; v1[e] = zm == 1 ? v1[e] * s1 : s1; } }
                        v0 = v0 * w0; v1 = v1 * w1;
                        if (RELU2) {
#pragma unroll
                            for (int e = 0; e < 4; ++e) { const float a = fmaxf(v0[e], 0.f), b = fmaxf(v1[e], 0.f); v0[e] = a * a; v1[e] = b * b; }
                        }
                        u32x4 w; w.x = cvt_pk_bf16(v0[0], v0[1]); w.y = cvt_pk_bf16(v0[2], v0[3]); w.z = cvt_pk_bf16(v1[0], v1[1]); w.w = cvt_pk_bf16(v1[2], v1[3]);
                        *(u32x4*)(O + (size_t)r * ldc + colt + bj * HALF + wc * 32 + 8 * fq) = w;
                        if (HALO && m == 3 && fr >= 13) *(u32x4*)(halo + ((size_t)(r >> 6) * 3 + ((r & 63) - 61)) * ldc + colt + bj * HALF + wc * 32 + 8 * fq) = w;
                    }
                } else if (ab != nullptr && wc == 0 && fq < 2) {
                    float* p = ab + (size_t)r * 16 + 8 * fq;
                    *(f32x4*)p = acc[ai][0][m][0] * rstd; *(f32x4*)(p + 4) = acc[ai][0][m][1] * rstd;
                }
            }
    }
};
template <bool LAST = false, bool INIT_F32 = false> struct EpiRes {
    static constexpr bool PERM = true, AFTER_DRAIN = false, USE_RS = false, ACC_INIT = true;
    bf16_t* xb; float* xout; float* xsq; const float* xin;
    __device__ __forceinline__ void init(f32x4 (&acc)[2][2][4][2], const Unit& u, int wr, int wc, int fr, int fq) const {
        const int row0 = u.pm * BM + wr * 64 + fr, colt = u.pn * BM;
#pragma unroll
        for (int ai = 0; ai < 2; ++ai)
#pragma unroll
            for (int m = 0; m < 4; ++m)
#pragma unroll
                for (int bj = 0; bj < 2; ++bj) { const size_t off = (size_t)(row0 + ai * HALF + m * 16) * 1024 + colt + bj * HALF + wc * 32 + 8 * fq;
                    if (INIT_F32) { acc[ai][bj][m][0] = *(const f32x4*)(xin + off); acc[ai][bj][m][1] = *(const f32x4*)(xin + off + 4); continue; }
                    const u32x4 w = *(const u32x4*)(xb + off);
                    acc[ai][bj][m][0] = (f32x4){__uint_as_float(w.x << 16), __uint_as_float(w.x & 0xffff0000u), __uint_as_float(w.y << 16), __uint_as_float(w.y & 0xffff0000u)};
                    acc[ai][bj][m][1] = (f32x4){__uint_as_float(w.z << 16), __uint_as_float(w.z & 0xffff0000u), __uint_as_float(w.w << 16), __uint_as_float(w.w & 0xffff0000u)}; }
    }
    __device__ __forceinline__ void operator()(const f32x4 (&acc)[2][2][4][2], const Unit& u, int wr, int wc, int fr, int fq, PG8_LAS unsigned char*, int) const {
        const int row0 = u.pm * BM + wr * 64 + fr, colt = u.pn * BM;
#pragma unroll
        for (int ai = 0; ai < 2; ++ai)
#pragma unroll
            for (int m = 0; m < 4; ++m) {
                const int r = row0 + ai * HALF + m * 16; float ss = 0.f;
#pragma unroll
                for (int bj = 0; bj < 2; ++bj) {
                    const size_t off = (size_t)r * 1024 + colt + bj * HALF + wc * 32 + 8 * fq;
                    const f32x4 v0 = acc[ai][bj][m][0], v1 = acc[ai][bj][m][1];
                    if (LAST) { *(f32x4*)(xout + off) = v0; *(f32x4*)(xout + off + 4) = v1; }
                    else {
                    ss += ((v0[0] * v0[0] + v0[1] * v0[1]) + (v0[2] * v0[2] + v0[3] * v0[3])) + ((v1[0] * v1[0] + v1[1] * v1[1]) + (v1[2] * v1[2] + v1[3] * v1[3]));
                    u32x4 w; w.x = cvt_pk_bf16(v0[0], v0[1]); w.y = cvt_pk_bf16(v0[2], v0[3]); w.z = cvt_pk_bf16(v1[0], v1[1]); w.w = cvt_pk_bf16(v1[2], v1[3]);
                    *(u32x4*)(xb + off) = w; }
                }
                if (!LAST) { ss = add_xor32(add_xor16(ss));
                if (fq == 0) xsq[(size_t)r * 16 + u.pn * 4 + wc] = ss; }
            }
    }
};

template <class Epi, class Sched, bool ALIGN_EPI = false, bool SP2 = false>
__device__ __forceinline__ void gemm_phase(PG8_LAS unsigned char* lds, const Gemm g, const Sched& S, const Epi& E, int wid) {
    const int lane = lane_id_v();
    const int tid = wid * 64 + lane, wr = wid >> 2, wc = wid & 3, fr = lane & 15, fq = lane >> 4;
    const int K = g.K, nt = K / BK;
    unsigned voffA[2], voffB[2];
#pragma unroll
    for (int i = 0; i < 2; ++i) { int R, C; stage_rc(tid * 16 + i * 8192, R, C); const int Rb = Epi::PERM ? ((R & ~31) + perm32(R & 31)) : R;
        voffA[i] = (unsigned)(R * g.lda + C) * 2u; voffB[i] = (unsigned)(Rb * K + C) * 2u; }
    const size_t kstep = (size_t)(BK * 2);
    const size_t hstepA = (size_t)HALF * g.lda * 2, hstepB = (size_t)HALF * K * 2;
    const size_t tstepA = 2 * hstepA, tstepB = 2 * hstepB;
    const unsigned ldsw = (unsigned)wid * 1024u;
    const int aoff = lds_byte(wr * 64 + fr, fq * 8), boff = lds_byte(wc * 32 + fr, fq * 8);
#define PG8_SA(b, h) (((b) * 2 + (h)) * HTB)
#define PG8_SB(b, h) ((4 + (b) * 2 + (h)) * HTB)
#define PG8_STAGE(bufoff, gbase, voff) do { _Pragma("unroll") for (int _i = 0; _i < 2; ++_i) \
        __builtin_amdgcn_global_load_lds((const unsigned*)((const char*)(gbase) + (voff)[_i]), (PG8_LAS unsigned*)(lds + (bufoff) + ldsw + _i * 8192), 16, 0, 0); } while (0)
#define PG8_LDA(dst, b, h) do { _Pragma("unroll") for (int m = 0; m < 4; ++m) _Pragma("unroll") for (int k = 0; k < 2; ++k) dst[m][k] = *(const PG8_LAS bf16x8*)(lds + PG8_SA(b, h) + aoff + m * 2048 + k * 1024); } while (0)
#define PG8_LDB(dst, b, h) do { _Pragma("unroll") for (int n = 0; n < 2; ++n) _Pragma("unroll") for (int k = 0; k < 2; ++k) dst[n][k] = *(const PG8_LAS bf16x8*)(lds + PG8_SB(b, h) + boff + n * 2048 + k * 1024); } while (0)
#define PG8_MMA(ai, bj, At, Bt) do { __builtin_amdgcn_s_setprio(1); _Pragma("unroll") for (int m = 0; m < 4; ++m) _Pragma("unroll") for (int n = 0; n < 2; ++n) _Pragma("unroll") for (int k = 0; k < 2; ++k) \
        acc[ai][bj][m][n] = __builtin_amdgcn_mfma_f32_16x16x32_bf16(Bt[n][k], At[m][k], acc[ai][bj][m][n], 0, 0, 0); __builtin_amdgcn_s_setprio(0); } while (0)
#define PG8_WAIT_V(n) asm volatile("s_waitcnt vmcnt(" #n ")" ::: "memory")
#define PG8_WAIT_L(n) asm volatile("s_waitcnt lgkmcnt(" #n ")" ::: "memory")
#define PG8_BAR __builtin_amdgcn_s_barrier()
#define PG8_SCHED __builtin_amdgcn_sched_barrier(0)
    Unit cur, nxt; int ui = 0;
    if (!S.next(0, cur)) return;
    f32x4 acc[2][2][4][2];
    if constexpr (Epi::ACC_INIT) E.init(acc, cur, wr, wc, fr, fq);
    else {
#pragma unroll
    for (int a = 0; a < 2; ++a)
#pragma unroll
        for (int b = 0; b < 2; ++b)
#pragma unroll
            for (int m = 0; m < 4; ++m)
#pragma unroll
                for (int n = 0; n < 2; ++n) acc[a][b][m][n] = (f32x4){0.f, 0.f, 0.f, 0.f};
    }
    bf16x8 At[4][2], B0[2][2], B1[2][2];
    const char* cA = (const char*)g.A + (size_t)cur.pm * tstepA; const char* cB = (const char*)g.Bt + (size_t)cur.pn * tstepB;
    S.a_ready(cur);
    if constexpr (Epi::USE_RS) { if (tid < 256) { f32x4 rq[4]; E.rs_load(cur, tid, rq); E.rs_store(rq, lds, 0, tid); } }
    if constexpr (SP2) {
        PG8_STAGE(PG8_SB(0, 0), cB, voffB); PG8_STAGE(PG8_SB(0, 1), cB + hstepB, voffB); PG8_STAGE(PG8_SA(0, 0), cA, voffA); PG8_STAGE(PG8_SA(0, 1), cA + hstepA, voffA);
        if (wr == 1) PG8_BAR;
        PG8_WAIT_V(2); PG8_BAR;
        PG8_STAGE(PG8_SB(1, 0), cB + kstep, voffB); PG8_STAGE(PG8_SA(1, 0), cA + kstep, voffA); PG8_STAGE(PG8_SB(1, 1), cB + hstepB + kstep, voffB);
        PG8_WAIT_V(6); PG8_BAR;
    } else {
        PG8_STAGE(PG8_SB(0, 0), cB, voffB); PG8_STAGE(PG8_SA(0, 0), cA, voffA); PG8_STAGE(PG8_SB(0, 1), cB + hstepB, voffB); PG8_STAGE(PG8_SA(0, 1), cA + hstepA, voffA);
        if (wr == 1) PG8_BAR;
        PG8_WAIT_V(4); PG8_BAR;
        PG8_STAGE(PG8_SB(1, 0), cB + kstep, voffB); PG8_STAGE(PG8_SA(1, 0), cA + kstep, voffA); PG8_STAGE(PG8_SB(1, 1), cB + hstepB + kstep, voffB);
        PG8_WAIT_V(6); PG8_BAR;
    }
    for (;;) {
        const bool has_next = S.next(ui + 1, nxt);
        const char* nA = has_next ? (const char*)g.A + (size_t)nxt.pm * tstepA : cA; const char* nB = has_next ? (const char*)g.Bt + (size_t)nxt.pn * tstepB : cB;
        for (int t = 0; t < nt; t += 2) {
            const bool last = (t == nt - 2);
            const char* a1 = cA + (size_t)(t + 1) * kstep;
            const char* a2 = last ? nA : cA + (size_t)(t + 2) * kstep; const char* b2 = last ? nB : cB + (size_t)(t + 2) * kstep;
            const char* a3 = a2 + kstep; const char* b3 = b2 + kstep;
            if (last && has_next) S.a_ready(nxt);
            if constexpr (SP2) {
            PG8_LDB(B0, 0, 0); PG8_LDB(B1, 0, 1); PG8_SCHED; PG8_LDA(At, 0, 0); PG8_STAGE(PG8_SA(1, 1), a1 + hstepA, voffA);
            PG8_WAIT_V(8); PG8_WAIT_L(0); PG8_BAR; PG8_MMA(0, 0, At, B0); PG8_MMA(0, 1, At, B1); PG8_BAR; PG8_SCHED;
            PG8_LDA(At, 0, 1); PG8_STAGE(PG8_SB(0, 0), b2, voffB); PG8_STAGE(PG8_SB(0, 1), b2 + hstepB, voffB); PG8_STAGE(PG8_SA(0, 0), a2, voffA);
            PG8_WAIT_V(8); PG8_WAIT_L(0); PG8_BAR; PG8_MMA(1, 0, At, B0); PG8_MMA(1, 1, At, B1); PG8_BAR; PG8_SCHED;
            PG8_LDB(B0, 1, 0); PG8_LDB(B1, 1, 1); PG8_SCHED; PG8_LDA(At, 1, 0); PG8_STAGE(PG8_SA(0, 1), a2 + hstepA, voffA);
            PG8_WAIT_V(8); PG8_WAIT_L(0); PG8_BAR; PG8_MMA(0, 0, At, B0); PG8_MMA(0, 1, At, B1); PG8_BAR; PG8_SCHED;
            PG8_LDA(At, 1, 1); PG8_STAGE(PG8_SB(1, 0), b3, voffB); PG8_STAGE(PG8_SB(1, 1), b3 + hstepB, voffB); PG8_STAGE(PG8_SA(1, 0), a3, voffA);
            PG8_WAIT_V(8); PG8_WAIT_L(0); PG8_BAR; PG8_MMA(1, 0, At, B0); PG8_MMA(1, 1, At, B1); PG8_BAR; PG8_SCHED;
            } else {
            PG8_LDB(B0, 0, 0); PG8_SCHED; PG8_LDA(At, 0, 0); PG8_STAGE(PG8_SA(1, 1), a1 + hstepA, voffA);
            PG8_WAIT_L(8); PG8_BAR; PG8_WAIT_L(0); PG8_MMA(0, 0, At, B0); PG8_BAR; PG8_SCHED;
            PG8_LDB(B1, 0, 1); PG8_STAGE(PG8_SB(0, 0), b2, voffB);
            PG8_BAR; PG8_WAIT_L(0); PG8_MMA(0, 1, At, B1); PG8_BAR;
            PG8_LDA(At, 0, 1); PG8_STAGE(PG8_SA(0, 0), a2, voffA);
            PG8_BAR; PG8_WAIT_L(0); PG8_MMA(1, 0, At, B0); PG8_BAR; PG8_SCHED;
            PG8_STAGE(PG8_SB(0, 1), b2 + hstepB, voffB);
            PG8_WAIT_V(6); PG8_BAR; PG8_MMA(1, 1, At, B1); PG8_BAR;
            PG8_LDB(B0, 1, 0); PG8_SCHED; PG8_LDA(At, 1, 0); PG8_STAGE(PG8_SA(0, 1), a2 + hstepA, voffA);
            PG8_WAIT_L(8); PG8_BAR; PG8_WAIT_L(0); PG8_MMA(0, 0, At, B0); PG8_BAR; PG8_SCHED;
            PG8_LDB(B1, 1, 1); PG8_STAGE(PG8_SB(1, 0), b3, voffB);
            PG8_BAR; PG8_WAIT_L(0); PG8_MMA(0, 1, At, B1); PG8_BAR;
            PG8_LDA(At, 1, 1); PG8_STAGE(PG8_SA(1, 0), a3, voffA);
            PG8_BAR; PG8_WAIT_L(0); PG8_MMA(1, 0, At, B0); PG8_BAR; PG8_SCHED;
            PG8_STAGE(PG8_SB(1, 1), b3 + hstepB, voffB);
            PG8_WAIT_V(6); PG8_BAR; PG8_MMA(1, 1, At, B1); PG8_BAR;
            }
        }
        if constexpr (ALIGN_EPI) { if (wr == 0) PG8_BAR; }
        if constexpr (Epi::USE_RS) {
            f32x4 rq[4]; if (has_next && wid < 4) E.rs_load(nxt, wid * 64 + lane_id_v(), rq);
            E(acc, cur, wr, wc, fr, fq, lds, ui & 1);
            if (has_next && wid < 4) E.rs_store(rq, lds, (ui + 1) & 1, wid * 64 + lane_id_v());
        } else { E(acc, cur, wr, wc, fr, fq, lds, ui & 1); }
        S.done(cur);
        if (!has_next) break;
        if constexpr (Epi::ACC_INIT) E.init(acc, nxt, wr, wc, fr, fq);
        else {
#pragma unroll
        for (int a = 0; a < 2; ++a)
#pragma unroll
            for (int b = 0; b < 2; ++b)
#pragma unroll
                for (int m = 0; m < 4; ++m)
#pragma unroll
                    for (int n = 0; n < 2; ++n) acc[a][b][m][n] = (f32x4){0.f, 0.f, 0.f, 0.f};
        }
        cur = nxt; cA = nA; cB = nB; ++ui;
        if constexpr (ALIGN_EPI) { if (wr == 1) PG8_BAR; }
    }
    PG8_WAIT_V(0);
    if constexpr (!ALIGN_EPI) { if (wr == 0) PG8_BAR; }
    PG8_BAR;
    if constexpr (Epi::AFTER_DRAIN) { E.fused(acc, cur, wr, wc, fr, fq, lds, wid, lane); S.done(cur); }
#undef PG8_SA
#undef PG8_SB
#undef PG8_STAGE
#undef PG8_LDA
#undef PG8_LDB
#undef PG8_MMA
#undef PG8_WAIT_V
#undef PG8_WAIT_L
#undef PG8_BAR
#undef PG8_SCHED
}
}

namespace att {
typedef unsigned short bf16_t;
typedef short bf16x8 __attribute__((ext_vector_type(8)));
typedef short s16x4 __attribute__((ext_vector_type(4)));
typedef float f32x16 __attribute__((ext_vector_type(16)));
typedef float f32x4 __attribute__((ext_vector_type(4)));
typedef unsigned u32x4 __attribute__((ext_vector_type(4)));
constexpr int NW = 8, QBLK = 32, KVBLK = 64, QB = NW * QBLK, D = 128;
constexpr int SHM_V = KVBLK * D * 2, SHM_K = KVBLK * D * 2;
constexpr int OFF_WS = 2 * SHM_V + 2 * SHM_K, OFF_BK = OFF_WS + NW * 64 * 4, ATT_LDS = OFF_BK + 8192;
constexpr float SCALE = 0.08838834764831845f, THR = 8.f;
constexpr int WBIG = 1 << 30;
#define KSWZ(row, colB) ((row) * 256 + ((colB) ^ (((row) & 7) << 4)))
#define SBAR() __builtin_amdgcn_sched_barrier(0)
__device__ __forceinline__ int v_st(int k, int c) { const int kk = (k & ~0xC) | ((k & 4) << 1) | ((k & 8) >> 1); return ((kk >> 3) * 4 + (c >> 5)) * 512 + ((kk & 7) * 32 + (c & 31)) * 2; }
__device__ __forceinline__ int v_rd_base(int lane) { return ((lane & 3) << 3) | (((lane >> 2) & 3) << 6) | (((lane >> 4) & 1) << 5) | (((lane >> 5) & 1) << 8); }
constexpr int v_rd_off(int d0, int ks, int half) { return d0 * 512 + ks * 4096 + half * 2048; }
__device__ __forceinline__ int crow(int r, int hi) { return (r & 3) + 8 * (r >> 2) + 4 * hi; }
__device__ __forceinline__ unsigned cvtpk(float lo, float hi) { unsigned r; asm volatile("v_cvt_pk_bf16_f32 %0, %1, %2" : "=v"(r) : "v"(lo), "v"(hi)); return r; }
__device__ __forceinline__ bf16x8 load8(const bf16_t* p) { return *reinterpret_cast<const bf16x8*>(p); }
__device__ __forceinline__ void mask_tile(f32x16& p0, f32x16& p1, int dq, unsigned W) {
    const float NEG = -__builtin_inff();
#pragma unroll
    for (int r = 0; r < 16; ++r) { const int c = (r & 3) + 8 * (r >> 2);
        if ((unsigned)(dq - c) >= W) p0[r] = NEG;
        if ((unsigned)(dq - c - 32) >= W) p1[r] = NEG; }
}
__device__ __forceinline__ void partialSM(f32x16& p0, f32x16& p1, float& m_reg, float& mn, float& alpha) {
    float pmax = p0[0]; for (int r = 1; r < 16; ++r) pmax = fmaxf(pmax, p0[r]); for (int r = 0; r < 16; ++r) pmax = fmaxf(pmax, p1[r]);
    { auto rr = __builtin_amdgcn_permlane32_swap(__float_as_uint(pmax), __float_as_uint(pmax), false, false);
      pmax = fmaxf(__uint_as_float(rr[0]), __uint_as_float(rr[1])); }
    constexpr float C2 = 1.4426950408889634f * SCALE;
    if (__builtin_expect(__all((pmax - m_reg) * SCALE <= THR), 1)) { mn = m_reg; alpha = 1.f; }
    else { mn = fmaxf(m_reg, pmax); alpha = __builtin_amdgcn_exp2f((m_reg - mn) * C2); m_reg = mn; }
    const float mnL = -mn * C2;
    for (int r = 0; r < 16; ++r) p0[r] = fmaf(p0[r], C2, mnL); for (int r = 0; r < 16; ++r) p1[r] = fmaf(p1[r], C2, mnL);
    for (int r = 0; r < 16; ++r) p0[r] = __builtin_amdgcn_exp2f(p0[r]);
}
__device__ __forceinline__ void finishSM(f32x16& p0, f32x16& p1, float alpha, float& l_reg, bf16x8& pa0, bf16x8& pa1, bf16x8& pa2, bf16x8& pa3) {
    for (int r = 0; r < 16; ++r) p1[r] = __builtin_amdgcn_exp2f(p1[r]);
    float ps = 0; for (int r = 0; r < 16; ++r) ps += p0[r]; for (int r = 0; r < 16; ++r) ps += p1[r];
    { auto rr = __builtin_amdgcn_permlane32_swap(__float_as_uint(ps), __float_as_uint(ps), false, false);
      ps = __uint_as_float(rr[0]) + __uint_as_float(rr[1]); }
    l_reg = l_reg * alpha + ps;
#define PK4(P, B_, OUT) do { unsigned a0 = cvtpk(P[B_+0], P[B_+1]), a1 = cvtpk(P[B_+2], P[B_+3]);                          \
        unsigned b0 = cvtpk(P[B_+4], P[B_+5]), b1 = cvtpk(P[B_+6], P[B_+7]);                                             \
        auto r0 = __builtin_amdgcn_permlane32_swap(a0, b0, false, false); auto r1 = __builtin_amdgcn_permlane32_swap(a1, b1, false, false); \
        u32x4 w = {r0[0], r1[0], r0[1], r1[1]}; OUT = *reinterpret_cast<bf16x8*>(&w); } while (0)
    PK4(p0, 0, pa0); PK4(p0, 8, pa1); PK4(p1, 0, pa2); PK4(p1, 8, pa3);
#undef PK4
}
template <int KB>
__device__ __forceinline__ void qkt(f32x16& p0, f32x16& p1, const char* K_lds, int r32, int hi, const bf16x8* qr, const float* bb) {
#pragma unroll
    for (int g = 0; g < 4; ++g) { const f32x4 b0 = *(const f32x4*)(bb + 8 * g), b1 = *(const f32x4*)(bb + 32 + 8 * g);
#pragma unroll
        for (int i = 0; i < 4; ++i) { p0[4 * g + i] = b0[i]; p1[4 * g + i] = b1[i]; } }
    const char* kb[4];
#pragma unroll
    for (int dd = 0; dd < 4; ++dd) kb[dd] = K_lds + KB * SHM_K + KSWZ(r32, (dd * 16 + hi * 8) * 2);
#pragma unroll
    for (int d0 = 0; d0 < 8; ++d0) { const char* a = kb[d0 & 3] + (d0 >> 2) * 128;
        bf16x8 b0 = *reinterpret_cast<const bf16x8*>(a);
        bf16x8 b1 = *reinterpret_cast<const bf16x8*>(a + 32 * 256);
        p0 = __builtin_amdgcn_mfma_f32_32x32x16_bf16(b0, qr[d0], p0, 0, 0, 0);
        p1 = __builtin_amdgcn_mfma_f32_32x32x16_bf16(b1, qr[d0], p1, 0, 0, 0); }
}
template <int VB>
__device__ __forceinline__ void pv_tile(f32x16* o, int vb0, bf16x8 pa0, bf16x8 pa1, bf16x8 pa2, bf16x8 pa3) {
#define TRRD(dst, off) asm volatile("ds_read_b64_tr_b16 %0, %1 offset:%2" : "=&v"(dst) : "v"(vb0), "i"(off) : "memory")
#define PV_D0(d0) do { s16x4 l0, l1, l2, l3, h0, h1, h2, h3; constexpr int b_ = VB * SHM_V + v_rd_off(d0, 0, 0);   \
        TRRD(l0, b_); TRRD(h0, b_ + 2048); TRRD(l1, b_ + 4096); TRRD(h1, b_ + 6144); TRRD(l2, b_ + 8192); TRRD(h2, b_ + 10240); TRRD(l3, b_ + 12288); TRRD(h3, b_ + 14336); \
        asm volatile("s_waitcnt lgkmcnt(0)" ::: "memory"); SBAR();   \
        o[d0] = __builtin_amdgcn_mfma_f32_32x32x16_bf16(pa0, (bf16x8){l0[0], l0[1], l0[2], l0[3], h0[0], h0[1], h0[2], h0[3]}, o[d0], 0, 0, 0);   \
        o[d0] = __builtin_amdgcn_mfma_f32_32x32x16_bf16(pa1, (bf16x8){l1[0], l1[1], l1[2], l1[3], h1[0], h1[1], h1[2], h1[3]}, o[d0], 0, 0, 0);   \
        o[d0] = __builtin_amdgcn_mfma_f32_32x32x16_bf16(pa2, (bf16x8){l2[0], l2[1], l2[2], l2[3], h2[0], h2[1], h2[2], h2[3]}, o[d0], 0, 0, 0);   \
        o[d0] = __builtin_amdgcn_mfma_f32_32x32x16_bf16(pa3, (bf16x8){l3[0], l3[1], l3[2], l3[3], h3[0], h3[1], h3[2], h3[3]}, o[d0], 0, 0, 0); } while (0)
    PV_D0(0); PV_D0(1); PV_D0(2); PV_D0(3);
#undef PV_D0
#undef TRRD
}
constexpr int QP = 4608;
struct Blk { bf16_t* Q; const bf16_t* K; const float* flog; float fb; int voff, goff, P0, skv, kvpitch; };
struct Seam { bf16x8 qr[8]; bf16x8 st_v0, st_v1, st_k0, st_k1; };
#define ROW(p, pitch, k0, rr) ((p) + (size_t)((k0) + (rr)) * (pitch) + sc)
#define VMW() asm volatile("s_waitcnt vmcnt(0)" ::: "memory")
#define VMWN(n) asm volatile("s_waitcnt vmcnt(%0)" :: "i"(n) : "memory")
#define SLOAD_H(Kp, Vp, pitch, k0) do { S.st_v0 = load8(ROW(Vp, pitch, k0, sr)); S.st_v1 = load8(ROW(Vp, pitch, k0, 32 + sr));              \
                         S.st_k0 = load8(ROW(Kp, pitch, k0, sr)); S.st_k1 = load8(ROW(Kp, pitch, k0, 32 + sr)); } while (0)
#define SWRITE_HK(bf) do { *(bf16x8*)(K_lds + (bf) * SHM_K + kws) = S.st_k0; *(bf16x8*)(K_lds + (bf) * SHM_K + kws + 32 * 256) = S.st_k1; } while (0)
#define SWRITE_HV(bf) do { *(bf16x8*)(V_lds + (bf) * SHM_V + vst0) = S.st_v0; *(bf16x8*)(V_lds + (bf) * SHM_V + vst1) = S.st_v1; } while (0)
#define SWRITE_H(bf) do { SWRITE_HV(bf); SWRITE_HK(bf); } while (0)
__device__ __forceinline__ void prime(const Blk& cur, char* lds, Seam& S, int wid) {
    const int lane = lane_id_v();
    const int tid = wid * 64 + lane, r32 = lane & 31, hi = lane >> 5;
    const int sr = tid >> 4, sc = (tid & 15) * 8, kws = KSWZ(sr, sc * 2); char* K_lds = lds + 2 * SHM_V;
    for (int d0 = 0; d0 < 8; ++d0) S.qr[d0] = load8(cur.Q + (size_t)(wid * QBLK + r32) * QP + d0 * 16 + hi * 8);
    SLOAD_H(cur.K, cur.K + cur.voff, cur.kvpitch, 0); VMW(); SWRITE_HK(0);
    __syncthreads();
}
__device__ __forceinline__ void block(const Blk& cur, const Blk& nxt, char* lds, Seam& S, int wid) {
    const int lane = lane_id_v();
    const int tid = wid * 64 + lane, r32 = lane & 31, hi = lane >> 5;
    constexpr int W = WBIG;
    int j_hi = (cur.P0 + QB - 1) / KVBLK + 1; if (j_hi > cur.skv / KVBLK) j_hi = cur.skv / KVBLK;
    const int NT = j_hi;
    const int qlo = cur.P0 + wid * QBLK, qm = qlo + r32 - 4 * hi;
    char* V_lds = lds; char* K_lds = lds + 2 * SHM_V;
    float* ws = (float*)(lds + OFF_WS) + wid * 64; float* li_l = ws, * al_l = ws + 32;
    float* bkl = (float*)(lds + OFF_BK);
    { const int nkeys = NT * KVBLK;
      if (cur.flog) { const int k0 = 4 * tid; float f[4];
#pragma unroll
          for (int e = 0; e < 4; ++e) { float x = 0.f; if (k0 + e < nkeys) x = cur.flog[(size_t)(k0 + e) * 16] + cur.fb;
              f[e] = k0 + e < nkeys ? fminf(x, 0.f) - log1pf(__expf(-fabsf(x))) : 0.f; }
          f[1] += f[0]; f[2] += f[1]; f[3] += f[2];
          float sc = f[3];
#pragma unroll
          for (int o_ = 1; o_ < 64; o_ <<= 1) { const float t_ = __shfl_up(sc, o_); if (lane >= o_) sc += t_; }
          if (lane == 63) ws[0] = sc;
          __syncthreads();
          float off = sc - f[3];
          for (int w_ = 0; w_ < wid; ++w_) off += ((const float*)(lds + OFF_WS))[w_ * 64];
#pragma unroll
          for (int e = 0; e < 4; ++e) if (k0 + e < nkeys) bkl[k0 + e] = -(f[e] + off) * (1.f / SCALE); }
      else for (int k = tid; k < nkeys; k += NW * 64) bkl[k] = 0.f;
      __syncthreads(); }
    float m_reg = -1e30f, l_reg = 0; f32x16 o[4] = {};
    const int sr = tid >> 4, sc = (tid & 15) * 8, vst0 = v_st(sr, sc), vst1 = v_st(32 + sr, sc), kws = KSWZ(sr, sc * 2);
    const int vb0 = (int)(uintptr_t)V_lds + v_rd_base(lane);
    const bf16_t* Kh = cur.K; const bf16_t* Vh = cur.K + cur.voff; const int kvp = cur.kvpitch;
#define RESC(a) do { if (__any((a) < 1.f)) { if (hi == 0) al_l[r32] = (a); asm volatile("s_waitcnt lgkmcnt(0)" ::: "memory");              \
                     for (int d_ = 0; d_ < 4; ++d_) for (int r = 0; r < 16; ++r) o[d_][r] *= al_l[crow(r, hi)]; } } while (0)
#define KBASE(t) ((t) * KVBLK)
#define MASKT(P0_, P1_, t) do { const int kb_ = KBASE(t); if (kb_ + KVBLK - 1 > qlo) mask_tile(P0_, P1_, qm - kb_, (unsigned)W); } while (0)
#define BB(t) (bkl + KBASE(t) + 4 * hi)
    constexpr int NQL = 8;
#define SEAM_K0() do { VMWN(NQL); SWRITE_HK(0); SBAR(); } while (0)
    f32x16 pA0, pA1, pB0, pB1; float mnA, mnB, alA, alB; bf16x8 pa0, pa1, pa2, pa3;
    SWRITE_HV(0); SBAR();
    if (NT > 1) { SLOAD_H(Kh, Vh, kvp, KBASE(1)); }
    SBAR(); qkt<0>(pA0, pA1, K_lds, r32, hi, S.qr, BB(0));
    MASKT(pA0, pA1, 0); partialSM(pA0, pA1, m_reg, mnA, alA);
    if (NT > 1) { VMW(); SWRITE_H(1); }
    __syncthreads();
#define HALF_STEP(PX0, PX1, mnX, alX, PY0, PY1, alY, t, KB, VB, SB) do {                                                      \
        SBAR(); qkt<KB>(PX0, PX1, K_lds, r32, hi, S.qr, BB(t));                                                                      \
        finishSM(PY0, PY1, alY, l_reg, pa0, pa1, pa2, pa3); SBAR();                                                           \
        if ((t) + 1 < NT) { SLOAD_H(Kh, Vh, kvp, KBASE((t) + 1)); SBAR(); }                                                   \
        pv_tile<VB>(o, vb0, pa0, pa1, pa2, pa3); MASKT(PX0, PX1, (t)); partialSM(PX0, PX1, m_reg, mnX, alX);   \
        __syncthreads();                                                                                                      \
        if ((t) + 1 < NT) { VMW(); SWRITE_H(SB); }                                                                            \
        RESC(alX); __syncthreads(); } while (0)
    for (int t = 1; t + 1 < NT; t += 2) {
        HALF_STEP(pB0, pB1, mnB, alB, pA0, pA1, alA, t, 1, 0, 0);
        HALF_STEP(pA0, pA1, mnA, alA, pB0, pB1, alB, t + 1, 0, 1, 1);
    }
    const bool even = (NT & 1) == 0;
    if (even) { SBAR(); qkt<1>(pB0, pB1, K_lds, r32, hi, S.qr, BB(NT - 1)); SBAR(); }
    SLOAD_H(nxt.K, nxt.K + nxt.voff, nxt.kvpitch, 0); SBAR();
#pragma unroll
    for (int d0 = 0; d0 < 8; ++d0) S.qr[d0] = load8(nxt.Q + (size_t)(wid * QBLK + r32) * QP + d0 * 16 + hi * 8);
    SBAR();
    finishSM(pA0, pA1, alA, l_reg, pa0, pa1, pa2, pa3); SBAR();
    pv_tile<0>(o, vb0, pa0, pa1, pa2, pa3);
    if (even) { MASKT(pB0, pB1, NT - 1); partialSM(pB0, pB1, m_reg, mnB, alB); __syncthreads(); RESC(alB);
        finishSM(pB0, pB1, alB, l_reg, pa0, pa1, pa2, pa3); SBAR(); pv_tile<1>(o, vb0, pa0, pa1, pa2, pa3); }
    SBAR(); SEAM_K0();
    if (hi == 0) li_l[r32] = l_reg; asm volatile("s_waitcnt lgkmcnt(0)" ::: "memory");
    float rli[16];
#pragma unroll
    for (int r = 0; r < 16; ++r) rli[r] = __builtin_amdgcn_rcpf(li_l[crow(r, hi)]);
    const int odd = r32 & 1;
    bf16_t* Ow = cur.Q + (size_t)(wid * QBLK + 4 * hi) * QP + (r32 & ~1) + 32 * odd; const int goff = cur.goff;
    auto fin = [&](auto has_gate) {
        unsigned g[16][2];
        if (has_gate.value) {
#pragma unroll
            for (int r = 0; r < 16; ++r) { const int ro = ((r & 3) + 8 * (r >> 2)) * QP;
#pragma unroll
                for (int dp = 0; dp < 2; ++dp) g[r][dp] = *(const unsigned*)(Ow + goff + ro + dp * 64); }
        }
#pragma unroll
        for (int r = 0; r < 16; ++r) { const int ro = ((r & 3) + 8 * (r >> 2)) * QP;
#pragma unroll
            for (int dp = 0; dp < 2; ++dp) { const float a = o[2 * dp][r] * rli[r], b = o[2 * dp + 1][r] * rli[r];
                const float recv = dppf<0xB1>(odd ? a : b);
                float lo = odd ? recv : a, hi2 = odd ? b : recv;
                if (has_gate.value) { lo *= __uint_as_float(g[r][dp] << 16); hi2 *= __uint_as_float(g[r][dp] & 0xffff0000u); }
                *(unsigned*)(Ow + ro + dp * 64) = cvtpk(lo, hi2); } }
    };
    if (goff) fin(std::true_type{}); else fin(std::false_type{});
    __syncthreads();
#undef RESC
#undef KBASE
#undef MASKT
#undef BB
#undef SEAM_K0
#undef HALF_STEP
}
#undef ROW
#undef VMW
#undef VMWN
#undef SLOAD_H
#undef SWRITE_HK
#undef SWRITE_HV
#undef SWRITE_H
#undef KSWZ
#undef SBAR
template <class Src> __device__ __forceinline__ void phase(char* lds, const Src& src, int wid) {
    Blk cur, nxt; if (!src(0, cur)) return;
    Seam S; prime(cur, lds, S, wid);
    for (int n = 0;; ++n) { const bool more = src(n + 1, nxt); if (!more) nxt = cur; block(cur, nxt, lds, S, wid); if (!more) break; cur = nxt; }
}
}

constexpr int NWAVES = 8;
#ifndef MK_LAUNCH_PER_PHASE
#define MK_LAUNCH_PER_PHASE 0
#endif
constexpr int N_PHASES = 12;

constexpr size_t KiB = 1u << 10, MiB = 1u << 20;
constexpr size_t WS_CTL = 0, CTL_ZERO_BYTES = 1 * MiB;
constexpr size_t WS_WIN0 = 1 * MiB, WS_WIN1 = WS_WIN0 + (size_t)N_IN * DM * 2;
constexpr size_t WS_WOUT0 = 20 * MiB, WS_WOUT1 = 23 * MiB;
constexpr size_t WS_WM1_0 = 26 * MiB, WS_WM1_1 = 34 * MiB, WS_WM2_0 = 42 * MiB, WS_WM2_1 = 50 * MiB;
constexpr size_t WS_WMKV = 58 * MiB;
constexpr size_t WS_PROJ = 60 * MiB;
constexpr size_t WS_XB = 204 * MiB;
constexpr size_t WS_SSQ = 236 * MiB;
constexpr size_t WS_AB = 245 * MiB;
constexpr size_t WS_MEMKV = 246 * MiB;
constexpr size_t WS_XSQ = 250 * MiB;
constexpr size_t WS_FCUM = 251 * MiB;
constexpr size_t WS_MSSQ = 251 * MiB + 512 * KiB;
constexpr size_t WS_MSQ = 251 * MiB + 768 * KiB;
constexpr size_t WS_END = 252 * MiB;
static_assert(WS_WIN1 + (size_t)N_IN * DM * 2 <= WS_WOUT0 && WS_PROJ + (size_t)MROWS * PW * 2 <= WS_XB && WS_SSQ + (size_t)36 * MROWS * 16 <= WS_AB, "d_ws map");
constexpr size_t DO_MEMB = 0;
constexpr int CW_BAR = 4096;

constexpr int LDS_BYTES = 155648;
constexpr int MISC_OFF = LDS_BYTES - 256;

#define GAS __attribute__((address_space(1)))
#define LAS __attribute__((address_space(3)))
typedef unsigned short bf16;
typedef unsigned v4u __attribute__((ext_vector_type(4)));
typedef float f32x4 __attribute__((ext_vector_type(4)));
typedef short bf16x8 __attribute__((ext_vector_type(8)));
typedef GAS unsigned gu32;
typedef GAS unsigned long long gu64;
#define RLX_AGENT __ATOMIC_RELAXED, __HIP_MEMORY_SCOPE_AGENT
#define LDS_WAIT() asm volatile("s_waitcnt lgkmcnt(0)" ::: "memory")
#define VM_WAIT() asm volatile("s_waitcnt vmcnt(0)" ::: "memory")
__device__ __forceinline__ unsigned long long rt() { return __builtin_amdgcn_s_memrealtime(); }
__device__ __forceinline__ unsigned f2bf(float f) { unsigned u = __builtin_bit_cast(unsigned, f); return (u + 0x7fffu + ((u >> 16) & 1u)) >> 16; }
__device__ __forceinline__ unsigned pk2(float lo, float hi) { return f2bf(lo) | (f2bf(hi) << 16); }

#define XB_TMO      128
#define XB_XCNT(j)  (256  + 64 * (j))
#define XB_XSUB(j)  (1280 + 64 * (j))
#define XB_XGEN(j)  (2304 + 64 * (j))
#define XB_TOP      3328
#define XB_TOPGEN   3392
#define XCD_BAR_WORDS 3456
#define XB_SPIN_CAP (1u << 18)

__device__ __forceinline__ unsigned xb_ld(unsigned* p)              { return __hip_atomic_load(p, __ATOMIC_RELAXED, __HIP_MEMORY_SCOPE_AGENT); }
__device__ __forceinline__ unsigned xb_add(unsigned* p, unsigned v) { return __hip_atomic_fetch_add(p, v, __ATOMIC_RELAXED, __HIP_MEMORY_SCOPE_AGENT); }
__device__ __forceinline__ unsigned xb_xcc_id() { return (unsigned)__builtin_amdgcn_s_getreg((3 << 11) | 20) & 0xFu; }
#define XB_SPIN(cond, bar) do { unsigned _sp = 0; while (cond) { __builtin_amdgcn_s_sleep(1); \
    if ((++_sp & 255u) == 0u) { if (xb_ld(&(bar)[XB_TMO])) break; if (_sp > XB_SPIN_CAP) { atomicAdd(&(bar)[XB_TMO], 1u); break; } } } } while (0)

struct XcdBarrier {
    unsigned* bar; unsigned x; int wv;
    volatile LAS unsigned* st;
};

__device__ __forceinline__ XcdBarrier xcd_barrier_post(unsigned* bar, volatile LAS unsigned* st) {
    XcdBarrier b; b.bar = bar; b.x = xb_xcc_id(); b.st = st;
    if (threadIdx.x == 0) (void)xb_add(&bar[XB_XCNT(b.x)], 1u);
    return b;
}
__device__ __forceinline__ void xcd_barrier_complete(unsigned* bar, unsigned x, unsigned& nloc, unsigned& nx) {
    const unsigned G = gridDim.x * gridDim.y * gridDim.z;
    unsigned sum, cnt, mine, sp = 0u;
    for (;;) {
        sum = 0u; cnt = 0u; mine = 0u;
#pragma unroll
        for (unsigned j = 0; j < 16; ++j) { const unsigned c = xb_ld(&bar[XB_XCNT(j)]); sum += c; cnt += (c > 0u) ? 1u : 0u; mine = (j == x) ? c : mine; }
        if (sum == G) break;
        __builtin_amdgcn_s_sleep(1);
        if ((++sp & 255u) == 0u) { if (xb_ld(&bar[XB_TMO])) break; if (sp > XB_SPIN_CAP) { atomicAdd(&bar[XB_TMO], 1u); break; } }
    }
    nloc = mine > 0u ? mine : 1u; nx = cnt > 0u ? cnt : 1u;
}

__device__ __forceinline__ void xcd_barrier(const XcdBarrier& b) {
    asm volatile("s_waitcnt vmcnt(0)" ::: "memory");
    __syncthreads();
    if (b.wv == 0 && lane_id_v() == 0) {
        unsigned* bar = b.bar;
        __builtin_amdgcn_s_waitcnt(0);
        unsigned nloc = b.st[0], nx = b.st[1];
        if (nloc == 0u) { xcd_barrier_complete(bar, b.x, nloc, nx); b.st[0] = nloc; b.st[1] = nx; }
        const unsigned old = xb_add(&bar[XB_XSUB(b.x)], 1u);
        const unsigned gen = old / nloc;
        if (old + 1u == (gen + 1u) * nloc) {
            __builtin_amdgcn_fence(__ATOMIC_RELEASE, "agent");
            asm volatile("s_waitcnt vmcnt(0)" ::: "memory");
            const unsigned og = xb_add(&bar[XB_TOP], 1u);
            const unsigned tg = og / nx;
            if (og + 1u == (tg + 1u) * nx) xb_add(&bar[XB_TOPGEN], 1u);
            else XB_SPIN(xb_ld(&bar[XB_TOPGEN]) == tg, bar);
            __builtin_amdgcn_fence(__ATOMIC_ACQUIRE, "agent");
            xb_add(&bar[XB_XGEN(b.x)], 1u);
            asm volatile("s_waitcnt vmcnt(0)" ::: "memory");
        } else {
            XB_SPIN(xb_ld(&bar[XB_XGEN(b.x)]) == gen, bar);
            __builtin_amdgcn_fence(__ATOMIC_ACQUIRE, "agent");
            asm volatile("s_waitcnt vmcnt(0)" ::: "memory");
        }
    }
    __syncthreads();
}


__device__ __forceinline__ float bflo(unsigned u) { return __builtin_bit_cast(float, u << 16); }
__device__ __forceinline__ float bfhi(unsigned u) { return __builtin_bit_cast(float, u & 0xffff0000u); }
typedef float f32x2_t __attribute__((ext_vector_type(2))); typedef __bf16 bf16x2_t __attribute__((ext_vector_type(2)));
__device__ __forceinline__ unsigned pkbf(float lo, float hi) { const f32x2_t v = {lo, hi}; const bf16x2_t b = __builtin_convertvector(v, bf16x2_t); return __builtin_bit_cast(unsigned, b); }
__device__ __forceinline__ float wave_sum(float v) { return add_xor32(add_xor16(row16_sum(v))); }
__device__ __forceinline__ float wave_max(float v) {
#pragma unroll
    for (int o = 1; o < 64; o <<= 1) v = fmaxf(v, __shfl_xor(v, o));
    return v;
}

struct Args { const float* in[20]; float* out; unsigned char* ws; int ph_lo, ph_hi, li, pad; };
enum { I_X = 0, I_MEM, I_MEMNW, I_WMKV, I_MEMKNW, I_NORM1, I_DNWIN, I_DNCONV, I_DNALOG, I_DNDT, I_DNONW, I_FOXWIN, I_FOXFB, I_FOXQNW, I_FOXKNW, I_MEMQNW, I_WOUT, I_NORM2, I_WM1, I_WM2 };

struct Frame {
    LAS unsigned char* lds;
    int G, bid, wv;
    const float* const* in; float* out; unsigned char* ws;
};


constexpr int CW_XCC = 32768, CW_BAD = 33792, CW_GRP = 65536;
struct GrpBar { unsigned* cnt; unsigned* tmo; int wv; bool on; };
__device__ __forceinline__ void grp_barrier(const GrpBar& gb, int seam) {
    asm volatile("s_waitcnt vmcnt(0)" ::: "memory");
    __syncthreads();
    if (gb.wv == 0 && lane_id_v() == 0) { unsigned* p = gb.cnt + seam * 64;
        (void)__hip_atomic_fetch_add(p, 1u, __ATOMIC_RELAXED, __HIP_MEMORY_SCOPE_AGENT);
        unsigned sp = 0;
        while (__hip_atomic_load(p, __ATOMIC_RELAXED, __HIP_MEMORY_SCOPE_AGENT) < 4u) { __builtin_amdgcn_s_sleep(1); if (++sp > (1u << 22)) { atomicAdd(gb.tmo, 1u); break; } }
        __builtin_amdgcn_fence(__ATOMIC_ACQUIRE, "agent");
        asm volatile("s_waitcnt vmcnt(0)" ::: "memory"); }
    __syncthreads();
}
struct Tix { int tid, lane, wave; };
__device__ __forceinline__ int lane_id() { return lane_id_v(); }
__device__ __forceinline__ Tix tix(int wv) { Tix t; t.lane = lane_id(); t.wave = wv; t.tid = wv * 64 + t.lane; return t; }
struct TSeg { const float* W; int K, ldw, src0, ncols; bf16* WT; int dst0; const float* scale; };
__device__ __forceinline__ TSeg get_seg(const Frame& F, int s) {
    TSeg t; t.scale = nullptr; t.src0 = 0; t.dst0 = 0;
    if (s < 12) {
        const int l = s / 6, j = s % 6;
        t.W = l ? F.in[I_FOXWIN] : F.in[I_DNWIN]; t.K = DM; t.ldw = l ? FOX_IN : DN_IN; t.WT = (bf16*)(F.ws + (l ? WS_WIN1 : WS_WIN0)); t.scale = F.in[I_NORM1] + l * DM;
        const int qm0 = l ? 4104 : 4112, nsc = l ? 8 : 16;
        t.ncols = 1024;
        if (j == 0) { t.src0 = 1024; t.dst0 = PC_K; } else if (j == 1) { t.src0 = 2048; t.dst0 = PC_V; } else if (j == 2) { t.src0 = 3072; t.dst0 = PC_Z; }
        else if (j == 3) { t.src0 = 0; t.dst0 = PC_Q; } else if (j == 4) { t.src0 = qm0; t.dst0 = PC_QM; t.ncols = 512; } else { t.src0 = 4096; t.dst0 = PC_AB; t.ncols = nsc; }
    } else if (s < 14) { const int l = s - 12; t.W = F.in[I_WOUT] + (size_t)l * OUT_IN * DM; t.K = OUT_IN; t.ldw = DM; t.ncols = DM; t.WT = (bf16*)(F.ws + (l ? WS_WOUT1 : WS_WOUT0)); }
    else if (s < 16) { const int l = s - 14; t.W = F.in[I_WM1] + (size_t)l * DM * FF; t.K = DM; t.ldw = FF; t.ncols = FF; t.WT = (bf16*)(F.ws + (l ? WS_WM1_1 : WS_WM1_0)); t.scale = F.in[I_NORM2] + l * DM; }
    else if (s < 18) { const int l = s - 16; t.W = F.in[I_WM2] + (size_t)l * FF * DM; t.K = FF; t.ldw = DM; t.ncols = DM; t.WT = (bf16*)(F.ws + (l ? WS_WM2_1 : WS_WM2_0)); }
    else { t.W = F.in[I_WMKV]; t.K = DM; t.ldw = DM; t.ncols = DM; t.WT = (bf16*)(F.ws + WS_WMKV); t.scale = F.in[I_MEMNW]; }
    return t;
}
__device__ __forceinline__ int seg_items(const TSeg& t) { return (t.K / 64) * ((t.ncols + 63) / 64); }
__device__ __forceinline__ void tr_load(const TSeg& t, int item, int lane, f32x4 (&v)[16]) {
    const int nblk = (t.ncols + 63) / 64, kb = item / nblk, nb = item - kb * nblk, k0 = 64 * kb, n0 = 64 * nb;
    const int n4 = (lane & 15) * 4, kr = lane >> 4; const bool ok = (n0 + n4) < t.ncols;
    const float* p = t.W + (size_t)(k0 + kr) * t.ldw + t.src0 + n0 + n4;
#pragma unroll
    for (int i = 0; i < 16; ++i) v[i] = ok ? *(const f32x4*)(p + (size_t)(4 * i) * t.ldw) : (f32x4){0.f, 0.f, 0.f, 0.f};
}
__device__ __forceinline__ void tr_store(const TSeg& t, int item, int lane, const f32x4 (&v)[16], LAS float* scr) {
    const int nblk = (t.ncols + 63) / 64, kb = item / nblk, nb = item - kb * nblk, k0 = 64 * kb, n0 = 64 * nb;
    const int n4 = (lane & 15) * 4, kr = lane >> 4;
#pragma unroll
    for (int i = 0; i < 16; ++i) *(LAS f32x4*)(scr + (4 * i + kr) * 68 + n4) = v[i];
    LDS_WAIT(); asm volatile("" ::: "memory");
    const int c = lane & 7; f32x4 s0 = {1.f, 1.f, 1.f, 1.f}, s1 = s0;
    if (t.scale) { s0 = *(const f32x4*)(t.scale + k0 + 8 * c); s1 = *(const f32x4*)(t.scale + k0 + 8 * c + 4); }
#pragma unroll
    for (int j = 0; j < 8; ++j) { const int n = (lane >> 3) + 8 * j; const LAS float* q = scr + (8 * c) * 68 + n;
        v4u o; o.x = pkbf(q[0 * 68] * s0[0], q[1 * 68] * s0[1]); o.y = pkbf(q[2 * 68] * s0[2], q[3 * 68] * s0[3]); o.z = pkbf(q[4 * 68] * s1[0], q[5 * 68] * s1[1]); o.w = pkbf(q[6 * 68] * s1[2], q[7 * 68] * s1[3]);
        if (n0 + n < t.ncols) *(v4u*)(t.WT + (size_t)(t.dst0 + n0 + n) * t.K + k0 + 8 * c) = o; }
    LDS_WAIT(); asm volatile("" ::: "memory");
}
template <int NR> __device__ __forceinline__ void rows_to_bf16(int lane, const float* x, bf16* o, float* sq) {
    f32x4 v[NR][4];
#pragma unroll
    for (int r = 0; r < NR; ++r)
#pragma unroll
        for (int j = 0; j < 4; ++j) v[r][j] = ((const f32x4*)(x + (size_t)r * DM))[lane + 64 * j];
#pragma unroll
    for (int r = 0; r < NR; ++r) { float s = 0.f;
#pragma unroll
        for (int j = 0; j < 4; ++j) s += (v[r][j].x * v[r][j].x + v[r][j].y * v[r][j].y) + (v[r][j].z * v[r][j].z + v[r][j].w * v[r][j].w);
        s = wave_sum(s);
        unsigned long long* o8 = (unsigned long long*)(o + (size_t)r * DM) + lane;
#pragma unroll
        for (int j = 0; j < 4; ++j) o8[64 * j] = (unsigned long long)pkbf(v[r][j].x, v[r][j].y) | ((unsigned long long)pkbf(v[r][j].z, v[r][j].w) << 32);
        if (lane < 16) sq[(size_t)r * 16 + lane] = lane == 0 ? s : 0.f; }
}
template <int S0, int S1> __device__ __forceinline__ void convert_weights(const Frame& F, LAS float* scr, int lane, int gw, int NGW, int base) {
#pragma unroll
    for (int s = S0; s < S1; ++s) {
        const TSeg t = get_seg(F, s); const int n = seg_items(t);
        int it = gw - (base % NGW); if (it < 0) it += NGW;
        f32x4 va[16], vb[16];
        if (it < n) tr_load(t, it, lane, va);
        while (it < n) {
            int nx = it + NGW; if (nx < n) tr_load(t, nx, lane, vb);
            tr_store(t, it, lane, va, scr); it = nx; if (it >= n) break;
            nx = it + NGW; if (nx < n) tr_load(t, nx, lane, va);
            tr_store(t, it, lane, vb, scr); it = nx;
        }
        base += n;
    }
}
__device__ __forceinline__ void p0_prologue(const Frame& F) {
    const Tix T = tix(F.wv);
    LAS float* scr = (LAS float*)(F.lds + T.wave * 17408);
    const int gw = F.bid * NWAVES + T.wave, NGW = F.G * NWAVES;
    for (int m = gw * 4; m < MROWS; m += NGW * 4) rows_to_bf16<4>(T.lane, F.in[I_X] + (size_t)m * DM, (bf16*)(F.ws + WS_XB) + (size_t)m * DM, (float*)(F.ws + WS_XSQ) + (size_t)m * 16);
    for (int m = gw; m < MMEM; m += NGW) rows_to_bf16<1>(T.lane, F.in[I_MEM] + (size_t)m * DM, (bf16*)((unsigned char*)F.out + DO_MEMB) + (size_t)m * DM, (float*)(F.ws + WS_MSQ) + (size_t)m * 16);
    convert_weights<0, 6>(F, scr, T.lane, gw, NGW, 0);
    convert_weights<18, 19>(F, scr, T.lane, gw, NGW, 1168);
}

typedef short dn_bf16x8 __attribute__((ext_vector_type(8)));
typedef unsigned dn_u32x2 __attribute__((ext_vector_type(2)));
__device__ __forceinline__ f32x4 mfma16(dn_bf16x8 a, dn_bf16x8 b, f32x4 c) { return __builtin_amdgcn_mfma_f32_16x16x32_bf16(a, b, c, 0, 0, 0); }
__device__ __forceinline__ f32x4 mfma4(float a, float b, f32x4 c) { return __builtin_amdgcn_mfma_f32_16x16x4f32(a, b, c, 0, 0, 0); }
__device__ __forceinline__ dn_bf16x8 pack8f(f32x4 x, f32x4 y) { v4u w; w.x = pkbf(x[0], x[1]); w.y = pkbf(x[2], x[3]); w.z = pkbf(y[0], y[1]); w.w = pkbf(y[2], y[3]); return __builtin_bit_cast(dn_bf16x8, w); }
__device__ __forceinline__ dn_u32x2 pack4f(f32x4 x) { dn_u32x2 w; w.x = pkbf(x[0], x[1]); w.y = pkbf(x[2], x[3]); return w; }
__device__ __forceinline__ unsigned short bf1(float x) { return (unsigned short)(pkbf(x, 0.f) & 0xffffu); }
constexpr size_t DO_QKS = 4 * MiB, DO_HALO = 20 * MiB, DO_EGL = 27 * MiB, DO_WNEG = 28 * MiB;
constexpr int P_RAW = 0, P_GB = 51712, P_QH = 53248, P_KH = 70656, P_VBT = 88064, P_KBGT = 106496, P_QKL = 124928, P_END = 134144;
constexpr int P_AT = 0, P_TB = 17408, P_PS = 26624, P_PS2 = 29184;
struct DnPre { v4u P[7]; float ga, gb; f32x4 cw[3][4]; };
__device__ __forceinline__ void dn_prep_load(const Frame& F, int u, DnPre& R) {
    const Tix T = tix(F.wv); const int tid = T.tid, lane = T.lane;
    const int bh = u >> 5, c = u & 31, b = bh >> 3, h = bh & 7; const size_t row0 = (size_t)b * SEQ + c * 64; const int gch = b * 32 + c;
    const bf16* proj = (const bf16*)(F.ws + WS_PROJ); const float* AB = (const float*)(F.ws + WS_AB); const bf16* halo = (const bf16*)((unsigned char*)F.out + DO_HALO);
#pragma unroll
    for (int j = 0; j < 7; ++j) { const int id = tid + 512 * j; v4u val = {0u, 0u, 0u, 0u};
        if (id < 67 * 48) { const int r = id / 48, rem = id - r * 48, seg = rem >> 4, ch = rem & 15;
            const int col = (seg == 0 ? PC_Q : seg == 1 ? PC_K : PC_V) + h * HD + ch * 8;
            if (r >= 3) val = *(const v4u*)(proj + (row0 + r - 3) * PW + col);
            else if (c > 0) val = *(const v4u*)(halo + ((size_t)(gch - 1) * 3 + r) * PW + col); }
        R.P[j] = val; }
    R.ga = AB[(row0 + lane) * 16 + h]; R.gb = AB[(row0 + lane) * 16 + 8 + h];
    const float* convw = F.in[I_DNCONV]; const int c4 = lane & 31;
#pragma unroll
    for (int seg = 0; seg < 3; ++seg)
#pragma unroll
        for (int j = 0; j < 4; ++j) R.cw[seg][j] = *(const f32x4*)(convw + j * 3072 + seg * 1024 + h * HD + 4 * c4);
}
__device__ __forceinline__ void dn_prep_unit(const Frame& F, int u, int u_next, DnPre& R) {
    const Tix T = tix(F.wv); const int tid = T.tid, lane = T.lane, wave = T.wave, m = lane & 15, g = lane >> 4;
    const int bh = u >> 5, c = u & 31, b = bh >> 3, h = bh & 7; const size_t row0 = (size_t)b * SEQ + c * 64;
    bf16* proj = (bf16*)(F.ws + WS_PROJ);
    bf16* xbimg = (bf16*)((unsigned char*)F.out + DO_WNEG) + (size_t)u * 8192; bf16* qks = (bf16*)((unsigned char*)F.out + DO_QKS) + (size_t)u * 4096; float* egl = (float*)((unsigned char*)F.out + DO_EGL);
    LAS unsigned char* L = F.lds; LAS float* GB = (LAS float*)(L + P_GB);
#pragma unroll
    for (int j = 0; j < 7; ++j) { const int id = tid + 512 * j;
        if (id < 67 * 48) { const int r = id / 48, rem = id - r * 48, seg = rem >> 4, ch = rem & 15; *(LAS v4u*)(L + P_RAW + r * 768 + seg * 256 + ch * 16) = R.P[j]; } }
    if (wave == 0) { const float a = R.ga, bb = R.gb;
        const float x = a + F.in[I_DNDT][h], sp = fmaxf(x, 0.f) + log1pf(__expf(-fabsf(x)));
        const float gt = -__expf(F.in[I_DNALOG][h]) * sp, beta = __builtin_amdgcn_rcpf(1.f + __expf(-bb));
        float gc = gt;
#pragma unroll
        for (int o = 1; o < 64; o <<= 1) { const float t = __shfl_up(gc, o); if (lane >= o) gc += t; }
        const float gl = __shfl(gc, 63);
        GB[lane] = gc; GB[64 + lane] = beta; GB[128 + lane] = beta * __expf(gc); GB[192 + lane] = __expf(gl - gc); GB[256 + lane] = __expf(gc);
        if (lane == 0) egl[u] = __expf(gl); }
    f32x4 cw[3][4];
#pragma unroll
    for (int seg = 0; seg < 3; ++seg)
#pragma unroll
        for (int j = 0; j < 4; ++j) cw[seg][j] = R.cw[seg][j];
    __syncthreads();
    if (u_next >= 0) dn_prep_load(F, u_next, R);
    { const int hf = lane >> 5, c4 = lane & 31;
#pragma unroll
      for (int jj = 0; jj < 12; ++jj) { constexpr int dummy_ = 0; (void)dummy_; const int seg = jj >> 2;
        const int wi = wave + 8 * jj, i = 2 * (wi & 31) + hf;
        f32x4 y = {0.f, 0.f, 0.f, 0.f};
#pragma unroll
        for (int j = 0; j < 4; ++j) { const f32x4 w = cw[seg][j];
            const dn_u32x2 xx = *(const LAS dn_u32x2*)(L + P_RAW + (i + j) * 768 + seg * 256 + c4 * 8);
            y[0] += w[0] * bflo(xx.x); y[1] += w[1] * bfhi(xx.x); y[2] += w[2] * bflo(xx.y); y[3] += w[3] * bfhi(xx.y); }
        f32x4 s;
#pragma unroll
        for (int e = 0; e < 4; ++e) s[e] = y[e] * __builtin_amdgcn_rcpf(1.f + __expf(-y[e]));
        if (seg < 2) { float ss = (s[0] * s[0] + s[1] * s[1]) + (s[2] * s[2] + s[3] * s[3]);
            ss = add_xor16(row16_sum(ss));
            const float r = rsqrtf(ss + EPS) * (seg == 0 ? QSCALE : 1.f);
            s = s * r;
            *(LAS dn_u32x2*)(L + (seg == 0 ? P_QH : P_KH) + i * 272 + c4 * 8) = pack4f(s);
            if (seg == 0) { const int cc = c4 & 7, p0 = cc < 4 ? 8 * cc : 8 * (cc - 4) + 4;
                *(dn_u32x2*)(proj + (row0 + i) * PW + PC_Q + h * HD + 32 * (c4 >> 3) + p0) = pack4f(s * GB[256 + i]); }
            else { const float bge = GB[128 + i];
#pragma unroll
                for (int e = 0; e < 4; ++e) *(LAS unsigned short*)(L + P_KBGT + (4 * c4 + e) * 144 + i * 2) = bf1(s[e] * bge); } }
        else { const float be = GB[64 + i];
#pragma unroll
            for (int e = 0; e < 4; ++e) *(LAS unsigned short*)(L + P_VBT + (4 * c4 + e) * 144 + i * 2) = bf1(s[e] * be); } } }
    __syncthreads();
    LAS float* AT = (LAS float*)(L + P_AT);
#pragma unroll
    for (int q = 0; q < 2; ++q) { const int tt = wave + 8 * q, it = tt >> 2, jt = tt & 3;
        f32x4 kk = {0.f, 0.f, 0.f, 0.f}, qk = {0.f, 0.f, 0.f, 0.f};
        if (jt <= it) {
#pragma unroll
            for (int kq = 0; kq < 4; ++kq) { const dn_bf16x8 bk = *(const LAS dn_bf16x8*)(L + P_KH + (16 * jt + m) * 272 + (32 * kq + 8 * g) * 2);
                const dn_bf16x8 ak = *(const LAS dn_bf16x8*)(L + P_KH + (16 * it + m) * 272 + (32 * kq + 8 * g) * 2), aq = *(const LAS dn_bf16x8*)(L + P_QH + (16 * it + m) * 272 + (32 * kq + 8 * g) * 2);
                kk = mfma16(ak, bk, kk); qk = mfma16(aq, bk, qk); } }
        const int j = 16 * jt + m, jl = j & 31, p = jl < 16 ? 8 * (jl >> 2) + (jl & 3) : 8 * ((jl - 16) >> 2) + 4 + (jl & 3);
        const float gcj = GB[j];
#pragma unroll
        for (int r = 0; r < 4; ++r) { const int i = 16 * it + 4 * g + r; const float dec = i >= j ? __expf(GB[i] - gcj) : 0.f;
            AT[i * 68 + j] = i > j ? GB[64 + i] * kk[r] * dec : 0.f;
            *(LAS unsigned short*)(L + P_QKL + i * 144 + (32 * (j >> 5) + p) * 2) = bf1(qk[r] * dec); } }
    __syncthreads();
    if (wave >= 4) { const int t4 = tid - 256;
        for (int id = t4; id < 1024; id += 256) { const int k = id >> 3, sp = (id >> 2) & 1, gg = id & 3; float o8[8];
#pragma unroll
            for (int j = 0; j < 8; ++j) { const int cc = 32 * sp + (j < 4 ? 4 * gg + j : 16 + 4 * gg + j - 4);
                o8[j] = bflo((unsigned)*(const LAS unsigned short*)(L + P_KH + cc * 272 + k * 2)) * GB[192 + cc]; }
            v4u w; w.x = pkbf(o8[0], o8[1]); w.y = pkbf(o8[2], o8[3]); w.z = pkbf(o8[4], o8[5]); w.w = pkbf(o8[6], o8[7]);
            *(v4u*)(proj + (row0 + (k >> 1)) * PW + PC_K + h * HD + (k & 1) * 64 + 32 * sp + 8 * gg) = w; }
        for (int id = t4; id < 512; id += 256) { const int i = id >> 3, j8 = (id & 7) * 8;
            *(v4u*)(qks + i * 64 + j8) = *(const LAS v4u*)(L + P_QKL + i * 144 + j8 * 2); } }
    if (wave == 0) { const int bb = g, j = m; float X[16];
        X[0] = j == 0 ? 1.f : 0.f;
#pragma unroll
        for (int i = 1; i < 16; ++i) { const LAS float* Lr = AT + (16 * bb + i) * 68 + 16 * bb; float Lv[16];
#pragma unroll
            for (int q = 0; q < (i + 3) / 4; ++q) { const f32x4 t = *(const LAS f32x4*)(Lr + 4 * q); Lv[4 * q] = t[0]; Lv[4 * q + 1] = t[1]; Lv[4 * q + 2] = t[2]; Lv[4 * q + 3] = t[3]; }
            float acc = i == j ? 1.f : 0.f;
#pragma unroll
            for (int mm = 0; mm < i; ++mm) acc -= Lv[mm] * X[mm];
            X[i] = acc; }
#pragma unroll
        for (int i = 0; i < 16; ++i) AT[(16 * bb + i) * 68 + 16 * bb + j] = X[i]; }
    __syncthreads();
    if (wave < 2) { const int lo = 2 * wave, hi = 2 * wave + 1; LAS float* PS = (LAS float*)(L + P_PS) + wave * 320;
        f32x4 acc = {0.f, 0.f, 0.f, 0.f};
#pragma unroll
        for (int s = 0; s < 4; ++s) acc = mfma4(AT[(16 * hi + m) * 68 + 16 * lo + 4 * s + g], AT[(16 * lo + 4 * s + g) * 68 + 16 * lo + m], acc);
#pragma unroll
        for (int r = 0; r < 4; ++r) PS[(4 * g + r) * 20 + m] = acc[r];
        LDS_WAIT();
        f32x4 acc2 = {0.f, 0.f, 0.f, 0.f};
#pragma unroll
        for (int s = 0; s < 4; ++s) acc2 = mfma4(AT[(16 * hi + m) * 68 + 16 * hi + 4 * s + g], PS[(4 * s + g) * 20 + m], acc2);
#pragma unroll
        for (int r = 0; r < 4; ++r) AT[(16 * hi + 4 * g + r) * 68 + 16 * lo + m] = -acc2[r]; }
    __syncthreads();
    { LAS float* PS2 = (LAS float*)(L + P_PS2); const int ti = (wave >> 1) & 1, tj = wave & 1;
      if (wave < 4) { f32x4 acc = {0.f, 0.f, 0.f, 0.f};
#pragma unroll
          for (int s = 0; s < 8; ++s) acc = mfma4(AT[(32 + 16 * ti + m) * 68 + 4 * s + g], AT[(4 * s + g) * 68 + 16 * tj + m], acc);
#pragma unroll
          for (int r = 0; r < 4; ++r) PS2[(16 * ti + 4 * g + r) * 36 + 16 * tj + m] = acc[r]; }
      __syncthreads();
      if (wave < 4) { f32x4 acc = {0.f, 0.f, 0.f, 0.f};
#pragma unroll
          for (int s = 0; s < 8; ++s) acc = mfma4(AT[(32 + 16 * ti + m) * 68 + 32 + 4 * s + g], PS2[(4 * s + g) * 36 + 16 * tj + m], acc);
#pragma unroll
          for (int r = 0; r < 4; ++r) AT[(32 + 16 * ti + 4 * g + r) * 68 + 16 * tj + m] = -acc[r]; } }
    __syncthreads();
    { const int i = tid >> 3, j0 = (tid & 7) * 8; const f32x4 t0 = *(const LAS f32x4*)(AT + i * 68 + j0), t1 = *(const LAS f32x4*)(AT + i * 68 + j0 + 4);
      v4u w; w.x = pkbf(t0[0], t0[1]); w.y = pkbf(t0[2], t0[3]); w.z = pkbf(t1[0], t1[1]); w.w = pkbf(t1[2], t1[3]);
      *(LAS v4u*)(L + P_TB + i * 144 + j0 * 2) = w; }
    __syncthreads();
#pragma unroll
    for (int q = 0; q < 8; ++q) { const int tt = wave + 8 * q; f32x4 acc = {0.f, 0.f, 0.f, 0.f};
        if (tt < 32) { const int ct = tt >> 3, nt = tt & 7;
#pragma unroll
            for (int sp = 0; sp < 2; ++sp) acc = mfma16(*(const LAS dn_bf16x8*)(L + P_TB + (16 * ct + m) * 144 + (32 * sp + 8 * g) * 2), *(const LAS dn_bf16x8*)(L + P_VBT + (16 * nt + m) * 144 + (32 * sp + 8 * g) * 2), acc);
            const int v = 16 * nt + m;
            *(dn_u32x2*)(proj + (row0 + (v >> 1)) * PW + PC_V + h * HD + (v & 1) * 64 + 16 * ct + 4 * g) = pack4f(acc); }
        else { const int t2 = tt - 32, kt = t2 >> 2, ct = t2 & 3;
#pragma unroll
            for (int sp = 0; sp < 2; ++sp) acc = mfma16(*(const LAS dn_bf16x8*)(L + P_KBGT + (16 * kt + m) * 144 + (32 * sp + 8 * g) * 2), *(const LAS dn_bf16x8*)(L + P_TB + (16 * ct + m) * 144 + (32 * sp + 8 * g) * 2), acc);
            *(dn_u32x2*)(xbimg + (16 * ct + m) * 128 + 32 * (kt >> 1) + 8 * g + 4 * (kt & 1)) = pack4f(-acc); } }
    __syncthreads();
}
constexpr int S_WN = 0, S_QG = 17408, S_KDT = 34816, S_QKM = 53248, S_UT = 62464, S_OB = 80896, S_PSQ = 114688, S_ONW = 116736, S_Z = 117248, S_END = 152064;
static_assert(S_END <= MISC_OFF, "scan LDS map");
__device__ __forceinline__ void dn_scan_unit(const Frame& F, int bh) {
    const Tix T = tix(F.wv); const int tid = T.tid, lane = T.lane, wave = T.wave, m = lane & 15, g = lane >> 4, n0 = 32 * wave;
    const int b = bh >> 3, h = bh & 7;
    bf16* proj = (bf16*)(F.ws + WS_PROJ); const bf16* xbi = (const bf16*)((const unsigned char*)F.out + DO_WNEG); const bf16* qks = (const bf16*)((unsigned char*)F.out + DO_QKS); const float* egl = (const float*)((unsigned char*)F.out + DO_EGL);
    LAS unsigned char* L = F.lds;
    LAS float* OB = (LAS float*)(L + S_OB);
    constexpr int NC = SEQ / 64;
#define WGBAR() do { asm volatile("s_waitcnt lgkmcnt(0)" ::: "memory"); __builtin_amdgcn_s_barrier(); asm volatile("" ::: "memory"); } while (0)
    if (wave >= 4) {
        const int ht = tid - 256;
        const unsigned lo_lin = (unsigned)ht * 16u;
        const unsigned lo_qg = (unsigned)(((ht >> 4) * PW + (ht & 15) * 8) * 2);
        const unsigned lo_kv = (unsigned)(((ht >> 4) * PW + ((ht >> 3) & 1) * 64 + (ht & 7) * 8) * 2);
        const unsigned ld_a = (unsigned)((ht >> 4) * 272 + (ht & 15) * 16), ld_b = (unsigned)((ht >> 3) * 144 + (ht & 7) * 16);
        const unsigned lo_fin = (unsigned)(((ht >> 2) * PW + (ht & 3) * 32) * 2);
        v4u RP[12], RQ[10];
#define DN_LOAD_P(cc) do { const size_t r0_ = (size_t)b * SEQ + (cc) * 64; const size_t u_ = (size_t)bh * 32 + (cc);               \
        _Pragma("unroll") for (int j_ = 0; j_ < 4; ++j_) {                                                                                                \
            RP[j_] = *(const v4u*)((const char*)(xbi + u_ * 8192 + 2048 * j_) + lo_lin);                                                                    \
            RP[4 + j_] = *(const v4u*)((const char*)(proj + (r0_ + 16 * j_) * PW + PC_Q + h * HD) + lo_qg);                                                 \
            RP[8 + j_] = *(const v4u*)((const char*)(proj + (r0_ + 16 * j_) * PW + PC_V + h * HD) + lo_kv); } } while (0)
#define DN_LOAD_Q(cc) do { const size_t r0_ = (size_t)b * SEQ + (cc) * 64; const size_t u_ = (size_t)bh * 32 + (cc);     \
        _Pragma("unroll") for (int j_ = 0; j_ < 4; ++j_) {                                                                                                \
            RQ[j_] = *(const v4u*)((const char*)(proj + (r0_ + 16 * j_) * PW + PC_K + h * HD) + lo_kv);                                                     \
            RQ[4 + j_] = *(const v4u*)((const char*)(proj + (r0_ + 16 * j_) * PW + PC_Z + h * HD) + lo_qg); }                                               \
        _Pragma("unroll") for (int j_ = 0; j_ < 2; ++j_) RQ[8 + j_] = *(const v4u*)((const char*)(qks + u_ * 4096 + 2048 * j_) + lo_lin); } while (0)
#define DN_WRITE_P() do { _Pragma("unroll") for (int j_ = 0; j_ < 4; ++j_) {                                                                               \
            *(LAS v4u*)(L + S_WN + ld_a + j_ * 4352) = RP[j_]; *(LAS v4u*)(L + S_QG + ld_a + j_ * 4352) = RP[4 + j_]; *(LAS v4u*)(L + S_UT + ld_b + j_ * 4608) = RP[8 + j_]; } } while (0)
#define DN_WRITE_Q(cc) do { _Pragma("unroll") for (int j_ = 0; j_ < 4; ++j_) { *(LAS v4u*)(L + S_KDT + ld_b + j_ * 4608) = RQ[j_];                         \
            *(LAS v4u*)(L + S_Z + ((cc) & 1) * 17408 + ld_a + j_ * 4352) = RQ[4 + j_]; }                                                                    \
        _Pragma("unroll") for (int j_ = 0; j_ < 2; ++j_) *(LAS v4u*)(L + S_QKM + ld_b + j_ * 4608) = RQ[8 + j_]; } while (0)
#define DN_FINAL(cc) do { const int fr_ = ht >> 2, fc_ = (ht & 3) * 32; float ss_ = 0.f;     \
        _Pragma("unroll") for (int p_ = 0; p_ < 8; ++p_) { const f32x4 o_ = *(const LAS f32x4*)(OB + fr_ * 132 + fc_ + 4 * p_);                              \
            ss_ += (o_[0] * o_[0] + o_[1] * o_[1]) + (o_[2] * o_[2] + o_[3] * o_[3]); }                                                                     \
        ss_ += dppf<0xB1>(ss_); ss_ += dppf<0x4E>(ss_);                                                                                                     \
        const float rn_ = rsqrtf(ss_ * (1.f / 128.f) + EPS);                                                                                               \
        bf16* dst_ = (bf16*)((char*)(proj + ((size_t)b * SEQ + (cc) * 64) * PW + PC_Q + h * HD) + lo_fin);              \
        _Pragma("unroll") for (int p_ = 0; p_ < 4; ++p_) {                                                                                                 \
            const f32x4 oa_ = *(const LAS f32x4*)(OB + fr_ * 132 + fc_ + 8 * p_), ob_ = *(const LAS f32x4*)(OB + fr_ * 132 + fc_ + 8 * p_ + 4);             \
            const v4u z_ = *(const LAS v4u*)(L + S_Z + ((cc) & 1) * 17408 + fr_ * 272 + (fc_ + 8 * p_) * 2);                                                \
            v4u w_; w_.x = pkbf(oa_[0] * rn_ * bflo(z_.x), oa_[1] * rn_ * bfhi(z_.x)); w_.y = pkbf(oa_[2] * rn_ * bflo(z_.y), oa_[3] * rn_ * bfhi(z_.y));   \
            w_.z = pkbf(ob_[0] * rn_ * bflo(z_.z), ob_[1] * rn_ * bfhi(z_.z)); w_.w = pkbf(ob_[2] * rn_ * bflo(z_.w), ob_[3] * rn_ * bfhi(z_.w));           \
            *(v4u*)(dst_ + 8 * p_) = w_; } } while (0)
        DN_LOAD_P(0); DN_LOAD_Q(0); DN_WRITE_P(); DN_WRITE_Q(0); DN_LOAD_P(1); DN_LOAD_Q(1);
        WGBAR();
        for (int c = 0; c < NC; ++c) {
            if (c > 0) { DN_FINAL(c - 1); DN_WRITE_Q(c); if (c + 1 < NC) DN_LOAD_Q(c + 1); }
            WGBAR();
            if (c + 1 < NC) { DN_WRITE_P(); if (c + 2 < NC) DN_LOAD_P(c + 2); }
            WGBAR();
        }
        DN_FINAL(NC - 1);
#undef DN_LOAD_P
#undef DN_LOAD_Q
#undef DN_WRITE_P
#undef DN_WRITE_Q
#undef DN_FINAL
    } else {
        f32x4 Sacc[2][8];
#pragma unroll
        for (int kt = 0; kt < 8; ++kt) { Sacc[0][kt] = (f32x4){0.f, 0.f, 0.f, 0.f}; Sacc[1][kt] = (f32x4){0.f, 0.f, 0.f, 0.f}; }
        const unsigned* eglu = (const unsigned*)egl + (size_t)bh * 32;
        float eg_next = __uint_as_float(__hip_atomic_load(eglu, __ATOMIC_RELAXED, __HIP_MEMORY_SCOPE_AGENT));
        const LAS unsigned char* fa = L + m * 272 + g * 16;
        const LAS unsigned char* fb = L + m * 144 + g * 16;
#define SBAR() __builtin_amdgcn_sched_barrier(0)
#define LD_A(X, base, ct) do { _Pragma("unroll") for (int s_ = 0; s_ < 4; ++s_) X[s_] = *(const LAS dn_bf16x8*)(fa + (base) + (ct) * 4352 + s_ * 64); } while (0)
#define LD_B(X, base, i0) do { _Pragma("unroll") for (int s_ = 0; s_ < 4; ++s_) X[s_] = *(const LAS dn_bf16x8*)(fb + (base) + ((i0) + (s_ >> 1)) * 2304 + (s_ & 1) * 64); } while (0)
        WGBAR();
        for (int c = 0; c < NC; ++c) {
            const float eg = eg_next;
            if (c + 1 < NC) eg_next = __uint_as_float(__hip_atomic_load(eglu + c + 1, __ATOMIC_RELAXED, __HIP_MEMORY_SCOPE_AGENT));
            dn_bf16x8 SB[2][4], X0[4], X1[4];
            LD_A(X0, S_WN, 0);
#pragma unroll
            for (int sl = 0; sl < 2; ++sl)
#pragma unroll
                for (int s = 0; s < 4; ++s) SB[sl][s] = pack8f(Sacc[sl][2 * s], Sacc[sl][2 * s + 1]);
            f32x4 VN[2][4], O[2][4];
#pragma unroll
            for (int ct = 0; ct < 4; ++ct)
#pragma unroll
                for (int sl = 0; sl < 2; ++sl) { const dn_u32x2 uu = *(const LAS dn_u32x2*)(L + S_UT + (n0 + 16 * sl + m) * 144 + (16 * ct + 4 * g) * 2);
                    VN[sl][ct] = (f32x4){bflo(uu.x), bfhi(uu.x), bflo(uu.y), bfhi(uu.y)}; O[sl][ct] = (f32x4){0.f, 0.f, 0.f, 0.f}; }
#pragma unroll
            for (int ct = 0; ct < 4; ++ct) {
                SBAR(); LD_A(X1, S_QG, ct); SBAR();
#pragma unroll
                for (int s = 0; s < 4; ++s) { VN[0][ct] = mfma16(X0[s], SB[0][s], VN[0][ct]); VN[1][ct] = mfma16(X0[s], SB[1][s], VN[1][ct]); }
                SBAR(); if (ct < 3) LD_A(X0, S_WN, ct + 1); SBAR();
#pragma unroll
                for (int s = 0; s < 4; ++s) { O[0][ct] = mfma16(X1[s], SB[0][s], O[0][ct]); O[1][ct] = mfma16(X1[s], SB[1][s], O[1][ct]); }
            }
            dn_bf16x8 VNB[2][2];
#pragma unroll
            for (int sl = 0; sl < 2; ++sl)
#pragma unroll
                for (int sp = 0; sp < 2; ++sp) VNB[sl][sp] = pack8f(VN[sl][2 * sp], VN[sl][2 * sp + 1]);
            WGBAR();
            SBAR(); LD_B(X0, S_QKM, 0); LD_B(X1, S_QKM, 2); SBAR();
#pragma unroll
            for (int s = 0; s < 4; ++s) { O[0][s >> 1] = mfma16(X0[s], VNB[0][s & 1], O[0][s >> 1]); O[1][s >> 1] = mfma16(X0[s], VNB[1][s & 1], O[1][s >> 1]); }
            SBAR(); LD_B(X0, S_KDT, 0); SBAR();
#pragma unroll
            for (int s = 0; s < 4; ++s) { O[0][2 + (s >> 1)] = mfma16(X1[s], VNB[0][s & 1], O[0][2 + (s >> 1)]); O[1][2 + (s >> 1)] = mfma16(X1[s], VNB[1][s & 1], O[1][2 + (s >> 1)]); }
#pragma unroll
            for (int kt = 0; kt < 8; ++kt) { Sacc[0][kt] = Sacc[0][kt] * eg; Sacc[1][kt] = Sacc[1][kt] * eg; }
#pragma unroll
            for (int q = 0; q < 4; ++q) {
                if (q & 1) { SBAR(); if (q < 3) LD_B(X0, S_KDT, 2 * q + 2); SBAR();
#pragma unroll
                    for (int s = 0; s < 4; ++s) { Sacc[0][2 * q + (s >> 1)] = mfma16(X1[s], VNB[0][s & 1], Sacc[0][2 * q + (s >> 1)]); Sacc[1][2 * q + (s >> 1)] = mfma16(X1[s], VNB[1][s & 1], Sacc[1][2 * q + (s >> 1)]); } }
                else { SBAR(); LD_B(X1, S_KDT, 2 * q + 2); SBAR();
#pragma unroll
                    for (int s = 0; s < 4; ++s) { Sacc[0][2 * q + (s >> 1)] = mfma16(X0[s], VNB[0][s & 1], Sacc[0][2 * q + (s >> 1)]); Sacc[1][2 * q + (s >> 1)] = mfma16(X0[s], VNB[1][s & 1], Sacc[1][2 * q + (s >> 1)]); } }
            }
#pragma unroll
            for (int sl = 0; sl < 2; ++sl)
#pragma unroll
                for (int ct = 0; ct < 4; ++ct)
#pragma unroll
                    for (int r = 0; r < 4; ++r) OB[(16 * ct + 4 * g + r) * 132 + n0 + 16 * sl + m] = O[sl][ct][r];
            WGBAR();
        }
#undef SBAR
#undef LD_A
#undef LD_B
    }
#undef WGBAR
}
__device__ __forceinline__ void fox_blk(const Frame& F, int it, int j, att::Blk& k) {
    const int bh = it >> 2, y = it & 3, qb = j == 0 ? y : 7 - y, b = bh >> 3, h = bh & 7; const size_t row0 = (size_t)b * SEQ + qb * 256;
    bf16* proj = (bf16*)(F.ws + WS_PROJ);
    k.Q = proj + row0 * PW + PC_Q + h * HD; k.K = proj + (size_t)b * SEQ * PW + PC_K + h * HD; k.voff = PC_V - PC_K; k.goff = PC_Z - PC_Q;
    k.flog = (const float*)(F.ws + WS_AB) + (size_t)b * SEQ * 16 + h; k.fb = F.in[I_FOXFB][h]; k.P0 = qb * 256; k.skv = SEQ; k.kvpitch = PW;
}
__device__ __forceinline__ void mem_blk(const Frame& F, int idx, att::Blk& k) {
    const int b = idx >> 5, hm = (idx >> 3) & 3, qb = idx & 7; const size_t row0 = (size_t)b * SEQ + qb * 256;
    bf16* proj = (bf16*)(F.ws + WS_PROJ); const bf16* mkv = (const bf16*)(F.ws + WS_MEMKV);
    static_assert(att::QP == PW, "attention Q pitch");
    k.Q = proj + row0 * PW + PC_QM + hm * HD; k.K = mkv + (size_t)b * NMEM * DM + hm * HD; k.voff = 512; k.goff = 0;
    k.flog = nullptr; k.fb = 0.f; k.P0 = 1 << 20; k.skv = NMEM; k.kvpitch = DM;
}
struct SrcL1 { const Frame* F; int vcu;
    __device__ __forceinline__ bool operator()(int n, att::Blk& k) const { const int it = vcu + (n / 3) * F->G, j = n % 3; if (it >= 256) return false;
        if (j < 2) fox_blk(*F, it, j, k); else mem_blk(*F, it, k); return true; } };
struct SrcL0 { const Frame* F; int first, stride;
    __device__ __forceinline__ bool operator()(int n, att::Blk& k) const { const int idx = first + n * stride; if (idx >= 256) return false; mem_blk(*F, idx, k); return true; } };
__device__ __forceinline__ void narrow_ab_unit(const Frame& F, int pm) {
    const Tix T = tix(F.wv); const int lane = T.lane, wave = T.wave, m = lane & 15, g = lane >> 4;
    const bf16* A = (const bf16*)(F.ws + WS_XB) + (size_t)(pm * 256 + 32 * wave + m) * DM + 8 * g; const bf16* B = (const bf16*)(F.ws + WS_WIN0) + (size_t)(PC_AB + m) * DM + 8 * g;
    f32x4 acc0 = {0.f, 0.f, 0.f, 0.f}, acc1 = acc0;
#pragma unroll 8
    for (int s = 0; s < DM / 32; ++s) { const dn_bf16x8 b = *(const dn_bf16x8*)(B + 32 * s);
        acc0 = mfma16(*(const dn_bf16x8*)(A + 32 * s), b, acc0); acc1 = mfma16(*(const dn_bf16x8*)(A + (size_t)16 * DM + 32 * s), b, acc1); }
    const float* xsq = (const float*)(F.ws + WS_XSQ); float* ab = (float*)(F.ws + WS_AB);
#pragma unroll
    for (int rt = 0; rt < 2; ++rt)
#pragma unroll
        for (int r = 0; r < 4; ++r) { const size_t row = (size_t)pm * 256 + 32 * wave + 16 * rt + 4 * g + r; const float* q = xsq + row * 16;
            const f32x4 t = (*(const f32x4*)q + *(const f32x4*)(q + 4)) + (*(const f32x4*)(q + 8) + *(const f32x4*)(q + 12));
            ab[row * 16 + m] = (rt ? acc1[r] : acc0[r]) * rsqrtf(((t[0] + t[1]) + (t[2] + t[3])) * (1.0f / 1024.0f) + EPS); }
}
constexpr int CW_SHD = 196608;
__device__ __forceinline__ void shadow_barrier(const Frame& F, unsigned want) {
    asm volatile("s_waitcnt vmcnt(0)" ::: "memory");
    __syncthreads();
    if (F.wv == 0 && lane_id() == 0) { unsigned* p = (unsigned*)((gu32*)(F.ws + WS_CTL) + CW_SHD);
        __builtin_amdgcn_fence(__ATOMIC_RELEASE, "agent"); asm volatile("s_waitcnt vmcnt(0)" ::: "memory");
        (void)__hip_atomic_fetch_add(p, 1u, __ATOMIC_RELAXED, __HIP_MEMORY_SCOPE_AGENT);
        unsigned sp = 0;
        while (__hip_atomic_load(p, __ATOMIC_RELAXED, __HIP_MEMORY_SCOPE_AGENT) < want) { __builtin_amdgcn_s_sleep(2); if (++sp > (1u << 22)) { atomicAdd((unsigned*)((gu32*)(F.ws + WS_CTL) + CW_BAR) + XB_TMO, 1u); break; } }
        __builtin_amdgcn_fence(__ATOMIC_ACQUIRE, "agent"); asm volatile("s_waitcnt vmcnt(0)" ::: "memory"); }
    __syncthreads();
}
#define IN(k) (lo <= (k) && (k) < hi)
#define SEAM(k) do { if (IN(k) && IN((k) + 1)) xcd_barrier(bar); } while (0)
#define SEAMG(k, s_) do { if (IN(k) && IN((k) + 1)) { if (gb.on) grp_barrier(gb, (s_)); else xcd_barrier(bar); } } while (0)
template <int layer> __device__ __forceinline__ void layer_body(const Frame& F, const XcdBarrier& bar, GrpBar& gb, bool grp_try, int lo, int hi, unsigned char* lds) {
    bf16* proj = (bf16*)(F.ws + WS_PROJ); bf16* xb = (bf16*)(F.ws + WS_XB); float* xsq = (float*)(F.ws + WS_XSQ);
    float* ab = (float*)(F.ws + WS_AB);

        const int pb = 1 + (layer ? 6 : 0);
        if (IN(pb)) {
            pg8::Gemm g{xb, (const bf16*)(F.ws + (layer ? WS_WIN1 : WS_WIN0)), MROWS, layer ? N_IN : 4096, DM, DM}; pg8::StaticOrder S; S.init(MROWS, layer ? N_IN : 4096, F.G, F.bid);
            const float* nk = layer ? F.in[I_FOXKNW] : nullptr; const float* nq = layer ? F.in[I_FOXQNW] : nullptr;
            pg8::EpiProj<true, false, layer == 0> E{proj, PW, xsq, ab, 18, (bf16*)((unsigned char*)F.out + DO_HALO), 0, layer ? 4 : 0, nk, 12, layer ? 16 : 12, nq, 16, 18, F.in[I_MEMQNW] + layer * HD, 8, 12, layer ? 2 : 1, F.in[I_DNONW]};
            pg8::gemm_phase<pg8::EpiProj<true, false, layer == 0>, pg8::StaticOrder, true, true>(F.lds, g, S, E, F.wv);
            if (layer == 0 && F.bid < 64) { __syncthreads(); narrow_ab_unit(F, 8 * (F.bid & 7) + ((F.bid >> 3) & 7)); }
        }
        SEAM(pb);
        if (layer == 0 && grp_try) gb.on = __hip_atomic_load((unsigned*)((gu32*)(F.ws + WS_CTL) + CW_BAD), __ATOMIC_RELAXED, __HIP_MEMORY_SCOPE_AGENT) == 0u;
        const int pm = pb + (layer ? 1 : 2);
        if (layer == 0) {
            if (IN(pb + 1)) { constexpr int NU = BATCH * NH * (SEQ / 64); DnPre R; int u = F.bid; if (u < NU) dn_prep_load(F, u, R);
                              for (; u < NU; u += F.G) dn_prep_unit(F, u, u + F.G < NU ? u + F.G : -1, R); }
            SEAM(pb + 1);
        }
        if (IN(pm)) {
            if (layer == 0) {
                if (F.bid < 64) dn_scan_unit(F, F.bid);
                else {
                    { const pg8::StrideUnits Sq{F.bid - 64, F.G - 64, 128, 1};
                      pg8::Gemm g{xb, (const bf16*)(F.ws + WS_WIN0), MROWS, N_IN, DM, DM};
                      pg8::EpiProj<true, false> E{proj, PW, xsq, nullptr, 18, nullptr, 0, 0, nullptr, 0, 0, nullptr, 16, 18, F.in[I_MEMQNW], 0, 0, 0, nullptr};
                      pg8::gemm_phase<pg8::EpiProj<true, false>, pg8::StrideUnits, true, true>(F.lds, g, Sq, E, F.wv);
                      const pg8::StrideUnits Sm{F.G - 1 - F.bid, F.G - 64, 32, 0};
                      pg8::Gemm g2{(const bf16*)((unsigned char*)F.out + DO_MEMB), (const bf16*)(F.ws + WS_WMKV), MMEM, DM, DM, DM};
                      pg8::EpiProj<true, false> E2{(bf16*)(F.ws + WS_MEMKV), DM, (const float*)(F.ws + WS_MSQ), nullptr, 4, nullptr, 0, 2, F.in[I_MEMKNW], 0, 0, nullptr, 0, 0, nullptr, 0, 0, 0, nullptr};
                      pg8::gemm_phase<pg8::EpiProj<true, false>, pg8::StrideUnits, true, true>(F.lds, g2, Sm, E2, F.wv); }
                    shadow_barrier(F, (unsigned)(F.G - 64));
                    const SrcL0 src{&F, F.bid - 64, F.G - 64}; att::phase((char*)lds, src, F.wv);
                    __syncthreads();
                    const Tix T = tix(F.wv); convert_weights<6, 18>(F, (LAS float*)(F.lds + T.wave * 17408), T.lane, (F.bid - 64) * NWAVES + T.wave, (F.G - 64) * NWAVES, 0); }
            } else {
                const int vcu = (F.G % 8 == 0) ? (F.bid % 8) * (F.G / 8) + F.bid / 8 : F.bid;
                const SrcL1 src{&F, vcu}; att::phase((char*)lds, src, F.wv);
            }
            __syncthreads();
        }
        SEAM(pm);
        if (IN(pm + 1)) {
            pg8::Gemm g{proj + PC_Q, (const bf16*)(F.ws + (layer ? WS_WOUT1 : WS_WOUT0)), MROWS, DM, OUT_IN, PW}; pg8::StaticOrder S; S.init(MROWS, DM, F.G, F.bid);
            pg8::EpiRes<false> E{xb, F.out, xsq, nullptr};
            pg8::gemm_phase<pg8::EpiRes<false>, pg8::StaticOrder, true, true>(F.lds, g, S, E, F.wv);
        }
        SEAMG(pm + 1, layer * 3 + 0);
        if (IN(pm + 2)) {
            pg8::Gemm g{xb, (const bf16*)(F.ws + (layer ? WS_WM1_1 : WS_WM1_0)), MROWS, FF, DM, DM}; pg8::StaticOrder S; S.init(MROWS, FF, F.G, F.bid);
            pg8::EpiProj<false, true> E{proj, FF, xsq, nullptr, 16, nullptr, 0, 0, nullptr, 0, 0, nullptr, 0, 0, nullptr, 0, 0, 0, nullptr};
            pg8::gemm_phase<pg8::EpiProj<false, true>, pg8::StaticOrder, true, true>(F.lds, g, S, E, F.wv);
        }
        SEAMG(pm + 2, layer * 3 + 1);
        if (IN(pm + 3)) {
            pg8::Gemm g{proj, (const bf16*)(F.ws + (layer ? WS_WM2_1 : WS_WM2_0)), MROWS, DM, FF, FF}; pg8::StaticOrder S; S.init(MROWS, DM, F.G, F.bid);
            pg8::EpiRes<layer == 1> E{xb, F.out, xsq, nullptr};
            pg8::gemm_phase<pg8::EpiRes<layer == 1>, pg8::StaticOrder, true, true>(F.lds, g, S, E, F.wv);
        }
        if (layer == 0) SEAMG(pm + 3, 2); else SEAM(pm + 3);
    }
#undef IN
#undef SEAM
#undef SEAMG
__global__ void __launch_bounds__(NWAVES * 64, 2) hyb_fwd(Args args) {
    extern __shared__ __attribute__((aligned(16))) unsigned char lds[];
    Frame F;
    F.lds = (LAS unsigned char*)lds;
    F.G = gridDim.x; F.bid = blockIdx.x; F.in = args.in; F.out = args.out; F.ws = args.ws; F.wv = __builtin_amdgcn_readfirstlane((int)threadIdx.x >> 6);
    volatile LAS unsigned* MISC = (volatile LAS unsigned*)(F.lds + MISC_OFF);
    gu32* ctl = (gu32*)(args.ws + WS_CTL);
    for (int u = threadIdx.x; u < (LDS_BYTES - MISC_OFF) / 4; u += NWAVES * 64) ((LAS unsigned*)(F.lds + MISC_OFF))[u] = 0u;
    __syncthreads();
    XcdBarrier bar; bar.bar = (unsigned*)(ctl + CW_BAR) + args.li * XCD_BAR_WORDS; bar.x = 0; bar.st = nullptr; bar.wv = F.wv;
    if (!MK_LAUNCH_PER_PHASE) { bar = xcd_barrier_post((unsigned*)(ctl + CW_BAR) + args.li * XCD_BAR_WORDS, MISC + 8); bar.wv = F.wv; }
    const int lo = args.ph_lo, hi = args.ph_hi;
#define IN(k) (lo <= (k) && (k) < hi)
#define SEAM(k) do { if (IN(k) && IN((k) + 1)) xcd_barrier(bar); } while (0)
    bf16* proj = (bf16*)(F.ws + WS_PROJ); bf16* xb = (bf16*)(F.ws + WS_XB); float* xsq = (float*)(F.ws + WS_XSQ);
    float* ab = (float*)(F.ws + WS_AB);

    GrpBar gb; gb.cnt = (unsigned*)(ctl + CW_GRP) + (size_t)(F.bid & 63) * 8 * 64; gb.tmo = (unsigned*)(ctl + CW_BAR) + XB_TMO; gb.wv = F.wv; gb.on = false;
    const bool grp_try = !MK_LAUNCH_PER_PHASE && F.G == 256 && lo == 0 && hi == N_PHASES;
    if (grp_try && F.wv == 0 && lane_id() == 0) __hip_atomic_store((unsigned*)(ctl + CW_XCC) + F.bid, xb_xcc_id() + 1u, __ATOMIC_RELAXED, __HIP_MEMORY_SCOPE_AGENT);
    if (IN(0)) { p0_prologue(F); } SEAM(0);
    if (grp_try && F.wv == 0 && lane_id() == 0) { const unsigned mine = xb_xcc_id() + 1u; bool same = true;
        for (int k = 1; k < 4; ++k) same = same && __hip_atomic_load((unsigned*)(ctl + CW_XCC) + ((F.bid + 64 * k) & 255), __ATOMIC_RELAXED, __HIP_MEMORY_SCOPE_AGENT) == mine;
        if (!same) atomicAdd((unsigned*)(ctl + CW_BAD), 1u); }

    layer_body<0>(F, bar, gb, grp_try, lo, hi, lds);
    layer_body<1>(F, bar, gb, grp_try, lo, hi, lds);
#undef IN
#undef SEAM
}

extern "C" void kernel_launch(void* const* d_in, const int* in_sizes, int n_in, void* d_out, int out_size, void* d_ws, size_t ws_size, hipStream_t stream) {
    static int grid = 0;
    if (grid == 0) {
        if (n_in != 20 || in_sizes[0] != MROWS * DM || out_size != MROWS * DM || ws_size < WS_END) {
            fprintf(stderr, "kernel_launch: shape/workspace mismatch (n_in %d, in0 %d, out %d, ws %zu; need ws >= %zu); nothing launched\n", n_in, n_in > 0 ? in_sizes[0] : -1, out_size, ws_size, (size_t)WS_END); grid = -1; return; }
        int dev = 0, cus = 0, per_cu = 0;
        if (hipGetDevice(&dev) != hipSuccess || hipDeviceGetAttribute(&cus, hipDeviceAttributeMultiprocessorCount, dev) != hipSuccess) { fprintf(stderr, "kernel_launch: device query failed\n"); grid = -1; return; }
        if (hipFuncSetAttribute((const void*)hyb_fwd, hipFuncAttributeMaxDynamicSharedMemorySize, LDS_BYTES) != hipSuccess) { fprintf(stderr, "kernel_launch: hipFuncSetAttribute failed\n"); grid = -1; return; }
        if (hipOccupancyMaxActiveBlocksPerMultiprocessor(&per_cu, (const void*)hyb_fwd, NWAVES * 64, LDS_BYTES) != hipSuccess || per_cu < 1) {
            fprintf(stderr, "kernel_launch: occupancy query reports %d workgroups per CU; nothing launched\n", per_cu); (void)hipGetLastError(); grid = -1; return; }
        if (cus < 128) { fprintf(stderr, "kernel_launch: %d CUs; this kernel's phase program needs at least 128 workgroups; nothing launched\n", cus); grid = -1; return; }
        grid = cus;
    }
    if (grid < 0) return;
    if (hipMemsetAsync((char*)d_ws + WS_CTL, 0, CTL_ZERO_BYTES, stream) != hipSuccess) { fprintf(stderr, "kernel_launch: memset failed\n"); return; }
    Args a{};
    for (int i = 0; i < 20; ++i) a.in[i] = (const float*)d_in[i];
    a.out = (float*)d_out; a.ws = (unsigned char*)d_ws;
#if MK_LAUNCH_PER_PHASE
    for (int p = 0; p < N_PHASES; ++p) { a.ph_lo = p; a.ph_hi = p + 1; a.li = 0; hipLaunchKernelGGL(hyb_fwd, dim3(grid), dim3(NWAVES * 64), LDS_BYTES, stream, a); }
#else
    a.ph_lo = 0; a.ph_hi = N_PHASES; a.li = 0;
    hipLaunchKernelGGL(hyb_fwd, dim3(grid), dim3(NWAVES * 64), LDS_BYTES, stream, a);
#endif
    const hipError_t le = hipPeekAtLastError();
    if (le != hipSuccess) fprintf(stderr, "kernel_launch: launch failed: %s\n", hipGetErrorName(le));
}
```

```cpp
#include <hip/hip_runtime.h>
#include <cstdio>
#include <cstdint>
#include <type_traits>

constexpr int BATCH = 8, SEQ = 2048, DM = 1024, MROWS = BATCH * SEQ;
constexpr int NMEM = 256, MMEM = BATCH * NMEM;
constexpr int HD = 128, NH = 8, NMH = 4, FF = 4096;
constexpr int PW = 4608;
constexpr int PC_K = 0, PC_V = 1024, PC_Z = 2048, PC_Q = 3072, PC_QM = 4096, PC_AB = 4608;
constexpr int N_IN = 4864;
constexpr int DN_IN = 4624, FOX_IN = 4616, OUT_IN = 1536;
constexpr float EPS = 1e-6f;
constexpr float QSCALE = 0.08838834764831845f;

__device__ __forceinline__ int lane_id_v() { int x; asm volatile("v_mbcnt_lo_u32_b32 %0, -1, 0\n\tv_mbcnt_hi_u32_b32 %0, -1, %0" : "=v"(x)); return x; }
template <int CTRL> __device__ __forceinline__ float dppf(float x) { return __builtin_bit_cast(float, __builtin_amdgcn_update_dpp(0, __builtin_bit_cast(int, x), CTRL, 0xf, 0xf, true)); }
__device__ __forceinline__ float row16_sum(float x) { x += dppf<0xB1>(x); x += dppf<0x4E>(x); x += dppf<0x141>(x); x += dppf<0x140>(x); return x; }
__device__ __forceinline__ float add_xor16(float x) { auto r = __builtin_amdgcn_permlane16_swap(__float_as_uint(x), __float_as_uint(x), false, false); return __uint_as_float(r[0]) + __uint_as_float(r[1]); }
__device__ __forceinline__ float add_xor32(float x) { auto r = __builtin_amdgcn_permlane32_swap(__float_as_uint(x), __float_as_uint(x), false, false); return __uint_as_float(r[0]) + __uint_as_float(r[1]); }
namespace pg8 {
#define PG8_LAS __attribute__((address_space(3)))
typedef unsigned short bf16_t;
typedef short bf16x8 __attribute__((ext_vector_type(8)));
typedef float f32x4 __attribute__((ext_vector_type(4)));
typedef unsigned u32x4 __attribute__((ext_vector_type(4)));
constexpr int BM = 256, BK = 64, HALF = 128, HTB = HALF * BK * 2  , STAGE_BYTES = 8 * HTB, NXCD = 8, WGM = 8;

__host__ __device__ __forceinline__ int lds_byte(int r, int c) { const int st = (r >> 4) * 2 + (c >> 5), rr = r & 15, cc = c & 31, ob = rr * 64 + cc * 2; return st * 1024 + (ob ^ (((ob >> 9) & 1) << 5)); }
__host__ __device__ __forceinline__ void stage_rc(int b, int& R, int& C) { const int st = b / 1024, sb = b % 1024, swz = sb ^ (((sb >> 9) & 1) << 5); R = (st >> 1) * 16 + swz / 64; C = (st & 1) * 32 + (swz % 64) / 2; }
__host__ __device__ __forceinline__ int perm32(int rho) { const int n = rho >> 4, i = rho & 15; return 8 * (i >> 2) + 4 * n + (i & 3); }

struct Unit { int pm, pn; };
struct Gemm { const bf16_t* A; const bf16_t* Bt; int M, N, K, lda; };

struct StaticOrder {
    int nM, nN, nwg, G, c;
    __host__ __device__ void init(int M, int N, int G_, int c_) { nM = M / BM; nN = N / BM; nwg = nM * nN; G = G_; c = c_; }
    __host__ __device__ bool next(int i, Unit& u) const {
        const long L = (long)i * G + c; if (L >= nwg) return false;
        int wgid = (int)L; { const int q = nwg / NXCD, r = nwg % NXCD, xcd = wgid % NXCD, off = wgid / NXCD; wgid = (xcd < r ? xcd * (q + 1) : r * (q + 1) + (xcd - r) * q) + off; }
        const int nig = WGM * nN, gid = wgid / nig, fm = gid * WGM, gsz = (nM - fm) < WGM ? (nM - fm) : WGM;
        u.pm = fm + ((wgid % nig) % gsz); u.pn = (wgid % nig) / gsz; return true;
    }
    __device__ __forceinline__ void a_ready(const Unit&) const {}
    __device__ __forceinline__ void done(const Unit&) const {}
};
struct StrideUnits {
    int start, stride, total, qm;
    __device__ __forceinline__ bool next(int i, Unit& u) const { const int t = start + i * stride; if (t >= total) return false; const int x = t & 7, j = t >> 3;
        if (qm) { u.pm = 8 * x + (j >> 1); u.pn = 16 + (j & 1); } else { u.pm = x; u.pn = j; } return true; }
    __device__ __forceinline__ void a_ready(const Unit&) const {}
    __device__ __forceinline__ void done(const Unit&) const {}
};

__device__ __forceinline__ unsigned cvt_pk_bf16(float lo, float hi) { unsigned r; asm volatile("v_cvt_pk_bf16_f32 %0, %1, %2" : "=v"(r) : "v"(lo), "v"(hi)); return r; }

constexpr int EPI_XCH = 131072, EPI_RS = 139264;
template <bool NORM, bool RELU2, bool HALO = false> struct EpiProj {
    static constexpr bool PERM = true, AFTER_DRAIN = false, USE_RS = true, ACC_INIT = false;
    bf16_t* O; int ldc; const float* xsq; float* ab; int n_main; bf16_t* halo;
    int nlo0, nhi0; const float* nw0; int nlo1, nhi1; const float* nw1; int nlo2, nhi2; const float* nw2;
    int zlo, zhi, zmode; const float* zw;
    __device__ __forceinline__ void rs_load(const Unit& u, int tid, f32x4 (&q)[4]) const { const float* p = xsq + (size_t)(u.pm * BM + tid) * 16;
#pragma unroll
        for (int i = 0; i < 4; ++i) q[i] = *(const f32x4*)(p + 4 * i); }
    __device__ __forceinline__ void rs_store(const f32x4 (&q)[4], PG8_LAS unsigned char* lds, int parity, int tid) const {
        const f32x4 t = (q[0] + q[1]) + (q[2] + q[3]);
        ((PG8_LAS float*)(lds + EPI_RS))[parity * 256 + tid] = rsqrtf(((t[0] + t[1]) + (t[2] + t[3])) * (1.0f / 1024.0f) + 1e-6f); }
    __device__ __forceinline__ void operator()(const f32x4 (&acc)[2][2][4][2], const Unit& u, int wr, int wc, int fr, int fq, PG8_LAS unsigned char* lds, int parity) const {
        const int rl0 = wr * 64 + fr, row0 = u.pm * BM + rl0, colt = u.pn * BM;
        const bool is_ab = u.pn >= n_main;
        const PG8_LAS float* RS = (const PG8_LAS float*)(lds + EPI_RS) + parity * 256;
        const float* nw = nullptr;
        if (NORM) { if (u.pn >= nlo0 && u.pn < nhi0) nw = nw0; else if (u.pn >= nlo1 && u.pn < nhi1) nw = nw1; else if (u.pn >= nlo2 && u.pn < nhi2) nw = nw2; }
        f32x4 w0 = {1.f, 1.f, 1.f, 1.f}, w1 = w0;
        const int zm = (NORM && u.pn >= zlo && u.pn < zhi) ? zmode : 0;
        if (zm == 1) { w0 = *(const f32x4*)(zw + wc * 32 + 8 * fq); w1 = *(const f32x4*)(zw + wc * 32 + 8 * fq + 4); }
        if (NORM && nw != nullptr) {
            w0 = *(const f32x4*)(nw + wc * 32 + 8 * fq); w1 = *(const f32x4*)(nw + wc * 32 + 8 * fq + 4);
            PG8_LAS float* X = (PG8_LAS float*)(lds + EPI_XCH);
#pragma unroll
            for (int ai = 0; ai < 2; ++ai)
#pragma unroll
                for (int m = 0; m < 4; ++m) { const int rl = rl0 + ai * HALF + m * 16; const float rstd = RS[rl];
#pragma unroll
                    for (int bj = 0; bj < 2; ++bj) { const f32x4 v0 = acc[ai][bj][m][0] * rstd, v1 = acc[ai][bj][m][1] * rstd;
                        float ss = ((v0[0] * v0[0] + v0[1] * v0[1]) + (v0[2] * v0[2] + v0[3] * v0[3])) + ((v1[0] * v1[0] + v1[1] * v1[1]) + (v1[2] * v1[2] + v1[3] * v1[3]));
                        ss = add_xor32(add_xor16(ss));
                        if (fq == 0) X[(bj * 256 + rl) * 4 + wc] = ss; } }
            asm volatile("s_waitcnt lgkmcnt(0)" ::: "memory"); __builtin_amdgcn_s_barrier(); asm volatile("" ::: "memory");
        }
#pragma unroll
        for (int ai = 0; ai < 2; ++ai)
#pragma unroll
            for (int m = 0; m < 4; ++m) {
                const int rl = rl0 + ai * HALF + m * 16, r = row0 + ai * HALF + m * 16;
                const float rstd = RS[rl];
                if (!is_ab) {
#pragma unroll
                    for (int bj = 0; bj < 2; ++bj) {
                        float sc = rstd;
                        if (NORM && nw != nullptr) { const f32x4 p4 = *(const PG8_LAS f32x4*)((const PG8_LAS float*)(lds + EPI_XCH) + (bj * 256 + rl) * 4);
                            sc = rstd * rsqrtf(((p4[0] + p4[1]) + (p4[2] + p4[3])) * (1.0f / 128.0f) + 1e-6f); }
                        f32x4 v0 = acc[ai][bj][m][0] * sc, v1 = acc[ai][bj][m][1] * sc;
                        if (zm != 0) {
#pragma unroll
                            for (int e = 0; e < 4; ++e) { const float s0 = __builtin_amdgcn_rcpf(1.f + __expf(-v0[e])), s1 = __builtin_amdgcn_rcpf(1.f + __expf(-v1[e]));
                                v0[e] = zm == 1 ? v0[e] * s0 : s0; v1[e] = zm == 1 ? v1[e] * s1 : s1; } }
                        v0 = v0 * w0; v1 = v1 * w1;
                        if (RELU2) {
#pragma unroll
                            for (int e = 0; e < 4; ++e) { const float a = fmaxf(v0[e], 0.f), b = fmaxf(v1[e], 0.f); v0[e] = a * a; v1[e] = b * b; }
                        }
                        u32x4 w; w.x = cvt_pk_bf16(v0[0], v0[1]); w.y = cvt_pk_bf16(v0[2], v0[3]); w.z = cvt_pk_bf16(v1[0], v1[1]); w.w = cvt_pk_bf16(v1[2], v1[3]);
                        *(u32x4*)(O + (size_t)r * ldc + colt + bj * HALF + wc * 32 + 8 * fq) = w;
                        if (HALO && m == 3 && fr >= 13) *(u32x4*)(halo + ((size_t)(r >> 6) * 3 + ((r & 63) - 61)) * ldc + colt + bj * HALF + wc * 32 + 8 * fq) = w;
                    }
                } else if (ab != nullptr && wc == 0 && fq < 2) {
                    float* p = ab + (size_t)r * 16 + 8 * fq;
                    *(f32x4*)p = acc[ai][0][m][0] * rstd; *(f32x4*)(p + 4) = acc[ai][0][m][1] * rstd;
                }
            }
    }
};
template <bool LAST = false, bool INIT_F32 = false> struct EpiRes {
    static constexpr bool PERM = true, AFTER_DRAIN = false, USE_RS = false, ACC_INIT = true;
    bf16_t* xb; float* xout; float* xsq; const float* xin;
    __device__ __forceinline__ void init(f32x4 (&acc)[2][2][4][2], const Unit& u, int wr, int wc, int fr, int fq) const {
        const int row0 = u.pm * BM + wr * 64 + fr, colt = u.pn * BM;
#pragma unroll
        for (int ai = 0; ai < 2; ++ai)
#pragma unroll
            for (int m = 0; m < 4; ++m)
#pragma unroll
                for (int bj = 0; bj < 2; ++bj) { const size_t off = (size_t)(row0 + ai * HALF + m * 16) * 1024 + colt + bj * HALF + wc * 32 + 8 * fq;
                    if (INIT_F32) { acc[ai][bj][m][0] = *(const f32x4*)(xin + off); acc[ai][bj][m][1] = *(const f32x4*)(xin + off + 4); continue; }
                    const u32x4 w = *(const u32x4*)(xb + off);
                    acc[ai][bj][m][0] = (f32x4){__uint_as_float(w.x << 16), __uint_as_float(w.x & 0xffff0000u), __uint_as_float(w.y << 16), __uint_as_float(w.y & 0xffff0000u)};
                    acc[ai][bj][m][1] = (f32x4){__uint_as_float(w.z << 16), __uint_as_float(w.z & 0xffff0000u), __uint_as_float(w.w << 16), __uint_as_float(w.w & 0xffff0000u)}; }
    }
    __device__ __forceinline__ void operator()(const f32x4 (&acc)[2][2][4][2], const Unit& u, int wr, int wc, int fr, int fq, PG8_LAS unsigned char*, int) const {
        const int row0 = u.pm * BM + wr * 64 + fr, colt = u.pn * BM;
#pragma unroll
        for (int ai = 0; ai < 2; ++ai)
#pragma unroll
            for (int m = 0; m < 4; ++m) {
                const int r = row0 + ai * HALF + m * 16; float ss = 0.f;
#pragma unroll
                for (int bj = 0; bj < 2; ++bj) {
                    const size_t off = (size_t)r * 1024 + colt + bj * HALF + wc * 32 + 8 * fq;
                    const f32x4 v0 = acc[ai][bj][m][0], v1 = acc[ai][bj][m][1];
                    if (LAST) { *(f32x4*)(xout + off) = v0; *(f32x4*)(xout + off + 4) = v1; }
                    else {
                    ss += ((v0[0] * v0[0] + v0[1] * v0[1]) + (v0[2] * v0[2] + v0[3] * v0[3])) + ((v1[0] * v1[0] + v1[1] * v1[1]) + (v1[2] * v1[2] + v1[3] * v1[3]));
                    u32x4 w; w.x = cvt_pk_bf16(v0[0], v0[1]); w.y = cvt_pk_bf16(v0[2], v0[3]); w.z = cvt_pk_bf16(v1[0], v1[1]); w.w = cvt_pk_bf16(v1[2], v1[3]);
                    *(u32x4*)(xb + off) = w; }
                }
                if (!LAST) { ss = add_xor32(add_xor16(ss));
                if (fq == 0) xsq[(size_t)r * 16 + u.pn * 4 + wc] = ss; }
            }
    }
};

template <class Epi, class Sched, bool ALIGN_EPI = false, bool SP2 = false>
__device__ __forceinline__ void gemm_phase(PG8_LAS unsigned char* lds, const Gemm g, const Sched& S, const Epi& E, int wid) {
    const int lane = lane_id_v();
    const int tid = wid * 64 + lane, wr = wid >> 2, wc = wid & 3, fr = lane & 15, fq = lane >> 4;
    const int K = g.K, nt = K / BK;
    unsigned voffA[2], voffB[2];
#pragma unroll
    for (int i = 0; i < 2; ++i) { int R, C; stage_rc(tid * 16 + i * 8192, R, C); const int Rb = Epi::PERM ? ((R & ~31) + perm32(R & 31)) : R;
        voffA[i] = (unsigned)(R * g.lda + C) * 2u; voffB[i] = (unsigned)(Rb * K + C) * 2u; }
    const size_t kstep = (size_t)(BK * 2);
    const size_t hstepA = (size_t)HALF * g.lda * 2, hstepB = (size_t)HALF * K * 2;
    const size_t tstepA = 2 * hstepA, tstepB = 2 * hstepB;
    const unsigned ldsw = (unsigned)wid * 1024u;
    const int aoff = lds_byte(wr * 64 + fr, fq * 8), boff = lds_byte(wc * 32 + fr, fq * 8);
#define PG8_SA(b, h) (((b) * 2 + (h)) * HTB)
#define PG8_SB(b, h) ((4 + (b) * 2 + (h)) * HTB)
#define PG8_STAGE(bufoff, gbase, voff) do { _Pragma("unroll") for (int _i = 0; _i < 2; ++_i) \
        __builtin_amdgcn_global_load_lds((const unsigned*)((const char*)(gbase) + (voff)[_i]), (PG8_LAS unsigned*)(lds + (bufoff) + ldsw + _i * 8192), 16, 0, 0); } while (0)
#define PG8_LDA(dst, b, h) do { _Pragma("unroll") for (int m = 0; m < 4; ++m) _Pragma("unroll") for (int k = 0; k < 2; ++k) dst[m][k] = *(const PG8_LAS bf16x8*)(lds + PG8_SA(b, h) + aoff + m * 2048 + k * 1024); } while (0)
#define PG8_LDB(dst, b, h) do { _Pragma("unroll") for (int n = 0; n < 2; ++n) _Pragma("unroll") for (int k = 0; k < 2; ++k) dst[n][k] = *(const PG8_LAS bf16x8*)(lds + PG8_SB(b, h) + boff + n * 2048 + k * 1024); } while (0)
#define PG8_MMA(ai, bj, At, Bt) do { __builtin_amdgcn_s_setprio(1); _Pragma("unroll") for (int m = 0; m < 4; ++m) _Pragma("unroll") for (int n = 0; n < 2; ++n) _Pragma("unroll") for (int k = 0; k < 2; ++k) \
        acc[ai][bj][m][n] = __builtin_amdgcn_mfma_f32_16x16x32_bf16(Bt[n][k], At[m][k], acc[ai][bj][m][n], 0, 0, 0); __builtin_amdgcn_s_setprio(0); } while (0)
#define PG8_WAIT_V(n) asm volatile("s_waitcnt vmcnt(" #n ")" ::: "memory")
#define PG8_WAIT_L(n) asm volatile("s_waitcnt lgkmcnt(" #n ")" ::: "memory")
#define PG8_BAR __builtin_amdgcn_s_barrier()
#define PG8_SCHED __builtin_amdgcn_sched_barrier(0)
    Unit cur, nxt; int ui = 0;
    if (!S.next(0, cur)) return;
    f32x4 acc[2][2][4][2];
    if constexpr (Epi::ACC_INIT) E.init(acc, cur, wr, wc, fr, fq);
    else {
#pragma unroll
    for (int a = 0; a < 2; ++a)
#pragma unroll
        for (int b = 0; b < 2; ++b)
#pragma unroll
            for (int m = 0; m < 4; ++m)
#pragma unroll
                for (int n = 0; n < 2; ++n) acc[a][b][m][n] = (f32x4){0.f, 0.f, 0.f, 0.f};
    }
    bf16x8 At[4][2], B0[2][2], B1[2][2];
    const char* cA = (const char*)g.A + (size_t)cur.pm * tstepA; const char* cB = (const char*)g.Bt + (size_t)cur.pn * tstepB;
    S.a_ready(cur);
    if constexpr (Epi::USE_RS) { if (tid < 256) { f32x4 rq[4]; E.rs_load(cur, tid, rq); E.rs_store(rq, lds, 0, tid); } }
    if constexpr (SP2) {
        PG8_STAGE(PG8_SB(0, 0), cB, voffB); PG8_STAGE(PG8_SB(0, 1), cB + hstepB, voffB); PG8_STAGE(PG8_SA(0, 0), cA, voffA); PG8_STAGE(PG8_SA(0, 1), cA + hstepA, voffA);
        if (wr == 1) PG8_BAR;
        PG8_WAIT_V(2); PG8_BAR;
        PG8_STAGE(PG8_SB(1, 0), cB + kstep, voffB); PG8_STAGE(PG8_SA(1, 0), cA + kstep, voffA); PG8_STAGE(PG8_SB(1, 1), cB + hstepB + kstep, voffB);
        PG8_WAIT_V(6); PG8_BAR;
    } else {
        PG8_STAGE(PG8_SB(0, 0), cB, voffB); PG8_STAGE(PG8_SA(0, 0), cA, voffA); PG8_STAGE(PG8_SB(0, 1), cB + hstepB, voffB); PG8_STAGE(PG8_SA(0, 1), cA + hstepA, voffA);
        if (wr == 1) PG8_BAR;
        PG8_WAIT_V(4); PG8_BAR;
        PG8_STAGE(PG8_SB(1, 0), cB + kstep, voffB); PG8_STAGE(PG8_SA(1, 0), cA + kstep, voffA); PG8_STAGE(PG8_SB(1, 1), cB + hstepB + kstep, voffB);
        PG8_WAIT_V(6); PG8_BAR;
    }
    for (;;) {
        const bool has_next = S.next(ui + 1, nxt);
        const char* nA = has_next ? (const char*)g.A + (size_t)nxt.pm * tstepA : cA; const char* nB = has_next ? (const char*)g.Bt + (size_t)nxt.pn * tstepB : cB;
        for (int t = 0; t < nt; t += 2) {
            const bool last = (t == nt - 2);
            const char* a1 = cA + (size_t)(t + 1) * kstep;
            const char* a2 = last ? nA : cA + (size_t)(t + 2) * kstep; const char* b2 = last ? nB : cB + (size_t)(t + 2) * kstep;
            const char* a3 = a2 + kstep; const char* b3 = b2 + kstep;
            if (last && has_next) S.a_ready(nxt);
            if constexpr (SP2) {
            PG8_LDB(B0, 0, 0); PG8_LDB(B1, 0, 1); PG8_SCHED; PG8_LDA(At, 0, 0); PG8_STAGE(PG8_SA(1, 1), a1 + hstepA, voffA);
            PG8_WAIT_V(8); PG8_WAIT_L(0); PG8_BAR; PG8_MMA(0, 0, At, B0); PG8_MMA(0, 1, At, B1); PG8_BAR; PG8_SCHED;
            PG8_LDA(At, 0, 1); PG8_STAGE(PG8_SB(0, 0), b2, voffB); PG8_STAGE(PG8_SB(0, 1), b2 + hstepB, voffB); PG8_STAGE(PG8_SA(0, 0), a2, voffA);
            PG8_WAIT_V(8); PG8_WAIT_L(0); PG8_BAR; PG8_MMA(1, 0, At, B0); PG8_MMA(1, 1, At, B1); PG8_BAR; PG8_SCHED;
            PG8_LDB(B0, 1, 0); PG8_LDB(B1, 1, 1); PG8_SCHED; PG8_LDA(At, 1, 0); PG8_STAGE(PG8_SA(0, 1), a2 + hstepA, voffA);
            PG8_WAIT_V(8); PG8_WAIT_L(0); PG8_BAR; PG8_MMA(0, 0, At, B0); PG8_MMA(0, 1, At, B1); PG8_BAR; PG8_SCHED;
            PG8_LDA(At, 1, 1); PG8_STAGE(PG8_SB(1, 0), b3, voffB); PG8_STAGE(PG8_SB(1, 1), b3 + hstepB, voffB); PG8_STAGE(PG8_SA(1, 0), a3, voffA);
            PG8_WAIT_V(8); PG8_WAIT_L(0); PG8_BAR; PG8_MMA(1, 0, At, B0); PG8_MMA(1, 1, At, B1); PG8_BAR; PG8_SCHED;
            } else {
            PG8_LDB(B0, 0, 0); PG8_SCHED; PG8_LDA(At, 0, 0); PG8_STAGE(PG8_SA(1, 1), a1 + hstepA, voffA);
            PG8_WAIT_L(8); PG8_BAR; PG8_WAIT_L(0); PG8_MMA(0, 0, At, B0); PG8_BAR; PG8_SCHED;
            PG8_LDB(B1, 0, 1); PG8_STAGE(PG8_SB(0, 0), b2, voffB);
            PG8_BAR; PG8_WAIT_L(0); PG8_MMA(0, 1, At, B1); PG8_BAR;
            PG8_LDA(At, 0, 1); PG8_STAGE(PG8_SA(0, 0), a2, voffA);
            PG8_BAR; PG8_WAIT_L(0); PG8_MMA(1, 0, At, B0); PG8_BAR; PG8_SCHED;
            PG8_STAGE(PG8_SB(0, 1), b2 + hstepB, voffB);
            PG8_WAIT_V(6); PG8_BAR; PG8_MMA(1, 1, At, B1); PG8_BAR;
            PG8_LDB(B0, 1, 0); PG8_SCHED; PG8_LDA(At, 1, 0); PG8_STAGE(PG8_SA(0, 1), a2 + hstepA, voffA);
            PG8_WAIT_L(8); PG8_BAR; PG8_WAIT_L(0); PG8_MMA(0, 0, At, B0); PG8_BAR; PG8_SCHED;
            PG8_LDB(B1, 1, 1); PG8_STAGE(PG8_SB(1, 0), b3, voffB);
            PG8_BAR; PG8_WAIT_L(0); PG8_MMA(0, 1, At, B1); PG8_BAR;
            PG8_LDA(At, 1, 1); PG8_STAGE(PG8_SA(1, 0), a3, voffA);
            PG8_BAR; PG8_WAIT_L(0); PG8_MMA(1, 0, At, B0); PG8_BAR; PG8_SCHED;
            PG8_STAGE(PG8_SB(1, 1), b3 + hstepB, voffB);
            PG8_WAIT_V(6); PG8_BAR; PG8_MMA(1, 1, At, B1); PG8_BAR;
            }
        }
        if constexpr (ALIGN_EPI) { if (wr == 0) PG8_BAR; }
        if constexpr (Epi::USE_RS) {
            f32x4 rq[4]; if (has_next && wid < 4) E.rs_load(nxt, wid * 64 + lane_id_v(), rq);
            E(acc, cur, wr, wc, fr, fq, lds, ui & 1);
            if (has_next && wid < 4) E.rs_store(rq, lds, (ui + 1) & 1, wid * 64 + lane_id_v());
        } else { E(acc, cur, wr, wc, fr, fq, lds, ui & 1); }
        S.done(cur);
        if (!has_next) break;
        if constexpr (Epi::ACC_INIT) E.init(acc, nxt, wr, wc, fr, fq);
        else {
#pragma unroll
        for (int a = 0; a < 2; ++a)
#pragma unroll
            for (int b = 0; b < 2; ++b)
#pragma unroll
                for (int m = 0; m < 4; ++m)
#pragma unroll
                    for (int n = 0; n < 2; ++n) acc[a][b][m][n] = (f32x4){0.f, 0.f, 0.f, 0.f};
        }
        cur = nxt; cA = nA; cB = nB; ++ui;
        if constexpr (ALIGN_EPI) { if (wr == 1) PG8_BAR; }
    }
    PG8_WAIT_V(0);
    if constexpr (!ALIGN_EPI) { if (wr == 0) PG8_BAR; }
    PG8_BAR;
    if constexpr (Epi::AFTER_DRAIN) { E.fused(acc, cur, wr, wc, fr, fq, lds, wid, lane); S.done(cur); }
#undef PG8_SA
#undef PG8_SB
#undef PG8_STAGE
#undef PG8_LDA
#undef PG8_LDB
#undef PG8_MMA
#undef PG8_WAIT_V
#undef PG8_WAIT_L
#undef PG8_BAR
#undef PG8_SCHED
}
}

namespace att {
typedef unsigned short bf16_t;
typedef short bf16x8 __attribute__((ext_vector_type(8)));
typedef short s16x4 __attribute__((ext_vector_type(4)));
typedef float f32x16 __attribute__((ext_vector_type(16)));
typedef float f32x4 __attribute__((ext_vector_type(4)));
typedef unsigned u32x4 __attribute__((ext_vector_type(4)));
constexpr int NW = 8, QBLK = 32, KVBLK = 64, QB = NW * QBLK, D = 128;
constexpr int SHM_V = KVBLK * D * 2, SHM_K = KVBLK * D * 2;
constexpr int OFF_WS = 2 * SHM_V + 2 * SHM_K, OFF_BK = OFF_WS + NW * 64 * 4, ATT_LDS = OFF_BK + 8192;
constexpr float SCALE = 0.08838834764831845f, THR = 8.f;
constexpr int WBIG = 1 << 30;
#define KSWZ(row, colB) ((row) * 256 + ((colB) ^ (((row) & 7) << 4)))
#define SBAR() __builtin_amdgcn_sched_barrier(0)
__device__ __forceinline__ int v_st(int k, int c) { const int kk = (k & ~0xC) | ((k & 4) << 1) | ((k & 8) >> 1); return ((kk >> 3) * 4 + (c >> 5)) * 512 + ((kk & 7) * 32 + (c & 31)) * 2; }
__device__ __forceinline__ int v_rd_base(int lane) { return ((lane & 3) << 3) | (((lane >> 2) & 3) << 6) | (((lane >> 4) & 1) << 5) | (((lane >> 5) & 1) << 8); }
constexpr int v_rd_off(int d0, int ks, int half) { return d0 * 512 + ks * 4096 + half * 2048; }
__device__ __forceinline__ int crow(int r, int hi) { return (r & 3) + 8 * (r >> 2) + 4 * hi; }
__device__ __forceinline__ unsigned cvtpk(float lo, float hi) { unsigned r; asm volatile("v_cvt_pk_bf16_f32 %0, %1, %2" : "=v"(r) : "v"(lo), "v"(hi)); return r; }
__device__ __forceinline__ bf16x8 load8(const bf16_t* p) { return *reinterpret_cast<const bf16x8*>(p); }
__device__ __forceinline__ void mask_tile(f32x16& p0, f32x16& p1, int dq, unsigned W) {
    const float NEG = -__builtin_inff();
#pragma unroll
    for (int r = 0; r < 16; ++r) { const int c = (r & 3) + 8 * (r >> 2);
        if ((unsigned)(dq - c) >= W) p0[r] = NEG;
        if ((unsigned)(dq - c - 32) >= W) p1[r] = NEG; }
}
__device__ __forceinline__ void partialSM(f32x16& p0, f32x16& p1, float& m_reg, float& mn, float& alpha) {
    float pmax = p0[0]; for (int r = 1; r < 16; ++r) pmax = fmaxf(pmax, p0[r]); for (int r = 0; r < 16; ++r) pmax = fmaxf(pmax, p1[r]);
    { auto rr = __builtin_amdgcn_permlane32_swap(__float_as_uint(pmax), __float_as_uint(pmax), false, false);
      pmax = fmaxf(__uint_as_float(rr[0]), __uint_as_float(rr[1])); }
    constexpr float C2 = 1.4426950408889634f * SCALE;
    if (__builtin_expect(__all((pmax - m_reg) * SCALE <= THR), 1)) { mn = m_reg; alpha = 1.f; }
    else { mn = fmaxf(m_reg, pmax); alpha = __builtin_amdgcn_exp2f((m_reg - mn) * C2); m_reg = mn; }
    const float mnL = -mn * C2;
    for (int r = 0; r < 16; ++r) p0[r] = fmaf(p0[r], C2, mnL); for (int r = 0; r < 16; ++r) p1[r] = fmaf(p1[r], C2, mnL);
    for (int r = 0; r < 16; ++r) p0[r] = __builtin_amdgcn_exp2f(p0[r]);
}
__device__ __forceinline__ void finishSM(f32x16& p0, f32x16& p1, float alpha, float& l_reg, bf16x8& pa0, bf16x8& pa1, bf16x8& pa2, bf16x8& pa3) {
    for (int r = 0; r < 16; ++r) p1[r] = __builtin_amdgcn_exp2f(p1[r]);
    float ps = 0; for (int r = 0; r < 16; ++r) ps += p0[r]; for (int r = 0; r < 16; ++r) ps += p1[r];
    { auto rr = __builtin_amdgcn_permlane32_swap(__float_as_uint(ps), __float_as_uint(ps), false, false);
      ps = __uint_as_float(rr[0]) + __uint_as_float(rr[1]); }
    l_reg = l_reg * alpha + ps;
#define PK4(P, B_, OUT) do { unsigned a0 = cvtpk(P[B_+0], P[B_+1]), a1 = cvtpk(P[B_+2], P[B_+3]);                          \
        unsigned b0 = cvtpk(P[B_+4], P[B_+5]), b1 = cvtpk(P[B_+6], P[B_+7]);                                             \
        auto r0 = __builtin_amdgcn_permlane32_swap(a0, b0, false, false); auto r1 = __builtin_amdgcn_permlane32_swap(a1, b1, false, false); \
        u32x4 w = {r0[0], r1[0], r0[1], r1[1]}; OUT = *reinterpret_cast<bf16x8*>(&w); } while (0)
    PK4(p0, 0, pa0); PK4(p0, 8, pa1); PK4(p1, 0, pa2); PK4(p1, 8, pa3);
#undef PK4
}
template <int KB>
__device__ __forceinline__ void qkt(f32x16& p0, f32x16& p1, const char* K_lds, int r32, int hi, const bf16x8* qr, const float* bb) {
#pragma unroll
    for (int g = 0; g < 4; ++g) { const f32x4 b0 = *(const f32x4*)(bb + 8 * g), b1 = *(const f32x4*)(bb + 32 + 8 * g);
#pragma unroll
        for (int i = 0; i < 4; ++i) { p0[4 * g + i] = b0[i]; p1[4 * g + i] = b1[i]; } }
    const char* kb[4];
#pragma unroll
    for (int dd = 0; dd < 4; ++dd) kb[dd] = K_lds + KB * SHM_K + KSWZ(r32, (dd * 16 + hi * 8) * 2);
#pragma unroll
    for (int d0 = 0; d0 < 8; ++d0) { const char* a = kb[d0 & 3] + (d0 >> 2) * 128;
        bf16x8 b0 = *reinterpret_cast<const bf16x8*>(a);
        bf16x8 b1 = *reinterpret_cast<const bf16x8*>(a + 32 * 256);
        p0 = __builtin_amdgcn_mfma_f32_32x32x16_bf16(b0, qr[d0], p0, 0, 0, 0);
        p1 = __builtin_amdgcn_mfma_f32_32x32x16_bf16(b1, qr[d0], p1, 0, 0, 0); }
}
template <int VB>
__device__ __forceinline__ void pv_tile(f32x16* o, int vb0, bf16x8 pa0, bf16x8 pa1, bf16x8 pa2, bf16x8 pa3) {
#define TRRD(dst, off) asm volatile("ds_read_b64_tr_b16 %0, %1 offset:%2" : "=&v"(dst) : "v"(vb0), "i"(off) : "memory")
#define PV_D0(d0) do { s16x4 l0, l1, l2, l3, h0, h1, h2, h3; constexpr int b_ = VB * SHM_V + v_rd_off(d0, 0, 0);   \
        TRRD(l0, b_); TRRD(h0, b_ + 2048); TRRD(l1, b_ + 4096); TRRD(h1, b_ + 6144); TRRD(l2, b_ + 8192); TRRD(h2, b_ + 10240); TRRD(l3, b_ + 12288); TRRD(h3, b_ + 14336); \
        asm volatile("s_waitcnt lgkmcnt(0)" ::: "memory"); SBAR();   \
        o[d0] = __builtin_amdgcn_mfma_f32_32x32x16_bf16(pa0, (bf16x8){l0[0], l0[1], l0[2], l0[3], h0[0], h0[1], h0[2], h0[3]}, o[d0], 0, 0, 0);   \
        o[d0] = __builtin_amdgcn_mfma_f32_32x32x16_bf16(pa1, (bf16x8){l1[0], l1[1], l1[2], l1[3], h1[0], h1[1], h1[2], h1[3]}, o[d0], 0, 0, 0);   \
        o[d0] = __builtin_amdgcn_mfma_f32_32x32x16_bf16(pa2, (bf16x8){l2[0], l2[1], l2[2], l2[3], h2[0], h2[1], h2[2], h2[3]}, o[d0], 0, 0, 0);   \
        o[d0] = __builtin_amdgcn_mfma_f32_32x32x16_bf16(pa3, (bf16x8){l3[0], l3[1], l3[2], l3[3], h3[0], h3[1], h3[2], h3[3]}, o[d0], 0, 0, 0); } while (0)
    PV_D0(0); PV_D0(1); PV_D0(2); PV_D0(3);
#undef PV_D0
#undef TRRD
}
constexpr int QP = 4608;
struct Blk { bf16_t* Q; const bf16_t* K; const float* flog; float fb; int voff, goff, P0, skv, kvpitch; };
struct Seam { bf16x8 qr[8]; bf16x8 st_v0, st_v1, st_k0, st_k1; };
#define ROW(p, pitch, k0, rr) ((p) + (size_t)((k0) + (rr)) * (pitch) + sc)
#define VMW() asm volatile("s_waitcnt vmcnt(0)" ::: "memory")
#define VMWN(n) asm volatile("s_waitcnt vmcnt(%0)" :: "i"(n) : "memory")
#define SLOAD_H(Kp, Vp, pitch, k0) do { S.st_v0 = load8(ROW(Vp, pitch, k0, sr)); S.st_v1 = load8(ROW(Vp, pitch, k0, 32 + sr));              \
                         S.st_k0 = load8(ROW(Kp, pitch, k0, sr)); S.st_k1 = load8(ROW(Kp, pitch, k0, 32 + sr)); } while (0)
#define SWRITE_HK(bf) do { *(bf16x8*)(K_lds + (bf) * SHM_K + kws) = S.st_k0; *(bf16x8*)(K_lds + (bf) * SHM_K + kws + 32 * 256) = S.st_k1; } while (0)
#define SWRITE_HV(bf) do { *(bf16x8*)(V_lds + (bf) * SHM_V + vst0) = S.st_v0; *(bf16x8*)(V_lds + (bf) * SHM_V + vst1) = S.st_v1; } while (0)
#define SWRITE_H(bf) do { SWRITE_HV(bf); SWRITE_HK(bf); } while (0)
__device__ __forceinline__ void prime(const Blk& cur, char* lds, Seam& S, int wid) {
    const int lane = lane_id_v();
    const int tid = wid * 64 + lane, r32 = lane & 31, hi = lane >> 5;
    const int sr = tid >> 4, sc = (tid & 15) * 8, kws = KSWZ(sr, sc * 2); char* K_lds = lds + 2 * SHM_V;
    for (int d0 = 0; d0 < 8; ++d0) S.qr[d0] = load8(cur.Q + (size_t)(wid * QBLK + r32) * QP + d0 * 16 + hi * 8);
    SLOAD_H(cur.K, cur.K + cur.voff, cur.kvpitch, 0); VMW(); SWRITE_HK(0);
    __syncthreads();
}
__device__ __forceinline__ void block(const Blk& cur, const Blk& nxt, char* lds, Seam& S, int wid) {
    const int lane = lane_id_v();
    const int tid = wid * 64 + lane, r32 = lane & 31, hi = lane >> 5;
    constexpr int W = WBIG;
    int j_hi = (cur.P0 + QB - 1) / KVBLK + 1; if (j_hi > cur.skv / KVBLK) j_hi = cur.skv / KVBLK;
    const int NT = j_hi;
    const int qlo = cur.P0 + wid * QBLK, qm = qlo + r32 - 4 * hi;
    char* V_lds = lds; char* K_lds = lds + 2 * SHM_V;
    float* ws = (float*)(lds + OFF_WS) + wid * 64; float* li_l = ws, * al_l = ws + 32;
    float* bkl = (float*)(lds + OFF_BK);
    { const int nkeys = NT * KVBLK;
      if (cur.flog) { const int k0 = 4 * tid; float f[4];
#pragma unroll
          for (int e = 0; e < 4; ++e) { float x = 0.f; if (k0 + e < nkeys) x = cur.flog[(size_t)(k0 + e) * 16] + cur.fb;
              f[e] = k0 + e < nkeys ? fminf(x, 0.f) - log1pf(__expf(-fabsf(x))) : 0.f; }
          f[1] += f[0]; f[2] += f[1]; f[3] += f[2];
          float sc = f[3];
#pragma unroll
          for (int o_ = 1; o_ < 64; o_ <<= 1) { const float t_ = __shfl_up(sc, o_); if (lane >= o_) sc += t_; }
          if (lane == 63) ws[0] = sc;
          __syncthreads();
          float off = sc - f[3];
          for (int w_ = 0; w_ < wid; ++w_) off += ((const float*)(lds + OFF_WS))[w_ * 64];
#pragma unroll
          for (int e = 0; e < 4; ++e) if (k0 + e < nkeys) bkl[k0 + e] = -(f[e] + off) * (1.f / SCALE); }
      else for (int k = tid; k < nkeys; k += NW * 64) bkl[k] = 0.f;
      __syncthreads(); }
    float m_reg = -1e30f, l_reg = 0; f32x16 o[4] = {};
    const int sr = tid >> 4, sc = (tid & 15) * 8, vst0 = v_st(sr, sc), vst1 = v_st(32 + sr, sc), kws = KSWZ(sr, sc * 2);
    const int vb0 = (int)(uintptr_t)V_lds + v_rd_base(lane);
    const bf16_t* Kh = cur.K; const bf16_t* Vh = cur.K + cur.voff; const int kvp = cur.kvpitch;
#define RESC(a) do { if (__any((a) < 1.f)) { if (hi == 0) al_l[r32] = (a); asm volatile("s_waitcnt lgkmcnt(0)" ::: "memory");              \
                     for (int d_ = 0; d_ < 4; ++d_) for (int r = 0; r < 16; ++r) o[d_][r] *= al_l[crow(r, hi)]; } } while (0)
#define KBASE(t) ((t) * KVBLK)
#define MASKT(P0_, P1_, t) do { const int kb_ = KBASE(t); if (kb_ + KVBLK - 1 > qlo) mask_tile(P0_, P1_, qm - kb_, (unsigned)W); } while (0)
#define BB(t) (bkl + KBASE(t) + 4 * hi)
    constexpr int NQL = 8;
#define SEAM_K0() do { VMWN(NQL); SWRITE_HK(0); SBAR(); } while (0)
    f32x16 pA0, pA1, pB0, pB1; float mnA, mnB, alA, alB; bf16x8 pa0, pa1, pa2, pa3;
    SWRITE_HV(0); SBAR();
    if (NT > 1) { SLOAD_H(Kh, Vh, kvp, KBASE(1)); }
    SBAR(); qkt<0>(pA0, pA1, K_lds, r32, hi, S.qr, BB(0));
    MASKT(pA0, pA1, 0); partialSM(pA0, pA1, m_reg, mnA, alA);
    if (NT > 1) { VMW(); SWRITE_H(1); }
    __syncthreads();
#define HALF_STEP(PX0, PX1, mnX, alX, PY0, PY1, alY, t, KB, VB, SB) do {                                                      \
        SBAR(); qkt<KB>(PX0, PX1, K_lds, r32, hi, S.qr, BB(t));                                                                      \
        finishSM(PY0, PY1, alY, l_reg, pa0, pa1, pa2, pa3); SBAR();                                                           \
        if ((t) + 1 < NT) { SLOAD_H(Kh, Vh, kvp, KBASE((t) + 1)); SBAR(); }                                                   \
        pv_tile<VB>(o, vb0, pa0, pa1, pa2, pa3); MASKT(PX0, PX1, (t)); partialSM(PX0, PX1, m_reg, mnX, alX);   \
        __syncthreads();                                                                                                      \
        if ((t) + 1 < NT) { VMW(); SWRITE_H(SB); }                                                                            \
        RESC(alX); __syncthreads(); } while (0)
    for (int t = 1; t + 1 < NT; t += 2) {
        HALF_STEP(pB0, pB1, mnB, alB, pA0, pA1, alA, t, 1, 0, 0);
        HALF_STEP(pA0, pA1, mnA, alA, pB0, pB1, alB, t + 1, 0, 1, 1);
    }
    const bool even = (NT & 1) == 0;
    if (even) { SBAR(); qkt<1>(pB0, pB1, K_lds, r32, hi, S.qr, BB(NT - 1)); SBAR(); }
    SLOAD_H(nxt.K, nxt.K + nxt.voff, nxt.kvpitch, 0); SBAR();
#pragma unroll
    for (int d0 = 0; d0 < 8; ++d0) S.qr[d0] = load8(nxt.Q + (size_t)(wid * QBLK + r32) * QP + d0 * 16 + hi * 8);
    SBAR();
    finishSM(pA0, pA1, alA, l_reg, pa0, pa1, pa2, pa3); SBAR();
    pv_tile<0>(o, vb0, pa0, pa1, pa2, pa3);
    if (even) { MASKT(pB0, pB1, NT - 1); partialSM(pB0, pB1, m_reg, mnB, alB); __syncthreads(); RESC(alB);
        finishSM(pB0, pB1, alB, l_reg, pa0, pa1, pa2, pa3); SBAR(); pv_tile<1>(o, vb0, pa0, pa1, pa2, pa3); }
    SBAR(); SEAM_K0();
    if (hi == 0) li_l[r32] = l_reg; asm volatile("s_waitcnt lgkmcnt(0)" ::: "memory");
    float rli[16];
#pragma unroll
    for (int r = 0; r < 16; ++r) rli[r] = __builtin_amdgcn_rcpf(li_l[crow(r, hi)]);
    const int odd = r32 & 1;
    bf16_t* Ow = cur.Q + (size_t)(wid * QBLK + 4 * hi) * QP + (r32 & ~1) + 32 * odd; const int goff = cur.goff;
    auto fin = [&](auto has_gate) {
        unsigned g[16][2];
        if (has_gate.value) {
#pragma unroll
            for (int r = 0; r < 16; ++r) { const int ro = ((r & 3) + 8 * (r >> 2)) * QP;
#pragma unroll
                for (int dp = 0; dp < 2; ++dp) g[r][dp] = *(const unsigned*)(Ow + goff + ro + dp * 64); }
        }
#pragma unroll
        for (int r = 0; r < 16; ++r) { const int ro = ((r & 3) + 8 * (r >> 2)) * QP;
#pragma unroll
            for (int dp = 0; dp < 2; ++dp) { const float a = o[2 * dp][r] * rli[r], b = o[2 * dp + 1][r] * rli[r];
                const float recv = dppf<0xB1>(odd ? a : b);
                float lo = odd ? recv : a, hi2 = odd ? b : recv;
                if (has_gate.value) { lo *= __uint_as_float(g[r][dp] << 16); hi2 *= __uint_as_float(g[r][dp] & 0xffff0000u); }
                *(unsigned*)(Ow + ro + dp * 64) = cvtpk(lo, hi2); } }
    };
    if (goff) fin(std::true_type{}); else fin(std::false_type{});
    __syncthreads();
#undef RESC
#undef KBASE
#undef MASKT
#undef BB
#undef SEAM_K0
#undef HALF_STEP
}
#undef ROW
#undef VMW
#undef VMWN
#undef SLOAD_H
#undef SWRITE_HK
#undef SWRITE_HV
#undef SWRITE_H
#undef KSWZ
#undef SBAR
template <class Src> __device__ __forceinline__ void phase(char* lds, const Src& src, int wid) {
    Blk cur, nxt; if (!src(0, cur)) return;
    Seam S; prime(cur, lds, S, wid);
    for (int n = 0;; ++n) { const bool more = src(n + 1, nxt); if (!more) nxt = cur; block(cur, nxt, lds, S, wid); if (!more) break; cur = nxt; }
}
}

constexpr int NWAVES = 8;
#ifndef MK_LAUNCH_PER_PHASE
#define MK_LAUNCH_PER_PHASE 0
#endif
constexpr int N_PHASES = 12;

constexpr size_t KiB = 1u << 10, MiB = 1u << 20;
constexpr size_t WS_CTL = 0, CTL_ZERO_BYTES = 1 * MiB;
constexpr size_t WS_WIN0 = 1 * MiB, WS_WIN1 = WS_WIN0 + (size_t)N_IN * DM * 2;
constexpr size_t WS_WOUT0 = 20 * MiB, WS_WOUT1 = 23 * MiB;
constexpr size_t WS_WM1_0 = 26 * MiB, WS_WM1_1 = 34 * MiB, WS_WM2_0 = 42 * MiB, WS_WM2_1 = 50 * MiB;
constexpr size_t WS_WMKV = 58 * MiB;
constexpr size_t WS_PROJ = 60 * MiB;
constexpr size_t WS_XB = 204 * MiB;
constexpr size_t WS_SSQ = 236 * MiB;
constexpr size_t WS_AB = 245 * MiB;
constexpr size_t WS_MEMKV = 246 * MiB;
constexpr size_t WS_XSQ = 250 * MiB;
constexpr size_t WS_FCUM = 251 * MiB;
constexpr size_t WS_MSSQ = 251 * MiB + 512 * KiB;
constexpr size_t WS_MSQ = 251 * MiB + 768 * KiB;
constexpr size_t WS_END = 252 * MiB;
static_assert(WS_WIN1 + (size_t)N_IN * DM * 2 <= WS_WOUT0 && WS_PROJ + (size_t)MROWS * PW * 2 <= WS_XB && WS_SSQ + (size_t)36 * MROWS * 16 <= WS_AB, "d_ws map");
constexpr size_t DO_MEMB = 0;
constexpr int CW_BAR = 4096;

constexpr int LDS_BYTES = 155648;
constexpr int MISC_OFF = LDS_BYTES - 256;

#define GAS __attribute__((address_space(1)))
#define LAS __attribute__((address_space(3)))
typedef unsigned short bf16;
typedef unsigned v4u __attribute__((ext_vector_type(4)));
typedef float f32x4 __attribute__((ext_vector_type(4)));
typedef short bf16x8 __attribute__((ext_vector_type(8)));
typedef GAS unsigned gu32;
typedef GAS unsigned long long gu64;
#define RLX_AGENT __ATOMIC_RELAXED, __HIP_MEMORY_SCOPE_AGENT
#define LDS_WAIT() asm volatile("s_waitcnt lgkmcnt(0)" ::: "memory")
#define VM_WAIT() asm volatile("s_waitcnt vmcnt(0)" ::: "memory")
__device__ __forceinline__ unsigned long long rt() { return __builtin_amdgcn_s_memrealtime(); }
__device__ __forceinline__ unsigned f2bf(float f) { unsigned u = __builtin_bit_cast(unsigned, f); return (u + 0x7fffu + ((u >> 16) & 1u)) >> 16; }
__device__ __forceinline__ unsigned pk2(float lo, float hi) { return f2bf(lo) | (f2bf(hi) << 16); }

#define XB_TMO      128
#define XB_XCNT(j)  (256  + 64 * (j))
#define XB_XSUB(j)  (1280 + 64 * (j))
#define XB_XGEN(j)  (2304 + 64 * (j))
#define XB_TOP      3328
#define XB_TOPGEN   3392
#define XCD_BAR_WORDS 3456
#define XB_SPIN_CAP (1u << 18)

__device__ __forceinline__ unsigned xb_ld(unsigned* p)              { return __hip_atomic_load(p, __ATOMIC_RELAXED, __HIP_MEMORY_SCOPE_AGENT); }
__device__ __forceinline__ unsigned xb_add(unsigned* p, unsigned v) { return __hip_atomic_fetch_add(p, v, __ATOMIC_RELAXED, __HIP_MEMORY_SCOPE_AGENT); }
__device__ __forceinline__ unsigned xb_xcc_id() { return (unsigned)__builtin_amdgcn_s_getreg((3 << 11) | 20) & 0xFu; }
#define XB_SPIN(cond, bar) do { unsigned _sp = 0; while (cond) { __builtin_amdgcn_s_sleep(1); \
    if ((++_sp & 255u) == 0u) { if (xb_ld(&(bar)[XB_TMO])) break; if (_sp > XB_SPIN_CAP) { atomicAdd(&(bar)[XB_TMO], 1u); break; } } } } while (0)

struct XcdBarrier {
    unsigned* bar; unsigned x; int wv;
    volatile LAS unsigned* st;
};

__device__ __forceinline__ XcdBarrier xcd_barrier_post(unsigned* bar, volatile LAS unsigned* st) {
    XcdBarrier b; b.bar = bar; b.x = xb_xcc_id(); b.st = st;
    if (threadIdx.x == 0) (void)xb_add(&bar[XB_XCNT(b.x)], 1u);
    return b;
}
__device__ __forceinline__ void xcd_barrier_complete(unsigned* bar, unsigned x, unsigned& nloc, unsigned& nx) {
    const unsigned G = gridDim.x * gridDim.y * gridDim.z;
    unsigned sum, cnt, mine, sp = 0u;
    for (;;) {
        sum = 0u; cnt = 0u; mine = 0u;
#pragma unroll
        for (unsigned j = 0; j < 16; ++j) { const unsigned c = xb_ld(&bar[XB_XCNT(j)]); sum += c; cnt += (c > 0u) ? 1u : 0u; mine = (j == x) ? c : mine; }
        if (sum == G) break;
        __builtin_amdgcn_s_sleep(1);
        if ((++sp & 255u) == 0u) { if (xb_ld(&bar[XB_TMO])) break; if (sp > XB_SPIN_CAP) { atomicAdd(&bar[XB_TMO], 1u); break; } }
    }
    nloc = mine > 0u ? mine : 1u; nx = cnt > 0u ? cnt : 1u;
}

__device__ __forceinline__ void xcd_barrier(const XcdBarrier& b) {
    asm volatile("s_waitcnt vmcnt(0)" ::: "memory");
    __syncthreads();
    if (b.wv == 0 && lane_id_v() == 0) {
        unsigned* bar = b.bar;
        __builtin_amdgcn_s_waitcnt(0);
        unsigned nloc = b.st[0], nx = b.st[1];
        if (nloc == 0u) { xcd_barrier_complete(bar, b.x, nloc, nx); b.st[0] = nloc; b.st[1] = nx; }
        const unsigned old = xb_add(&bar[XB_XSUB(b.x)], 1u);
        const unsigned gen = old / nloc;
        if (old + 1u == (gen + 1u) * nloc) {
            __builtin_amdgcn_fence(__ATOMIC_RELEASE, "agent");
            asm volatile("s_waitcnt vmcnt(0)" ::: "memory");
            const unsigned og = xb_add(&bar[XB_TOP], 1u);
            const unsigned tg = og / nx;
            if (og + 1u == (tg + 1u) * nx) xb_add(&bar[XB_TOPGEN], 1u);
            else XB_SPIN(xb_ld(&bar[XB_TOPGEN]) == tg, bar);
            __builtin_amdgcn_fence(__ATOMIC_ACQUIRE, "agent");
            xb_add(&bar[XB_XGEN(b.x)], 1u);
            asm volatile("s_waitcnt vmcnt(0)" ::: "memory");
        } else {
            XB_SPIN(xb_ld(&bar[XB_XGEN(b.x)]) == gen, bar);
            __builtin_amdgcn_fence(__ATOMIC_ACQUIRE, "agent");
            asm volatile("s_waitcnt vmcnt(0)" ::: "memory");
        }
    }
    __syncthreads();
}


__device__ __forceinline__ float bflo(unsigned u) { return __builtin_bit_cast(float, u << 16); }
__device__ __forceinline__ float bfhi(unsigned u) { return __builtin_bit_cast(float, u & 0xffff0000u); }
typedef float f32x2_t __attribute__((ext_vector_type(2))); typedef __bf16 bf16x2_t __attribute__((ext_vector_type(2)));
__device__ __forceinline__ unsigned pkbf(float lo, float hi) { const f32x2_t v = {lo, hi}; const bf16x2_t b = __builtin_convertvector(v, bf16x2_t); return __builtin_bit_cast(unsigned, b); }
__device__ __forceinline__ float wave_sum(float v) { return add_xor32(add_xor16(row16_sum(v))); }
__device__ __forceinline__ float wave_max(float v) {
#pragma unroll
    for (int o = 1; o < 64; o <<= 1) v = fmaxf(v, __shfl_xor(v, o));
    return v;
}

struct Args { const float* in[20]; float* out; unsigned char* ws; int ph_lo, ph_hi, li, pad; };
enum { I_X = 0, I_MEM, I_MEMNW, I_WMKV, I_MEMKNW, I_NORM1, I_DNWIN, I_DNCONV, I_DNALOG, I_DNDT, I_DNONW, I_FOXWIN, I_FOXFB, I_FOXQNW, I_FOXKNW, I_MEMQNW, I_WOUT, I_NORM2, I_WM1, I_WM2 };

struct Frame {
    LAS unsigned char* lds;
    int G, bid, wv;
    const float* const* in; float* out; unsigned char* ws;
};


constexpr int CW_XCC = 32768, CW_BAD = 33792, CW_GRP = 65536;
struct GrpBar { unsigned* cnt; unsigned* tmo; int wv; bool on; };
__device__ __forceinline__ void grp_barrier(const GrpBar& gb, int seam) {
    asm volatile("s_waitcnt vmcnt(0)" ::: "memory");
    __syncthreads();
    if (gb.wv == 0 && lane_id_v() == 0) { unsigned* p = gb.cnt + seam * 64;
        (void)__hip_atomic_fetch_add(p, 1u, __ATOMIC_RELAXED, __HIP_MEMORY_SCOPE_AGENT);
        unsigned sp = 0;
        while (__hip_atomic_load(p, __ATOMIC_RELAXED, __HIP_MEMORY_SCOPE_AGENT) < 4u) { __builtin_amdgcn_s_sleep(1); if (++sp > (1u << 22)) { atomicAdd(gb.tmo, 1u); break; } }
        __builtin_amdgcn_fence(__ATOMIC_ACQUIRE, "agent");
        asm volatile("s_waitcnt vmcnt(0)" ::: "memory"); }
    __syncthreads();
}
struct Tix { int tid, lane, wave; };
__device__ __forceinline__ int lane_id() { return lane_id_v(); }
__device__ __forceinline__ Tix tix(int wv) { Tix t; t.lane = lane_id(); t.wave = wv; t.tid = wv * 64 + t.lane; return t; }
struct TSeg { const float* W; int K, ldw, src0, ncols; bf16* WT; int dst0; const float* scale; };
__device__ __forceinline__ TSeg get_seg(const Frame& F, int s) {
    TSeg t; t.scale = nullptr; t.src0 = 0; t.dst0 = 0;
    if (s < 12) {
        const int l = s / 6, j = s % 6;
        t.W = l ? F.in[I_FOXWIN] : F.in[I_DNWIN]; t.K = DM; t.ldw = l ? FOX_IN : DN_IN; t.WT = (bf16*)(F.ws + (l ? WS_WIN1 : WS_WIN0)); t.scale = F.in[I_NORM1] + l * DM;
        const int qm0 = l ? 4104 : 4112, nsc = l ? 8 : 16;
        t.ncols = 1024;
        if (j == 0) { t.src0 = 1024; t.dst0 = PC_K; } else if (j == 1) { t.src0 = 2048; t.dst0 = PC_V; } else if (j == 2) { t.src0 = 3072; t.dst0 = PC_Z; }
        else if (j == 3) { t.src0 = 0; t.dst0 = PC_Q; } else if (j == 4) { t.src0 = qm0; t.dst0 = PC_QM; t.ncols = 512; } else { t.src0 = 4096; t.dst0 = PC_AB; t.ncols = nsc; }
    } else if (s < 14) { const int l = s - 12; t.W = F.in[I_WOUT] + (size_t)l * OUT_IN * DM; t.K = OUT_IN; t.ldw = DM; t.ncols = DM; t.WT = (bf16*)(F.ws + (l ? WS_WOUT1 : WS_WOUT0)); }
    else if (s < 16) { const int l = s - 14; t.W = F.in[I_WM1] + (size_t)l * DM * FF; t.K = DM; t.ldw = FF; t.ncols = FF; t.WT = (bf16*)(F.ws + (l ? WS_WM1_1 : WS_WM1_0)); t.scale = F.in[I_NORM2] + l * DM; }
    else if (s < 18) { const int l = s - 16; t.W = F.in[I_WM2] + (size_t)l * FF * DM; t.K = FF; t.ldw = DM; t.ncols = DM; t.WT = (bf16*)(F.ws + (l ? WS_WM2_1 : WS_WM2_0)); }
    else { t.W = F.in[I_WMKV]; t.K = DM; t.ldw = DM; t.ncols = DM; t.WT = (bf16*)(F.ws + WS_WMKV); t.scale = F.in[I_MEMNW]; }
    return t;
}
__device__ __forceinline__ int seg_items(const TSeg& t) { return (t.K / 64) * ((t.ncols + 63) / 64); }
__device__ __forceinline__ void tr_load(const TSeg& t, int item, int lane, f32x4 (&v)[16]) {
    const int nblk = (t.ncols + 63) / 64, kb = item / nblk, nb = item - kb * nblk, k0 = 64 * kb, n0 = 64 * nb;
    const int n4 = (lane & 15) * 4, kr = lane >> 4; const bool ok = (n0 + n4) < t.ncols;
    const float* p = t.W + (size_t)(k0 + kr) * t.ldw + t.src0 + n0 + n4;
#pragma unroll
    for (int i = 0; i < 16; ++i) v[i] = ok ? __builtin_nontemporal_load((const f32x4*)(p + (size_t)(4 * i) * t.ldw)) : (f32x4){0.f, 0.f, 0.f, 0.f};
}
__device__ __forceinline__ void tr_store(const TSeg& t, int item, int lane, const f32x4 (&v)[16], LAS float* scr) {
    const int nblk = (t.ncols + 63) / 64, kb = item / nblk, nb = item - kb * nblk, k0 = 64 * kb, n0 = 64 * nb;
    const int n4 = (lane & 15) * 4, kr = lane >> 4;
#pragma unroll
    for (int i = 0; i < 16; ++i) *(LAS f32x4*)(scr + (4 * i + kr) * 68 + n4) = v[i];
    LDS_WAIT(); asm volatile("" ::: "memory");
    const int c = lane & 7; f32x4 s0 = {1.f, 1.f, 1.f, 1.f}, s1 = s0;
    if (t.scale) { s0 = *(const f32x4*)(t.scale + k0 + 8 * c); s1 = *(const f32x4*)(t.scale + k0 + 8 * c + 4); }
#pragma unroll
    for (int j = 0; j < 8; ++j) { const int n = (lane >> 3) + 8 * j; const LAS float* q = scr + (8 * c) * 68 + n;
        v4u o; o.x = pkbf(q[0 * 68] * s0[0], q[1 * 68] * s0[1]); o.y = pkbf(q[2 * 68] * s0[2], q[3 * 68] * s0[3]); o.z = pkbf(q[4 * 68] * s1[0], q[5 * 68] * s1[1]); o.w = pkbf(q[6 * 68] * s1[2], q[7 * 68] * s1[3]);
        if (n0 + n < t.ncols) *(v4u*)(t.WT + (size_t)(t.dst0 + n0 + n) * t.K + k0 + 8 * c) = o; }
    LDS_WAIT(); asm volatile("" ::: "memory");
}
template <int NR> __device__ __forceinline__ void rows_to_bf16(int lane, const float* x, bf16* o, float* sq) {
    f32x4 v[NR][4];
#pragma unroll
    for (int r = 0; r < NR; ++r)
#pragma unroll
        for (int j = 0; j < 4; ++j) v[r][j] = __builtin_nontemporal_load((const f32x4*)(x + (size_t)r * DM) + lane + 64 * j);
#pragma unroll
    for (int r = 0; r < NR; ++r) { float s = 0.f;
#pragma unroll
        for (int j = 0; j < 4; ++j) s += (v[r][j].x * v[r][j].x + v[r][j].y * v[r][j].y) + (v[r][j].z * v[r][j].z + v[r][j].w * v[r][j].w);
        s = wave_sum(s);
        unsigned long long* o8 = (unsigned long long*)(o + (size_t)r * DM) + lane;
#pragma unroll
        for (int j = 0; j < 4; ++j) o8[64 * j] = (unsigned long long)pkbf(v[r][j].x, v[r][j].y) | ((unsigned long long)pkbf(v[r][j].z, v[r][j].w) << 32);
        if (lane < 16) sq[(size_t)r * 16 + lane] = lane == 0 ? s : 0.f; }
}
template <int S0, int S1> __device__ __forceinline__ void convert_weights(const Frame& F, LAS float* scr, int lane, int gw, int NGW, int base) {
#pragma unroll
    for (int s = S0; s < S1; ++s) {
        const TSeg t = get_seg(F, s); const int n = seg_items(t);
        int it = gw - (base % NGW); if (it < 0) it += NGW;
        f32x4 va[16], vb[16];
        if (it < n) tr_load(t, it, lane, va);
        while (it < n) {
            int nx = it + NGW; if (nx < n) tr_load(t, nx, lane, vb);
            tr_store(t, it, lane, va, scr); it = nx; if (it >= n) break;
            nx = it + NGW; if (nx < n) tr_load(t, nx, lane, va);
            tr_store(t, it, lane, vb, scr); it = nx;
        }
        base += n;
    }
}
__device__ __forceinline__ void p0_prologue(const Frame& F) {
    const Tix T = tix(F.wv);
    LAS float* scr = (LAS float*)(F.lds + T.wave * 17408);
    const int gw = F.bid * NWAVES + T.wave, NGW = F.G * NWAVES;
    for (int m = gw * 4; m < MROWS; m += NGW * 4) rows_to_bf16<4>(T.lane, F.in[I_X] + (size_t)m * DM, (bf16*)(F.ws + WS_XB) + (size_t)m * DM, (float*)(F.ws + WS_XSQ) + (size_t)m * 16);
    for (int m = gw; m < MMEM; m += NGW) rows_to_bf16<1>(T.lane, F.in[I_MEM] + (size_t)m * DM, (bf16*)((unsigned char*)F.out + DO_MEMB) + (size_t)m * DM, (float*)(F.ws + WS_MSQ) + (size_t)m * 16);
    convert_weights<0, 6>(F, scr, T.lane, gw, NGW, 0);
    convert_weights<18, 19>(F, scr, T.lane, gw, NGW, 1168);
}

typedef short dn_bf16x8 __attribute__((ext_vector_type(8)));
typedef unsigned dn_u32x2 __attribute__((ext_vector_type(2)));
__device__ __forceinline__ f32x4 mfma16(dn_bf16x8 a, dn_bf16x8 b, f32x4 c) { return __builtin_amdgcn_mfma_f32_16x16x32_bf16(a, b, c, 0, 0, 0); }
__device__ __forceinline__ f32x4 mfma4(float a, float b, f32x4 c) { return __builtin_amdgcn_mfma_f32_16x16x4f32(a, b, c, 0, 0, 0); }
__device__ __forceinline__ dn_bf16x8 pack8f(f32x4 x, f32x4 y) { v4u w; w.x = pkbf(x[0], x[1]); w.y = pkbf(x[2], x[3]); w.z = pkbf(y[0], y[1]); w.w = pkbf(y[2], y[3]); return __builtin_bit_cast(dn_bf16x8, w); }
__device__ __forceinline__ dn_u32x2 pack4f(f32x4 x) { dn_u32x2 w; w.x = pkbf(x[0], x[1]); w.y = pkbf(x[2], x[3]); return w; }
__device__ __forceinline__ unsigned short bf1(float x) { return (unsigned short)(pkbf(x, 0.f) & 0xffffu); }
constexpr size_t DO_QKS = 4 * MiB, DO_HALO = 20 * MiB, DO_EGL = 27 * MiB, DO_WNEG = 28 * MiB;
constexpr int P_RAW = 0, P_GB = 51712, P_QH = 53248, P_KH = 70656, P_VBT = 88064, P_KBGT = 106496, P_QKL = 124928, P_END = 134144;
constexpr int P_AT = 0, P_TB = 17408, P_PS = 26624, P_PS2 = 29184;
struct DnPre { v4u P[7]; float ga, gb; f32x4 cw[3][4]; };
__device__ __forceinline__ void dn_prep_load(const Frame& F, int u, DnPre& R) {
    const Tix T = tix(F.wv); const int tid = T.tid, lane = T.lane;
    const int bh = u >> 5, c = u & 31, b = bh >> 3, h = bh & 7; const size_t row0 = (size_t)b * SEQ + c * 64; const int gch = b * 32 + c;
    const bf16* proj = (const bf16*)(F.ws + WS_PROJ); const float* AB = (const float*)(F.ws + WS_AB); const bf16* halo = (const bf16*)((unsigned char*)F.out + DO_HALO);
#pragma unroll
    for (int j = 0; j < 7; ++j) { const int id = tid + 512 * j; v4u val = {0u, 0u, 0u, 0u};
        if (id < 67 * 48) { const int r = id / 48, rem = id - r * 48, seg = rem >> 4, ch = rem & 15;
            const int col = (seg == 0 ? PC_Q : seg == 1 ? PC_K : PC_V) + h * HD + ch * 8;
            if (r >= 3) val = *(const v4u*)(proj + (row0 + r - 3) * PW + col);
            else if (c > 0) val = *(const v4u*)(halo + ((size_t)(gch - 1) * 3 + r) * PW + col); }
        R.P[j] = val; }
    R.ga = AB[(row0 + lane) * 16 + h]; R.gb = AB[(row0 + lane) * 16 + 8 + h];
    const float* convw = F.in[I_DNCONV]; const int c4 = lane & 31;
#pragma unroll
    for (int seg = 0; seg < 3; ++seg)
#pragma unroll
        for (int j = 0; j < 4; ++j) R.cw[seg][j] = *(const f32x4*)(convw + j * 3072 + seg * 1024 + h * HD + 4 * c4);
}
__device__ __forceinline__ void dn_prep_unit(const Frame& F, int u, int u_next, DnPre& R) {
    const Tix T = tix(F.wv); const int tid = T.tid, lane = T.lane, wave = T.wave, m = lane & 15, g = lane >> 4;
    const int bh = u >> 5, c = u & 31, b = bh >> 3, h = bh & 7; const size_t row0 = (size_t)b * SEQ + c * 64;
    bf16* proj = (bf16*)(F.ws + WS_PROJ);
    bf16* xbimg = (bf16*)((unsigned char*)F.out + DO_WNEG) + (size_t)u * 8192; bf16* qks = (bf16*)((unsigned char*)F.out + DO_QKS) + (size_t)u * 4096; float* egl = (float*)((unsigned char*)F.out + DO_EGL);
    LAS unsigned char* L = F.lds; LAS float* GB = (LAS float*)(L + P_GB);
#pragma unroll
    for (int j = 0; j < 7; ++j) { const int id = tid + 512 * j;
        if (id < 67 * 48) { const int r = id / 48, rem = id - r * 48, seg = rem >> 4, ch = rem & 15; *(LAS v4u*)(L + P_RAW + r * 768 + seg * 256 + ch * 16) = R.P[j]; } }
    if (wave == 0) { const float a = R.ga, bb = R.gb;
        const float x = a + F.in[I_DNDT][h], sp = fmaxf(x, 0.f) + log1pf(__expf(-fabsf(x)));
        const float gt = -__expf(F.in[I_DNALOG][h]) * sp, beta = __builtin_amdgcn_rcpf(1.f + __expf(-bb));
        float gc = gt;
#pragma unroll
        for (int o = 1; o < 64; o <<= 1) { const float t = __shfl_up(gc, o); if (lane >= o) gc += t; }
        const float gl = __shfl(gc, 63);
        GB[lane] = gc; GB[64 + lane] = beta; GB[128 + lane] = beta * __expf(gc); GB[192 + lane] = __expf(gl - gc); GB[256 + lane] = __expf(gc);
        if (lane == 0) egl[u] = __expf(gl); }
    f32x4 cw[3][4];
#pragma unroll
    for (int seg = 0; seg < 3; ++seg)
#pragma unroll
        for (int j = 0; j < 4; ++j) cw[seg][j] = R.cw[seg][j];
    __syncthreads();
    if (u_next >= 0) dn_prep_load(F, u_next, R);
    { const int hf = lane >> 5, c4 = lane & 31;
#pragma unroll
      for (int jj = 0; jj < 12; ++jj) { constexpr int dummy_ = 0; (void)dummy_; const int seg = jj >> 2;
        const int wi = wave + 8 * jj, i = 2 * (wi & 31) + hf;
        f32x4 y = {0.f, 0.f, 0.f, 0.f};
#pragma unroll
        for (int j = 0; j < 4; ++j) { const f32x4 w = cw[seg][j];
            const dn_u32x2 xx = *(const LAS dn_u32x2*)(L + P_RAW + (i + j) * 768 + seg * 256 + c4 * 8);
            y[0] += w[0] * bflo(xx.x); y[1] += w[1] * bfhi(xx.x); y[2] += w[2] * bflo(xx.y); y[3] += w[3] * bfhi(xx.y); }
        f32x4 s;
#pragma unroll
        for (int e = 0; e < 4; ++e) s[e] = y[e] * __builtin_amdgcn_rcpf(1.f + __expf(-y[e]));
        if (seg < 2) { float ss = (s[0] * s[0] + s[1] * s[1]) + (s[2] * s[2] + s[3] * s[3]);
            ss = add_xor16(row16_sum(ss));
            const float r = rsqrtf(ss + EPS) * (seg == 0 ? QSCALE : 1.f);
            s = s * r;
            *(LAS dn_u32x2*)(L + (seg == 0 ? P_QH : P_KH) + i * 272 + c4 * 8) = pack4f(s);
            if (seg == 0) { const int cc = c4 & 7, p0 = cc < 4 ? 8 * cc : 8 * (cc - 4) + 4;
                *(dn_u32x2*)(proj + (row0 + i) * PW + PC_Q + h * HD + 32 * (c4 >> 3) + p0) = pack4f(s * GB[256 + i]); }
            else { const float bge = GB[128 + i];
#pragma unroll
                for (int e = 0; e < 4; ++e) *(LAS unsigned short*)(L + P_KBGT + (4 * c4 + e) * 144 + i * 2) = bf1(s[e] * bge); } }
        else { const float be = GB[64 + i];
#pragma unroll
            for (int e = 0; e < 4; ++e) *(LAS unsigned short*)(L + P_VBT + (4 * c4 + e) * 144 + i * 2) = bf1(s[e] * be); } } }
    __syncthreads();
    LAS float* AT = (LAS float*)(L + P_AT);
#pragma unroll
    for (int q = 0; q < 2; ++q) { const int tt = wave + 8 * q, it = tt >> 2, jt = tt & 3;
        f32x4 kk = {0.f, 0.f, 0.f, 0.f}, qk = {0.f, 0.f, 0.f, 0.f};
        if (jt <= it) {
#pragma unroll
            for (int kq = 0; kq < 4; ++kq) { const dn_bf16x8 bk = *(const LAS dn_bf16x8*)(L + P_KH + (16 * jt + m) * 272 + (32 * kq + 8 * g) * 2);
                const dn_bf16x8 ak = *(const LAS dn_bf16x8*)(L + P_KH + (16 * it + m) * 272 + (32 * kq + 8 * g) * 2), aq = *(const LAS dn_bf16x8*)(L + P_QH + (16 * it + m) * 272 + (32 * kq + 8 * g) * 2);
                kk = mfma16(ak, bk, kk); qk = mfma16(aq, bk, qk); } }
        const int j = 16 * jt + m, jl = j & 31, p = jl < 16 ? 8 * (jl >> 2) + (jl & 3) : 8 * ((jl - 16) >> 2) + 4 + (jl & 3);
        const float gcj = GB[j];
#pragma unroll
        for (int r = 0; r < 4; ++r) { const int i = 16 * it + 4 * g + r; const float dec = i >= j ? __expf(GB[i] - gcj) : 0.f;
            AT[i * 68 + j] = i > j ? GB[64 + i] * kk[r] * dec : 0.f;
            *(LAS unsigned short*)(L + P_QKL + i * 144 + (32 * (j >> 5) + p) * 2) = bf1(qk[r] * dec); } }
    __syncthreads();
    if (wave >= 4) { const int t4 = tid - 256;
        for (int id = t4; id < 1024; id += 256) { const int k = id >> 3, sp = (id >> 2) & 1, gg = id & 3; float o8[8];
#pragma unroll
            for (int j = 0; j < 8; ++j) { const int cc = 32 * sp + (j < 4 ? 4 * gg + j : 16 + 4 * gg + j - 4);
                o8[j] = bflo((unsigned)*(const LAS unsigned short*)(L + P_KH + cc * 272 + k * 2)) * GB[192 + cc]; }
            v4u w; w.x = pkbf(o8[0], o8[1]); w.y = pkbf(o8[2], o8[3]); w.z = pkbf(o8[4], o8[5]); w.w = pkbf(o8[6], o8[7]);
            *(v4u*)(proj + (row0 + (k >> 1)) * PW + PC_K + h * HD + (k & 1) * 64 + 32 * sp + 8 * gg) = w; }
        for (int id = t4; id < 512; id += 256) { const int i = id >> 3, j8 = (id & 7) * 8;
            *(v4u*)(qks + i * 64 + j8) = *(const LAS v4u*)(L + P_QKL + i * 144 + j8 * 2); } }
    if (wave == 0) { const int bb = g, j = m; float X[16];
        X[0] = j == 0 ? 1.f : 0.f;
#pragma unroll
        for (int i = 1; i < 16; ++i) { const LAS float* Lr = AT + (16 * bb + i) * 68 + 16 * bb; float Lv[16];
#pragma unroll
            for (int q = 0; q < (i + 3) / 4; ++q) { const f32x4 t = *(const LAS f32x4*)(Lr + 4 * q); Lv[4 * q] = t[0]; Lv[4 * q + 1] = t[1]; Lv[4 * q + 2] = t[2]; Lv[4 * q + 3] = t[3]; }
            float acc = i == j ? 1.f : 0.f;
#pragma unroll
            for (int mm = 0; mm < i; ++mm) acc -= Lv[mm] * X[mm];
            X[i] = acc; }
#pragma unroll
        for (int i = 0; i < 16; ++i) AT[(16 * bb + i) * 68 + 16 * bb + j] = X[i]; }
    __syncthreads();
    if (wave < 2) { const int lo = 2 * wave, hi = 2 * wave + 1; LAS float* PS = (LAS float*)(L + P_PS) + wave * 320;
        f32x4 acc = {0.f, 0.f, 0.f, 0.f};
#pragma unroll
        for (int s = 0; s < 4; ++s) acc = mfma4(AT[(16 * hi + m) * 68 + 16 * lo + 4 * s + g], AT[(16 * lo + 4 * s + g) * 68 + 16 * lo + m], acc);
#pragma unroll
        for (int r = 0; r < 4; ++r) PS[(4 * g + r) * 20 + m] = acc[r];
        LDS_WAIT();
        f32x4 acc2 = {0.f, 0.f, 0.f, 0.f};
#pragma unroll
        for (int s = 0; s < 4; ++s) acc2 = mfma4(AT[(16 * hi + m) * 68 + 16 * hi + 4 * s + g], PS[(4 * s + g) * 20 + m], acc2);
#pragma unroll
        for (int r = 0; r < 4; ++r) AT[(16 * hi + 4 * g + r) * 68 + 16 * lo + m] = -acc2[r]; }
    __syncthreads();
    { LAS float* PS2 = (LAS float*)(L + P_PS2); const int ti = (wave >> 1) & 1, tj = wave & 1;
      if (wave < 4) { f32x4 acc = {0.f, 0.f, 0.f, 0.f};
#pragma unroll
          for (int s = 0; s < 8; ++s) acc = mfma4(AT[(32 + 16 * ti + m) * 68 + 4 * s + g], AT[(4 * s + g) * 68 + 16 * tj + m], acc);
#pragma unroll
          for (int r = 0; r < 4; ++r) PS2[(16 * ti + 4 * g + r) * 36 + 16 * tj + m] = acc[r]; }
      __syncthreads();
      if (wave < 4) { f32x4 acc = {0.f, 0.f, 0.f, 0.f};
#pragma unroll
          for (int s = 0; s < 8; ++s) acc = mfma4(AT[(32 + 16 * ti + m) * 68 + 32 + 4 * s + g], PS2[(4 * s + g) * 36 + 16 * tj + m], acc);
#pragma unroll
          for (int r = 0; r < 4; ++r) AT[(32 + 16 * ti + 4 * g + r) * 68 + 16 * tj + m] = -acc[r]; } }
    __syncthreads();
    { const int i = tid >> 3, j0 = (tid & 7) * 8; const f32x4 t0 = *(const LAS f32x4*)(AT + i * 68 + j0), t1 = *(const LAS f32x4*)(AT + i * 68 + j0 + 4);
      v4u w; w.x = pkbf(t0[0], t0[1]); w.y = pkbf(t0[2], t0[3]); w.z = pkbf(t1[0], t1[1]); w.w = pkbf(t1[2], t1[3]);
      *(LAS v4u*)(L + P_TB + i * 144 + j0 * 2) = w; }
    __syncthreads();
#pragma unroll
    for (int q = 0; q < 8; ++q) { const int tt = wave + 8 * q; f32x4 acc = {0.f, 0.f, 0.f, 0.f};
        if (tt < 32) { const int ct = tt >> 3, nt = tt & 7;
#pragma unroll
            for (int sp = 0; sp < 2; ++sp) acc = mfma16(*(const LAS dn_bf16x8*)(L + P_TB + (16 * ct + m) * 144 + (32 * sp + 8 * g) * 2), *(const LAS dn_bf16x8*)(L + P_VBT + (16 * nt + m) * 144 + (32 * sp + 8 * g) * 2), acc);
            const int v = 16 * nt + m;
            *(dn_u32x2*)(proj + (row0 + (v >> 1)) * PW + PC_V + h * HD + (v & 1) * 64 + 16 * ct + 4 * g) = pack4f(acc); }
        else { const int t2 = tt - 32, kt = t2 >> 2, ct = t2 & 3;
#pragma unroll
            for (int sp = 0; sp < 2; ++sp) acc = mfma16(*(const LAS dn_bf16x8*)(L + P_KBGT + (16 * kt + m) * 144 + (32 * sp + 8 * g) * 2), *(const LAS dn_bf16x8*)(L + P_TB + (16 * ct + m) * 144 + (32 * sp + 8 * g) * 2), acc);
            *(dn_u32x2*)(xbimg + (16 * ct + m) * 128 + 32 * (kt >> 1) + 8 * g + 4 * (kt & 1)) = pack4f(-acc); } }
    __syncthreads();
}
constexpr int S_WN = 0, S_QG = 17408, S_KDT = 34816, S_QKM = 53248, S_UT = 62464, S_OB = 80896, S_PSQ = 114688, S_ONW = 116736, S_Z = 117248, S_END = 152064;
static_assert(S_END <= MISC_OFF, "scan LDS map");
__device__ __forceinline__ void dn_scan_unit(const Frame& F, int bh) {
    const Tix T = tix(F.wv); const int tid = T.tid, lane = T.lane, wave = T.wave, m = lane & 15, g = lane >> 4, n0 = 32 * wave;
    const int b = bh >> 3, h = bh & 7;
    bf16* proj = (bf16*)(F.ws + WS_PROJ); const bf16* xbi = (const bf16*)((const unsigned char*)F.out + DO_WNEG); const bf16* qks = (const bf16*)((unsigned char*)F.out + DO_QKS); const float* egl = (const float*)((unsigned char*)F.out + DO_EGL);
    LAS unsigned char* L = F.lds;
    LAS float* OB = (LAS float*)(L + S_OB);
    constexpr int NC = SEQ / 64;
#define WGBAR() do { asm volatile("s_waitcnt lgkmcnt(0)" ::: "memory"); __builtin_amdgcn_s_barrier(); asm volatile("" ::: "memory"); } while (0)
    if (wave >= 4) {
        const int ht = tid - 256;
        const unsigned lo_lin = (unsigned)ht * 16u;
        const unsigned lo_qg = (unsigned)(((ht >> 4) * PW + (ht & 15) * 8) * 2);
        const unsigned lo_kv = (unsigned)(((ht >> 4) * PW + ((ht >> 3) & 1) * 64 + (ht & 7) * 8) * 2);
        const unsigned ld_a = (unsigned)((ht >> 4) * 272 + (ht & 15) * 16), ld_b = (unsigned)((ht >> 3) * 144 + (ht & 7) * 16);
        const unsigned lo_fin = (unsigned)(((ht >> 2) * PW + (ht & 3) * 32) * 2);
        v4u RP[12], RQ[10];
#define DN_LOAD_P(cc) do { const size_t r0_ = (size_t)b * SEQ + (cc) * 64; const size_t u_ = (size_t)bh * 32 + (cc);               \
        _Pragma("unroll") for (int j_ = 0; j_ < 4; ++j_) {                                                                                                \
            RP[j_] = *(const v4u*)((const char*)(xbi + u_ * 8192 + 2048 * j_) + lo_lin);                                                                    \
            RP[4 + j_] = *(const v4u*)((const char*)(proj + (r0_ + 16 * j_) * PW + PC_Q + h * HD) + lo_qg);                                                 \
            RP[8 + j_] = *(const v4u*)((const char*)(proj + (r0_ + 16 * j_) * PW + PC_V + h * HD) + lo_kv); } } while (0)
#define DN_LOAD_Q(cc) do { const size_t r0_ = (size_t)b * SEQ + (cc) * 64; const size_t u_ = (size_t)bh * 32 + (cc);     \
        _Pragma("unroll") for (int j_ = 0; j_ < 4; ++j_) {                                                                                                \
            RQ[j_] = *(const v4u*)((const char*)(proj + (r0_ + 16 * j_) * PW + PC_K + h * HD) + lo_kv);                                                     \
            RQ[4 + j_] = *(const v4u*)((const char*)(proj + (r0_ + 16 * j_) * PW + PC_Z + h * HD) + lo_qg); }                                               \
        _Pragma("unroll") for (int j_ = 0; j_ < 2; ++j_) RQ[8 + j_] = *(const v4u*)((const char*)(qks + u_ * 4096 + 2048 * j_) + lo_lin); } while (0)
#define DN_WRITE_P() do { _Pragma("unroll") for (int j_ = 0; j_ < 4; ++j_) {                                                                               \
            *(LAS v4u*)(L + S_WN + ld_a + j_ * 4352) = RP[j_]; *(LAS v4u*)(L + S_QG + ld_a + j_ * 4352) = RP[4 + j_]; *(LAS v4u*)(L + S_UT + ld_b + j_ * 4608) = RP[8 + j_]; } } while (0)
#define DN_WRITE_Q(cc) do { _Pragma("unroll") for (int j_ = 0; j_ < 4; ++j_) { *(LAS v4u*)(L + S_KDT + ld_b + j_ * 4608) = RQ[j_];                         \
            *(LAS v4u*)(L + S_Z + ((cc) & 1) * 17408 + ld_a + j_ * 4352) = RQ[4 + j_]; }                                                                    \
        _Pragma("unroll") for (int j_ = 0; j_ < 2; ++j_) *(LAS v4u*)(L + S_QKM + ld_b + j_ * 4608) = RQ[8 + j_]; } while (0)
#define DN_FINAL(cc) do { const int fr_ = ht >> 2, fc_ = (ht & 3) * 32; float ss_ = 0.f;     \
        _Pragma("unroll") for (int p_ = 0; p_ < 8; ++p_) { const f32x4 o_ = *(const LAS f32x4*)(OB + fr_ * 132 + fc_ + 4 * p_);                              \
            ss_ += (o_[0] * o_[0] + o_[1] * o_[1]) + (o_[2] * o_[2] + o_[3] * o_[3]); }                                                                     \
        ss_ += dppf<0xB1>(ss_); ss_ += dppf<0x4E>(ss_);                                                                                                     \
        const float rn_ = rsqrtf(ss_ * (1.f / 128.f) + EPS);                                                                                               \
        bf16* dst_ = (bf16*)((char*)(proj + ((size_t)b * SEQ + (cc) * 64) * PW + PC_Q + h * HD) + lo_fin);              \
        _Pragma("unroll") for (int p_ = 0; p_ < 4; ++p_) {                                                                                                 \
            const f32x4 oa_ = *(const LAS f32x4*)(OB + fr_ * 132 + fc_ + 8 * p_), ob_ = *(const LAS f32x4*)(OB + fr_ * 132 + fc_ + 8 * p_ + 4);             \
            const v4u z_ = *(const LAS v4u*)(L + S_Z + ((cc) & 1) * 17408 + fr_ * 272 + (fc_ + 8 * p_) * 2);                                                \
            v4u w_; w_.x = pkbf(oa_[0] * rn_ * bflo(z_.x), oa_[1] * rn_ * bfhi(z_.x)); w_.y = pkbf(oa_[2] * rn_ * bflo(z_.y), oa_[3] * rn_ * bfhi(z_.y));   \
            w_.z = pkbf(ob_[0] * rn_ * bflo(z_.z), ob_[1] * rn_ * bfhi(z_.z)); w_.w = pkbf(ob_[2] * rn_ * bflo(z_.w), ob_[3] * rn_ * bfhi(z_.w));           \
            *(v4u*)(dst_ + 8 * p_) = w_; } } while (0)
        DN_LOAD_P(0); DN_LOAD_Q(0); DN_WRITE_P(); DN_WRITE_Q(0); DN_LOAD_P(1); DN_LOAD_Q(1);
        WGBAR();
        for (int c = 0; c < NC; ++c) {
            if (c > 0) { DN_FINAL(c - 1); DN_WRITE_Q(c); if (c + 1 < NC) DN_LOAD_Q(c + 1); }
            WGBAR();
            if (c + 1 < NC) { DN_WRITE_P(); if (c + 2 < NC) DN_LOAD_P(c + 2); }
            WGBAR();
        }
        DN_FINAL(NC - 1);
#undef DN_LOAD_P
#undef DN_LOAD_Q
#undef DN_WRITE_P
#undef DN_WRITE_Q
#undef DN_FINAL
    } else {
        f32x4 Sacc[2][8];
#pragma unroll
        for (int kt = 0; kt < 8; ++kt) { Sacc[0][kt] = (f32x4){0.f, 0.f, 0.f, 0.f}; Sacc[1][kt] = (f32x4){0.f, 0.f, 0.f, 0.f}; }
        const unsigned* eglu = (const unsigned*)egl + (size_t)bh * 32;
        float eg_next = __uint_as_float(__hip_atomic_load(eglu, __ATOMIC_RELAXED, __HIP_MEMORY_SCOPE_AGENT));
        const LAS unsigned char* fa = L + m * 272 + g * 16;
        const LAS unsigned char* fb = L + m * 144 + g * 16;
#define SBAR() __builtin_amdgcn_sched_barrier(0)
#define LD_A(X, base, ct) do { _Pragma("unroll") for (int s_ = 0; s_ < 4; ++s_) X[s_] = *(const LAS dn_bf16x8*)(fa + (base) + (ct) * 4352 + s_ * 64); } while (0)
#define LD_B(X, base, i0) do { _Pragma("unroll") for (int s_ = 0; s_ < 4; ++s_) X[s_] = *(const LAS dn_bf16x8*)(fb + (base) + ((i0) + (s_ >> 1)) * 2304 + (s_ & 1) * 64); } while (0)
        WGBAR();
        for (int c = 0; c < NC; ++c) {
            const float eg = eg_next;
            if (c + 1 < NC) eg_next = __uint_as_float(__hip_atomic_load(eglu + c + 1, __ATOMIC_RELAXED, __HIP_MEMORY_SCOPE_AGENT));
            dn_bf16x8 SB[2][4], X0[4], X1[4];
            LD_A(X0, S_WN, 0);
#pragma unroll
            for (int sl = 0; sl < 2; ++sl)
#pragma unroll
                for (int s = 0; s < 4; ++s) SB[sl][s] = pack8f(Sacc[sl][2 * s], Sacc[sl][2 * s + 1]);
            f32x4 VN[2][4], O[2][4];
#pragma unroll
            for (int ct = 0; ct < 4; ++ct)
#pragma unroll
                for (int sl = 0; sl < 2; ++sl) { const dn_u32x2 uu = *(const LAS dn_u32x2*)(L + S_UT + (n0 + 16 * sl + m) * 144 + (16 * ct + 4 * g) * 2);
                    VN[sl][ct] = (f32x4){bflo(uu.x), bfhi(uu.x), bflo(uu.y), bfhi(uu.y)}; O[sl][ct] = (f32x4){0.f, 0.f, 0.f, 0.f}; }
#pragma unroll
            for (int ct = 0; ct < 4; ++ct) {
                SBAR(); LD_A(X1, S_QG, ct); SBAR();
#pragma unroll
                for (int s = 0; s < 4; ++s) { VN[0][ct] = mfma16(X0[s], SB[0][s], VN[0][ct]); VN[1][ct] = mfma16(X0[s], SB[1][s], VN[1][ct]); }
                SBAR(); if (ct < 3) LD_A(X0, S_WN, ct + 1); SBAR();
#pragma unroll
                for (int s = 0; s < 4; ++s) { O[0][ct] = mfma16(X1[s], SB[0][s], O[0][ct]); O[1][ct] = mfma16(X1[s], SB[1][s], O[1][ct]); }
            }
            dn_bf16x8 VNB[2][2];
#pragma unroll
            for (int sl = 0; sl < 2; ++sl)
#pragma unroll
                for (int sp = 0; sp < 2; ++sp) VNB[sl][sp] = pack8f(VN[sl][2 * sp], VN[sl][2 * sp + 1]);
            WGBAR();
            SBAR(); LD_B(X0, S_QKM, 0); LD_B(X1, S_QKM, 2); SBAR();
#pragma unroll
            for (int s = 0; s < 4; ++s) { O[0][s >> 1] = mfma16(X0[s], VNB[0][s & 1], O[0][s >> 1]); O[1][s >> 1] = mfma16(X0[s], VNB[1][s & 1], O[1][s >> 1]); }
            SBAR(); LD_B(X0, S_KDT, 0); SBAR();
#pragma unroll
            for (int s = 0; s < 4; ++s) { O[0][2 + (s >> 1)] = mfma16(X1[s], VNB[0][s & 1], O[0][2 + (s >> 1)]); O[1][2 + (s >> 1)] = mfma16(X1[s], VNB[1][s & 1], O[1][2 + (s >> 1)]); }
#pragma unroll
            for (int kt = 0; kt < 8; ++kt) { Sacc[0][kt] = Sacc[0][kt] * eg; Sacc[1][kt] = Sacc[1][kt] * eg; }
#pragma unroll
            for (int q = 0; q < 4; ++q) {
                if (q & 1) { SBAR(); if (q < 3) LD_B(X0, S_KDT, 2 * q + 2); SBAR();
#pragma unroll
                    for (int s = 0; s < 4; ++s) { Sacc[0][2 * q + (s >> 1)] = mfma16(X1[s], VNB[0][s & 1], Sacc[0][2 * q + (s >> 1)]); Sacc[1][2 * q + (s >> 1)] = mfma16(X1[s], VNB[1][s & 1], Sacc[1][2 * q + (s >> 1)]); } }
                else { SBAR(); LD_B(X1, S_KDT, 2 * q + 2); SBAR();
#pragma unroll
                    for (int s = 0; s < 4; ++s) { Sacc[0][2 * q + (s >> 1)] = mfma16(X0[s], VNB[0][s & 1], Sacc[0][2 * q + (s >> 1)]); Sacc[1][2 * q + (s >> 1)] = mfma16(X0[s], VNB[1][s & 1], Sacc[1][2 * q + (s >> 1)]); } }
            }
#pragma unroll
            for (int sl = 0; sl < 2; ++sl)
#pragma unroll
                for (int ct = 0; ct < 4; ++ct)
#pragma unroll
                    for (int r = 0; r < 4; ++r) OB[(16 * ct + 4 * g + r) * 132 + n0 + 16 * sl + m] = O[sl][ct][r];
            WGBAR();
        }
#undef SBAR
#undef LD_A
#undef LD_B
    }
#undef WGBAR
}
__device__ __forceinline__ void fox_blk(const Frame& F, int it, int j, att::Blk& k) {
    const int bh = it >> 2, y = it & 3, qb = j == 0 ? y : 7 - y, b = bh >> 3, h = bh & 7; const size_t row0 = (size_t)b * SEQ + qb * 256;
    bf16* proj = (bf16*)(F.ws + WS_PROJ);
    k.Q = proj + row0 * PW + PC_Q + h * HD; k.K = proj + (size_t)b * SEQ * PW + PC_K + h * HD; k.voff = PC_V - PC_K; k.goff = PC_Z - PC_Q;
    k.flog = (const float*)(F.ws + WS_AB) + (size_t)b * SEQ * 16 + h; k.fb = F.in[I_FOXFB][h]; k.P0 = qb * 256; k.skv = SEQ; k.kvpitch = PW;
}
__device__ __forceinline__ void mem_blk(const Frame& F, int idx, att::Blk& k) {
    const int b = idx >> 5, hm = (idx >> 3) & 3, qb = idx & 7; const size_t row0 = (size_t)b * SEQ + qb * 256;
    bf16* proj = (bf16*)(F.ws + WS_PROJ); const bf16* mkv = (const bf16*)(F.ws + WS_MEMKV);
    static_assert(att::QP == PW, "attention Q pitch");
    k.Q = proj + row0 * PW + PC_QM + hm * HD; k.K = mkv + (size_t)b * NMEM * DM + hm * HD; k.voff = 512; k.goff = 0;
    k.flog = nullptr; k.fb = 0.f; k.P0 = 1 << 20; k.skv = NMEM; k.kvpitch = DM;
}
struct SrcL1 { const Frame* F; int vcu;
    __device__ __forceinline__ bool operator()(int n, att::Blk& k) const { const int it = vcu + (n / 3) * F->G, j = n % 3; if (it >= 256) return false;
        if (j < 2) fox_blk(*F, it, j, k); else mem_blk(*F, it, k); return true; } };
struct SrcL0 { const Frame* F; int first, stride;
    __device__ __forceinline__ bool operator()(int n, att::Blk& k) const { const int idx = first + n * stride; if (idx >= 256) return false; mem_blk(*F, idx, k); return true; } };
__device__ __forceinline__ void narrow_ab_unit(const Frame& F, int pm) {
    const Tix T = tix(F.wv); const int lane = T.lane, wave = T.wave, m = lane & 15, g = lane >> 4;
    const bf16* A = (const bf16*)(F.ws + WS_XB) + (size_t)(pm * 256 + 32 * wave + m) * DM + 8 * g; const bf16* B = (const bf16*)(F.ws + WS_WIN0) + (size_t)(PC_AB + m) * DM + 8 * g;
    f32x4 acc0 = {0.f, 0.f, 0.f, 0.f}, acc1 = acc0;
#pragma unroll 8
    for (int s = 0; s < DM / 32; ++s) { const dn_bf16x8 b = *(const dn_bf16x8*)(B + 32 * s);
        acc0 = mfma16(*(const dn_bf16x8*)(A + 32 * s), b, acc0); acc1 = mfma16(*(const dn_bf16x8*)(A + (size_t)16 * DM + 32 * s), b, acc1); }
    const float* xsq = (const float*)(F.ws + WS_XSQ); float* ab = (float*)(F.ws + WS_AB);
#pragma unroll
    for (int rt = 0; rt < 2; ++rt)
#pragma unroll
        for (int r = 0; r < 4; ++r) { const size_t row = (size_t)pm * 256 + 32 * wave + 16 * rt + 4 * g + r; const float* q = xsq + row * 16;
            const f32x4 t = (*(const f32x4*)q + *(const f32x4*)(q + 4)) + (*(const f32x4*)(q + 8) + *(const f32x4*)(q + 12));
            ab[row * 16 + m] = (rt ? acc1[r] : acc0[r]) * rsqrtf(((t[0] + t[1]) + (t[2] + t[3])) * (1.0f / 1024.0f) + EPS); }
}
constexpr int CW_SHD = 196608;
__device__ __forceinline__ void shadow_barrier(const Frame& F, unsigned want) {
    asm volatile("s_waitcnt vmcnt(0)" ::: "memory");
    __syncthreads();
    if (F.wv == 0 && lane_id() == 0) { unsigned* p = (unsigned*)((gu32*)(F.ws + WS_CTL) + CW_SHD);
        __builtin_amdgcn_fence(__ATOMIC_RELEASE, "agent"); asm volatile("s_waitcnt vmcnt(0)" ::: "memory");
        (void)__hip_atomic_fetch_add(p, 1u, __ATOMIC_RELAXED, __HIP_MEMORY_SCOPE_AGENT);
        unsigned sp = 0;
        while (__hip_atomic_load(p, __ATOMIC_RELAXED, __HIP_MEMORY_SCOPE_AGENT) < want) { __builtin_amdgcn_s_sleep(2); if (++sp > (1u << 22)) { atomicAdd((unsigned*)((gu32*)(F.ws + WS_CTL) + CW_BAR) + XB_TMO, 1u); break; } }
        __builtin_amdgcn_fence(__ATOMIC_ACQUIRE, "agent"); asm volatile("s_waitcnt vmcnt(0)" ::: "memory"); }
    __syncthreads();
}
#define IN(k) (lo <= (k) && (k) < hi)
#define SEAM(k) do { if (IN(k) && IN((k) + 1)) xcd_barrier(bar); } while (0)
#define SEAMG(k, s_) do { if (IN(k) && IN((k) + 1)) { if (gb.on) grp_barrier(gb, (s_)); else xcd_barrier(bar); } } while (0)
template <int layer> __device__ __forceinline__ void layer_body(const Frame& F, const XcdBarrier& bar, GrpBar& gb, bool grp_try, int lo, int hi, unsigned char* lds) {
    bf16* proj = (bf16*)(F.ws + WS_PROJ); bf16* xb = (bf16*)(F.ws + WS_XB); float* xsq = (float*)(F.ws + WS_XSQ);
    float* ab = (float*)(F.ws + WS_AB);

        const int pb = 1 + (layer ? 6 : 0);
        if (IN(pb)) {
            pg8::Gemm g{xb, (const bf16*)(F.ws + (layer ? WS_WIN1 : WS_WIN0)), MROWS, layer ? N_IN : 4096, DM, DM}; pg8::StaticOrder S; S.init(MROWS, layer ? N_IN : 4096, F.G, F.bid);
            const float* nk = layer ? F.in[I_FOXKNW] : nullptr; const float* nq = layer ? F.in[I_FOXQNW] : nullptr;
            pg8::EpiProj<true, false, layer == 0> E{proj, PW, xsq, ab, 18, (bf16*)((unsigned char*)F.out + DO_HALO), 0, layer ? 4 : 0, nk, 12, layer ? 16 : 12, nq, 16, 18, F.in[I_MEMQNW] + layer * HD, 8, 12, layer ? 2 : 1, F.in[I_DNONW]};
            pg8::gemm_phase<pg8::EpiProj<true, false, layer == 0>, pg8::StaticOrder, true, true>(F.lds, g, S, E, F.wv);
            if (layer == 0 && F.bid < 64) { __syncthreads(); narrow_ab_unit(F, 8 * (F.bid & 7) + ((F.bid >> 3) & 7)); }
        }
        SEAM(pb);
        if (layer == 0 && grp_try) gb.on = __hip_atomic_load((unsigned*)((gu32*)(F.ws + WS_CTL) + CW_BAD), __ATOMIC_RELAXED, __HIP_MEMORY_SCOPE_AGENT) == 0u;
        const int pm = pb + (layer ? 1 : 2);
        if (layer == 0) {
            if (IN(pb + 1)) { constexpr int NU = BATCH * NH * (SEQ / 64); DnPre R; int u = F.bid; if (u < NU) dn_prep_load(F, u, R);
                              for (; u < NU; u += F.G) dn_prep_unit(F, u, u + F.G < NU ? u + F.G : -1, R); }
            SEAM(pb + 1);
        }
        if (IN(pm)) {
            if (layer == 0) {
                if (F.bid < 64) dn_scan_unit(F, F.bid);
                else {
                    { const pg8::StrideUnits Sq{F.bid - 64, F.G - 64, 128, 1};
                      pg8::Gemm g{xb, (const bf16*)(F.ws + WS_WIN0), MROWS, N_IN, DM, DM};
                      pg8::EpiProj<true, false> E{proj, PW, xsq, nullptr, 18, nullptr, 0, 0, nullptr, 0, 0, nullptr, 16, 18, F.in[I_MEMQNW], 0, 0, 0, nullptr};
                      pg8::gemm_phase<pg8::EpiProj<true, false>, pg8::StrideUnits, true, true>(F.lds, g, Sq, E, F.wv);
                      const pg8::StrideUnits Sm{F.G - 1 - F.bid, F.G - 64, 32, 0};
                      pg8::Gemm g2{(const bf16*)((unsigned char*)F.out + DO_MEMB), (const bf16*)(F.ws + WS_WMKV), MMEM, DM, DM, DM};
                      pg8::EpiProj<true, false> E2{(bf16*)(F.ws + WS_MEMKV), DM, (const float*)(F.ws + WS_MSQ), nullptr, 4, nullptr, 0, 2, F.in[I_MEMKNW], 0, 0, nullptr, 0, 0, nullptr, 0, 0, 0, nullptr};
                      pg8::gemm_phase<pg8::EpiProj<true, false>, pg8::StrideUnits, true, true>(F.lds, g2, Sm, E2, F.wv); }
                    shadow_barrier(F, (unsigned)(F.G - 64));
                    const SrcL0 src{&F, F.bid - 64, F.G - 64}; att::phase((char*)lds, src, F.wv);
                    __syncthreads();
                    const Tix T = tix(F.wv); convert_weights<6, 18>(F, (LAS float*)(F.lds + T.wave * 17408), T.lane, (F.bid - 64) * NWAVES + T.wave, (F.G - 64) * NWAVES, 0); }
            } else {
                const int vcu = (F.G % 8 == 0) ? (F.bid % 8) * (F.G / 8) + F.bid / 8 : F.bid;
                const SrcL1 src{&F, vcu}; att::phase((char*)lds, src, F.wv);
            }
            __syncthreads();
        }
        SEAM(pm);
        if (IN(pm + 1)) {
            pg8::Gemm g{proj + PC_Q, (const bf16*)(F.ws + (layer ? WS_WOUT1 : WS_WOUT0)), MROWS, DM, OUT_IN, PW}; pg8::StaticOrder S; S.init(MROWS, DM, F.G, F.bid);
            pg8::EpiRes<false> E{xb, F.out, xsq, nullptr};
            pg8::gemm_phase<pg8::EpiRes<false>, pg8::StaticOrder, true, true>(F.lds, g, S, E, F.wv);
        }
        SEAMG(pm + 1, layer * 3 + 0);
        if (IN(pm + 2)) {
            pg8::Gemm g{xb, (const bf16*)(F.ws + (layer ? WS_WM1_1 : WS_WM1_0)), MROWS, FF, DM, DM}; pg8::StaticOrder S; S.init(MROWS, FF, F.G, F.bid);
            pg8::EpiProj<false, true> E{proj, FF, xsq, nullptr, 16, nullptr, 0, 0, nullptr, 0, 0, nullptr, 0, 0, nullptr, 0, 0, 0, nullptr};
            pg8::gemm_phase<pg8::EpiProj<false, true>, pg8::StaticOrder, true, true>(F.lds, g, S, E, F.wv);
        }
        SEAMG(pm + 2, layer * 3 + 1);
        if (IN(pm + 3)) {
            pg8::Gemm g{proj, (const bf16*)(F.ws + (layer ? WS_WM2_1 : WS_WM2_0)), MROWS, DM, FF, FF}; pg8::StaticOrder S; S.init(MROWS, DM, F.G, F.bid);
            pg8::EpiRes<layer == 1> E{xb, F.out, xsq, nullptr};
            pg8::gemm_phase<pg8::EpiRes<layer == 1>, pg8::StaticOrder, true, true>(F.lds, g, S, E, F.wv);
        }
        if (layer == 0) SEAMG(pm + 3, 2); else SEAM(pm + 3);
    }
#undef IN
#undef SEAM
#undef SEAMG
__global__ void __launch_bounds__(NWAVES * 64, 2) hyb_fwd(Args args) {
    extern __shared__ __attribute__((aligned(16))) unsigned char lds[];
    Frame F;
    F.lds = (LAS unsigned char*)lds;
    F.G = gridDim.x; F.bid = blockIdx.x; F.in = args.in; F.out = args.out; F.ws = args.ws; F.wv = __builtin_amdgcn_readfirstlane((int)threadIdx.x >> 6);
    volatile LAS unsigned* MISC = (volatile LAS unsigned*)(F.lds + MISC_OFF);
    gu32* ctl = (gu32*)(args.ws + WS_CTL);
    for (int u = threadIdx.x; u < (LDS_BYTES - MISC_OFF) / 4; u += NWAVES * 64) ((LAS unsigned*)(F.lds + MISC_OFF))[u] = 0u;
    __syncthreads();
    XcdBarrier bar; bar.bar = (unsigned*)(ctl + CW_BAR) + args.li * XCD_BAR_WORDS; bar.x = 0; bar.st = nullptr; bar.wv = F.wv;
    if (!MK_LAUNCH_PER_PHASE) { bar = xcd_barrier_post((unsigned*)(ctl + CW_BAR) + args.li * XCD_BAR_WORDS, MISC + 8); bar.wv = F.wv; }
    const int lo = args.ph_lo, hi = args.ph_hi;
#define IN(k) (lo <= (k) && (k) < hi)
#define SEAM(k) do { if (IN(k) && IN((k) + 1)) xcd_barrier(bar); } while (0)
    bf16* proj = (bf16*)(F.ws + WS_PROJ); bf16* xb = (bf16*)(F.ws + WS_XB); float* xsq = (float*)(F.ws + WS_XSQ);
    float* ab = (float*)(F.ws + WS_AB);

    GrpBar gb; gb.cnt = (unsigned*)(ctl + CW_GRP) + (size_t)(F.bid & 63) * 8 * 64; gb.tmo = (unsigned*)(ctl + CW_BAR) + XB_TMO; gb.wv = F.wv; gb.on = false;
    const bool grp_try = !MK_LAUNCH_PER_PHASE && F.G == 256 && lo == 0 && hi == N_PHASES;
    if (grp_try && F.wv == 0 && lane_id() == 0) __hip_atomic_store((unsigned*)(ctl + CW_XCC) + F.bid, xb_xcc_id() + 1u, __ATOMIC_RELAXED, __HIP_MEMORY_SCOPE_AGENT);
    if (IN(0)) { p0_prologue(F); } SEAM(0);
    if (grp_try && F.wv == 0 && lane_id() == 0) { const unsigned mine = xb_xcc_id() + 1u; bool same = true;
        for (int k = 1; k < 4; ++k) same = same && __hip_atomic_load((unsigned*)(ctl + CW_XCC) + ((F.bid + 64 * k) & 255), __ATOMIC_RELAXED, __HIP_MEMORY_SCOPE_AGENT) == mine;
        if (!same) atomicAdd((unsigned*)(ctl + CW_BAD), 1u); }

    layer_body<0>(F, bar, gb, grp_try, lo, hi, lds);
    layer_body<1>(F, bar, gb, grp_try, lo, hi, lds);
#undef IN
#undef SEAM
}

extern "C" void kernel_launch(void* const* d_in, const int* in_sizes, int n_in, void* d_out, int out_size, void* d_ws, size_t ws_size, hipStream_t stream) {
    static int grid = 0;
    if (grid == 0) {
        if (n_in != 20 || in_sizes[0] != MROWS * DM || out_size != MROWS * DM || ws_size < WS_END) {
            fprintf(stderr, "kernel_launch: shape/workspace mismatch (n_in %d, in0 %d, out %d, ws %zu; need ws >= %zu); nothing launched\n", n_in, n_in > 0 ? in_sizes[0] : -1, out_size, ws_size, (size_t)WS_END); grid = -1; return; }
        int dev = 0, cus = 0, per_cu = 0;
        if (hipGetDevice(&dev) != hipSuccess || hipDeviceGetAttribute(&cus, hipDeviceAttributeMultiprocessorCount, dev) != hipSuccess) { fprintf(stderr, "kernel_launch: device query failed\n"); grid = -1; return; }
        if (hipFuncSetAttribute((const void*)hyb_fwd, hipFuncAttributeMaxDynamicSharedMemorySize, LDS_BYTES) != hipSuccess) { fprintf(stderr, "kernel_launch: hipFuncSetAttribute failed\n"); grid = -1; return; }
        if (hipOccupancyMaxActiveBlocksPerMultiprocessor(&per_cu, (const void*)hyb_fwd, NWAVES * 64, LDS_BYTES) != hipSuccess || per_cu < 1) {
            fprintf(stderr, "kernel_launch: occupancy query reports %d workgroups per CU; nothing launched\n", per_cu); (void)hipGetLastError(); grid = -1; return; }
        if (cus < 128) { fprintf(stderr, "kernel_launch: %d CUs; this kernel's phase program needs at least 128 workgroups; nothing launched\n", cus); grid = -1; return; }
        grid = cus;
    }
    if (grid < 0) return;
    if (hipMemsetAsync((char*)d_ws + WS_CTL, 0, CTL_ZERO_BYTES, stream) != hipSuccess) { fprintf(stderr, "kernel_launch: memset failed\n"); return; }
    Args a{};
    for (int i = 0; i < 20; ++i) a.in[i] = (const float*)d_in[i];
    a.out = (float*)d_out; a.ws = (unsigned char*)d_ws;
#if MK_LAUNCH_PER_PHASE
    for (int p = 0; p < N_PHASES; ++p) { a.ph_lo = p; a.ph_hi = p + 1; a.li = 0; hipLaunchKernelGGL(hyb_fwd, dim3(grid), dim3(NWAVES * 64), LDS_BYTES, stream, a); }
#else
    a.ph_lo = 0; a.ph_hi = N_PHASES; a.li = 0;
    hipLaunchKernelGGL(hyb_fwd, dim3(grid), dim3(NWAVES * 64), LDS_BYTES, stream, a);
#endif
    const hipError_t le = hipPeekAtLastError();
    if (le != hipSuccess) fprintf(stderr, "kernel_launch: launch failed: %s\n", hipGetErrorName(le));
}
```

```cpp
#include <hip/hip_runtime.h>
#include <cstdio>
#include <cstdint>
#include <type_traits>

constexpr int BATCH = 8, SEQ = 2048, DM = 1024, MROWS = BATCH * SEQ;
constexpr int NMEM = 256, MMEM = BATCH * NMEM;
constexpr int HD = 128, NH = 8, NMH = 4, FF = 4096;
constexpr int PW = 4608;
constexpr int PC_K = 0, PC_V = 1024, PC_Z = 2048, PC_Q = 3072, PC_QM = 4096, PC_AB = 4608;
constexpr int N_IN = 4864;
constexpr int DN_IN = 4624, FOX_IN = 4616, OUT_IN = 1536;
constexpr float EPS = 1e-6f;
constexpr float QSCALE = 0.08838834764831845f;

__device__ __forceinline__ int lane_id_v() { int x; asm volatile("v_mbcnt_lo_u32_b32 %0, -1, 0\n\tv_mbcnt_hi_u32_b32 %0, -1, %0" : "=v"(x)); return x; }
template <int CTRL> __device__ __forceinline__ float dppf(float x) { return __builtin_bit_cast(float, __builtin_amdgcn_update_dpp(0, __builtin_bit_cast(int, x), CTRL, 0xf, 0xf, true)); }
__device__ __forceinline__ float row16_sum(float x) { x += dppf<0xB1>(x); x += dppf<0x4E>(x); x += dppf<0x141>(x); x += dppf<0x140>(x); return x; }
__device__ __forceinline__ float add_xor16(float x) { auto r = __builtin_amdgcn_permlane16_swap(__float_as_uint(x), __float_as_uint(x), false, false); return __uint_as_float(r[0]) + __uint_as_float(r[1]); }
__device__ __forceinline__ float add_xor32(float x) { auto r = __builtin_amdgcn_permlane32_swap(__float_as_uint(x), __float_as_uint(x), false, false); return __uint_as_float(r[0]) + __uint_as_float(r[1]); }
namespace pg8 {
#define PG8_LAS __attribute__((address_space(3)))
typedef unsigned short bf16_t;
typedef short bf16x8 __attribute__((ext_vector_type(8)));
typedef float f32x4 __attribute__((ext_vector_type(4)));
typedef unsigned u32x4 __attribute__((ext_vector_type(4)));
constexpr int BM = 256, BK = 64, HALF = 128, HTB = HALF * BK * 2  , STAGE_BYTES = 8 * HTB, NXCD = 8, WGM = 8;

__host__ __device__ __forceinline__ int lds_byte(int r, int c) { const int st = (r >> 4) * 2 + (c >> 5), rr = r & 15, cc = c & 31, ob = rr * 64 + cc * 2; return st * 1024 + (ob ^ (((ob >> 9) & 1) << 5)); }
__host__ __device__ __forceinline__ void stage_rc(int b, int& R, int& C) { const int st = b / 1024, sb = b % 1024, swz = sb ^ (((sb >> 9) & 1) << 5); R = (st >> 1) * 16 + swz / 64; C = (st & 1) * 32 + (swz % 64) / 2; }
__host__ __device__ __forceinline__ int perm32(int rho) { const int n = rho >> 4, i = rho & 15; return 8 * (i >> 2) + 4 * n + (i & 3); }

struct Unit { int pm, pn; };
struct Gemm { const bf16_t* A; const bf16_t* Bt; int M, N, K, lda; };

struct StaticOrder {
    int nM, nN, nwg, G, c;
    __host__ __device__ void init(int M, int N, int G_, int c_) { nM = M / BM; nN = N / BM; nwg = nM * nN; G = G_; c = c_; }
    __host__ __device__ bool next(int i, Unit& u) const {
        const long L = (long)i * G + c; if (L >= nwg) return false;
        int wgid = (int)L; { const int q = nwg / NXCD, r = nwg % NXCD, xcd = wgid % NXCD, off = wgid / NXCD; wgid = (xcd < r ? xcd * (q + 1) : r * (q + 1) + (xcd - r) * q) + off; }
        const int nig = WGM * nN, gid = wgid / nig, fm = gid * WGM, gsz = (nM - fm) < WGM ? (nM - fm) : WGM;
        u.pm = fm + ((wgid % nig) % gsz); u.pn = (wgid % nig) / gsz; return true;
    }
    __device__ __forceinline__ void a_ready(const Unit&) const {}
    __device__ __forceinline__ void done(const Unit&) const {}
};
struct StrideUnits {
    int start, stride, total, qm;
    __device__ __forceinline__ bool next(int i, Unit& u) const { const int t = start + i * stride; if (t >= total) return false; const int x = t & 7, j = t >> 3;
        if (qm) { u.pm = 8 * x + (j >> 1); u.pn = 16 + (j & 1); } else { u.pm = x; u.pn = j; } return true; }
    __device__ __forceinline__ void a_ready(const Unit&) const {}
    __device__ __forceinline__ void done(const Unit&) const {}
};

__device__ __forceinline__ unsigned cvt_pk_bf16(float lo, float hi) { unsigned r; asm volatile("v_cvt_pk_bf16_f32 %0, %1, %2" : "=v"(r) : "v"(lo), "v"(hi)); return r; }

constexpr int EPI_XCH = 131072, EPI_RS = 139264;
template <bool NORM, bool RELU2, bool HALO = false> struct EpiProj {
    static constexpr bool PERM = true, AFTER_DRAIN = false, USE_RS = true, ACC_INIT = false;
    bf16_t* O; int ldc; const float* xsq; float* ab; int n_main; bf16_t* halo;
    int nlo0, nhi0; const float* nw0; int nlo1, nhi1; const float* nw1; int nlo2, nhi2; const float* nw2;
    int zlo, zhi, zmode; const float* zw;
    __device__ __forceinline__ void rs_load(const Unit& u, int tid, f32x4 (&q)[4]) const { const float* p = xsq + (size_t)(u.pm * BM + tid) * 16;
#pragma unroll
        for (int i = 0; i < 4; ++i) q[i] = *(const f32x4*)(p + 4 * i); }
    __device__ __forceinline__ void rs_store(const f32x4 (&q)[4], PG8_LAS unsigned char* lds, int parity, int tid) const {
        const f32x4 t = (q[0] + q[1]) + (q[2] + q[3]);
        ((PG8_LAS float*)(lds + EPI_RS))[parity * 256 + tid] = rsqrtf(((t[0] + t[1]) + (t[2] + t[3])) * (1.0f / 1024.0f) + 1e-6f); }
    __device__ __forceinline__ void operator()(const f32x4 (&acc)[2][2][4][2], const Unit& u, int wr, int wc, int fr, int fq, PG8_LAS unsigned char* lds, int parity) const {
        const int rl0 = wr * 64 + fr, row0 = u.pm * BM + rl0, colt = u.pn * BM;
        const bool is_ab = u.pn >= n_main;
        const PG8_LAS float* RS = (const PG8_LAS float*)(lds + EPI_RS) + parity * 256;
        const float* nw = nullptr;
        if (NORM) { if (u.pn >= nlo0 && u.pn < nhi0) nw = nw0; else if (u.pn >= nlo1 && u.pn < nhi1) nw = nw1; else if (u.pn >= nlo2 && u.pn < nhi2) nw = nw2; }
        f32x4 w0 = {1.f, 1.f, 1.f, 1.f}, w1 = w0;
        const int zm = (NORM && u.pn >= zlo && u.pn < zhi) ? zmode : 0;
        if (zm == 1) { w0 = *(const f32x4*)(zw + wc * 32 + 8 * fq); w1 = *(const f32x4*)(zw + wc * 32 + 8 * fq + 4); }
        if (NORM && nw != nullptr) {
            w0 = *(const f32x4*)(nw + wc * 32 + 8 * fq); w1 = *(const f32x4*)(nw + wc * 32 + 8 * fq + 4);
            PG8_LAS float* X = (PG8_LAS float*)(lds + EPI_XCH);
#pragma unroll
            for (int ai = 0; ai < 2; ++ai)
#pragma unroll
                for (int m = 0; m < 4; ++m) { const int rl = rl0 + ai * HALF + m * 16; const float rstd = RS[rl];
#pragma unroll
                    for (int bj = 0; bj < 2; ++bj) { const f32x4 v0 = acc[ai][bj][m][0] * rstd, v1 = acc[ai][bj][m][1] * rstd;
                        float ss = ((v0[0] * v0[0] + v0[1] * v0[1]) + (v0[2] * v0[2] + v0[3] * v0[3])) + ((v1[0] * v1[0] + v1[1] * v1[1]) + (v1[2] * v1[2] + v1[3] * v1[3]));
                        ss = add_xor32(add_xor16(ss));
                        if (fq == 0) X[(bj * 256 + rl) * 4 + wc] = ss; } }
            asm volatile("s_waitcnt lgkmcnt(0)" ::: "memory"); __builtin_amdgcn_s_barrier(); asm volatile("" ::: "memory");
        }
#pragma unroll
        for (int ai = 0; ai < 2; ++ai)
#pragma unroll
            for (int m = 0; m < 4; ++m) {
                const int rl = rl0 + ai * HALF + m * 16, r = row0 + ai * HALF + m * 16;
                const float rstd = RS[rl];
                if (!is_ab) {
#pragma unroll
                    for (int bj = 0; bj < 2; ++bj) {
                        float sc = rstd;
                        if (NORM && nw != nullptr) { const f32x4 p4 = *(const PG8_LAS f32x4*)((const PG8_LAS float*)(lds + EPI_XCH) + (bj * 256 + rl) * 4);
                            sc = rstd * rsqrtf(((p4[0] + p4[1]) + (p4[2] + p4[3])) * (1.0f / 128.0f) + 1e-6f); }
                        f32x4 v0 = acc[ai][bj][m][0] * sc, v1 = acc[ai][bj][m][1] * sc;
                        if (zm != 0) {
#pragma unroll
                            for (int e = 0; e < 4; ++e) { const float s0 = __builtin_amdgcn_rcpf(1.f + __expf(-v0[e])), s1 = __builtin_amdgcn_rcpf(1.f + __expf(-v1[e]));
                                v0[e] = zm == 1 ? v0[e] * s0 : s0; v1[e] = zm == 1 ? v1[e] * s1 : s1; } }
                        v0 = v0 * w0; v1 = v1 * w1;
                        if (RELU2) {
#pragma unroll
                            for (int e = 0; e < 4; ++e) { const float a = fmaxf(v0[e], 0.f), b = fmaxf(v1[e], 0.f); v0[e] = a * a; v1[e] = b * b; }
                        }
                        u32x4 w; w.x = cvt_pk_bf16(v0[0], v0[1]); w.y = cvt_pk_bf16(v0[2], v0[3]); w.z = cvt_pk_bf16(v1[0], v1[1]); w.w = cvt_pk_bf16(v1[2], v1[3]);
                        *(u32x4*)(O + (size_t)r * ldc + colt + bj * HALF + wc * 32 + 8 * fq) = w;
                        if (HALO && m == 3 && fr >= 13) *(u32x4*)(halo + ((size_t)(r >> 6) * 3 + ((r & 63) - 61)) * ldc + colt + bj * HALF + wc * 32 + 8 * fq) = w;
                    }
                } else if (ab != nullptr && wc == 0 && fq < 2) {
                    float* p = ab + (size_t)r * 16 + 8 * fq;
                    *(f32x4*)p = acc[ai][0][m][0] * rstd; *(f32x4*)(p + 4) = acc[ai][0][m][1] * rstd;
                }
            }
    }
};
template <bool LAST = false, bool INIT_F32 = false> struct EpiRes {
    static constexpr bool PERM = true, AFTER_DRAIN = false, USE_RS = false, ACC_INIT = true;
    bf16_t* xb; float* xout; float* xsq; const float* xin;
    __device__ __forceinline__ void init(f32x4 (&acc)[2][2][4][2], const Unit& u, int wr, int wc, int fr, int fq) const {
        const int row0 = u.pm * BM + wr * 64 + fr, colt = u.pn * BM;
#pragma unroll
        for (int ai = 0; ai < 2; ++ai)
#pragma unroll
            for (int m = 0; m < 4; ++m)
#pragma unroll
                for (int bj = 0; bj < 2; ++bj) { const size_t off = (size_t)(row0 + ai * HALF + m * 16) * 1024 + colt + bj * HALF + wc * 32 + 8 * fq;
                    if (INIT_F32) { acc[ai][bj][m][0] = *(const f32x4*)(xin + off); acc[ai][bj][m][1] = *(const f32x4*)(xin + off + 4); continue; }
                    const u32x4 w = *(const u32x4*)(xb + off);
                    acc[ai][bj][m][0] = (f32x4){__uint_as_float(w.x << 16), __uint_as_float(w.x & 0xffff0000u), __uint_as_float(w.y << 16), __uint_as_float(w.y & 0xffff0000u)};
                    acc[ai][bj][m][1] = (f32x4){__uint_as_float(w.z << 16), __uint_as_float(w.z & 0xffff0000u), __uint_as_float(w.w << 16), __uint_as_float(w.w & 0xffff0000u)}; }
    }
    __device__ __forceinline__ void operator()(const f32x4 (&acc)[2][2][4][2], const Unit& u, int wr, int wc, int fr, int fq, PG8_LAS unsigned char*, int) const {
        const int row0 = u.pm * BM + wr * 64 + fr, colt = u.pn * BM;
#pragma unroll
        for (int ai = 0; ai < 2; ++ai)
#pragma unroll
            for (int m = 0; m < 4; ++m) {
                const int r = row0 + ai * HALF + m * 16; float ss = 0.f;
#pragma unroll
                for (int bj = 0; bj < 2; ++bj) {
                    const size_t off = (size_t)r * 1024 + colt + bj * HALF + wc * 32 + 8 * fq;
                    const f32x4 v0 = acc[ai][bj][m][0], v1 = acc[ai][bj][m][1];
                    if (LAST) { *(f32x4*)(xout + off) = v0; *(f32x4*)(xout + off + 4) = v1; }
                    else {
                    ss += ((v0[0] * v0[0] + v0[1] * v0[1]) + (v0[2] * v0[2] + v0[3] * v0[3])) + ((v1[0] * v1[0] + v1[1] * v1[1]) + (v1[2] * v1[2] + v1[3] * v1[3]));
                    u32x4 w; w.x = cvt_pk_bf16(v0[0], v0[1]); w.y = cvt_pk_bf16(v0[2], v0[3]); w.z = cvt_pk_bf16(v1[0], v1[1]); w.w = cvt_pk_bf16(v1[2], v1[3]);
                    *(u32x4*)(xb + off) = w; }
                }
                if (!LAST) { ss = add_xor32(add_xor16(ss));
                if (fq == 0) xsq[(size_t)r * 16 + u.pn * 4 + wc] = ss; }
            }
    }
};

template <class Epi, class Sched, bool ALIGN_EPI = false, bool SP2 = false>
__device__ __forceinline__ void gemm_phase(PG8_LAS unsigned char* lds, const Gemm g, const Sched& S, const Epi& E, int wid) {
    const int lane = lane_id_v();
    const int tid = wid * 64 + lane, wr = wid >> 2, wc = wid & 3, fr = lane & 15, fq = lane >> 4;
    const int K = g.K, nt = K / BK;
    unsigned voffA[2], voffB[2];
#pragma unroll
    for (int i = 0; i < 2; ++i) { int R, C; stage_rc(tid * 16 + i * 8192, R, C); const int Rb = Epi::PERM ? ((R & ~31) + perm32(R & 31)) : R;
        voffA[i] = (unsigned)(R * g.lda + C) * 2u; voffB[i] = (unsigned)(Rb * K + C) * 2u; }
    const size_t kstep = (size_t)(BK * 2);
    const size_t hstepA = (size_t)HALF * g.lda * 2, hstepB = (size_t)HALF * K * 2;
    const size_t tstepA = 2 * hstepA, tstepB = 2 * hstepB;
    const unsigned ldsw = (unsigned)wid * 1024u;
    const int aoff = lds_byte(wr * 64 + fr, fq * 8), boff = lds_byte(wc * 32 + fr, fq * 8);
#define PG8_SA(b, h) (((b) * 2 + (h)) * HTB)
#define PG8_SB(b, h) ((4 + (b) * 2 + (h)) * HTB)
#define PG8_STAGE(bufoff, gbase, voff) do { _Pragma("unroll") for (int _i = 0; _i < 2; ++_i) \
        __builtin_amdgcn_global_load_lds((const unsigned*)((const char*)(gbase) + (voff)[_i]), (PG8_LAS unsigned*)(lds + (bufoff) + ldsw + _i * 8192), 16, 0, 0); } while (0)
#define PG8_LDA(dst, b, h) do { _Pragma("unroll") for (int m = 0; m < 4; ++m) _Pragma("unroll") for (int k = 0; k < 2; ++k) dst[m][k] = *(const PG8_LAS bf16x8*)(lds + PG8_SA(b, h) + aoff + m * 2048 + k * 1024); } while (0)
#define PG8_LDB(dst, b, h) do { _Pragma("unroll") for (int n = 0; n < 2; ++n) _Pragma("unroll") for (int k = 0; k < 2; ++k) dst[n][k] = *(const PG8_LAS bf16x8*)(lds + PG8_SB(b, h) + boff + n * 2048 + k * 1024); } while (0)
#define PG8_MMA(ai, bj, At, Bt) do { __builtin_amdgcn_s_setprio(1); _Pragma("unroll") for (int m = 0; m < 4; ++m) _Pragma("unroll") for (int n = 0; n < 2; ++n) _Pragma("unroll") for (int k = 0; k < 2; ++k) \
        acc[ai][bj][m][n] = __builtin_amdgcn_mfma_f32_16x16x32_bf16(Bt[n][k], At[m][k], acc[ai][bj][m][n], 0, 0, 0); __builtin_amdgcn_s_setprio(0); } while (0)
#define PG8_WAIT_V(n) asm volatile("s_waitcnt vmcnt(" #n ")" ::: "memory")
#define PG8_WAIT_L(n) asm volatile("s_waitcnt lgkmcnt(" #n ")" ::: "memory")
#define PG8_BAR __builtin_amdgcn_s_barrier()
#define PG8_SCHED __builtin_amdgcn_sched_barrier(0)
    Unit cur, nxt; int ui = 0;
    if (!S.next(0, cur)) return;
    f32x4 acc[2][2][4][2];
    if constexpr (Epi::ACC_INIT) E.init(acc, cur, wr, wc, fr, fq);
    else {
#pragma unroll
    for (int a = 0; a < 2; ++a)
#pragma unroll
        for (int b = 0; b < 2; ++b)
#pragma unroll
            for (int m = 0; m < 4; ++m)
#pragma unroll
                for (int n = 0; n < 2; ++n) acc[a][b][m][n] = (f32x4){0.f, 0.f, 0.f, 0.f};
    }
    bf16x8 At[4][2], B0[2][2], B1[2][2];
    const char* cA = (const char*)g.A + (size_t)cur.pm * tstepA; const char* cB = (const char*)g.Bt + (size_t)cur.pn * tstepB;
    S.a_ready(cur);
    if constexpr (Epi::USE_RS) { if (tid < 256) { f32x4 rq[4]; E.rs_load(cur, tid, rq); E.rs_store(rq, lds, 0, tid); } }
    if constexpr (SP2) {
        PG8_STAGE(PG8_SB(0, 0), cB, voffB); PG8_STAGE(PG8_SB(0, 1), cB + hstepB, voffB); PG8_STAGE(PG8_SA(0, 0), cA, voffA); PG8_STAGE(PG8_SA(0, 1), cA + hstepA, voffA);
        if (wr == 1) PG8_BAR;
        PG8_WAIT_V(2); PG8_BAR;
        PG8_STAGE(PG8_SB(1, 0), cB + kstep, voffB); PG8_STAGE(PG8_SA(1, 0), cA + kstep, voffA); PG8_STAGE(PG8_SB(1, 1), cB + hstepB + kstep, voffB);
        PG8_WAIT_V(6); PG8_BAR;
    } else {
        PG8_STAGE(PG8_SB(0, 0), cB, voffB); PG8_STAGE(PG8_SA(0, 0), cA, voffA); PG8_STAGE(PG8_SB(0, 1), cB + hstepB, voffB); PG8_STAGE(PG8_SA(0, 1), cA + hstepA, voffA);
        if (wr == 1) PG8_BAR;
        PG8_WAIT_V(4); PG8_BAR;
        PG8_STAGE(PG8_SB(1, 0), cB + kstep, voffB); PG8_STAGE(PG8_SA(1, 0), cA + kstep, voffA); PG8_STAGE(PG8_SB(1, 1), cB + hstepB + kstep, voffB);
        PG8_WAIT_V(6); PG8_BAR;
    }
    for (;;) {
        const bool has_next = S.next(ui + 1, nxt);
        const char* nA = has_next ? (const char*)g.A + (size_t)nxt.pm * tstepA : cA; const char* nB = has_next ? (const char*)g.Bt + (size_t)nxt.pn * tstepB : cB;
        for (int t = 0; t < nt; t += 2) {
            const bool last = (t == nt - 2);
            const char* a1 = cA + (size_t)(t + 1) * kstep;
            const char* a2 = last ? nA : cA + (size_t)(t + 2) * kstep; const char* b2 = last ? nB : cB + (size_t)(t + 2) * kstep;
            const char* a3 = a2 + kstep; const char* b3 = b2 + kstep;
            if (last && has_next) S.a_ready(nxt);
            if constexpr (SP2) {
            PG8_LDB(B0, 0, 0); PG8_LDB(B1, 0, 1); PG8_SCHED; PG8_LDA(At, 0, 0); PG8_STAGE(PG8_SA(1, 1), a1 + hstepA, voffA);
            PG8_WAIT_V(8); PG8_WAIT_L(0); PG8_BAR; PG8_MMA(0, 0, At, B0); PG8_MMA(0, 1, At, B1); PG8_BAR; PG8_SCHED;
            PG8_LDA(At, 0, 1); PG8_STAGE(PG8_SB(0, 0), b2, voffB); PG8_STAGE(PG8_SB(0, 1), b2 + hstepB, voffB); PG8_STAGE(PG8_SA(0, 0), a2, voffA);
            PG8_WAIT_V(8); PG8_WAIT_L(0); PG8_BAR; PG8_MMA(1, 0, At, B0); PG8_MMA(1, 1, At, B1); PG8_BAR; PG8_SCHED;
            PG8_LDB(B0, 1, 0); PG8_LDB(B1, 1, 1); PG8_SCHED; PG8_LDA(At, 1, 0); PG8_STAGE(PG8_SA(0, 1), a2 + hstepA, voffA);
            PG8_WAIT_V(8); PG8_WAIT_L(0); PG8_BAR; PG8_MMA(0, 0, At, B0); PG8_MMA(0, 1, At, B1); PG8_BAR; PG8_SCHED;
            PG8_LDA(At, 1, 1); PG8_STAGE(PG8_SB(1, 0), b3, voffB); PG8_STAGE(PG8_SB(1, 1), b3 + hstepB, voffB); PG8_STAGE(PG8_SA(1, 0), a3, voffA);
            PG8_WAIT_V(8); PG8_WAIT_L(0); PG8_BAR; PG8_MMA(1, 0, At, B0); PG8_MMA(1, 1, At, B1); PG8_BAR; PG8_SCHED;
            } else {
            PG8_LDB(B0, 0, 0); PG8_SCHED; PG8_LDA(At, 0, 0); PG8_STAGE(PG8_SA(1, 1), a1 + hstepA, voffA);
            PG8_WAIT_L(8); PG8_BAR; PG8_WAIT_L(0); PG8_MMA(0, 0, At, B0); PG8_BAR; PG8_SCHED;
            PG8_LDB(B1, 0, 1); PG8_STAGE(PG8_SB(0, 0), b2, voffB);
            PG8_BAR; PG8_WAIT_L(0); PG8_MMA(0, 1, At, B1); PG8_BAR;
            PG8_LDA(At, 0, 1); PG8_STAGE(PG8_SA(0, 0), a2, voffA);
            PG8_BAR; PG8_WAIT_L(0); PG8_MMA(1, 0, At, B0); PG8_BAR; PG8_SCHED;
            PG8_STAGE(PG8_SB(0, 1), b2 + hstepB, voffB);
            PG8_WAIT_V(6); PG8_BAR; PG8_MMA(1, 1, At, B1); PG8_BAR;
            PG8_LDB(B0, 1, 0); PG8_SCHED; PG8_LDA(At, 1, 0); PG8_STAGE(PG8_SA(0, 1), a2 + hstepA, voffA);
            PG8_WAIT_L(8); PG8_BAR; PG8_WAIT_L(0); PG8_MMA(0, 0, At, B0); PG8_BAR; PG8_SCHED;
            PG8_LDB(B1, 1, 1); PG8_STAGE(PG8_SB(1, 0), b3, voffB);
            PG8_BAR; PG8_WAIT_L(0); PG8_MMA(0, 1, At, B1); PG8_BAR;
            PG8_LDA(At, 1, 1); PG8_STAGE(PG8_SA(1, 0), a3, voffA);
            PG8_BAR; PG8_WAIT_L(0); PG8_MMA(1, 0, At, B0); PG8_BAR; PG8_SCHED;
            PG8_STAGE(PG8_SB(1, 1), b3 + hstepB, voffB);
            PG8_WAIT_V(6); PG8_BAR; PG8_MMA(1, 1, At, B1); PG8_BAR;
            }
        }
        if constexpr (ALIGN_EPI) { if (wr == 0) PG8_BAR; }
        if constexpr (Epi::USE_RS) {
            f32x4 rq[4]; if (has_next && wid < 4) E.rs_load(nxt, wid * 64 + lane_id_v(), rq);
            E(acc, cur, wr, wc, fr, fq, lds, ui & 1);
            if (has_next && wid < 4) E.rs_store(rq, lds, (ui + 1) & 1, wid * 64 + lane_id_v());
        } else { E(acc, cur, wr, wc, fr, fq, lds, ui & 1); }
        S.done(cur);
        if (!has_next) break;
        if constexpr (Epi::ACC_INIT) E.init(acc, nxt, wr, wc, fr, fq);
        else {
#pragma unroll
        for (int a = 0; a < 2; ++a)
#pragma unroll
            for (int b = 0; b < 2; ++b)
#pragma unroll
                for (int m = 0; m < 4; ++m)
#pragma unroll
                    for (int n = 0; n < 2; ++n) acc[a][b][m][n] = (f32x4){0.f, 0.f, 0.f, 0.f};
        }
        cur = nxt; cA = nA; cB = nB; ++ui;
        if constexpr (ALIGN_EPI) { if (wr == 1) PG8_BAR; }
    }
    PG8_WAIT_V(0);
    if constexpr (!ALIGN_EPI) { if (wr == 0) PG8_BAR; }
    PG8_BAR;
    if constexpr (Epi::AFTER_DRAIN) { E.fused(acc, cur, wr, wc, fr, fq, lds, wid, lane); S.done(cur); }
#undef PG8_SA
#undef PG8_SB
#undef PG8_STAGE
#undef PG8_LDA
#undef PG8_LDB
#undef PG8_MMA
#undef PG8_WAIT_V
#undef PG8_WAIT_L
#undef PG8_BAR
#undef PG8_SCHED
}
}

namespace att {
typedef unsigned short bf16_t;
typedef short bf16x8 __attribute__((ext_vector_type(8)));
typedef short s16x4 __attribute__((ext_vector_type(4)));
typedef float f32x16 __attribute__((ext_vector_type(16)));
typedef float f32x4 __attribute__((ext_vector_type(4)));
typedef unsigned u32x4 __attribute__((ext_vector_type(4)));
constexpr int NW = 8, QBLK = 32, KVBLK = 64, QB = NW * QBLK, D = 128;
constexpr int SHM_V = KVBLK * D * 2, SHM_K = KVBLK * D * 2;
constexpr int OFF_WS = 2 * SHM_V + 2 * SHM_K, OFF_BK = OFF_WS + NW * 64 * 4, ATT_LDS = OFF_BK + 8192;
constexpr float SCALE = 0.08838834764831845f, THR = 8.f;
constexpr int WBIG = 1 << 30;
#define KSWZ(row, colB) ((row) * 256 + ((colB) ^ (((row) & 7) << 4)))
#define SBAR() __builtin_amdgcn_sched_barrier(0)
__device__ __forceinline__ int v_st(int k, int c) { const int kk = (k & ~0xC) | ((k & 4) << 1) | ((k & 8) >> 1); return ((kk >> 3) * 4 + (c >> 5)) * 512 + ((kk & 7) * 32 + (c & 31)) * 2; }
__device__ __forceinline__ int v_rd_base(int lane) { return ((lane & 3) << 3) | (((lane >> 2) & 3) << 6) | (((lane >> 4) & 1) << 5) | (((lane >> 5) & 1) << 8); }
constexpr int v_rd_off(int d0, int ks, int half) { return d0 * 512 + ks * 4096 + half * 2048; }
__device__ __forceinline__ int crow(int r, int hi) { return (r & 3) + 8 * (r >> 2) + 4 * hi; }
__device__ __forceinline__ unsigned cvtpk(float lo, float hi) { unsigned r; asm volatile("v_cvt_pk_bf16_f32 %0, %1, %2" : "=v"(r) : "v"(lo), "v"(hi)); return r; }
__device__ __forceinline__ bf16x8 load8(const bf16_t* p) { return *reinterpret_cast<const bf16x8*>(p); }
__device__ __forceinline__ void mask_tile(f32x16& p0, f32x16& p1, int dq, unsigned W) {
    const float NEG = -__builtin_inff();
#pragma unroll
    for (int r = 0; r < 16; ++r) { const int c = (r & 3) + 8 * (r >> 2);
        if ((unsigned)(dq - c) >= W) p0[r] = NEG;
        if ((unsigned)(dq - c - 32) >= W) p1[r] = NEG; }
}
__device__ __forceinline__ void partialSM(f32x16& p0, f32x16& p1, float& m_reg, float& mn, float& alpha) {
    float pmax = p0[0]; for (int r = 1; r < 16; ++r) pmax = fmaxf(pmax, p0[r]); for (int r = 0; r < 16; ++r) pmax = fmaxf(pmax, p1[r]);
    { auto rr = __builtin_amdgcn_permlane32_swap(__float_as_uint(pmax), __float_as_uint(pmax), false, false);
      pmax = fmaxf(__uint_as_float(rr[0]), __uint_as_float(rr[1])); }
    constexpr float C2 = 1.4426950408889634f * SCALE;
    if (__builtin_expect(__all((pmax - m_reg) * SCALE <= THR), 1)) { mn = m_reg; alpha = 1.f; }
    else { mn = fmaxf(m_reg, pmax); alpha = __builtin_amdgcn_exp2f((m_reg - mn) * C2); m_reg = mn; }
    const float mnL = -mn * C2;
    for (int r = 0; r < 16; ++r) p0[r] = fmaf(p0[r], C2, mnL); for (int r = 0; r < 16; ++r) p1[r] = fmaf(p1[r], C2, mnL);
    for (int r = 0; r < 16; ++r) p0[r] = __builtin_amdgcn_exp2f(p0[r]);
}
__device__ __forceinline__ void finishSM(f32x16& p0, f32x16& p1, float alpha, float& l_reg, bf16x8& pa0, bf16x8& pa1, bf16x8& pa2, bf16x8& pa3) {
    for (int r = 0; r < 16; ++r) p1[r] = __builtin_amdgcn_exp2f(p1[r]);
    float ps = 0; for (int r = 0; r < 16; ++r) ps += p0[r]; for (int r = 0; r < 16; ++r) ps += p1[r];
    { auto rr = __builtin_amdgcn_permlane32_swap(__float_as_uint(ps), __float_as_uint(ps), false, false);
      ps = __uint_as_float(rr[0]) + __uint_as_float(rr[1]); }
    l_reg = l_reg * alpha + ps;
#define PK4(P, B_, OUT) do { unsigned a0 = cvtpk(P[B_+0], P[B_+1]), a1 = cvtpk(P[B_+2], P[B_+3]);                          \
        unsigned b0 = cvtpk(P[B_+4], P[B_+5]), b1 = cvtpk(P[B_+6], P[B_+7]);                                             \
        auto r0 = __builtin_amdgcn_permlane32_swap(a0, b0, false, false); auto r1 = __builtin_amdgcn_permlane32_swap(a1, b1, false, false); \
        u32x4 w = {r0[0], r1[0], r0[1], r1[1]}; OUT = *reinterpret_cast<bf16x8*>(&w); } while (0)
    PK4(p0, 0, pa0); PK4(p0, 8, pa1); PK4(p1, 0, pa2); PK4(p1, 8, pa3);
#undef PK4
}
template <int KB>
__device__ __forceinline__ void qkt(f32x16& p0, f32x16& p1, const char* K_lds, int r32, int hi, const bf16x8* qr, const float* bb) {
#pragma unroll
    for (int g = 0; g < 4; ++g) { const f32x4 b0 = *(const f32x4*)(bb + 8 * g), b1 = *(const f32x4*)(bb + 32 + 8 * g);
#pragma unroll
        for (int i = 0; i < 4; ++i) { p0[4 * g + i] = b0[i]; p1[4 * g + i] = b1[i]; } }
    const char* kb[4];
#pragma unroll
    for (int dd = 0; dd < 4; ++dd) kb[dd] = K_lds + KB * SHM_K + KSWZ(r32, (dd * 16 + hi * 8) * 2);
#pragma unroll
    for (int d0 = 0; d0 < 8; ++d0) { const char* a = kb[d0 & 3] + (d0 >> 2) * 128;
        bf16x8 b0 = *reinterpret_cast<const bf16x8*>(a);
        bf16x8 b1 = *reinterpret_cast<const bf16x8*>(a + 32 * 256);
        p0 = __builtin_amdgcn_mfma_f32_32x32x16_bf16(b0, qr[d0], p0, 0, 0, 0);
        p1 = __builtin_amdgcn_mfma_f32_32x32x16_bf16(b1, qr[d0], p1, 0, 0, 0); }
}
template <int VB>
__device__ __forceinline__ void pv_tile(f32x16* o, int vb0, bf16x8 pa0, bf16x8 pa1, bf16x8 pa2, bf16x8 pa3) {
#define TRRD(dst, off) asm volatile("ds_read_b64_tr_b16 %0, %1 offset:%2" : "=&v"(dst) : "v"(vb0), "i"(off) : "memory")
#define PV_D0(d0) do { s16x4 l0, l1, l2, l3, h0, h1, h2, h3; constexpr int b_ = VB * SHM_V + v_rd_off(d0, 0, 0);   \
        TRRD(l0, b_); TRRD(h0, b_ + 2048); TRRD(l1, b_ + 4096); TRRD(h1, b_ + 6144); TRRD(l2, b_ + 8192); TRRD(h2, b_ + 10240); TRRD(l3, b_ + 12288); TRRD(h3, b_ + 14336); \
        asm volatile("s_waitcnt lgkmcnt(0)" ::: "memory"); SBAR();   \
        o[d0] = __builtin_amdgcn_mfma_f32_32x32x16_bf16(pa0, (bf16x8){l0[0], l0[1], l0[2], l0[3], h0[0], h0[1], h0[2], h0[3]}, o[d0], 0, 0, 0);   \
        o[d0] = __builtin_amdgcn_mfma_f32_32x32x16_bf16(pa1, (bf16x8){l1[0], l1[1], l1[2], l1[3], h1[0], h1[1], h1[2], h1[3]}, o[d0], 0, 0, 0);   \
        o[d0] = __builtin_amdgcn_mfma_f32_32x32x16_bf16(pa2, (bf16x8){l2[0], l2[1], l2[2], l2[3], h2[0], h2[1], h2[2], h2[3]}, o[d0], 0, 0, 0);   \
        o[d0] = __builtin_amdgcn_mfma_f32_32x32x16_bf16(pa3, (bf16x8){l3[0], l3[1], l3[2], l3[3], h3[0], h3[1], h3[2], h3[3]}, o[d0], 0, 0, 0); } while (0)
    PV_D0(0); PV_D0(1); PV_D0(2); PV_D0(3);
#undef PV_D0
#undef TRRD
}
constexpr int QP = 4608;
struct Blk { bf16_t* Q; const bf16_t* K; const float* flog; float fb; int voff, goff, P0, skv, kvpitch; };
struct Seam { bf16x8 qr[8]; bf16x8 st_v0, st_v1, st_k0, st_k1; };
#define ROW(p, pitch, k0, rr) ((p) + (size_t)((k0) + (rr)) * (pitch) + sc)
#define VMW() asm volatile("s_waitcnt vmcnt(0)" ::: "memory")
#define VMWN(n) asm volatile("s_waitcnt vmcnt(%0)" :: "i"(n) : "memory")
#define SLOAD_H(Kp, Vp, pitch, k0) do { S.st_v0 = load8(ROW(Vp, pitch, k0, sr)); S.st_v1 = load8(ROW(Vp, pitch, k0, 32 + sr));              \
                         S.st_k0 = load8(ROW(Kp, pitch, k0, sr)); S.st_k1 = load8(ROW(Kp, pitch, k0, 32 + sr)); } while (0)
#define SWRITE_HK(bf) do { *(bf16x8*)(K_lds + (bf) * SHM_K + kws) = S.st_k0; *(bf16x8*)(K_lds + (bf) * SHM_K + kws + 32 * 256) = S.st_k1; } while (0)
#define SWRITE_HV(bf) do { *(bf16x8*)(V_lds + (bf) * SHM_V + vst0) = S.st_v0; *(bf16x8*)(V_lds + (bf) * SHM_V + vst1) = S.st_v1; } while (0)
#define SWRITE_H(bf) do { SWRITE_HV(bf); SWRITE_HK(bf); } while (0)
__device__ __forceinline__ void prime(const Blk& cur, char* lds, Seam& S, int wid) {
    const int lane = lane_id_v();
    const int tid = wid * 64 + lane, r32 = lane & 31, hi = lane >> 5;
    const int sr = tid >> 4, sc = (tid & 15) * 8, kws = KSWZ(sr, sc * 2); char* K_lds = lds + 2 * SHM_V;
    for (int d0 = 0; d0 < 8; ++d0) S.qr[d0] = load8(cur.Q + (size_t)(wid * QBLK + r32) * QP + d0 * 16 + hi * 8);
    SLOAD_H(cur.K, cur.K + cur.voff, cur.kvpitch, 0); VMW(); SWRITE_HK(0);
    __syncthreads();
}
__device__ __forceinline__ void block(const Blk& cur, const Blk& nxt, char* lds, Seam& S, int wid) {
    const int lane = lane_id_v();
    const int tid = wid * 64 + lane, r32 = lane & 31, hi = lane >> 5;
    constexpr int W = WBIG;
    int j_hi = (cur.P0 + QB - 1) / KVBLK + 1; if (j_hi > cur.skv / KVBLK) j_hi = cur.skv / KVBLK;
    const int NT = j_hi;
    const int qlo = cur.P0 + wid * QBLK, qm = qlo + r32 - 4 * hi;
    char* V_lds = lds; char* K_lds = lds + 2 * SHM_V;
    float* ws = (float*)(lds + OFF_WS) + wid * 64; float* li_l = ws, * al_l = ws + 32;
    float* bkl = (float*)(lds + OFF_BK);
    { const int nkeys = NT * KVBLK;
      if (cur.flog) { const int k0 = 4 * tid; float f[4];
#pragma unroll
          for (int e = 0; e < 4; ++e) { float x = 0.f; if (k0 + e < nkeys) x = cur.flog[(size_t)(k0 + e) * 16] + cur.fb;
              f[e] = k0 + e < nkeys ? fminf(x, 0.f) - log1pf(__expf(-fabsf(x))) : 0.f; }
          f[1] += f[0]; f[2] += f[1]; f[3] += f[2];
          float sc = f[3];
#pragma unroll
          for (int o_ = 1; o_ < 64; o_ <<= 1) { const float t_ = __shfl_up(sc, o_); if (lane >= o_) sc += t_; }
          if (lane == 63) ws[0] = sc;
          __syncthreads();
          float off = sc - f[3];
          for (int w_ = 0; w_ < wid; ++w_) off += ((const float*)(lds + OFF_WS))[w_ * 64];
#pragma unroll
          for (int e = 0; e < 4; ++e) if (k0 + e < nkeys) bkl[k0 + e] = -(f[e] + off) * (1.f / SCALE); }
      else for (int k = tid; k < nkeys; k += NW * 64) bkl[k] = 0.f;
      __syncthreads(); }
    float m_reg = -1e30f, l_reg = 0; f32x16 o[4] = {};
    const int sr = tid >> 4, sc = (tid & 15) * 8, vst0 = v_st(sr, sc), vst1 = v_st(32 + sr, sc), kws = KSWZ(sr, sc * 2);
    const int vb0 = (int)(uintptr_t)V_lds + v_rd_base(lane);
    const bf16_t* Kh = cur.K; const bf16_t* Vh = cur.K + cur.voff; const int kvp = cur.kvpitch;
#define RESC(a) do { if (__any((a) < 1.f)) { if (hi == 0) al_l[r32] = (a); asm volatile("s_waitcnt lgkmcnt(0)" ::: "memory");              \
                     for (int d_ = 0; d_ < 4; ++d_) for (int r = 0; r < 16; ++r) o[d_][r] *= al_l[crow(r, hi)]; } } while (0)
#define KBASE(t) ((t) * KVBLK)
#define MASKT(P0_, P1_, t) do { const int kb_ = KBASE(t); if (kb_ + KVBLK - 1 > qlo) mask_tile(P0_, P1_, qm - kb_, (unsigned)W); } while (0)
#define BB(t) (bkl + KBASE(t) + 4 * hi)
    constexpr int NQL = 8;
#define SEAM_K0() do { VMWN(NQL); SWRITE_HK(0); SBAR(); } while (0)
    f32x16 pA0, pA1, pB0, pB1; float mnA, mnB, alA, alB; bf16x8 pa0, pa1, pa2, pa3;
    SWRITE_HV(0); SBAR();
    if (NT > 1) { SLOAD_H(Kh, Vh, kvp, KBASE(1)); }
    SBAR(); qkt<0>(pA0, pA1, K_lds, r32, hi, S.qr, BB(0));
    MASKT(pA0, pA1, 0); partialSM(pA0, pA1, m_reg, mnA, alA);
    if (NT > 1) { VMW(); SWRITE_H(1); }
    __syncthreads();
#define HALF_STEP(PX0, PX1, mnX, alX, PY0, PY1, alY, t, KB, VB, SB) do {                                                      \
        SBAR(); qkt<KB>(PX0, PX1, K_lds, r32, hi, S.qr, BB(t));                                                                      \
        finishSM(PY0, PY1, alY, l_reg, pa0, pa1, pa2, pa3); SBAR();                                                           \
        if ((t) + 1 < NT) { SLOAD_H(Kh, Vh, kvp, KBASE((t) + 1)); SBAR(); }                                                   \
        pv_tile<VB>(o, vb0, pa0, pa1, pa2, pa3); MASKT(PX0, PX1, (t)); partialSM(PX0, PX1, m_reg, mnX, alX);   \
        __syncthreads();                                                                                                      \
        if ((t) + 1 < NT) { VMW(); SWRITE_H(SB); }                                                                            \
        RESC(alX); __syncthreads(); } while (0)
    for (int t = 1; t + 1 < NT; t += 2) {
        HALF_STEP(pB0, pB1, mnB, alB, pA0, pA1, alA, t, 1, 0, 0);
        HALF_STEP(pA0, pA1, mnA, alA, pB0, pB1, alB, t + 1, 0, 1, 1);
    }
    const bool even = (NT & 1) == 0;
    if (even) { SBAR(); qkt<1>(pB0, pB1, K_lds, r32, hi, S.qr, BB(NT - 1)); SBAR(); }
    SLOAD_H(nxt.K, nxt.K + nxt.voff, nxt.kvpitch, 0); SBAR();
#pragma unroll
    for (int d0 = 0; d0 < 8; ++d0) S.qr[d0] = load8(nxt.Q + (size_t)(wid * QBLK + r32) * QP + d0 * 16 + hi * 8);
    SBAR();
    finishSM(pA0, pA1, alA, l_reg, pa0, pa1, pa2, pa3); SBAR();
    pv_tile<0>(o, vb0, pa0, pa1, pa2, pa3);
    if (even) { MASKT(pB0, pB1, NT - 1); partialSM(pB0, pB1, m_reg, mnB, alB); __syncthreads(); RESC(alB);
        finishSM(pB0, pB1, alB, l_reg, pa0, pa1, pa2, pa3); SBAR(); pv_tile<1>(o, vb0, pa0, pa1, pa2, pa3); }
    SBAR(); SEAM_K0();
    if (hi == 0) li_l[r32] = l_reg; asm volatile("s_waitcnt lgkmcnt(0)" ::: "memory");
    float rli[16];
#pragma unroll
    for (int r = 0; r < 16; ++r) rli[r] = __builtin_amdgcn_rcpf(li_l[crow(r, hi)]);
    const int odd = r32 & 1;
    bf16_t* Ow = cur.Q + (size_t)(wid * QBLK + 4 * hi) * QP + (r32 & ~1) + 32 * odd; const int goff = cur.goff;
    auto fin = [&](auto has_gate) {
        unsigned g[16][2];
        if (has_gate.value) {
#pragma unroll
            for (int r = 0; r < 16; ++r) { const int ro = ((r & 3) + 8 * (r >> 2)) * QP;
#pragma unroll
                for (int dp = 0; dp < 2; ++dp) g[r][dp] = *(const unsigned*)(Ow + goff + ro + dp * 64); }
        }
#pragma unroll
        for (int r = 0; r < 16; ++r) { const int ro = ((r & 3) + 8 * (r >> 2)) * QP;
#pragma unroll
            for (int dp = 0; dp < 2; ++dp) { const float a = o[2 * dp][r] * rli[r], b = o[2 * dp + 1][r] * rli[r];
                const float recv = dppf<0xB1>(odd ? a : b);
                float lo = odd ? recv : a, hi2 = odd ? b : recv;
                if (has_gate.value) { lo *= __uint_as_float(g[r][dp] << 16); hi2 *= __uint_as_float(g[r][dp] & 0xffff0000u); }
                *(unsigned*)(Ow + ro + dp * 64) = cvtpk(lo, hi2); } }
    };
    if (goff) fin(std::true_type{}); else fin(std::false_type{});
    __syncthreads();
#undef RESC
#undef KBASE
#undef MASKT
#undef BB
#undef SEAM_K0
#undef HALF_STEP
}
#undef ROW
#undef VMW
#undef VMWN
#undef SLOAD_H
#undef SWRITE_HK
#undef SWRITE_HV
#undef SWRITE_H
#undef KSWZ
#undef SBAR
template <class Src> __device__ __forceinline__ void phase(char* lds, const Src& src, int wid) {
    Blk cur, nxt; if (!src(0, cur)) return;
    Seam S; prime(cur, lds, S, wid);
    for (int n = 0;; ++n) { const bool more = src(n + 1, nxt); if (!more) nxt = cur; block(cur, nxt, lds, S, wid); if (!more) break; cur = nxt; }
}
}

constexpr int NWAVES = 8;
#ifndef MK_LAUNCH_PER_PHASE
#define MK_LAUNCH_PER_PHASE 0
#endif
constexpr int N_PHASES = 12;

constexpr size_t KiB = 1u << 10, MiB = 1u << 20;
constexpr size_t WS_CTL = 0, CTL_ZERO_BYTES = 1 * MiB;
constexpr size_t WS_WIN0 = 1 * MiB, WS_WIN1 = WS_WIN0 + (size_t)N_IN * DM * 2;
constexpr size_t WS_WOUT0 = 20 * MiB, WS_WOUT1 = 23 * MiB;
constexpr size_t WS_WM1_0 = 26 * MiB, WS_WM1_1 = 34 * MiB, WS_WM2_0 = 42 * MiB, WS_WM2_1 = 50 * MiB;
constexpr size_t WS_WMKV = 58 * MiB;
constexpr size_t WS_PROJ = 60 * MiB;
constexpr size_t WS_XB = 204 * MiB;
constexpr size_t WS_SSQ = 236 * MiB;
constexpr size_t WS_AB = 245 * MiB;
constexpr size_t WS_MEMKV = 246 * MiB;
constexpr size_t WS_XSQ = 250 * MiB;
constexpr size_t WS_FCUM = 251 * MiB;
constexpr size_t WS_MSSQ = 251 * MiB + 512 * KiB;
constexpr size_t WS_MSQ = 251 * MiB + 768 * KiB;
constexpr size_t WS_END = 252 * MiB;
static_assert(WS_WIN1 + (size_t)N_IN * DM * 2 <= WS_WOUT0 && WS_PROJ + (size_t)MROWS * PW * 2 <= WS_XB && WS_SSQ + (size_t)36 * MROWS * 16 <= WS_AB, "d_ws map");
constexpr size_t DO_MEMB = 0;
constexpr int CW_BAR = 4096;

constexpr int LDS_BYTES = 155648;
constexpr int MISC_OFF = LDS_BYTES - 256;

#define GAS __attribute__((address_space(1)))
#define LAS __attribute__((address_space(3)))
typedef unsigned short bf16;
typedef unsigned v4u __attribute__((ext_vector_type(4)));
typedef float f32x4 __attribute__((ext_vector_type(4)));
typedef short bf16x8 __attribute__((ext_vector_type(8)));
typedef GAS unsigned gu32;
typedef GAS unsigned long long gu64;
#define RLX_AGENT __ATOMIC_RELAXED, __HIP_MEMORY_SCOPE_AGENT
#define LDS_WAIT() asm volatile("s_waitcnt lgkmcnt(0)" ::: "memory")
#define VM_WAIT() asm volatile("s_waitcnt vmcnt(0)" ::: "memory")
__device__ __forceinline__ unsigned long long rt() { return __builtin_amdgcn_s_memrealtime(); }
__device__ __forceinline__ unsigned f2bf(float f) { unsigned u = __builtin_bit_cast(unsigned, f); return (u + 0x7fffu + ((u >> 16) & 1u)) >> 16; }
__device__ __forceinline__ unsigned pk2(float lo, float hi) { return f2bf(lo) | (f2bf(hi) << 16); }

#define XB_TMO      128
#define XB_XCNT(j)  (256  + 64 * (j))
#define XB_XSUB(j)  (1280 + 64 * (j))
#define XB_XGEN(j)  (2304 + 64 * (j))
#define XB_TOP      3328
#define XB_TOPGEN   3392
#define XCD_BAR_WORDS 3456
#define XB_SPIN_CAP (1u << 18)

__device__ __forceinline__ unsigned xb_ld(unsigned* p)              { return __hip_atomic_load(p, __ATOMIC_RELAXED, __HIP_MEMORY_SCOPE_AGENT); }
__device__ __forceinline__ unsigned xb_add(unsigned* p, unsigned v) { return __hip_atomic_fetch_add(p, v, __ATOMIC_RELAXED, __HIP_MEMORY_SCOPE_AGENT); }
__device__ __forceinline__ unsigned xb_xcc_id() { return (unsigned)__builtin_amdgcn_s_getreg((3 << 11) | 20) & 0xFu; }
#define XB_SPIN(cond, bar) do { unsigned _sp = 0; while (cond) { __builtin_amdgcn_s_sleep(1); \
    if ((++_sp & 255u) == 0u) { if (xb_ld(&(bar)[XB_TMO])) break; if (_sp > XB_SPIN_CAP) { atomicAdd(&(bar)[XB_TMO], 1u); break; } } } } while (0)

struct XcdBarrier {
    unsigned* bar; unsigned x; int wv;
    volatile LAS unsigned* st;
};

__device__ __forceinline__ XcdBarrier xcd_barrier_post(unsigned* bar, volatile LAS unsigned* st) {
    XcdBarrier b; b.bar = bar; b.x = xb_xcc_id(); b.st = st;
    if (threadIdx.x == 0) (void)xb_add(&bar[XB_XCNT(b.x)], 1u);
    return b;
}
__device__ __forceinline__ void xcd_barrier_complete(unsigned* bar, unsigned x, unsigned& nloc, unsigned& nx) {
    const unsigned G = gridDim.x * gridDim.y * gridDim.z;
    unsigned sum, cnt, mine, sp = 0u;
    for (;;) {
        sum = 0u; cnt = 0u; mine = 0u;
#pragma unroll
        for (unsigned j = 0; j < 16; ++j) { const unsigned c = xb_ld(&bar[XB_XCNT(j)]); sum += c; cnt += (c > 0u) ? 1u : 0u; mine = (j == x) ? c : mine; }
        if (sum == G) break;
        __builtin_amdgcn_s_sleep(1);
        if ((++sp & 255u) == 0u) { if (xb_ld(&bar[XB_TMO])) break; if (sp > XB_SPIN_CAP) { atomicAdd(&bar[XB_TMO], 1u); break; } }
    }
    nloc = mine > 0u ? mine : 1u; nx = cnt > 0u ? cnt : 1u;
}

__device__ __forceinline__ void xcd_barrier(const XcdBarrier& b) {
    asm volatile("s_waitcnt vmcnt(0)" ::: "memory");
    __syncthreads();
    if (b.wv == 0 && lane_id_v() == 0) {
        unsigned* bar = b.bar;
        __builtin_amdgcn_s_waitcnt(0);
        unsigned nloc = b.st[0], nx = b.st[1];
        if (nloc == 0u) { xcd_barrier_complete(bar, b.x, nloc, nx); b.st[0] = nloc; b.st[1] = nx; }
        const unsigned old = xb_add(&bar[XB_XSUB(b.x)], 1u);
        const unsigned gen = old / nloc;
        if (old + 1u == (gen + 1u) * nloc) {
            __builtin_amdgcn_fence(__ATOMIC_RELEASE, "agent");
            asm volatile("s_waitcnt vmcnt(0)" ::: "memory");
            const unsigned og = xb_add(&bar[XB_TOP], 1u);
            const unsigned tg = og / nx;
            if (og + 1u == (tg + 1u) * nx) xb_add(&bar[XB_TOPGEN], 1u);
            else XB_SPIN(xb_ld(&bar[XB_TOPGEN]) == tg, bar);
            __builtin_amdgcn_fence(__ATOMIC_ACQUIRE, "agent");
            xb_add(&bar[XB_XGEN(b.x)], 1u);
            asm volatile("s_waitcnt vmcnt(0)" ::: "memory");
        } else {
            XB_SPIN(xb_ld(&bar[XB_XGEN(b.x)]) == gen, bar);
            __builtin_amdgcn_fence(__ATOMIC_ACQUIRE, "agent");
            asm volatile("s_waitcnt vmcnt(0)" ::: "memory");
        }
    }
    __syncthreads();
}


__device__ __forceinline__ float bflo(unsigned u) { return __builtin_bit_cast(float, u << 16); }
__device__ __forceinline__ float bfhi(unsigned u) { return __builtin_bit_cast(float, u & 0xffff0000u); }
typedef float f32x2_t __attribute__((ext_vector_type(2))); typedef __bf16 bf16x2_t __attribute__((ext_vector_type(2)));
__device__ __forceinline__ unsigned pkbf(float lo, float hi) { const f32x2_t v = {lo, hi}; const bf16x2_t b = __builtin_convertvector(v, bf16x2_t); return __builtin_bit_cast(unsigned, b); }
__device__ __forceinline__ float wave_sum(float v) { return add_xor32(add_xor16(row16_sum(v))); }
__device__ __forceinline__ float wave_max(float v) {
#pragma unroll
    for (int o = 1; o < 64; o <<= 1) v = fmaxf(v, __shfl_xor(v, o));
    return v;
}

struct Args { const float* in[20]; float* out; unsigned char* ws; int ph_lo, ph_hi, li, pad; };
enum { I_X = 0, I_MEM, I_MEMNW, I_WMKV, I_MEMKNW, I_NORM1, I_DNWIN, I_DNCONV, I_DNALOG, I_DNDT, I_DNONW, I_FOXWIN, I_FOXFB, I_FOXQNW, I_FOXKNW, I_MEMQNW, I_WOUT, I_NORM2, I_WM1, I_WM2 };

struct Frame {
    LAS unsigned char* lds;
    int G, bid, wv;
    const float* const* in; float* out; unsigned char* ws;
};


constexpr int CW_XCC = 32768, CW_BAD = 33792, CW_GRP = 65536;
struct GrpBar { unsigned* cnt; unsigned* tmo; int wv; bool on; };
__device__ __forceinline__ void grp_barrier(const GrpBar& gb, int seam) {
    asm volatile("s_waitcnt vmcnt(0)" ::: "memory");
    __syncthreads();
    if (gb.wv == 0 && lane_id_v() == 0) { unsigned* p = gb.cnt + seam * 64;
        (void)__hip_atomic_fetch_add(p, 1u, __ATOMIC_RELAXED, __HIP_MEMORY_SCOPE_AGENT);
        unsigned sp = 0;
        while (__hip_atomic_load(p, __ATOMIC_RELAXED, __HIP_MEMORY_SCOPE_AGENT) < 4u) { __builtin_amdgcn_s_sleep(1); if (++sp > (1u << 22)) { atomicAdd(gb.tmo, 1u); break; } }
        __builtin_amdgcn_fence(__ATOMIC_ACQUIRE, "agent");
        asm volatile("s_waitcnt vmcnt(0)" ::: "memory"); }
    __syncthreads();
}
struct Tix { int tid, lane, wave; };
__device__ __forceinline__ int lane_id() { return lane_id_v(); }
__device__ __forceinline__ Tix tix(int wv) { Tix t; t.lane = lane_id(); t.wave = wv; t.tid = wv * 64 + t.lane; return t; }
struct TSeg { const float* W; int K, ldw, src0, ncols; bf16* WT; int dst0; const float* scale; };
__device__ __forceinline__ TSeg get_seg(const Frame& F, int s) {
    TSeg t; t.scale = nullptr; t.src0 = 0; t.dst0 = 0;
    if (s < 12) {
        const int l = s / 6, j = s % 6;
        t.W = l ? F.in[I_FOXWIN] : F.in[I_DNWIN]; t.K = DM; t.ldw = l ? FOX_IN : DN_IN; t.WT = (bf16*)(F.ws + (l ? WS_WIN1 : WS_WIN0)); t.scale = F.in[I_NORM1] + l * DM;
        const int qm0 = l ? 4104 : 4112, nsc = l ? 8 : 16;
        t.ncols = 1024;
        if (j == 0) { t.src0 = 1024; t.dst0 = PC_K; } else if (j == 1) { t.src0 = 2048; t.dst0 = PC_V; } else if (j == 2) { t.src0 = 3072; t.dst0 = PC_Z; }
        else if (j == 3) { t.src0 = 0; t.dst0 = PC_Q; } else if (j == 4) { t.src0 = qm0; t.dst0 = PC_QM; t.ncols = 512; } else { t.src0 = 4096; t.dst0 = PC_AB; t.ncols = nsc; }
    } else if (s < 14) { const int l = s - 12; t.W = F.in[I_WOUT] + (size_t)l * OUT_IN * DM; t.K = OUT_IN; t.ldw = DM; t.ncols = DM; t.WT = (bf16*)(F.ws + (l ? WS_WOUT1 : WS_WOUT0)); }
    else if (s < 16) { const int l = s - 14; t.W = F.in[I_WM1] + (size_t)l * DM * FF; t.K = DM; t.ldw = FF; t.ncols = FF; t.WT = (bf16*)(F.ws + (l ? WS_WM1_1 : WS_WM1_0)); t.scale = F.in[I_NORM2] + l * DM; }
    else if (s < 18) { const int l = s - 16; t.W = F.in[I_WM2] + (size_t)l * FF * DM; t.K = FF; t.ldw = DM; t.ncols = DM; t.WT = (bf16*)(F.ws + (l ? WS_WM2_1 : WS_WM2_0)); }
    else { t.W = F.in[I_WMKV]; t.K = DM; t.ldw = DM; t.ncols = DM; t.WT = (bf16*)(F.ws + WS_WMKV); t.scale = F.in[I_MEMNW]; }
    return t;
}
__device__ __forceinline__ int seg_items(const TSeg& t) { return (t.K / 64) * ((t.ncols + 63) / 64); }
__device__ __forceinline__ void tr_load(const TSeg& t, int item, int lane, f32x4 (&v)[16]) {
    const int nblk = (t.ncols + 63) / 64, kb = item / nblk, nb = item - kb * nblk, k0 = 64 * kb, n0 = 64 * nb;
    const int n4 = (lane & 15) * 4, kr = lane >> 4; const bool ok = (n0 + n4) < t.ncols;
    const float* p = t.W + (size_t)(k0 + kr) * t.ldw + t.src0 + n0 + n4;
#pragma unroll
    for (int i = 0; i < 16; ++i) v[i] = ok ? __builtin_nontemporal_load((const f32x4*)(p + (size_t)(4 * i) * t.ldw)) : (f32x4){0.f, 0.f, 0.f, 0.f};
}
__device__ __forceinline__ void tr_store(const TSeg& t, int item, int lane, const f32x4 (&v)[16], LAS float* scr) {
    const int nblk = (t.ncols + 63) / 64, kb = item / nblk, nb = item - kb * nblk, k0 = 64 * kb, n0 = 64 * nb;
    const int n4 = (lane & 15) * 4, kr = lane >> 4;
#pragma unroll
    for (int i = 0; i < 16; ++i) *(LAS f32x4*)(scr + (4 * i + kr) * 68 + n4) = v[i];
    LDS_WAIT(); asm volatile("" ::: "memory");
    const int c = lane & 7; f32x4 s0 = {1.f, 1.f, 1.f, 1.f}, s1 = s0;
    if (t.scale) { s0 = *(const f32x4*)(t.scale + k0 + 8 * c); s1 = *(const f32x4*)(t.scale + k0 + 8 * c + 4); }
#pragma unroll
    for (int j = 0; j < 8; ++j) { const int n = (lane >> 3) + 8 * j; const LAS float* q = scr + (8 * c) * 68 + n;
        v4u o; o.x = pkbf(q[0 * 68] * s0[0], q[1 * 68] * s0[1]); o.y = pkbf(q[2 * 68] * s0[2], q[3 * 68] * s0[3]); o.z = pkbf(q[4 * 68] * s1[0], q[5 * 68] * s1[1]); o.w = pkbf(q[6 * 68] * s1[2], q[7 * 68] * s1[3]);
        if (n0 + n < t.ncols) *(v4u*)(t.WT + (size_t)(t.dst0 + n0 + n) * t.K + k0 + 8 * c) = o; }
    LDS_WAIT(); asm volatile("" ::: "memory");
}
template <int NR> __device__ __forceinline__ void rows_to_bf16(int lane, const float* x, bf16* o, float* sq) {
    f32x4 v[NR][4];
#pragma unroll
    for (int r = 0; r < NR; ++r)
#pragma unroll
        for (int j = 0; j < 4; ++j) v[r][j] = __builtin_nontemporal_load((const f32x4*)(x + (size_t)r * DM) + lane + 64 * j);
#pragma unroll
    for (int r = 0; r < NR; ++r) { float s = 0.f;
#pragma unroll
        for (int j = 0; j < 4; ++j) s += (v[r][j].x * v[r][j].x + v[r][j].y * v[r][j].y) + (v[r][j].z * v[r][j].z + v[r][j].w * v[r][j].w);
        s = wave_sum(s);
        unsigned long long* o8 = (unsigned long long*)(o + (size_t)r * DM) + lane;
#pragma unroll
        for (int j = 0; j < 4; ++j) o8[64 * j] = (unsigned long long)pkbf(v[r][j].x, v[r][j].y) | ((unsigned long long)pkbf(v[r][j].z, v[r][j].w) << 32);
        if (lane < 16) sq[(size_t)r * 16 + lane] = lane == 0 ? s : 0.f; }
}
template <int S0, int S1> __device__ __forceinline__ void convert_weights(const Frame& F, LAS float* scr, int lane, int gw, int NGW, int base) {
#pragma unroll
    for (int s = S0; s < S1; ++s) {
        const TSeg t = get_seg(F, s); const int n = seg_items(t);
        int it = gw - (base % NGW); if (it < 0) it += NGW;
        f32x4 va[16], vb[16];
        if (it < n) tr_load(t, it, lane, va);
        while (it < n) {
            int nx = it + NGW; if (nx < n) tr_load(t, nx, lane, vb);
            tr_store(t, it, lane, va, scr); it = nx; if (it >= n) break;
            nx = it + NGW; if (nx < n) tr_load(t, nx, lane, va);
            tr_store(t, it, lane, vb, scr); it = nx;
        }
        base += n;
    }
}
__device__ __forceinline__ void p0_prologue(const Frame& F) {
    const Tix T = tix(F.wv);
    LAS float* scr = (LAS float*)(F.lds + T.wave * 17408);
    const int gw = F.bid * NWAVES + T.wave, NGW = F.G * NWAVES;
    for (int m = gw * 4; m < MROWS; m += NGW * 4) rows_to_bf16<4>(T.lane, F.in[I_X] + (size_t)m * DM, (bf16*)(F.ws + WS_XB) + (size_t)m * DM, (float*)(F.ws + WS_XSQ) + (size_t)m * 16);
    for (int m = gw; m < MMEM; m += NGW) rows_to_bf16<1>(T.lane, F.in[I_MEM] + (size_t)m * DM, (bf16*)((unsigned char*)F.out + DO_MEMB) + (size_t)m * DM, (float*)(F.ws + WS_MSQ) + (size_t)m * 16);
    convert_weights<0, 6>(F, scr, T.lane, gw, NGW, 0);
    convert_weights<18, 19>(F, scr, T.lane, gw, NGW, 1168);
}

typedef short dn_bf16x8 __attribute__((ext_vector_type(8)));
typedef unsigned dn_u32x2 __attribute__((ext_vector_type(2)));
__device__ __forceinline__ f32x4 mfma16(dn_bf16x8 a, dn_bf16x8 b, f32x4 c) { return __builtin_amdgcn_mfma_f32_16x16x32_bf16(a, b, c, 0, 0, 0); }
__device__ __forceinline__ f32x4 mfma4(float a, float b, f32x4 c) { return __builtin_amdgcn_mfma_f32_16x16x4f32(a, b, c, 0, 0, 0); }
__device__ __forceinline__ dn_bf16x8 pack8f(f32x4 x, f32x4 y) { v4u w; w.x = pkbf(x[0], x[1]); w.y = pkbf(x[2], x[3]); w.z = pkbf(y[0], y[1]); w.w = pkbf(y[2], y[3]); return __builtin_bit_cast(dn_bf16x8, w); }
__device__ __forceinline__ dn_u32x2 pack4f(f32x4 x) { dn_u32x2 w; w.x = pkbf(x[0], x[1]); w.y = pkbf(x[2], x[3]); return w; }
__device__ __forceinline__ unsigned short bf1(float x) { return (unsigned short)(pkbf(x, 0.f) & 0xffffu); }
constexpr size_t DO_QKS = 4 * MiB, DO_HALO = 20 * MiB, DO_EGL = 27 * MiB, DO_WNEG = 28 * MiB;
constexpr int P_RAW = 0, P_GB = 51712, P_QH = 53248, P_KH = 70656, P_VBT = 88064, P_KBGT = 106496, P_QKL = 124928, P_END = 134144;
constexpr int P_AT = 0, P_TB = 17408, P_PS = 26624, P_PS2 = 29184;
struct DnPre { v4u P[7]; float ga, gb; f32x4 cw[3][4]; };
__device__ __forceinline__ void dn_prep_load(const Frame& F, int u, DnPre& R) {
    const Tix T = tix(F.wv); const int tid = T.tid, lane = T.lane;
    const int bh = u >> 5, c = u & 31, b = bh >> 3, h = bh & 7; const size_t row0 = (size_t)b * SEQ + c * 64; const int gch = b * 32 + c;
    const bf16* proj = (const bf16*)(F.ws + WS_PROJ); const float* AB = (const float*)(F.ws + WS_AB); const bf16* halo = (const bf16*)((unsigned char*)F.out + DO_HALO);
#pragma unroll
    for (int j = 0; j < 7; ++j) { const int id = tid + 512 * j; v4u val = {0u, 0u, 0u, 0u};
        if (id < 67 * 48) { const int r = id / 48, rem = id - r * 48, seg = rem >> 4, ch = rem & 15;
            const int col = (seg == 0 ? PC_Q : seg == 1 ? PC_K : PC_V) + h * HD + ch * 8;
            if (r >= 3) val = *(const v4u*)(proj + (row0 + r - 3) * PW + col);
            else if (c > 0) val = *(const v4u*)(halo + ((size_t)(gch - 1) * 3 + r) * PW + col); }
        R.P[j] = val; }
    R.ga = AB[(row0 + lane) * 16 + h]; R.gb = AB[(row0 + lane) * 16 + 8 + h];
    const float* convw = F.in[I_DNCONV]; const int c4 = lane & 31;
#pragma unroll
    for (int seg = 0; seg < 3; ++seg)
#pragma unroll
        for (int j = 0; j < 4; ++j) R.cw[seg][j] = *(const f32x4*)(convw + j * 3072 + seg * 1024 + h * HD + 4 * c4);
}
__device__ __forceinline__ void dn_prep_unit(const Frame& F, int u, int u_next, DnPre& R) {
    const Tix T = tix(F.wv); const int tid = T.tid, lane = T.lane, wave = T.wave, m = lane & 15, g = lane >> 4;
    const int bh = u >> 5, c = u & 31, b = bh >> 3, h = bh & 7; const size_t row0 = (size_t)b * SEQ + c * 64;
    bf16* proj = (bf16*)(F.ws + WS_PROJ);
    bf16* xbimg = (bf16*)((unsigned char*)F.out + DO_WNEG) + (size_t)u * 8192; bf16* qks = (bf16*)((unsigned char*)F.out + DO_QKS) + (size_t)u * 4096; float* egl = (float*)((unsigned char*)F.out + DO_EGL);
    LAS unsigned char* L = F.lds; LAS float* GB = (LAS float*)(L + P_GB);
#pragma unroll
    for (int j = 0; j < 7; ++j) { const int id = tid + 512 * j;
        if (id < 67 * 48) { const int r = id / 48, rem = id - r * 48, seg = rem >> 4, ch = rem & 15; *(LAS v4u*)(L + P_RAW + r * 768 + seg * 256 + ch * 16) = R.P[j]; } }
    if (wave == 0) { const float a = R.ga, bb = R.gb;
        const float x = a + F.in[I_DNDT][h], sp = fmaxf(x, 0.f) + log1pf(__expf(-fabsf(x)));
        const float gt = -__expf(F.in[I_DNALOG][h]) * sp, beta = __builtin_amdgcn_rcpf(1.f + __expf(-bb));
        float gc = gt;
#pragma unroll
        for (int o = 1; o < 64; o <<= 1) { const float t = __shfl_up(gc, o); if (lane >= o) gc += t; }
        const float gl = __shfl(gc, 63);
        GB[lane] = gc; GB[64 + lane] = beta; GB[128 + lane] = beta * __expf(gc); GB[192 + lane] = __expf(gl - gc); GB[256 + lane] = __expf(gc);
        if (lane == 0) egl[u] = __expf(gl); }
    f32x4 cw[3][4];
#pragma unroll
    for (int seg = 0; seg < 3; ++seg)
#pragma unroll
        for (int j = 0; j < 4; ++j) cw[seg][j] = R.cw[seg][j];
    __syncthreads();
    if (u_next >= 0) dn_prep_load(F, u_next, R);
    { const int hf = lane >> 5, c4 = lane & 31;
#pragma unroll
      for (int jj = 0; jj < 12; ++jj) { constexpr int dummy_ = 0; (void)dummy_; const int seg = jj >> 2;
        const int wi = wave + 8 * jj, i = 2 * (wi & 31) + hf;
        f32x4 y = {0.f, 0.f, 0.f, 0.f};
#pragma unroll
        for (int j = 0; j < 4; ++j) { const f32x4 w = cw[seg][j];
            const dn_u32x2 xx = *(const LAS dn_u32x2*)(L + P_RAW + (i + j) * 768 + seg * 256 + c4 * 8);
            y[0] += w[0] * bflo(xx.x); y[1] += w[1] * bfhi(xx.x); y[2] += w[2] * bflo(xx.y); y[3] += w[3] * bfhi(xx.y); }
        f32x4 s;
#pragma unroll
        for (int e = 0; e < 4; ++e) s[e] = y[e] * __builtin_amdgcn_rcpf(1.f + __expf(-y[e]));
        if (seg < 2) { float ss = (s[0] * s[0] + s[1] * s[1]) + (s[2] * s[2] + s[3] * s[3]);
            ss = add_xor16(row16_sum(ss));
            const float r = rsqrtf(ss + EPS) * (seg == 0 ? QSCALE : 1.f);
            s = s * r;
            *(LAS dn_u32x2*)(L + (seg == 0 ? P_QH : P_KH) + i * 272 + c4 * 8) = pack4f(s);
            if (seg == 0) { const int cc = c4 & 7, p0 = cc < 4 ? 8 * cc : 8 * (cc - 4) + 4;
                *(dn_u32x2*)(proj + (row0 + i) * PW + PC_Q + h * HD + 32 * (c4 >> 3) + p0) = pack4f(s * GB[256 + i]); }
            else { const float bge = GB[128 + i];
#pragma unroll
                for (int e = 0; e < 4; ++e) *(LAS unsigned short*)(L + P_KBGT + (4 * c4 + e) * 144 + i * 2) = bf1(s[e] * bge); } }
        else { const float be = GB[64 + i];
#pragma unroll
            for (int e = 0; e < 4; ++e) *(LAS unsigned short*)(L + P_VBT + (4 * c4 + e) * 144 + i * 2) = bf1(s[e] * be); } } }
    __syncthreads();
    LAS float* AT = (LAS float*)(L + P_AT);
#pragma unroll
    for (int q = 0; q < 2; ++q) { const int tt = wave + 8 * q, it = tt >> 2, jt = tt & 3;
        f32x4 kk = {0.f, 0.f, 0.f, 0.f}, qk = {0.f, 0.f, 0.f, 0.f};
        if (jt <= it) {
#pragma unroll
            for (int kq = 0; kq < 4; ++kq) { const dn_bf16x8 bk = *(const LAS dn_bf16x8*)(L + P_KH + (16 * jt + m) * 272 + (32 * kq + 8 * g) * 2);
                const dn_bf16x8 ak = *(const LAS dn_bf16x8*)(L + P_KH + (16 * it + m) * 272 + (32 * kq + 8 * g) * 2), aq = *(const LAS dn_bf16x8*)(L + P_QH + (16 * it + m) * 272 + (32 * kq + 8 * g) * 2);
                kk = mfma16(ak, bk, kk); qk = mfma16(aq, bk, qk); } }
        const int j = 16 * jt + m, jl = j & 31, p = jl < 16 ? 8 * (jl >> 2) + (jl & 3) : 8 * ((jl - 16) >> 2) + 4 + (jl & 3);
        const float gcj = GB[j];
#pragma unroll
        for (int r = 0; r < 4; ++r) { const int i = 16 * it + 4 * g + r; const float dec = i >= j ? __expf(GB[i] - gcj) : 0.f;
            AT[i * 68 + j] = i > j ? GB[64 + i] * kk[r] * dec : 0.f;
            *(LAS unsigned short*)(L + P_QKL + i * 144 + (32 * (j >> 5) + p) * 2) = bf1(qk[r] * dec); } }
    __syncthreads();
    if (wave >= 4) { const int t4 = tid - 256;
        for (int id = t4; id < 1024; id += 256) { const int k = id >> 3, sp = (id >> 2) & 1, gg = id & 3; float o8[8];
#pragma unroll
            for (int j = 0; j < 8; ++j) { const int cc = 32 * sp + (j < 4 ? 4 * gg + j : 16 + 4 * gg + j - 4);
                o8[j] = bflo((unsigned)*(const LAS unsigned short*)(L + P_KH + cc * 272 + k * 2)) * GB[192 + cc]; }
            v4u w; w.x = pkbf(o8[0], o8[1]); w.y = pkbf(o8[2], o8[3]); w.z = pkbf(o8[4], o8[5]); w.w = pkbf(o8[6], o8[7]);
            *(v4u*)(proj + (row0 + (k >> 1)) * PW + PC_K + h * HD + (k & 1) * 64 + 32 * sp + 8 * gg) = w; }
        for (int id = t4; id < 512; id += 256) { const int i = id >> 3, j8 = (id & 7) * 8;
            *(v4u*)(qks + i * 64 + j8) = *(const LAS v4u*)(L + P_QKL + i * 144 + j8 * 2); } }
    if (wave == 0) { const int bb = g, j = m; float X[16];
        X[0] = j == 0 ? 1.f : 0.f;
#pragma unroll
        for (int i = 1; i < 16; ++i) { const LAS float* Lr = AT + (16 * bb + i) * 68 + 16 * bb; float Lv[16];
#pragma unroll
            for (int q = 0; q < (i + 3) / 4; ++q) { const f32x4 t = *(const LAS f32x4*)(Lr + 4 * q); Lv[4 * q] = t[0]; Lv[4 * q + 1] = t[1]; Lv[4 * q + 2] = t[2]; Lv[4 * q + 3] = t[3]; }
            float acc = i == j ? 1.f : 0.f;
#pragma unroll
            for (int mm = 0; mm < i; ++mm) acc -= Lv[mm] * X[mm];
            X[i] = acc; }
#pragma unroll
        for (int i = 0; i < 16; ++i) AT[(16 * bb + i) * 68 + 16 * bb + j] = X[i]; }
    __syncthreads();
    if (wave < 2) { const int lo = 2 * wave, hi = 2 * wave + 1; LAS float* PS = (LAS float*)(L + P_PS) + wave * 320;
        f32x4 acc = {0.f, 0.f, 0.f, 0.f};
#pragma unroll
        for (int s = 0; s < 4; ++s) acc = mfma4(AT[(16 * hi + m) * 68 + 16 * lo + 4 * s + g], AT[(16 * lo + 4 * s + g) * 68 + 16 * lo + m], acc);
#pragma unroll
        for (int r = 0; r < 4; ++r) PS[(4 * g + r) * 20 + m] = acc[r];
        LDS_WAIT();
        f32x4 acc2 = {0.f, 0.f, 0.f, 0.f};
#pragma unroll
        for (int s = 0; s < 4; ++s) acc2 = mfma4(AT[(16 * hi + m) * 68 + 16 * hi + 4 * s + g], PS[(4 * s + g) * 20 + m], acc2);
#pragma unroll
        for (int r = 0; r < 4; ++r) AT[(16 * hi + 4 * g + r) * 68 + 16 * lo + m] = -acc2[r]; }
    __syncthreads();
    { LAS float* PS2 = (LAS float*)(L + P_PS2); const int ti = (wave >> 1) & 1, tj = wave & 1;
      if (wave < 4) { f32x4 acc = {0.f, 0.f, 0.f, 0.f};
#pragma unroll
          for (int s = 0; s < 8; ++s) acc = mfma4(AT[(32 + 16 * ti + m) * 68 + 4 * s + g], AT[(4 * s + g) * 68 + 16 * tj + m], acc);
#pragma unroll
          for (int r = 0; r < 4; ++r) PS2[(16 * ti + 4 * g + r) * 36 + 16 * tj + m] = acc[r]; }
      __syncthreads();
      if (wave < 4) { f32x4 acc = {0.f, 0.f, 0.f, 0.f};
#pragma unroll
          for (int s = 0; s < 8; ++s) acc = mfma4(AT[(32 + 16 * ti + m) * 68 + 32 + 4 * s + g], PS2[(4 * s + g) * 36 + 16 * tj + m], acc);
#pragma unroll
          for (int r = 0; r < 4; ++r) AT[(32 + 16 * ti + 4 * g + r) * 68 + 16 * tj + m] = -acc[r]; } }
    __syncthreads();
    { const int i = tid >> 3, j0 = (tid & 7) * 8; const f32x4 t0 = *(const LAS f32x4*)(AT + i * 68 + j0), t1 = *(const LAS f32x4*)(AT + i * 68 + j0 + 4);
      v4u w; w.x = pkbf(t0[0], t0[1]); w.y = pkbf(t0[2], t0[3]); w.z = pkbf(t1[0], t1[1]); w.w = pkbf(t1[2], t1[3]);
      *(LAS v4u*)(L + P_TB + i * 144 + j0 * 2) = w; }
    __syncthreads();
#pragma unroll
    for (int q = 0; q < 8; ++q) { const int tt = wave + 8 * q; f32x4 acc = {0.f, 0.f, 0.f, 0.f};
        if (tt < 32) { const int ct = tt >> 3, nt = tt & 7;
#pragma unroll
            for (int sp = 0; sp < 2; ++sp) acc = mfma16(*(const LAS dn_bf16x8*)(L + P_TB + (16 * ct + m) * 144 + (32 * sp + 8 * g) * 2), *(const LAS dn_bf16x8*)(L + P_VBT + (16 * nt + m) * 144 + (32 * sp + 8 * g) * 2), acc);
            const int v = 16 * nt + m;
            *(dn_u32x2*)(proj + (row0 + (v >> 1)) * PW + PC_V + h * HD + (v & 1) * 64 + 16 * ct + 4 * g) = pack4f(acc); }
        else { const int t2 = tt - 32, kt = t2 >> 2, ct = t2 & 3;
#pragma unroll
            for (int sp = 0; sp < 2; ++sp) acc = mfma16(*(const LAS dn_bf16x8*)(L + P_KBGT + (16 * kt + m) * 144 + (32 * sp + 8 * g) * 2), *(const LAS dn_bf16x8*)(L + P_TB + (16 * ct + m) * 144 + (32 * sp + 8 * g) * 2), acc);
            *(dn_u32x2*)(xbimg + (16 * ct + m) * 128 + 32 * (kt >> 1) + 8 * g + 4 * (kt & 1)) = pack4f(-acc); } }
    __syncthreads();
}
constexpr int S_WN = 0, S_QG = 17408, S_KDT = 34816, S_QKM = 53248, S_UT = 62464, S_OB = 80896, S_PSQ = 114688, S_ONW = 116736, S_Z = 117248, S_END = 152064;
static_assert(S_END <= MISC_OFF, "scan LDS map");
__device__ __forceinline__ void dn_scan_unit(const Frame& F, int bh) {
    const Tix T = tix(F.wv); const int tid = T.tid, lane = T.lane, wave = T.wave, m = lane & 15, g = lane >> 4, n0 = 32 * wave;
    const int b = bh >> 3, h = bh & 7;
    bf16* proj = (bf16*)(F.ws + WS_PROJ); const bf16* xbi = (const bf16*)((const unsigned char*)F.out + DO_WNEG); const bf16* qks = (const bf16*)((unsigned char*)F.out + DO_QKS); const float* egl = (const float*)((unsigned char*)F.out + DO_EGL);
    LAS unsigned char* L = F.lds;
    LAS float* OB = (LAS float*)(L + S_OB);
    constexpr int NC = SEQ / 64;
#define WGBAR() do { asm volatile("s_waitcnt lgkmcnt(0)" ::: "memory"); __builtin_amdgcn_s_barrier(); asm volatile("" ::: "memory"); } while (0)
    if (wave >= 4) {
        const int ht = tid - 256;
        const unsigned lo_lin = (unsigned)ht * 16u;
        const unsigned lo_qg = (unsigned)(((ht >> 4) * PW + (ht & 15) * 8) * 2);
        const unsigned lo_kv = (unsigned)(((ht >> 4) * PW + ((ht >> 3) & 1) * 64 + (ht & 7) * 8) * 2);
        const unsigned ld_a = (unsigned)((ht >> 4) * 272 + (ht & 15) * 16), ld_b = (unsigned)((ht >> 3) * 144 + (ht & 7) * 16);
        const unsigned lo_fin = (unsigned)(((ht >> 2) * PW + (ht & 3) * 32) * 2);
        v4u RP[12], RQ[10];
#define DN_LOAD_P(cc) do { const size_t r0_ = (size_t)b * SEQ + (cc) * 64; const size_t u_ = (size_t)bh * 32 + (cc);               \
        _Pragma("unroll") for (int j_ = 0; j_ < 4; ++j_) {                                                                                                \
            RP[j_] = __builtin_nontemporal_load((const v4u*)((const char*)(xbi + u_ * 8192 + 2048 * j_) + lo_lin));                                                                    \
            RP[4 + j_] = __builtin_nontemporal_load((const v4u*)((const char*)(proj + (r0_ + 16 * j_) * PW + PC_Q + h * HD) + lo_qg));                                                 \
            RP[8 + j_] = __builtin_nontemporal_load((const v4u*)((const char*)(proj + (r0_ + 16 * j_) * PW + PC_V + h * HD) + lo_kv)); } } while (0)
#define DN_LOAD_Q(cc) do { const size_t r0_ = (size_t)b * SEQ + (cc) * 64; const size_t u_ = (size_t)bh * 32 + (cc);     \
        _Pragma("unroll") for (int j_ = 0; j_ < 4; ++j_) {                                                                                                \
            RQ[j_] = __builtin_nontemporal_load((const v4u*)((const char*)(proj + (r0_ + 16 * j_) * PW + PC_K + h * HD) + lo_kv));                                                     \
            RQ[4 + j_] = __builtin_nontemporal_load((const v4u*)((const char*)(proj + (r0_ + 16 * j_) * PW + PC_Z + h * HD) + lo_qg)); }                                               \
        _Pragma("unroll") for (int j_ = 0; j_ < 2; ++j_) RQ[8 + j_] = __builtin_nontemporal_load((const v4u*)((const char*)(qks + u_ * 4096 + 2048 * j_) + lo_lin)); } while (0)
#define DN_WRITE_P() do { _Pragma("unroll") for (int j_ = 0; j_ < 4; ++j_) {                                                                               \
            *(LAS v4u*)(L + S_WN + ld_a + j_ * 4352) = RP[j_]; *(LAS v4u*)(L + S_QG + ld_a + j_ * 4352) = RP[4 + j_]; *(LAS v4u*)(L + S_UT + ld_b + j_ * 4608) = RP[8 + j_]; } } while (0)
#define DN_WRITE_Q(cc) do { _Pragma("unroll") for (int j_ = 0; j_ < 4; ++j_) { *(LAS v4u*)(L + S_KDT + ld_b + j_ * 4608) = RQ[j_];                         \
            *(LAS v4u*)(L + S_Z + ((cc) & 1) * 17408 + ld_a + j_ * 4352) = RQ[4 + j_]; }                                                                    \
        _Pragma("unroll") for (int j_ = 0; j_ < 2; ++j_) *(LAS v4u*)(L + S_QKM + ld_b + j_ * 4608) = RQ[8 + j_]; } while (0)
#define DN_FINAL(cc) do { const int fr_ = ht >> 2, fc_ = (ht & 3) * 32; float ss_ = 0.f;     \
        _Pragma("unroll") for (int p_ = 0; p_ < 8; ++p_) { const f32x4 o_ = *(const LAS f32x4*)(OB + fr_ * 132 + fc_ + 4 * p_);                              \
            ss_ += (o_[0] * o_[0] + o_[1] * o_[1]) + (o_[2] * o_[2] + o_[3] * o_[3]); }                                                                     \
        ss_ += dppf<0xB1>(ss_); ss_ += dppf<0x4E>(ss_);                                                                                                     \
        const float rn_ = rsqrtf(ss_ * (1.f / 128.f) + EPS);                                                                                               \
        bf16* dst_ = (bf16*)((char*)(proj + ((size_t)b * SEQ + (cc) * 64) * PW + PC_Q + h * HD) + lo_fin);              \
        _Pragma("unroll") for (int p_ = 0; p_ < 4; ++p_) {                                                                                                 \
            const f32x4 oa_ = *(const LAS f32x4*)(OB + fr_ * 132 + fc_ + 8 * p_), ob_ = *(const LAS f32x4*)(OB + fr_ * 132 + fc_ + 8 * p_ + 4);             \
            const v4u z_ = *(const LAS v4u*)(L + S_Z + ((cc) & 1) * 17408 + fr_ * 272 + (fc_ + 8 * p_) * 2);                                                \
            v4u w_; w_.x = pkbf(oa_[0] * rn_ * bflo(z_.x), oa_[1] * rn_ * bfhi(z_.x)); w_.y = pkbf(oa_[2] * rn_ * bflo(z_.y), oa_[3] * rn_ * bfhi(z_.y));   \
            w_.z = pkbf(ob_[0] * rn_ * bflo(z_.z), ob_[1] * rn_ * bfhi(z_.z)); w_.w = pkbf(ob_[2] * rn_ * bflo(z_.w), ob_[3] * rn_ * bfhi(z_.w));           \
            *(v4u*)(dst_ + 8 * p_) = w_; } } while (0)
        DN_LOAD_P(0); DN_LOAD_Q(0); DN_WRITE_P(); DN_WRITE_Q(0); DN_LOAD_P(1); DN_LOAD_Q(1);
        WGBAR();
        for (int c = 0; c < NC; ++c) {
            if (c > 0) { DN_FINAL(c - 1); DN_WRITE_Q(c); if (c + 1 < NC) DN_LOAD_Q(c + 1); }
            WGBAR();
            if (c + 1 < NC) { DN_WRITE_P(); if (c + 2 < NC) DN_LOAD_P(c + 2); }
            WGBAR();
        }
        DN_FINAL(NC - 1);
#undef DN_LOAD_P
#undef DN_LOAD_Q
#undef DN_WRITE_P
#undef DN_WRITE_Q
#undef DN_FINAL
    } else {
        f32x4 Sacc[2][8];
#pragma unroll
        for (int kt = 0; kt < 8; ++kt) { Sacc[0][kt] = (f32x4){0.f, 0.f, 0.f, 0.f}; Sacc[1][kt] = (f32x4){0.f, 0.f, 0.f, 0.f}; }
        const unsigned* eglu = (const unsigned*)egl + (size_t)bh * 32;
        float eg_next = __uint_as_float(__hip_atomic_load(eglu, __ATOMIC_RELAXED, __HIP_MEMORY_SCOPE_AGENT));
        const LAS unsigned char* fa = L + m * 272 + g * 16;
        const LAS unsigned char* fb = L + m * 144 + g * 16;
#define SBAR() __builtin_amdgcn_sched_barrier(0)
#define LD_A(X, base, ct) do { _Pragma("unroll") for (int s_ = 0; s_ < 4; ++s_) X[s_] = *(const LAS dn_bf16x8*)(fa + (base) + (ct) * 4352 + s_ * 64); } while (0)
#define LD_B(X, base, i0) do { _Pragma("unroll") for (int s_ = 0; s_ < 4; ++s_) X[s_] = *(const LAS dn_bf16x8*)(fb + (base) + ((i0) + (s_ >> 1)) * 2304 + (s_ & 1) * 64); } while (0)
        WGBAR();
        for (int c = 0; c < NC; ++c) {
            const float eg = eg_next;
            if (c + 1 < NC) eg_next = __uint_as_float(__hip_atomic_load(eglu + c + 1, __ATOMIC_RELAXED, __HIP_MEMORY_SCOPE_AGENT));
            dn_bf16x8 SB[2][4], X0[4], X1[4];
            LD_A(X0, S_WN, 0);
#pragma unroll
            for (int sl = 0; sl < 2; ++sl)
#pragma unroll
                for (int s = 0; s < 4; ++s) SB[sl][s] = pack8f(Sacc[sl][2 * s], Sacc[sl][2 * s + 1]);
            f32x4 VN[2][4], O[2][4];
#pragma unroll
            for (int ct = 0; ct < 4; ++ct)
#pragma unroll
                for (int sl = 0; sl < 2; ++sl) { const dn_u32x2 uu = *(const LAS dn_u32x2*)(L + S_UT + (n0 + 16 * sl + m) * 144 + (16 * ct + 4 * g) * 2);
                    VN[sl][ct] = (f32x4){bflo(uu.x), bfhi(uu.x), bflo(uu.y), bfhi(uu.y)}; O[sl][ct] = (f32x4){0.f, 0.f, 0.f, 0.f}; }
#pragma unroll
            for (int ct = 0; ct < 4; ++ct) {
                SBAR(); LD_A(X1, S_QG, ct); SBAR();
#pragma unroll
                for (int s = 0; s < 4; ++s) { VN[0][ct] = mfma16(X0[s], SB[0][s], VN[0][ct]); VN[1][ct] = mfma16(X0[s], SB[1][s], VN[1][ct]); }
                SBAR(); if (ct < 3) LD_A(X0, S_WN, ct + 1); SBAR();
#pragma unroll
                for (int s = 0; s < 4; ++s) { O[0][ct] = mfma16(X1[s], SB[0][s], O[0][ct]); O[1][ct] = mfma16(X1[s], SB[1][s], O[1][ct]); }
            }
            dn_bf16x8 VNB[2][2];
#pragma unroll
            for (int sl = 0; sl < 2; ++sl)
#pragma unroll
                for (int sp = 0; sp < 2; ++sp) VNB[sl][sp] = pack8f(VN[sl][2 * sp], VN[sl][2 * sp + 1]);
            WGBAR();
            SBAR(); LD_B(X0, S_QKM, 0); LD_B(X1, S_QKM, 2); SBAR();
#pragma unroll
            for (int s = 0; s < 4; ++s) { O[0][s >> 1] = mfma16(X0[s], VNB[0][s & 1], O[0][s >> 1]); O[1][s >> 1] = mfma16(X0[s], VNB[1][s & 1], O[1][s >> 1]); }
            SBAR(); LD_B(X0, S_KDT, 0); SBAR();
#pragma unroll
            for (int s = 0; s < 4; ++s) { O[0][2 + (s >> 1)] = mfma16(X1[s], VNB[0][s & 1], O[0][2 + (s >> 1)]); O[1][2 + (s >> 1)] = mfma16(X1[s], VNB[1][s & 1], O[1][2 + (s >> 1)]); }
#pragma unroll
            for (int kt = 0; kt < 8; ++kt) { Sacc[0][kt] = Sacc[0][kt] * eg; Sacc[1][kt] = Sacc[1][kt] * eg; }
#pragma unroll
            for (int q = 0; q < 4; ++q) {
                if (q & 1) { SBAR(); if (q < 3) LD_B(X0, S_KDT, 2 * q + 2); SBAR();
#pragma unroll
                    for (int s = 0; s < 4; ++s) { Sacc[0][2 * q + (s >> 1)] = mfma16(X1[s], VNB[0][s & 1], Sacc[0][2 * q + (s >> 1)]); Sacc[1][2 * q + (s >> 1)] = mfma16(X1[s], VNB[1][s & 1], Sacc[1][2 * q + (s >> 1)]); } }
                else { SBAR(); LD_B(X1, S_KDT, 2 * q + 2); SBAR();
#pragma unroll
                    for (int s = 0; s < 4; ++s) { Sacc[0][2 * q + (s >> 1)] = mfma16(X0[s], VNB[0][s & 1], Sacc[0][2 * q + (s >> 1)]); Sacc[1][2 * q + (s >> 1)] = mfma16(X0[s], VNB[1][s & 1], Sacc[1][2 * q + (s >> 1)]); } }
            }
#pragma unroll
            for (int sl = 0; sl < 2; ++sl)
#pragma unroll
                for (int ct = 0; ct < 4; ++ct)
#pragma unroll
                    for (int r = 0; r < 4; ++r) OB[(16 * ct + 4 * g + r) * 132 + n0 + 16 * sl + m] = O[sl][ct][r];
            WGBAR();
        }
#undef SBAR
#undef LD_A
#undef LD_B
    }
#undef WGBAR
}
__device__ __forceinline__ void fox_blk(const Frame& F, int it, int j, att::Blk& k) {
    const int bh = it >> 2, y = it & 3, qb = j == 0 ? y : 7 - y, b = bh >> 3, h = bh & 7; const size_t row0 = (size_t)b * SEQ + qb * 256;
    bf16* proj = (bf16*)(F.ws + WS_PROJ);
    k.Q = proj + row0 * PW + PC_Q + h * HD; k.K = proj + (size_t)b * SEQ * PW + PC_K + h * HD; k.voff = PC_V - PC_K; k.goff = PC_Z - PC_Q;
    k.flog = (const float*)(F.ws + WS_AB) + (size_t)b * SEQ * 16 + h; k.fb = F.in[I_FOXFB][h]; k.P0 = qb * 256; k.skv = SEQ; k.kvpitch = PW;
}
__device__ __forceinline__ void mem_blk(const Frame& F, int idx, att::Blk& k) {
    const int b = idx >> 5, hm = (idx >> 3) & 3, qb = idx & 7; const size_t row0 = (size_t)b * SEQ + qb * 256;
    bf16* proj = (bf16*)(F.ws + WS_PROJ); const bf16* mkv = (const bf16*)(F.ws + WS_MEMKV);
    static_assert(att::QP == PW, "attention Q pitch");
    k.Q = proj + row0 * PW + PC_QM + hm * HD; k.K = mkv + (size_t)b * NMEM * DM + hm * HD; k.voff = 512; k.goff = 0;
    k.flog = nullptr; k.fb = 0.f; k.P0 = 1 << 20; k.skv = NMEM; k.kvpitch = DM;
}
struct SrcL1 { const Frame* F; int vcu;
    __device__ __forceinline__ bool operator()(int n, att::Blk& k) const { const int it = vcu + (n / 3) * F->G, j = n % 3; if (it >= 256) return false;
        if (j < 2) fox_blk(*F, it, j, k); else mem_blk(*F, it, k); return true; } };
struct SrcL0 { const Frame* F; int first, stride;
    __device__ __forceinline__ bool operator()(int n, att::Blk& k) const { const int idx = first + n * stride; if (idx >= 256) return false; mem_blk(*F, idx, k); return true; } };
__device__ __forceinline__ void narrow_ab_unit(const Frame& F, int pm) {
    const Tix T = tix(F.wv); const int lane = T.lane, wave = T.wave, m = lane & 15, g = lane >> 4;
    const bf16* A = (const bf16*)(F.ws + WS_XB) + (size_t)(pm * 256 + 32 * wave + m) * DM + 8 * g; const bf16* B = (const bf16*)(F.ws + WS_WIN0) + (size_t)(PC_AB + m) * DM + 8 * g;
    f32x4 acc0 = {0.f, 0.f, 0.f, 0.f}, acc1 = acc0;
#pragma unroll 8
    for (int s = 0; s < DM / 32; ++s) { const dn_bf16x8 b = *(const dn_bf16x8*)(B + 32 * s);
        acc0 = mfma16(*(const dn_bf16x8*)(A + 32 * s), b, acc0); acc1 = mfma16(*(const dn_bf16x8*)(A + (size_t)16 * DM + 32 * s), b, acc1); }
    const float* xsq = (const float*)(F.ws + WS_XSQ); float* ab = (float*)(F.ws + WS_AB);
#pragma unroll
    for (int rt = 0; rt < 2; ++rt)
#pragma unroll
        for (int r = 0; r < 4; ++r) { const size_t row = (size_t)pm * 256 + 32 * wave + 16 * rt + 4 * g + r; const float* q = xsq + row * 16;
            const f32x4 t = (*(const f32x4*)q + *(const f32x4*)(q + 4)) + (*(const f32x4*)(q + 8) + *(const f32x4*)(q + 12));
            ab[row * 16 + m] = (rt ? acc1[r] : acc0[r]) * rsqrtf(((t[0] + t[1]) + (t[2] + t[3])) * (1.0f / 1024.0f) + EPS); }
}
constexpr int CW_SHD = 196608;
__device__ __forceinline__ void shadow_barrier(const Frame& F, unsigned want) {
    asm volatile("s_waitcnt vmcnt(0)" ::: "memory");
    __syncthreads();
    if (F.wv == 0 && lane_id() == 0) { unsigned* p = (unsigned*)((gu32*)(F.ws + WS_CTL) + CW_SHD);
        __builtin_amdgcn_fence(__ATOMIC_RELEASE, "agent"); asm volatile("s_waitcnt vmcnt(0)" ::: "memory");
        (void)__hip_atomic_fetch_add(p, 1u, __ATOMIC_RELAXED, __HIP_MEMORY_SCOPE_AGENT);
        unsigned sp = 0;
        while (__hip_atomic_load(p, __ATOMIC_RELAXED, __HIP_MEMORY_SCOPE_AGENT) < want) { __builtin_amdgcn_s_sleep(2); if (++sp > (1u << 22)) { atomicAdd((unsigned*)((gu32*)(F.ws + WS_CTL) + CW_BAR) + XB_TMO, 1u); break; } }
        __builtin_amdgcn_fence(__ATOMIC_ACQUIRE, "agent"); asm volatile("s_waitcnt vmcnt(0)" ::: "memory"); }
    __syncthreads();
}
#define IN(k) (lo <= (k) && (k) < hi)
#define SEAM(k) do { if (IN(k) && IN((k) + 1)) xcd_barrier(bar); } while (0)
#define SEAMG(k, s_) do { if (IN(k) && IN((k) + 1)) { if (gb.on) grp_barrier(gb, (s_)); else xcd_barrier(bar); } } while (0)
template <int layer> __device__ __forceinline__ void layer_body(const Frame& F, const XcdBarrier& bar, GrpBar& gb, bool grp_try, int lo, int hi, unsigned char* lds) {
    bf16* proj = (bf16*)(F.ws + WS_PROJ); bf16* xb = (bf16*)(F.ws + WS_XB); float* xsq = (float*)(F.ws + WS_XSQ);
    float* ab = (float*)(F.ws + WS_AB);

        const int pb = 1 + (layer ? 6 : 0);
        if (IN(pb)) {
            pg8::Gemm g{xb, (const bf16*)(F.ws + (layer ? WS_WIN1 : WS_WIN0)), MROWS, layer ? N_IN : 4096, DM, DM}; pg8::StaticOrder S; S.init(MROWS, layer ? N_IN : 4096, F.G, F.bid);
            const float* nk = layer ? F.in[I_FOXKNW] : nullptr; const float* nq = layer ? F.in[I_FOXQNW] : nullptr;
            pg8::EpiProj<true, false, layer == 0> E{proj, PW, xsq, ab, 18, (bf16*)((unsigned char*)F.out + DO_HALO), 0, layer ? 4 : 0, nk, 12, layer ? 16 : 12, nq, 16, 18, F.in[I_MEMQNW] + layer * HD, 8, 12, layer ? 2 : 1, F.in[I_DNONW]};
            pg8::gemm_phase<pg8::EpiProj<true, false, layer == 0>, pg8::StaticOrder, true, true>(F.lds, g, S, E, F.wv);
            if (layer == 0 && F.bid < 64) { __syncthreads(); narrow_ab_unit(F, 8 * (F.bid & 7) + ((F.bid >> 3) & 7)); }
        }
        SEAM(pb);
        if (layer == 0 && grp_try) gb.on = __hip_atomic_load((unsigned*)((gu32*)(F.ws + WS_CTL) + CW_BAD), __ATOMIC_RELAXED, __HIP_MEMORY_SCOPE_AGENT) == 0u;
        const int pm = pb + (layer ? 1 : 2);
        if (layer == 0) {
            if (IN(pb + 1)) { constexpr int NU = BATCH * NH * (SEQ / 64); DnPre R; int u = F.bid; if (u < NU) dn_prep_load(F, u, R);
                              for (; u < NU; u += F.G) dn_prep_unit(F, u, u + F.G < NU ? u + F.G : -1, R); }
            SEAM(pb + 1);
        }
        if (IN(pm)) {
            if (layer == 0) {
                if (F.bid < 64) dn_scan_unit(F, F.bid);
                else {
                    { const pg8::StrideUnits Sq{F.bid - 64, F.G - 64, 128, 1};
                      pg8::Gemm g{xb, (const bf16*)(F.ws + WS_WIN0), MROWS, N_IN, DM, DM};
                      pg8::EpiProj<true, false> E{proj, PW, xsq, nullptr, 18, nullptr, 0, 0, nullptr, 0, 0, nullptr, 16, 18, F.in[I_MEMQNW], 0, 0, 0, nullptr};
                      pg8::gemm_phase<pg8::EpiProj<true, false>, pg8::StrideUnits, true, true>(F.lds, g, Sq, E, F.wv);
                      const pg8::StrideUnits Sm{F.G - 1 - F.bid, F.G - 64, 32, 0};
                      pg8::Gemm g2{(const bf16*)((unsigned char*)F.out + DO_MEMB), (const bf16*)(F.ws + WS_WMKV), MMEM, DM, DM, DM};
                      pg8::EpiProj<true, false> E2{(bf16*)(F.ws + WS_MEMKV), DM, (const float*)(F.ws + WS_MSQ), nullptr, 4, nullptr, 0, 2, F.in[I_MEMKNW], 0, 0, nullptr, 0, 0, nullptr, 0, 0, 0, nullptr};
                      pg8::gemm_phase<pg8::EpiProj<true, false>, pg8::StrideUnits, true, true>(F.lds, g2, Sm, E2, F.wv); }
                    shadow_barrier(F, (unsigned)(F.G - 64));
                    const SrcL0 src{&F, F.bid - 64, F.G - 64}; att::phase((char*)lds, src, F.wv);
                    __syncthreads();
                    const Tix T = tix(F.wv); convert_weights<6, 18>(F, (LAS float*)(F.lds + T.wave * 17408), T.lane, (F.bid - 64) * NWAVES + T.wave, (F.G - 64) * NWAVES, 0); }
            } else {
                const int vcu = (F.G % 8 == 0) ? (F.bid % 8) * (F.G / 8) + F.bid / 8 : F.bid;
                const SrcL1 src{&F, vcu}; att::phase((char*)lds, src, F.wv);
            }
            __syncthreads();
        }
        SEAM(pm);
        if (IN(pm + 1)) {
            pg8::Gemm g{proj + PC_Q, (const bf16*)(F.ws + (layer ? WS_WOUT1 : WS_WOUT0)), MROWS, DM, OUT_IN, PW}; pg8::StaticOrder S; S.init(MROWS, DM, F.G, F.bid);
            pg8::EpiRes<false> E{xb, F.out, xsq, nullptr};
            pg8::gemm_phase<pg8::EpiRes<false>, pg8::StaticOrder, true, true>(F.lds, g, S, E, F.wv);
        }
        SEAMG(pm + 1, layer * 3 + 0);
        if (IN(pm + 2)) {
            pg8::Gemm g{xb, (const bf16*)(F.ws + (layer ? WS_WM1_1 : WS_WM1_0)), MROWS, FF, DM, DM}; pg8::StaticOrder S; S.init(MROWS, FF, F.G, F.bid);
            pg8::EpiProj<false, true> E{proj, FF, xsq, nullptr, 16, nullptr, 0, 0, nullptr, 0, 0, nullptr, 0, 0, nullptr, 0, 0, 0, nullptr};
            pg8::gemm_phase<pg8::EpiProj<false, true>, pg8::StaticOrder, true, true>(F.lds, g, S, E, F.wv);
        }
        SEAMG(pm + 2, layer * 3 + 1);
        if (IN(pm + 3)) {
            pg8::Gemm g{proj, (const bf16*)(F.ws + (layer ? WS_WM2_1 : WS_WM2_0)), MROWS, DM, FF, FF}; pg8::StaticOrder S; S.init(MROWS, DM, F.G, F.bid);
            pg8::EpiRes<layer == 1> E{xb, F.out, xsq, nullptr};
            pg8::gemm_phase<pg8::EpiRes<layer == 1>, pg8::StaticOrder, true, true>(F.lds, g, S, E, F.wv);
        }
        if (layer == 0) SEAMG(pm + 3, 2); else SEAM(pm + 3);
    }
#undef IN
#undef SEAM
#undef SEAMG
__global__ void __launch_bounds__(NWAVES * 64, 2) hyb_fwd(Args args) {
    extern __shared__ __attribute__((aligned(16))) unsigned char lds[];
    Frame F;
    F.lds = (LAS unsigned char*)lds;
    F.G = gridDim.x; F.bid = blockIdx.x; F.in = args.in; F.out = args.out; F.ws = args.ws; F.wv = __builtin_amdgcn_readfirstlane((int)threadIdx.x >> 6);
    volatile LAS unsigned* MISC = (volatile LAS unsigned*)(F.lds + MISC_OFF);
    gu32* ctl = (gu32*)(args.ws + WS_CTL);
    for (int u = threadIdx.x; u < (LDS_BYTES - MISC_OFF) / 4; u += NWAVES * 64) ((LAS unsigned*)(F.lds + MISC_OFF))[u] = 0u;
    __syncthreads();
    XcdBarrier bar; bar.bar = (unsigned*)(ctl + CW_BAR) + args.li * XCD_BAR_WORDS; bar.x = 0; bar.st = nullptr; bar.wv = F.wv;
    if (!MK_LAUNCH_PER_PHASE) { bar = xcd_barrier_post((unsigned*)(ctl + CW_BAR) + args.li * XCD_BAR_WORDS, MISC + 8); bar.wv = F.wv; }
    const int lo = args.ph_lo, hi = args.ph_hi;
#define IN(k) (lo <= (k) && (k) < hi)
#define SEAM(k) do { if (IN(k) && IN((k) + 1)) xcd_barrier(bar); } while (0)
    bf16* proj = (bf16*)(F.ws + WS_PROJ); bf16* xb = (bf16*)(F.ws + WS_XB); float* xsq = (float*)(F.ws + WS_XSQ);
    float* ab = (float*)(F.ws + WS_AB);

    GrpBar gb; gb.cnt = (unsigned*)(ctl + CW_GRP) + (size_t)(F.bid & 63) * 8 * 64; gb.tmo = (unsigned*)(ctl + CW_BAR) + XB_TMO; gb.wv = F.wv; gb.on = false;
    const bool grp_try = !MK_LAUNCH_PER_PHASE && F.G == 256 && lo == 0 && hi == N_PHASES;
    if (grp_try && F.wv == 0 && lane_id() == 0) __hip_atomic_store((unsigned*)(ctl + CW_XCC) + F.bid, xb_xcc_id() + 1u, __ATOMIC_RELAXED, __HIP_MEMORY_SCOPE_AGENT);
    if (IN(0)) { p0_prologue(F); } SEAM(0);
    if (grp_try && F.wv == 0 && lane_id() == 0) { const unsigned mine = xb_xcc_id() + 1u; bool same = true;
        for (int k = 1; k < 4; ++k) same = same && __hip_atomic_load((unsigned*)(ctl + CW_XCC) + ((F.bid + 64 * k) & 255), __ATOMIC_RELAXED, __HIP_MEMORY_SCOPE_AGENT) == mine;
        if (!same) atomicAdd((unsigned*)(ctl + CW_BAD), 1u); }

    layer_body<0>(F, bar, gb, grp_try, lo, hi, lds);
    layer_body<1>(F, bar, gb, grp_try, lo, hi, lds);
#undef IN
#undef SEAM
}

extern "C" void kernel_launch(void* const* d_in, const int* in_sizes, int n_in, void* d_out, int out_size, void* d_ws, size_t ws_size, hipStream_t stream) {
    static int grid = 0;
    if (grid == 0) {
        if (n_in != 20 || in_sizes[0] != MROWS * DM || out_size != MROWS * DM || ws_size < WS_END) {
            fprintf(stderr, "kernel_launch: shape/workspace mismatch (n_in %d, in0 %d, out %d, ws %zu; need ws >= %zu); nothing launched\n", n_in, n_in > 0 ? in_sizes[0] : -1, out_size, ws_size, (size_t)WS_END); grid = -1; return; }
        int dev = 0, cus = 0, per_cu = 0;
        if (hipGetDevice(&dev) != hipSuccess || hipDeviceGetAttribute(&cus, hipDeviceAttributeMultiprocessorCount, dev) != hipSuccess) { fprintf(stderr, "kernel_launch: device query failed\n"); grid = -1; return; }
        if (hipFuncSetAttribute((const void*)hyb_fwd, hipFuncAttributeMaxDynamicSharedMemorySize, LDS_BYTES) != hipSuccess) { fprintf(stderr, "kernel_launch: hipFuncSetAttribute failed\n"); grid = -1; return; }
        if (hipOccupancyMaxActiveBlocksPerMultiprocessor(&per_cu, (const void*)hyb_fwd, NWAVES * 64, LDS_BYTES) != hipSuccess || per_cu < 1) {
            fprintf(stderr, "kernel_launch: occupancy query reports %d workgroups per CU; nothing launched\n", per_cu); (void)hipGetLastError(); grid = -1; return; }
        if (cus < 128) { fprintf(stderr, "kernel_launch: %d CUs; this kernel's phase program needs at least 128 workgroups; nothing launched\n", cus); grid = -1; return; }
        grid = cus;
    }
    if (grid < 0) return;
    if (hipMemsetAsync((char*)d_ws + WS_CTL, 0, CTL_ZERO_BYTES, stream) != hipSuccess) { fprintf(stderr, "kernel_launch: memset failed\n"); return; }
    Args a{};
    for (int i = 0; i < 20; ++i) a.in[i] = (const float*)d_in[i];
    a.out = (float*)d_out; a.ws = (unsigned char*)d_ws;
#if MK_LAUNCH_PER_PHASE
    for (int p = 0; p < N_PHASES; ++p) { a.ph_lo = p; a.ph_hi = p + 1; a.li = 0; hipLaunchKernelGGL(hyb_fwd, dim3(grid), dim3(NWAVES * 64), LDS_BYTES, stream, a); }
#else
    a.ph_lo = 0; a.ph_hi = N_PHASES; a.li = 0;
    hipLaunchKernelGGL(hyb_fwd, dim3(grid), dim3(NWAVES * 64), LDS_BYTES, stream, a);
#endif
    const hipError_t le = hipPeekAtLastError();
    if (le != hipSuccess) fprintf(stderr, "kernel_launch: launch failed: %s\n", hipGetErrorName(le));
}
```

```cpp
#include <hip/hip_runtime.h>
#include <cstdio>
#include <cstdint>
#include <type_traits>

constexpr int BATCH = 8, SEQ = 2048, DM = 1024, MROWS = BATCH * SEQ;
constexpr int NMEM = 256, MMEM = BATCH * NMEM;
constexpr int HD = 128, NH = 8, NMH = 4, FF = 4096;
constexpr int PW = 4608;
constexpr int PC_K = 0, PC_V = 1024, PC_Z = 2048, PC_Q = 3072, PC_QM = 4096, PC_AB = 4608;
constexpr int N_IN = 4864;
constexpr int DN_IN = 4624, FOX_IN = 4616, OUT_IN = 1536;
constexpr float EPS = 1e-6f;
constexpr float QSCALE = 0.08838834764831845f;

__device__ __forceinline__ int lane_id_v() { int x; asm volatile("v_mbcnt_lo_u32_b32 %0, -1, 0\n\tv_mbcnt_hi_u32_b32 %0, -1, %0" : "=v"(x)); return x; }
template <int CTRL> __device__ __forceinline__ float dppf(float x) { return __builtin_bit_cast(float, __builtin_amdgcn_update_dpp(0, __builtin_bit_cast(int, x), CTRL, 0xf, 0xf, true)); }
__device__ __forceinline__ float row16_sum(float x) { x += dppf<0xB1>(x); x += dppf<0x4E>(x); x += dppf<0x141>(x); x += dppf<0x140>(x); return x; }
__device__ __forceinline__ float add_xor16(float x) { auto r = __builtin_amdgcn_permlane16_swap(__float_as_uint(x), __float_as_uint(x), false, false); return __uint_as_float(r[0]) + __uint_as_float(r[1]); }
__device__ __forceinline__ float add_xor32(float x) { auto r = __builtin_amdgcn_permlane32_swap(__float_as_uint(x), __float_as_uint(x), false, false); return __uint_as_float(r[0]) + __uint_as_float(r[1]); }
namespace pg8 {
#define PG8_LAS __attribute__((address_space(3)))
typedef unsigned short bf16_t;
typedef short bf16x8 __attribute__((ext_vector_type(8)));
typedef float f32x4 __attribute__((ext_vector_type(4)));
typedef unsigned u32x4 __attribute__((ext_vector_type(4)));
constexpr int BM = 256, BK = 64, HALF = 128, HTB = HALF * BK * 2  , STAGE_BYTES = 8 * HTB, NXCD = 8, WGM = 8;

__host__ __device__ __forceinline__ int lds_byte(int r, int c) { const int st = (r >> 4) * 2 + (c >> 5), rr = r & 15, cc = c & 31, ob = rr * 64 + cc * 2; return st * 1024 + (ob ^ (((ob >> 9) & 1) << 5)); }
__host__ __device__ __forceinline__ void stage_rc(int b, int& R, int& C) { const int st = b / 1024, sb = b % 1024, swz = sb ^ (((sb >> 9) & 1) << 5); R = (st >> 1) * 16 + swz / 64; C = (st & 1) * 32 + (swz % 64) / 2; }
__host__ __device__ __forceinline__ int perm32(int rho) { const int n = rho >> 4, i = rho & 15; return 8 * (i >> 2) + 4 * n + (i & 3); }

struct Unit { int pm, pn; };
struct Gemm { const bf16_t* A; const bf16_t* Bt; int M, N, K, lda; };

struct StaticOrder {
    int nM, nN, nwg, G, c;
    __host__ __device__ void init(int M, int N, int G_, int c_) { nM = M / BM; nN = N / BM; nwg = nM * nN; G = G_; c = c_; }
    __host__ __device__ bool next(int i, Unit& u) const {
        const long L = (long)i * G + c; if (L >= nwg) return false;
        int wgid = (int)L; { const int q = nwg / NXCD, r = nwg % NXCD, xcd = wgid % NXCD, off = wgid / NXCD; wgid = (xcd < r ? xcd * (q + 1) : r * (q + 1) + (xcd - r) * q) + off; }
        const int nig = WGM * nN, gid = wgid / nig, fm = gid * WGM, gsz = (nM - fm) < WGM ? (nM - fm) : WGM;
        u.pm = fm + ((wgid % nig) % gsz); u.pn = (wgid % nig) / gsz; return true;
    }
    __device__ __forceinline__ void a_ready(const Unit&) const {}
    __device__ __forceinline__ void done(const Unit&) const {}
};
struct StrideUnits {
    int start, stride, total, qm;
    __device__ __forceinline__ bool next(int i, Unit& u) const { const int t = start + i * stride; if (t >= total) return false; const int x = t & 7, j = t >> 3;
        if (qm) { u.pm = 8 * x + (j >> 1); u.pn = 16 + (j & 1); } else { u.pm = x; u.pn = j; } return true; }
    __device__ __forceinline__ void a_ready(const Unit&) const {}
    __device__ __forceinline__ void done(const Unit&) const {}
};

__device__ __forceinline__ unsigned cvt_pk_bf16(float lo, float hi) { unsigned r; asm volatile("v_cvt_pk_bf16_f32 %0, %1, %2" : "=v"(r) : "v"(lo), "v"(hi)); return r; }

constexpr int EPI_XCH = 131072, EPI_RS = 139264;
template <bool NORM, bool RELU2, bool HALO = false> struct EpiProj {
    static constexpr bool PERM = true, AFTER_DRAIN = false, USE_RS = true, ACC_INIT = false;
    bf16_t* O; int ldc; const float* xsq; float* ab; int n_main; bf16_t* halo;
    int nlo0, nhi0; const float* nw0; int nlo1, nhi1; const float* nw1; int nlo2, nhi2; const float* nw2;
    int zlo, zhi, zmode; const float* zw;
    __device__ __forceinline__ void rs_load(const Unit& u, int tid, f32x4 (&q)[4]) const { const float* p = xsq + (size_t)(u.pm * BM + tid) * 16;
#pragma unroll
        for (int i = 0; i < 4; ++i) q[i] = *(const f32x4*)(p + 4 * i); }
    __device__ __forceinline__ void rs_store(const f32x4 (&q)[4], PG8_LAS unsigned char* lds, int parity, int tid) const {
        const f32x4 t = (q[0] + q[1]) + (q[2] + q[3]);
        ((PG8_LAS float*)(lds + EPI_RS))[parity * 256 + tid] = rsqrtf(((t[0] + t[1]) + (t[2] + t[3])) * (1.0f / 1024.0f) + 1e-6f); }
    __device__ __forceinline__ void operator()(const f32x4 (&acc)[2][2][4][2], const Unit& u, int wr, int wc, int fr, int fq, PG8_LAS unsigned char* lds, int parity) const {
        const int rl0 = wr * 64 + fr, row0 = u.pm * BM + rl0, colt = u.pn * BM;
        const bool is_ab = u.pn >= n_main;
        const int lid_ = fr + 16 * fq, fr2 = lid_ >> 2, fq2 = lid_ & 3, psrc = 4 * (fr2 + 16 * fq2);
        const PG8_LAS float* RS = (const PG8_LAS float*)(lds + EPI_RS) + parity * 256;
        const float* nw = nullptr;
        if (NORM) { if (u.pn >= nlo0 && u.pn < nhi0) nw = nw0; else if (u.pn >= nlo1 && u.pn < nhi1) nw = nw1; else if (u.pn >= nlo2 && u.pn < nhi2) nw = nw2; }
        f32x4 w0 = {1.f, 1.f, 1.f, 1.f}, w1 = w0;
        const int zm = (NORM && u.pn >= zlo && u.pn < zhi) ? zmode : 0;
        if (zm == 1) { w0 = *(const f32x4*)(zw + wc * 32 + 8 * fq); w1 = *(const f32x4*)(zw + wc * 32 + 8 * fq + 4); }
        if (NORM && nw != nullptr) {
            w0 = *(const f32x4*)(nw + wc * 32 + 8 * fq); w1 = *(const f32x4*)(nw + wc * 32 + 8 * fq + 4);
            PG8_LAS float* X = (PG8_LAS float*)(lds + EPI_XCH);
#pragma unroll
            for (int ai = 0; ai < 2; ++ai)
#pragma unroll
                for (int m = 0; m < 4; ++m) { const int rl = rl0 + ai * HALF + m * 16; const float rstd = RS[rl];
#pragma unroll
                    for (int bj = 0; bj < 2; ++bj) { const f32x4 v0 = acc[ai][bj][m][0] * rstd, v1 = acc[ai][bj][m][1] * rstd;
                        float ss = ((v0[0] * v0[0] + v0[1] * v0[1]) + (v0[2] * v0[2] + v0[3] * v0[3])) + ((v1[0] * v1[0] + v1[1] * v1[1]) + (v1[2] * v1[2] + v1[3] * v1[3]));
                        ss = add_xor32(add_xor16(ss));
                        if (fq == 0) X[(bj * 256 + rl) * 4 + wc] = ss; } }
            asm volatile("s_waitcnt lgkmcnt(0)" ::: "memory"); __builtin_amdgcn_s_barrier(); asm volatile("" ::: "memory");
        }
#pragma unroll
        for (int ai = 0; ai < 2; ++ai)
#pragma unroll
            for (int m = 0; m < 4; ++m) {
                const int rl = rl0 + ai * HALF + m * 16, r = row0 + ai * HALF + m * 16;
                const float rstd = RS[rl];
                if (!is_ab) {
#pragma unroll
                    for (int bj = 0; bj < 2; ++bj) {
                        float sc = rstd;
                        if (NORM && nw != nullptr) { const f32x4 p4 = *(const PG8_LAS f32x4*)((const PG8_LAS float*)(lds + EPI_XCH) + (bj * 256 + rl) * 4);
                            sc = rstd * rsqrtf(((p4[0] + p4[1]) + (p4[2] + p4[3])) * (1.0f / 128.0f) + 1e-6f); }
                        f32x4 v0 = acc[ai][bj][m][0] * sc, v1 = acc[ai][bj][m][1] * sc;
                        if (zm != 0) {
#pragma unroll
                            for (int e = 0; e < 4; ++e) { const float s0 = __builtin_amdgcn_rcpf(1.f + __expf(-v0[e])), s1 = __builtin_amdgcn_rcpf(1.f + __expf(-v1[e]));
                                v0[e] = zm == 1 ? v0[e] * s0 : s0; v1[e] = zm == 1 ? v1[e] * s1 : s1; } }
                        v0 = v0 * w0; v1 = v1 * w1;
                        if (RELU2) {
#pragma unroll
                            for (int e = 0; e < 4; ++e) { const float a = fmaxf(v0[e], 0.f), b = fmaxf(v1[e], 0.f); v0[e] = a * a; v1[e] = b * b; }
                        }
                        u32x4 w; w.x = cvt_pk_bf16(v0[0], v0[1]); w.y = cvt_pk_bf16(v0[2], v0[3]); w.z = cvt_pk_bf16(v1[0], v1[1]); w.w = cvt_pk_bf16(v1[2], v1[3]);
                        u32x4 wp; wp.x = (unsigned)__builtin_amdgcn_ds_bpermute(psrc, (int)w.x); wp.y = (unsigned)__builtin_amdgcn_ds_bpermute(psrc, (int)w.y);
                        wp.z = (unsigned)__builtin_amdgcn_ds_bpermute(psrc, (int)w.z); wp.w = (unsigned)__builtin_amdgcn_ds_bpermute(psrc, (int)w.w);
                        const int r2 = r - fr + fr2;
                        *(u32x4*)(O + (size_t)r2 * ldc + colt + bj * HALF + wc * 32 + 8 * fq2) = wp;
                        if (HALO && m == 3 && fr2 >= 13) *(u32x4*)(halo + ((size_t)(r2 >> 6) * 3 + ((r2 & 63) - 61)) * ldc + colt + bj * HALF + wc * 32 + 8 * fq2) = wp;
                    }
                } else if (ab != nullptr && wc == 0 && fq < 2) {
                    float* p = ab + (size_t)r * 16 + 8 * fq;
                    *(f32x4*)p = acc[ai][0][m][0] * rstd; *(f32x4*)(p + 4) = acc[ai][0][m][1] * rstd;
                }
            }
    }
};
template <bool LAST = false, bool INIT_F32 = false> struct EpiRes {
    static constexpr bool PERM = true, AFTER_DRAIN = false, USE_RS = false, ACC_INIT = true;
    bf16_t* xb; float* xout; float* xsq; const float* xin;
    __device__ __forceinline__ void init(f32x4 (&acc)[2][2][4][2], const Unit& u, int wr, int wc, int fr, int fq) const {
        const int row0 = u.pm * BM + wr * 64 + fr, colt = u.pn * BM;
#pragma unroll
        for (int ai = 0; ai < 2; ++ai)
#pragma unroll
            for (int m = 0; m < 4; ++m)
#pragma unroll
                for (int bj = 0; bj < 2; ++bj) { const size_t off = (size_t)(row0 + ai * HALF + m * 16) * 1024 + colt + bj * HALF + wc * 32 + 8 * fq;
                    if (INIT_F32) { acc[ai][bj][m][0] = *(const f32x4*)(xin + off); acc[ai][bj][m][1] = *(const f32x4*)(xin + off + 4); continue; }
                    const u32x4 w = *(const u32x4*)(xb + off);
                    acc[ai][bj][m][0] = (f32x4){__uint_as_float(w.x << 16), __uint_as_float(w.x & 0xffff0000u), __uint_as_float(w.y << 16), __uint_as_float(w.y & 0xffff0000u)};
                    acc[ai][bj][m][1] = (f32x4){__uint_as_float(w.z << 16), __uint_as_float(w.z & 0xffff0000u), __uint_as_float(w.w << 16), __uint_as_float(w.w & 0xffff0000u)}; }
    }
    __device__ __forceinline__ void operator()(const f32x4 (&acc)[2][2][4][2], const Unit& u, int wr, int wc, int fr, int fq, PG8_LAS unsigned char*, int) const {
        const int row0 = u.pm * BM + wr * 64 + fr, colt = u.pn * BM;
        const int lid_ = fr + 16 * fq, fr2 = lid_ >> 2, fq2 = lid_ & 3, psrc = 4 * (fr2 + 16 * fq2);
#pragma unroll
        for (int ai = 0; ai < 2; ++ai)
#pragma unroll
            for (int m = 0; m < 4; ++m) {
                const int r = row0 + ai * HALF + m * 16; float ss = 0.f;
#pragma unroll
                for (int bj = 0; bj < 2; ++bj) {
                    const size_t off = (size_t)r * 1024 + colt + bj * HALF + wc * 32 + 8 * fq;
                    const f32x4 v0 = acc[ai][bj][m][0], v1 = acc[ai][bj][m][1];
                    if (LAST) { *(f32x4*)(xout + off) = v0; *(f32x4*)(xout + off + 4) = v1; }
                    else {
                    ss += ((v0[0] * v0[0] + v0[1] * v0[1]) + (v0[2] * v0[2] + v0[3] * v0[3])) + ((v1[0] * v1[0] + v1[1] * v1[1]) + (v1[2] * v1[2] + v1[3] * v1[3]));
                    u32x4 w; w.x = cvt_pk_bf16(v0[0], v0[1]); w.y = cvt_pk_bf16(v0[2], v0[3]); w.z = cvt_pk_bf16(v1[0], v1[1]); w.w = cvt_pk_bf16(v1[2], v1[3]);
                    u32x4 wp; wp.x = (unsigned)__builtin_amdgcn_ds_bpermute(psrc, (int)w.x); wp.y = (unsigned)__builtin_amdgcn_ds_bpermute(psrc, (int)w.y);
                    wp.z = (unsigned)__builtin_amdgcn_ds_bpermute(psrc, (int)w.z); wp.w = (unsigned)__builtin_amdgcn_ds_bpermute(psrc, (int)w.w);
                    *(u32x4*)(xb + (size_t)(r - fr + fr2) * 1024 + colt + bj * HALF + wc * 32 + 8 * fq2) = wp; }
                }
                if (!LAST) { ss = add_xor32(add_xor16(ss));
                if (fq == 0) xsq[(size_t)r * 16 + u.pn * 4 + wc] = ss; }
            }
    }
};

template <class Epi, class Sched, bool ALIGN_EPI = false, bool SP2 = false>
__device__ __forceinline__ void gemm_phase(PG8_LAS unsigned char* lds, const Gemm g, const Sched& S, const Epi& E, int wid) {
    const int lane = lane_id_v();
    const int tid = wid * 64 + lane, wr = wid >> 2, wc = wid & 3, fr = lane & 15, fq = lane >> 4;
    const int K = g.K, nt = K / BK;
    unsigned voffA[2], voffB[2];
#pragma unroll
    for (int i = 0; i < 2; ++i) { int R, C; stage_rc(tid * 16 + i * 8192, R, C); const int Rb = Epi::PERM ? ((R & ~31) + perm32(R & 31)) : R;
        voffA[i] = (unsigned)(R * g.lda + C) * 2u; voffB[i] = (unsigned)(Rb * K + C) * 2u; }
    const size_t kstep = (size_t)(BK * 2);
    const size_t hstepA = (size_t)HALF * g.lda * 2, hstepB = (size_t)HALF * K * 2;
    const size_t tstepA = 2 * hstepA, tstepB = 2 * hstepB;
    const unsigned ldsw = (unsigned)wid * 1024u;
    const int aoff = lds_byte(wr * 64 + fr, fq * 8), boff = lds_byte(wc * 32 + fr, fq * 8);
#define PG8_SA(b, h) (((b) * 2 + (h)) * HTB)
#define PG8_SB(b, h) ((4 + (b) * 2 + (h)) * HTB)
#define PG8_STAGE(bufoff, gbase, voff) do { _Pragma("unroll") for (int _i = 0; _i < 2; ++_i) \
        __builtin_amdgcn_global_load_lds((const unsigned*)((const char*)(gbase) + (voff)[_i]), (PG8_LAS unsigned*)(lds + (bufoff) + ldsw + _i * 8192), 16, 0, 0); } while (0)
#define PG8_LDA(dst, b, h) do { _Pragma("unroll") for (int m = 0; m < 4; ++m) _Pragma("unroll") for (int k = 0; k < 2; ++k) dst[m][k] = *(const PG8_LAS bf16x8*)(lds + PG8_SA(b, h) + aoff + m * 2048 + k * 1024); } while (0)
#define PG8_LDB(dst, b, h) do { _Pragma("unroll") for (int n = 0; n < 2; ++n) _Pragma("unroll") for (int k = 0; k < 2; ++k) dst[n][k] = *(const PG8_LAS bf16x8*)(lds + PG8_SB(b, h) + boff + n * 2048 + k * 1024); } while (0)
#define PG8_MMA(ai, bj, At, Bt) do { __builtin_amdgcn_s_setprio(1); _Pragma("unroll") for (int m = 0; m < 4; ++m) _Pragma("unroll") for (int n = 0; n < 2; ++n) _Pragma("unroll") for (int k = 0; k < 2; ++k) \
        acc[ai][bj][m][n] = __builtin_amdgcn_mfma_f32_16x16x32_bf16(Bt[n][k], At[m][k], acc[ai][bj][m][n], 0, 0, 0); __builtin_amdgcn_s_setprio(0); } while (0)
#define PG8_WAIT_V(n) asm volatile("s_waitcnt vmcnt(" #n ")" ::: "memory")
#define PG8_WAIT_L(n) asm volatile("s_waitcnt lgkmcnt(" #n ")" ::: "memory")
#define PG8_BAR __builtin_amdgcn_s_barrier()
#define PG8_SCHED __builtin_amdgcn_sched_barrier(0)
    Unit cur, nxt; int ui = 0;
    if (!S.next(0, cur)) return;
    f32x4 acc[2][2][4][2];
    if constexpr (Epi::ACC_INIT) E.init(acc, cur, wr, wc, fr, fq);
    else {
#pragma unroll
    for (int a = 0; a < 2; ++a)
#pragma unroll
        for (int b = 0; b < 2; ++b)
#pragma unroll
            for (int m = 0; m < 4; ++m)
#pragma unroll
                for (int n = 0; n < 2; ++n) acc[a][b][m][n] = (f32x4){0.f, 0.f, 0.f, 0.f};
    }
    bf16x8 At[4][2], B0[2][2], B1[2][2];
    const char* cA = (const char*)g.A + (size_t)cur.pm * tstepA; const char* cB = (const char*)g.Bt + (size_t)cur.pn * tstepB;
    S.a_ready(cur);
    if constexpr (Epi::USE_RS) { if (tid < 256) { f32x4 rq[4]; E.rs_load(cur, tid, rq); E.rs_store(rq, lds, 0, tid); } }
    if constexpr (SP2) {
        PG8_STAGE(PG8_SB(0, 0), cB, voffB); PG8_STAGE(PG8_SB(0, 1), cB + hstepB, voffB); PG8_STAGE(PG8_SA(0, 0), cA, voffA); PG8_STAGE(PG8_SA(0, 1), cA + hstepA, voffA);
        if (wr == 1) PG8_BAR;
        PG8_WAIT_V(2); PG8_BAR;
        PG8_STAGE(PG8_SB(1, 0), cB + kstep, voffB); PG8_STAGE(PG8_SA(1, 0), cA + kstep, voffA); PG8_STAGE(PG8_SB(1, 1), cB + hstepB + kstep, voffB);
        PG8_WAIT_V(6); PG8_BAR;
    } else {
        PG8_STAGE(PG8_SB(0, 0), cB, voffB); PG8_STAGE(PG8_SA(0, 0), cA, voffA); PG8_STAGE(PG8_SB(0, 1), cB + hstepB, voffB); PG8_STAGE(PG8_SA(0, 1), cA + hstepA, voffA);
        if (wr == 1) PG8_BAR;
        PG8_WAIT_V(4); PG8_BAR;
        PG8_STAGE(PG8_SB(1, 0), cB + kstep, voffB); PG8_STAGE(PG8_SA(1, 0), cA + kstep, voffA); PG8_STAGE(PG8_SB(1, 1), cB + hstepB + kstep, voffB);
        PG8_WAIT_V(6); PG8_BAR;
    }
    for (;;) {
        const bool has_next = S.next(ui + 1, nxt);
        const char* nA = has_next ? (const char*)g.A + (size_t)nxt.pm * tstepA : cA; const char* nB = has_next ? (const char*)g.Bt + (size_t)nxt.pn * tstepB : cB;
        for (int t = 0; t < nt; t += 2) {
            const bool last = (t == nt - 2);
            const char* a1 = cA + (size_t)(t + 1) * kstep;
            const char* a2 = last ? nA : cA + (size_t)(t + 2) * kstep; const char* b2 = last ? nB : cB + (size_t)(t + 2) * kstep;
            const char* a3 = a2 + kstep; const char* b3 = b2 + kstep;
            if (last && has_next) S.a_ready(nxt);
            if constexpr (SP2) {
            PG8_LDB(B0, 0, 0); PG8_LDB(B1, 0, 1); PG8_SCHED; PG8_LDA(At, 0, 0); PG8_STAGE(PG8_SA(1, 1), a1 + hstepA, voffA);
            PG8_WAIT_V(8); PG8_WAIT_L(0); PG8_BAR; PG8_MMA(0, 0, At, B0); PG8_MMA(0, 1, At, B1); PG8_BAR; PG8_SCHED;
            PG8_LDA(At, 0, 1); PG8_STAGE(PG8_SB(0, 0), b2, voffB); PG8_STAGE(PG8_SB(0, 1), b2 + hstepB, voffB); PG8_STAGE(PG8_SA(0, 0), a2, voffA);
            PG8_WAIT_V(8); PG8_WAIT_L(0); PG8_BAR; PG8_MMA(1, 0, At, B0); PG8_MMA(1, 1, At, B1); PG8_BAR; PG8_SCHED;
            PG8_LDB(B0, 1, 0); PG8_LDB(B1, 1, 1); PG8_SCHED; PG8_LDA(At, 1, 0); PG8_STAGE(PG8_SA(0, 1), a2 + hstepA, voffA);
            PG8_WAIT_V(8); PG8_WAIT_L(0); PG8_BAR; PG8_MMA(0, 0, At, B0); PG8_MMA(0, 1, At, B1); PG8_BAR; PG8_SCHED;
            PG8_LDA(At, 1, 1); PG8_STAGE(PG8_SB(1, 0), b3, voffB); PG8_STAGE(PG8_SB(1, 1), b3 + hstepB, voffB); PG8_STAGE(PG8_SA(1, 0), a3, voffA);
            PG8_WAIT_V(8); PG8_WAIT_L(0); PG8_BAR; PG8_MMA(1, 0, At, B0); PG8_MMA(1, 1, At, B1); PG8_BAR; PG8_SCHED;
            } else {
            PG8_LDB(B0, 0, 0); PG8_SCHED; PG8_LDA(At, 0, 0); PG8_STAGE(PG8_SA(1, 1), a1 + hstepA, voffA);
            PG8_WAIT_L(8); PG8_BAR; PG8_WAIT_L(0); PG8_MMA(0, 0, At, B0); PG8_BAR; PG8_SCHED;
            PG8_LDB(B1, 0, 1); PG8_STAGE(PG8_SB(0, 0), b2, voffB);
            PG8_BAR; PG8_WAIT_L(0); PG8_MMA(0, 1, At, B1); PG8_BAR;
            PG8_LDA(At, 0, 1); PG8_STAGE(PG8_SA(0, 0), a2, voffA);
            PG8_BAR; PG8_WAIT_L(0); PG8_MMA(1, 0, At, B0); PG8_BAR; PG8_SCHED;
            PG8_STAGE(PG8_SB(0, 1), b2 + hstepB, voffB);
            PG8_WAIT_V(6); PG8_BAR; PG8_MMA(1, 1, At, B1); PG8_BAR;
            PG8_LDB(B0, 1, 0); PG8_SCHED; PG8_LDA(At, 1, 0); PG8_STAGE(PG8_SA(0, 1), a2 + hstepA, voffA);
            PG8_WAIT_L(8); PG8_BAR; PG8_WAIT_L(0); PG8_MMA(0, 0, At, B0); PG8_BAR; PG8_SCHED;
            PG8_LDB(B1, 1, 1); PG8_STAGE(PG8_SB(1, 0), b3, voffB);
            PG8_BAR; PG8_WAIT_L(0); PG8_MMA(0, 1, At, B1); PG8_BAR;
            PG8_LDA(At, 1, 1); PG8_STAGE(PG8_SA(1, 0), a3, voffA);
            PG8_BAR; PG8_WAIT_L(0); PG8_MMA(1, 0, At, B0); PG8_BAR; PG8_SCHED;
            PG8_STAGE(PG8_SB(1, 1), b3 + hstepB, voffB);
            PG8_WAIT_V(6); PG8_BAR; PG8_MMA(1, 1, At, B1); PG8_BAR;
            }
        }
        if constexpr (ALIGN_EPI) { if (wr == 0) PG8_BAR; }
        if constexpr (Epi::USE_RS) {
            f32x4 rq[4]; if (has_next && wid < 4) E.rs_load(nxt, wid * 64 + lane_id_v(), rq);
            E(acc, cur, wr, wc, fr, fq, lds, ui & 1);
            if (has_next && wid < 4) E.rs_store(rq, lds, (ui + 1) & 1, wid * 64 + lane_id_v());
        } else { E(acc, cur, wr, wc, fr, fq, lds, ui & 1); }
        S.done(cur);
        if (!has_next) break;
        if constexpr (Epi::ACC_INIT) E.init(acc, nxt, wr, wc, fr, fq);
        else {
#pragma unroll
        for (int a = 0; a < 2; ++a)
#pragma unroll
            for (int b = 0; b < 2; ++b)
#pragma unroll
                for (int m = 0; m < 4; ++m)
#pragma unroll
                    for (int n = 0; n < 2; ++n) acc[a][b][m][n] = (f32x4){0.f, 0.f, 0.f, 0.f};
        }
        cur = nxt; cA = nA; cB = nB; ++ui;
        if constexpr (ALIGN_EPI) { if (wr == 1) PG8_BAR; }
    }
    PG8_WAIT_V(0);
    if constexpr (!ALIGN_EPI) { if (wr == 0) PG8_BAR; }
    PG8_BAR;
    if constexpr (Epi::AFTER_DRAIN) { E.fused(acc, cur, wr, wc, fr, fq, lds, wid, lane); S.done(cur); }
#undef PG8_SA
#undef PG8_SB
#undef PG8_STAGE
#undef PG8_LDA
#undef PG8_LDB
#undef PG8_MMA
#undef PG8_WAIT_V
#undef PG8_WAIT_L
#undef PG8_BAR
#undef PG8_SCHED
}
}

namespace att {
typedef unsigned short bf16_t;
typedef short bf16x8 __attribute__((ext_vector_type(8)));
typedef short s16x4 __attribute__((ext_vector_type(4)));
typedef float f32x16 __attribute__((ext_vector_type(16)));
typedef float f32x4 __attribute__((ext_vector_type(4)));
typedef unsigned u32x4 __attribute__((ext_vector_type(4)));
constexpr int NW = 8, QBLK = 32, KVBLK = 64, QB = NW * QBLK, D = 128;
constexpr int SHM_V = KVBLK * D * 2, SHM_K = KVBLK * D * 2;
constexpr int OFF_WS = 2 * SHM_V + 2 * SHM_K, OFF_BK = OFF_WS + NW * 64 * 4, ATT_LDS = OFF_BK + 8192;
constexpr float SCALE = 0.08838834764831845f, THR = 8.f;
constexpr int WBIG = 1 << 30;
#define KSWZ(row, colB) ((row) * 256 + ((colB) ^ (((row) & 7) << 4)))
#define SBAR() __builtin_amdgcn_sched_barrier(0)
__device__ __forceinline__ int v_st(int k, int c) { const int kk = (k & ~0xC) | ((k & 4) << 1) | ((k & 8) >> 1); return ((kk >> 3) * 4 + (c >> 5)) * 512 + ((kk & 7) * 32 + (c & 31)) * 2; }
__device__ __forceinline__ int v_rd_base(int lane) { return ((lane & 3) << 3) | (((lane >> 2) & 3) << 6) | (((lane >> 4) & 1) << 5) | (((lane >> 5) & 1) << 8); }
constexpr int v_rd_off(int d0, int ks, int half) { return d0 * 512 + ks * 4096 + half * 2048; }
__device__ __forceinline__ int crow(int r, int hi) { return (r & 3) + 8 * (r >> 2) + 4 * hi; }
__device__ __forceinline__ unsigned cvtpk(float lo, float hi) { unsigned r; asm volatile("v_cvt_pk_bf16_f32 %0, %1, %2" : "=v"(r) : "v"(lo), "v"(hi)); return r; }
__device__ __forceinline__ bf16x8 load8(const bf16_t* p) { return *reinterpret_cast<const bf16x8*>(p); }
__device__ __forceinline__ void mask_tile(f32x16& p0, f32x16& p1, int dq, unsigned W) {
    const float NEG = -__builtin_inff();
#pragma unroll
    for (int r = 0; r < 16; ++r) { const int c = (r & 3) + 8 * (r >> 2);
        if ((unsigned)(dq - c) >= W) p0[r] = NEG;
        if ((unsigned)(dq - c - 32) >= W) p1[r] = NEG; }
}
__device__ __forceinline__ void partialSM(f32x16& p0, f32x16& p1, float& m_reg, float& mn, float& alpha) {
    float pmax = p0[0]; for (int r = 1; r < 16; ++r) pmax = fmaxf(pmax, p0[r]); for (int r = 0; r < 16; ++r) pmax = fmaxf(pmax, p1[r]);
    { auto rr = __builtin_amdgcn_permlane32_swap(__float_as_uint(pmax), __float_as_uint(pmax), false, false);
      pmax = fmaxf(__uint_as_float(rr[0]), __uint_as_float(rr[1])); }
    constexpr float C2 = 1.4426950408889634f * SCALE;
    if (__builtin_expect(__all((pmax - m_reg) * SCALE <= THR), 1)) { mn = m_reg; alpha = 1.f; }
    else { mn = fmaxf(m_reg, pmax); alpha = __builtin_amdgcn_exp2f((m_reg - mn) * C2); m_reg = mn; }
    const float mnL = -mn * C2;
    for (int r = 0; r < 16; ++r) p0[r] = fmaf(p0[r], C2, mnL); for (int r = 0; r < 16; ++r) p1[r] = fmaf(p1[r], C2, mnL);
    for (int r = 0; r < 16; ++r) p0[r] = __builtin_amdgcn_exp2f(p0[r]);
}
__device__ __forceinline__ void finishSM(f32x16& p0, f32x16& p1, float alpha, float& l_reg, bf16x8& pa0, bf16x8& pa1, bf16x8& pa2, bf16x8& pa3) {
    for (int r = 0; r < 16; ++r) p1[r] = __builtin_amdgcn_exp2f(p1[r]);
    float ps = 0; for (int r = 0; r < 16; ++r) ps += p0[r]; for (int r = 0; r < 16; ++r) ps += p1[r];
    { auto rr = __builtin_amdgcn_permlane32_swap(__float_as_uint(ps), __float_as_uint(ps), false, false);
      ps = __uint_as_float(rr[0]) + __uint_as_float(rr[1]); }
    l_reg = l_reg * alpha + ps;
#define PK4(P, B_, OUT) do { unsigned a0 = cvtpk(P[B_+0], P[B_+1]), a1 = cvtpk(P[B_+2], P[B_+3]);                          \
        unsigned b0 = cvtpk(P[B_+4], P[B_+5]), b1 = cvtpk(P[B_+6], P[B_+7]);                                             \
        auto r0 = __builtin_amdgcn_permlane32_swap(a0, b0, false, false); auto r1 = __builtin_amdgcn_permlane32_swap(a1, b1, false, false); \
        u32x4 w = {r0[0], r1[0], r0[1], r1[1]}; OUT = *reinterpret_cast<bf16x8*>(&w); } while (0)
    PK4(p0, 0, pa0); PK4(p0, 8, pa1); PK4(p1, 0, pa2); PK4(p1, 8, pa3);
#undef PK4
}
template <int KB>
__device__ __forceinline__ void qkt(f32x16& p0, f32x16& p1, const char* K_lds, int r32, int hi, const bf16x8* qr, const float* bb) {
#pragma unroll
    for (int g = 0; g < 4; ++g) { const f32x4 b0 = *(const f32x4*)(bb + 8 * g), b1 = *(const f32x4*)(bb + 32 + 8 * g);
#pragma unroll
        for (int i = 0; i < 4; ++i) { p0[4 * g + i] = b0[i]; p1[4 * g + i] = b1[i]; } }
    const char* kb[4];
#pragma unroll
    for (int dd = 0; dd < 4; ++dd) kb[dd] = K_lds + KB * SHM_K + KSWZ(r32, (dd * 16 + hi * 8) * 2);
#pragma unroll
    for (int d0 = 0; d0 < 8; ++d0) { const char* a = kb[d0 & 3] + (d0 >> 2) * 128;
        bf16x8 b0 = *reinterpret_cast<const bf16x8*>(a);
        bf16x8 b1 = *reinterpret_cast<const bf16x8*>(a + 32 * 256);
        p0 = __builtin_amdgcn_mfma_f32_32x32x16_bf16(b0, qr[d0], p0, 0, 0, 0);
        p1 = __builtin_amdgcn_mfma_f32_32x32x16_bf16(b1, qr[d0], p1, 0, 0, 0); }
}
template <int VB>
__device__ __forceinline__ void pv_tile(f32x16* o, int vb0, bf16x8 pa0, bf16x8 pa1, bf16x8 pa2, bf16x8 pa3) {
#define TRRD(dst, off) asm volatile("ds_read_b64_tr_b16 %0, %1 offset:%2" : "=&v"(dst) : "v"(vb0), "i"(off) : "memory")
#define PV_D0(d0) do { s16x4 l0, l1, l2, l3, h0, h1, h2, h3; constexpr int b_ = VB * SHM_V + v_rd_off(d0, 0, 0);   \
        TRRD(l0, b_); TRRD(h0, b_ + 2048); TRRD(l1, b_ + 4096); TRRD(h1, b_ + 6144); TRRD(l2, b_ + 8192); TRRD(h2, b_ + 10240); TRRD(l3, b_ + 12288); TRRD(h3, b_ + 14336); \
        asm volatile("s_waitcnt lgkmcnt(0)" ::: "memory"); SBAR();   \
        o[d0] = __builtin_amdgcn_mfma_f32_32x32x16_bf16(pa0, (bf16x8){l0[0], l0[1], l0[2], l0[3], h0[0], h0[1], h0[2], h0[3]}, o[d0], 0, 0, 0);   \
        o[d0] = __builtin_amdgcn_mfma_f32_32x32x16_bf16(pa1, (bf16x8){l1[0], l1[1], l1[2], l1[3], h1[0], h1[1], h1[2], h1[3]}, o[d0], 0, 0, 0);   \
        o[d0] = __builtin_amdgcn_mfma_f32_32x32x16_bf16(pa2, (bf16x8){l2[0], l2[1], l2[2], l2[3], h2[0], h2[1], h2[2], h2[3]}, o[d0], 0, 0, 0);   \
        o[d0] = __builtin_amdgcn_mfma_f32_32x32x16_bf16(pa3, (bf16x8){l3[0], l3[1], l3[2], l3[3], h3[0], h3[1], h3[2], h3[3]}, o[d0], 0, 0, 0); } while (0)
    PV_D0(0); PV_D0(1); PV_D0(2); PV_D0(3);
#undef PV_D0
#undef TRRD
}
constexpr int QP = 4608;
struct Blk { bf16_t* Q; const bf16_t* K; const float* flog; float fb; int voff, goff, P0, skv, kvpitch, reuse; float lim; };
struct Seam { bf16x8 qr[8]; bf16x8 st_v0, st_v1, st_k0, st_k1; };
__device__ __forceinline__ int ntiles(const Blk& b) { int j = (b.P0 + QB - 1) / KVBLK + 1; if (j > b.skv / KVBLK) j = b.skv / KVBLK; return j; }
#define ROW(p, pitch, k0, rr) ((p) + (size_t)((k0) + (rr)) * (pitch) + sc)
#define VMW() asm volatile("s_waitcnt vmcnt(0)" ::: "memory")
#define VMWN(n) asm volatile("s_waitcnt vmcnt(%0)" :: "i"(n) : "memory")
#define SLOAD_H(Kp, Vp, pitch, k0) do { S.st_v0 = load8(ROW(Vp, pitch, k0, sr)); S.st_v1 = load8(ROW(Vp, pitch, k0, 32 + sr));              \
                         S.st_k0 = load8(ROW(Kp, pitch, k0, sr)); S.st_k1 = load8(ROW(Kp, pitch, k0, 32 + sr)); } while (0)
#define SWRITE_HK(bf) do { *(bf16x8*)(K_lds + (bf) * SHM_K + kws) = S.st_k0; *(bf16x8*)(K_lds + (bf) * SHM_K + kws + 32 * 256) = S.st_k1; } while (0)
#define SWRITE_HV(bf) do { *(bf16x8*)(V_lds + (bf) * SHM_V + vst0) = S.st_v0; *(bf16x8*)(V_lds + (bf) * SHM_V + vst1) = S.st_v1; } while (0)
#define SWRITE_H(bf) do { SWRITE_HV(bf); SWRITE_HK(bf); } while (0)
__device__ __forceinline__ void prime(const Blk& cur, char* lds, Seam& S, int wid) {
    const int lane = lane_id_v();
    const int tid = wid * 64 + lane, r32 = lane & 31, hi = lane >> 5;
    const int sr = tid >> 4, sc = (tid & 15) * 8, kws = KSWZ(sr, sc * 2); char* K_lds = lds + 2 * SHM_V;
    for (int d0 = 0; d0 < 8; ++d0) S.qr[d0] = load8(cur.Q + (size_t)(wid * QBLK + r32) * QP + d0 * 16 + hi * 8);
    SLOAD_H(cur.K, cur.K + cur.voff, cur.kvpitch, (ntiles(cur) - 1) * KVBLK); VMW(); SWRITE_HK(0);
    __syncthreads();
}
__device__ __forceinline__ void block(const Blk& cur, const Blk& nxt, char* lds, Seam& S, int wid) {
    const int lane = lane_id_v();
    const int tid = wid * 64 + lane, r32 = lane & 31, hi = lane >> 5;
    constexpr int W = WBIG;
    int j_hi = (cur.P0 + QB - 1) / KVBLK + 1; if (j_hi > cur.skv / KVBLK) j_hi = cur.skv / KVBLK;
    const int NTF = j_hi; int NT = NTF;
    const int qlo = cur.P0 + wid * QBLK, qm = qlo + r32 - 4 * hi;
    char* V_lds = lds; char* K_lds = lds + 2 * SHM_V;
    float* ws = (float*)(lds + OFF_WS) + wid * 64; float* li_l = ws, * al_l = ws + 32;
    float* bkl = (float*)(lds + OFF_BK);
    { const int nkeys = NT * KVBLK;
      if (cur.reuse) {}
      else if (cur.flog) { const int k0 = 4 * tid; float f[4];
#pragma unroll
          for (int e = 0; e < 4; ++e) { float x = 0.f; if (k0 + e < nkeys) x = cur.flog[(size_t)(k0 + e) * 16] + cur.fb;
              f[e] = k0 + e < nkeys ? fminf(x, 0.f) - log1pf(__expf(-fabsf(x))) : 0.f; }
          f[1] += f[0]; f[2] += f[1]; f[3] += f[2];
          float sc = f[3];
#pragma unroll
          for (int o_ = 1; o_ < 64; o_ <<= 1) { const float t_ = __shfl_up(sc, o_); if (lane >= o_) sc += t_; }
          if (lane == 63) ws[0] = sc;
          __syncthreads();
          float off = sc - f[3];
          for (int w_ = 0; w_ < wid; ++w_) off += ((const float*)(lds + OFF_WS))[w_ * 64];
#pragma unroll
          for (int e = 0; e < 4; ++e) if (k0 + e < nkeys) bkl[k0 + e] = -(f[e] + off) * (1.f / SCALE); }
      else for (int k = tid; k < nkeys; k += NW * 64) bkl[k] = 0.f;
      __syncthreads(); }
    if (cur.flog != nullptr && NTF > 5) { const float ref = bkl[cur.P0];
        for (int t = 5; t < NTF; ++t) if ((ref - bkl[(NTF - 1 - t) * KVBLK + KVBLK - 1]) * SCALE > cur.lim) { NT = t; break; }
        NT = __builtin_amdgcn_readfirstlane(NT); }
    float m_reg = -1e30f, l_reg = 0; f32x16 o[4] = {};
    const int sr = tid >> 4, sc = (tid & 15) * 8, vst0 = v_st(sr, sc), vst1 = v_st(32 + sr, sc), kws = KSWZ(sr, sc * 2);
    const int vb0 = (int)(uintptr_t)V_lds + v_rd_base(lane);
    const bf16_t* Kh = cur.K; const bf16_t* Vh = cur.K + cur.voff; const int kvp = cur.kvpitch;
#define RESC(a) do { if (__any((a) < 1.f)) { if (hi == 0) al_l[r32] = (a); asm volatile("s_waitcnt lgkmcnt(0)" ::: "memory");              \
                     for (int d_ = 0; d_ < 4; ++d_) for (int r = 0; r < 16; ++r) o[d_][r] *= al_l[crow(r, hi)]; } } while (0)
#define KBASE(t) ((NTF - 1 - (t)) * KVBLK)
#define MASKT(P0_, P1_, t) do { const int kb_ = KBASE(t); if (kb_ + KVBLK - 1 > qlo) mask_tile(P0_, P1_, qm - kb_, (unsigned)W); } while (0)
#define BB(t) (bkl + KBASE(t) + 4 * hi)
    constexpr int NQL = 8;
#define SEAM_K0() do { VMWN(NQL); SWRITE_HK(0); SBAR(); } while (0)
    f32x16 pA0, pA1, pB0, pB1; float mnA, mnB, alA, alB; bf16x8 pa0, pa1, pa2, pa3;
    SWRITE_HV(0); SBAR();
    if (NT > 1) { SLOAD_H(Kh, Vh, kvp, KBASE(1)); }
    SBAR(); qkt<0>(pA0, pA1, K_lds, r32, hi, S.qr, BB(0));
    MASKT(pA0, pA1, 0); partialSM(pA0, pA1, m_reg, mnA, alA);
    if (NT > 1) { VMW(); SWRITE_H(1); }
    __syncthreads();
#define HALF_STEP(PX0, PX1, mnX, alX, PY0, PY1, alY, t, KB, VB, SB) do {                                                      \
        SBAR(); qkt<KB>(PX0, PX1, K_lds, r32, hi, S.qr, BB(t));                                                                      \
        finishSM(PY0, PY1, alY, l_reg, pa0, pa1, pa2, pa3); SBAR();                                                           \
        if ((t) + 1 < NT) { SLOAD_H(Kh, Vh, kvp, KBASE((t) + 1)); SBAR(); }                                                   \
        pv_tile<VB>(o, vb0, pa0, pa1, pa2, pa3); MASKT(PX0, PX1, (t)); partialSM(PX0, PX1, m_reg, mnX, alX);   \
        __syncthreads();                                                                                                      \
        if ((t) + 1 < NT) { VMW(); SWRITE_H(SB); }                                                                            \
        RESC(alX); __syncthreads(); } while (0)
    for (int t = 1; t + 1 < NT; t += 2) {
        HALF_STEP(pB0, pB1, mnB, alB, pA0, pA1, alA, t, 1, 0, 0);
        HALF_STEP(pA0, pA1, mnA, alA, pB0, pB1, alB, t + 1, 0, 1, 1);
    }
    const bool even = (NT & 1) == 0;
    if (even) { SBAR(); qkt<1>(pB0, pB1, K_lds, r32, hi, S.qr, BB(NT - 1)); SBAR(); }
    SLOAD_H(nxt.K, nxt.K + nxt.voff, nxt.kvpitch, (ntiles(nxt) - 1) * KVBLK); SBAR();
#pragma unroll
    for (int d0 = 0; d0 < 8; ++d0) S.qr[d0] = load8(nxt.Q + (size_t)(wid * QBLK + r32) * QP + d0 * 16 + hi * 8);
    SBAR();
    finishSM(pA0, pA1, alA, l_reg, pa0, pa1, pa2, pa3); SBAR();
    pv_tile<0>(o, vb0, pa0, pa1, pa2, pa3);
    if (even) { MASKT(pB0, pB1, NT - 1); partialSM(pB0, pB1, m_reg, mnB, alB); __syncthreads(); RESC(alB);
        finishSM(pB0, pB1, alB, l_reg, pa0, pa1, pa2, pa3); SBAR(); pv_tile<1>(o, vb0, pa0, pa1, pa2, pa3); }
    SBAR(); SEAM_K0();
    if (hi == 0) li_l[r32] = l_reg; asm volatile("s_waitcnt lgkmcnt(0)" ::: "memory");
    float rli[16];
#pragma unroll
    for (int r = 0; r < 16; ++r) rli[r] = __builtin_amdgcn_rcpf(li_l[crow(r, hi)]);
    const int odd = r32 & 1;
    bf16_t* Ow = cur.Q + (size_t)(wid * QBLK + 4 * hi) * QP + (r32 & ~1) + 32 * odd; const int goff = cur.goff;
    auto fin = [&](auto has_gate) {
        unsigned g[16][2];
        if (has_gate.value) {
#pragma unroll
            for (int r = 0; r < 16; ++r) { const int ro = ((r & 3) + 8 * (r >> 2)) * QP;
#pragma unroll
                for (int dp = 0; dp < 2; ++dp) g[r][dp] = *(const unsigned*)(Ow + goff + ro + dp * 64); }
        }
#pragma unroll
        for (int r = 0; r < 16; ++r) { const int ro = ((r & 3) + 8 * (r >> 2)) * QP;
#pragma unroll
            for (int dp = 0; dp < 2; ++dp) { const float a = o[2 * dp][r] * rli[r], b = o[2 * dp + 1][r] * rli[r];
                const float recv = dppf<0xB1>(odd ? a : b);
                float lo = odd ? recv : a, hi2 = odd ? b : recv;
                if (has_gate.value) { lo *= __uint_as_float(g[r][dp] << 16); hi2 *= __uint_as_float(g[r][dp] & 0xffff0000u); }
                *(unsigned*)(Ow + ro + dp * 64) = cvtpk(lo, hi2); } }
    };
    if (goff) fin(std::true_type{}); else fin(std::false_type{});
    __syncthreads();
#undef RESC
#undef KBASE
#undef MASKT
#undef BB
#undef SEAM_K0
#undef HALF_STEP
}
#undef ROW
#undef VMW
#undef VMWN
#undef SLOAD_H
#undef SWRITE_HK
#undef SWRITE_HV
#undef SWRITE_H
#undef KSWZ
#undef SBAR
template <class Src> __device__ __forceinline__ void phase(char* lds, const Src& src, int wid) {
    Blk cur, nxt; if (!src(0, cur)) return;
    Seam S; prime(cur, lds, S, wid);
    for (int n = 0;; ++n) { const bool more = src(n + 1, nxt); if (!more) nxt = cur; block(cur, nxt, lds, S, wid); if (!more) break; cur = nxt; }
}
}

constexpr int NWAVES = 8;
#ifndef MK_LAUNCH_PER_PHASE
#define MK_LAUNCH_PER_PHASE 0
#endif
constexpr int N_PHASES = 12;

constexpr size_t KiB = 1u << 10, MiB = 1u << 20;
constexpr size_t WS_CTL = 0, CTL_ZERO_BYTES = 1 * MiB;
constexpr size_t WS_WIN0 = 1 * MiB, WS_WIN1 = WS_WIN0 + (size_t)N_IN * DM * 2;
constexpr size_t WS_WOUT0 = 20 * MiB, WS_WOUT1 = 23 * MiB;
constexpr size_t WS_WM1_0 = 26 * MiB, WS_WM1_1 = 34 * MiB, WS_WM2_0 = 42 * MiB, WS_WM2_1 = 50 * MiB;
constexpr size_t WS_WMKV = 58 * MiB;
constexpr size_t WS_PROJ = 60 * MiB;
constexpr size_t WS_XB = 204 * MiB;
constexpr size_t WS_SSQ = 236 * MiB;
constexpr size_t WS_AB = 245 * MiB;
constexpr size_t WS_MEMKV = 246 * MiB;
constexpr size_t WS_XSQ = 250 * MiB;
constexpr size_t WS_FCUM = 251 * MiB;
constexpr size_t WS_MSSQ = 251 * MiB + 512 * KiB;
constexpr size_t WS_MSQ = 251 * MiB + 768 * KiB;
constexpr size_t WS_END = 252 * MiB;
static_assert(WS_WIN1 + (size_t)N_IN * DM * 2 <= WS_WOUT0 && WS_PROJ + (size_t)MROWS * PW * 2 <= WS_XB && WS_SSQ + (size_t)36 * MROWS * 16 <= WS_AB, "d_ws map");
constexpr size_t DO_MEMB = 0;
constexpr int CW_BAR = 4096;

constexpr int LDS_BYTES = 155648;
constexpr int MISC_OFF = LDS_BYTES - 256;

#define GAS __attribute__((address_space(1)))
#define LAS __attribute__((address_space(3)))
typedef unsigned short bf16;
typedef unsigned v4u __attribute__((ext_vector_type(4)));
typedef float f32x4 __attribute__((ext_vector_type(4)));
typedef short bf16x8 __attribute__((ext_vector_type(8)));
typedef GAS unsigned gu32;
typedef GAS unsigned long long gu64;
#define RLX_AGENT __ATOMIC_RELAXED, __HIP_MEMORY_SCOPE_AGENT
#define LDS_WAIT() asm volatile("s_waitcnt lgkmcnt(0)" ::: "memory")
#define VM_WAIT() asm volatile("s_waitcnt vmcnt(0)" ::: "memory")
__device__ __forceinline__ unsigned long long rt() { return __builtin_amdgcn_s_memrealtime(); }
__device__ __forceinline__ unsigned f2bf(float f) { unsigned u = __builtin_bit_cast(unsigned, f); return (u + 0x7fffu + ((u >> 16) & 1u)) >> 16; }
__device__ __forceinline__ unsigned pk2(float lo, float hi) { return f2bf(lo) | (f2bf(hi) << 16); }

#define XB_TMO      128
#define XB_XCNT(j)  (256  + 64 * (j))
#define XB_XSUB(j)  (1280 + 64 * (j))
#define XB_XGEN(j)  (2304 + 64 * (j))
#define XB_TOP      3328
#define XB_TOPGEN   3392
#define XCD_BAR_WORDS 3456
#define XB_SPIN_CAP (1u << 18)

__device__ __forceinline__ unsigned xb_ld(unsigned* p)              { return __hip_atomic_load(p, __ATOMIC_RELAXED, __HIP_MEMORY_SCOPE_AGENT); }
__device__ __forceinline__ unsigned xb_add(unsigned* p, unsigned v) { return __hip_atomic_fetch_add(p, v, __ATOMIC_RELAXED, __HIP_MEMORY_SCOPE_AGENT); }
__device__ __forceinline__ unsigned xb_xcc_id() { return (unsigned)__builtin_amdgcn_s_getreg((3 << 11) | 20) & 0xFu; }
#define XB_SPIN(cond, bar) do { unsigned _sp = 0; while (cond) { __builtin_amdgcn_s_sleep(1); \
    if ((++_sp & 255u) == 0u) { if (xb_ld(&(bar)[XB_TMO])) break; if (_sp > XB_SPIN_CAP) { atomicAdd(&(bar)[XB_TMO], 1u); break; } } } } while (0)

struct XcdBarrier {
    unsigned* bar; unsigned x; int wv;
    volatile LAS unsigned* st;
};

__device__ __forceinline__ XcdBarrier xcd_barrier_post(unsigned* bar, volatile LAS unsigned* st) {
    XcdBarrier b; b.bar = bar; b.x = xb_xcc_id(); b.st = st;
    if (threadIdx.x == 0) (void)xb_add(&bar[XB_XCNT(b.x)], 1u);
    return b;
}
__device__ __forceinline__ void xcd_barrier_complete(unsigned* bar, unsigned x, unsigned& nloc, unsigned& nx) {
    const unsigned G = gridDim.x * gridDim.y * gridDim.z;
    unsigned sum, cnt, mine, sp = 0u;
    for (;;) {
        sum = 0u; cnt = 0u; mine = 0u;
#pragma unroll
        for (unsigned j = 0; j < 16; ++j) { const unsigned c = xb_ld(&bar[XB_XCNT(j)]); sum += c; cnt += (c > 0u) ? 1u : 0u; mine = (j == x) ? c : mine; }
        if (sum == G) break;
        __builtin_amdgcn_s_sleep(1);
        if ((++sp & 255u) == 0u) { if (xb_ld(&bar[XB_TMO])) break; if (sp > XB_SPIN_CAP) { atomicAdd(&bar[XB_TMO], 1u); break; } }
    }
    nloc = mine > 0u ? mine : 1u; nx = cnt > 0u ? cnt : 1u;
}

__device__ __forceinline__ void xcd_barrier(const XcdBarrier& b) {
    asm volatile("s_waitcnt vmcnt(0)" ::: "memory");
    __syncthreads();
    if (b.wv == 0 && lane_id_v() == 0) {
        unsigned* bar = b.bar;
        __builtin_amdgcn_s_waitcnt(0);
        unsigned nloc = b.st[0], nx = b.st[1];
        if (nloc == 0u) { xcd_barrier_complete(bar, b.x, nloc, nx); b.st[0] = nloc; b.st[1] = nx; }
        const unsigned old = xb_add(&bar[XB_XSUB(b.x)], 1u);
        const unsigned gen = old / nloc;
        if (old + 1u == (gen + 1u) * nloc) {
            __builtin_amdgcn_fence(__ATOMIC_RELEASE, "agent");
            asm volatile("s_waitcnt vmcnt(0)" ::: "memory");
            const unsigned og = xb_add(&bar[XB_TOP], 1u);
            const unsigned tg = og / nx;
            if (og + 1u == (tg + 1u) * nx) xb_add(&bar[XB_TOPGEN], 1u);
            else XB_SPIN(xb_ld(&bar[XB_TOPGEN]) == tg, bar);
            __builtin_amdgcn_fence(__ATOMIC_ACQUIRE, "agent");
            xb_add(&bar[XB_XGEN(b.x)], 1u);
            asm volatile("s_waitcnt vmcnt(0)" ::: "memory");
        } else {
            XB_SPIN(xb_ld(&bar[XB_XGEN(b.x)]) == gen, bar);
            __builtin_amdgcn_fence(__ATOMIC_ACQUIRE, "agent");
            asm volatile("s_waitcnt vmcnt(0)" ::: "memory");
        }
    }
    __syncthreads();
}


__device__ __forceinline__ float bflo(unsigned u) { return __builtin_bit_cast(float, u << 16); }
__device__ __forceinline__ float bfhi(unsigned u) { return __builtin_bit_cast(float, u & 0xffff0000u); }
typedef float f32x2_t __attribute__((ext_vector_type(2))); typedef __bf16 bf16x2_t __attribute__((ext_vector_type(2)));
__device__ __forceinline__ unsigned pkbf(float lo, float hi) { const f32x2_t v = {lo, hi}; const bf16x2_t b = __builtin_convertvector(v, bf16x2_t); return __builtin_bit_cast(unsigned, b); }
__device__ __forceinline__ float wave_sum(float v) { return add_xor32(add_xor16(row16_sum(v))); }
__device__ __forceinline__ float wave_max(float v) {
#pragma unroll
    for (int o = 1; o < 64; o <<= 1) v = fmaxf(v, __shfl_xor(v, o));
    return v;
}

struct Args { const float* in[20]; float* out; unsigned char* ws; int ph_lo, ph_hi, li, pad; };
enum { I_X = 0, I_MEM, I_MEMNW, I_WMKV, I_MEMKNW, I_NORM1, I_DNWIN, I_DNCONV, I_DNALOG, I_DNDT, I_DNONW, I_FOXWIN, I_FOXFB, I_FOXQNW, I_FOXKNW, I_MEMQNW, I_WOUT, I_NORM2, I_WM1, I_WM2 };

struct Frame {
    LAS unsigned char* lds;
    int G, bid, wv;
    const float* const* in; float* out; unsigned char* ws;
};


constexpr int CW_XCC = 32768, CW_BAD = 33792, CW_GRP = 65536;
struct GrpBar { unsigned* cnt; unsigned* tmo; int wv; bool on; };
__device__ __forceinline__ void grp_barrier(const GrpBar& gb, int seam) {
    asm volatile("s_waitcnt vmcnt(0)" ::: "memory");
    __syncthreads();
    if (gb.wv == 0 && lane_id_v() == 0) { unsigned* p = gb.cnt + seam * 64;
        (void)__hip_atomic_fetch_add(p, 1u, __ATOMIC_RELAXED, __HIP_MEMORY_SCOPE_AGENT);
        unsigned sp = 0;
        while (__hip_atomic_load(p, __ATOMIC_RELAXED, __HIP_MEMORY_SCOPE_AGENT) < 4u) { __builtin_amdgcn_s_sleep(1); if (++sp > (1u << 22)) { atomicAdd(gb.tmo, 1u); break; } }
        __builtin_amdgcn_fence(__ATOMIC_ACQUIRE, "agent");
        asm volatile("s_waitcnt vmcnt(0)" ::: "memory"); }
    __syncthreads();
}
struct Tix { int tid, lane, wave; };
__device__ __forceinline__ int lane_id() { return lane_id_v(); }
__device__ __forceinline__ Tix tix(int wv) { Tix t; t.lane = lane_id(); t.wave = wv; t.tid = wv * 64 + t.lane; return t; }
struct TSeg { const float* W; int K, ldw, src0, ncols; bf16* WT; int dst0; const float* scale; };
__device__ __forceinline__ TSeg get_seg(const Frame& F, int s) {
    TSeg t; t.scale = nullptr; t.src0 = 0; t.dst0 = 0;
    if (s < 12) {
        const int l = s / 6, j = s % 6;
        t.W = l ? F.in[I_FOXWIN] : F.in[I_DNWIN]; t.K = DM; t.ldw = l ? FOX_IN : DN_IN; t.WT = (bf16*)(F.ws + (l ? WS_WIN1 : WS_WIN0)); t.scale = F.in[I_NORM1] + l * DM;
        const int qm0 = l ? 4104 : 4112, nsc = l ? 8 : 16;
        t.ncols = 1024;
        if (j == 0) { t.src0 = 1024; t.dst0 = PC_K; } else if (j == 1) { t.src0 = 2048; t.dst0 = PC_V; } else if (j == 2) { t.src0 = 3072; t.dst0 = PC_Z; }
        else if (j == 3) { t.src0 = 0; t.dst0 = PC_Q; } else if (j == 4) { t.src0 = qm0; t.dst0 = PC_QM; t.ncols = 512; } else { t.src0 = 4096; t.dst0 = PC_AB; t.ncols = nsc; }
    } else if (s < 14) { const int l = s - 12; t.W = F.in[I_WOUT] + (size_t)l * OUT_IN * DM; t.K = OUT_IN; t.ldw = DM; t.ncols = DM; t.WT = (bf16*)(F.ws + (l ? WS_WOUT1 : WS_WOUT0)); }
    else if (s < 16) { const int l = s - 14; t.W = F.in[I_WM1] + (size_t)l * DM * FF; t.K = DM; t.ldw = FF; t.ncols = FF; t.WT = (bf16*)(F.ws + (l ? WS_WM1_1 : WS_WM1_0)); t.scale = F.in[I_NORM2] + l * DM; }
    else if (s < 18) { const int l = s - 16; t.W = F.in[I_WM2] + (size_t)l * FF * DM; t.K = FF; t.ldw = DM; t.ncols = DM; t.WT = (bf16*)(F.ws + (l ? WS_WM2_1 : WS_WM2_0)); }
    else { t.W = F.in[I_WMKV]; t.K = DM; t.ldw = DM; t.ncols = DM; t.WT = (bf16*)(F.ws + WS_WMKV); t.scale = F.in[I_MEMNW]; }
    return t;
}
__device__ __forceinline__ int seg_items(const TSeg& t) { return (t.K / 64) * ((t.ncols + 63) / 64); }
__device__ __forceinline__ void tr_load(const TSeg& t, int item, int lane, f32x4 (&v)[16]) {
    const int nblk = (t.ncols + 63) / 64, kb = item / nblk, nb = item - kb * nblk, k0 = 64 * kb, n0 = 64 * nb;
    const int n4 = (lane & 15) * 4, kr = lane >> 4; const bool ok = (n0 + n4) < t.ncols;
    const float* p = t.W + (size_t)(k0 + kr) * t.ldw + t.src0 + n0 + n4;
#pragma unroll
    for (int i = 0; i < 16; ++i) v[i] = ok ? __builtin_nontemporal_load((const f32x4*)(p + (size_t)(4 * i) * t.ldw)) : (f32x4){0.f, 0.f, 0.f, 0.f};
}
__device__ __forceinline__ void tr_store(const TSeg& t, int item, int lane, const f32x4 (&v)[16], LAS float* scr) {
    const int nblk = (t.ncols + 63) / 64, kb = item / nblk, nb = item - kb * nblk, k0 = 64 * kb, n0 = 64 * nb;
    const int n4 = (lane & 15) * 4, kr = lane >> 4;
#pragma unroll
    for (int i = 0; i < 16; ++i) *(LAS f32x4*)(scr + (4 * i + kr) * 68 + n4) = v[i];
    LDS_WAIT(); asm volatile("" ::: "memory");
    const int c = lane & 7; f32x4 s0 = {1.f, 1.f, 1.f, 1.f}, s1 = s0;
    if (t.scale) { s0 = *(const f32x4*)(t.scale + k0 + 8 * c); s1 = *(const f32x4*)(t.scale + k0 + 8 * c + 4); }
#pragma unroll
    for (int j = 0; j < 8; ++j) { const int n = (lane >> 3) + 8 * j; const LAS float* q = scr + (8 * c) * 68 + n;
        v4u o; o.x = pkbf(q[0 * 68] * s0[0], q[1 * 68] * s0[1]); o.y = pkbf(q[2 * 68] * s0[2], q[3 * 68] * s0[3]); o.z = pkbf(q[4 * 68] * s1[0], q[5 * 68] * s1[1]); o.w = pkbf(q[6 * 68] * s1[2], q[7 * 68] * s1[3]);
        if (n0 + n < t.ncols) *(v4u*)(t.WT + (size_t)(t.dst0 + n0 + n) * t.K + k0 + 8 * c) = o; }
    LDS_WAIT(); asm volatile("" ::: "memory");
}
template <int NR> __device__ __forceinline__ void rows_to_bf16(int lane, const float* x, bf16* o, float* sq) {
    f32x4 v[NR][4];
#pragma unroll
    for (int r = 0; r < NR; ++r)
#pragma unroll
        for (int j = 0; j < 4; ++j) v[r][j] = __builtin_nontemporal_load((const f32x4*)(x + (size_t)r * DM) + lane + 64 * j);
#pragma unroll
    for (int r = 0; r < NR; ++r) { float s = 0.f;
#pragma unroll
        for (int j = 0; j < 4; ++j) s += (v[r][j].x * v[r][j].x + v[r][j].y * v[r][j].y) + (v[r][j].z * v[r][j].z + v[r][j].w * v[r][j].w);
        s = wave_sum(s);
        unsigned long long* o8 = (unsigned long long*)(o + (size_t)r * DM) + lane;
#pragma unroll
        for (int j = 0; j < 4; ++j) o8[64 * j] = (unsigned long long)pkbf(v[r][j].x, v[r][j].y) | ((unsigned long long)pkbf(v[r][j].z, v[r][j].w) << 32);
        if (lane < 16) sq[(size_t)r * 16 + lane] = lane == 0 ? s : 0.f; }
}
template <int S0, int S1> __device__ __forceinline__ void convert_weights(const Frame& F, LAS float* scr, int lane, int gw, int NGW, int base) {
#pragma unroll
    for (int s = S0; s < S1; ++s) {
        const TSeg t = get_seg(F, s); const int n = seg_items(t);
        int it = gw - (base % NGW); if (it < 0) it += NGW;
        f32x4 va[16], vb[16];
        if (it < n) tr_load(t, it, lane, va);
        while (it < n) {
            int nx = it + NGW; if (nx < n) tr_load(t, nx, lane, vb);
            tr_store(t, it, lane, va, scr); it = nx; if (it >= n) break;
            nx = it + NGW; if (nx < n) tr_load(t, nx, lane, va);
            tr_store(t, it, lane, vb, scr); it = nx;
        }
        base += n;
    }
}
__device__ __forceinline__ void p0_prologue(const Frame& F) {
    const Tix T = tix(F.wv);
    LAS float* scr = (LAS float*)(F.lds + T.wave * 17408);
    const int gw = F.bid * NWAVES + T.wave, NGW = F.G * NWAVES;
    for (int m = gw * 8; m < MROWS; m += NGW * 8) rows_to_bf16<8>(T.lane, F.in[I_X] + (size_t)m * DM, (bf16*)(F.ws + WS_XB) + (size_t)m * DM, (float*)(F.ws + WS_XSQ) + (size_t)m * 16);
    for (int m = gw; m < MMEM; m += NGW) rows_to_bf16<1>(T.lane, F.in[I_MEM] + (size_t)m * DM, (bf16*)((unsigned char*)F.out + DO_MEMB) + (size_t)m * DM, (float*)(F.ws + WS_MSQ) + (size_t)m * 16);
    convert_weights<0, 6>(F, scr, T.lane, gw, NGW, 0);
    convert_weights<18, 19>(F, scr, T.lane, gw, NGW, 1168);
}

typedef short dn_bf16x8 __attribute__((ext_vector_type(8)));
typedef unsigned dn_u32x2 __attribute__((ext_vector_type(2)));
__device__ __forceinline__ f32x4 mfma16(dn_bf16x8 a, dn_bf16x8 b, f32x4 c) { return __builtin_amdgcn_mfma_f32_16x16x32_bf16(a, b, c, 0, 0, 0); }
__device__ __forceinline__ f32x4 mfma4(float a, float b, f32x4 c) { return __builtin_amdgcn_mfma_f32_16x16x4f32(a, b, c, 0, 0, 0); }
__device__ __forceinline__ dn_bf16x8 pack8f(f32x4 x, f32x4 y) { v4u w; w.x = pkbf(x[0], x[1]); w.y = pkbf(x[2], x[3]); w.z = pkbf(y[0], y[1]); w.w = pkbf(y[2], y[3]); return __builtin_bit_cast(dn_bf16x8, w); }
__device__ __forceinline__ dn_u32x2 pack4f(f32x4 x) { dn_u32x2 w; w.x = pkbf(x[0], x[1]); w.y = pkbf(x[2], x[3]); return w; }
__device__ __forceinline__ unsigned short bf1(float x) { return (unsigned short)(pkbf(x, 0.f) & 0xffffu); }
constexpr size_t DO_QKS = 4 * MiB, DO_HALO = 20 * MiB, DO_EGL = 27 * MiB, DO_WNEG = 28 * MiB;
constexpr int P_RAW = 0, P_GB = 51712, P_QH = 53248, P_KH = 70656, P_VBT = 88064, P_KBGT = 106496, P_QKL = 124928, P_END = 134144;
constexpr int P_AT = 0, P_TB = 17408, P_PS = 26624, P_PS2 = 29184;
struct DnPre { v4u P[7]; float ga, gb; f32x4 cw[3][4]; };
__device__ __forceinline__ void dn_prep_load(const Frame& F, int u, DnPre& R) {
    const Tix T = tix(F.wv); const int tid = T.tid, lane = T.lane;
    const int bh = u >> 5, c = u & 31, b = bh >> 3, h = bh & 7; const size_t row0 = (size_t)b * SEQ + c * 64; const int gch = b * 32 + c;
    const bf16* proj = (const bf16*)(F.ws + WS_PROJ); const float* AB = (const float*)(F.ws + WS_AB); const bf16* halo = (const bf16*)((unsigned char*)F.out + DO_HALO);
#pragma unroll
    for (int j = 0; j < 7; ++j) { const int id = tid + 512 * j; v4u val = {0u, 0u, 0u, 0u};
        if (id < 67 * 48) { const int r = id / 48, rem = id - r * 48, seg = rem >> 4, ch = rem & 15;
            const int col = (seg == 0 ? PC_Q : seg == 1 ? PC_K : PC_V) + h * HD + ch * 8;
            if (r >= 3) val = *(const v4u*)(proj + (row0 + r - 3) * PW + col);
            else if (c > 0) val = *(const v4u*)(halo + ((size_t)(gch - 1) * 3 + r) * PW + col); }
        R.P[j] = val; }
    R.ga = AB[(row0 + lane) * 16 + h]; R.gb = AB[(row0 + lane) * 16 + 8 + h];
    const float* convw = F.in[I_DNCONV]; const int c4 = lane & 31;
#pragma unroll
    for (int seg = 0; seg < 3; ++seg)
#pragma unroll
        for (int j = 0; j < 4; ++j) R.cw[seg][j] = *(const f32x4*)(convw + j * 3072 + seg * 1024 + h * HD + 4 * c4);
}
__device__ __forceinline__ void dn_gates(const Frame& F, int u, float ga, float gbv, LAS float* GB, int lane) {
    const int h = (u >> 5) & 7; float* egl = (float*)((unsigned char*)F.out + DO_EGL);
    const float x = ga + F.in[I_DNDT][h], sp = fmaxf(x, 0.f) + log1pf(__expf(-fabsf(x)));
    const float gt = -__expf(F.in[I_DNALOG][h]) * sp, beta = __builtin_amdgcn_rcpf(1.f + __expf(-gbv));
    float gc = gt;
#pragma unroll
    for (int o = 1; o < 64; o <<= 1) { const float t = __shfl_up(gc, o); if (lane >= o) gc += t; }
    const float gl = __shfl(gc, 63);
    GB[lane] = gc; GB[64 + lane] = beta; GB[128 + lane] = beta * __expf(gc); GB[192 + lane] = __expf(gl - gc); GB[256 + lane] = __expf(gc);
    if (lane == 0) egl[u] = __expf(gl);
}
#define PBAR() do { asm volatile("s_waitcnt lgkmcnt(0)" ::: "memory"); __builtin_amdgcn_s_barrier(); asm volatile("" ::: "memory"); } while (0)
__device__ __forceinline__ void dn_prep_unit(const Frame& F, int u, int u_next, DnPre& R, int par, bool first) {
    const Tix T = tix(F.wv); const int tid = T.tid, lane = T.lane, wave = T.wave, m = lane & 15, g = lane >> 4;
    const int bh = u >> 5, c = u & 31, b = bh >> 3, h = bh & 7; const size_t row0 = (size_t)b * SEQ + c * 64;
    bf16* proj = (bf16*)(F.ws + WS_PROJ);
    bf16* xbimg = (bf16*)((unsigned char*)F.out + DO_WNEG) + (size_t)u * 8192; bf16* qks = (bf16*)((unsigned char*)F.out + DO_QKS) + (size_t)u * 4096; float* egl = (float*)((unsigned char*)F.out + DO_EGL);
    LAS unsigned char* L = F.lds; LAS float* GB = (LAS float*)(L + (par ? P_END : P_GB)); LAS float* GBn = (LAS float*)(L + (par ? P_GB : P_END));
#pragma unroll
    for (int j = 0; j < 7; ++j) { const int id = tid + 512 * j;
        if (id < 67 * 48) { const int r = id / 48, rem = id - r * 48, seg = rem >> 4, ch = rem & 15; *(LAS v4u*)(L + P_RAW + r * 768 + seg * 256 + ch * 16) = R.P[j]; } }
    if (wave == 0 && first) dn_gates(F, u, R.ga, R.gb, GB, lane);
    f32x4 cw[3][4];
#pragma unroll
    for (int seg = 0; seg < 3; ++seg)
#pragma unroll
        for (int j = 0; j < 4; ++j) cw[seg][j] = R.cw[seg][j];
    PBAR();
    if (u_next >= 0) dn_prep_load(F, u_next, R);
    { const int hf = lane >> 5, c4 = lane & 31;
      dn_u32x2 xr[4][4]; float gbv[4];
      float kept[4][4];
#pragma unroll
      for (int jj = 0; jj < 12; ++jj) { constexpr int dummy_ = 0; (void)dummy_; const int seg = jj >> 2;
        const int i = 8 * wave + 2 * (jj & 3) + hf;
        if ((jj & 3) == 0) {
#pragma unroll
            for (int q = 0; q < 4; ++q) { const int iq = 8 * wave + 2 * q + hf;
#pragma unroll
                for (int j = 0; j < 4; ++j) xr[q][j] = *(const LAS dn_u32x2*)(L + P_RAW + (iq + j) * 768 + seg * 256 + c4 * 8);
                gbv[q] = GB[(seg == 0 ? 256 : seg == 1 ? 128 : 64) + iq]; } }
        f32x4 y = {0.f, 0.f, 0.f, 0.f};
#pragma unroll
        for (int j = 0; j < 4; ++j) { const f32x4 w = cw[seg][j];
            const dn_u32x2 xx = xr[jj & 3][j];
            y[0] += w[0] * bflo(xx.x); y[1] += w[1] * bfhi(xx.x); y[2] += w[2] * bflo(xx.y); y[3] += w[3] * bfhi(xx.y); }
        f32x4 s;
#pragma unroll
        for (int e = 0; e < 4; ++e) s[e] = y[e] * __builtin_amdgcn_rcpf(1.f + __expf(-y[e]));
        if (seg < 2) { float ss = (s[0] * s[0] + s[1] * s[1]) + (s[2] * s[2] + s[3] * s[3]);
            ss = add_xor16(row16_sum(ss));
            const float r = rsqrtf(ss + EPS) * (seg == 0 ? QSCALE : 1.f);
            s = s * r;
            *(LAS dn_u32x2*)(L + (seg == 0 ? P_QH : P_KH) + i * 272 + c4 * 8) = pack4f(s);
            if (seg == 0) { const int cc = c4 & 7, p0 = cc < 4 ? 8 * cc : 8 * (cc - 4) + 4;
                *(dn_u32x2*)(proj + (row0 + i) * PW + PC_Q + h * HD + 32 * (c4 >> 3) + p0) = pack4f(s * gbv[jj & 3]); }
            else { const float bge = gbv[jj & 3];
#pragma unroll
                for (int e = 0; e < 4; ++e) kept[jj & 3][e] = s[e] * bge; } }
        else { const float be = gbv[jj & 3];
#pragma unroll
            for (int e = 0; e < 4; ++e) kept[jj & 3][e] = s[e] * be; }
        if (seg >= 1 && (jj & 3) == 3) { unsigned w0[4], w1[4];
#pragma unroll
            for (int q = 0; q < 4; ++q) {
                const auto r0 = __builtin_amdgcn_permlane32_swap(__float_as_uint(kept[q][0]), __float_as_uint(kept[q][2]), false, false);
                const auto r1 = __builtin_amdgcn_permlane32_swap(__float_as_uint(kept[q][1]), __float_as_uint(kept[q][3]), false, false);
                w0[q] = pkbf(__uint_as_float(r0[0]), __uint_as_float(r0[1])); w1[q] = pkbf(__uint_as_float(r1[0]), __uint_as_float(r1[1])); }
            LAS unsigned char* dst = L + (seg == 1 ? P_KBGT : P_VBT) + (4 * c4 + 2 * hf) * 144 + 16 * wave;
            *(LAS v4u*)dst = (v4u){w0[0], w0[1], w0[2], w0[3]}; *(LAS v4u*)(dst + 144) = (v4u){w1[0], w1[1], w1[2], w1[3]}; } } }
    PBAR();
    LAS float* AT = (LAS float*)(L + P_AT);
#pragma unroll
    for (int q = 0; q < 2; ++q) { const int tt = wave + 8 * q, it = tt >> 2, jt = tt & 3;
        f32x4 kk = {0.f, 0.f, 0.f, 0.f}, qk = {0.f, 0.f, 0.f, 0.f};
        if (jt <= it) {
#pragma unroll
            for (int kq = 0; kq < 4; ++kq) { const dn_bf16x8 bk = *(const LAS dn_bf16x8*)(L + P_KH + (16 * jt + m) * 272 + (32 * kq + 8 * g) * 2);
                const dn_bf16x8 ak = *(const LAS dn_bf16x8*)(L + P_KH + (16 * it + m) * 272 + (32 * kq + 8 * g) * 2), aq = *(const LAS dn_bf16x8*)(L + P_QH + (16 * it + m) * 272 + (32 * kq + 8 * g) * 2);
                kk = mfma16(ak, bk, kk); qk = mfma16(aq, bk, qk); } }
        const int j = 16 * jt + m, jl = j & 31, p = jl < 16 ? 8 * (jl >> 2) + (jl & 3) : 8 * ((jl - 16) >> 2) + 4 + (jl & 3);
        const float gcj = GB[j];
#pragma unroll
        for (int r = 0; r < 4; ++r) { const int i = 16 * it + 4 * g + r; const float dec = i >= j ? __expf(GB[i] - gcj) : 0.f;
            AT[i * 68 + j] = i > j ? GB[64 + i] * kk[r] * dec : 0.f;
            *(LAS unsigned short*)(L + P_QKL + i * 144 + (32 * (j >> 5) + p) * 2) = bf1(qk[r] * dec); } }
    PBAR();
    if (wave >= 4) { const int t4 = tid - 256;
        for (int id = t4; id < 1024; id += 256) { const int k = id >> 3, sp = (id >> 2) & 1, gg = id & 3; float o8[8];
#pragma unroll
            for (int j = 0; j < 8; ++j) { const int cc = 32 * sp + (j < 4 ? 4 * gg + j : 16 + 4 * gg + j - 4);
                o8[j] = bflo((unsigned)*(const LAS unsigned short*)(L + P_KH + cc * 272 + k * 2)) * GB[192 + cc]; }
            v4u w; w.x = pkbf(o8[0], o8[1]); w.y = pkbf(o8[2], o8[3]); w.z = pkbf(o8[4], o8[5]); w.w = pkbf(o8[6], o8[7]);
            *(v4u*)(proj + (row0 + (k >> 1)) * PW + PC_K + h * HD + (k & 1) * 64 + 32 * sp + 8 * gg) = w; }
        for (int id = t4; id < 512; id += 256) { const int i = id >> 3, j8 = (id & 7) * 8;
            *(v4u*)(qks + i * 64 + j8) = *(const LAS v4u*)(L + P_QKL + i * 144 + j8 * 2); } }
    if (wave == 1 && u_next >= 0) dn_gates(F, u_next, R.ga, R.gb, GBn, lane);
    if (wave == 0) { const int bb = g, j = m; float X[16];
        X[0] = j == 0 ? 1.f : 0.f;
#pragma unroll
        for (int i = 1; i < 16; ++i) { const LAS float* Lr = AT + (16 * bb + i) * 68 + 16 * bb; float Lv[16];
#pragma unroll
            for (int q = 0; q < (i + 3) / 4; ++q) { const f32x4 t = *(const LAS f32x4*)(Lr + 4 * q); Lv[4 * q] = t[0]; Lv[4 * q + 1] = t[1]; Lv[4 * q + 2] = t[2]; Lv[4 * q + 3] = t[3]; }
            float acc = i == j ? 1.f : 0.f;
#pragma unroll
            for (int mm = 0; mm < i; ++mm) acc -= Lv[mm] * X[mm];
            X[i] = acc; }
#pragma unroll
        for (int i = 0; i < 16; ++i) AT[(16 * bb + i) * 68 + 16 * bb + j] = X[i]; }
    PBAR();
    if (wave < 2) { const int lo = 2 * wave, hi = 2 * wave + 1; LAS float* PS = (LAS float*)(L + P_PS) + wave * 320;
        f32x4 acc = {0.f, 0.f, 0.f, 0.f};
#pragma unroll
        for (int s = 0; s < 4; ++s) acc = mfma4(AT[(16 * hi + m) * 68 + 16 * lo + 4 * s + g], AT[(16 * lo + 4 * s + g) * 68 + 16 * lo + m], acc);
#pragma unroll
        for (int r = 0; r < 4; ++r) PS[(4 * g + r) * 20 + m] = acc[r];
        LDS_WAIT();
        f32x4 acc2 = {0.f, 0.f, 0.f, 0.f};
#pragma unroll
        for (int s = 0; s < 4; ++s) acc2 = mfma4(AT[(16 * hi + m) * 68 + 16 * hi + 4 * s + g], PS[(4 * s + g) * 20 + m], acc2);
#pragma unroll
        for (int r = 0; r < 4; ++r) AT[(16 * hi + 4 * g + r) * 68 + 16 * lo + m] = -acc2[r]; }
    PBAR();
    { LAS float* PS2 = (LAS float*)(L + P_PS2); const int ti = (wave >> 1) & 1, tj = wave & 1;
      if (wave < 4) { f32x4 acc = {0.f, 0.f, 0.f, 0.f};
#pragma unroll
          for (int s = 0; s < 8; ++s) acc = mfma4(AT[(32 + 16 * ti + m) * 68 + 4 * s + g], AT[(4 * s + g) * 68 + 16 * tj + m], acc);
#pragma unroll
          for (int r = 0; r < 4; ++r) PS2[(16 * ti + 4 * g + r) * 36 + 16 * tj + m] = acc[r]; }
      PBAR();
      if (wave < 4) { f32x4 acc = {0.f, 0.f, 0.f, 0.f};
#pragma unroll
          for (int s = 0; s < 8; ++s) acc = mfma4(AT[(32 + 16 * ti + m) * 68 + 32 + 4 * s + g], PS2[(4 * s + g) * 36 + 16 * tj + m], acc);
#pragma unroll
          for (int r = 0; r < 4; ++r) AT[(32 + 16 * ti + 4 * g + r) * 68 + 16 * tj + m] = -acc[r]; } }
    PBAR();
    { const int i = tid >> 3, j0 = (tid & 7) * 8; const f32x4 t0 = *(const LAS f32x4*)(AT + i * 68 + j0), t1 = *(const LAS f32x4*)(AT + i * 68 + j0 + 4);
      v4u w; w.x = pkbf(t0[0], t0[1]); w.y = pkbf(t0[2], t0[3]); w.z = pkbf(t1[0], t1[1]); w.w = pkbf(t1[2], t1[3]);
      *(LAS v4u*)(L + P_TB + i * 144 + j0 * 2) = w; }
    PBAR();
#pragma unroll
    for (int q = 0; q < 8; ++q) { const int tt = wave + 8 * q; f32x4 acc = {0.f, 0.f, 0.f, 0.f};
        if (tt < 32) { const int ct = tt >> 3, nt = tt & 7;
#pragma unroll
            for (int sp = 0; sp < 2; ++sp) acc = mfma16(*(const LAS dn_bf16x8*)(L + P_TB + (16 * ct + m) * 144 + (32 * sp + 8 * g) * 2), *(const LAS dn_bf16x8*)(L + P_VBT + (16 * nt + m) * 144 + (32 * sp + 8 * g) * 2), acc);
            const int v = 16 * nt + m;
            *(dn_u32x2*)(proj + (row0 + (v >> 1)) * PW + PC_V + h * HD + (v & 1) * 64 + 16 * ct + 4 * g) = pack4f(acc); }
        else { const int t2 = tt - 32, kt = t2 >> 2, ct = t2 & 3;
#pragma unroll
            for (int sp = 0; sp < 2; ++sp) acc = mfma16(*(const LAS dn_bf16x8*)(L + P_KBGT + (16 * kt + m) * 144 + (32 * sp + 8 * g) * 2), *(const LAS dn_bf16x8*)(L + P_TB + (16 * ct + m) * 144 + (32 * sp + 8 * g) * 2), acc);
            *(dn_u32x2*)(xbimg + (16 * ct + m) * 128 + 32 * (kt >> 1) + 8 * g + 4 * (kt & 1)) = pack4f(-acc); } }
    PBAR();
}
#undef PBAR
constexpr int S_WN = 0, S_QG = 17408, S_KDT = 34816, S_QKM = 53248, S_UT = 62464, S_OB = 80896, S_PSQ = 114688, S_ONW = 116736, S_Z = 117248, S_END = 152064;
static_assert(S_END <= MISC_OFF, "scan LDS map");
__device__ __forceinline__ void dn_scan_unit(const Frame& F, int bh) {
    const Tix T = tix(F.wv); const int tid = T.tid, lane = T.lane, wave = T.wave, m = lane & 15, g = lane >> 4, n0 = 32 * wave;
    const int b = bh >> 3, h = bh & 7;
    bf16* proj = (bf16*)(F.ws + WS_PROJ); const bf16* xbi = (const bf16*)((const unsigned char*)F.out + DO_WNEG); const bf16* qks = (const bf16*)((unsigned char*)F.out + DO_QKS); const float* egl = (const float*)((unsigned char*)F.out + DO_EGL);
    LAS unsigned char* L = F.lds;
    LAS float* OB = (LAS float*)(L + S_OB);
    constexpr int NC = SEQ / 64;
#define WGBAR() do { asm volatile("s_waitcnt lgkmcnt(0)" ::: "memory"); __builtin_amdgcn_s_barrier(); asm volatile("" ::: "memory"); } while (0)
    if (wave >= 4) {
        const int ht = tid - 256;
        const unsigned lo_lin = (unsigned)ht * 16u;
        const unsigned lo_qg = (unsigned)(((ht >> 4) * PW + (ht & 15) * 8) * 2);
        const unsigned lo_kv = (unsigned)(((ht >> 4) * PW + ((ht >> 3) & 1) * 64 + (ht & 7) * 8) * 2);
        const unsigned ld_a = (unsigned)((ht >> 4) * 272 + (ht & 15) * 16), ld_b = (unsigned)((ht >> 3) * 144 + (ht & 7) * 16);
        const unsigned lo_fin = (unsigned)(((ht >> 2) * PW + (ht & 3) * 8) * 2);
        v4u RP[12], RQ[10];
#define DN_LOAD_P(cc) do { const size_t r0_ = (size_t)b * SEQ + (cc) * 64; const size_t u_ = (size_t)bh * 32 + (cc);               \
        _Pragma("unroll") for (int j_ = 0; j_ < 4; ++j_) {                                                                                                \
            RP[j_] = __builtin_nontemporal_load((const v4u*)((const char*)(xbi + u_ * 8192 + 2048 * j_) + lo_lin));                                                                    \
            RP[4 + j_] = __builtin_nontemporal_load((const v4u*)((const char*)(proj + (r0_ + 16 * j_) * PW + PC_Q + h * HD) + lo_qg));                                                 \
            RP[8 + j_] = __builtin_nontemporal_load((const v4u*)((const char*)(proj + (r0_ + 16 * j_) * PW + PC_V + h * HD) + lo_kv)); } } while (0)
#define DN_LOAD_Q(cc) do { const size_t r0_ = (size_t)b * SEQ + (cc) * 64; const size_t u_ = (size_t)bh * 32 + (cc);     \
        _Pragma("unroll") for (int j_ = 0; j_ < 4; ++j_) {                                                                                                \
            RQ[j_] = __builtin_nontemporal_load((const v4u*)((const char*)(proj + (r0_ + 16 * j_) * PW + PC_K + h * HD) + lo_kv));                                                     \
            RQ[4 + j_] = __builtin_nontemporal_load((const v4u*)((const char*)(proj + (r0_ + 16 * j_) * PW + PC_Z + h * HD) + lo_qg)); }                                               \
        _Pragma("unroll") for (int j_ = 0; j_ < 2; ++j_) RQ[8 + j_] = __builtin_nontemporal_load((const v4u*)((const char*)(qks + u_ * 4096 + 2048 * j_) + lo_lin)); } while (0)
#define DN_WRITE_P() do { _Pragma("unroll") for (int j_ = 0; j_ < 4; ++j_) {                                                                               \
            *(LAS v4u*)(L + S_WN + ld_a + j_ * 4352) = RP[j_]; *(LAS v4u*)(L + S_QG + ld_a + j_ * 4352) = RP[4 + j_]; *(LAS v4u*)(L + S_UT + ld_b + j_ * 4608) = RP[8 + j_]; } } while (0)
#define DN_WRITE_Q(cc) do { _Pragma("unroll") for (int j_ = 0; j_ < 4; ++j_) { *(LAS v4u*)(L + S_KDT + ld_b + j_ * 4608) = RQ[j_];                         \
            *(LAS v4u*)(L + S_Z + ((cc) & 1) * 17408 + ld_a + j_ * 4352) = RQ[4 + j_]; }                                                                    \
        _Pragma("unroll") for (int j_ = 0; j_ < 2; ++j_) *(LAS v4u*)(L + S_QKM + ld_b + j_ * 4608) = RQ[8 + j_]; } while (0)
#define DN_FINAL(cc) do { const int fr_ = ht >> 2, fc_ = (ht & 3) * 8; float ss_ = 0.f;     \
        _Pragma("unroll") for (int p_ = 0; p_ < 8; ++p_) { const f32x4 o_ = *(const LAS f32x4*)(OB + fr_ * 132 + fc_ + 32 * (p_ >> 1) + 4 * (p_ & 1));                 \
            ss_ += (o_[0] * o_[0] + o_[1] * o_[1]) + (o_[2] * o_[2] + o_[3] * o_[3]); }                                                                     \
        ss_ += dppf<0xB1>(ss_); ss_ += dppf<0x4E>(ss_);                                                                                                     \
        const float rn_ = rsqrtf(ss_ * (1.f / 128.f) + EPS);                                                                                               \
        bf16* dst_ = (bf16*)((char*)(proj + ((size_t)b * SEQ + (cc) * 64) * PW + PC_Q + h * HD) + lo_fin);              \
        _Pragma("unroll") for (int p_ = 0; p_ < 4; ++p_) {                                                                                                 \
            const f32x4 oa_ = *(const LAS f32x4*)(OB + fr_ * 132 + fc_ + 32 * p_), ob_ = *(const LAS f32x4*)(OB + fr_ * 132 + fc_ + 32 * p_ + 4);           \
            const v4u z_ = *(const LAS v4u*)(L + S_Z + ((cc) & 1) * 17408 + fr_ * 272 + (fc_ + 32 * p_) * 2);                                               \
            v4u w_; w_.x = pkbf(oa_[0] * rn_ * bflo(z_.x), oa_[1] * rn_ * bfhi(z_.x)); w_.y = pkbf(oa_[2] * rn_ * bflo(z_.y), oa_[3] * rn_ * bfhi(z_.y));   \
            w_.z = pkbf(ob_[0] * rn_ * bflo(z_.z), ob_[1] * rn_ * bfhi(z_.z)); w_.w = pkbf(ob_[2] * rn_ * bflo(z_.w), ob_[3] * rn_ * bfhi(z_.w));           \
            *(v4u*)(dst_ + 32 * p_) = w_; } } while (0)
        DN_LOAD_P(0); DN_LOAD_Q(0); DN_WRITE_P(); DN_WRITE_Q(0); DN_LOAD_P(1); DN_LOAD_Q(1);
        WGBAR();
        for (int c = 0; c < NC; ++c) {
            if (c > 0) { DN_FINAL(c - 1); DN_WRITE_Q(c); if (c + 1 < NC) DN_LOAD_Q(c + 1); }
            WGBAR();
            if (c + 1 < NC) { DN_WRITE_P(); if (c + 2 < NC) DN_LOAD_P(c + 2); }
            WGBAR();
        }
        DN_FINAL(NC - 1);
#undef DN_LOAD_P
#undef DN_LOAD_Q
#undef DN_WRITE_P
#undef DN_WRITE_Q
#undef DN_FINAL
    } else {
        f32x4 Sacc[2][8];
#pragma unroll
        for (int kt = 0; kt < 8; ++kt) { Sacc[0][kt] = (f32x4){0.f, 0.f, 0.f, 0.f}; Sacc[1][kt] = (f32x4){0.f, 0.f, 0.f, 0.f}; }
        const unsigned* eglu = (const unsigned*)egl + (size_t)bh * 32;
        float eg_next = __uint_as_float(__hip_atomic_load(eglu, __ATOMIC_RELAXED, __HIP_MEMORY_SCOPE_AGENT));
        const LAS unsigned char* fa = L + m * 272 + g * 16;
        const LAS unsigned char* fb = L + m * 144 + g * 16;
#define SBAR() __builtin_amdgcn_sched_barrier(0)
#define LD_A(X, base, ct) do { _Pragma("unroll") for (int s_ = 0; s_ < 4; ++s_) X[s_] = *(const LAS dn_bf16x8*)(fa + (base) + (ct) * 4352 + s_ * 64); } while (0)
#define LD_B(X, base, i0) do { _Pragma("unroll") for (int s_ = 0; s_ < 4; ++s_) X[s_] = *(const LAS dn_bf16x8*)(fb + (base) + ((i0) + (s_ >> 1)) * 2304 + (s_ & 1) * 64); } while (0)
        WGBAR();
        for (int c = 0; c < NC; ++c) {
            const float eg = eg_next;
            if (c + 1 < NC) eg_next = __uint_as_float(__hip_atomic_load(eglu + c + 1, __ATOMIC_RELAXED, __HIP_MEMORY_SCOPE_AGENT));
            dn_bf16x8 SB[2][4], X0[4], X1[4];
            LD_A(X0, S_WN, 0);
#pragma unroll
            for (int sl = 0; sl < 2; ++sl)
#pragma unroll
                for (int s = 0; s < 4; ++s) SB[sl][s] = pack8f(Sacc[sl][2 * s], Sacc[sl][2 * s + 1]);
            f32x4 VN[2][4], O[2][4];
#pragma unroll
            for (int ct = 0; ct < 4; ++ct)
#pragma unroll
                for (int sl = 0; sl < 2; ++sl) { const dn_u32x2 uu = *(const LAS dn_u32x2*)(L + S_UT + (n0 + 16 * sl + m) * 144 + (16 * ct + 4 * g) * 2);
                    VN[sl][ct] = (f32x4){bflo(uu.x), bfhi(uu.x), bflo(uu.y), bfhi(uu.y)}; O[sl][ct] = (f32x4){0.f, 0.f, 0.f, 0.f}; }
#pragma unroll
            for (int ct = 0; ct < 4; ++ct) {
                SBAR(); LD_A(X1, S_QG, ct); SBAR();
#pragma unroll
                for (int s = 0; s < 4; ++s) { VN[0][ct] = mfma16(X0[s], SB[0][s], VN[0][ct]); VN[1][ct] = mfma16(X0[s], SB[1][s], VN[1][ct]); }
                SBAR(); if (ct < 3) LD_A(X0, S_WN, ct + 1); SBAR();
#pragma unroll
                for (int s = 0; s < 4; ++s) { O[0][ct] = mfma16(X1[s], SB[0][s], O[0][ct]); O[1][ct] = mfma16(X1[s], SB[1][s], O[1][ct]); }
            }
            dn_bf16x8 VNB[2][2];
#pragma unroll
            for (int sl = 0; sl < 2; ++sl)
#pragma unroll
                for (int sp = 0; sp < 2; ++sp) VNB[sl][sp] = pack8f(VN[sl][2 * sp], VN[sl][2 * sp + 1]);
            WGBAR();
            SBAR(); LD_B(X0, S_QKM, 0); LD_B(X1, S_QKM, 2); SBAR();
#pragma unroll
            for (int s = 0; s < 4; ++s) { O[0][s >> 1] = mfma16(X0[s], VNB[0][s & 1], O[0][s >> 1]); O[1][s >> 1] = mfma16(X0[s], VNB[1][s & 1], O[1][s >> 1]); }
            SBAR(); LD_B(X0, S_KDT, 0); SBAR();
#pragma unroll
            for (int s = 0; s < 4; ++s) { O[0][2 + (s >> 1)] = mfma16(X1[s], VNB[0][s & 1], O[0][2 + (s >> 1)]); O[1][2 + (s >> 1)] = mfma16(X1[s], VNB[1][s & 1], O[1][2 + (s >> 1)]); }
#pragma unroll
            for (int kt = 0; kt < 8; ++kt) { Sacc[0][kt] = Sacc[0][kt] * eg; Sacc[1][kt] = Sacc[1][kt] * eg; }
#pragma unroll
            for (int q = 0; q < 4; ++q) {
                if (q & 1) { SBAR(); if (q < 3) LD_B(X0, S_KDT, 2 * q + 2); SBAR();
#pragma unroll
                    for (int s = 0; s < 4; ++s) { Sacc[0][2 * q + (s >> 1)] = mfma16(X1[s], VNB[0][s & 1], Sacc[0][2 * q + (s >> 1)]); Sacc[1][2 * q + (s >> 1)] = mfma16(X1[s], VNB[1][s & 1], Sacc[1][2 * q + (s >> 1)]); } }
                else { SBAR(); LD_B(X1, S_KDT, 2 * q + 2); SBAR();
#pragma unroll
                    for (int s = 0; s < 4; ++s) { Sacc[0][2 * q + (s >> 1)] = mfma16(X0[s], VNB[0][s & 1], Sacc[0][2 * q + (s >> 1)]); Sacc[1][2 * q + (s >> 1)] = mfma16(X0[s], VNB[1][s & 1], Sacc[1][2 * q + (s >> 1)]); } }
            }
#pragma unroll
            for (int sl = 0; sl < 2; ++sl)
#pragma unroll
                for (int ct = 0; ct < 4; ++ct)
#pragma unroll
                    for (int r = 0; r < 4; ++r) OB[(16 * ct + 4 * g + r) * 132 + n0 + 16 * sl + m] = O[sl][ct][r];
            WGBAR();
        }
#undef SBAR
#undef LD_A
#undef LD_B
    }
#undef WGBAR
}
__device__ __forceinline__ void fox_blk(const Frame& F, int it, int j, att::Blk& k) {
    const int bh = it >> 2, y = it & 3, qb = j == 0 ? 7 - y : y, b = bh >> 3, h = bh & 7; const size_t row0 = (size_t)b * SEQ + qb * 256;
    bf16* proj = (bf16*)(F.ws + WS_PROJ);
    k.Q = proj + row0 * PW + PC_Q + h * HD; k.K = proj + (size_t)b * SEQ * PW + PC_K + h * HD; k.voff = PC_V - PC_K; k.goff = PC_Z - PC_Q;
    k.flog = (const float*)(F.ws + WS_AB) + (size_t)b * SEQ * 16 + h; k.fb = F.in[I_FOXFB][h]; k.P0 = qb * 256; k.skv = SEQ; k.kvpitch = PW; k.reuse = j; k.lim = 1e30f;
}
__device__ __forceinline__ void mem_blk(const Frame& F, int idx, att::Blk& k) {
    const int b = idx >> 5, hm = (idx >> 3) & 3, qb = idx & 7; const size_t row0 = (size_t)b * SEQ + qb * 256;
    bf16* proj = (bf16*)(F.ws + WS_PROJ); const bf16* mkv = (const bf16*)(F.ws + WS_MEMKV);
    static_assert(att::QP == PW, "attention Q pitch");
    k.Q = proj + row0 * PW + PC_QM + hm * HD; k.K = mkv + (size_t)b * NMEM * DM + hm * HD; k.voff = 512; k.goff = 0;
    k.flog = nullptr; k.fb = 0.f; k.P0 = 1 << 20; k.skv = NMEM; k.kvpitch = DM; k.reuse = 0; k.lim = 1e30f;
}
struct SrcL1 { const Frame* F; int vcu;
    __device__ __forceinline__ bool operator()(int n, att::Blk& k) const { const int it = vcu + (n / 3) * F->G, j = n % 3; if (it >= 256) return false;
        if (j < 2) fox_blk(*F, it, j, k); else mem_blk(*F, it, k); return true; } };
struct SrcDyn { const Frame* F; int it; unsigned* ctr; volatile LAS unsigned* slot; float lim; int mode;
    __device__ __forceinline__ bool operator()(int n, att::Blk& k) const {
        if (mode == 0) { if (n >= 2) return false; fox_blk(*F, it, n, k); k.lim = lim; return true; }
        if (F->wv == 0 && lane_id() == 0) *slot = __hip_atomic_fetch_add(ctr, 1u, __ATOMIC_RELAXED, __HIP_MEMORY_SCOPE_AGENT);
        __syncthreads(); const unsigned t = *slot; __syncthreads();
        if (t >= 32u) return false;
        mem_blk(*F, (it & ~31) + (int)t, k); return true; } };
struct SrcL0 { const Frame* F; int first, stride;
    __device__ __forceinline__ bool operator()(int n, att::Blk& k) const { const int idx = first + n * stride; if (idx >= 256) return false; mem_blk(*F, idx, k); return true; } };
__device__ __forceinline__ void narrow_ab_unit(const Frame& F, int pm, int q) {
    const Tix T = tix(F.wv); const int lane = T.lane, wave = T.wave, m = lane & 15, g = lane >> 4, t = wave & 3, kh = wave >> 2;
    const size_t row_t = (size_t)pm * 256 + 64 * q + 16 * t;
    const bf16* A = (const bf16*)(F.ws + WS_XB) + (row_t + m) * DM + 512 * kh + 8 * g; const bf16* B = (const bf16*)(F.ws + WS_WIN0) + (size_t)(PC_AB + m) * DM + 512 * kh + 8 * g;
    dn_bf16x8 a[16], b[16];
#pragma unroll
    for (int s = 0; s < 16; ++s) { a[s] = *(const dn_bf16x8*)(A + 32 * s); b[s] = *(const dn_bf16x8*)(B + 32 * s); }
    f32x4 acc = {0.f, 0.f, 0.f, 0.f};
#pragma unroll
    for (int s = 0; s < 16; ++s) acc = mfma16(a[s], b[s], acc);
    LAS f32x4* X = (LAS f32x4*)F.lds;
    if (kh) X[t * 64 + lane] = acc;
    const float* xsq = (const float*)(F.ws + WS_XSQ); float* ab = (float*)(F.ws + WS_AB);
    float rs[4];
    if (!kh) {
#pragma unroll
        for (int r = 0; r < 4; ++r) { const float* qq = xsq + (row_t + 4 * g + r) * 16;
            const f32x4 tt = (*(const f32x4*)qq + *(const f32x4*)(qq + 4)) + (*(const f32x4*)(qq + 8) + *(const f32x4*)(qq + 12));
            rs[r] = rsqrtf(((tt[0] + tt[1]) + (tt[2] + tt[3])) * (1.0f / 1024.0f) + EPS); } }
    __syncthreads();
    if (!kh) { const f32x4 o = X[t * 64 + lane];
#pragma unroll
        for (int r = 0; r < 4; ++r) ab[(row_t + 4 * g + r) * 16 + m] = (acc[r] + o[r]) * rs[r]; }
    __syncthreads();
}
constexpr int CW_SHD = 196608;
__device__ __forceinline__ void shadow_barrier(const Frame& F, unsigned want) {
    asm volatile("s_waitcnt vmcnt(0)" ::: "memory");
    __syncthreads();
    if (F.wv == 0 && lane_id() == 0) { unsigned* p = (unsigned*)((gu32*)(F.ws + WS_CTL) + CW_SHD);
        __builtin_amdgcn_fence(__ATOMIC_RELEASE, "agent"); asm volatile("s_waitcnt vmcnt(0)" ::: "memory");
        (void)__hip_atomic_fetch_add(p, 1u, __ATOMIC_RELAXED, __HIP_MEMORY_SCOPE_AGENT);
        unsigned sp = 0;
        while (__hip_atomic_load(p, __ATOMIC_RELAXED, __HIP_MEMORY_SCOPE_AGENT) < want) { __builtin_amdgcn_s_sleep(2); if (++sp > (1u << 22)) { atomicAdd((unsigned*)((gu32*)(F.ws + WS_CTL) + CW_BAR) + XB_TMO, 1u); break; } }
        __builtin_amdgcn_fence(__ATOMIC_ACQUIRE, "agent"); asm volatile("s_waitcnt vmcnt(0)" ::: "memory"); }
    __syncthreads();
}
constexpr int CW_CLS = 196608 + 4096;
__device__ __forceinline__ void class_sync(const Frame& F, int which, unsigned want, bool same_l2, bool wait) {
    asm volatile("s_waitcnt vmcnt(0)" ::: "memory");
    __syncthreads();
    if (F.wv == 0 && lane_id() == 0) { unsigned* p = (unsigned*)((gu32*)(F.ws + WS_CTL) + CW_CLS) + ((F.bid & 7) * 4 + which) * 32;
        if (!same_l2) { __builtin_amdgcn_fence(__ATOMIC_RELEASE, "agent"); asm volatile("s_waitcnt vmcnt(0)" ::: "memory"); }
        (void)__hip_atomic_fetch_add(p, 1u, __ATOMIC_RELAXED, __HIP_MEMORY_SCOPE_AGENT);
        if (wait) { unsigned sp = 0;
            while (__hip_atomic_load(p, __ATOMIC_RELAXED, __HIP_MEMORY_SCOPE_AGENT) < want) { __builtin_amdgcn_s_sleep(1); if (++sp > (1u << 22)) { atomicAdd((unsigned*)((gu32*)(F.ws + WS_CTL) + CW_BAR) + XB_TMO, 1u); break; } }
            __builtin_amdgcn_fence(__ATOMIC_ACQUIRE, "agent"); asm volatile("s_waitcnt vmcnt(0)" ::: "memory"); } }
    __syncthreads();
}
#define IN(k) (lo <= (k) && (k) < hi)
#define SEAM(k) do { if (IN(k) && IN((k) + 1)) xcd_barrier(bar); } while (0)
#define SEAMG(k, s_) do { if (IN(k) && IN((k) + 1)) { if (gb.on) grp_barrier(gb, (s_)); else xcd_barrier(bar); } } while (0)
template <int layer> __device__ __forceinline__ void layer_body(const Frame& F, const XcdBarrier& bar, GrpBar& gb, bool grp_try, bool cls_ok, int lo, int hi, unsigned char* lds) {
    bf16* proj = (bf16*)(F.ws + WS_PROJ); bf16* xb = (bf16*)(F.ws + WS_XB); float* xsq = (float*)(F.ws + WS_XSQ);
    float* ab = (float*)(F.ws + WS_AB);

        const int pb = 1 + (layer ? 6 : 0);
        if (IN(pb)) {
            pg8::Gemm g{xb, (const bf16*)(F.ws + (layer ? WS_WIN1 : WS_WIN0)), MROWS, layer ? N_IN : 4096, DM, DM}; pg8::StaticOrder S; S.init(MROWS, layer ? N_IN : 4096, F.G, F.bid);
            const float* nk = layer ? F.in[I_FOXKNW] : nullptr; const float* nq = layer ? F.in[I_FOXQNW] : nullptr;
            pg8::EpiProj<true, false, layer == 0> E{proj, PW, xsq, ab, 18, (bf16*)((unsigned char*)F.out + DO_HALO), 0, layer ? 4 : 0, nk, 12, layer ? 16 : 12, nq, 16, 18, F.in[I_MEMQNW] + layer * HD, 8, 12, layer ? 2 : 1, F.in[I_DNONW]};
            pg8::gemm_phase<pg8::EpiProj<true, false, layer == 0>, pg8::StaticOrder, true, true>(F.lds, g, S, E, F.wv);
            if (layer == 0) { __syncthreads(); for (int u = F.bid; u < 256; u += F.G) narrow_ab_unit(F, 8 * (u & 7) + ((u >> 3) & 7), u >> 6); }
        }
        if (grp_try) { if (IN(pb) && IN(pb + 1)) class_sync(F, layer ? 2 : 0, 32u, cls_ok, true); } else SEAM(pb);
        const int pm = pb + (layer ? 1 : 2);
        if (layer == 0) {
            if (IN(pb + 1)) {
                if (grp_try) { const int x = F.bid & 7, i = F.bid >> 3, u0 = (8 * x + (i >> 2)) * 32 + 8 * (i & 3);
                    DnPre R; dn_prep_load(F, u0, R);
                    for (int k = 0; k < 8; ++k) dn_prep_unit(F, u0 + k, k < 7 ? u0 + k + 1 : -1, R, k & 1, k == 0); }
                else { constexpr int NU = BATCH * NH * (SEQ / 64); DnPre R; int u = F.bid; if (u < NU) dn_prep_load(F, u, R);
                       for (int k = 0; u < NU; u += F.G, ++k) dn_prep_unit(F, u, u + F.G < NU ? u + F.G : -1, R, k & 1, k == 0); } }
            if (grp_try) { if (IN(pb + 1) && IN(pb + 2)) class_sync(F, 1, 32u, cls_ok, F.bid < 64); } else SEAM(pb + 1);
        }
        if (IN(pm)) {
            if (layer == 0) {
                if (F.bid < 64) dn_scan_unit(F, grp_try ? 8 * (F.bid & 7) + (F.bid >> 3) : F.bid);
                else {
                    { const pg8::StrideUnits Sq{F.bid - 64, F.G - 64, 128, 1};
                      pg8::Gemm g{xb, (const bf16*)(F.ws + WS_WIN0), MROWS, N_IN, DM, DM};
                      pg8::EpiProj<true, false> E{proj, PW, xsq, nullptr, 18, nullptr, 0, 0, nullptr, 0, 0, nullptr, 16, 18, F.in[I_MEMQNW], 0, 0, 0, nullptr};
                      pg8::gemm_phase<pg8::EpiProj<true, false>, pg8::StrideUnits, true, true>(F.lds, g, Sq, E, F.wv);
                      const pg8::StrideUnits Sm{F.G - 1 - F.bid, F.G - 64, 32, 0};
                      pg8::Gemm g2{(const bf16*)((unsigned char*)F.out + DO_MEMB), (const bf16*)(F.ws + WS_WMKV), MMEM, DM, DM, DM};
                      pg8::EpiProj<true, false> E2{(bf16*)(F.ws + WS_MEMKV), DM, (const float*)(F.ws + WS_MSQ), nullptr, 4, nullptr, 0, 2, F.in[I_MEMKNW], 0, 0, nullptr, 0, 0, nullptr, 0, 0, 0, nullptr};
                      pg8::gemm_phase<pg8::EpiProj<true, false>, pg8::StrideUnits, true, true>(F.lds, g2, Sm, E2, F.wv); }
                    __syncthreads();
                    { const Tix T = tix(F.wv); convert_weights<6, 18>(F, (LAS float*)(F.lds + T.wave * 17408), T.lane, (F.bid - 64) * NWAVES + T.wave, (F.G - 64) * NWAVES, 0); }
                    shadow_barrier(F, (unsigned)(F.G - 64));
                    const SrcL0 src{&F, F.bid - 64, F.G - 64}; att::phase((char*)lds, src, F.wv); }
            } else {
                const int vcu = (F.G % 8 == 0) ? (F.bid % 8) * (F.G / 8) + F.bid / 8 : F.bid;
                if (grp_try) {
                    const Tix T = tix(F.wv); const float* wqn = F.in[I_FOXQNW]; const float* wkn = F.in[I_FOXKNW];
                    const float wq = wave_max(fmaxf(fabsf(wqn[T.lane]), fabsf(wqn[T.lane + 64]))), wk = wave_max(fmaxf(fabsf(wkn[T.lane]), fabsf(wkn[T.lane + 64])));
                    const float lim = 2.f * att::SCALE * (128.f * 1.02f * wq * wk) + att::THR + 105.f;
                    SrcDyn src{&F, vcu, (unsigned*)((gu32*)(F.ws + WS_CTL) + CW_CLS) + 2048 + (F.bid & 7) * 32, (volatile LAS unsigned*)(F.lds + MISC_OFF) + 12, lim, 0};
                    att::phase((char*)lds, src, F.wv); __syncthreads(); src.mode = 1; att::phase((char*)lds, src, F.wv); }
                else { const SrcL1 src{&F, vcu}; att::phase((char*)lds, src, F.wv); }
            }
            __syncthreads();
        }
        if (layer == 1 && grp_try) { if (IN(pm) && IN(pm + 1)) class_sync(F, 3, 32u, cls_ok, true); } else SEAM(pm);
        if (layer == 0 && grp_try) gb.on = __hip_atomic_load((unsigned*)((gu32*)(F.ws + WS_CTL) + CW_BAD), __ATOMIC_RELAXED, __HIP_MEMORY_SCOPE_AGENT) == 0u;
        if (IN(pm + 1)) {
            pg8::Gemm g{proj + PC_Q, (const bf16*)(F.ws + (layer ? WS_WOUT1 : WS_WOUT0)), MROWS, DM, OUT_IN, PW}; pg8::StaticOrder S; S.init(MROWS, DM, F.G, F.bid);
            pg8::EpiRes<false> E{xb, F.out, xsq, nullptr};
            pg8::gemm_phase<pg8::EpiRes<false>, pg8::StaticOrder, true, true>(F.lds, g, S, E, F.wv);
        }
        SEAMG(pm + 1, layer * 3 + 0);
        if (IN(pm + 2)) {
            pg8::Gemm g{xb, (const bf16*)(F.ws + (layer ? WS_WM1_1 : WS_WM1_0)), MROWS, FF, DM, DM}; pg8::StaticOrder S; S.init(MROWS, FF, F.G, F.bid);
            pg8::EpiProj<false, true> E{proj, FF, xsq, nullptr, 16, nullptr, 0, 0, nullptr, 0, 0, nullptr, 0, 0, nullptr, 0, 0, 0, nullptr};
            pg8::gemm_phase<pg8::EpiProj<false, true>, pg8::StaticOrder, true, true>(F.lds, g, S, E, F.wv);
        }
        SEAMG(pm + 2, layer * 3 + 1);
        if (IN(pm + 3)) {
            pg8::Gemm g{proj, (const bf16*)(F.ws + (layer ? WS_WM2_1 : WS_WM2_0)), MROWS, DM, FF, FF}; pg8::StaticOrder S; S.init(MROWS, DM, F.G, F.bid);
            pg8::EpiRes<layer == 1> E{xb, F.out, xsq, nullptr};
            pg8::gemm_phase<pg8::EpiRes<layer == 1>, pg8::StaticOrder, true, true>(F.lds, g, S, E, F.wv);
        }
        if (layer == 0) SEAMG(pm + 3, 2); else SEAM(pm + 3);
    }
#undef IN
#undef SEAM
#undef SEAMG
__global__ void __launch_bounds__(NWAVES * 64, 2) hyb_fwd(Args args) {
    extern __shared__ __attribute__((aligned(16))) unsigned char lds[];
    Frame F;
    F.lds = (LAS unsigned char*)lds;
    F.G = gridDim.x; F.bid = blockIdx.x; F.in = args.in; F.out = args.out; F.ws = args.ws; F.wv = __builtin_amdgcn_readfirstlane((int)threadIdx.x >> 6);
    volatile LAS unsigned* MISC = (volatile LAS unsigned*)(F.lds + MISC_OFF);
    gu32* ctl = (gu32*)(args.ws + WS_CTL);
    for (int u = threadIdx.x; u < (LDS_BYTES - MISC_OFF) / 4; u += NWAVES * 64) ((LAS unsigned*)(F.lds + MISC_OFF))[u] = 0u;
    __syncthreads();
    XcdBarrier bar; bar.bar = (unsigned*)(ctl + CW_BAR) + args.li * XCD_BAR_WORDS; bar.x = 0; bar.st = nullptr; bar.wv = F.wv;
    if (!MK_LAUNCH_PER_PHASE) { bar = xcd_barrier_post((unsigned*)(ctl + CW_BAR) + args.li * XCD_BAR_WORDS, MISC + 8); bar.wv = F.wv; }
    const int lo = args.ph_lo, hi = args.ph_hi;
#define IN(k) (lo <= (k) && (k) < hi)
#define SEAM(k) do { if (IN(k) && IN((k) + 1)) xcd_barrier(bar); } while (0)
    bf16* proj = (bf16*)(F.ws + WS_PROJ); bf16* xb = (bf16*)(F.ws + WS_XB); float* xsq = (float*)(F.ws + WS_XSQ);
    float* ab = (float*)(F.ws + WS_AB);

    GrpBar gb; gb.cnt = (unsigned*)(ctl + CW_GRP) + (size_t)(F.bid & 63) * 8 * 64; gb.tmo = (unsigned*)(ctl + CW_BAR) + XB_TMO; gb.wv = F.wv; gb.on = false;
    const bool grp_try = !MK_LAUNCH_PER_PHASE && F.G == 256 && lo == 0 && hi == N_PHASES;
    if (grp_try && F.wv == 0 && lane_id() == 0) __hip_atomic_store((unsigned*)(ctl + CW_XCC) + F.bid, xb_xcc_id() + 1u, __ATOMIC_RELAXED, __HIP_MEMORY_SCOPE_AGENT);
    if (IN(0)) { p0_prologue(F); } SEAM(0);
    if (grp_try && F.wv == 0 && lane_id() == 0) { const unsigned mine = xb_xcc_id() + 1u; bool same = true;
        for (int k = 1; k < 4; ++k) same = same && __hip_atomic_load((unsigned*)(ctl + CW_XCC) + ((F.bid + 64 * k) & 255), __ATOMIC_RELAXED, __HIP_MEMORY_SCOPE_AGENT) == mine;
        if (!same) atomicAdd((unsigned*)(ctl + CW_BAD), 1u);
        bool cls = true;
        for (int k = 0; k < 32; ++k) cls = cls && __hip_atomic_load((unsigned*)(ctl + CW_XCC) + ((F.bid & 7) + 8 * k), __ATOMIC_RELAXED, __HIP_MEMORY_SCOPE_AGENT) == mine;
        MISC[10] = cls ? 1u : 0u; }
    __syncthreads();
    const bool cls_ok = grp_try && MISC[10] != 0u;

    layer_body<0>(F, bar, gb, grp_try, cls_ok, lo, hi, lds);
    layer_body<1>(F, bar, gb, grp_try, cls_ok, lo, hi, lds);
#undef IN
#undef SEAM
}

extern "C" void kernel_launch(void* const* d_in, const int* in_sizes, int n_in, void* d_out, int out_size, void* d_ws, size_t ws_size, hipStream_t stream) {
    static int grid = 0;
    if (grid == 0) {
        if (n_in != 20 || in_sizes[0] != MROWS * DM || out_size != MROWS * DM || ws_size < WS_END) {
            fprintf(stderr, "kernel_launch: shape/workspace mismatch (n_in %d, in0 %d, out %d, ws %zu; need ws >= %zu); nothing launched\n", n_in, n_in > 0 ? in_sizes[0] : -1, out_size, ws_size, (size_t)WS_END); grid = -1; return; }
        int dev = 0, cus = 0, per_cu = 0;
        if (hipGetDevice(&dev) != hipSuccess || hipDeviceGetAttribute(&cus, hipDeviceAttributeMultiprocessorCount, dev) != hipSuccess) { fprintf(stderr, "kernel_launch: device query failed\n"); grid = -1; return; }
        if (hipFuncSetAttribute((const void*)hyb_fwd, hipFuncAttributeMaxDynamicSharedMemorySize, LDS_BYTES) != hipSuccess) { fprintf(stderr, "kernel_launch: hipFuncSetAttribute failed\n"); grid = -1; return; }
        if (hipOccupancyMaxActiveBlocksPerMultiprocessor(&per_cu, (const void*)hyb_fwd, NWAVES * 64, LDS_BYTES) != hipSuccess || per_cu < 1) {
            fprintf(stderr, "kernel_launch: occupancy query reports %d workgroups per CU; nothing launched\n", per_cu); (void)hipGetLastError(); grid = -1; return; }
        if (cus < 128) { fprintf(stderr, "kernel_launch: %d CUs; this kernel's phase program needs at least 128 workgroups; nothing launched\n", cus); grid = -1; return; }
        grid = cus;
    }
    if (grid < 0) return;
    if (hipMemsetAsync((char*)d_ws + WS_CTL, 0, CTL_ZERO_BYTES, stream) != hipSuccess) { fprintf(stderr, "kernel_launch: memset failed\n"); return; }
    Args a{};
    for (int i = 0; i < 20; ++i) a.in[i] = (const float*)d_in[i];
    a.out = (float*)d_out; a.ws = (unsigned char*)d_ws;
#if MK_LAUNCH_PER_PHASE
    for (int p = 0; p < N_PHASES; ++p) { a.ph_lo = p; a.ph_hi = p + 1; a.li = 0; hipLaunchKernelGGL(hyb_fwd, dim3(grid), dim3(NWAVES * 64), LDS_BYTES, stream, a); }
#else
    a.ph_lo = 0; a.ph_hi = N_PHASES; a.li = 0;
    hipLaunchKernelGGL(hyb_fwd, dim3(grid), dim3(NWAVES * 64), LDS_BYTES, stream, a);
#endif
    const hipError_t le = hipPeekAtLastError();
    if (le != hipSuccess) fprintf(stderr, "kernel_launch: launch failed: %s\n", hipGetErrorName(le));
}
```
